# Optimizing an MI355X kernel written in HIP

```python
import math
import jax
import jax.numpy as jnp
from jax import lax
import numpy as np

D_MODEL = 1024
BATCH = 8
SEQ = 2048
DEPTH = 2

GRID_W = 64
CTX_LEN = 256
N_MIXERS = 2
N_MLA_LAYERS = (DEPTH + N_MIXERS - 1) // N_MIXERS
N_S5_LAYERS = DEPTH // N_MIXERS
EPS = 1e-6

MLA_HEADS = 16
QK_NOPE_DIM = 64
QK_ROPE_DIM = 32
V_HEAD_DIM = 64
Q_LORA_RANK = 256
KV_LORA_RANK = 128
MLA_WIDTH = MLA_HEADS * V_HEAD_DIM
QK_DIM = QK_NOPE_DIM + QK_ROPE_DIM
SOFTMAX_SCALE = QK_DIM ** -0.5
ROPE_THETA = 10000.0
Q_BLOCK = 128
MLA_IN_WIDTH = Q_LORA_RANK + KV_LORA_RANK + QK_ROPE_DIM + MLA_WIDTH

S5_WIDTH = D_MODEL
S5_GROUP = 16
S5_GROUPS = S5_WIDTH // S5_GROUP
S5_STATE = 64
DT_MIN = 0.001
DT_MAX = 0.1

kernel_name = "hybrid_mla_s5_context_prefix_dit"


def rmsnorm(x, g):
    xf = x.astype(jnp.float32)
    y = xf * lax.rsqrt(jnp.mean(xf * xf, axis=-1, keepdims=True) + EPS)
    return (y * g.astype(jnp.float32)).astype(x.dtype)


def grid_positions(L):
    rows = L // GRID_W
    row = jnp.repeat(jnp.arange(rows, dtype=jnp.int32), GRID_W)
    col = jnp.tile(jnp.arange(GRID_W, dtype=jnp.int32), rows)
    return row, col


def rope_1d(x, pos):
    d = x.shape[-1]
    inv = 1.0 / (ROPE_THETA ** (jnp.arange(0, d, 2, dtype=jnp.float32) / d))
    ang = pos.astype(jnp.float32)[:, None] * inv[None, :]
    cos = jnp.cos(ang)[:, None, :].astype(x.dtype)
    sin = jnp.sin(ang)[:, None, :].astype(x.dtype)
    x1, x2 = x[..., : d // 2], x[..., d // 2:]
    return jnp.concatenate([x1 * cos - x2 * sin, x1 * sin + x2 * cos], axis=-1)


def axial_rope(x, row, col):
    h = x.shape[-1] // 2
    return jnp.concatenate([rope_1d(x[..., :h], row), rope_1d(x[..., h:], col)], axis=-1)


def mla_project(h, w_in, q_norm, w_uq, kv_norm, w_ukv):
    B_, L, _ = h.shape
    p = h @ w_in
    o1 = Q_LORA_RANK
    o2 = o1 + KV_LORA_RANK
    o3 = o2 + QK_ROPE_DIM
    cq, ckv, kr, z = p[..., :o1], p[..., o1:o2], p[..., o2:o3], p[..., o3:]
    q = (rmsnorm(cq, q_norm) @ w_uq).reshape(B_, L, MLA_HEADS, QK_DIM)
    kv = (rmsnorm(ckv, kv_norm) @ w_ukv).reshape(B_, L, MLA_HEADS, QK_NOPE_DIM + V_HEAD_DIM)
    q_nope, q_rope = q[..., :QK_NOPE_DIM], q[..., QK_NOPE_DIM:]
    k_nope, v = kv[..., :QK_NOPE_DIM], kv[..., QK_NOPE_DIM:]
    return q_nope, q_rope, k_nope, kr[:, :, None, :], v, z


def mla_keys(k_nope, kr):
    kr_b = jnp.broadcast_to(kr, k_nope.shape[:-1] + (QK_ROPE_DIM,))
    return jnp.concatenate([k_nope, kr_b], axis=-1)


def attend(q, k, v):
    s = jnp.einsum('bqhd,bkhd->bhqk', q.astype(jnp.float32), k.astype(jnp.float32)) * SOFTMAX_SCALE
    p = jax.nn.softmax(s, axis=-1)
    return jnp.einsum('bhqk,bkhd->bqhd', p, v.astype(jnp.float32)).astype(v.dtype)


def mla_mixer(h_lat, h_ctx, need_ctx, w_in, q_norm, w_uq, kv_norm, w_ukv, w_out):
    B_, L, _ = h_lat.shape
    Lc = h_ctx.shape[1]
    row, col = grid_positions(L)
    qn_l, qr_l, kn_l, kr_l, v_l, z_l = mla_project(h_lat, w_in, q_norm, w_uq, kv_norm, w_ukv)
    qn_c, qr_c, kn_c, kr_c, v_c, z_c = mla_project(h_ctx, w_in, q_norm, w_uq, kv_norm, w_ukv)
    q_lat = jnp.concatenate([qn_l, axial_rope(qr_l, row, col)], axis=-1)
    k_lat = mla_keys(kn_l, axial_rope(kr_l, row, col))
    k_ctx = mla_keys(kn_c, kr_c)
    k_all = jnp.concatenate([k_ctx, k_lat], axis=1)
    v_all = jnp.concatenate([v_c, v_l], axis=1)
    nb = L // Q_BLOCK
    qb = jnp.transpose(q_lat.reshape(B_, nb, Q_BLOCK, MLA_HEADS, QK_DIM), (1, 0, 2, 3, 4))
    ob = lax.map(lambda qq: attend(qq, k_all, v_all), qb)
    o_lat = jnp.transpose(ob, (1, 0, 2, 3, 4)).reshape(B_, L, MLA_WIDTH)
    out_lat = (o_lat * jax.nn.silu(z_l)) @ w_out
    out_ctx = None
    if need_ctx:
        q_ctx = jnp.concatenate([qn_c, qr_c], axis=-1)
        o_ctx = attend(q_ctx, k_ctx, v_c).reshape(B_, Lc, MLA_WIDTH)
        out_ctx = (o_ctx * jax.nn.silu(z_c)) @ w_out
    return out_lat, out_ctx


def s5_discretise(a_re, a_im, log_step, b_re, b_im):
    dt = jnp.exp(log_step.astype(jnp.float32))[:, None]
    ar = a_re.astype(jnp.float32)
    ai = a_im.astype(jnp.float32)
    mag = jnp.exp(ar * dt)
    lb_re = mag * jnp.cos(ai * dt)
    lb_im = mag * jnp.sin(ai * dt)
    den = ar * ar + ai * ai
    nr = lb_re - 1.0
    f_re = ((nr * ar + lb_im * ai) / den)[..., None]
    f_im = ((lb_im * ar - nr * ai) / den)[..., None]
    br = b_re.astype(jnp.float32)
    bi = b_im.astype(jnp.float32)
    bb_re = f_re * br - f_im * bi
    bb_im = f_re * bi + f_im * br
    return lb_re, lb_im, bb_re, bb_im


def linear_recurrence_combine(e1, e2):
    a1r, a1i, b1r, b1i = e1
    a2r, a2i, b2r, b2i = e2
    return (a2r * a1r - a2i * a1i,
            a2r * a1i + a2i * a1r,
            a2r * b1r - a2i * b1i + b2r,
            a2r * b1i + a2i * b1r + b2i)


def s5_scan(u, disc, c_re, c_im, s0, reverse):
    lb_re, lb_im, bb_re, bb_im = disc
    L = u.shape[1]
    bu_re = jnp.einsum('blgc,gpc->blgp', u, bb_re)
    bu_im = jnp.einsum('blgc,gpc->blgp', u, bb_im)
    if s0 is not None:
        s0r, s0i = s0
        idx = L - 1 if reverse else 0
        bu_re = bu_re.at[:, idx].add(lb_re * s0r - lb_im * s0i)
        bu_im = bu_im.at[:, idx].add(lb_re * s0i + lb_im * s0r)
    a_re = jnp.broadcast_to(lb_re, (1, L) + lb_re.shape)
    a_im = jnp.broadcast_to(lb_im, (1, L) + lb_im.shape)
    _, _, s_re, s_im = lax.associative_scan(
        linear_recurrence_combine, (a_re, a_im, bu_re, bu_im), reverse=reverse, axis=1)
    y = (jnp.einsum('blgp,gcp->blgc', s_re, c_re.astype(jnp.float32))
         - jnp.einsum('blgp,gcp->blgc', s_im, c_im.astype(jnp.float32)))
    fin = (s_re[:, 0], s_im[:, 0]) if reverse else (s_re[:, -1], s_im[:, -1])
    return y, fin


def s5_finish(y_ssm, u, z, d, w_glu, b_glu, w_out):
    B_, L, _ = u.shape
    y = y_ssm.reshape(B_, L, S5_WIDTH) + d.astype(jnp.float32) * u.astype(jnp.float32)
    y = jax.nn.gelu(y).astype(u.dtype)
    y = y * jax.nn.sigmoid(y @ w_glu + b_glu)
    return (y * jax.nn.silu(z)) @ w_out


def s5_mixer(h_lat, h_ctx, need_ctx, w_in, a_re, a_im, log_step, b_re, b_im, c_re, c_im,
             d, w_glu, b_glu, w_out):
    B_, L, _ = h_lat.shape
    Lc = h_ctx.shape[1]
    p_l = h_lat @ w_in
    p_c = h_ctx @ w_in
    u_l, z_l = p_l[..., :S5_WIDTH], p_l[..., S5_WIDTH:]
    u_c, z_c = p_c[..., :S5_WIDTH], p_c[..., S5_WIDTH:]
    g_l = u_l.astype(jnp.float32).reshape(B_, L, S5_GROUPS, S5_GROUP)
    g_c = u_c.astype(jnp.float32).reshape(B_, Lc, S5_GROUPS, S5_GROUP)
    y_l = jnp.zeros_like(g_l)
    y_c = jnp.zeros_like(g_c)
    for k, rev in enumerate((False, True)):
        disc = s5_discretise(a_re[k], a_im[k], log_step[k], b_re[k], b_im[k])
        yc_k, s_fin = s5_scan(g_c, disc, c_re[k], c_im[k], None, rev)
        yl_k, _ = s5_scan(g_l, disc, c_re[k], c_im[k], s_fin, rev)
        y_l = y_l + yl_k
        y_c = y_c + yc_k
    out_lat = s5_finish(y_l, u_l, z_l, d, w_glu, b_glu, w_out)
    out_ctx = s5_finish(y_c, u_c, z_c, d, w_glu, b_glu, w_out) if need_ctx else None
    return out_lat, out_ctx


def setup_inputs(seed: int = 0) -> dict:
    key = jax.random.key(seed)
    ks = jax.random.split(key, 32)

    def nrm(k, shape, scale):
        return jax.random.normal(k, shape, jnp.float32) * scale

    D, E = D_MODEL, MLA_WIDTH
    G, P, CH = S5_GROUPS, S5_STATE, S5_GROUP
    a_im_base = jnp.pi * jnp.arange(P, dtype=jnp.float32)
    return {
        'x': nrm(ks[0], (BATCH, SEQ, D), 1.0),
        'c': nrm(ks[1], (BATCH, D), 1.0),
        'ctx': nrm(ks[2], (BATCH, CTX_LEN, D), 1.0),
        'c_ctx': nrm(ks[3], (D,), 1.0),
        'ada_w': nrm(ks[4], (DEPTH, D, 3 * D), 0.5 * D ** -0.5),
        'ada_b': nrm(ks[5], (DEPTH, 3 * D), 0.01),
        'norm_g': 1.0 + nrm(ks[6], (DEPTH, D), 0.01),
        'mla_w_in': nrm(ks[7], (N_MLA_LAYERS, D, MLA_IN_WIDTH), D ** -0.5),
        'mla_q_norm': 1.0 + nrm(ks[8], (N_MLA_LAYERS, Q_LORA_RANK), 0.01),
        'mla_w_uq': nrm(ks[9], (N_MLA_LAYERS, Q_LORA_RANK, MLA_HEADS * QK_DIM), Q_LORA_RANK ** -0.5),
        'mla_kv_norm': 1.0 + nrm(ks[10], (N_MLA_LAYERS, KV_LORA_RANK), 0.01),
        'mla_w_ukv': nrm(ks[11], (N_MLA_LAYERS, KV_LORA_RANK, MLA_HEADS * (QK_NOPE_DIM + V_HEAD_DIM)),
                         KV_LORA_RANK ** -0.5),
        'mla_w_out': nrm(ks[12], (N_MLA_LAYERS, E, D), E ** -0.5),
        's5_w_in': nrm(ks[13], (N_S5_LAYERS, D, 2 * S5_WIDTH), D ** -0.5),
        's5_a_re': -0.5 + nrm(ks[14], (N_S5_LAYERS, 2, G, P), 0.01),
        's5_a_im': a_im_base + nrm(ks[15], (N_S5_LAYERS, 2, G, P), 0.01),
        's5_log_step': jax.random.uniform(ks[16], (N_S5_LAYERS, 2, G), jnp.float32,
                                          math.log(DT_MIN), math.log(DT_MAX)),
        's5_b_re': nrm(ks[17], (N_S5_LAYERS, 2, G, P, CH), (2 * CH) ** -0.5),
        's5_b_im': nrm(ks[18], (N_S5_LAYERS, 2, G, P, CH), (2 * CH) ** -0.5),
        's5_c_re': nrm(ks[19], (N_S5_LAYERS, 2, G, CH, P), P ** -0.5),
        's5_c_im': nrm(ks[20], (N_S5_LAYERS, 2, G, CH, P), P ** -0.5),
        's5_d': nrm(ks[21], (N_S5_LAYERS, S5_WIDTH), 1.0),
        's5_w_glu': nrm(ks[22], (N_S5_LAYERS, S5_WIDTH, S5_WIDTH), S5_WIDTH ** -0.5),
        's5_b_glu': nrm(ks[23], (N_S5_LAYERS, S5_WIDTH), 0.01),
        's5_w_out': nrm(ks[24], (N_S5_LAYERS, S5_WIDTH, D), S5_WIDTH ** -0.5),
        'final_g': 1.0 + nrm(ks[25], (D,), 0.01),
    }


def reference(x, c, ctx, c_ctx, ada_w, ada_b, norm_g,
              mla_w_in, mla_q_norm, mla_w_uq, mla_kv_norm, mla_w_ukv, mla_w_out,
              s5_w_in, s5_a_re, s5_a_im, s5_log_step, s5_b_re, s5_b_im, s5_c_re, s5_c_im,
              s5_d, s5_w_glu, s5_b_glu, s5_w_out, final_g):
    silu_c = jax.nn.silu(c)
    silu_cc = jax.nn.silu(c_ctx)
    for i in range(DEPTH):
        need_ctx = i < DEPTH - 1
        mod_l = silu_c @ ada_w[i] + ada_b[i]
        mod_c = silu_cc @ ada_w[i] + ada_b[i]
        sh_l, sc_l, gt_l = jnp.split(mod_l, 3, axis=-1)
        sh_c, sc_c, gt_c = jnp.split(mod_c, 3, axis=-1)
        h_l = rmsnorm(x, norm_g[i]) * (1.0 + sc_l[:, None, :]) + sh_l[:, None, :]
        h_c = rmsnorm(ctx, norm_g[i]) * (1.0 + sc_c) + sh_c
        j = i // N_MIXERS
        if i % N_MIXERS == 0:
            o_l, o_c = mla_mixer(h_l, h_c, need_ctx, mla_w_in[j], mla_q_norm[j], mla_w_uq[j],
                                 mla_kv_norm[j], mla_w_ukv[j], mla_w_out[j])
        else:
            o_l, o_c = s5_mixer(h_l, h_c, need_ctx, s5_w_in[j], s5_a_re[j], s5_a_im[j],
                                s5_log_step[j], s5_b_re[j], s5_b_im[j], s5_c_re[j], s5_c_im[j],
                                s5_d[j], s5_w_glu[j], s5_b_glu[j], s5_w_out[j])
        x = x + gt_l[:, None, :] * o_l
        if need_ctx:
            ctx = ctx + gt_c * o_c
    return rmsnorm(x, final_g)
```

```cpp
#include <hip/hip_runtime.h>
#include <hip/hip_cooperative_groups.h>
#include <cstdio>
namespace cg = cooperative_groups;
#ifndef USE_NAIVE
#define USE_NAIVE 0
#endif
#ifndef SINGLE_LAUNCH
#define SINGLE_LAUNCH 1
#endif

#define DI __device__ __forceinline__
typedef unsigned short bfr;

constexpr int D = 1024, NB = 8, SEQ = 2048, LC = 256, LALL = 2304;
constexpr int TOK = NB * LALL;
constexpr int NLAT = NB * SEQ;
constexpr int NH = 16, DQK = 96, DV = 64;
constexpr int NIN0 = 1440, NIN1 = 2048;
constexpr float EPS = 1e-6f;
constexpr float QSCALE = 0.10206207261596577f * 1.4426950408889634f;
constexpr int TC = 32;
constexpr int NCH = LALL / TC;
constexpr int NCHL = SEQ / TC;

enum { I_X = 0, I_C, I_CTX, I_CCTX, I_ADAW, I_ADAB, I_NORMG, I_WIN0, I_QNORM, I_WUQ, I_KVNORM, I_WUKV, I_WOUT0,
       I_WIN1, I_ARE, I_AIM, I_LOGSTEP, I_BRE, I_BIM, I_CRE, I_CIM, I_S5D, I_WGLU, I_BGLU, I_WOUT1, I_FINALG, N_INPUTS };

constexpr size_t al256(size_t x) { return (x + 255) & ~(size_t)255; }
constexpr size_t O_WT_IN0 = 0;
constexpr size_t O_WT_UQ = O_WT_IN0 + al256((size_t)NIN0 * 1024 * 2);
constexpr size_t O_WT_UKV = O_WT_UQ + al256((size_t)1536 * 256 * 2);
constexpr size_t O_WT_OUT0 = O_WT_UKV + al256((size_t)2048 * 128 * 2);
constexpr size_t O_WT_IN1 = O_WT_OUT0 + al256((size_t)1024 * 1024 * 2);
constexpr size_t O_WT_GLU = O_WT_IN1 + al256((size_t)2048 * 1024 * 2);
constexpr size_t O_WT_OUT1 = O_WT_GLU + al256((size_t)1024 * 1024 * 2);
constexpr size_t O_MOD = O_WT_OUT1 + al256((size_t)1024 * 1024 * 2);
constexpr size_t O_RS0 = O_MOD + al256((size_t)2 * 9 * 3072 * 4);
constexpr size_t O_PART1 = O_RS0 + al256((size_t)TOK * 4);
constexpr size_t O_PART2 = O_PART1 + al256((size_t)16 * TOK * 4);
constexpr size_t O_X1CTX = O_PART2 + al256((size_t)16 * NLAT * 4);
constexpr size_t O_KTAB = O_X1CTX + al256((size_t)NB * LC * 1024 * 4);
constexpr size_t O_WST = O_KTAB + al256((size_t)64 * 63 * 256 * 2);
constexpr size_t O_VOP = O_WST + al256((size_t)64 * 256 * 512 * 2);
constexpr size_t O_LAYER = O_VOP + al256((size_t)64 * 512 * 256 * 2);
constexpr size_t O_PC = O_LAYER;
constexpr size_t O_SZ0 = O_PC + al256((size_t)TOK * 384 * 2);
constexpr size_t O_K = O_SZ0 + al256((size_t)TOK * 1024 * 2);
constexpr size_t O_VT = O_K + al256((size_t)NB * NH * LALL * DQK * 2);
constexpr size_t O_OG = O_VT + al256((size_t)NB * NH * DV * LALL * 2);
constexpr size_t O_END0 = O_OG + al256((size_t)TOK * 1024 * 2);
constexpr size_t O_U2 = O_LAYER;
constexpr size_t O_SZ1 = O_U2 + al256((size_t)64 * TOK * 16 * 2);
constexpr size_t O_SLOC = O_SZ1 + al256((size_t)NLAT * 1024 * 2);
constexpr size_t O_SIN = O_SLOC + al256((size_t)64 * (NB * NCH) * 256 * 4);
constexpr size_t O_YG = O_SIN + al256((size_t)64 * (NB * NCHL) * 256 * 2);
constexpr size_t O_END1 = O_YG + al256((size_t)NLAT * 1024 * 2);
constexpr size_t O_Y2 = O_SLOC;
constexpr size_t WS_NEED = (O_END0 > O_END1 ? O_END0 : O_END1);
static_assert(WS_NEED <= (size_t)256 * 1024 * 1024, "workspace too large");
static_assert((size_t)NB * NH * LALL * DQK * 2 <= (size_t)NLAT * 1024 * 4, "Q does not fit d_out");

struct Params {
  const float* in[N_INPUTS];
  float* out;
  char* ws;
  int prog[32];
  int nprog;
  int pad;
};

DI bfr f2bf(float x) {
  unsigned u = __float_as_uint(x);
  u += 0x7fffu + ((u >> 16) & 1u);
  return (bfr)(u >> 16);
}
DI int opaque_tid() {
  int t = threadIdx.x;
  asm volatile("" : "+v"(t));
  return t;
}
DI float bf2f(bfr b) { return __uint_as_float(((unsigned)b) << 16); }
DI float silu_f(float v) { return v / (1.f + __expf(-v)); }
DI float sigmoid_f(float v) { return 1.f / (1.f + __expf(-v)); }
DI float gelu_tanh(float v) {
  float u = 0.7978845608028654f * (v + 0.044715f * v * v * v);
  return 0.5f * v * (1.f + tanhf(u));
}
DI float wave_sum(float v) {
#pragma unroll
  for (int o = 32; o > 0; o >>= 1) v += __shfl_xor(v, o);
  return v;
}
DI float wave_max(float v) {
#pragma unroll
  for (int o = 32; o > 0; o >>= 1) v = fmaxf(v, __shfl_xor(v, o));
  return v;
}
DI const float* xrow0(const Params& p, int tok) {
  int b = tok / LALL, pos = tok - b * LALL;
  return pos < LC ? p.in[I_CTX] + ((size_t)(b * LC + pos)) * D : p.in[I_X] + ((size_t)(b * SEQ + pos - LC)) * D;
}
DI float* xrow1(const Params& p, int tok) {
  int b = tok / LALL, pos = tok - b * LALL;
  return pos < LC ? (float*)(p.ws + O_X1CTX) + ((size_t)(b * LC + pos)) * D : p.out + ((size_t)(b * SEQ + pos - LC)) * D;
}
DI const float* modrow(const Params& p, int layer, int tok) {
  int b = tok / LALL, pos = tok - b * LALL;
  int r = pos < LC ? 8 : b;
  return (const float*)(p.ws + O_MOD) + ((size_t)(layer * 9 + r)) * 3072;
}
DI void rope_cs(int fi, int posv, float& cs, float& sn) {
  float inv = exp2f(-(float)fi * (13.287712379549449f / 8.f));
  sincosf((float)posv * inv, &sn, &cs);
}
DI float rope_apply(int j, float v, float vp, int lpos) {
  int posv = (j & 16) ? (lpos & 63) : (lpos >> 6);
  float cs, sn;
  rope_cs(j & 7, posv, cs, sn);
  return (j & 8) ? (vp * sn + v * cs) : (v * cs - vp * sn);
}

DI void s5_disc(const Params& p, int dir, int g, int pp, double& dt, double& ar, double& ai, float& fr, float& fi) {
  dt = exp((double)p.in[I_LOGSTEP][dir * 64 + g]);
  ar = (double)p.in[I_ARE][(dir * 64 + g) * 64 + pp];
  ai = (double)p.in[I_AIM][(dir * 64 + g) * 64 + pp];
  double mag = exp(ar * dt);
  double a = ai * dt;
  a -= 6.283185307179586 * rint(a * 0.15915494309189535);
  float sn, cs;
  sincosf((float)a, &sn, &cs);
  double lr = mag * (double)cs, li = mag * (double)sn;
  double den = ar * ar + ai * ai, nr = lr - 1.0;
  fr = (float)((nr * ar + li * ai) / den);
  fi = (float)((li * ar - nr * ai) / den);
}
DI void s5_pow(double dt, double ar, double ai, int k, float& wr, float& wi) {
  double mag = exp(ar * dt * (double)k);
  double a = ai * dt * (double)k;
  a -= 6.283185307179586 * rint(a * 0.15915494309189535);
  float sn, cs;
  sincosf((float)a, &sn, &cs);
  wr = (float)mag * cs;
  wi = (float)mag * sn;
}

enum { PH_PREP = 0, PH_N1, PH_N2, PH_N3, PH_N4, PH_N4B, PH_N5, PH_N6A, PH_N6B, PH_N9, PH_N10, PH_N10B, PH_FINAL,
       PH_O1, PH_O2, PH_O3, PH_O4, PH_O5, PH_O6, PH_O7, PH_O8, PH_O9, PH_O10, PH_COUNT };

constexpr int SMEM_BYTES = 48 * 1024;


DI void prep_transpose(const Params& p, int widx, int tile, char* smem) {
  const int tidx_ = opaque_tid();
  int K, N;
  size_t dst;
  const float* W;
  const float* scl = nullptr;
  switch (widx) {
    case 0: W = p.in[I_WIN0]; K = 1024; N = NIN0; dst = O_WT_IN0; break;
    case 1: W = p.in[I_WUQ]; K = 256; N = 1536; dst = O_WT_UQ; scl = p.in[I_QNORM]; break;
    case 2: W = p.in[I_WUKV]; K = 128; N = 2048; dst = O_WT_UKV; scl = p.in[I_KVNORM]; break;
    case 3: W = p.in[I_WOUT0]; K = 1024; N = 1024; dst = O_WT_OUT0; break;
    case 4: W = p.in[I_WIN1]; K = 1024; N = NIN1; dst = O_WT_IN1; break;
    case 5: W = p.in[I_WGLU]; K = 1024; N = 1024; dst = O_WT_GLU; break;
    default: W = p.in[I_WOUT1]; K = 1024; N = 1024; dst = O_WT_OUT1; break;
  }
  float (*t)[33] = (float (*)[33])smem;
  int ntn = N / 32;
  int kt = tile / ntn, nt = tile - kt * ntn;
  int tx = tidx_ & 31, ty = tidx_ >> 5;
#pragma unroll
  for (int i = 0; i < 4; ++i) {
    int k = kt * 32 + ty + 8 * i, n = nt * 32 + tx;
    float v = W[(size_t)k * N + n];
    if (scl) v *= scl[k];
    t[ty + 8 * i][tx] = v;
  }
  __syncthreads();
  bfr* Wt = (bfr*)(p.ws + dst);
#pragma unroll
  for (int i = 0; i < 4; ++i) {
    int n = nt * 32 + ty + 8 * i, k = kt * 32 + tx;
    Wt[(size_t)n * K + k] = f2bf(t[tx][ty + 8 * i]);
  }
  __syncthreads();
}

DI void prep_mod(const Params& p, int unit, char* smem) {
  const int tidx_ = opaque_tid();
  int layer = unit / 48, cgp = unit - layer * 48;
  float* sil = (float*)smem;
  float* red = sil + 9 * 1024;
  for (int i = tidx_; i < 9 * 1024; i += 256) {
    int r = i >> 10, k = i & 1023;
    float v = r < 8 ? p.in[I_C][r * 1024 + k] : p.in[I_CCTX][k];
    sil[i] = silu_f(v);
  }
  __syncthreads();
  int nn = tidx_ & 63, kg = tidx_ >> 6;
  int n = cgp * 64 + nn;
  const float* W = p.in[I_ADAW] + (size_t)layer * 1024 * 3072;
  float acc[9];
#pragma unroll
  for (int r = 0; r < 9; ++r) acc[r] = 0.f;
  for (int k = kg * 256; k < kg * 256 + 256; ++k) {
    float w = W[(size_t)k * 3072 + n];
#pragma unroll
    for (int r = 0; r < 9; ++r) acc[r] += sil[r * 1024 + k] * w;
  }
#pragma unroll
  for (int r = 0; r < 9; ++r) red[(kg * 9 + r) * 64 + nn] = acc[r];
  __syncthreads();
  if (kg == 0) {
    float bias = p.in[I_ADAB][layer * 3072 + n];
    float* mod = (float*)(p.ws + O_MOD);
#pragma unroll
    for (int r = 0; r < 9; ++r) {
      float s = red[(0 * 9 + r) * 64 + nn] + red[(1 * 9 + r) * 64 + nn] + red[(2 * 9 + r) * 64 + nn] + red[(3 * 9 + r) * 64 + nn];
      mod[((size_t)(layer * 9 + r)) * 3072 + n] = s + bias;
    }
  }
  __syncthreads();
}

DI void prep_rs0(const Params& p, int unit) {
  const int tidx_ = opaque_tid();
  int tok = unit * 4 + (tidx_ >> 6);
  int lane = tidx_ & 63;
  const float4* r = (const float4*)xrow0(p, tok);
  float s = 0.f;
#pragma unroll
  for (int i = 0; i < 4; ++i) {
    float4 v = r[lane + 64 * i];
    s += v.x * v.x + v.y * v.y + v.z * v.z + v.w * v.w;
  }
  s = wave_sum(s);
  if (lane == 0) ((float*)(p.ws + O_RS0))[tok] = rsqrtf(s * (1.f / 1024.f) + EPS);
}

DI void prep_ktab(const Params& p, int unit, char* smem) {
  const int tidx_ = opaque_tid();
  int g = unit / 63, lagidx = unit - g * 63;
  int lag = lagidx - 31;
  float2* E = (float2*)smem;
  int tid = tidx_;
  if (tid < 128) {
    int dir = tid >> 6, pp = tid & 63;
    bool used = (dir == 0) ? (lag >= 0) : (lag <= 0);
    float2 e = make_float2(0.f, 0.f);
    if (used) {
      double dt, ar, ai;
      float fr, fi, wr, wi;
      s5_disc(p, dir, g, pp, dt, ar, ai, fr, fi);
      s5_pow(dt, ar, ai, lag < 0 ? -lag : lag, wr, wi);
      e.x = wr * fr - wi * fi;
      e.y = wr * fi + wi * fr;
    }
    E[tid] = e;
  }
  __syncthreads();
  int c = tid >> 4, c2 = tid & 15;
  float acc = 0.f;
  for (int dir = 0; dir < 2; ++dir) {
    bool used = (dir == 0) ? (lag >= 0) : (lag <= 0);
    if (!used) continue;
    const float* bre = p.in[I_BRE] + ((size_t)(dir * 64 + g)) * 64 * 16;
    const float* bim = p.in[I_BIM] + ((size_t)(dir * 64 + g)) * 64 * 16;
    const float* cre = p.in[I_CRE] + ((size_t)(dir * 64 + g)) * 16 * 64;
    const float* cim = p.in[I_CIM] + ((size_t)(dir * 64 + g)) * 16 * 64;
    for (int pp = 0; pp < 64; ++pp) {
      float2 e = E[dir * 64 + pp];
      float br = bre[pp * 16 + c2], bi = bim[pp * 16 + c2];
      float gr = e.x * br - e.y * bi, gi = e.x * bi + e.y * br;
      float cr = cre[c * 64 + pp], ci = cim[c * 64 + pp];
      acc += cr * gr - ci * gi;
    }
  }
  ((bfr*)(p.ws + O_KTAB))[((size_t)unit * 16 + c) * 16 + c2] = f2bf(acc);
  __syncthreads();
}

DI void prep_ops(const Params& p, int unit) {
  const int tidx_ = opaque_tid();
  int idx = unit * 256 + tidx_;
  int pp = idx & 63, t = (idx >> 6) & 31, dir = (idx >> 11) & 1, g = idx >> 12;
  double dt, ar, ai;
  float fr, fi, wr, wi;
  s5_disc(p, dir, g, pp, dt, ar, ai, fr, fi);
  s5_pow(dt, ar, ai, dir == 0 ? (TC - 1 - t) : t, wr, wi);
  float er = wr * fr - wi * fi, ei = wr * fi + wi * fr;
  const float* bre = p.in[I_BRE] + (((size_t)(dir * 64 + g)) * 64 + pp) * 16;
  const float* bim = p.in[I_BIM] + (((size_t)(dir * 64 + g)) * 64 + pp) * 16;
  bfr* wst = (bfr*)(p.ws + O_WST) + (size_t)g * 256 * 512;
  bfr* rre = wst + (size_t)(dir * 128 + pp) * 512 + t * 16;
  bfr* rim = wst + (size_t)(dir * 128 + 64 + pp) * 512 + t * 16;
#pragma unroll
  for (int c2 = 0; c2 < 16; ++c2) {
    float br = bre[c2], bi = bim[c2];
    rre[c2] = f2bf(er * br - ei * bi);
    rim[c2] = f2bf(er * bi + ei * br);
  }
  s5_pow(dt, ar, ai, dir == 0 ? (t + 1) : (TC - t), wr, wi);
  const float* cre = p.in[I_CRE] + ((size_t)(dir * 64 + g)) * 16 * 64;
  const float* cim = p.in[I_CIM] + ((size_t)(dir * 64 + g)) * 16 * 64;
  bfr* vop = (bfr*)(p.ws + O_VOP) + (size_t)g * 512 * 256;
#pragma unroll
  for (int c = 0; c < 16; ++c) {
    float cr = cre[c * 64 + pp], ci = cim[c * 64 + pp];
    float dr = cr * wr - ci * wi, di = cr * wi + ci * wr;
    vop[(size_t)(t * 16 + c) * 256 + dir * 128 + pp] = f2bf(dr);
    vop[(size_t)(t * 16 + c) * 256 + dir * 128 + 64 + pp] = f2bf(-di);
  }
}

constexpr int TR_T0 = 32 * 45, TR_T1 = 8 * 48, TR_T2 = 4 * 64, TR_T3 = 1024, TR_T4 = 32 * 64, TR_T5 = 1024, TR_T6 = 1024;
constexpr int TR_TOTAL = TR_T0 + TR_T1 + TR_T2 + TR_T3 + TR_T4 + TR_T5 + TR_T6;
constexpr int U_MOD = 96, U_RS0 = TOK / 4, U_KTAB = 64 * 63, U_OPS = 64 * 2 * 64 * 32 / 256;
constexpr int PREP_UNITS = TR_TOTAL + U_MOD + U_RS0 + U_KTAB + U_OPS;

DI void phase_prep(const Params& p, char* smem) {
  for (int u = blockIdx.x; u < PREP_UNITS; u += gridDim.x) {
    int v = u;
    if (v < U_MOD) { prep_mod(p, v, smem); continue; }
    v -= U_MOD;
    if (v < TR_TOTAL) {
      int w = 0;
      if (v >= TR_T0) { v -= TR_T0; w = 1;
        if (v >= TR_T1) { v -= TR_T1; w = 2;
          if (v >= TR_T2) { v -= TR_T2; w = 3;
            if (v >= TR_T3) { v -= TR_T3; w = 4;
              if (v >= TR_T4) { v -= TR_T4; w = 5;
                if (v >= TR_T5) { v -= TR_T5; w = 6; } } } } } }
      prep_transpose(p, w, v, smem);
      continue;
    }
    v -= TR_TOTAL;
    if (v < U_RS0) { prep_rs0(p, v); continue; }
    v -= U_RS0;
    if (v < U_KTAB) { prep_ktab(p, v, smem); continue; }
    v -= U_KTAB;
    prep_ops(p, v);
  }
}

DI void phase_n1(const Params& p) {
  const float* W = p.in[I_WIN0];
  const float* rs0 = (const float*)(p.ws + O_RS0);
  const float* ng = p.in[I_NORMG];
  const size_t total = (size_t)TOK * NIN0;
  for (size_t idx = (size_t)blockIdx.x * 256 + threadIdx.x; idx < total; idx += (size_t)gridDim.x * 256) {
    int tok = (int)(idx / NIN0), n = (int)(idx - (size_t)tok * NIN0);
    int b = tok / LALL, pos = tok - b * LALL;
    bool lat = pos >= LC;
    const float* xr = xrow0(p, tok);
    const float* md = modrow(p, 0, tok);
    float rs = rs0[tok];
    bool rope = lat && n >= 384 && n < 416;
    int n2 = rope ? (n ^ 8) : n;
    float acc = 0.f, acc2 = 0.f;
    for (int k = 0; k < 1024; ++k) {
      float h = xr[k] * rs * ng[k] * (1.f + md[1024 + k]) + md[k];
      acc += h * W[(size_t)k * NIN0 + n];
      acc2 += h * W[(size_t)k * NIN0 + n2];
    }
    if (n < 384) {
      ((bfr*)(p.ws + O_PC))[(size_t)tok * 384 + n] = f2bf(acc);
    } else if (n < 416) {
      int j = n - 384;
      float v = rope ? rope_apply(j, acc, acc2, pos - LC) : acc;
      bfr bv = f2bf(v);
      bfr* K = (bfr*)(p.ws + O_K);
      for (int h = 0; h < NH; ++h) K[(((size_t)(b * NH + h)) * LALL + pos) * DQK + 64 + j] = bv;
    } else {
      ((bfr*)(p.ws + O_SZ0))[(size_t)tok * 1024 + (n - 416)] = f2bf(silu_f(acc));
    }
  }
}

DI void phase_n2(const Params& p) {
  const int NTOT = 1536 + 2048;
  const bfr* PC = (const bfr*)(p.ws + O_PC);
  const size_t total = (size_t)TOK * NTOT;
  bfr* Q = (bfr*)p.out;
  bfr* K = (bfr*)(p.ws + O_K);
  bfr* VT = (bfr*)(p.ws + O_VT);
  for (size_t idx = (size_t)blockIdx.x * 256 + threadIdx.x; idx < total; idx += (size_t)gridDim.x * 256) {
    int tok = (int)(idx / NTOT), n = (int)(idx - (size_t)tok * NTOT);
    int b = tok / LALL, pos = tok - b * LALL;
    bool lat = pos >= LC;
    if (n < 1536) {
      int h = n / 96, d = n - h * 96;
      bool rope = lat && d >= 64;
      int n2 = rope ? (n ^ 8) : n;
      const float* W = p.in[I_WUQ];
      const float* qn = p.in[I_QNORM];
      float acc = 0.f, acc2 = 0.f, ss = 0.f;
      for (int k = 0; k < 256; ++k) {
        float a = bf2f(PC[(size_t)tok * 384 + k]);
        ss += a * a;
        float aw = a * qn[k];
        acc += aw * W[(size_t)k * 1536 + n];
        acc2 += aw * W[(size_t)k * 1536 + n2];
      }
      float r = rsqrtf(ss * (1.f / 256.f) + EPS);
      acc *= r; acc2 *= r;
      float v = rope ? rope_apply(d - 64, acc, acc2, pos - LC) : acc;
      Q[(((size_t)(b * NH + h)) * LALL + pos) * DQK + d] = f2bf(v * QSCALE);
    } else {
      int n3 = n - 1536;
      int h = n3 / 128, d = n3 - h * 128;
      const float* W = p.in[I_WUKV];
      const float* kn = p.in[I_KVNORM];
      float acc = 0.f, ss = 0.f;
      for (int k = 0; k < 128; ++k) {
        float a = bf2f(PC[(size_t)tok * 384 + 256 + k]);
        ss += a * a;
        acc += a * kn[k] * W[(size_t)k * 2048 + n3];
      }
      acc *= rsqrtf(ss * (1.f / 128.f) + EPS);
      if (d < 64) K[(((size_t)(b * NH + h)) * LALL + pos) * DQK + d] = f2bf(acc);
      else VT[(((size_t)(b * NH + h)) * DV + (d - 64)) * LALL + pos] = f2bf(acc);
    }
  }
}

DI void phase_n3(const Params& p) {
  const bfr* Q = (const bfr*)p.out;
  const bfr* K = (const bfr*)(p.ws + O_K);
  const bfr* VT = (const bfr*)(p.ws + O_VT);
  const bfr* SZ = (const bfr*)(p.ws + O_SZ0);
  bfr* OG = (bfr*)(p.ws + O_OG);
  int lane = threadIdx.x & 63;
  const int total = NB * NH * LALL;
  for (int w = blockIdx.x * 4 + (threadIdx.x >> 6); w < total; w += gridDim.x * 4) {
    int bh = w / LALL, pos = w - bh * LALL;
    int b = bh / NH, h = bh - b * NH;
    int nk = pos < LC ? LC : LALL;
    const bfr* q = Q + ((size_t)bh * LALL + pos) * DQK;
    const bfr* kb = K + (size_t)bh * LALL * DQK;
    const bfr* vb = VT + (size_t)bh * DV * LALL;
    float s[36];
    float mx = -1e30f;
#pragma unroll
    for (int i = 0; i < 36; ++i) {
      int key = i * 64 + lane;
      float a = -1e30f;
      if (key < nk) {
        a = 0.f;
        const bfr* kr = kb + (size_t)key * DQK;
        for (int d = 0; d < DQK; ++d) a += bf2f(q[d]) * bf2f(kr[d]);
      }
      s[i] = a;
      mx = fmaxf(mx, a);
    }
    mx = wave_max(mx);
    float l = 0.f;
    float o[64];
#pragma unroll
    for (int d = 0; d < 64; ++d) o[d] = 0.f;
#pragma unroll
    for (int i = 0; i < 36; ++i) {
      int key = i * 64 + lane;
      if (key < nk) {
        float pr = exp2f(s[i] - mx);
        l += pr;
#pragma unroll
        for (int d = 0; d < 64; ++d) o[d] += pr * bf2f(vb[(size_t)d * LALL + key]);
      }
    }
    l = wave_sum(l);
    float mine = 0.f;
#pragma unroll
    for (int d = 0; d < 64; ++d) {
      float t = wave_sum(o[d]);
      if (lane == d) mine = t;
    }
    int tok = b * LALL + pos;
    float z = bf2f(SZ[(size_t)tok * 1024 + h * 64 + lane]);
    OG[(size_t)tok * 1024 + h * 64 + lane] = f2bf(mine / l * z);
  }
}

DI void phase_n4(const Params& p) {
  const float* W = p.in[I_WOUT0];
  const bfr* OG = (const bfr*)(p.ws + O_OG);
  const size_t total = (size_t)TOK * 1024;
  for (size_t idx = (size_t)blockIdx.x * 256 + threadIdx.x; idx < total; idx += (size_t)gridDim.x * 256) {
    int tok = (int)(idx >> 10), n = (int)(idx & 1023);
    float acc = 0.f;
    for (int k = 0; k < 1024; ++k) acc += bf2f(OG[(size_t)tok * 1024 + k]) * W[(size_t)k * 1024 + n];
    float v = xrow0(p, tok)[n] + modrow(p, 0, tok)[2048 + n] * acc;
    xrow1(p, tok)[n] = v;
  }
}

DI void phase_rowsq(const Params& p, int layer) {
  int lane = threadIdx.x & 63;
  int nrows = layer == 1 ? TOK : NLAT;
  float* part = (float*)(p.ws + (layer == 1 ? O_PART1 : O_PART2));
  for (int r = blockIdx.x * 4 + (threadIdx.x >> 6); r < nrows; r += gridDim.x * 4) {
    const float4* row = (const float4*)(layer == 1 ? xrow1(p, r) : p.out + (size_t)r * D);
    float s = 0.f;
#pragma unroll
    for (int i = 0; i < 4; ++i) {
      float4 v = row[lane + 64 * i];
      s += v.x * v.x + v.y * v.y + v.z * v.z + v.w * v.w;
    }
    s = wave_sum(s);
    if (lane < 16) part[(size_t)lane * nrows + r] = lane == 0 ? s : 0.f;
  }
}
DI float rs_from_part(const float* part, int nrows, int r) {
  float s = 0.f;
#pragma unroll
  for (int j = 0; j < 16; ++j) s += part[(size_t)j * nrows + r];
  return rsqrtf(s * (1.f / 1024.f) + EPS);
}

DI void phase_n5(const Params& p) {
  const float* W = p.in[I_WIN1];
  const float* ng = p.in[I_NORMG] + 1024;
  const float* part = (const float*)(p.ws + O_PART1);
  bfr* U2 = (bfr*)(p.ws + O_U2);
  bfr* SZ1 = (bfr*)(p.ws + O_SZ1);
  const size_t total = (size_t)TOK * NIN1;
  for (size_t idx = (size_t)blockIdx.x * 256 + threadIdx.x; idx < total; idx += (size_t)gridDim.x * 256) {
    int tok = (int)(idx >> 11), n = (int)(idx & 2047);
    int b = tok / LALL, pos = tok - b * LALL;
    bool lat = pos >= LC;
    if (!lat && n >= 1024) continue;
    const float* xr = xrow1(p, tok);
    const float* md = modrow(p, 1, tok);
    float rs = rs_from_part(part, TOK, tok);
    float acc = 0.f;
    for (int k = 0; k < 1024; ++k) {
      float h = xr[k] * rs * ng[k] * (1.f + md[1024 + k]) + md[k];
      acc += h * W[(size_t)k * NIN1 + n];
    }
    if (n < 1024) U2[((size_t)(n >> 4) * TOK + tok) * 16 + (n & 15)] = f2bf(acc);
    else SZ1[((size_t)(b * SEQ + pos - LC)) * 1024 + (n - 1024)] = f2bf(silu_f(acc));
  }
}

DI void phase_n6(const Params& p, int dir) {
  int lane = threadIdx.x & 63;
  const bfr* U2 = (const bfr*)(p.ws + O_U2);
  bfr* YF = (bfr*)(p.ws + O_Y2);
  bfr* YG = (bfr*)(p.ws + O_YG);
  for (int w = blockIdx.x * 4 + (threadIdx.x >> 6); w < NB * 64; w += gridDim.x * 4) {
    int b = w >> 6, g = w & 63;
    double dt, ar, ai;
    float fr, fi, lr, li;
    s5_disc(p, dir, g, lane, dt, ar, ai, fr, fi);
    s5_pow(dt, ar, ai, 1, lr, li);
    float bbr[16], bbi[16], ccr[16], cci[16];
    const float* bre = p.in[I_BRE] + (((size_t)(dir * 64 + g)) * 64 + lane) * 16;
    const float* bim = p.in[I_BIM] + (((size_t)(dir * 64 + g)) * 64 + lane) * 16;
    const float* cre = p.in[I_CRE] + ((size_t)(dir * 64 + g)) * 16 * 64;
    const float* cim = p.in[I_CIM] + ((size_t)(dir * 64 + g)) * 16 * 64;
#pragma unroll
    for (int c = 0; c < 16; ++c) {
      float br = bre[c], bi = bim[c];
      bbr[c] = fr * br - fi * bi;
      bbi[c] = fr * bi + fi * br;
      ccr[c] = cre[c * 64 + lane];
      cci[c] = cim[c * 64 + lane];
    }
    float sr = 0.f, si = 0.f;
    const bfr* ub = U2 + ((size_t)g * TOK + (size_t)b * LALL) * 16;
    for (int step = 0; step < LALL; ++step) {
      int pos = dir == 0 ? step : (step < LC ? (LC - 1 - step) : (LALL - 1 - (step - LC)));
      const bfr* ur = ub + (size_t)pos * 16;
      float ur_f[16];
      float br = 0.f, bi = 0.f;
#pragma unroll
      for (int c = 0; c < 16; ++c) {
        float uv = bf2f(ur[c]);
        ur_f[c] = uv;
        br += bbr[c] * uv;
        bi += bbi[c] * uv;
      }
      float nr = lr * sr - li * si + br;
      float ni = lr * si + li * sr + bi;
      sr = nr; si = ni;
      if (pos >= LC) {
        float mine = 0.f, myu = 0.f;
#pragma unroll
        for (int c = 0; c < 16; ++c) {
          float t = wave_sum(ccr[c] * sr - cci[c] * si);
          if (lane == c) { mine = t; myu = ur_f[c]; }
        }
        if (lane < 16) {
          size_t o = ((size_t)(b * SEQ + pos - LC)) * 1024 + g * 16 + lane;
          if (dir == 0) YF[o] = f2bf(mine);
          else {
            float y = bf2f(YF[o]) + mine + p.in[I_S5D][g * 16 + lane] * myu;
            YG[o] = f2bf(gelu_tanh(y));
          }
        }
      }
    }
  }
}

DI void phase_n9(const Params& p) {
  const float* W = p.in[I_WGLU];
  const bfr* YG = (const bfr*)(p.ws + O_YG);
  const bfr* SZ1 = (const bfr*)(p.ws + O_SZ1);
  bfr* Y2 = (bfr*)(p.ws + O_Y2);
  const size_t total = (size_t)NLAT * 1024;
  for (size_t idx = (size_t)blockIdx.x * 256 + threadIdx.x; idx < total; idx += (size_t)gridDim.x * 256) {
    int lt = (int)(idx >> 10), n = (int)(idx & 1023);
    float acc = p.in[I_BGLU][n];
    for (int k = 0; k < 1024; ++k) acc += bf2f(YG[(size_t)lt * 1024 + k]) * W[(size_t)k * 1024 + n];
    float y = bf2f(YG[idx]);
    Y2[idx] = f2bf(y * sigmoid_f(acc) * bf2f(SZ1[idx]));
  }
}

DI void phase_n10(const Params& p) {
  const float* W = p.in[I_WOUT1];
  const bfr* Y2 = (const bfr*)(p.ws + O_Y2);
  const float* mod = (const float*)(p.ws + O_MOD);
  const size_t total = (size_t)NLAT * 1024;
  for (size_t idx = (size_t)blockIdx.x * 256 + threadIdx.x; idx < total; idx += (size_t)gridDim.x * 256) {
    int lt = (int)(idx >> 10), n = (int)(idx & 1023);
    int b = lt >> 11;
    float acc = 0.f;
    for (int k = 0; k < 1024; ++k) acc += bf2f(Y2[(size_t)lt * 1024 + k]) * W[(size_t)k * 1024 + n];
    p.out[idx] = p.out[idx] + mod[((size_t)(9 + b)) * 3072 + 2048 + n] * acc;
  }
}

DI void phase_final(const Params& p) {
  const int tidx_ = opaque_tid();
  const float* part = (const float*)(p.ws + O_PART2);
  const float* fg = p.in[I_FINALG];
  int lane = tidx_ & 63;
  for (int r = blockIdx.x * 4 + (tidx_ >> 6); r < NLAT; r += gridDim.x * 4) {
    float rs = rs_from_part(part, NLAT, r);
    float4* row = (float4*)(p.out + (size_t)r * D);
    const float4* g4 = (const float4*)fg;
#pragma unroll
    for (int i = 0; i < 4; ++i) {
      float4 v = row[lane + 64 * i];
      float4 g = g4[lane + 64 * i];
      v.x *= rs * g.x; v.y *= rs * g.y; v.z *= rs * g.z; v.w *= rs * g.w;
      row[lane + 64 * i] = v;
    }
  }
}

typedef short bf16x8 __attribute__((ext_vector_type(8)));
typedef short s16x4 __attribute__((ext_vector_type(4)));
typedef float f32x16 __attribute__((ext_vector_type(16)));
typedef __bf16 bf2_t __attribute__((ext_vector_type(2)));
typedef float f2_t __attribute__((ext_vector_type(2)));
DI unsigned pk2(float a, float b) {
  f2_t v = {a, b};
  bf2_t r = __builtin_convertvector(v, bf2_t);
  return __builtin_bit_cast(unsigned, r);
}
#define SCHED_FENCE() __builtin_amdgcn_sched_barrier(0)
#define MFMA32(a, b, c) __builtin_amdgcn_mfma_f32_32x32x16_bf16((a), (b), (c), 0, 0, 0)
DI int crow(int i, int h) { return (i & 3) + 8 * (i >> 2) + 4 * h; }

constexpr int LDT = 72;
struct GemmSmem {
  bfr A[128 * LDT];
  bfr B[128 * LDT];
  float gs[1024];
  float sh[1024];
  float rs[128];
};
static_assert(sizeof(GemmSmem) <= SMEM_BYTES, "smem");

DI void zero_acc(f32x16 (&acc)[2][2]) {
#pragma unroll
  for (int a = 0; a < 2; ++a)
#pragma unroll
    for (int b = 0; b < 2; ++b)
#pragma unroll
      for (int i = 0; i < 16; ++i) acc[a][b][i] = 0.f;
}

template <bool AF32, class AAddr, class BAddr>
DI void gemm_main(f32x16 (&acc)[2][2], int KT, AAddr aaddr, BAddr baddr, GemmSmem* sm) {
  const int tid = opaque_tid(), lane = tid & 63, wave = tid >> 6;
  const int wm = wave >> 1, wn = wave & 1, r = lane & 31, h = lane >> 5;
  uint4 bv0, bv1, bv2, bv3, av0, av1, av2, av3;
  float4 af0, af1, af2, af3, af4, af5, af6, af7;
  const int lrow = tid >> 3, lkc = (tid & 7) * 8;
  const int frow = tid >> 4, fkc = (tid & 15) * 4;
#define GM_LOAD(KT_)                                                                     \
  {                                                                                      \
    const int kk_ = (KT_) * 64;                                                          \
    bv0 = *(const uint4*)baddr(lrow, kk_ + lkc);                                         \
    bv1 = *(const uint4*)baddr(lrow + 32, kk_ + lkc);                                    \
    bv2 = *(const uint4*)baddr(lrow + 64, kk_ + lkc);                                    \
    bv3 = *(const uint4*)baddr(lrow + 96, kk_ + lkc);                                    \
    if constexpr (AF32) {                                                                \
      af0 = *(const float4*)(aaddr(frow) + kk_ + fkc);                                   \
      af1 = *(const float4*)(aaddr(frow + 16) + kk_ + fkc);                              \
      af2 = *(const float4*)(aaddr(frow + 32) + kk_ + fkc);                              \
      af3 = *(const float4*)(aaddr(frow + 48) + kk_ + fkc);                              \
      af4 = *(const float4*)(aaddr(frow + 64) + kk_ + fkc);                              \
      af5 = *(const float4*)(aaddr(frow + 80) + kk_ + fkc);                              \
      af6 = *(const float4*)(aaddr(frow + 96) + kk_ + fkc);                              \
      af7 = *(const float4*)(aaddr(frow + 112) + kk_ + fkc);                             \
    } else {                                                                             \
      av0 = *(const uint4*)aaddr(lrow, kk_ + lkc);                                       \
      av1 = *(const uint4*)aaddr(lrow + 32, kk_ + lkc);                                  \
      av2 = *(const uint4*)aaddr(lrow + 64, kk_ + lkc);                                  \
      av3 = *(const uint4*)aaddr(lrow + 96, kk_ + lkc);                                  \
    }                                                                                    \
  }
#define GM_STF(AF_, ROW_)                                                                \
  {                                                                                      \
    float rr_ = sm->rs[ROW_];                                                            \
    uint2 o_;                                                                            \
    o_.x = pk2(AF_.x * rr_ * g_.x + s_.x, AF_.y * rr_ * g_.y + s_.y);                    \
    o_.y = pk2(AF_.z * rr_ * g_.z + s_.z, AF_.w * rr_ * g_.w + s_.w);                    \
    *(uint2*)(sm->A + (ROW_) * LDT + fkc) = o_;                                          \
  }
#define GM_STORE(KT_)                                                                    \
  {                                                                                      \
    *(uint4*)(sm->B + lrow * LDT + lkc) = bv0;                                           \
    *(uint4*)(sm->B + (lrow + 32) * LDT + lkc) = bv1;                                    \
    *(uint4*)(sm->B + (lrow + 64) * LDT + lkc) = bv2;                                    \
    *(uint4*)(sm->B + (lrow + 96) * LDT + lkc) = bv3;                                    \
    if constexpr (AF32) {                                                                \
      const int k_ = (KT_) * 64 + fkc;                                                   \
      const float4 g_ = *(const float4*)(sm->gs + k_);                                   \
      const float4 s_ = *(const float4*)(sm->sh + k_);                                   \
      GM_STF(af0, frow) GM_STF(af1, frow + 16) GM_STF(af2, frow + 32) GM_STF(af3, frow + 48) \
      GM_STF(af4, frow + 64) GM_STF(af5, frow + 80) GM_STF(af6, frow + 96) GM_STF(af7, frow + 112) \
    } else {                                                                             \
      *(uint4*)(sm->A + lrow * LDT + lkc) = av0;                                         \
      *(uint4*)(sm->A + (lrow + 32) * LDT + lkc) = av1;                                  \
      *(uint4*)(sm->A + (lrow + 64) * LDT + lkc) = av2;                                  \
      *(uint4*)(sm->A + (lrow + 96) * LDT + lkc) = av3;                                  \
    }                                                                                    \
  }
  GM_LOAD(0)
  for (int kt = 0; kt < KT; ++kt) {
    GM_STORE(kt)
    __syncthreads();
    if (kt + 1 < KT) GM_LOAD(kt + 1)
#pragma unroll
    for (int ks = 0; ks < 4; ++ks) {
      bf16x8 a[2], b[2];
#pragma unroll
      for (int mi = 0; mi < 2; ++mi) a[mi] = *(const bf16x8*)(sm->A + (wm * 64 + mi * 32 + r) * LDT + ks * 16 + h * 8);
#pragma unroll
      for (int ni = 0; ni < 2; ++ni) b[ni] = *(const bf16x8*)(sm->B + (wn * 64 + ni * 32 + r) * LDT + ks * 16 + h * 8);
#pragma unroll
      for (int mi = 0; mi < 2; ++mi)
#pragma unroll
        for (int ni = 0; ni < 2; ++ni) acc[mi][ni] = MFMA32(a[mi], b[ni], acc[mi][ni]);
    }
    __syncthreads();
  }
}

DI float transpose_reduce16(float (&v)[16], int lane) {
  float r8[8], r4[4], r2[2];
  {
    bool up = lane & 8;
#pragma unroll
    for (int i = 0; i < 8; ++i) {
      float send = up ? v[i] : v[i + 8];
      float keep = up ? v[i + 8] : v[i];
      r8[i] = keep + __shfl_xor(send, 8);
    }
  }
  {
    bool up = lane & 4;
#pragma unroll
    for (int i = 0; i < 4; ++i) {
      float send = up ? r8[i] : r8[i + 4];
      float keep = up ? r8[i + 4] : r8[i];
      r4[i] = keep + __shfl_xor(send, 4);
    }
  }
  {
    bool up = lane & 2;
#pragma unroll
    for (int i = 0; i < 2; ++i) {
      float send = up ? r4[i] : r4[i + 2];
      float keep = up ? r4[i + 2] : r4[i];
      r2[i] = keep + __shfl_xor(send, 2);
    }
  }
  bool up = lane & 1;
  float send = up ? r2[0] : r2[1];
  float keep = up ? r2[1] : r2[0];
  return keep + __shfl_xor(send, 1);
}

#define WAVE_IDS                                              \
  const int tid = opaque_tid(), lane = tid & 63, wave = tid >> 6; \
  const int wm = wave >> 1, wn = wave & 1, r = lane & 31, h = lane >> 5; \
  (void)wm; (void)wn; (void)r; (void)h;

DI void phase_o1(const Params& p, char* smem) {
  GemmSmem* sm = (GemmSmem*)smem;
  WAVE_IDS
  const int NT = 12, units = (TOK / 128) * NT;
  const bfr* WT = (const bfr*)(p.ws + O_WT_IN0);
  const float* RS0 = (const float*)(p.ws + O_RS0);
  bfr* PC = (bfr*)(p.ws + O_PC);
  bfr* SZ0 = (bfr*)(p.ws + O_SZ0);
  bfr* Kb = (bfr*)(p.ws + O_K);
  for (int u = blockIdx.x; u < units; u += gridDim.x) {
    int mt = u / NT, nt = u - mt * NT;
    int m0 = mt * 128, n0 = nt * 128;
    __syncthreads();
    const float* md = modrow(p, 0, m0);
    const float* ng = p.in[I_NORMG];
    for (int k = tid; k < 1024; k += 256) {
      sm->gs[k] = ng[k] * (1.f + md[1024 + k]);
      sm->sh[k] = md[k];
    }
    if (tid < 128) sm->rs[tid] = RS0[m0 + tid];
    __syncthreads();
    const float* abase = xrow0(p, m0);
    f32x16 acc[2][2];
    zero_acc(acc);
    gemm_main<true>(
        acc, 16, [&](int row) { return abase + (size_t)row * 1024; },
        [&](int row, int k) {
          int n = n0 + row;
          n = n < NIN0 ? n : NIN0 - 1;
          return WT + (size_t)n * 1024 + k;
        },
        sm);
    int b = m0 / LALL, pos0 = m0 - b * LALL;
    bool lat = pos0 >= LC;
#pragma unroll
    for (int mi = 0; mi < 2; ++mi)
#pragma unroll
      for (int ni = 0; ni < 2; ++ni) {
        int col0 = n0 + wn * 64 + ni * 32;
        if (col0 >= NIN0) continue;
        int col = col0 + r;
#pragma unroll
        for (int i = 0; i < 16; ++i) {
          int row = wm * 64 + mi * 32 + crow(i, h);
          int tok = m0 + row;
          float v = acc[mi][ni][i];
          if (col0 < 384) {
            PC[(size_t)tok * 384 + col] = f2bf(v);
          } else if (col0 == 384) {
            float vp = __shfl_xor(v, 8);
            int pos = pos0 + row;
            float val = lat ? rope_apply(r, v, vp, pos - LC) : v;
            bfr bv = f2bf(val);
            for (int hh = 0; hh < NH; ++hh) Kb[(((size_t)(b * NH + hh)) * LALL + pos) * DQK + 64 + r] = bv;
          } else {
            SZ0[(size_t)tok * 1024 + (col - 416)] = f2bf(silu_f(v));
          }
          SCHED_FENCE();
        }
      }
  }
}

DI void phase_o2(const Params& p, char* smem) {
  GemmSmem* sm = (GemmSmem*)smem;
  WAVE_IDS
  const int UQ = (TOK / 128) * 12, UKV = (TOK / 128) * 16;
  const bfr* PC = (const bfr*)(p.ws + O_PC);
  bfr* Q = (bfr*)p.out;
  bfr* Kb = (bfr*)(p.ws + O_K);
  bfr* VT = (bfr*)(p.ws + O_VT);
  for (int u = blockIdx.x; u < UQ + UKV; u += gridDim.x) {
    bool isq = u < UQ;
    int uu = isq ? u : u - UQ;
    int NT = isq ? 12 : 16;
    int mt = uu / NT, nt = uu - mt * NT;
    int m0 = mt * 128, n0 = nt * 128;
    int Kd = isq ? 256 : 128;
    int aoff = isq ? 0 : 256;
    const bfr* WT = (const bfr*)(p.ws + (isq ? O_WT_UQ : O_WT_UKV));
    __syncthreads();
    {
      int row = tid >> 1, half = tid & 1;
      const bfr* ap = PC + (size_t)(m0 + row) * 384 + aoff + half * (Kd / 2);
      float ss = 0.f;
      for (int j = 0; j < Kd / 16; ++j) {
        uint4 v = *(const uint4*)(ap + j * 8);
        unsigned w[4] = {v.x, v.y, v.z, v.w};
#pragma unroll
        for (int e = 0; e < 4; ++e) {
          float lo = __uint_as_float(w[e] << 16), hi = __uint_as_float(w[e] & 0xffff0000u);
          ss += lo * lo + hi * hi;
        }
      }
      ss += __shfl_xor(ss, 1);
      if (half == 0) sm->rs[row] = rsqrtf(ss / (float)Kd + EPS);
    }
    __syncthreads();
    f32x16 acc[2][2];
    zero_acc(acc);
    gemm_main<false>(
        acc, Kd / 64, [&](int row, int k) { return PC + (size_t)(m0 + row) * 384 + aoff + k; },
        [&](int row, int k) { return WT + (size_t)(n0 + row) * Kd + k; }, sm);
    int b = m0 / LALL, pos0 = m0 - b * LALL;
    bool lat = pos0 >= LC;
#pragma unroll
    for (int mi = 0; mi < 2; ++mi)
#pragma unroll
      for (int ni = 0; ni < 2; ++ni) {
        int col0 = n0 + wn * 64 + ni * 32;
        if (isq) {
          int hh = col0 / 96, d0 = col0 - hh * 96;
          bool rope = lat && d0 == 64;
#pragma unroll
          for (int i = 0; i < 16; ++i) {
            int row = wm * 64 + mi * 32 + crow(i, h);
            int pos = pos0 + row;
            float v = acc[mi][ni][i] * sm->rs[row];
            float vp = __shfl_xor(v, 8);
            float val = rope ? rope_apply(r, v, vp, pos - LC) : v;
            Q[(((size_t)(b * NH + hh)) * LALL + pos) * DQK + d0 + r] = f2bf(val * QSCALE);
            SCHED_FENCE();
          }
        } else {
          int hh = col0 >> 7, d0 = col0 & 127;
          if (d0 < 64) {
#pragma unroll
            for (int i = 0; i < 16; ++i) {
              int row = wm * 64 + mi * 32 + crow(i, h);
              int pos = pos0 + row;
              float v = acc[mi][ni][i] * sm->rs[row];
              Kb[(((size_t)(b * NH + hh)) * LALL + pos) * DQK + d0 + r] = f2bf(v);
              SCHED_FENCE();
            }
          } else {
            int dvv = d0 - 64 + r;
#pragma unroll
            for (int g4 = 0; g4 < 4; ++g4) {
              int row = wm * 64 + mi * 32 + 8 * g4 + 4 * h;
              int pos = pos0 + row;
              uint2 o;
              o.x = pk2(acc[mi][ni][4 * g4 + 0] * sm->rs[row + 0], acc[mi][ni][4 * g4 + 1] * sm->rs[row + 1]);
              o.y = pk2(acc[mi][ni][4 * g4 + 2] * sm->rs[row + 2], acc[mi][ni][4 * g4 + 3] * sm->rs[row + 3]);
              *(uint2*)(VT + (((size_t)(b * NH + hh)) * DV + dvv) * LALL + pos) = o;
            }
          }
        }
      }
  }
}

constexpr int KLD = 104;
constexpr int VLD = 68;
struct AttnSmem {
  bfr K[64 * KLD];
  bfr V[64 * VLD];
};
static_assert(sizeof(AttnSmem) <= SMEM_BYTES, "smem");

DI void attn_item(const Params& p, AttnSmem* sm, int bh, int qpos0, int nkeys) {
  WAVE_IDS
  const bfr* Q = (const bfr*)p.out;
  const bfr* Kg = (const bfr*)(p.ws + O_K) + (size_t)bh * LALL * DQK;
  const bfr* Vg = (const bfr*)(p.ws + O_VT) + (size_t)bh * DV * LALL;
  const int qpos = qpos0 + wave * 32 + r;
  bf16x8 bq[6];
  {
    const bfr* qp = Q + ((size_t)bh * LALL + qpos) * DQK + 8 * h;
#pragma unroll
    for (int s = 0; s < 6; ++s) bq[s] = *(const bf16x8*)(qp + 16 * s);
  }
  f32x16 o[2];
#pragma unroll
  for (int d = 0; d < 2; ++d)
#pragma unroll
    for (int i = 0; i < 16; ++i) o[d][i] = 0.f;
  float mrun = -1e30f, lrun = 0.f;
  uint4 kv0, kv1, kv2, vv0, vv1;
  const int kr0 = tid / 12, kc0 = (tid - kr0 * 12) * 8;
  const int kr1 = (tid + 256) / 12, kc1 = (tid + 256 - kr1 * 12) * 8;
  const int kr2 = (tid + 512) / 12, kc2 = (tid + 512 - kr2 * 12) * 8;
  const int vr0 = tid >> 3, vc0 = (tid & 7) * 8;
#define AT_GLOAD(KEY0_)                                                          \
  {                                                                              \
    const int key0_ = (KEY0_);                                                   \
    kv0 = *(const uint4*)(Kg + (size_t)(key0_ + kr0) * DQK + kc0);               \
    kv1 = *(const uint4*)(Kg + (size_t)(key0_ + kr1) * DQK + kc1);               \
    kv2 = *(const uint4*)(Kg + (size_t)(key0_ + kr2) * DQK + kc2);               \
    vv0 = *(const uint4*)(Vg + (size_t)vr0 * LALL + key0_ + vc0);                \
    vv1 = *(const uint4*)(Vg + (size_t)(vr0 + 32) * LALL + key0_ + vc0);         \
  }
#define AT_LSTORE()                                                              \
  {                                                                              \
    *(uint4*)(sm->K + kr0 * KLD + kc0) = kv0;                                    \
    *(uint4*)(sm->K + kr1 * KLD + kc1) = kv1;                                    \
    *(uint4*)(sm->K + kr2 * KLD + kc2) = kv2;                                    \
    uint2* d0_ = (uint2*)(sm->V + vr0 * VLD + vc0);                              \
    d0_[0] = make_uint2(vv0.x, vv0.y);                                           \
    d0_[1] = make_uint2(vv0.z, vv0.w);                                           \
    uint2* d1_ = (uint2*)(sm->V + (vr0 + 32) * VLD + vc0);                       \
    d1_[0] = make_uint2(vv1.x, vv1.y);                                           \
    d1_[1] = make_uint2(vv1.z, vv1.w);                                           \
  }
  const int NTI = nkeys / 64;
  AT_GLOAD(0)
  for (int it = 0; it < NTI; ++it) {
    AT_LSTORE()
    __syncthreads();
    if (it + 1 < NTI) AT_GLOAD((it + 1) * 64)
    f32x16 st[2];
#pragma unroll
    for (int kb = 0; kb < 2; ++kb) {
#pragma unroll
      for (int i = 0; i < 16; ++i) st[kb][i] = 0.f;
#pragma unroll
      for (int s = 0; s < 6; ++s) {
        bf16x8 ka = *(const bf16x8*)(sm->K + (kb * 32 + r) * KLD + 16 * s + 8 * h);
        st[kb] = MFMA32(ka, bq[s], st[kb]);
      }
    }
    float mx = st[0][0];
#pragma unroll
    for (int kb = 0; kb < 2; ++kb)
#pragma unroll
      for (int i = 0; i < 16; ++i) mx = fmaxf(mx, st[kb][i]);
    mx = fmaxf(mx, __shfl_xor(mx, 32));
    float mnew = fmaxf(mrun, mx);
    float alpha = exp2f(mrun - mnew);
    mrun = mnew;
    float ps = 0.f;
#pragma unroll
    for (int kb = 0; kb < 2; ++kb)
#pragma unroll
      for (int i = 0; i < 16; ++i) {
        float e = exp2f(st[kb][i] - mnew);
        st[kb][i] = e;
        ps += e;
      }
    lrun = lrun * alpha + ps;
#pragma unroll
    for (int d = 0; d < 2; ++d)
#pragma unroll
      for (int i = 0; i < 16; ++i) o[d][i] *= alpha;
#pragma unroll
    for (int kb = 0; kb < 2; ++kb)
#pragma unroll
      for (int s2 = 0; s2 < 2; ++s2) {
        unsigned pw[4];
#pragma unroll
        for (int j = 0; j < 4; ++j) pw[j] = pk2(st[kb][8 * s2 + 2 * j], st[kb][8 * s2 + 2 * j + 1]);
        bf16x8 pb;
        {
          uint4 t = make_uint4(pw[0], pw[1], pw[2], pw[3]);
          pb = __builtin_bit_cast(bf16x8, t);
        }
#pragma unroll
        for (int d = 0; d < 2; ++d) {
          const bfr* vp = sm->V + (d * 32 + r) * VLD + kb * 32 + 16 * s2 + 4 * h;
          uint2 lo = *(const uint2*)vp;
          uint2 hi = *(const uint2*)(vp + 8);
          uint4 t = make_uint4(lo.x, lo.y, hi.x, hi.y);
          bf16x8 va = __builtin_bit_cast(bf16x8, t);
          o[d] = MFMA32(va, pb, o[d]);
        }
      }
    __syncthreads();
  }
  float ltot = lrun + __shfl_xor(lrun, 32);
  float inv = 1.f / ltot;
  int b = bh / NH, hh = bh - b * NH;
  size_t tok = (size_t)b * LALL + qpos;
  const bfr* SZ = (const bfr*)(p.ws + O_SZ0) + tok * 1024 + hh * 64;
  bfr* OG = (bfr*)(p.ws + O_OG) + tok * 1024 + hh * 64;
#pragma unroll
  for (int d = 0; d < 2; ++d)
#pragma unroll
    for (int g4 = 0; g4 < 4; ++g4) {
      int dv0 = d * 32 + 8 * g4 + 4 * h;
      uint2 z = *(const uint2*)(SZ + dv0);
      float z0 = __uint_as_float(z.x << 16), z1 = __uint_as_float(z.x & 0xffff0000u);
      float z2 = __uint_as_float(z.y << 16), z3 = __uint_as_float(z.y & 0xffff0000u);
      uint2 ov;
      ov.x = pk2(o[d][4 * g4 + 0] * inv * z0, o[d][4 * g4 + 1] * inv * z1);
      ov.y = pk2(o[d][4 * g4 + 2] * inv * z2, o[d][4 * g4 + 3] * inv * z3);
      *(uint2*)(OG + dv0) = ov;
    }
}

DI void phase_o3(const Params& p, char* smem) {
  AttnSmem* sm = (AttnSmem*)smem;
  const int xcd = blockIdx.x & 7, local = blockIdx.x >> 3, nloc = gridDim.x >> 3;
  for (int j = local; j < 256; j += nloc) {
    int u = xcd * 256 + j;
    attn_item(p, sm, u >> 4, LC + (u & 15) * 128, LALL);
  }
  for (int j = local; j < 32; j += nloc) {
    int u = xcd * 32 + j;
    attn_item(p, sm, u >> 1, (u & 1) * 128, LC);
  }
}

template <int LAYER>
DI void phase_oproj(const Params& p, char* smem) {
  GemmSmem* sm = (GemmSmem*)smem;
  WAVE_IDS
  constexpr int NROWS = LAYER == 0 ? TOK : NLAT;
  const int NT = 8, units = (NROWS / 128) * NT;
  const bfr* Ab = (const bfr*)(p.ws + (LAYER == 0 ? O_OG : O_Y2));
  const bfr* WT = (const bfr*)(p.ws + (LAYER == 0 ? O_WT_OUT0 : O_WT_OUT1));
  float* part = (float*)(p.ws + (LAYER == 0 ? O_PART1 : O_PART2));
  for (int u = blockIdx.x; u < units; u += gridDim.x) {
    int mt = u / NT, nt = u - mt * NT;
    int m0 = mt * 128, n0 = nt * 128;
    f32x16 acc[2][2];
    zero_acc(acc);
    gemm_main<false>(
        acc, 16, [&](int row, int k) { return Ab + (size_t)(m0 + row) * 1024 + k; },
        [&](int row, int k) { return WT + (size_t)(n0 + row) * 1024 + k; }, sm);
    const float* xin;
    float* xout;
    const float* gt;
    if (LAYER == 0) {
      xin = xrow0(p, m0);
      xout = xrow1(p, m0);
      gt = modrow(p, 0, m0) + 2048;
    } else {
      xin = p.out + (size_t)m0 * 1024;
      xout = p.out + (size_t)m0 * 1024;
      gt = (const float*)(p.ws + O_MOD) + ((size_t)(9 + (m0 >> 11))) * 3072 + 2048;
    }
    float tot = 0.f;
#pragma unroll
    for (int mi = 0; mi < 2; ++mi) {
      float sq[16];
#pragma unroll
      for (int i = 0; i < 16; ++i) sq[i] = 0.f;
#pragma unroll
      for (int ni = 0; ni < 2; ++ni) {
        int col = n0 + wn * 64 + ni * 32 + r;
        float g = gt[col];
#pragma unroll
        for (int i = 0; i < 16; ++i) {
          int row = wm * 64 + mi * 32 + crow(i, h);
          float v = xin[(size_t)row * 1024 + col] + g * acc[mi][ni][i];
          xout[(size_t)row * 1024 + col] = v;
          sq[i] += v * v;
          SCHED_FENCE();
        }
      }
      float t = transpose_reduce16(sq, lane);
      t += __shfl_xor(t, 16);
      if (((lane >> 4) & 1) == mi) tot = t;
    }
    int idx = lane & 31;
    int row = m0 + wm * 64 + (idx >> 4) * 32 + crow(idx & 15, h);
    part[(size_t)(nt * 2 + wn) * NROWS + row] = tot;
  }
}

DI void phase_o5(const Params& p, char* smem) {
  GemmSmem* sm = (GemmSmem*)smem;
  WAVE_IDS
  const int NT = 16, units = (TOK / 128) * NT;
  const bfr* WT = (const bfr*)(p.ws + O_WT_IN1);
  const float* part = (const float*)(p.ws + O_PART1);
  bfr* U2 = (bfr*)(p.ws + O_U2);
  bfr* SZ1 = (bfr*)(p.ws + O_SZ1);
  for (int u = blockIdx.x; u < units; u += gridDim.x) {
    int mt = u / NT, nt = u - mt * NT;
    int m0 = mt * 128, n0 = nt * 128;
    int b = m0 / LALL, pos0 = m0 - b * LALL;
    bool lat = pos0 >= LC;
    if (!lat && nt >= 8) continue;
    __syncthreads();
    const float* md = modrow(p, 1, m0);
    const float* ng = p.in[I_NORMG] + 1024;
    for (int k = tid; k < 1024; k += 256) {
      sm->gs[k] = ng[k] * (1.f + md[1024 + k]);
      sm->sh[k] = md[k];
    }
    if (tid < 128) sm->rs[tid] = rs_from_part(part, TOK, m0 + tid);
    __syncthreads();
    const float* abase = xrow1(p, m0);
    f32x16 acc[2][2];
    zero_acc(acc);
    gemm_main<true>(
        acc, 16, [&](int row) { return abase + (size_t)row * 1024; },
        [&](int row, int k) { return WT + (size_t)(n0 + row) * 1024 + k; }, sm);
#pragma unroll
    for (int mi = 0; mi < 2; ++mi)
#pragma unroll
      for (int ni = 0; ni < 2; ++ni) {
        int col = n0 + wn * 64 + ni * 32 + r;
#pragma unroll
        for (int i = 0; i < 16; ++i) {
          int row = wm * 64 + mi * 32 + crow(i, h);
          int tok = m0 + row;
          float v = acc[mi][ni][i];
          if (col < 1024) U2[((size_t)(col >> 4) * TOK + tok) * 16 + (col & 15)] = f2bf(v);
          else SZ1[((size_t)(b * SEQ + pos0 + row - LC)) * 1024 + (col - 1024)] = f2bf(silu_f(v));
          SCHED_FENCE();
        }
      }
  }
}

DI void phase_o6(const Params& p, char* smem) {
  GemmSmem* sm = (GemmSmem*)smem;
  WAVE_IDS
  const int NROW = NB * NCH;
  const int units = 64 * 5 * 2;
  const bfr* U2 = (const bfr*)(p.ws + O_U2);
  const bfr* WST = (const bfr*)(p.ws + O_WST);
  float* SLOC = (float*)(p.ws + O_SLOC);
  for (int u = blockIdx.x; u < units; u += gridDim.x) {
    int g = u / 10, rem = u - g * 10;
    int mt = rem >> 1, nt = rem & 1;
    int m0 = mt * 128, n0 = nt * 128;
    const bfr* Ag = U2 + (size_t)g * TOK * 16;
    const bfr* Bg = WST + (size_t)g * 256 * 512;
    f32x16 acc[2][2];
    zero_acc(acc);
    gemm_main<false>(
        acc, 8,
        [&](int row, int k) {
          int rr = m0 + row;
          rr = rr < NROW ? rr : NROW - 1;
          return Ag + (size_t)rr * 512 + k;
        },
        [&](int row, int k) { return Bg + (size_t)(n0 + row) * 512 + k; }, sm);
#pragma unroll
    for (int mi = 0; mi < 2; ++mi)
#pragma unroll
      for (int ni = 0; ni < 2; ++ni) {
        int col = n0 + wn * 64 + ni * 32 + r;
#pragma unroll
        for (int i = 0; i < 16; ++i) {
          int row = m0 + wm * 64 + mi * 32 + crow(i, h);
          if (row < NROW) SLOC[((size_t)g * NROW + row) * 256 + col] = acc[mi][ni][i];
        }
      }
  }
}

DI void phase_o7(const Params& p) {
  const int tidx_ = opaque_tid();
  const float* SLOC = (const float*)(p.ws + O_SLOC);
  bfr* SIN = (bfr*)(p.ws + O_SIN);
  const int total = NB * 64 * 2 * 64;
  for (int idx = blockIdx.x * 256 + tidx_; idx < total; idx += gridDim.x * 256) {
    int pp = idx & 63, dir = (idx >> 6) & 1, g = (idx >> 7) & 63, b = idx >> 13;
    double dt, ar, ai;
    float fr, fi, lr, li;
    s5_disc(p, dir, g, pp, dt, ar, ai, fr, fi);
    s5_pow(dt, ar, ai, TC, lr, li);
    float sr = 0.f, si = 0.f;
    for (int step = 0; step < NCH; ++step) {
      int cp = dir == 0 ? step : (step < 8 ? 7 - step : NCH - 1 - (step - 8));
      const float* sl = SLOC + ((size_t)g * (NB * NCH) + b * NCH + cp) * 256 + dir * 128 + pp;
#ifdef PROBE_NOCARRY
      if ((dir == 0 && cp == 8) || (dir == 1 && cp == NCH - 1)) { sr = 0.f; si = 0.f; }
#endif
      if (cp >= 8) {
        bfr* so = SIN + ((size_t)g * (NB * NCHL) + b * NCHL + (cp - 8)) * 256 + dir * 128 + pp;
        so[0] = f2bf(sr);
        so[64] = f2bf(si);
      }
      float lre = sl[0], lim = sl[64];
      float nr = lr * sr - li * si + lre;
      float ni = lr * si + li * sr + lim;
      sr = nr;
      si = ni;
    }
  }
}

DI void phase_o8(const Params& p, char* smem) {
  GemmSmem* sm = (GemmSmem*)smem;
  WAVE_IDS
  const int units = 64 * 4 * 4;
  const bfr* U2 = (const bfr*)(p.ws + O_U2);
  const bfr* SIN = (const bfr*)(p.ws + O_SIN);
  const bfr* KTAB = (const bfr*)(p.ws + O_KTAB);
  const bfr* VOP = (const bfr*)(p.ws + O_VOP);
  bfr* YG = (bfr*)(p.ws + O_YG);
  for (int u = blockIdx.x; u < units; u += gridDim.x) {
    int g = u >> 4, mt = (u >> 2) & 3, nt = u & 3;
    int m0 = mt * 128, n0 = nt * 128;
    const bfr* Ug = U2 + (size_t)g * TOK * 16;
    f32x16 acc[2][2];
    zero_acc(acc);
    gemm_main<false>(
        acc, 12,
        [&](int row, int k) {
          int rr = m0 + row;
          int b = rr >> 6, n = rr & 63;
          const bfr* a1 = Ug + ((size_t)b * LALL + LC + n * TC) * 16 + k;
          const bfr* a2 = SIN + ((size_t)g * (NB * NCHL) + rr) * 256 + (k - 512);
          return k < 512 ? a1 : a2;
        },
        [&](int row, int k) {
          int m = n0 + row;
          int t = m >> 4, c = m & 15;
          int j = k >> 4;
          const bfr* b1 = KTAB + (((size_t)g * 63 + (t - j + 31)) * 16 + c) * 16 + (k & 15);
          const bfr* b2 = VOP + ((size_t)g * 512 + m) * 256 + (k - 512);
          return k < 512 ? b1 : b2;
        },
        sm);
#pragma unroll
    for (int mi = 0; mi < 2; ++mi)
#pragma unroll
      for (int ni = 0; ni < 2; ++ni) {
        int m = n0 + wn * 64 + ni * 32 + r;
        int t = m >> 4, c = m & 15;
        int ch = g * 16 + c;
        float dd = p.in[I_S5D][ch];
#pragma unroll
        for (int i = 0; i < 16; ++i) {
          int rr = m0 + wm * 64 + mi * 32 + crow(i, h);
          int b = rr >> 6, n = rr & 63;
          float uu = bf2f(Ug[((size_t)b * LALL + LC + n * TC + t) * 16 + c]);
          float y = acc[mi][ni][i] + dd * uu;
          YG[((size_t)(b * SEQ + n * TC + t)) * 1024 + ch] = f2bf(gelu_tanh(y));
          SCHED_FENCE();
        }
      }
  }
}

DI void phase_o9(const Params& p, char* smem) {
  GemmSmem* sm = (GemmSmem*)smem;
  WAVE_IDS
  const int NT = 8, units = (NLAT / 128) * NT;
  const bfr* YG = (const bfr*)(p.ws + O_YG);
  const bfr* SZ1 = (const bfr*)(p.ws + O_SZ1);
  const bfr* WT = (const bfr*)(p.ws + O_WT_GLU);
  bfr* Y2 = (bfr*)(p.ws + O_Y2);
  for (int u = blockIdx.x; u < units; u += gridDim.x) {
    int mt = u / NT, nt = u - mt * NT;
    int m0 = mt * 128, n0 = nt * 128;
    f32x16 acc[2][2];
    zero_acc(acc);
    gemm_main<false>(
        acc, 16, [&](int row, int k) { return YG + (size_t)(m0 + row) * 1024 + k; },
        [&](int row, int k) { return WT + (size_t)(n0 + row) * 1024 + k; }, sm);
#pragma unroll
    for (int mi = 0; mi < 2; ++mi)
#pragma unroll
      for (int ni = 0; ni < 2; ++ni) {
        int col = n0 + wn * 64 + ni * 32 + r;
        float bg = p.in[I_BGLU][col];
#pragma unroll
        for (int i = 0; i < 16; ++i) {
          size_t o = (size_t)(m0 + wm * 64 + mi * 32 + crow(i, h)) * 1024 + col;
          float y = bf2f(YG[o]);
          Y2[o] = f2bf(y * sigmoid_f(acc[mi][ni][i] + bg) * bf2f(SZ1[o]));
          SCHED_FENCE();
        }
      }
  }
}

DI void run_phase(const Params& p, int ph, char* smem) {
  switch (ph) {
#if !defined(ONLY) || ONLY == 0
    case PH_PREP: phase_prep(p, smem); break;
#endif
#if USE_NAIVE
    case PH_N1: phase_n1(p); break;
    case PH_N2: phase_n2(p); break;
    case PH_N3: phase_n3(p); break;
    case PH_N4: phase_n4(p); break;
    case PH_N4B: phase_rowsq(p, 1); break;
    case PH_N5: phase_n5(p); break;
    case PH_N6A: phase_n6(p, 0); break;
    case PH_N6B: phase_n6(p, 1); break;
    case PH_N9: phase_n9(p); break;
    case PH_N10: phase_n10(p); break;
    case PH_N10B: phase_rowsq(p, 2); break;
#endif
#if !defined(ONLY) || ONLY == 1
    case PH_FINAL: phase_final(p); break;
#endif
#if !defined(ONLY) || ONLY == 2
    case PH_O1: phase_o1(p, smem); break;
#endif
#if !defined(ONLY) || ONLY == 3
    case PH_O2: phase_o2(p, smem); break;
#endif
#if !defined(ONLY) || ONLY == 4
    case PH_O3: phase_o3(p, smem); break;
#endif
#if !defined(ONLY) || ONLY == 5
    case PH_O4: phase_oproj<0>(p, smem); break;
#endif
#if !defined(ONLY) || ONLY == 6
    case PH_O5: phase_o5(p, smem); break;
#endif
#if !defined(ONLY) || ONLY == 7
    case PH_O6: phase_o6(p, smem); break;
#endif
#if !defined(ONLY) || ONLY == 8
    case PH_O7: phase_o7(p); break;
#endif
#if !defined(ONLY) || ONLY == 9
    case PH_O8: phase_o8(p, smem); break;
#endif
#if !defined(ONLY) || ONLY == 10
    case PH_O9: phase_o9(p, smem); break;
#endif
#if !defined(ONLY) || ONLY == 11
    case PH_O10: phase_oproj<1>(p, smem); break;
#endif
    default: break;
  }
}

__global__ void __launch_bounds__(256, 2) mega_one(Params p, int ph) {
  __shared__ __attribute__((aligned(16))) char smem[SMEM_BYTES];
  run_phase(p, ph, smem);
}

#if !defined(ONLY) && SINGLE_LAUNCH
__global__ void __launch_bounds__(256, 2) mega(Params p) {
  __shared__ __attribute__((aligned(16))) char smem[SMEM_BYTES];
  cg::grid_group grid = cg::this_grid();
#if !defined(OMIT) || OMIT != 0
  phase_prep(p, smem);
#endif
  cg::this_grid().sync();
#if !defined(OMIT) || OMIT != 1
  phase_o1(p, smem);
#endif
  cg::this_grid().sync();
#if !defined(OMIT) || OMIT != 2
  phase_o2(p, smem);
#endif
  cg::this_grid().sync();
#if !defined(OMIT) || OMIT != 3
  phase_o3(p, smem);
#endif
  cg::this_grid().sync();
#if !defined(OMIT) || OMIT != 4
  phase_oproj<0>(p, smem);
#endif
  cg::this_grid().sync();
#if !defined(OMIT) || OMIT != 5
  phase_o5(p, smem);
#endif
  cg::this_grid().sync();
#if !defined(OMIT) || OMIT != 6
  phase_o6(p, smem);
#endif
  cg::this_grid().sync();
#if !defined(OMIT) || OMIT != 7
  phase_o7(p);
#endif
  cg::this_grid().sync();
#if !defined(OMIT) || OMIT != 8
  phase_o8(p, smem);
#endif
  cg::this_grid().sync();
#if !defined(OMIT) || OMIT != 9
  phase_o9(p, smem);
#endif
  cg::this_grid().sync();
#if !defined(OMIT) || OMIT != 10
  phase_oproj<1>(p, smem);
#endif
  cg::this_grid().sync();
#if !defined(OMIT) || OMIT != 11
  phase_final(p);
#endif
}
#else
__global__ void mega(Params p) {}
#endif


extern "C" void kernel_launch(void* const* d_in, const int* in_sizes, int n_in, void* d_out, int out_size, void* d_ws,
                              size_t ws_size, hipStream_t stream) {
  static int grid_blocks = 0;
  if (!grid_blocks) {
    int dev = 0, cus = 0, per_cu = 0;
    hipGetDevice(&dev);
    hipDeviceGetAttribute(&cus, hipDeviceAttributeMultiprocessorCount, dev);
#if SINGLE_LAUNCH
    hipOccupancyMaxActiveBlocksPerMultiprocessor(&per_cu, mega, 256, 0);
#else
    hipOccupancyMaxActiveBlocksPerMultiprocessor(&per_cu, mega_one, 256, 0);
#endif
    if (per_cu < 1) per_cu = 1;
    grid_blocks = cus * per_cu;
  }
  if (ws_size < WS_NEED || n_in < N_INPUTS) {
    fprintf(stderr, "workspace too small or bad inputs: %zu < %zu\n", ws_size, (size_t)WS_NEED);
    return;
  }
  Params p{};
  for (int i = 0; i < N_INPUTS; ++i) p.in[i] = (const float*)d_in[i];
  p.out = (float*)d_out;
  p.ws = (char*)d_ws;
#ifndef PROG
#define PROG PH_PREP, PH_O1, PH_O2, PH_O3, PH_O4, PH_O5, PH_O6, PH_O7, PH_O8, PH_O9, PH_O10, PH_FINAL
#endif
  const int prog[] = {PROG};
  p.nprog = (int)(sizeof(prog) / sizeof(int));
  for (int i = 0; i < p.nprog; ++i) p.prog[i] = prog[i];
#if SINGLE_LAUNCH
  void* args[] = {&p};
  hipError_t e = hipLaunchCooperativeKernel((void*)mega, dim3(grid_blocks), dim3(256), args, 0, stream);
  if (e != hipSuccess) fprintf(stderr, "cooperative launch failed: %s (grid %d)\n", hipGetErrorString(e), grid_blocks);
#else
  for (int i = 0; i < p.nprog; ++i) {
    mega_one<<<dim3(grid_blocks), dim3(256), 0, stream>>>(p, p.prog[i]);
  }
#endif
}
```

```cpp
#include <hip/hip_runtime.h>
#include <hip/hip_cooperative_groups.h>
#include <cstdio>
namespace cg = cooperative_groups;
#ifndef USE_NAIVE
#define USE_NAIVE 0
#endif
#ifndef SINGLE_LAUNCH
#define SINGLE_LAUNCH 1
#endif

#define DI __device__ __forceinline__
typedef unsigned short bfr;

constexpr int D = 1024, NB = 8, SEQ = 2048, LC = 256, LALL = 2304;
constexpr int TOK = NB * LALL;
constexpr int NLAT = NB * SEQ;
constexpr int NH = 16, DQK = 96, DV = 64;
constexpr int NIN0 = 1440, NIN1 = 2048;
constexpr float EPS = 1e-6f;
constexpr float QSCALE = 0.10206207261596577f * 1.4426950408889634f;
constexpr int TC = 32;
constexpr int NCH = LALL / TC;
constexpr int NCHL = SEQ / TC;

enum { I_X = 0, I_C, I_CTX, I_CCTX, I_ADAW, I_ADAB, I_NORMG, I_WIN0, I_QNORM, I_WUQ, I_KVNORM, I_WUKV, I_WOUT0,
       I_WIN1, I_ARE, I_AIM, I_LOGSTEP, I_BRE, I_BIM, I_CRE, I_CIM, I_S5D, I_WGLU, I_BGLU, I_WOUT1, I_FINALG, N_INPUTS };

constexpr size_t al256(size_t x) { return (x + 255) & ~(size_t)255; }
constexpr size_t O_WT_IN0 = 0;
constexpr size_t O_WT_UQ = O_WT_IN0 + al256((size_t)NIN0 * 1024 * 2);
constexpr size_t O_WT_UKV = O_WT_UQ + al256((size_t)1536 * 256 * 2);
constexpr size_t O_WT_OUT0 = O_WT_UKV + al256((size_t)2048 * 128 * 2);
constexpr size_t O_WT_IN1 = O_WT_OUT0 + al256((size_t)1024 * 1024 * 2);
constexpr size_t O_WT_GLU = O_WT_IN1 + al256((size_t)2048 * 1024 * 2);
constexpr size_t O_WT_OUT1 = O_WT_GLU + al256((size_t)1024 * 1024 * 2);
constexpr size_t O_MOD = O_WT_OUT1 + al256((size_t)1024 * 1024 * 2);
constexpr size_t O_RS0 = O_MOD + al256((size_t)2 * 9 * 3072 * 4);
constexpr size_t O_PART1 = O_RS0 + al256((size_t)TOK * 4);
constexpr size_t O_PART2 = O_PART1 + al256((size_t)16 * TOK * 4);
constexpr size_t O_X1CTX = O_PART2 + al256((size_t)16 * NLAT * 4);
constexpr size_t O_KTAB = O_X1CTX + al256((size_t)NB * LC * 1024 * 4);
constexpr size_t O_WST = O_KTAB + al256((size_t)64 * 63 * 256 * 2);
constexpr size_t O_VOP = O_WST + al256((size_t)64 * 256 * 512 * 2);
constexpr size_t O_BAR = O_VOP + al256((size_t)64 * 512 * 256 * 2);
constexpr size_t BAR_BYTES = 3456 * 4;
constexpr size_t O_LAYER = O_BAR + al256(BAR_BYTES);
constexpr size_t O_PC = O_LAYER;
constexpr size_t O_SZ0 = O_PC + al256((size_t)TOK * 384 * 2);
constexpr size_t O_K = O_SZ0 + al256((size_t)TOK * 1024 * 2);
constexpr size_t O_VT = O_K + al256((size_t)NB * NH * LALL * DQK * 2);
constexpr size_t O_OG = O_VT + al256((size_t)NB * NH * DV * LALL * 2);
constexpr size_t O_END0 = O_OG + al256((size_t)TOK * 1024 * 2);
constexpr size_t O_U2 = O_LAYER;
constexpr size_t O_SZ1 = O_U2 + al256((size_t)64 * TOK * 16 * 2);
constexpr size_t O_SLOC = O_SZ1 + al256((size_t)NLAT * 1024 * 2);
constexpr size_t O_SIN = O_SLOC + al256((size_t)64 * (NB * NCH) * 256 * 4);
constexpr size_t O_YG = O_SIN + al256((size_t)64 * (NB * NCHL) * 256 * 2);
constexpr size_t O_END1 = O_YG + al256((size_t)NLAT * 1024 * 2);
constexpr size_t O_Y2 = O_SLOC;
constexpr size_t WS_NEED = (O_END0 > O_END1 ? O_END0 : O_END1);
static_assert(WS_NEED <= (size_t)256 * 1024 * 1024, "workspace too large");
static_assert((size_t)NB * NH * LALL * DQK * 2 <= (size_t)NLAT * 1024 * 4, "Q does not fit d_out");

struct Params {
  const float* in[N_INPUTS];
  float* out;
  char* ws;
  int prog[32];
  int nprog;
  int pad;
};

DI bfr f2bf(float x) {
  unsigned u = __float_as_uint(x);
  u += 0x7fffu + ((u >> 16) & 1u);
  return (bfr)(u >> 16);
}
DI int opaque_tid() {
  int t = threadIdx.x;
  asm volatile("" : "+v"(t));
  return t;
}
DI float bf2f(bfr b) { return __uint_as_float(((unsigned)b) << 16); }
DI float silu_f(float v) { return v / (1.f + __expf(-v)); }
DI float sigmoid_f(float v) { return 1.f / (1.f + __expf(-v)); }
DI float gelu_tanh(float v) {
  float u = 0.7978845608028654f * (v + 0.044715f * v * v * v);
  return 0.5f * v * (1.f + tanhf(u));
}
DI float wave_sum(float v) {
#pragma unroll
  for (int o = 32; o > 0; o >>= 1) v += __shfl_xor(v, o);
  return v;
}
DI float wave_max(float v) {
#pragma unroll
  for (int o = 32; o > 0; o >>= 1) v = fmaxf(v, __shfl_xor(v, o));
  return v;
}
DI const float* xrow0(const Params& p, int tok) {
  int b = tok / LALL, pos = tok - b * LALL;
  return pos < LC ? p.in[I_CTX] + ((size_t)(b * LC + pos)) * D : p.in[I_X] + ((size_t)(b * SEQ + pos - LC)) * D;
}
DI float* xrow1(const Params& p, int tok) {
  int b = tok / LALL, pos = tok - b * LALL;
  return pos < LC ? (float*)(p.ws + O_X1CTX) + ((size_t)(b * LC + pos)) * D : p.out + ((size_t)(b * SEQ + pos - LC)) * D;
}
DI const float* modrow(const Params& p, int layer, int tok) {
  int b = tok / LALL, pos = tok - b * LALL;
  int r = pos < LC ? 8 : b;
  return (const float*)(p.ws + O_MOD) + ((size_t)(layer * 9 + r)) * 3072;
}
DI void rope_cs(int fi, int posv, float& cs, float& sn) {
  float inv = exp2f(-(float)fi * (13.287712379549449f / 8.f));
  sincosf((float)posv * inv, &sn, &cs);
}
DI float rope_apply(int j, float v, float vp, int lpos) {
  int posv = (j & 16) ? (lpos & 63) : (lpos >> 6);
  float cs, sn;
  rope_cs(j & 7, posv, cs, sn);
  return (j & 8) ? (vp * sn + v * cs) : (v * cs - vp * sn);
}

DI void s5_disc(const Params& p, int dir, int g, int pp, double& dt, double& ar, double& ai, float& fr, float& fi) {
  dt = exp((double)p.in[I_LOGSTEP][dir * 64 + g]);
  ar = (double)p.in[I_ARE][(dir * 64 + g) * 64 + pp];
  ai = (double)p.in[I_AIM][(dir * 64 + g) * 64 + pp];
  double mag = exp(ar * dt);
  double a = ai * dt;
  a -= 6.283185307179586 * rint(a * 0.15915494309189535);
  float sn, cs;
  sincosf((float)a, &sn, &cs);
  double lr = mag * (double)cs, li = mag * (double)sn;
  double den = ar * ar + ai * ai, nr = lr - 1.0;
  fr = (float)((nr * ar + li * ai) / den);
  fi = (float)((li * ar - nr * ai) / den);
}
DI void s5_pow(double dt, double ar, double ai, int k, float& wr, float& wi) {
  double mag = exp(ar * dt * (double)k);
  double a = ai * dt * (double)k;
  a -= 6.283185307179586 * rint(a * 0.15915494309189535);
  float sn, cs;
  sincosf((float)a, &sn, &cs);
  wr = (float)mag * cs;
  wi = (float)mag * sn;
}

enum { PH_PREP = 0, PH_N1, PH_N2, PH_N3, PH_N4, PH_N4B, PH_N5, PH_N6A, PH_N6B, PH_N9, PH_N10, PH_N10B, PH_FINAL,
       PH_O1, PH_O2, PH_O3, PH_O4, PH_O5, PH_O6, PH_O7, PH_O8, PH_O9, PH_O10, PH_COUNT };

constexpr int SMEM_BYTES = 48 * 1024;


DI void prep_transpose(const Params& p, int widx, int tile, char* smem) {
  const int tidx_ = opaque_tid();
  int K, N;
  size_t dst;
  const float* W;
  const float* scl = nullptr;
  switch (widx) {
    case 0: W = p.in[I_WIN0]; K = 1024; N = NIN0; dst = O_WT_IN0; break;
    case 1: W = p.in[I_WUQ]; K = 256; N = 1536; dst = O_WT_UQ; scl = p.in[I_QNORM]; break;
    case 2: W = p.in[I_WUKV]; K = 128; N = 2048; dst = O_WT_UKV; scl = p.in[I_KVNORM]; break;
    case 3: W = p.in[I_WOUT0]; K = 1024; N = 1024; dst = O_WT_OUT0; break;
    case 4: W = p.in[I_WIN1]; K = 1024; N = NIN1; dst = O_WT_IN1; break;
    case 5: W = p.in[I_WGLU]; K = 1024; N = 1024; dst = O_WT_GLU; break;
    default: W = p.in[I_WOUT1]; K = 1024; N = 1024; dst = O_WT_OUT1; break;
  }
  float (*t)[33] = (float (*)[33])smem;
  int ntn = N / 32;
  int kt = tile / ntn, nt = tile - kt * ntn;
  int tx = tidx_ & 31, ty = tidx_ >> 5;
#pragma unroll
  for (int i = 0; i < 4; ++i) {
    int k = kt * 32 + ty + 8 * i, n = nt * 32 + tx;
    float v = W[(size_t)k * N + n];
    if (scl) v *= scl[k];
    t[ty + 8 * i][tx] = v;
  }
  __syncthreads();
  bfr* Wt = (bfr*)(p.ws + dst);
#pragma unroll
  for (int i = 0; i < 4; ++i) {
    int n = nt * 32 + ty + 8 * i, k = kt * 32 + tx;
    Wt[(size_t)n * K + k] = f2bf(t[tx][ty + 8 * i]);
  }
  __syncthreads();
}

DI void prep_mod(const Params& p, int unit, char* smem) {
  const int tidx_ = opaque_tid();
  int layer = unit / 48, cgp = unit - layer * 48;
  float* sil = (float*)smem;
  float* red = sil + 9 * 1024;
  for (int i = tidx_; i < 9 * 1024; i += 256) {
    int r = i >> 10, k = i & 1023;
    float v = r < 8 ? p.in[I_C][r * 1024 + k] : p.in[I_CCTX][k];
    sil[i] = silu_f(v);
  }
  __syncthreads();
  int nn = tidx_ & 63, kg = tidx_ >> 6;
  int n = cgp * 64 + nn;
  const float* W = p.in[I_ADAW] + (size_t)layer * 1024 * 3072;
  float acc[9];
#pragma unroll
  for (int r = 0; r < 9; ++r) acc[r] = 0.f;
  for (int k = kg * 256; k < kg * 256 + 256; ++k) {
    float w = W[(size_t)k * 3072 + n];
#pragma unroll
    for (int r = 0; r < 9; ++r) acc[r] += sil[r * 1024 + k] * w;
  }
#pragma unroll
  for (int r = 0; r < 9; ++r) red[(kg * 9 + r) * 64 + nn] = acc[r];
  __syncthreads();
  if (kg == 0) {
    float bias = p.in[I_ADAB][layer * 3072 + n];
    float* mod = (float*)(p.ws + O_MOD);
#pragma unroll
    for (int r = 0; r < 9; ++r) {
      float s = red[(0 * 9 + r) * 64 + nn] + red[(1 * 9 + r) * 64 + nn] + red[(2 * 9 + r) * 64 + nn] + red[(3 * 9 + r) * 64 + nn];
      mod[((size_t)(layer * 9 + r)) * 3072 + n] = s + bias;
    }
  }
  __syncthreads();
}

DI void prep_rs0(const Params& p, int unit) {
  const int tidx_ = opaque_tid();
  int tok = unit * 4 + (tidx_ >> 6);
  int lane = tidx_ & 63;
  const float4* r = (const float4*)xrow0(p, tok);
  float s = 0.f;
#pragma unroll
  for (int i = 0; i < 4; ++i) {
    float4 v = r[lane + 64 * i];
    s += v.x * v.x + v.y * v.y + v.z * v.z + v.w * v.w;
  }
  s = wave_sum(s);
  if (lane == 0) ((float*)(p.ws + O_RS0))[tok] = rsqrtf(s * (1.f / 1024.f) + EPS);
}

DI void prep_ktab(const Params& p, int unit, char* smem) {
  const int tidx_ = opaque_tid();
  int g = unit / 63, lagidx = unit - g * 63;
  int lag = lagidx - 31;
  float2* E = (float2*)smem;
  int tid = tidx_;
  if (tid < 128) {
    int dir = tid >> 6, pp = tid & 63;
    bool used = (dir == 0) ? (lag >= 0) : (lag <= 0);
    float2 e = make_float2(0.f, 0.f);
    if (used) {
      double dt, ar, ai;
      float fr, fi, wr, wi;
      s5_disc(p, dir, g, pp, dt, ar, ai, fr, fi);
      s5_pow(dt, ar, ai, lag < 0 ? -lag : lag, wr, wi);
      e.x = wr * fr - wi * fi;
      e.y = wr * fi + wi * fr;
    }
    E[tid] = e;
  }
  __syncthreads();
  int c = tid >> 4, c2 = tid & 15;
  float acc = 0.f;
  for (int dir = 0; dir < 2; ++dir) {
    bool used = (dir == 0) ? (lag >= 0) : (lag <= 0);
    if (!used) continue;
    const float* bre = p.in[I_BRE] + ((size_t)(dir * 64 + g)) * 64 * 16;
    const float* bim = p.in[I_BIM] + ((size_t)(dir * 64 + g)) * 64 * 16;
    const float* cre = p.in[I_CRE] + ((size_t)(dir * 64 + g)) * 16 * 64;
    const float* cim = p.in[I_CIM] + ((size_t)(dir * 64 + g)) * 16 * 64;
    for (int pp = 0; pp < 64; ++pp) {
      float2 e = E[dir * 64 + pp];
      float br = bre[pp * 16 + c2], bi = bim[pp * 16 + c2];
      float gr = e.x * br - e.y * bi, gi = e.x * bi + e.y * br;
      float cr = cre[c * 64 + pp], ci = cim[c * 64 + pp];
      acc += cr * gr - ci * gi;
    }
  }
  ((bfr*)(p.ws + O_KTAB))[((size_t)unit * 16 + c) * 16 + c2] = f2bf(acc);
  __syncthreads();
}

DI void prep_ops(const Params& p, int unit) {
  const int tidx_ = opaque_tid();
  int idx = unit * 256 + tidx_;
  int pp = idx & 63, t = (idx >> 6) & 31, dir = (idx >> 11) & 1, g = idx >> 12;
  double dt, ar, ai;
  float fr, fi, wr, wi;
  s5_disc(p, dir, g, pp, dt, ar, ai, fr, fi);
  s5_pow(dt, ar, ai, dir == 0 ? (TC - 1 - t) : t, wr, wi);
  float er = wr * fr - wi * fi, ei = wr * fi + wi * fr;
  const float* bre = p.in[I_BRE] + (((size_t)(dir * 64 + g)) * 64 + pp) * 16;
  const float* bim = p.in[I_BIM] + (((size_t)(dir * 64 + g)) * 64 + pp) * 16;
  bfr* wst = (bfr*)(p.ws + O_WST) + (size_t)g * 256 * 512;
  bfr* rre = wst + (size_t)(dir * 128 + pp) * 512 + t * 16;
  bfr* rim = wst + (size_t)(dir * 128 + 64 + pp) * 512 + t * 16;
#pragma unroll
  for (int c2 = 0; c2 < 16; ++c2) {
    float br = bre[c2], bi = bim[c2];
    rre[c2] = f2bf(er * br - ei * bi);
    rim[c2] = f2bf(er * bi + ei * br);
  }
  s5_pow(dt, ar, ai, dir == 0 ? (t + 1) : (TC - t), wr, wi);
  const float* cre = p.in[I_CRE] + ((size_t)(dir * 64 + g)) * 16 * 64;
  const float* cim = p.in[I_CIM] + ((size_t)(dir * 64 + g)) * 16 * 64;
  bfr* vop = (bfr*)(p.ws + O_VOP) + (size_t)g * 512 * 256;
#pragma unroll
  for (int c = 0; c < 16; ++c) {
    float cr = cre[c * 64 + pp], ci = cim[c * 64 + pp];
    float dr = cr * wr - ci * wi, di = cr * wi + ci * wr;
    vop[(size_t)(t * 16 + c) * 256 + dir * 128 + pp] = f2bf(dr);
    vop[(size_t)(t * 16 + c) * 256 + dir * 128 + 64 + pp] = f2bf(-di);
  }
}

constexpr int TR_T0 = 32 * 45, TR_T1 = 8 * 48, TR_T2 = 4 * 64, TR_T3 = 1024, TR_T4 = 32 * 64, TR_T5 = 1024, TR_T6 = 1024;
constexpr int TR_TOTAL = TR_T0 + TR_T1 + TR_T2 + TR_T3 + TR_T4 + TR_T5 + TR_T6;
constexpr int U_MOD = 96, U_RS0 = TOK / 4, U_KTAB = 64 * 63, U_OPS = 64 * 2 * 64 * 32 / 256;
constexpr int PREP_UNITS = TR_TOTAL + U_MOD + U_RS0 + U_KTAB + U_OPS;

DI void phase_prep(const Params& p, char* smem) {
  for (int u = blockIdx.x; u < PREP_UNITS; u += gridDim.x) {
    int v = u;
    if (v < U_MOD) { prep_mod(p, v, smem); continue; }
    v -= U_MOD;
    if (v < TR_TOTAL) {
      int w = 0;
      if (v >= TR_T0) { v -= TR_T0; w = 1;
        if (v >= TR_T1) { v -= TR_T1; w = 2;
          if (v >= TR_T2) { v -= TR_T2; w = 3;
            if (v >= TR_T3) { v -= TR_T3; w = 4;
              if (v >= TR_T4) { v -= TR_T4; w = 5;
                if (v >= TR_T5) { v -= TR_T5; w = 6; } } } } } }
      prep_transpose(p, w, v, smem);
      continue;
    }
    v -= TR_TOTAL;
    if (v < U_RS0) { prep_rs0(p, v); continue; }
    v -= U_RS0;
    if (v < U_KTAB) { prep_ktab(p, v, smem); continue; }
    v -= U_KTAB;
    prep_ops(p, v);
  }
}

DI void phase_n1(const Params& p) {
  const float* W = p.in[I_WIN0];
  const float* rs0 = (const float*)(p.ws + O_RS0);
  const float* ng = p.in[I_NORMG];
  const size_t total = (size_t)TOK * NIN0;
  for (size_t idx = (size_t)blockIdx.x * 256 + threadIdx.x; idx < total; idx += (size_t)gridDim.x * 256) {
    int tok = (int)(idx / NIN0), n = (int)(idx - (size_t)tok * NIN0);
    int b = tok / LALL, pos = tok - b * LALL;
    bool lat = pos >= LC;
    const float* xr = xrow0(p, tok);
    const float* md = modrow(p, 0, tok);
    float rs = rs0[tok];
    bool rope = lat && n >= 384 && n < 416;
    int n2 = rope ? (n ^ 8) : n;
    float acc = 0.f, acc2 = 0.f;
    for (int k = 0; k < 1024; ++k) {
      float h = xr[k] * rs * ng[k] * (1.f + md[1024 + k]) + md[k];
      acc += h * W[(size_t)k * NIN0 + n];
      acc2 += h * W[(size_t)k * NIN0 + n2];
    }
    if (n < 384) {
      ((bfr*)(p.ws + O_PC))[(size_t)tok * 384 + n] = f2bf(acc);
    } else if (n < 416) {
      int j = n - 384;
      float v = rope ? rope_apply(j, acc, acc2, pos - LC) : acc;
      bfr bv = f2bf(v);
      bfr* K = (bfr*)(p.ws + O_K);
      for (int h = 0; h < NH; ++h) K[(((size_t)(b * NH + h)) * LALL + pos) * DQK + 64 + j] = bv;
    } else {
      ((bfr*)(p.ws + O_SZ0))[(size_t)tok * 1024 + (n - 416)] = f2bf(silu_f(acc));
    }
  }
}

DI void phase_n2(const Params& p) {
  const int NTOT = 1536 + 2048;
  const bfr* PC = (const bfr*)(p.ws + O_PC);
  const size_t total = (size_t)TOK * NTOT;
  bfr* Q = (bfr*)p.out;
  bfr* K = (bfr*)(p.ws + O_K);
  bfr* VT = (bfr*)(p.ws + O_VT);
  for (size_t idx = (size_t)blockIdx.x * 256 + threadIdx.x; idx < total; idx += (size_t)gridDim.x * 256) {
    int tok = (int)(idx / NTOT), n = (int)(idx - (size_t)tok * NTOT);
    int b = tok / LALL, pos = tok - b * LALL;
    bool lat = pos >= LC;
    if (n < 1536) {
      int h = n / 96, d = n - h * 96;
      bool rope = lat && d >= 64;
      int n2 = rope ? (n ^ 8) : n;
      const float* W = p.in[I_WUQ];
      const float* qn = p.in[I_QNORM];
      float acc = 0.f, acc2 = 0.f, ss = 0.f;
      for (int k = 0; k < 256; ++k) {
        float a = bf2f(PC[(size_t)tok * 384 + k]);
        ss += a * a;
        float aw = a * qn[k];
        acc += aw * W[(size_t)k * 1536 + n];
        acc2 += aw * W[(size_t)k * 1536 + n2];
      }
      float r = rsqrtf(ss * (1.f / 256.f) + EPS);
      acc *= r; acc2 *= r;
      float v = rope ? rope_apply(d - 64, acc, acc2, pos - LC) : acc;
      Q[(((size_t)(b * NH + h)) * LALL + pos) * DQK + d] = f2bf(v * QSCALE);
    } else {
      int n3 = n - 1536;
      int h = n3 / 128, d = n3 - h * 128;
      const float* W = p.in[I_WUKV];
      const float* kn = p.in[I_KVNORM];
      float acc = 0.f, ss = 0.f;
      for (int k = 0; k < 128; ++k) {
        float a = bf2f(PC[(size_t)tok * 384 + 256 + k]);
        ss += a * a;
        acc += a * kn[k] * W[(size_t)k * 2048 + n3];
      }
      acc *= rsqrtf(ss * (1.f / 128.f) + EPS);
      if (d < 64) K[(((size_t)(b * NH + h)) * LALL + pos) * DQK + d] = f2bf(acc);
      else VT[(((size_t)(b * NH + h)) * DV + (d - 64)) * LALL + pos] = f2bf(acc);
    }
  }
}

DI void phase_n3(const Params& p) {
  const bfr* Q = (const bfr*)p.out;
  const bfr* K = (const bfr*)(p.ws + O_K);
  const bfr* VT = (const bfr*)(p.ws + O_VT);
  const bfr* SZ = (const bfr*)(p.ws + O_SZ0);
  bfr* OG = (bfr*)(p.ws + O_OG);
  int lane = threadIdx.x & 63;
  const int total = NB * NH * LALL;
  for (int w = blockIdx.x * 4 + (threadIdx.x >> 6); w < total; w += gridDim.x * 4) {
    int bh = w / LALL, pos = w - bh * LALL;
    int b = bh / NH, h = bh - b * NH;
    int nk = pos < LC ? LC : LALL;
    const bfr* q = Q + ((size_t)bh * LALL + pos) * DQK;
    const bfr* kb = K + (size_t)bh * LALL * DQK;
    const bfr* vb = VT + (size_t)bh * DV * LALL;
    float s[36];
    float mx = -1e30f;
#pragma unroll
    for (int i = 0; i < 36; ++i) {
      int key = i * 64 + lane;
      float a = -1e30f;
      if (key < nk) {
        a = 0.f;
        const bfr* kr = kb + (size_t)key * DQK;
        for (int d = 0; d < DQK; ++d) a += bf2f(q[d]) * bf2f(kr[d]);
      }
      s[i] = a;
      mx = fmaxf(mx, a);
    }
    mx = wave_max(mx);
    float l = 0.f;
    float o[64];
#pragma unroll
    for (int d = 0; d < 64; ++d) o[d] = 0.f;
#pragma unroll
    for (int i = 0; i < 36; ++i) {
      int key = i * 64 + lane;
      if (key < nk) {
        float pr = exp2f(s[i] - mx);
        l += pr;
#pragma unroll
        for (int d = 0; d < 64; ++d) o[d] += pr * bf2f(vb[(size_t)d * LALL + key]);
      }
    }
    l = wave_sum(l);
    float mine = 0.f;
#pragma unroll
    for (int d = 0; d < 64; ++d) {
      float t = wave_sum(o[d]);
      if (lane == d) mine = t;
    }
    int tok = b * LALL + pos;
    float z = bf2f(SZ[(size_t)tok * 1024 + h * 64 + lane]);
    OG[(size_t)tok * 1024 + h * 64 + lane] = f2bf(mine / l * z);
  }
}

DI void phase_n4(const Params& p) {
  const float* W = p.in[I_WOUT0];
  const bfr* OG = (const bfr*)(p.ws + O_OG);
  const size_t total = (size_t)TOK * 1024;
  for (size_t idx = (size_t)blockIdx.x * 256 + threadIdx.x; idx < total; idx += (size_t)gridDim.x * 256) {
    int tok = (int)(idx >> 10), n = (int)(idx & 1023);
    float acc = 0.f;
    for (int k = 0; k < 1024; ++k) acc += bf2f(OG[(size_t)tok * 1024 + k]) * W[(size_t)k * 1024 + n];
    float v = xrow0(p, tok)[n] + modrow(p, 0, tok)[2048 + n] * acc;
    xrow1(p, tok)[n] = v;
  }
}

DI void phase_rowsq(const Params& p, int layer) {
  int lane = threadIdx.x & 63;
  int nrows = layer == 1 ? TOK : NLAT;
  float* part = (float*)(p.ws + (layer == 1 ? O_PART1 : O_PART2));
  for (int r = blockIdx.x * 4 + (threadIdx.x >> 6); r < nrows; r += gridDim.x * 4) {
    const float4* row = (const float4*)(layer == 1 ? xrow1(p, r) : p.out + (size_t)r * D);
    float s = 0.f;
#pragma unroll
    for (int i = 0; i < 4; ++i) {
      float4 v = row[lane + 64 * i];
      s += v.x * v.x + v.y * v.y + v.z * v.z + v.w * v.w;
    }
    s = wave_sum(s);
    if (lane < 16) part[(size_t)lane * nrows + r] = lane == 0 ? s : 0.f;
  }
}
DI float rs_from_part(const float* part, int nrows, int r) {
  float s = 0.f;
#pragma unroll
  for (int j = 0; j < 16; ++j) s += part[(size_t)j * nrows + r];
  return rsqrtf(s * (1.f / 1024.f) + EPS);
}

DI void phase_n5(const Params& p) {
  const float* W = p.in[I_WIN1];
  const float* ng = p.in[I_NORMG] + 1024;
  const float* part = (const float*)(p.ws + O_PART1);
  bfr* U2 = (bfr*)(p.ws + O_U2);
  bfr* SZ1 = (bfr*)(p.ws + O_SZ1);
  const size_t total = (size_t)TOK * NIN1;
  for (size_t idx = (size_t)blockIdx.x * 256 + threadIdx.x; idx < total; idx += (size_t)gridDim.x * 256) {
    int tok = (int)(idx >> 11), n = (int)(idx & 2047);
    int b = tok / LALL, pos = tok - b * LALL;
    bool lat = pos >= LC;
    if (!lat && n >= 1024) continue;
    const float* xr = xrow1(p, tok);
    const float* md = modrow(p, 1, tok);
    float rs = rs_from_part(part, TOK, tok);
    float acc = 0.f;
    for (int k = 0; k < 1024; ++k) {
      float h = xr[k] * rs * ng[k] * (1.f + md[1024 + k]) + md[k];
      acc += h * W[(size_t)k * NIN1 + n];
    }
    if (n < 1024) U2[((size_t)(n >> 4) * TOK + tok) * 16 + (n & 15)] = f2bf(acc);
    else SZ1[((size_t)(b * SEQ + pos - LC)) * 1024 + (n - 1024)] = f2bf(silu_f(acc));
  }
}

DI void phase_n6(const Params& p, int dir) {
  int lane = threadIdx.x & 63;
  const bfr* U2 = (const bfr*)(p.ws + O_U2);
  bfr* YF = (bfr*)(p.ws + O_Y2);
  bfr* YG = (bfr*)(p.ws + O_YG);
  for (int w = blockIdx.x * 4 + (threadIdx.x >> 6); w < NB * 64; w += gridDim.x * 4) {
    int b = w >> 6, g = w & 63;
    double dt, ar, ai;
    float fr, fi, lr, li;
    s5_disc(p, dir, g, lane, dt, ar, ai, fr, fi);
    s5_pow(dt, ar, ai, 1, lr, li);
    float bbr[16], bbi[16], ccr[16], cci[16];
    const float* bre = p.in[I_BRE] + (((size_t)(dir * 64 + g)) * 64 + lane) * 16;
    const float* bim = p.in[I_BIM] + (((size_t)(dir * 64 + g)) * 64 + lane) * 16;
    const float* cre = p.in[I_CRE] + ((size_t)(dir * 64 + g)) * 16 * 64;
    const float* cim = p.in[I_CIM] + ((size_t)(dir * 64 + g)) * 16 * 64;
#pragma unroll
    for (int c = 0; c < 16; ++c) {
      float br = bre[c], bi = bim[c];
      bbr[c] = fr * br - fi * bi;
      bbi[c] = fr * bi + fi * br;
      ccr[c] = cre[c * 64 + lane];
      cci[c] = cim[c * 64 + lane];
    }
    float sr = 0.f, si = 0.f;
    const bfr* ub = U2 + ((size_t)g * TOK + (size_t)b * LALL) * 16;
    for (int step = 0; step < LALL; ++step) {
      int pos = dir == 0 ? step : (step < LC ? (LC - 1 - step) : (LALL - 1 - (step - LC)));
      const bfr* ur = ub + (size_t)pos * 16;
      float ur_f[16];
      float br = 0.f, bi = 0.f;
#pragma unroll
      for (int c = 0; c < 16; ++c) {
        float uv = bf2f(ur[c]);
        ur_f[c] = uv;
        br += bbr[c] * uv;
        bi += bbi[c] * uv;
      }
      float nr = lr * sr - li * si + br;
      float ni = lr * si + li * sr + bi;
      sr = nr; si = ni;
      if (pos >= LC) {
        float mine = 0.f, myu = 0.f;
#pragma unroll
        for (int c = 0; c < 16; ++c) {
          float t = wave_sum(ccr[c] * sr - cci[c] * si);
          if (lane == c) { mine = t; myu = ur_f[c]; }
        }
        if (lane < 16) {
          size_t o = ((size_t)(b * SEQ + pos - LC)) * 1024 + g * 16 + lane;
          if (dir == 0) YF[o] = f2bf(mine);
          else {
            float y = bf2f(YF[o]) + mine + p.in[I_S5D][g * 16 + lane] * myu;
            YG[o] = f2bf(gelu_tanh(y));
          }
        }
      }
    }
  }
}

DI void phase_n9(const Params& p) {
  const float* W = p.in[I_WGLU];
  const bfr* YG = (const bfr*)(p.ws + O_YG);
  const bfr* SZ1 = (const bfr*)(p.ws + O_SZ1);
  bfr* Y2 = (bfr*)(p.ws + O_Y2);
  const size_t total = (size_t)NLAT * 1024;
  for (size_t idx = (size_t)blockIdx.x * 256 + threadIdx.x; idx < total; idx += (size_t)gridDim.x * 256) {
    int lt = (int)(idx >> 10), n = (int)(idx & 1023);
    float acc = p.in[I_BGLU][n];
    for (int k = 0; k < 1024; ++k) acc += bf2f(YG[(size_t)lt * 1024 + k]) * W[(size_t)k * 1024 + n];
    float y = bf2f(YG[idx]);
    Y2[idx] = f2bf(y * sigmoid_f(acc) * bf2f(SZ1[idx]));
  }
}

DI void phase_n10(const Params& p) {
  const float* W = p.in[I_WOUT1];
  const bfr* Y2 = (const bfr*)(p.ws + O_Y2);
  const float* mod = (const float*)(p.ws + O_MOD);
  const size_t total = (size_t)NLAT * 1024;
  for (size_t idx = (size_t)blockIdx.x * 256 + threadIdx.x; idx < total; idx += (size_t)gridDim.x * 256) {
    int lt = (int)(idx >> 10), n = (int)(idx & 1023);
    int b = lt >> 11;
    float acc = 0.f;
    for (int k = 0; k < 1024; ++k) acc += bf2f(Y2[(size_t)lt * 1024 + k]) * W[(size_t)k * 1024 + n];
    p.out[idx] = p.out[idx] + mod[((size_t)(9 + b)) * 3072 + 2048 + n] * acc;
  }
}

DI void phase_final(const Params& p) {
  const int tidx_ = opaque_tid();
  const float* part = (const float*)(p.ws + O_PART2);
  const float* fg = p.in[I_FINALG];
  int lane = tidx_ & 63;
  for (int r = blockIdx.x * 4 + (tidx_ >> 6); r < NLAT; r += gridDim.x * 4) {
    float rs = rs_from_part(part, NLAT, r);
    float4* row = (float4*)(p.out + (size_t)r * D);
    const float4* g4 = (const float4*)fg;
#pragma unroll
    for (int i = 0; i < 4; ++i) {
      float4 v = row[lane + 64 * i];
      float4 g = g4[lane + 64 * i];
      v.x *= rs * g.x; v.y *= rs * g.y; v.z *= rs * g.z; v.w *= rs * g.w;
      row[lane + 64 * i] = v;
    }
  }
}

typedef short bf16x8 __attribute__((ext_vector_type(8)));
typedef short s16x4 __attribute__((ext_vector_type(4)));
typedef float f32x16 __attribute__((ext_vector_type(16)));
typedef __bf16 bf2_t __attribute__((ext_vector_type(2)));
typedef float f2_t __attribute__((ext_vector_type(2)));
DI unsigned pk2(float a, float b) {
  f2_t v = {a, b};
  bf2_t r = __builtin_convertvector(v, bf2_t);
  return __builtin_bit_cast(unsigned, r);
}
#define SCHED_FENCE() __builtin_amdgcn_sched_barrier(0)
#define MFMA32(a, b, c) __builtin_amdgcn_mfma_f32_32x32x16_bf16((a), (b), (c), 0, 0, 0)
DI int crow(int i, int h) { return (i & 3) + 8 * (i >> 2) + 4 * h; }

constexpr int LDT = 72;
struct GemmSmem {
  bfr A[128 * LDT];
  bfr B[128 * LDT];
  float gs[1024];
  float sh[1024];
  float rs[128];
};
static_assert(sizeof(GemmSmem) <= SMEM_BYTES, "smem");

DI void zero_acc(f32x16 (&acc)[2][2]) {
#pragma unroll
  for (int a = 0; a < 2; ++a)
#pragma unroll
    for (int b = 0; b < 2; ++b)
#pragma unroll
      for (int i = 0; i < 16; ++i) acc[a][b][i] = 0.f;
}

template <bool AF32, class AAddr, class BAddr>
DI void gemm_main(f32x16 (&acc)[2][2], int KT, AAddr aaddr, BAddr baddr, GemmSmem* sm) {
  const int tid = opaque_tid(), lane = tid & 63, wave = tid >> 6;
  const int wm = wave >> 1, wn = wave & 1, r = lane & 31, h = lane >> 5;
  uint4 bv0, bv1, bv2, bv3, av0, av1, av2, av3;
  float4 af0, af1, af2, af3, af4, af5, af6, af7;
  const int lrow = tid >> 3, lkc = (tid & 7) * 8;
  const int frow = tid >> 4, fkc = (tid & 15) * 4;
#define GM_LOAD(KT_)                                                                     \
  {                                                                                      \
    const int kk_ = (KT_) * 64;                                                          \
    bv0 = *(const uint4*)baddr(lrow, kk_ + lkc);                                         \
    bv1 = *(const uint4*)baddr(lrow + 32, kk_ + lkc);                                    \
    bv2 = *(const uint4*)baddr(lrow + 64, kk_ + lkc);                                    \
    bv3 = *(const uint4*)baddr(lrow + 96, kk_ + lkc);                                    \
    if constexpr (AF32) {                                                                \
      af0 = *(const float4*)(aaddr(frow) + kk_ + fkc);                                   \
      af1 = *(const float4*)(aaddr(frow + 16) + kk_ + fkc);                              \
      af2 = *(const float4*)(aaddr(frow + 32) + kk_ + fkc);                              \
      af3 = *(const float4*)(aaddr(frow + 48) + kk_ + fkc);                              \
      af4 = *(const float4*)(aaddr(frow + 64) + kk_ + fkc);                              \
      af5 = *(const float4*)(aaddr(frow + 80) + kk_ + fkc);                              \
      af6 = *(const float4*)(aaddr(frow + 96) + kk_ + fkc);                              \
      af7 = *(const float4*)(aaddr(frow + 112) + kk_ + fkc);                             \
    } else {                                                                             \
      av0 = *(const uint4*)aaddr(lrow, kk_ + lkc);                                       \
      av1 = *(const uint4*)aaddr(lrow + 32, kk_ + lkc);                                  \
      av2 = *(const uint4*)aaddr(lrow + 64, kk_ + lkc);                                  \
      av3 = *(const uint4*)aaddr(lrow + 96, kk_ + lkc);                                  \
    }                                                                                    \
  }
#define GM_STF(AF_, ROW_)                                                                \
  {                                                                                      \
    float rr_ = sm->rs[ROW_];                                                            \
    uint2 o_;                                                                            \
    o_.x = pk2(AF_.x * rr_ * g_.x + s_.x, AF_.y * rr_ * g_.y + s_.y);                    \
    o_.y = pk2(AF_.z * rr_ * g_.z + s_.z, AF_.w * rr_ * g_.w + s_.w);                    \
    *(uint2*)(sm->A + (ROW_) * LDT + fkc) = o_;                                          \
  }
#define GM_STORE(KT_)                                                                    \
  {                                                                                      \
    *(uint4*)(sm->B + lrow * LDT + lkc) = bv0;                                           \
    *(uint4*)(sm->B + (lrow + 32) * LDT + lkc) = bv1;                                    \
    *(uint4*)(sm->B + (lrow + 64) * LDT + lkc) = bv2;                                    \
    *(uint4*)(sm->B + (lrow + 96) * LDT + lkc) = bv3;                                    \
    if constexpr (AF32) {                                                                \
      const int k_ = (KT_) * 64 + fkc;                                                   \
      const float4 g_ = *(const float4*)(sm->gs + k_);                                   \
      const float4 s_ = *(const float4*)(sm->sh + k_);                                   \
      GM_STF(af0, frow) GM_STF(af1, frow + 16) GM_STF(af2, frow + 32) GM_STF(af3, frow + 48) \
      GM_STF(af4, frow + 64) GM_STF(af5, frow + 80) GM_STF(af6, frow + 96) GM_STF(af7, frow + 112) \
    } else {                                                                             \
      *(uint4*)(sm->A + lrow * LDT + lkc) = av0;                                         \
      *(uint4*)(sm->A + (lrow + 32) * LDT + lkc) = av1;                                  \
      *(uint4*)(sm->A + (lrow + 64) * LDT + lkc) = av2;                                  \
      *(uint4*)(sm->A + (lrow + 96) * LDT + lkc) = av3;                                  \
    }                                                                                    \
  }
  GM_LOAD(0)
  for (int kt = 0; kt < KT; ++kt) {
    GM_STORE(kt)
    __syncthreads();
    if (kt + 1 < KT) GM_LOAD(kt + 1)
#pragma unroll
    for (int ks = 0; ks < 4; ++ks) {
      bf16x8 a[2], b[2];
#pragma unroll
      for (int mi = 0; mi < 2; ++mi) a[mi] = *(const bf16x8*)(sm->A + (wm * 64 + mi * 32 + r) * LDT + ks * 16 + h * 8);
#pragma unroll
      for (int ni = 0; ni < 2; ++ni) b[ni] = *(const bf16x8*)(sm->B + (wn * 64 + ni * 32 + r) * LDT + ks * 16 + h * 8);
#pragma unroll
      for (int mi = 0; mi < 2; ++mi)
#pragma unroll
        for (int ni = 0; ni < 2; ++ni) acc[mi][ni] = MFMA32(a[mi], b[ni], acc[mi][ni]);
    }
    __syncthreads();
  }
}

DI float transpose_reduce16(float (&v)[16], int lane) {
  float r8[8], r4[4], r2[2];
  {
    bool up = lane & 8;
#pragma unroll
    for (int i = 0; i < 8; ++i) {
      float send = up ? v[i] : v[i + 8];
      float keep = up ? v[i + 8] : v[i];
      r8[i] = keep + __shfl_xor(send, 8);
    }
  }
  {
    bool up = lane & 4;
#pragma unroll
    for (int i = 0; i < 4; ++i) {
      float send = up ? r8[i] : r8[i + 4];
      float keep = up ? r8[i + 4] : r8[i];
      r4[i] = keep + __shfl_xor(send, 4);
    }
  }
  {
    bool up = lane & 2;
#pragma unroll
    for (int i = 0; i < 2; ++i) {
      float send = up ? r4[i] : r4[i + 2];
      float keep = up ? r4[i + 2] : r4[i];
      r2[i] = keep + __shfl_xor(send, 2);
    }
  }
  bool up = lane & 1;
  float send = up ? r2[0] : r2[1];
  float keep = up ? r2[1] : r2[0];
  return keep + __shfl_xor(send, 1);
}

#define WAVE_IDS                                              \
  const int tid = opaque_tid(), lane = tid & 63, wave = tid >> 6; \
  const int wm = wave >> 1, wn = wave & 1, r = lane & 31, h = lane >> 5; \
  (void)wm; (void)wn; (void)r; (void)h;

DI void phase_o1(const Params& p, char* smem) {
  GemmSmem* sm = (GemmSmem*)smem;
  WAVE_IDS
  const int NT = 12, units = (TOK / 128) * NT;
  const bfr* WT = (const bfr*)(p.ws + O_WT_IN0);
  const float* RS0 = (const float*)(p.ws + O_RS0);
  bfr* PC = (bfr*)(p.ws + O_PC);
  bfr* SZ0 = (bfr*)(p.ws + O_SZ0);
  bfr* Kb = (bfr*)(p.ws + O_K);
  for (int u = blockIdx.x; u < units; u += gridDim.x) {
    int mt = u / NT, nt = u - mt * NT;
    int m0 = mt * 128, n0 = nt * 128;
    __syncthreads();
    const float* md = modrow(p, 0, m0);
    const float* ng = p.in[I_NORMG];
    for (int k = tid; k < 1024; k += 256) {
      sm->gs[k] = ng[k] * (1.f + md[1024 + k]);
      sm->sh[k] = md[k];
    }
    if (tid < 128) sm->rs[tid] = RS0[m0 + tid];
    __syncthreads();
    const float* abase = xrow0(p, m0);
    f32x16 acc[2][2];
    zero_acc(acc);
    gemm_main<true>(
        acc, 16, [&](int row) { return abase + (size_t)row * 1024; },
        [&](int row, int k) {
          int n = n0 + row;
          n = n < NIN0 ? n : NIN0 - 1;
          return WT + (size_t)n * 1024 + k;
        },
        sm);
    int b = m0 / LALL, pos0 = m0 - b * LALL;
    bool lat = pos0 >= LC;
#pragma unroll
    for (int mi = 0; mi < 2; ++mi)
#pragma unroll
      for (int ni = 0; ni < 2; ++ni) {
        int col0 = n0 + wn * 64 + ni * 32;
        if (col0 >= NIN0) continue;
        int col = col0 + r;
#pragma unroll
        for (int i = 0; i < 16; ++i) {
          int row = wm * 64 + mi * 32 + crow(i, h);
          int tok = m0 + row;
          float v = acc[mi][ni][i];
          if (col0 < 384) {
            PC[(size_t)tok * 384 + col] = f2bf(v);
          } else if (col0 == 384) {
            float vp = __shfl_xor(v, 8);
            int pos = pos0 + row;
            float val = lat ? rope_apply(r, v, vp, pos - LC) : v;
            bfr bv = f2bf(val);
            for (int hh = 0; hh < NH; ++hh) Kb[(((size_t)(b * NH + hh)) * LALL + pos) * DQK + 64 + r] = bv;
          } else {
            SZ0[(size_t)tok * 1024 + (col - 416)] = f2bf(silu_f(v));
          }
          SCHED_FENCE();
        }
      }
  }
}

DI void phase_o2(const Params& p, char* smem) {
  GemmSmem* sm = (GemmSmem*)smem;
  WAVE_IDS
  const int UQ = (TOK / 128) * 12, UKV = (TOK / 128) * 16;
  const bfr* PC = (const bfr*)(p.ws + O_PC);
  bfr* Q = (bfr*)p.out;
  bfr* Kb = (bfr*)(p.ws + O_K);
  bfr* VT = (bfr*)(p.ws + O_VT);
  for (int u = blockIdx.x; u < UQ + UKV; u += gridDim.x) {
    bool isq = u < UQ;
    int uu = isq ? u : u - UQ;
    int NT = isq ? 12 : 16;
    int mt = uu / NT, nt = uu - mt * NT;
    int m0 = mt * 128, n0 = nt * 128;
    int Kd = isq ? 256 : 128;
    int aoff = isq ? 0 : 256;
    const bfr* WT = (const bfr*)(p.ws + (isq ? O_WT_UQ : O_WT_UKV));
    __syncthreads();
    {
      int row = tid >> 1, half = tid & 1;
      const bfr* ap = PC + (size_t)(m0 + row) * 384 + aoff + half * (Kd / 2);
      float ss = 0.f;
      for (int j = 0; j < Kd / 16; ++j) {
        uint4 v = *(const uint4*)(ap + j * 8);
        unsigned w[4] = {v.x, v.y, v.z, v.w};
#pragma unroll
        for (int e = 0; e < 4; ++e) {
          float lo = __uint_as_float(w[e] << 16), hi = __uint_as_float(w[e] & 0xffff0000u);
          ss += lo * lo + hi * hi;
        }
      }
      ss += __shfl_xor(ss, 1);
      if (half == 0) sm->rs[row] = rsqrtf(ss / (float)Kd + EPS);
    }
    __syncthreads();
    f32x16 acc[2][2];
    zero_acc(acc);
    gemm_main<false>(
        acc, Kd / 64, [&](int row, int k) { return PC + (size_t)(m0 + row) * 384 + aoff + k; },
        [&](int row, int k) { return WT + (size_t)(n0 + row) * Kd + k; }, sm);
    int b = m0 / LALL, pos0 = m0 - b * LALL;
    bool lat = pos0 >= LC;
#pragma unroll
    for (int mi = 0; mi < 2; ++mi)
#pragma unroll
      for (int ni = 0; ni < 2; ++ni) {
        int col0 = n0 + wn * 64 + ni * 32;
        if (isq) {
          int hh = col0 / 96, d0 = col0 - hh * 96;
          bool rope = lat && d0 == 64;
#pragma unroll
          for (int i = 0; i < 16; ++i) {
            int row = wm * 64 + mi * 32 + crow(i, h);
            int pos = pos0 + row;
            float v = acc[mi][ni][i] * sm->rs[row];
            float vp = __shfl_xor(v, 8);
            float val = rope ? rope_apply(r, v, vp, pos - LC) : v;
            Q[(((size_t)(b * NH + hh)) * LALL + pos) * DQK + d0 + r] = f2bf(val * QSCALE);
            SCHED_FENCE();
          }
        } else {
          int hh = col0 >> 7, d0 = col0 & 127;
          if (d0 < 64) {
#pragma unroll
            for (int i = 0; i < 16; ++i) {
              int row = wm * 64 + mi * 32 + crow(i, h);
              int pos = pos0 + row;
              float v = acc[mi][ni][i] * sm->rs[row];
              Kb[(((size_t)(b * NH + hh)) * LALL + pos) * DQK + d0 + r] = f2bf(v);
              SCHED_FENCE();
            }
          } else {
            int dvv = d0 - 64 + r;
#pragma unroll
            for (int g4 = 0; g4 < 4; ++g4) {
              int row = wm * 64 + mi * 32 + 8 * g4 + 4 * h;
              int pos = pos0 + row;
              uint2 o;
              o.x = pk2(acc[mi][ni][4 * g4 + 0] * sm->rs[row + 0], acc[mi][ni][4 * g4 + 1] * sm->rs[row + 1]);
              o.y = pk2(acc[mi][ni][4 * g4 + 2] * sm->rs[row + 2], acc[mi][ni][4 * g4 + 3] * sm->rs[row + 3]);
              *(uint2*)(VT + (((size_t)(b * NH + hh)) * DV + dvv) * LALL + pos) = o;
            }
          }
        }
      }
  }
}

constexpr int KLD = 104;
constexpr int VLD = 68;
struct AttnSmem {
  bfr K[64 * KLD];
  bfr V[64 * VLD];
};
static_assert(sizeof(AttnSmem) <= SMEM_BYTES, "smem");

DI void attn_item(const Params& p, AttnSmem* sm, int bh, int qpos0, int nkeys) {
  WAVE_IDS
  const bfr* Q = (const bfr*)p.out;
  const bfr* Kg = (const bfr*)(p.ws + O_K) + (size_t)bh * LALL * DQK;
  const bfr* Vg = (const bfr*)(p.ws + O_VT) + (size_t)bh * DV * LALL;
  const int qpos = qpos0 + wave * 32 + r;
  bf16x8 bq[6];
  {
    const bfr* qp = Q + ((size_t)bh * LALL + qpos) * DQK + 8 * h;
#pragma unroll
    for (int s = 0; s < 6; ++s) bq[s] = *(const bf16x8*)(qp + 16 * s);
  }
  f32x16 o[2];
#pragma unroll
  for (int d = 0; d < 2; ++d)
#pragma unroll
    for (int i = 0; i < 16; ++i) o[d][i] = 0.f;
  float mrun = -1e30f, lrun = 0.f;
  uint4 kv0, kv1, kv2, vv0, vv1;
  const int kr0 = tid / 12, kc0 = (tid - kr0 * 12) * 8;
  const int kr1 = (tid + 256) / 12, kc1 = (tid + 256 - kr1 * 12) * 8;
  const int kr2 = (tid + 512) / 12, kc2 = (tid + 512 - kr2 * 12) * 8;
  const int vr0 = tid >> 3, vc0 = (tid & 7) * 8;
#define AT_GLOAD(KEY0_)                                                          \
  {                                                                              \
    const int key0_ = (KEY0_);                                                   \
    kv0 = *(const uint4*)(Kg + (size_t)(key0_ + kr0) * DQK + kc0);               \
    kv1 = *(const uint4*)(Kg + (size_t)(key0_ + kr1) * DQK + kc1);               \
    kv2 = *(const uint4*)(Kg + (size_t)(key0_ + kr2) * DQK + kc2);               \
    vv0 = *(const uint4*)(Vg + (size_t)vr0 * LALL + key0_ + vc0);                \
    vv1 = *(const uint4*)(Vg + (size_t)(vr0 + 32) * LALL + key0_ + vc0);         \
  }
#define AT_LSTORE()                                                              \
  {                                                                              \
    *(uint4*)(sm->K + kr0 * KLD + kc0) = kv0;                                    \
    *(uint4*)(sm->K + kr1 * KLD + kc1) = kv1;                                    \
    *(uint4*)(sm->K + kr2 * KLD + kc2) = kv2;                                    \
    uint2* d0_ = (uint2*)(sm->V + vr0 * VLD + vc0);                              \
    d0_[0] = make_uint2(vv0.x, vv0.y);                                           \
    d0_[1] = make_uint2(vv0.z, vv0.w);                                           \
    uint2* d1_ = (uint2*)(sm->V + (vr0 + 32) * VLD + vc0);                       \
    d1_[0] = make_uint2(vv1.x, vv1.y);                                           \
    d1_[1] = make_uint2(vv1.z, vv1.w);                                           \
  }
  const int NTI = nkeys / 64;
  AT_GLOAD(0)
  for (int it = 0; it < NTI; ++it) {
    AT_LSTORE()
    __syncthreads();
    if (it + 1 < NTI) AT_GLOAD((it + 1) * 64)
    f32x16 st[2];
#pragma unroll
    for (int kb = 0; kb < 2; ++kb) {
#pragma unroll
      for (int i = 0; i < 16; ++i) st[kb][i] = 0.f;
#pragma unroll
      for (int s = 0; s < 6; ++s) {
        bf16x8 ka = *(const bf16x8*)(sm->K + (kb * 32 + r) * KLD + 16 * s + 8 * h);
        st[kb] = MFMA32(ka, bq[s], st[kb]);
      }
    }
    float mx = st[0][0];
#pragma unroll
    for (int kb = 0; kb < 2; ++kb)
#pragma unroll
      for (int i = 0; i < 16; ++i) mx = fmaxf(mx, st[kb][i]);
    mx = fmaxf(mx, __shfl_xor(mx, 32));
    float mnew = fmaxf(mrun, mx);
    float alpha = exp2f(mrun - mnew);
    mrun = mnew;
    float ps = 0.f;
#pragma unroll
    for (int kb = 0; kb < 2; ++kb)
#pragma unroll
      for (int i = 0; i < 16; ++i) {
        float e = exp2f(st[kb][i] - mnew);
        st[kb][i] = e;
        ps += e;
      }
    lrun = lrun * alpha + ps;
#pragma unroll
    for (int d = 0; d < 2; ++d)
#pragma unroll
      for (int i = 0; i < 16; ++i) o[d][i] *= alpha;
#pragma unroll
    for (int kb = 0; kb < 2; ++kb)
#pragma unroll
      for (int s2 = 0; s2 < 2; ++s2) {
        unsigned pw[4];
#pragma unroll
        for (int j = 0; j < 4; ++j) pw[j] = pk2(st[kb][8 * s2 + 2 * j], st[kb][8 * s2 + 2 * j + 1]);
        bf16x8 pb;
        {
          uint4 t = make_uint4(pw[0], pw[1], pw[2], pw[3]);
          pb = __builtin_bit_cast(bf16x8, t);
        }
#pragma unroll
        for (int d = 0; d < 2; ++d) {
          const bfr* vp = sm->V + (d * 32 + r) * VLD + kb * 32 + 16 * s2 + 4 * h;
          uint2 lo = *(const uint2*)vp;
          uint2 hi = *(const uint2*)(vp + 8);
          uint4 t = make_uint4(lo.x, lo.y, hi.x, hi.y);
          bf16x8 va = __builtin_bit_cast(bf16x8, t);
          o[d] = MFMA32(va, pb, o[d]);
        }
      }
    __syncthreads();
  }
  float ltot = lrun + __shfl_xor(lrun, 32);
  float inv = 1.f / ltot;
  int b = bh / NH, hh = bh - b * NH;
  size_t tok = (size_t)b * LALL + qpos;
  const bfr* SZ = (const bfr*)(p.ws + O_SZ0) + tok * 1024 + hh * 64;
  bfr* OG = (bfr*)(p.ws + O_OG) + tok * 1024 + hh * 64;
#pragma unroll
  for (int d = 0; d < 2; ++d)
#pragma unroll
    for (int g4 = 0; g4 < 4; ++g4) {
      int dv0 = d * 32 + 8 * g4 + 4 * h;
      uint2 z = *(const uint2*)(SZ + dv0);
      float z0 = __uint_as_float(z.x << 16), z1 = __uint_as_float(z.x & 0xffff0000u);
      float z2 = __uint_as_float(z.y << 16), z3 = __uint_as_float(z.y & 0xffff0000u);
      uint2 ov;
      ov.x = pk2(o[d][4 * g4 + 0] * inv * z0, o[d][4 * g4 + 1] * inv * z1);
      ov.y = pk2(o[d][4 * g4 + 2] * inv * z2, o[d][4 * g4 + 3] * inv * z3);
      *(uint2*)(OG + dv0) = ov;
    }
}

DI void phase_o3(const Params& p, char* smem) {
  AttnSmem* sm = (AttnSmem*)smem;
  const int xcd = blockIdx.x & 7, local = blockIdx.x >> 3, nloc = gridDim.x >> 3;
  for (int j = local; j < 256; j += nloc) {
    int u = xcd * 256 + j;
    attn_item(p, sm, u >> 4, LC + (u & 15) * 128, LALL);
  }
  for (int j = local; j < 32; j += nloc) {
    int u = xcd * 32 + j;
    attn_item(p, sm, u >> 1, (u & 1) * 128, LC);
  }
}

template <int LAYER>
DI void phase_oproj(const Params& p, char* smem) {
  GemmSmem* sm = (GemmSmem*)smem;
  WAVE_IDS
  constexpr int NROWS = LAYER == 0 ? TOK : NLAT;
  const int NT = 8, units = (NROWS / 128) * NT;
  const bfr* Ab = (const bfr*)(p.ws + (LAYER == 0 ? O_OG : O_Y2));
  const bfr* WT = (const bfr*)(p.ws + (LAYER == 0 ? O_WT_OUT0 : O_WT_OUT1));
  float* part = (float*)(p.ws + (LAYER == 0 ? O_PART1 : O_PART2));
  for (int u = blockIdx.x; u < units; u += gridDim.x) {
    int mt = u / NT, nt = u - mt * NT;
    int m0 = mt * 128, n0 = nt * 128;
    f32x16 acc[2][2];
    zero_acc(acc);
    gemm_main<false>(
        acc, 16, [&](int row, int k) { return Ab + (size_t)(m0 + row) * 1024 + k; },
        [&](int row, int k) { return WT + (size_t)(n0 + row) * 1024 + k; }, sm);
    const float* xin;
    float* xout;
    const float* gt;
    if (LAYER == 0) {
      xin = xrow0(p, m0);
      xout = xrow1(p, m0);
      gt = modrow(p, 0, m0) + 2048;
    } else {
      xin = p.out + (size_t)m0 * 1024;
      xout = p.out + (size_t)m0 * 1024;
      gt = (const float*)(p.ws + O_MOD) + ((size_t)(9 + (m0 >> 11))) * 3072 + 2048;
    }
    float tot = 0.f;
#pragma unroll
    for (int mi = 0; mi < 2; ++mi) {
      float sq[16];
#pragma unroll
      for (int i = 0; i < 16; ++i) sq[i] = 0.f;
#pragma unroll
      for (int ni = 0; ni < 2; ++ni) {
        int col = n0 + wn * 64 + ni * 32 + r;
        float g = gt[col];
#pragma unroll
        for (int i = 0; i < 16; ++i) {
          int row = wm * 64 + mi * 32 + crow(i, h);
          float v = xin[(size_t)row * 1024 + col] + g * acc[mi][ni][i];
          xout[(size_t)row * 1024 + col] = v;
          sq[i] += v * v;
          SCHED_FENCE();
        }
      }
      float t = transpose_reduce16(sq, lane);
      t += __shfl_xor(t, 16);
      if (((lane >> 4) & 1) == mi) tot = t;
    }
    int idx = lane & 31;
    int row = m0 + wm * 64 + (idx >> 4) * 32 + crow(idx & 15, h);
    part[(size_t)(nt * 2 + wn) * NROWS + row] = tot;
  }
}

DI void phase_o5(const Params& p, char* smem) {
  GemmSmem* sm = (GemmSmem*)smem;
  WAVE_IDS
  const int NT = 16, units = (TOK / 128) * NT;
  const bfr* WT = (const bfr*)(p.ws + O_WT_IN1);
  const float* part = (const float*)(p.ws + O_PART1);
  bfr* U2 = (bfr*)(p.ws + O_U2);
  bfr* SZ1 = (bfr*)(p.ws + O_SZ1);
  for (int u = blockIdx.x; u < units; u += gridDim.x) {
    int mt = u / NT, nt = u - mt * NT;
    int m0 = mt * 128, n0 = nt * 128;
    int b = m0 / LALL, pos0 = m0 - b * LALL;
    bool lat = pos0 >= LC;
    if (!lat && nt >= 8) continue;
    __syncthreads();
    const float* md = modrow(p, 1, m0);
    const float* ng = p.in[I_NORMG] + 1024;
    for (int k = tid; k < 1024; k += 256) {
      sm->gs[k] = ng[k] * (1.f + md[1024 + k]);
      sm->sh[k] = md[k];
    }
    if (tid < 128) sm->rs[tid] = rs_from_part(part, TOK, m0 + tid);
    __syncthreads();
    const float* abase = xrow1(p, m0);
    f32x16 acc[2][2];
    zero_acc(acc);
    gemm_main<true>(
        acc, 16, [&](int row) { return abase + (size_t)row * 1024; },
        [&](int row, int k) { return WT + (size_t)(n0 + row) * 1024 + k; }, sm);
#pragma unroll
    for (int mi = 0; mi < 2; ++mi)
#pragma unroll
      for (int ni = 0; ni < 2; ++ni) {
        int col = n0 + wn * 64 + ni * 32 + r;
#pragma unroll
        for (int i = 0; i < 16; ++i) {
          int row = wm * 64 + mi * 32 + crow(i, h);
          int tok = m0 + row;
          float v = acc[mi][ni][i];
          if (col < 1024) U2[((size_t)(col >> 4) * TOK + tok) * 16 + (col & 15)] = f2bf(v);
          else SZ1[((size_t)(b * SEQ + pos0 + row - LC)) * 1024 + (col - 1024)] = f2bf(silu_f(v));
          SCHED_FENCE();
        }
      }
  }
}

DI void phase_o6(const Params& p, char* smem) {
  GemmSmem* sm = (GemmSmem*)smem;
  WAVE_IDS
  const int NROW = NB * NCH;
  const int units = 64 * 5 * 2;
  const bfr* U2 = (const bfr*)(p.ws + O_U2);
  const bfr* WST = (const bfr*)(p.ws + O_WST);
  float* SLOC = (float*)(p.ws + O_SLOC);
  for (int u = blockIdx.x; u < units; u += gridDim.x) {
    int g = u / 10, rem = u - g * 10;
    int mt = rem >> 1, nt = rem & 1;
    int m0 = mt * 128, n0 = nt * 128;
    const bfr* Ag = U2 + (size_t)g * TOK * 16;
    const bfr* Bg = WST + (size_t)g * 256 * 512;
    f32x16 acc[2][2];
    zero_acc(acc);
    gemm_main<false>(
        acc, 8,
        [&](int row, int k) {
          int rr = m0 + row;
          rr = rr < NROW ? rr : NROW - 1;
          return Ag + (size_t)rr * 512 + k;
        },
        [&](int row, int k) { return Bg + (size_t)(n0 + row) * 512 + k; }, sm);
#pragma unroll
    for (int mi = 0; mi < 2; ++mi)
#pragma unroll
      for (int ni = 0; ni < 2; ++ni) {
        int col = n0 + wn * 64 + ni * 32 + r;
#pragma unroll
        for (int i = 0; i < 16; ++i) {
          int row = m0 + wm * 64 + mi * 32 + crow(i, h);
          if (row < NROW) SLOC[((size_t)g * NROW + row) * 256 + col] = acc[mi][ni][i];
        }
      }
  }
}

DI void phase_o7(const Params& p) {
  const int tidx_ = opaque_tid();
  const float* SLOC = (const float*)(p.ws + O_SLOC);
  bfr* SIN = (bfr*)(p.ws + O_SIN);
  const int total = NB * 64 * 2 * 64;
  for (int idx = blockIdx.x * 256 + tidx_; idx < total; idx += gridDim.x * 256) {
    int pp = idx & 63, dir = (idx >> 6) & 1, g = (idx >> 7) & 63, b = idx >> 13;
    double dt, ar, ai;
    float fr, fi, lr, li;
    s5_disc(p, dir, g, pp, dt, ar, ai, fr, fi);
    s5_pow(dt, ar, ai, TC, lr, li);
    float sr = 0.f, si = 0.f;
    for (int step = 0; step < NCH; ++step) {
      int cp = dir == 0 ? step : (step < 8 ? 7 - step : NCH - 1 - (step - 8));
      const float* sl = SLOC + ((size_t)g * (NB * NCH) + b * NCH + cp) * 256 + dir * 128 + pp;
#ifdef PROBE_NOCARRY
      if ((dir == 0 && cp == 8) || (dir == 1 && cp == NCH - 1)) { sr = 0.f; si = 0.f; }
#endif
      if (cp >= 8) {
        bfr* so = SIN + ((size_t)g * (NB * NCHL) + b * NCHL + (cp - 8)) * 256 + dir * 128 + pp;
        so[0] = f2bf(sr);
        so[64] = f2bf(si);
      }
      float lre = sl[0], lim = sl[64];
      float nr = lr * sr - li * si + lre;
      float ni = lr * si + li * sr + lim;
      sr = nr;
      si = ni;
    }
  }
}

DI void phase_o8(const Params& p, char* smem) {
  GemmSmem* sm = (GemmSmem*)smem;
  WAVE_IDS
  const int units = 64 * 4 * 4;
  const bfr* U2 = (const bfr*)(p.ws + O_U2);
  const bfr* SIN = (const bfr*)(p.ws + O_SIN);
  const bfr* KTAB = (const bfr*)(p.ws + O_KTAB);
  const bfr* VOP = (const bfr*)(p.ws + O_VOP);
  bfr* YG = (bfr*)(p.ws + O_YG);
  for (int u = blockIdx.x; u < units; u += gridDim.x) {
    int g = u >> 4, mt = (u >> 2) & 3, nt = u & 3;
    int m0 = mt * 128, n0 = nt * 128;
    const bfr* Ug = U2 + (size_t)g * TOK * 16;
    f32x16 acc[2][2];
    zero_acc(acc);
    gemm_main<false>(
        acc, 12,
        [&](int row, int k) {
          int rr = m0 + row;
          int b = rr >> 6, n = rr & 63;
          const bfr* a1 = Ug + ((size_t)b * LALL + LC + n * TC) * 16 + k;
          const bfr* a2 = SIN + ((size_t)g * (NB * NCHL) + rr) * 256 + (k - 512);
          return k < 512 ? a1 : a2;
        },
        [&](int row, int k) {
          int m = n0 + row;
          int t = m >> 4, c = m & 15;
          int j = k >> 4;
          const bfr* b1 = KTAB + (((size_t)g * 63 + (t - j + 31)) * 16 + c) * 16 + (k & 15);
          const bfr* b2 = VOP + ((size_t)g * 512 + m) * 256 + (k - 512);
          return k < 512 ? b1 : b2;
        },
        sm);
#pragma unroll
    for (int mi = 0; mi < 2; ++mi)
#pragma unroll
      for (int ni = 0; ni < 2; ++ni) {
        int m = n0 + wn * 64 + ni * 32 + r;
        int t = m >> 4, c = m & 15;
        int ch = g * 16 + c;
        float dd = p.in[I_S5D][ch];
#pragma unroll
        for (int i = 0; i < 16; ++i) {
          int rr = m0 + wm * 64 + mi * 32 + crow(i, h);
          int b = rr >> 6, n = rr & 63;
          float uu = bf2f(Ug[((size_t)b * LALL + LC + n * TC + t) * 16 + c]);
          float y = acc[mi][ni][i] + dd * uu;
          YG[((size_t)(b * SEQ + n * TC + t)) * 1024 + ch] = f2bf(gelu_tanh(y));
          SCHED_FENCE();
        }
      }
  }
}

DI void phase_o9(const Params& p, char* smem) {
  GemmSmem* sm = (GemmSmem*)smem;
  WAVE_IDS
  const int NT = 8, units = (NLAT / 128) * NT;
  const bfr* YG = (const bfr*)(p.ws + O_YG);
  const bfr* SZ1 = (const bfr*)(p.ws + O_SZ1);
  const bfr* WT = (const bfr*)(p.ws + O_WT_GLU);
  bfr* Y2 = (bfr*)(p.ws + O_Y2);
  for (int u = blockIdx.x; u < units; u += gridDim.x) {
    int mt = u / NT, nt = u - mt * NT;
    int m0 = mt * 128, n0 = nt * 128;
    f32x16 acc[2][2];
    zero_acc(acc);
    gemm_main<false>(
        acc, 16, [&](int row, int k) { return YG + (size_t)(m0 + row) * 1024 + k; },
        [&](int row, int k) { return WT + (size_t)(n0 + row) * 1024 + k; }, sm);
#pragma unroll
    for (int mi = 0; mi < 2; ++mi)
#pragma unroll
      for (int ni = 0; ni < 2; ++ni) {
        int col = n0 + wn * 64 + ni * 32 + r;
        float bg = p.in[I_BGLU][col];
#pragma unroll
        for (int i = 0; i < 16; ++i) {
          size_t o = (size_t)(m0 + wm * 64 + mi * 32 + crow(i, h)) * 1024 + col;
          float y = bf2f(YG[o]);
          Y2[o] = f2bf(y * sigmoid_f(acc[mi][ni][i] + bg) * bf2f(SZ1[o]));
          SCHED_FENCE();
        }
      }
  }
}

#define XB_TMO      128
#define XB_XCNT(j)  (256  + 64 * (j))
#define XB_XSUB(j)  (1280 + 64 * (j))
#define XB_XGEN(j)  (2304 + 64 * (j))
#define XB_TOP      3328
#define XB_TOPGEN   3392
#define XCD_BAR_WORDS 3456
#define XB_SPIN_CAP (1u << 18)
#define LAS __attribute__((address_space(3)))
DI unsigned xb_ld(unsigned* p) { return __hip_atomic_load(p, __ATOMIC_RELAXED, __HIP_MEMORY_SCOPE_AGENT); }
DI unsigned xb_add(unsigned* p, unsigned v) { return __hip_atomic_fetch_add(p, v, __ATOMIC_RELAXED, __HIP_MEMORY_SCOPE_AGENT); }
DI unsigned xb_xcc_id() { return (unsigned)__builtin_amdgcn_s_getreg((3 << 11) | 20) & 0xFu; }
#define XB_SPIN(cond, bar) do { unsigned _sp = 0; while (cond) { __builtin_amdgcn_s_sleep(1); \
    if ((++_sp & 255u) == 0u) { if (xb_ld(&(bar)[XB_TMO])) break; if (_sp > XB_SPIN_CAP) { atomicAdd(&(bar)[XB_TMO], 1u); break; } } } } while (0)
struct XcdBarrier {
  unsigned* bar;
  unsigned x;
  volatile LAS unsigned* st;
};
DI XcdBarrier xcd_barrier_post(unsigned* bar, volatile LAS unsigned* st) {
  XcdBarrier b;
  b.bar = bar;
  b.x = xb_xcc_id();
  b.st = st;
  if (threadIdx.x == 0) (void)xb_add(&bar[XB_XCNT(b.x)], 1u);
  return b;
}
DI void xcd_barrier_complete(unsigned* bar, unsigned x, unsigned& nloc, unsigned& nx) {
  const unsigned G = gridDim.x * gridDim.y * gridDim.z;
  unsigned sum, cnt, mine, sp = 0u;
  for (;;) {
    sum = 0u; cnt = 0u; mine = 0u;
#pragma unroll
    for (unsigned j = 0; j < 16; ++j) {
      const unsigned c = xb_ld(&bar[XB_XCNT(j)]);
      sum += c;
      cnt += (c > 0u) ? 1u : 0u;
      mine = (j == x) ? c : mine;
    }
    if (sum == G) break;
    __builtin_amdgcn_s_sleep(1);
    if ((++sp & 255u) == 0u) {
      if (xb_ld(&bar[XB_TMO])) break;
      if (sp > XB_SPIN_CAP) { atomicAdd(&bar[XB_TMO], 1u); break; }
    }
  }
  nloc = mine > 0u ? mine : 1u;
  nx = cnt > 0u ? cnt : 1u;
}
DI void xcd_barrier(const XcdBarrier& b) {
  asm volatile("s_waitcnt vmcnt(0)" ::: "memory");
  __syncthreads();
  if (threadIdx.x == 0) {
    unsigned* bar = b.bar;
    __builtin_amdgcn_s_waitcnt(0);
    unsigned nloc = b.st[0], nx = b.st[1];
    if (nloc == 0u) {
      xcd_barrier_complete(bar, b.x, nloc, nx);
      b.st[0] = nloc;
      b.st[1] = nx;
    }
    const unsigned old = xb_add(&bar[XB_XSUB(b.x)], 1u);
    const unsigned gen = old / nloc;
    if (old + 1u == (gen + 1u) * nloc) {
      __builtin_amdgcn_fence(__ATOMIC_RELEASE, "agent");
      asm volatile("s_waitcnt vmcnt(0)" ::: "memory");
      const unsigned og = xb_add(&bar[XB_TOP], 1u);
      const unsigned tg = og / nx;
      if (og + 1u == (tg + 1u) * nx) xb_add(&bar[XB_TOPGEN], 1u);
      else XB_SPIN(xb_ld(&bar[XB_TOPGEN]) == tg, bar);
      __builtin_amdgcn_fence(__ATOMIC_ACQUIRE, "agent");
      xb_add(&bar[XB_XGEN(b.x)], 1u);
      asm volatile("s_waitcnt vmcnt(0)" ::: "memory");
    } else {
      XB_SPIN(xb_ld(&bar[XB_XGEN(b.x)]) == gen, bar);
      __builtin_amdgcn_fence(__ATOMIC_ACQUIRE, "agent");
      asm volatile("s_waitcnt vmcnt(0)" ::: "memory");
    }
  }
  __syncthreads();
}

DI void run_phase(const Params& p, int ph, char* smem) {
  switch (ph) {
#if !defined(ONLY) || ONLY == 0
    case PH_PREP: phase_prep(p, smem); break;
#endif
#if USE_NAIVE
    case PH_N1: phase_n1(p); break;
    case PH_N2: phase_n2(p); break;
    case PH_N3: phase_n3(p); break;
    case PH_N4: phase_n4(p); break;
    case PH_N4B: phase_rowsq(p, 1); break;
    case PH_N5: phase_n5(p); break;
    case PH_N6A: phase_n6(p, 0); break;
    case PH_N6B: phase_n6(p, 1); break;
    case PH_N9: phase_n9(p); break;
    case PH_N10: phase_n10(p); break;
    case PH_N10B: phase_rowsq(p, 2); break;
#endif
#if !defined(ONLY) || ONLY == 1
    case PH_FINAL: phase_final(p); break;
#endif
#if !defined(ONLY) || ONLY == 2
    case PH_O1: phase_o1(p, smem); break;
#endif
#if !defined(ONLY) || ONLY == 3
    case PH_O2: phase_o2(p, smem); break;
#endif
#if !defined(ONLY) || ONLY == 4
    case PH_O3: phase_o3(p, smem); break;
#endif
#if !defined(ONLY) || ONLY == 5
    case PH_O4: phase_oproj<0>(p, smem); break;
#endif
#if !defined(ONLY) || ONLY == 6
    case PH_O5: phase_o5(p, smem); break;
#endif
#if !defined(ONLY) || ONLY == 7
    case PH_O6: phase_o6(p, smem); break;
#endif
#if !defined(ONLY) || ONLY == 8
    case PH_O7: phase_o7(p); break;
#endif
#if !defined(ONLY) || ONLY == 9
    case PH_O8: phase_o8(p, smem); break;
#endif
#if !defined(ONLY) || ONLY == 10
    case PH_O9: phase_o9(p, smem); break;
#endif
#if !defined(ONLY) || ONLY == 11
    case PH_O10: phase_oproj<1>(p, smem); break;
#endif
    default: break;
  }
}

__global__ void __launch_bounds__(256, 2) mega_one(Params p, int ph) {
  __shared__ __attribute__((aligned(16))) char smem[SMEM_BYTES];
  run_phase(p, ph, smem);
}

#if !defined(ONLY) && SINGLE_LAUNCH
__global__ void __launch_bounds__(256, 2) mega(Params p) {
  __shared__ __attribute__((aligned(16))) char smem[SMEM_BYTES];
  __shared__ uint4 xb_words;
  if (threadIdx.x == 0) xb_words = make_uint4(0u, 0u, 0u, 0u);
  __syncthreads();
  if (p.nprog < 0) cg::this_grid().sync();
  const XcdBarrier xb = xcd_barrier_post((unsigned*)(p.ws + O_BAR), (volatile LAS unsigned*)&xb_words);
  cg::grid_group grid = cg::this_grid();
#if !defined(OMIT) || OMIT != 0
  phase_prep(p, smem);
#endif
  xcd_barrier(xb);
#if !defined(OMIT) || OMIT != 1
  phase_o1(p, smem);
#endif
  xcd_barrier(xb);
#if !defined(OMIT) || OMIT != 2
  phase_o2(p, smem);
#endif
  xcd_barrier(xb);
#if !defined(OMIT) || OMIT != 3
  phase_o3(p, smem);
#endif
  xcd_barrier(xb);
#if !defined(OMIT) || OMIT != 4
  phase_oproj<0>(p, smem);
#endif
  xcd_barrier(xb);
#if !defined(OMIT) || OMIT != 5
  phase_o5(p, smem);
#endif
  xcd_barrier(xb);
#if !defined(OMIT) || OMIT != 6
  phase_o6(p, smem);
#endif
  xcd_barrier(xb);
#if !defined(OMIT) || OMIT != 7
  phase_o7(p);
#endif
  xcd_barrier(xb);
#if !defined(OMIT) || OMIT != 8
  phase_o8(p, smem);
#endif
  xcd_barrier(xb);
#if !defined(OMIT) || OMIT != 9
  phase_o9(p, smem);
#endif
  xcd_barrier(xb);
#if !defined(OMIT) || OMIT != 10
  phase_oproj<1>(p, smem);
#endif
  xcd_barrier(xb);
#if !defined(OMIT) || OMIT != 11
  phase_final(p);
#endif
}
#else
__global__ void mega(Params p) {}
#endif


extern "C" void kernel_launch(void* const* d_in, const int* in_sizes, int n_in, void* d_out, int out_size, void* d_ws,
                              size_t ws_size, hipStream_t stream) {
  static int grid_blocks = 0;
  if (!grid_blocks) {
    int dev = 0, cus = 0, per_cu = 0;
    hipGetDevice(&dev);
    hipDeviceGetAttribute(&cus, hipDeviceAttributeMultiprocessorCount, dev);
#if SINGLE_LAUNCH
    hipOccupancyMaxActiveBlocksPerMultiprocessor(&per_cu, mega, 256, 0);
#else
    hipOccupancyMaxActiveBlocksPerMultiprocessor(&per_cu, mega_one, 256, 0);
#endif
    if (per_cu < 1) per_cu = 1;
    if (per_cu > 2) per_cu = 2;
    grid_blocks = cus * per_cu;
  }
  if (ws_size < WS_NEED || n_in < N_INPUTS) {
    fprintf(stderr, "workspace too small or bad inputs: %zu < %zu\n", ws_size, (size_t)WS_NEED);
    return;
  }
  Params p{};
  for (int i = 0; i < N_INPUTS; ++i) p.in[i] = (const float*)d_in[i];
  p.out = (float*)d_out;
  p.ws = (char*)d_ws;
#ifndef PROG
#define PROG PH_PREP, PH_O1, PH_O2, PH_O3, PH_O4, PH_O5, PH_O6, PH_O7, PH_O8, PH_O9, PH_O10, PH_FINAL
#endif
  const int prog[] = {PROG};
  p.nprog = (int)(sizeof(prog) / sizeof(int));
  for (int i = 0; i < p.nprog; ++i) p.prog[i] = prog[i];
#if SINGLE_LAUNCH
  hipMemsetAsync((char*)d_ws + O_BAR, 0, BAR_BYTES, stream);
  void* args[] = {&p};
  hipError_t e = hipLaunchCooperativeKernel((void*)mega, dim3(grid_blocks), dim3(256), args, 0, stream);
  if (e != hipSuccess) fprintf(stderr, "cooperative launch failed: %s (grid %d)\n", hipGetErrorString(e), grid_blocks);
#else
  for (int i = 0; i < p.nprog; ++i) {
    mega_one<<<dim3(grid_blocks), dim3(256), 0, stream>>>(p, p.prog[i]);
  }
#endif
}
```

```cpp
#include <hip/hip_runtime.h>
#include <hip/hip_cooperative_groups.h>
#include <cstdio>
namespace cg = cooperative_groups;
#ifndef DUP
#define DUP 0
#endif
#ifndef USE_NAIVE
#define USE_NAIVE 0
#endif
#ifndef SINGLE_LAUNCH
#define SINGLE_LAUNCH 1
#endif

#define DI __device__ __forceinline__
typedef unsigned short bfr;

constexpr int D = 1024, NB = 8, SEQ = 2048, LC = 256, LALL = 2304;
constexpr int TOK = NB * LALL;
constexpr int NLAT = NB * SEQ;
constexpr int NH = 16, DQK = 96, DV = 64;
constexpr int NIN0 = 1440, NIN1 = 2048;
constexpr float EPS = 1e-6f;
constexpr float QSCALE = 0.10206207261596577f * 1.4426950408889634f;
constexpr int TC = 32;
constexpr int NCH = LALL / TC;
constexpr int NCHL = SEQ / TC;

enum { I_X = 0, I_C, I_CTX, I_CCTX, I_ADAW, I_ADAB, I_NORMG, I_WIN0, I_QNORM, I_WUQ, I_KVNORM, I_WUKV, I_WOUT0,
       I_WIN1, I_ARE, I_AIM, I_LOGSTEP, I_BRE, I_BIM, I_CRE, I_CIM, I_S5D, I_WGLU, I_BGLU, I_WOUT1, I_FINALG, N_INPUTS };

constexpr size_t al256(size_t x) { return (x + 255) & ~(size_t)255; }
constexpr size_t O_WT_IN0 = 0;
constexpr size_t O_WT_UQ = O_WT_IN0 + al256((size_t)NIN0 * 1024 * 2);
constexpr size_t O_WT_UKV = O_WT_UQ + al256((size_t)1536 * 256 * 2);
constexpr size_t O_WT_OUT0 = O_WT_UKV + al256((size_t)2048 * 128 * 2);
constexpr size_t O_WT_IN1 = O_WT_OUT0 + al256((size_t)1024 * 1024 * 2);
constexpr size_t O_WT_GLU = O_WT_IN1 + al256((size_t)2048 * 1024 * 2);
constexpr size_t O_WT_OUT1 = O_WT_GLU + al256((size_t)1024 * 1024 * 2);
constexpr size_t O_MOD = O_WT_OUT1 + al256((size_t)1024 * 1024 * 2);
constexpr size_t O_RS0 = O_MOD + al256((size_t)2 * 9 * 3072 * 4);
constexpr size_t O_PART1 = O_RS0 + al256((size_t)TOK * 4);
constexpr size_t O_PART2 = O_PART1 + al256((size_t)16 * TOK * 4);
constexpr size_t O_X1CTX = O_PART2 + al256((size_t)16 * NLAT * 4);
constexpr size_t O_KTAB = O_X1CTX + al256((size_t)NB * LC * 1024 * 4);
constexpr size_t O_WST = O_KTAB + al256((size_t)64 * 63 * 256 * 2);
constexpr size_t O_VOP = O_WST + al256((size_t)64 * 256 * 512 * 2);
constexpr size_t O_BAR = O_VOP + al256((size_t)64 * 512 * 256 * 2);
constexpr size_t BAR_BYTES = 3456 * 4;
constexpr size_t O_LAYER = O_BAR + al256(BAR_BYTES);
constexpr size_t O_PC = O_LAYER;
constexpr size_t O_SZ0 = O_PC + al256((size_t)TOK * 384 * 2);
constexpr size_t O_K = O_SZ0 + al256((size_t)TOK * 1024 * 2);
constexpr size_t O_VT = O_K + al256((size_t)NB * NH * LALL * DQK * 2);
constexpr size_t O_OG = O_VT + al256((size_t)NB * NH * DV * LALL * 2);
constexpr size_t O_END0 = O_OG + al256((size_t)TOK * 1024 * 2);
constexpr size_t O_U2 = O_LAYER;
constexpr size_t O_SZ1 = O_U2 + al256((size_t)64 * TOK * 16 * 2);
constexpr size_t O_SLOC = O_SZ1 + al256((size_t)NLAT * 1024 * 2);
constexpr size_t O_SIN = O_SLOC + al256((size_t)64 * (NB * NCH) * 256 * 4);
constexpr size_t O_YG = O_SIN + al256((size_t)64 * (NB * NCHL) * 256 * 2);
constexpr size_t O_END1 = O_YG + al256((size_t)NLAT * 1024 * 2);
constexpr size_t O_Y2 = O_SLOC;
constexpr size_t WS_NEED = (O_END0 > O_END1 ? O_END0 : O_END1);
static_assert(WS_NEED <= (size_t)256 * 1024 * 1024, "workspace too large");
static_assert((size_t)NB * NH * LALL * DQK * 2 <= (size_t)NLAT * 1024 * 4, "Q does not fit d_out");

struct Params {
  const float* in[N_INPUTS];
  float* out;
  char* ws;
  int prog[32];
  int nprog;
  int pad;
};

DI bfr f2bf(float x) {
  unsigned u = __float_as_uint(x);
  u += 0x7fffu + ((u >> 16) & 1u);
  return (bfr)(u >> 16);
}
DI int opaque_tid() {
  int t = threadIdx.x;
  asm volatile("" : "+v"(t));
  return t;
}
DI float bf2f(bfr b) { return __uint_as_float(((unsigned)b) << 16); }
DI float silu_f(float v) { return v / (1.f + __expf(-v)); }
DI float sigmoid_f(float v) { return 1.f / (1.f + __expf(-v)); }
DI float gelu_tanh(float v) {
  float u = 0.7978845608028654f * (v + 0.044715f * v * v * v);
  return 0.5f * v * (1.f + tanhf(u));
}
DI float wave_sum(float v) {
#pragma unroll
  for (int o = 32; o > 0; o >>= 1) v += __shfl_xor(v, o);
  return v;
}
DI float wave_max(float v) {
#pragma unroll
  for (int o = 32; o > 0; o >>= 1) v = fmaxf(v, __shfl_xor(v, o));
  return v;
}
DI const float* xrow0(const Params& p, int tok) {
  int b = tok / LALL, pos = tok - b * LALL;
  return pos < LC ? p.in[I_CTX] + ((size_t)(b * LC + pos)) * D : p.in[I_X] + ((size_t)(b * SEQ + pos - LC)) * D;
}
DI float* xrow1(const Params& p, int tok) {
  int b = tok / LALL, pos = tok - b * LALL;
  return pos < LC ? (float*)(p.ws + O_X1CTX) + ((size_t)(b * LC + pos)) * D : p.out + ((size_t)(b * SEQ + pos - LC)) * D;
}
DI const float* modrow(const Params& p, int layer, int tok) {
  int b = tok / LALL, pos = tok - b * LALL;
  int r = pos < LC ? 8 : b;
  return (const float*)(p.ws + O_MOD) + ((size_t)(layer * 9 + r)) * 3072;
}
DI void rope_cs(int fi, int posv, float& cs, float& sn) {
  float inv = exp2f(-(float)fi * (13.287712379549449f / 8.f));
  sincosf((float)posv * inv, &sn, &cs);
}
DI float rope_apply(int j, float v, float vp, int lpos) {
  int posv = (j & 16) ? (lpos & 63) : (lpos >> 6);
  float cs, sn;
  rope_cs(j & 7, posv, cs, sn);
  return (j & 8) ? (vp * sn + v * cs) : (v * cs - vp * sn);
}

DI void s5_disc(const Params& p, int dir, int g, int pp, double& dt, double& ar, double& ai, float& fr, float& fi) {
  dt = exp((double)p.in[I_LOGSTEP][dir * 64 + g]);
  ar = (double)p.in[I_ARE][(dir * 64 + g) * 64 + pp];
  ai = (double)p.in[I_AIM][(dir * 64 + g) * 64 + pp];
  double mag = exp(ar * dt);
  double a = ai * dt;
  a -= 6.283185307179586 * rint(a * 0.15915494309189535);
  float sn, cs;
  sincosf((float)a, &sn, &cs);
  double lr = mag * (double)cs, li = mag * (double)sn;
  double den = ar * ar + ai * ai, nr = lr - 1.0;
  fr = (float)((nr * ar + li * ai) / den);
  fi = (float)((li * ar - nr * ai) / den);
}
DI void s5_pow(double dt, double ar, double ai, int k, float& wr, float& wi) {
  double mag = exp(ar * dt * (double)k);
  double a = ai * dt * (double)k;
  a -= 6.283185307179586 * rint(a * 0.15915494309189535);
  float sn, cs;
  sincosf((float)a, &sn, &cs);
  wr = (float)mag * cs;
  wi = (float)mag * sn;
}

enum { PH_PREP = 0, PH_N1, PH_N2, PH_N3, PH_N4, PH_N4B, PH_N5, PH_N6A, PH_N6B, PH_N9, PH_N10, PH_N10B, PH_FINAL,
       PH_O1, PH_O2, PH_O3, PH_O4, PH_O5, PH_O6, PH_O7, PH_O8, PH_O9, PH_O10, PH_COUNT };

constexpr int SMEM_BYTES = 48 * 1024;


DI void prep_transpose(const Params& p, int widx, int tile, char* smem) {
  const int tidx_ = opaque_tid();
  int K, N;
  size_t dst;
  const float* W;
  const float* scl = nullptr;
  switch (widx) {
    case 0: W = p.in[I_WIN0]; K = 1024; N = NIN0; dst = O_WT_IN0; break;
    case 1: W = p.in[I_WUQ]; K = 256; N = 1536; dst = O_WT_UQ; scl = p.in[I_QNORM]; break;
    case 2: W = p.in[I_WUKV]; K = 128; N = 2048; dst = O_WT_UKV; scl = p.in[I_KVNORM]; break;
    case 3: W = p.in[I_WOUT0]; K = 1024; N = 1024; dst = O_WT_OUT0; break;
    case 4: W = p.in[I_WIN1]; K = 1024; N = NIN1; dst = O_WT_IN1; break;
    case 5: W = p.in[I_WGLU]; K = 1024; N = 1024; dst = O_WT_GLU; break;
    default: W = p.in[I_WOUT1]; K = 1024; N = 1024; dst = O_WT_OUT1; break;
  }
  float (*t)[33] = (float (*)[33])smem;
  int ntn = N / 32;
  int kt = tile / ntn, nt = tile - kt * ntn;
  int tx = tidx_ & 31, ty = tidx_ >> 5;
#pragma unroll
  for (int i = 0; i < 4; ++i) {
    int k = kt * 32 + ty + 8 * i, n = nt * 32 + tx;
    float v = W[(size_t)k * N + n];
    if (scl) v *= scl[k];
    t[ty + 8 * i][tx] = v;
  }
  __syncthreads();
  bfr* Wt = (bfr*)(p.ws + dst);
#pragma unroll
  for (int i = 0; i < 4; ++i) {
    int n = nt * 32 + ty + 8 * i, k = kt * 32 + tx;
    Wt[(size_t)n * K + k] = f2bf(t[tx][ty + 8 * i]);
  }
  __syncthreads();
}

DI void prep_mod(const Params& p, int unit, char* smem) {
  const int tidx_ = opaque_tid();
  int layer = unit / 48, cgp = unit - layer * 48;
  float* sil = (float*)smem;
  float* red = sil + 9 * 1024;
  for (int i = tidx_; i < 9 * 1024; i += 256) {
    int r = i >> 10, k = i & 1023;
    float v = r < 8 ? p.in[I_C][r * 1024 + k] : p.in[I_CCTX][k];
    sil[i] = silu_f(v);
  }
  __syncthreads();
  int nn = tidx_ & 63, kg = tidx_ >> 6;
  int n = cgp * 64 + nn;
  const float* W = p.in[I_ADAW] + (size_t)layer * 1024 * 3072;
  float acc[9];
#pragma unroll
  for (int r = 0; r < 9; ++r) acc[r] = 0.f;
  for (int k = kg * 256; k < kg * 256 + 256; ++k) {
    float w = W[(size_t)k * 3072 + n];
#pragma unroll
    for (int r = 0; r < 9; ++r) acc[r] += sil[r * 1024 + k] * w;
  }
#pragma unroll
  for (int r = 0; r < 9; ++r) red[(kg * 9 + r) * 64 + nn] = acc[r];
  __syncthreads();
  if (kg == 0) {
    float bias = p.in[I_ADAB][layer * 3072 + n];
    float* mod = (float*)(p.ws + O_MOD);
#pragma unroll
    for (int r = 0; r < 9; ++r) {
      float s = red[(0 * 9 + r) * 64 + nn] + red[(1 * 9 + r) * 64 + nn] + red[(2 * 9 + r) * 64 + nn] + red[(3 * 9 + r) * 64 + nn];
      mod[((size_t)(layer * 9 + r)) * 3072 + n] = s + bias;
    }
  }
  __syncthreads();
}

DI void prep_rs0(const Params& p, int unit) {
  const int tidx_ = opaque_tid();
  int tok = unit * 4 + (tidx_ >> 6);
  int lane = tidx_ & 63;
  const float4* r = (const float4*)xrow0(p, tok);
  float s = 0.f;
#pragma unroll
  for (int i = 0; i < 4; ++i) {
    float4 v = r[lane + 64 * i];
    s += v.x * v.x + v.y * v.y + v.z * v.z + v.w * v.w;
  }
  s = wave_sum(s);
  if (lane == 0) ((float*)(p.ws + O_RS0))[tok] = rsqrtf(s * (1.f / 1024.f) + EPS);
}

DI void prep_ktab(const Params& p, int unit, char* smem) {
  const int tidx_ = opaque_tid();
  int g = unit / 63, lagidx = unit - g * 63;
  int lag = lagidx - 31;
  float2* E = (float2*)smem;
  int tid = tidx_;
  if (tid < 128) {
    int dir = tid >> 6, pp = tid & 63;
    bool used = (dir == 0) ? (lag >= 0) : (lag <= 0);
    float2 e = make_float2(0.f, 0.f);
    if (used) {
      double dt, ar, ai;
      float fr, fi, wr, wi;
      s5_disc(p, dir, g, pp, dt, ar, ai, fr, fi);
      s5_pow(dt, ar, ai, lag < 0 ? -lag : lag, wr, wi);
      e.x = wr * fr - wi * fi;
      e.y = wr * fi + wi * fr;
    }
    E[tid] = e;
  }
  __syncthreads();
  int c = tid >> 4, c2 = tid & 15;
  float acc = 0.f;
  for (int dir = 0; dir < 2; ++dir) {
    bool used = (dir == 0) ? (lag >= 0) : (lag <= 0);
    if (!used) continue;
    const float* bre = p.in[I_BRE] + ((size_t)(dir * 64 + g)) * 64 * 16;
    const float* bim = p.in[I_BIM] + ((size_t)(dir * 64 + g)) * 64 * 16;
    const float* cre = p.in[I_CRE] + ((size_t)(dir * 64 + g)) * 16 * 64;
    const float* cim = p.in[I_CIM] + ((size_t)(dir * 64 + g)) * 16 * 64;
    for (int pp = 0; pp < 64; ++pp) {
      float2 e = E[dir * 64 + pp];
      float br = bre[pp * 16 + c2], bi = bim[pp * 16 + c2];
      float gr = e.x * br - e.y * bi, gi = e.x * bi + e.y * br;
      float cr = cre[c * 64 + pp], ci = cim[c * 64 + pp];
      acc += cr * gr - ci * gi;
    }
  }
  ((bfr*)(p.ws + O_KTAB))[((size_t)unit * 16 + c) * 16 + c2] = f2bf(acc);
  __syncthreads();
}

DI void prep_ops(const Params& p, int unit) {
  const int tidx_ = opaque_tid();
  int idx = unit * 256 + tidx_;
  int pp = idx & 63, t = (idx >> 6) & 31, dir = (idx >> 11) & 1, g = idx >> 12;
  double dt, ar, ai;
  float fr, fi, wr, wi;
  s5_disc(p, dir, g, pp, dt, ar, ai, fr, fi);
  s5_pow(dt, ar, ai, dir == 0 ? (TC - 1 - t) : t, wr, wi);
  float er = wr * fr - wi * fi, ei = wr * fi + wi * fr;
  const float* bre = p.in[I_BRE] + (((size_t)(dir * 64 + g)) * 64 + pp) * 16;
  const float* bim = p.in[I_BIM] + (((size_t)(dir * 64 + g)) * 64 + pp) * 16;
  bfr* wst = (bfr*)(p.ws + O_WST) + (size_t)g * 256 * 512;
  bfr* rre = wst + (size_t)(dir * 128 + pp) * 512 + t * 16;
  bfr* rim = wst + (size_t)(dir * 128 + 64 + pp) * 512 + t * 16;
#pragma unroll
  for (int c2 = 0; c2 < 16; ++c2) {
    float br = bre[c2], bi = bim[c2];
    rre[c2] = f2bf(er * br - ei * bi);
    rim[c2] = f2bf(er * bi + ei * br);
  }
  s5_pow(dt, ar, ai, dir == 0 ? (t + 1) : (TC - t), wr, wi);
  const float* cre = p.in[I_CRE] + ((size_t)(dir * 64 + g)) * 16 * 64;
  const float* cim = p.in[I_CIM] + ((size_t)(dir * 64 + g)) * 16 * 64;
  bfr* vop = (bfr*)(p.ws + O_VOP) + (size_t)g * 512 * 256;
#pragma unroll
  for (int c = 0; c < 16; ++c) {
    float cr = cre[c * 64 + pp], ci = cim[c * 64 + pp];
    float dr = cr * wr - ci * wi, di = cr * wi + ci * wr;
    vop[(size_t)(t * 16 + c) * 256 + dir * 128 + pp] = f2bf(dr);
    vop[(size_t)(t * 16 + c) * 256 + dir * 128 + 64 + pp] = f2bf(-di);
  }
}

constexpr int TR_T0 = 32 * 45, TR_T1 = 8 * 48, TR_T2 = 4 * 64, TR_T3 = 1024, TR_T4 = 32 * 64, TR_T5 = 1024, TR_T6 = 1024;
constexpr int TR_TOTAL = TR_T0 + TR_T1 + TR_T2 + TR_T3 + TR_T4 + TR_T5 + TR_T6;
constexpr int U_MOD = 96, U_RS0 = TOK / 4, U_KTAB = 64 * 63, U_OPS = 64 * 2 * 64 * 32 / 256;
constexpr int PREP_UNITS = TR_TOTAL + U_MOD + U_RS0 + U_KTAB + U_OPS;

DI void phase_prep(const Params& p, char* smem) {
  for (int u = blockIdx.x; u < PREP_UNITS; u += gridDim.x) {
    int v = u;
    if (v < U_MOD) { prep_mod(p, v, smem); continue; }
    v -= U_MOD;
    if (v < TR_TOTAL) {
      int w = 0;
      if (v >= TR_T0) { v -= TR_T0; w = 1;
        if (v >= TR_T1) { v -= TR_T1; w = 2;
          if (v >= TR_T2) { v -= TR_T2; w = 3;
            if (v >= TR_T3) { v -= TR_T3; w = 4;
              if (v >= TR_T4) { v -= TR_T4; w = 5;
                if (v >= TR_T5) { v -= TR_T5; w = 6; } } } } } }
      prep_transpose(p, w, v, smem);
      continue;
    }
    v -= TR_TOTAL;
    if (v < U_RS0) { prep_rs0(p, v); continue; }
    v -= U_RS0;
    if (v < U_KTAB) { prep_ktab(p, v, smem); continue; }
    v -= U_KTAB;
    prep_ops(p, v);
  }
}

DI void phase_n1(const Params& p) {
  const float* W = p.in[I_WIN0];
  const float* rs0 = (const float*)(p.ws + O_RS0);
  const float* ng = p.in[I_NORMG];
  const size_t total = (size_t)TOK * NIN0;
  for (size_t idx = (size_t)blockIdx.x * 256 + threadIdx.x; idx < total; idx += (size_t)gridDim.x * 256) {
    int tok = (int)(idx / NIN0), n = (int)(idx - (size_t)tok * NIN0);
    int b = tok / LALL, pos = tok - b * LALL;
    bool lat = pos >= LC;
    const float* xr = xrow0(p, tok);
    const float* md = modrow(p, 0, tok);
    float rs = rs0[tok];
    bool rope = lat && n >= 384 && n < 416;
    int n2 = rope ? (n ^ 8) : n;
    float acc = 0.f, acc2 = 0.f;
    for (int k = 0; k < 1024; ++k) {
      float h = xr[k] * rs * ng[k] * (1.f + md[1024 + k]) + md[k];
      acc += h * W[(size_t)k * NIN0 + n];
      acc2 += h * W[(size_t)k * NIN0 + n2];
    }
    if (n < 384) {
      ((bfr*)(p.ws + O_PC))[(size_t)tok * 384 + n] = f2bf(acc);
    } else if (n < 416) {
      int j = n - 384;
      float v = rope ? rope_apply(j, acc, acc2, pos - LC) : acc;
      bfr bv = f2bf(v);
      bfr* K = (bfr*)(p.ws + O_K);
      for (int h = 0; h < NH; ++h) K[(((size_t)(b * NH + h)) * LALL + pos) * DQK + 64 + j] = bv;
    } else {
      ((bfr*)(p.ws + O_SZ0))[(size_t)tok * 1024 + (n - 416)] = f2bf(silu_f(acc));
    }
  }
}

DI void phase_n2(const Params& p) {
  const int NTOT = 1536 + 2048;
  const bfr* PC = (const bfr*)(p.ws + O_PC);
  const size_t total = (size_t)TOK * NTOT;
  bfr* Q = (bfr*)p.out;
  bfr* K = (bfr*)(p.ws + O_K);
  bfr* VT = (bfr*)(p.ws + O_VT);
  for (size_t idx = (size_t)blockIdx.x * 256 + threadIdx.x; idx < total; idx += (size_t)gridDim.x * 256) {
    int tok = (int)(idx / NTOT), n = (int)(idx - (size_t)tok * NTOT);
    int b = tok / LALL, pos = tok - b * LALL;
    bool lat = pos >= LC;
    if (n < 1536) {
      int h = n / 96, d = n - h * 96;
      bool rope = lat && d >= 64;
      int n2 = rope ? (n ^ 8) : n;
      const float* W = p.in[I_WUQ];
      const float* qn = p.in[I_QNORM];
      float acc = 0.f, acc2 = 0.f, ss = 0.f;
      for (int k = 0; k < 256; ++k) {
        float a = bf2f(PC[(size_t)tok * 384 + k]);
        ss += a * a;
        float aw = a * qn[k];
        acc += aw * W[(size_t)k * 1536 + n];
        acc2 += aw * W[(size_t)k * 1536 + n2];
      }
      float r = rsqrtf(ss * (1.f / 256.f) + EPS);
      acc *= r; acc2 *= r;
      float v = rope ? rope_apply(d - 64, acc, acc2, pos - LC) : acc;
      Q[(((size_t)(b * NH + h)) * LALL + pos) * DQK + d] = f2bf(v * QSCALE);
    } else {
      int n3 = n - 1536;
      int h = n3 / 128, d = n3 - h * 128;
      const float* W = p.in[I_WUKV];
      const float* kn = p.in[I_KVNORM];
      float acc = 0.f, ss = 0.f;
      for (int k = 0; k < 128; ++k) {
        float a = bf2f(PC[(size_t)tok * 384 + 256 + k]);
        ss += a * a;
        acc += a * kn[k] * W[(size_t)k * 2048 + n3];
      }
      acc *= rsqrtf(ss * (1.f / 128.f) + EPS);
      if (d < 64) K[(((size_t)(b * NH + h)) * LALL + pos) * DQK + d] = f2bf(acc);
      else VT[(((size_t)(b * NH + h)) * DV + (d - 64)) * LALL + pos] = f2bf(acc);
    }
  }
}

DI void phase_n3(const Params& p) {
  const bfr* Q = (const bfr*)p.out;
  const bfr* K = (const bfr*)(p.ws + O_K);
  const bfr* VT = (const bfr*)(p.ws + O_VT);
  const bfr* SZ = (const bfr*)(p.ws + O_SZ0);
  bfr* OG = (bfr*)(p.ws + O_OG);
  int lane = threadIdx.x & 63;
  const int total = NB * NH * LALL;
  for (int w = blockIdx.x * 4 + (threadIdx.x >> 6); w < total; w += gridDim.x * 4) {
    int bh = w / LALL, pos = w - bh * LALL;
    int b = bh / NH, h = bh - b * NH;
    int nk = pos < LC ? LC : LALL;
    const bfr* q = Q + ((size_t)bh * LALL + pos) * DQK;
    const bfr* kb = K + (size_t)bh * LALL * DQK;
    const bfr* vb = VT + (size_t)bh * DV * LALL;
    float s[36];
    float mx = -1e30f;
#pragma unroll
    for (int i = 0; i < 36; ++i) {
      int key = i * 64 + lane;
      float a = -1e30f;
      if (key < nk) {
        a = 0.f;
        const bfr* kr = kb + (size_t)key * DQK;
        for (int d = 0; d < DQK; ++d) a += bf2f(q[d]) * bf2f(kr[d]);
      }
      s[i] = a;
      mx = fmaxf(mx, a);
    }
    mx = wave_max(mx);
    float l = 0.f;
    float o[64];
#pragma unroll
    for (int d = 0; d < 64; ++d) o[d] = 0.f;
#pragma unroll
    for (int i = 0; i < 36; ++i) {
      int key = i * 64 + lane;
      if (key < nk) {
        float pr = exp2f(s[i] - mx);
        l += pr;
#pragma unroll
        for (int d = 0; d < 64; ++d) o[d] += pr * bf2f(vb[(size_t)d * LALL + key]);
      }
    }
    l = wave_sum(l);
    float mine = 0.f;
#pragma unroll
    for (int d = 0; d < 64; ++d) {
      float t = wave_sum(o[d]);
      if (lane == d) mine = t;
    }
    int tok = b * LALL + pos;
    float z = bf2f(SZ[(size_t)tok * 1024 + h * 64 + lane]);
    OG[(size_t)tok * 1024 + h * 64 + lane] = f2bf(mine / l * z);
  }
}

DI void phase_n4(const Params& p) {
  const float* W = p.in[I_WOUT0];
  const bfr* OG = (const bfr*)(p.ws + O_OG);
  const size_t total = (size_t)TOK * 1024;
  for (size_t idx = (size_t)blockIdx.x * 256 + threadIdx.x; idx < total; idx += (size_t)gridDim.x * 256) {
    int tok = (int)(idx >> 10), n = (int)(idx & 1023);
    float acc = 0.f;
    for (int k = 0; k < 1024; ++k) acc += bf2f(OG[(size_t)tok * 1024 + k]) * W[(size_t)k * 1024 + n];
    float v = xrow0(p, tok)[n] + modrow(p, 0, tok)[2048 + n] * acc;
    xrow1(p, tok)[n] = v;
  }
}

DI void phase_rowsq(const Params& p, int layer) {
  int lane = threadIdx.x & 63;
  int nrows = layer == 1 ? TOK : NLAT;
  float* part = (float*)(p.ws + (layer == 1 ? O_PART1 : O_PART2));
  for (int r = blockIdx.x * 4 + (threadIdx.x >> 6); r < nrows; r += gridDim.x * 4) {
    const float4* row = (const float4*)(layer == 1 ? xrow1(p, r) : p.out + (size_t)r * D);
    float s = 0.f;
#pragma unroll
    for (int i = 0; i < 4; ++i) {
      float4 v = row[lane + 64 * i];
      s += v.x * v.x + v.y * v.y + v.z * v.z + v.w * v.w;
    }
    s = wave_sum(s);
    if (lane < 16) part[(size_t)lane * nrows + r] = lane == 0 ? s : 0.f;
  }
}
DI float rs_from_part(const float* part, int nrows, int r) {
  float s = 0.f;
#pragma unroll
  for (int j = 0; j < 16; ++j) s += part[(size_t)j * nrows + r];
  return rsqrtf(s * (1.f / 1024.f) + EPS);
}

DI void phase_n5(const Params& p) {
  const float* W = p.in[I_WIN1];
  const float* ng = p.in[I_NORMG] + 1024;
  const float* part = (const float*)(p.ws + O_PART1);
  bfr* U2 = (bfr*)(p.ws + O_U2);
  bfr* SZ1 = (bfr*)(p.ws + O_SZ1);
  const size_t total = (size_t)TOK * NIN1;
  for (size_t idx = (size_t)blockIdx.x * 256 + threadIdx.x; idx < total; idx += (size_t)gridDim.x * 256) {
    int tok = (int)(idx >> 11), n = (int)(idx & 2047);
    int b = tok / LALL, pos = tok - b * LALL;
    bool lat = pos >= LC;
    if (!lat && n >= 1024) continue;
    const float* xr = xrow1(p, tok);
    const float* md = modrow(p, 1, tok);
    float rs = rs_from_part(part, TOK, tok);
    float acc = 0.f;
    for (int k = 0; k < 1024; ++k) {
      float h = xr[k] * rs * ng[k] * (1.f + md[1024 + k]) + md[k];
      acc += h * W[(size_t)k * NIN1 + n];
    }
    if (n < 1024) U2[((size_t)(n >> 4) * TOK + tok) * 16 + (n & 15)] = f2bf(acc);
    else SZ1[((size_t)(b * SEQ + pos - LC)) * 1024 + (n - 1024)] = f2bf(silu_f(acc));
  }
}

DI void phase_n6(const Params& p, int dir) {
  int lane = threadIdx.x & 63;
  const bfr* U2 = (const bfr*)(p.ws + O_U2);
  bfr* YF = (bfr*)(p.ws + O_Y2);
  bfr* YG = (bfr*)(p.ws + O_YG);
  for (int w = blockIdx.x * 4 + (threadIdx.x >> 6); w < NB * 64; w += gridDim.x * 4) {
    int b = w >> 6, g = w & 63;
    double dt, ar, ai;
    float fr, fi, lr, li;
    s5_disc(p, dir, g, lane, dt, ar, ai, fr, fi);
    s5_pow(dt, ar, ai, 1, lr, li);
    float bbr[16], bbi[16], ccr[16], cci[16];
    const float* bre = p.in[I_BRE] + (((size_t)(dir * 64 + g)) * 64 + lane) * 16;
    const float* bim = p.in[I_BIM] + (((size_t)(dir * 64 + g)) * 64 + lane) * 16;
    const float* cre = p.in[I_CRE] + ((size_t)(dir * 64 + g)) * 16 * 64;
    const float* cim = p.in[I_CIM] + ((size_t)(dir * 64 + g)) * 16 * 64;
#pragma unroll
    for (int c = 0; c < 16; ++c) {
      float br = bre[c], bi = bim[c];
      bbr[c] = fr * br - fi * bi;
      bbi[c] = fr * bi + fi * br;
      ccr[c] = cre[c * 64 + lane];
      cci[c] = cim[c * 64 + lane];
    }
    float sr = 0.f, si = 0.f;
    const bfr* ub = U2 + ((size_t)g * TOK + (size_t)b * LALL) * 16;
    for (int step = 0; step < LALL; ++step) {
      int pos = dir == 0 ? step : (step < LC ? (LC - 1 - step) : (LALL - 1 - (step - LC)));
      const bfr* ur = ub + (size_t)pos * 16;
      float ur_f[16];
      float br = 0.f, bi = 0.f;
#pragma unroll
      for (int c = 0; c < 16; ++c) {
        float uv = bf2f(ur[c]);
        ur_f[c] = uv;
        br += bbr[c] * uv;
        bi += bbi[c] * uv;
      }
      float nr = lr * sr - li * si + br;
      float ni = lr * si + li * sr + bi;
      sr = nr; si = ni;
      if (pos >= LC) {
        float mine = 0.f, myu = 0.f;
#pragma unroll
        for (int c = 0; c < 16; ++c) {
          float t = wave_sum(ccr[c] * sr - cci[c] * si);
          if (lane == c) { mine = t; myu = ur_f[c]; }
        }
        if (lane < 16) {
          size_t o = ((size_t)(b * SEQ + pos - LC)) * 1024 + g * 16 + lane;
          if (dir == 0) YF[o] = f2bf(mine);
          else {
            float y = bf2f(YF[o]) + mine + p.in[I_S5D][g * 16 + lane] * myu;
            YG[o] = f2bf(gelu_tanh(y));
          }
        }
      }
    }
  }
}

DI void phase_n9(const Params& p) {
  const float* W = p.in[I_WGLU];
  const bfr* YG = (const bfr*)(p.ws + O_YG);
  const bfr* SZ1 = (const bfr*)(p.ws + O_SZ1);
  bfr* Y2 = (bfr*)(p.ws + O_Y2);
  const size_t total = (size_t)NLAT * 1024;
  for (size_t idx = (size_t)blockIdx.x * 256 + threadIdx.x; idx < total; idx += (size_t)gridDim.x * 256) {
    int lt = (int)(idx >> 10), n = (int)(idx & 1023);
    float acc = p.in[I_BGLU][n];
    for (int k = 0; k < 1024; ++k) acc += bf2f(YG[(size_t)lt * 1024 + k]) * W[(size_t)k * 1024 + n];
    float y = bf2f(YG[idx]);
    Y2[idx] = f2bf(y * sigmoid_f(acc) * bf2f(SZ1[idx]));
  }
}

DI void phase_n10(const Params& p) {
  const float* W = p.in[I_WOUT1];
  const bfr* Y2 = (const bfr*)(p.ws + O_Y2);
  const float* mod = (const float*)(p.ws + O_MOD);
  const size_t total = (size_t)NLAT * 1024;
  for (size_t idx = (size_t)blockIdx.x * 256 + threadIdx.x; idx < total; idx += (size_t)gridDim.x * 256) {
    int lt = (int)(idx >> 10), n = (int)(idx & 1023);
    int b = lt >> 11;
    float acc = 0.f;
    for (int k = 0; k < 1024; ++k) acc += bf2f(Y2[(size_t)lt * 1024 + k]) * W[(size_t)k * 1024 + n];
    p.out[idx] = p.out[idx] + mod[((size_t)(9 + b)) * 3072 + 2048 + n] * acc;
  }
}

DI void phase_final(const Params& p) {
  const int tidx_ = opaque_tid();
  const float* part = (const float*)(p.ws + O_PART2);
  const float* fg = p.in[I_FINALG];
  int lane = tidx_ & 63;
  for (int r = blockIdx.x * 4 + (tidx_ >> 6); r < NLAT; r += gridDim.x * 4) {
    float rs = rs_from_part(part, NLAT, r);
    float4* row = (float4*)(p.out + (size_t)r * D);
    const float4* g4 = (const float4*)fg;
#pragma unroll
    for (int i = 0; i < 4; ++i) {
      float4 v = row[lane + 64 * i];
      float4 g = g4[lane + 64 * i];
      v.x *= rs * g.x; v.y *= rs * g.y; v.z *= rs * g.z; v.w *= rs * g.w;
      row[lane + 64 * i] = v;
    }
  }
}

typedef short bf16x8 __attribute__((ext_vector_type(8)));
typedef short s16x4 __attribute__((ext_vector_type(4)));
typedef float f32x16 __attribute__((ext_vector_type(16)));
typedef __bf16 bf2_t __attribute__((ext_vector_type(2)));
typedef float f2_t __attribute__((ext_vector_type(2)));
DI unsigned pk2(float a, float b) {
  f2_t v = {a, b};
  bf2_t r = __builtin_convertvector(v, bf2_t);
  return __builtin_bit_cast(unsigned, r);
}
#define SCHED_FENCE() __builtin_amdgcn_sched_barrier(0)
#define MFMA32(a, b, c) __builtin_amdgcn_mfma_f32_32x32x16_bf16((a), (b), (c), 0, 0, 0)
DI int crow(int i, int h) { return (i & 3) + 8 * (i >> 2) + 4 * h; }

constexpr int LDT = 72;
struct GemmSmem {
  bfr A[128 * LDT];
  bfr B[128 * LDT];
  float gs[1024];
  float sh[1024];
  float rs[128];
};
static_assert(sizeof(GemmSmem) <= SMEM_BYTES, "smem");

DI void zero_acc(f32x16 (&acc)[2][2]) {
#pragma unroll
  for (int a = 0; a < 2; ++a)
#pragma unroll
    for (int b = 0; b < 2; ++b)
#pragma unroll
      for (int i = 0; i < 16; ++i) acc[a][b][i] = 0.f;
}

template <bool AF32, class AAddr, class BAddr>
DI void gemm_main(f32x16 (&acc)[2][2], int KT, AAddr aaddr, BAddr baddr, GemmSmem* sm) {
  const int tid = opaque_tid(), lane = tid & 63, wave = tid >> 6;
  const int wm = wave >> 1, wn = wave & 1, r = lane & 31, h = lane >> 5;
  uint4 bv0, bv1, bv2, bv3, av0, av1, av2, av3;
  float4 af0, af1, af2, af3, af4, af5, af6, af7;
  const int lrow = tid >> 3, lkc = (tid & 7) * 8;
  const int frow = tid >> 4, fkc = (tid & 15) * 4;
#define GM_LOAD(KT_)                                                                     \
  {                                                                                      \
    const int kk_ = (KT_) * 64;                                                          \
    bv0 = *(const uint4*)baddr(lrow, kk_ + lkc);                                         \
    bv1 = *(const uint4*)baddr(lrow + 32, kk_ + lkc);                                    \
    bv2 = *(const uint4*)baddr(lrow + 64, kk_ + lkc);                                    \
    bv3 = *(const uint4*)baddr(lrow + 96, kk_ + lkc);                                    \
    if constexpr (AF32) {                                                                \
      af0 = *(const float4*)(aaddr(frow) + kk_ + fkc);                                   \
      af1 = *(const float4*)(aaddr(frow + 16) + kk_ + fkc);                              \
      af2 = *(const float4*)(aaddr(frow + 32) + kk_ + fkc);                              \
      af3 = *(const float4*)(aaddr(frow + 48) + kk_ + fkc);                              \
      af4 = *(const float4*)(aaddr(frow + 64) + kk_ + fkc);                              \
      af5 = *(const float4*)(aaddr(frow + 80) + kk_ + fkc);                              \
      af6 = *(const float4*)(aaddr(frow + 96) + kk_ + fkc);                              \
      af7 = *(const float4*)(aaddr(frow + 112) + kk_ + fkc);                             \
    } else {                                                                             \
      av0 = *(const uint4*)aaddr(lrow, kk_ + lkc);                                       \
      av1 = *(const uint4*)aaddr(lrow + 32, kk_ + lkc);                                  \
      av2 = *(const uint4*)aaddr(lrow + 64, kk_ + lkc);                                  \
      av3 = *(const uint4*)aaddr(lrow + 96, kk_ + lkc);                                  \
    }                                                                                    \
  }
#define GM_STF(AF_, ROW_)                                                                \
  {                                                                                      \
    float rr_ = sm->rs[ROW_];                                                            \
    uint2 o_;                                                                            \
    o_.x = pk2(AF_.x * rr_ * g_.x + s_.x, AF_.y * rr_ * g_.y + s_.y);                    \
    o_.y = pk2(AF_.z * rr_ * g_.z + s_.z, AF_.w * rr_ * g_.w + s_.w);                    \
    *(uint2*)(sm->A + (ROW_) * LDT + fkc) = o_;                                          \
  }
#define GM_STORE(KT_)                                                                    \
  {                                                                                      \
    *(uint4*)(sm->B + lrow * LDT + lkc) = bv0;                                           \
    *(uint4*)(sm->B + (lrow + 32) * LDT + lkc) = bv1;                                    \
    *(uint4*)(sm->B + (lrow + 64) * LDT + lkc) = bv2;                                    \
    *(uint4*)(sm->B + (lrow + 96) * LDT + lkc) = bv3;                                    \
    if constexpr (AF32) {                                                                \
      const int k_ = (KT_) * 64 + fkc;                                                   \
      const float4 g_ = *(const float4*)(sm->gs + k_);                                   \
      const float4 s_ = *(const float4*)(sm->sh + k_);                                   \
      GM_STF(af0, frow) GM_STF(af1, frow + 16) GM_STF(af2, frow + 32) GM_STF(af3, frow + 48) \
      GM_STF(af4, frow + 64) GM_STF(af5, frow + 80) GM_STF(af6, frow + 96) GM_STF(af7, frow + 112) \
    } else {                                                                             \
      *(uint4*)(sm->A + lrow * LDT + lkc) = av0;                                         \
      *(uint4*)(sm->A + (lrow + 32) * LDT + lkc) = av1;                                  \
      *(uint4*)(sm->A + (lrow + 64) * LDT + lkc) = av2;                                  \
      *(uint4*)(sm->A + (lrow + 96) * LDT + lkc) = av3;                                  \
    }                                                                                    \
  }
  GM_LOAD(0)
  for (int kt = 0; kt < KT; ++kt) {
    GM_STORE(kt)
    __syncthreads();
    if (kt + 1 < KT) GM_LOAD(kt + 1)
    SCHED_FENCE();
#pragma unroll
    for (int ks = 0; ks < 4; ++ks) {
      bf16x8 a[2], b[2];
#pragma unroll
      for (int mi = 0; mi < 2; ++mi) a[mi] = *(const bf16x8*)(sm->A + (wm * 64 + mi * 32 + r) * LDT + ks * 16 + h * 8);
#pragma unroll
      for (int ni = 0; ni < 2; ++ni) b[ni] = *(const bf16x8*)(sm->B + (wn * 64 + ni * 32 + r) * LDT + ks * 16 + h * 8);
#pragma unroll
      for (int mi = 0; mi < 2; ++mi)
#pragma unroll
        for (int ni = 0; ni < 2; ++ni) acc[mi][ni] = MFMA32(a[mi], b[ni], acc[mi][ni]);
    }
    __syncthreads();
  }
}

DI float transpose_reduce16(float (&v)[16], int lane) {
  float r8[8], r4[4], r2[2];
  {
    bool up = lane & 8;
#pragma unroll
    for (int i = 0; i < 8; ++i) {
      float send = up ? v[i] : v[i + 8];
      float keep = up ? v[i + 8] : v[i];
      r8[i] = keep + __shfl_xor(send, 8);
    }
  }
  {
    bool up = lane & 4;
#pragma unroll
    for (int i = 0; i < 4; ++i) {
      float send = up ? r8[i] : r8[i + 4];
      float keep = up ? r8[i + 4] : r8[i];
      r4[i] = keep + __shfl_xor(send, 4);
    }
  }
  {
    bool up = lane & 2;
#pragma unroll
    for (int i = 0; i < 2; ++i) {
      float send = up ? r4[i] : r4[i + 2];
      float keep = up ? r4[i + 2] : r4[i];
      r2[i] = keep + __shfl_xor(send, 2);
    }
  }
  bool up = lane & 1;
  float send = up ? r2[0] : r2[1];
  float keep = up ? r2[1] : r2[0];
  return keep + __shfl_xor(send, 1);
}

#define WAVE_IDS                                              \
  const int tid = opaque_tid(), lane = tid & 63, wave = tid >> 6; \
  const int wm = wave >> 1, wn = wave & 1, r = lane & 31, h = lane >> 5; \
  (void)wm; (void)wn; (void)r; (void)h;

DI void phase_o1(const Params& p, char* smem) {
  GemmSmem* sm = (GemmSmem*)smem;
  WAVE_IDS
  const int NT = 12, units = (TOK / 128) * NT;
  const bfr* WT = (const bfr*)(p.ws + O_WT_IN0);
  const float* RS0 = (const float*)(p.ws + O_RS0);
  bfr* PC = (bfr*)(p.ws + O_PC);
  bfr* SZ0 = (bfr*)(p.ws + O_SZ0);
  bfr* Kb = (bfr*)(p.ws + O_K);
  for (int u = blockIdx.x; u < units; u += gridDim.x) {
    int mt = u / NT, nt = u - mt * NT;
    int m0 = mt * 128, n0 = nt * 128;
    __syncthreads();
    const float* md = modrow(p, 0, m0);
    const float* ng = p.in[I_NORMG];
    for (int k = tid; k < 1024; k += 256) {
      sm->gs[k] = ng[k] * (1.f + md[1024 + k]);
      sm->sh[k] = md[k];
    }
    if (tid < 128) sm->rs[tid] = RS0[m0 + tid];
    __syncthreads();
    const float* abase = xrow0(p, m0);
    f32x16 acc[2][2];
    zero_acc(acc);
    gemm_main<true>(
        acc, 16, [&](int row) { return abase + (size_t)row * 1024; },
        [&](int row, int k) {
          int n = n0 + row;
          n = n < NIN0 ? n : NIN0 - 1;
          return WT + (size_t)n * 1024 + k;
        },
        sm);
    int b = m0 / LALL, pos0 = m0 - b * LALL;
    bool lat = pos0 >= LC;
#pragma unroll
    for (int mi = 0; mi < 2; ++mi)
#pragma unroll
      for (int ni = 0; ni < 2; ++ni) {
        int col0 = n0 + wn * 64 + ni * 32;
        if (col0 >= NIN0) continue;
        int col = col0 + r;
#pragma unroll
        for (int i = 0; i < 16; ++i) {
          int row = wm * 64 + mi * 32 + crow(i, h);
          int tok = m0 + row;
          float v = acc[mi][ni][i];
          if (col0 < 384) {
            PC[(size_t)tok * 384 + col] = f2bf(v);
          } else if (col0 == 384) {
            float vp = __shfl_xor(v, 8);
            int pos = pos0 + row;
            float val = lat ? rope_apply(r, v, vp, pos - LC) : v;
            bfr bv = f2bf(val);
            for (int hh = 0; hh < NH; ++hh) Kb[(((size_t)(b * NH + hh)) * LALL + pos) * DQK + 64 + r] = bv;
          } else {
            SZ0[(size_t)tok * 1024 + (col - 416)] = f2bf(silu_f(v));
          }
          SCHED_FENCE();
        }
      }
  }
}

DI void phase_o2(const Params& p, char* smem) {
  GemmSmem* sm = (GemmSmem*)smem;
  WAVE_IDS
  const int UQ = (TOK / 128) * 12, UKV = (TOK / 128) * 16;
  const bfr* PC = (const bfr*)(p.ws + O_PC);
  bfr* Q = (bfr*)p.out;
  bfr* Kb = (bfr*)(p.ws + O_K);
  bfr* VT = (bfr*)(p.ws + O_VT);
  for (int u = blockIdx.x; u < UQ + UKV; u += gridDim.x) {
    bool isq = u < UQ;
    int uu = isq ? u : u - UQ;
    int NT = isq ? 12 : 16;
    int mt = uu / NT, nt = uu - mt * NT;
    int m0 = mt * 128, n0 = nt * 128;
    int Kd = isq ? 256 : 128;
    int aoff = isq ? 0 : 256;
    const bfr* WT = (const bfr*)(p.ws + (isq ? O_WT_UQ : O_WT_UKV));
    __syncthreads();
    {
      int row = tid >> 1, half = tid & 1;
      const bfr* ap = PC + (size_t)(m0 + row) * 384 + aoff + half * (Kd / 2);
      float ss = 0.f;
      for (int j = 0; j < Kd / 16; ++j) {
        uint4 v = *(const uint4*)(ap + j * 8);
        unsigned w[4] = {v.x, v.y, v.z, v.w};
#pragma unroll
        for (int e = 0; e < 4; ++e) {
          float lo = __uint_as_float(w[e] << 16), hi = __uint_as_float(w[e] & 0xffff0000u);
          ss += lo * lo + hi * hi;
        }
      }
      ss += __shfl_xor(ss, 1);
      if (half == 0) sm->rs[row] = rsqrtf(ss / (float)Kd + EPS);
    }
    __syncthreads();
    f32x16 acc[2][2];
    zero_acc(acc);
    gemm_main<false>(
        acc, Kd / 64, [&](int row, int k) { return PC + (size_t)(m0 + row) * 384 + aoff + k; },
        [&](int row, int k) { return WT + (size_t)(n0 + row) * Kd + k; }, sm);
    int b = m0 / LALL, pos0 = m0 - b * LALL;
    bool lat = pos0 >= LC;
#pragma unroll
    for (int mi = 0; mi < 2; ++mi)
#pragma unroll
      for (int ni = 0; ni < 2; ++ni) {
        int col0 = n0 + wn * 64 + ni * 32;
        if (isq) {
          int hh = col0 / 96, d0 = col0 - hh * 96;
          bool rope = lat && d0 == 64;
#pragma unroll
          for (int i = 0; i < 16; ++i) {
            int row = wm * 64 + mi * 32 + crow(i, h);
            int pos = pos0 + row;
            float v = acc[mi][ni][i] * sm->rs[row];
            float vp = __shfl_xor(v, 8);
            float val = rope ? rope_apply(r, v, vp, pos - LC) : v;
            Q[(((size_t)(b * NH + hh)) * LALL + pos) * DQK + d0 + r] = f2bf(val * QSCALE);
            SCHED_FENCE();
          }
        } else {
          int hh = col0 >> 7, d0 = col0 & 127;
          if (d0 < 64) {
#pragma unroll
            for (int i = 0; i < 16; ++i) {
              int row = wm * 64 + mi * 32 + crow(i, h);
              int pos = pos0 + row;
              float v = acc[mi][ni][i] * sm->rs[row];
              Kb[(((size_t)(b * NH + hh)) * LALL + pos) * DQK + d0 + r] = f2bf(v);
              SCHED_FENCE();
            }
          } else {
            int dvv = d0 - 64 + r;
#pragma unroll
            for (int g4 = 0; g4 < 4; ++g4) {
              int row = wm * 64 + mi * 32 + 8 * g4 + 4 * h;
              int pos = pos0 + row;
              uint2 o;
              o.x = pk2(acc[mi][ni][4 * g4 + 0] * sm->rs[row + 0], acc[mi][ni][4 * g4 + 1] * sm->rs[row + 1]);
              o.y = pk2(acc[mi][ni][4 * g4 + 2] * sm->rs[row + 2], acc[mi][ni][4 * g4 + 3] * sm->rs[row + 3]);
              *(uint2*)(VT + (((size_t)(b * NH + hh)) * DV + dvv) * LALL + pos) = o;
            }
          }
        }
      }
  }
}

constexpr int KLD = 104;
constexpr int VLD = 68;
struct AttnSmem {
  bfr K[64 * KLD];
  bfr V[64 * VLD];
};
static_assert(sizeof(AttnSmem) <= SMEM_BYTES, "smem");

DI void attn_item(const Params& p, AttnSmem* sm, int bh, int qpos0, int nkeys) {
  WAVE_IDS
  const bfr* Q = (const bfr*)p.out;
  const bfr* Kg = (const bfr*)(p.ws + O_K) + (size_t)bh * LALL * DQK;
  const bfr* Vg = (const bfr*)(p.ws + O_VT) + (size_t)bh * DV * LALL;
  const int qpos = qpos0 + wave * 32 + r;
  bf16x8 bq[6];
  {
    const bfr* qp = Q + ((size_t)bh * LALL + qpos) * DQK + 8 * h;
#pragma unroll
    for (int s = 0; s < 6; ++s) bq[s] = *(const bf16x8*)(qp + 16 * s);
  }
  f32x16 o[2];
#pragma unroll
  for (int d = 0; d < 2; ++d)
#pragma unroll
    for (int i = 0; i < 16; ++i) o[d][i] = 0.f;
  float mrun = -1e30f, lrun = 0.f;
  uint4 kv0, kv1, kv2, vv0, vv1;
  const int kr0 = tid / 12, kc0 = (tid - kr0 * 12) * 8;
  const int kr1 = (tid + 256) / 12, kc1 = (tid + 256 - kr1 * 12) * 8;
  const int kr2 = (tid + 512) / 12, kc2 = (tid + 512 - kr2 * 12) * 8;
  const int vr0 = tid >> 3, vc0 = (tid & 7) * 8;
#define AT_GLOAD(KEY0_)                                                          \
  {                                                                              \
    const int key0_ = (KEY0_);                                                   \
    kv0 = *(const uint4*)(Kg + (size_t)(key0_ + kr0) * DQK + kc0);               \
    kv1 = *(const uint4*)(Kg + (size_t)(key0_ + kr1) * DQK + kc1);               \
    kv2 = *(const uint4*)(Kg + (size_t)(key0_ + kr2) * DQK + kc2);               \
    vv0 = *(const uint4*)(Vg + (size_t)vr0 * LALL + key0_ + vc0);                \
    vv1 = *(const uint4*)(Vg + (size_t)(vr0 + 32) * LALL + key0_ + vc0);         \
  }
#define AT_LSTORE()                                                              \
  {                                                                              \
    *(uint4*)(sm->K + kr0 * KLD + kc0) = kv0;                                    \
    *(uint4*)(sm->K + kr1 * KLD + kc1) = kv1;                                    \
    *(uint4*)(sm->K + kr2 * KLD + kc2) = kv2;                                    \
    uint2* d0_ = (uint2*)(sm->V + vr0 * VLD + vc0);                              \
    d0_[0] = make_uint2(vv0.x, vv0.y);                                           \
    d0_[1] = make_uint2(vv0.z, vv0.w);                                           \
    uint2* d1_ = (uint2*)(sm->V + (vr0 + 32) * VLD + vc0);                       \
    d1_[0] = make_uint2(vv1.x, vv1.y);                                           \
    d1_[1] = make_uint2(vv1.z, vv1.w);                                           \
  }
  const int NTI = nkeys / 64;
  AT_GLOAD(0)
  for (int it = 0; it < NTI; ++it) {
    AT_LSTORE()
    __syncthreads();
    if (it + 1 < NTI) AT_GLOAD((it + 1) * 64)
    SCHED_FENCE();
    f32x16 st[2];
#pragma unroll
    for (int kb = 0; kb < 2; ++kb) {
#pragma unroll
      for (int i = 0; i < 16; ++i) st[kb][i] = 0.f;
#pragma unroll
      for (int s = 0; s < 6; ++s) {
        bf16x8 ka = *(const bf16x8*)(sm->K + (kb * 32 + r) * KLD + 16 * s + 8 * h);
        st[kb] = MFMA32(ka, bq[s], st[kb]);
      }
    }
    float mx = st[0][0];
#pragma unroll
    for (int kb = 0; kb < 2; ++kb)
#pragma unroll
      for (int i = 0; i < 16; ++i) mx = fmaxf(mx, st[kb][i]);
    mx = fmaxf(mx, __shfl_xor(mx, 32));
    float mnew = fmaxf(mrun, mx);
    float alpha = exp2f(mrun - mnew);
    mrun = mnew;
    float ps = 0.f;
#pragma unroll
    for (int kb = 0; kb < 2; ++kb)
#pragma unroll
      for (int i = 0; i < 16; ++i) {
        float e = exp2f(st[kb][i] - mnew);
        st[kb][i] = e;
        ps += e;
      }
    lrun = lrun * alpha + ps;
#pragma unroll
    for (int d = 0; d < 2; ++d)
#pragma unroll
      for (int i = 0; i < 16; ++i) o[d][i] *= alpha;
#pragma unroll
    for (int kb = 0; kb < 2; ++kb)
#pragma unroll
      for (int s2 = 0; s2 < 2; ++s2) {
        unsigned pw[4];
#pragma unroll
        for (int j = 0; j < 4; ++j) pw[j] = pk2(st[kb][8 * s2 + 2 * j], st[kb][8 * s2 + 2 * j + 1]);
        bf16x8 pb;
        {
          uint4 t = make_uint4(pw[0], pw[1], pw[2], pw[3]);
          pb = __builtin_bit_cast(bf16x8, t);
        }
#pragma unroll
        for (int d = 0; d < 2; ++d) {
          const bfr* vp = sm->V + (d * 32 + r) * VLD + kb * 32 + 16 * s2 + 4 * h;
          uint2 lo = *(const uint2*)vp;
          uint2 hi = *(const uint2*)(vp + 8);
          uint4 t = make_uint4(lo.x, lo.y, hi.x, hi.y);
          bf16x8 va = __builtin_bit_cast(bf16x8, t);
          o[d] = MFMA32(va, pb, o[d]);
        }
      }
    __syncthreads();
  }
  float ltot = lrun + __shfl_xor(lrun, 32);
  float inv = 1.f / ltot;
  int b = bh / NH, hh = bh - b * NH;
  size_t tok = (size_t)b * LALL + qpos;
  const bfr* SZ = (const bfr*)(p.ws + O_SZ0) + tok * 1024 + hh * 64;
  bfr* OG = (bfr*)(p.ws + O_OG) + tok * 1024 + hh * 64;
#pragma unroll
  for (int d = 0; d < 2; ++d)
#pragma unroll
    for (int g4 = 0; g4 < 4; ++g4) {
      int dv0 = d * 32 + 8 * g4 + 4 * h;
      uint2 z = *(const uint2*)(SZ + dv0);
      float z0 = __uint_as_float(z.x << 16), z1 = __uint_as_float(z.x & 0xffff0000u);
      float z2 = __uint_as_float(z.y << 16), z3 = __uint_as_float(z.y & 0xffff0000u);
      uint2 ov;
      ov.x = pk2(o[d][4 * g4 + 0] * inv * z0, o[d][4 * g4 + 1] * inv * z1);
      ov.y = pk2(o[d][4 * g4 + 2] * inv * z2, o[d][4 * g4 + 3] * inv * z3);
      *(uint2*)(OG + dv0) = ov;
    }
}

DI void phase_o3(const Params& p, char* smem) {
  AttnSmem* sm = (AttnSmem*)smem;
  const int xcd = blockIdx.x & 7, local = blockIdx.x >> 3, nloc = gridDim.x >> 3;
  for (int j = local; j < 256; j += nloc) {
    int u = xcd * 256 + j;
    attn_item(p, sm, u >> 4, LC + (u & 15) * 128, LALL);
  }
  for (int j = local; j < 32; j += nloc) {
    int u = xcd * 32 + j;
    attn_item(p, sm, u >> 1, (u & 1) * 128, LC);
  }
}

template <int LAYER>
DI void phase_oproj(const Params& p, char* smem) {
  GemmSmem* sm = (GemmSmem*)smem;
  WAVE_IDS
  constexpr int NROWS = LAYER == 0 ? TOK : NLAT;
  const int NT = 8, units = (NROWS / 128) * NT;
  const bfr* Ab = (const bfr*)(p.ws + (LAYER == 0 ? O_OG : O_Y2));
  const bfr* WT = (const bfr*)(p.ws + (LAYER == 0 ? O_WT_OUT0 : O_WT_OUT1));
  float* part = (float*)(p.ws + (LAYER == 0 ? O_PART1 : O_PART2));
  for (int u = blockIdx.x; u < units; u += gridDim.x) {
    int mt = u / NT, nt = u - mt * NT;
    int m0 = mt * 128, n0 = nt * 128;
    f32x16 acc[2][2];
    zero_acc(acc);
    gemm_main<false>(
        acc, 16, [&](int row, int k) { return Ab + (size_t)(m0 + row) * 1024 + k; },
        [&](int row, int k) { return WT + (size_t)(n0 + row) * 1024 + k; }, sm);
    const float* xin;
    float* xout;
    const float* gt;
    if (LAYER == 0) {
      xin = xrow0(p, m0);
      xout = xrow1(p, m0);
      gt = modrow(p, 0, m0) + 2048;
    } else {
      xin = p.out + (size_t)m0 * 1024;
      xout = p.out + (size_t)m0 * 1024;
      gt = (const float*)(p.ws + O_MOD) + ((size_t)(9 + (m0 >> 11))) * 3072 + 2048;
    }
    float tot = 0.f;
#pragma unroll
    for (int mi = 0; mi < 2; ++mi) {
      float sq[16];
#pragma unroll
      for (int i = 0; i < 16; ++i) sq[i] = 0.f;
#pragma unroll
      for (int ni = 0; ni < 2; ++ni) {
        int col = n0 + wn * 64 + ni * 32 + r;
        float g = gt[col];
        float xv[16];
#pragma unroll
        for (int i = 0; i < 16; ++i) xv[i] = xin[(size_t)(wm * 64 + mi * 32 + crow(i, h)) * 1024 + col];
        SCHED_FENCE();
#pragma unroll
        for (int i = 0; i < 16; ++i) {
          int row = wm * 64 + mi * 32 + crow(i, h);
          float v = xv[i] + g * acc[mi][ni][i];
          xout[(size_t)row * 1024 + col] = v;
          sq[i] += v * v;
        }
        SCHED_FENCE();
      }
      float t = transpose_reduce16(sq, lane);
      t += __shfl_xor(t, 16);
      if (((lane >> 4) & 1) == mi) tot = t;
    }
    int idx = lane & 31;
    int row = m0 + wm * 64 + (idx >> 4) * 32 + crow(idx & 15, h);
    part[(size_t)(nt * 2 + wn) * NROWS + row] = tot;
  }
}

DI void phase_o5(const Params& p, char* smem) {
  GemmSmem* sm = (GemmSmem*)smem;
  WAVE_IDS
  const int NT = 16, units = (TOK / 128) * NT;
  const bfr* WT = (const bfr*)(p.ws + O_WT_IN1);
  const float* part = (const float*)(p.ws + O_PART1);
  bfr* U2 = (bfr*)(p.ws + O_U2);
  bfr* SZ1 = (bfr*)(p.ws + O_SZ1);
  for (int u = blockIdx.x; u < units; u += gridDim.x) {
    int mt = u / NT, nt = u - mt * NT;
    int m0 = mt * 128, n0 = nt * 128;
    int b = m0 / LALL, pos0 = m0 - b * LALL;
    bool lat = pos0 >= LC;
    if (!lat && nt >= 8) continue;
    __syncthreads();
    const float* md = modrow(p, 1, m0);
    const float* ng = p.in[I_NORMG] + 1024;
    for (int k = tid; k < 1024; k += 256) {
      sm->gs[k] = ng[k] * (1.f + md[1024 + k]);
      sm->sh[k] = md[k];
    }
    if (tid < 128) sm->rs[tid] = rs_from_part(part, TOK, m0 + tid);
    __syncthreads();
    const float* abase = xrow1(p, m0);
    f32x16 acc[2][2];
    zero_acc(acc);
    gemm_main<true>(
        acc, 16, [&](int row) { return abase + (size_t)row * 1024; },
        [&](int row, int k) { return WT + (size_t)(n0 + row) * 1024 + k; }, sm);
#pragma unroll
    for (int mi = 0; mi < 2; ++mi)
#pragma unroll
      for (int ni = 0; ni < 2; ++ni) {
        int col = n0 + wn * 64 + ni * 32 + r;
#pragma unroll
        for (int i = 0; i < 16; ++i) {
          int row = wm * 64 + mi * 32 + crow(i, h);
          int tok = m0 + row;
          float v = acc[mi][ni][i];
          if (col < 1024) U2[((size_t)(col >> 4) * TOK + tok) * 16 + (col & 15)] = f2bf(v);
          else SZ1[((size_t)(b * SEQ + pos0 + row - LC)) * 1024 + (col - 1024)] = f2bf(silu_f(v));
          SCHED_FENCE();
        }
      }
  }
}

DI void phase_o6(const Params& p, char* smem) {
  GemmSmem* sm = (GemmSmem*)smem;
  WAVE_IDS
  const int NROW = NB * NCH;
  const int units = 64 * 5 * 2;
  const bfr* U2 = (const bfr*)(p.ws + O_U2);
  const bfr* WST = (const bfr*)(p.ws + O_WST);
  float* SLOC = (float*)(p.ws + O_SLOC);
  for (int u = blockIdx.x; u < units; u += gridDim.x) {
    int g = u / 10, rem = u - g * 10;
    int mt = rem >> 1, nt = rem & 1;
    int m0 = mt * 128, n0 = nt * 128;
    const bfr* Ag = U2 + (size_t)g * TOK * 16;
    const bfr* Bg = WST + (size_t)g * 256 * 512;
    f32x16 acc[2][2];
    zero_acc(acc);
    gemm_main<false>(
        acc, 8,
        [&](int row, int k) {
          int rr = m0 + row;
          rr = rr < NROW ? rr : NROW - 1;
          return Ag + (size_t)rr * 512 + k;
        },
        [&](int row, int k) { return Bg + (size_t)(n0 + row) * 512 + k; }, sm);
#pragma unroll
    for (int mi = 0; mi < 2; ++mi)
#pragma unroll
      for (int ni = 0; ni < 2; ++ni) {
        int col = n0 + wn * 64 + ni * 32 + r;
#pragma unroll
        for (int i = 0; i < 16; ++i) {
          int row = m0 + wm * 64 + mi * 32 + crow(i, h);
          if (row < NROW) SLOC[((size_t)g * NROW + row) * 256 + col] = acc[mi][ni][i];
        }
      }
  }
}

DI void phase_o7(const Params& p) {
  const int tidx_ = opaque_tid();
  const float* SLOC = (const float*)(p.ws + O_SLOC);
  bfr* SIN = (bfr*)(p.ws + O_SIN);
  const int total = NB * 64 * 2 * 64;
  for (int idx = blockIdx.x * 256 + tidx_; idx < total; idx += gridDim.x * 256) {
    int pp = idx & 63, dir = (idx >> 6) & 1, g = (idx >> 7) & 63, b = idx >> 13;
    double dt, ar, ai;
    float fr, fi, lr, li;
    s5_disc(p, dir, g, pp, dt, ar, ai, fr, fi);
    s5_pow(dt, ar, ai, TC, lr, li);
    float sr = 0.f, si = 0.f;
    for (int step = 0; step < NCH; ++step) {
      int cp = dir == 0 ? step : (step < 8 ? 7 - step : NCH - 1 - (step - 8));
      const float* sl = SLOC + ((size_t)g * (NB * NCH) + b * NCH + cp) * 256 + dir * 128 + pp;
#ifdef PROBE_NOCARRY
      if ((dir == 0 && cp == 8) || (dir == 1 && cp == NCH - 1)) { sr = 0.f; si = 0.f; }
#endif
      if (cp >= 8) {
        bfr* so = SIN + ((size_t)g * (NB * NCHL) + b * NCHL + (cp - 8)) * 256 + dir * 128 + pp;
        so[0] = f2bf(sr);
        so[64] = f2bf(si);
      }
      float lre = sl[0], lim = sl[64];
      float nr = lr * sr - li * si + lre;
      float ni = lr * si + li * sr + lim;
      sr = nr;
      si = ni;
    }
  }
}

DI void phase_o8(const Params& p, char* smem) {
  GemmSmem* sm = (GemmSmem*)smem;
  WAVE_IDS
  const int units = 64 * 4 * 4;
  const bfr* U2 = (const bfr*)(p.ws + O_U2);
  const bfr* SIN = (const bfr*)(p.ws + O_SIN);
  const bfr* KTAB = (const bfr*)(p.ws + O_KTAB);
  const bfr* VOP = (const bfr*)(p.ws + O_VOP);
  bfr* YG = (bfr*)(p.ws + O_YG);
  for (int u = blockIdx.x; u < units; u += gridDim.x) {
    int g = u >> 4, mt = (u >> 2) & 3, nt = u & 3;
    int m0 = mt * 128, n0 = nt * 128;
    const bfr* Ug = U2 + (size_t)g * TOK * 16;
    f32x16 acc[2][2];
    zero_acc(acc);
    gemm_main<false>(
        acc, 12,
        [&](int row, int k) {
          int rr = m0 + row;
          int b = rr >> 6, n = rr & 63;
          const bfr* a1 = Ug + ((size_t)b * LALL + LC + n * TC) * 16 + k;
          const bfr* a2 = SIN + ((size_t)g * (NB * NCHL) + rr) * 256 + (k - 512);
          return k < 512 ? a1 : a2;
        },
        [&](int row, int k) {
          int m = n0 + row;
          int t = m >> 4, c = m & 15;
          int j = k >> 4;
          const bfr* b1 = KTAB + (((size_t)g * 63 + (t - j + 31)) * 16 + c) * 16 + (k & 15);
          const bfr* b2 = VOP + ((size_t)g * 512 + m) * 256 + (k - 512);
          return k < 512 ? b1 : b2;
        },
        sm);
#pragma unroll
    for (int mi = 0; mi < 2; ++mi)
#pragma unroll
      for (int ni = 0; ni < 2; ++ni) {
        int m = n0 + wn * 64 + ni * 32 + r;
        int t = m >> 4, c = m & 15;
        int ch = g * 16 + c;
        float dd = p.in[I_S5D][ch];
        float uv[16];
#pragma unroll
        for (int i = 0; i < 16; ++i) {
          int rr = m0 + wm * 64 + mi * 32 + crow(i, h);
          int b = rr >> 6, n = rr & 63;
          uv[i] = bf2f(Ug[((size_t)b * LALL + LC + n * TC + t) * 16 + c]);
        }
        SCHED_FENCE();
#pragma unroll
        for (int i = 0; i < 16; ++i) {
          int rr = m0 + wm * 64 + mi * 32 + crow(i, h);
          int b = rr >> 6, n = rr & 63;
          float y = acc[mi][ni][i] + dd * uv[i];
          YG[((size_t)(b * SEQ + n * TC + t)) * 1024 + ch] = f2bf(gelu_tanh(y));
        }
        SCHED_FENCE();
      }
  }
}

DI void phase_o9(const Params& p, char* smem) {
  GemmSmem* sm = (GemmSmem*)smem;
  WAVE_IDS
  const int NT = 8, units = (NLAT / 128) * NT;
  const bfr* YG = (const bfr*)(p.ws + O_YG);
  const bfr* SZ1 = (const bfr*)(p.ws + O_SZ1);
  const bfr* WT = (const bfr*)(p.ws + O_WT_GLU);
  bfr* Y2 = (bfr*)(p.ws + O_Y2);
  for (int u = blockIdx.x; u < units; u += gridDim.x) {
    int mt = u / NT, nt = u - mt * NT;
    int m0 = mt * 128, n0 = nt * 128;
    f32x16 acc[2][2];
    zero_acc(acc);
    gemm_main<false>(
        acc, 16, [&](int row, int k) { return YG + (size_t)(m0 + row) * 1024 + k; },
        [&](int row, int k) { return WT + (size_t)(n0 + row) * 1024 + k; }, sm);
#pragma unroll
    for (int mi = 0; mi < 2; ++mi)
#pragma unroll
      for (int ni = 0; ni < 2; ++ni) {
        int col = n0 + wn * 64 + ni * 32 + r;
        float bg = p.in[I_BGLU][col];
        float yv[16], zv[16];
#pragma unroll
        for (int i = 0; i < 16; ++i) {
          size_t o = (size_t)(m0 + wm * 64 + mi * 32 + crow(i, h)) * 1024 + col;
          yv[i] = bf2f(YG[o]);
          zv[i] = bf2f(SZ1[o]);
        }
        SCHED_FENCE();
#pragma unroll
        for (int i = 0; i < 16; ++i) {
          size_t o = (size_t)(m0 + wm * 64 + mi * 32 + crow(i, h)) * 1024 + col;
          Y2[o] = f2bf(yv[i] * sigmoid_f(acc[mi][ni][i] + bg) * zv[i]);
        }
        SCHED_FENCE();
      }
  }
}

#define XB_TMO      128
#define XB_XCNT(j)  (256  + 64 * (j))
#define XB_XSUB(j)  (1280 + 64 * (j))
#define XB_XGEN(j)  (2304 + 64 * (j))
#define XB_TOP      3328
#define XB_TOPGEN   3392
#define XCD_BAR_WORDS 3456
#define XB_SPIN_CAP (1u << 18)
#define LAS __attribute__((address_space(3)))
DI unsigned xb_ld(unsigned* p) { return __hip_atomic_load(p, __ATOMIC_RELAXED, __HIP_MEMORY_SCOPE_AGENT); }
DI unsigned xb_add(unsigned* p, unsigned v) { return __hip_atomic_fetch_add(p, v, __ATOMIC_RELAXED, __HIP_MEMORY_SCOPE_AGENT); }
DI unsigned xb_xcc_id() { return (unsigned)__builtin_amdgcn_s_getreg((3 << 11) | 20) & 0xFu; }
#define XB_SPIN(cond, bar) do { unsigned _sp = 0; while (cond) { __builtin_amdgcn_s_sleep(1); \
    if ((++_sp & 255u) == 0u) { if (xb_ld(&(bar)[XB_TMO])) break; if (_sp > XB_SPIN_CAP) { atomicAdd(&(bar)[XB_TMO], 1u); break; } } } } while (0)
struct XcdBarrier {
  unsigned* bar;
  unsigned x;
  volatile LAS unsigned* st;
};
DI XcdBarrier xcd_barrier_post(unsigned* bar, volatile LAS unsigned* st) {
  XcdBarrier b;
  b.bar = bar;
  b.x = xb_xcc_id();
  b.st = st;
  if (threadIdx.x == 0) (void)xb_add(&bar[XB_XCNT(b.x)], 1u);
  return b;
}
DI void xcd_barrier_complete(unsigned* bar, unsigned x, unsigned& nloc, unsigned& nx) {
  const unsigned G = gridDim.x * gridDim.y * gridDim.z;
  unsigned sum, cnt, mine, sp = 0u;
  for (;;) {
    sum = 0u; cnt = 0u; mine = 0u;
#pragma unroll
    for (unsigned j = 0; j < 16; ++j) {
      const unsigned c = xb_ld(&bar[XB_XCNT(j)]);
      sum += c;
      cnt += (c > 0u) ? 1u : 0u;
      mine = (j == x) ? c : mine;
    }
    if (sum == G) break;
    __builtin_amdgcn_s_sleep(1);
    if ((++sp & 255u) == 0u) {
      if (xb_ld(&bar[XB_TMO])) break;
      if (sp > XB_SPIN_CAP) { atomicAdd(&bar[XB_TMO], 1u); break; }
    }
  }
  nloc = mine > 0u ? mine : 1u;
  nx = cnt > 0u ? cnt : 1u;
}
DI void xcd_barrier(const XcdBarrier& b) {
  asm volatile("s_waitcnt vmcnt(0)" ::: "memory");
  __syncthreads();
  if (threadIdx.x == 0) {
    unsigned* bar = b.bar;
    __builtin_amdgcn_s_waitcnt(0);
    unsigned nloc = b.st[0], nx = b.st[1];
    if (nloc == 0u) {
      xcd_barrier_complete(bar, b.x, nloc, nx);
      b.st[0] = nloc;
      b.st[1] = nx;
    }
    const unsigned old = xb_add(&bar[XB_XSUB(b.x)], 1u);
    const unsigned gen = old / nloc;
    if (old + 1u == (gen + 1u) * nloc) {
      __builtin_amdgcn_fence(__ATOMIC_RELEASE, "agent");
      asm volatile("s_waitcnt vmcnt(0)" ::: "memory");
      const unsigned og = xb_add(&bar[XB_TOP], 1u);
      const unsigned tg = og / nx;
      if (og + 1u == (tg + 1u) * nx) xb_add(&bar[XB_TOPGEN], 1u);
      else XB_SPIN(xb_ld(&bar[XB_TOPGEN]) == tg, bar);
      __builtin_amdgcn_fence(__ATOMIC_ACQUIRE, "agent");
      xb_add(&bar[XB_XGEN(b.x)], 1u);
      asm volatile("s_waitcnt vmcnt(0)" ::: "memory");
    } else {
      XB_SPIN(xb_ld(&bar[XB_XGEN(b.x)]) == gen, bar);
      __builtin_amdgcn_fence(__ATOMIC_ACQUIRE, "agent");
      asm volatile("s_waitcnt vmcnt(0)" ::: "memory");
    }
  }
  __syncthreads();
}

DI void run_phase(const Params& p, int ph, char* smem) {
  switch (ph) {
#if !defined(ONLY) || ONLY == 0
    case PH_PREP: phase_prep(p, smem); break;
#endif
#if USE_NAIVE
    case PH_N1: phase_n1(p); break;
    case PH_N2: phase_n2(p); break;
    case PH_N3: phase_n3(p); break;
    case PH_N4: phase_n4(p); break;
    case PH_N4B: phase_rowsq(p, 1); break;
    case PH_N5: phase_n5(p); break;
    case PH_N6A: phase_n6(p, 0); break;
    case PH_N6B: phase_n6(p, 1); break;
    case PH_N9: phase_n9(p); break;
    case PH_N10: phase_n10(p); break;
    case PH_N10B: phase_rowsq(p, 2); break;
#endif
#if !defined(ONLY) || ONLY == 1
    case PH_FINAL: phase_final(p); break;
#endif
#if !defined(ONLY) || ONLY == 2
    case PH_O1: phase_o1(p, smem); break;
#endif
#if !defined(ONLY) || ONLY == 3
    case PH_O2: phase_o2(p, smem); break;
#endif
#if !defined(ONLY) || ONLY == 4
    case PH_O3: phase_o3(p, smem); break;
#endif
#if !defined(ONLY) || ONLY == 5
    case PH_O4: phase_oproj<0>(p, smem); break;
#endif
#if !defined(ONLY) || ONLY == 6
    case PH_O5: phase_o5(p, smem); break;
#endif
#if !defined(ONLY) || ONLY == 7
    case PH_O6: phase_o6(p, smem); break;
#endif
#if !defined(ONLY) || ONLY == 8
    case PH_O7: phase_o7(p); break;
#endif
#if !defined(ONLY) || ONLY == 9
    case PH_O8: phase_o8(p, smem); break;
#endif
#if !defined(ONLY) || ONLY == 10
    case PH_O9: phase_o9(p, smem); break;
#endif
#if !defined(ONLY) || ONLY == 11
    case PH_O10: phase_oproj<1>(p, smem); break;
#endif
    default: break;
  }
}

__global__ void __launch_bounds__(256, 2) mega_one(Params p, int ph) {
  __shared__ __attribute__((aligned(16))) char smem[SMEM_BYTES];
  run_phase(p, ph, smem);
}

#if !defined(ONLY) && SINGLE_LAUNCH
__global__ void __launch_bounds__(256, 2) mega(Params p) {
  __shared__ __attribute__((aligned(16))) char smem[SMEM_BYTES];
  __shared__ uint4 xb_words;
  if (threadIdx.x == 0) xb_words = make_uint4(0u, 0u, 0u, 0u);
  __syncthreads();
  if (p.nprog < 0) cg::this_grid().sync();
  const XcdBarrier xb = xcd_barrier_post((unsigned*)(p.ws + O_BAR), (volatile LAS unsigned*)&xb_words);
  cg::grid_group grid = cg::this_grid();
#if !defined(OMIT) || OMIT != 0
  phase_prep(p, smem);
#endif
  xcd_barrier(xb);
#if (DUP >> 0) & 1
  phase_prep(p, smem);
  xcd_barrier(xb);
#endif
#if !defined(OMIT) || OMIT != 1
  phase_o1(p, smem);
#endif
  xcd_barrier(xb);
#if (DUP >> 1) & 1
  phase_o1(p, smem);
  xcd_barrier(xb);
#endif
#if !defined(OMIT) || OMIT != 2
  phase_o2(p, smem);
#endif
  xcd_barrier(xb);
#if (DUP >> 2) & 1
  phase_o2(p, smem);
  xcd_barrier(xb);
#endif
#if !defined(OMIT) || OMIT != 3
  phase_o3(p, smem);
#endif
  xcd_barrier(xb);
#if (DUP >> 3) & 1
  phase_o3(p, smem);
  xcd_barrier(xb);
#endif
#if !defined(OMIT) || OMIT != 4
  phase_oproj<0>(p, smem);
#endif
  xcd_barrier(xb);
#if (DUP >> 4) & 1
  phase_oproj<0>(p, smem);
  xcd_barrier(xb);
#endif
#if !defined(OMIT) || OMIT != 5
  phase_o5(p, smem);
#endif
  xcd_barrier(xb);
#if (DUP >> 5) & 1
  phase_o5(p, smem);
  xcd_barrier(xb);
#endif
#if !defined(OMIT) || OMIT != 6
  phase_o6(p, smem);
#endif
  xcd_barrier(xb);
#if (DUP >> 6) & 1
  phase_o6(p, smem);
  xcd_barrier(xb);
#endif
#if !defined(OMIT) || OMIT != 7
  phase_o7(p);
#endif
  xcd_barrier(xb);
#if (DUP >> 7) & 1
  phase_o7(p);
  xcd_barrier(xb);
#endif
#if !defined(OMIT) || OMIT != 8
  phase_o8(p, smem);
#endif
  xcd_barrier(xb);
#if (DUP >> 8) & 1
  phase_o8(p, smem);
  xcd_barrier(xb);
#endif
#if !defined(OMIT) || OMIT != 9
  phase_o9(p, smem);
#endif
  xcd_barrier(xb);
#if (DUP >> 9) & 1
  phase_o9(p, smem);
  xcd_barrier(xb);
#endif
#if !defined(OMIT) || OMIT != 10
  phase_oproj<1>(p, smem);
#endif
  xcd_barrier(xb);
#if !defined(OMIT) || OMIT != 11
  phase_final(p);
#endif
}
#else
__global__ void mega(Params p) {}
#endif


extern "C" void kernel_launch(void* const* d_in, const int* in_sizes, int n_in, void* d_out, int out_size, void* d_ws,
                              size_t ws_size, hipStream_t stream) {
  static int grid_blocks = 0;
  if (!grid_blocks) {
    int dev = 0, cus = 0, per_cu = 0;
    hipGetDevice(&dev);
    hipDeviceGetAttribute(&cus, hipDeviceAttributeMultiprocessorCount, dev);
#if SINGLE_LAUNCH
    hipOccupancyMaxActiveBlocksPerMultiprocessor(&per_cu, mega, 256, 0);
#else
    hipOccupancyMaxActiveBlocksPerMultiprocessor(&per_cu, mega_one, 256, 0);
#endif
    if (per_cu < 1) per_cu = 1;
    if (per_cu > 2) per_cu = 2;
    grid_blocks = cus * per_cu;
  }
  if (ws_size < WS_NEED || n_in < N_INPUTS) {
    fprintf(stderr, "workspace too small or bad inputs: %zu < %zu\n", ws_size, (size_t)WS_NEED);
    return;
  }
  Params p{};
  for (int i = 0; i < N_INPUTS; ++i) p.in[i] = (const float*)d_in[i];
  p.out = (float*)d_out;
  p.ws = (char*)d_ws;
#ifndef PROG
#define PROG PH_PREP, PH_O1, PH_O2, PH_O3, PH_O4, PH_O5, PH_O6, PH_O7, PH_O8, PH_O9, PH_O10, PH_FINAL
#endif
  const int prog[] = {PROG};
  p.nprog = (int)(sizeof(prog) / sizeof(int));
  for (int i = 0; i < p.nprog; ++i) p.prog[i] = prog[i];
#if SINGLE_LAUNCH
  hipMemsetAsync((char*)d_ws + O_BAR, 0, BAR_BYTES, stream);
  void* args[] = {&p};
  hipError_t e = hipLaunchCooperativeKernel((void*)mega, dim3(grid_blocks), dim3(256), args, 0, stream);
  if (e != hipSuccess) fprintf(stderr, "cooperative launch failed: %s (grid %d)\n", hipGetErrorString(e), grid_blocks);
#else
  for (int i = 0; i < p.nprog; ++i) {
    mega_one<<<dim3(grid_blocks), dim3(256), 0, stream>>>(p, p.prog[i]);
  }
#endif
}
```

```cpp
#include <hip/hip_runtime.h>
#include <hip/hip_cooperative_groups.h>
#include <cstdio>
namespace cg = cooperative_groups;
#ifndef DUP
#define DUP 0
#endif
#ifndef USE_NAIVE
#define USE_NAIVE 0
#endif
#ifndef SINGLE_LAUNCH
#define SINGLE_LAUNCH 1
#endif

#define DI __device__ __forceinline__
typedef unsigned short bfr;

constexpr int D = 1024, NB = 8, SEQ = 2048, LC = 256, LALL = 2304;
constexpr int TOK = NB * LALL;
constexpr int NLAT = NB * SEQ;
constexpr int NH = 16, DQK = 96, DV = 64;
constexpr int NIN0 = 1440, NIN1 = 2048;
constexpr float EPS = 1e-6f;
constexpr float QSCALE = 0.10206207261596577f * 1.4426950408889634f;
constexpr int TC = 32;
constexpr int NCH = LALL / TC;
constexpr int NCHL = SEQ / TC;

enum { I_X = 0, I_C, I_CTX, I_CCTX, I_ADAW, I_ADAB, I_NORMG, I_WIN0, I_QNORM, I_WUQ, I_KVNORM, I_WUKV, I_WOUT0,
       I_WIN1, I_ARE, I_AIM, I_LOGSTEP, I_BRE, I_BIM, I_CRE, I_CIM, I_S5D, I_WGLU, I_BGLU, I_WOUT1, I_FINALG, N_INPUTS };

constexpr size_t al256(size_t x) { return (x + 255) & ~(size_t)255; }
constexpr size_t O_WT_IN0 = 0;
constexpr size_t O_WT_UQ = O_WT_IN0 + al256((size_t)NIN0 * 1024 * 2);
constexpr size_t O_WT_UKV = O_WT_UQ + al256((size_t)1536 * 256 * 2);
constexpr size_t O_WT_OUT0 = O_WT_UKV + al256((size_t)2048 * 128 * 2);
constexpr size_t O_WT_IN1 = O_WT_OUT0 + al256((size_t)1024 * 1024 * 2);
constexpr size_t O_WT_GLU = O_WT_IN1 + al256((size_t)2048 * 1024 * 2);
constexpr size_t O_WT_OUT1 = O_WT_GLU + al256((size_t)1024 * 1024 * 2);
constexpr size_t O_MOD = O_WT_OUT1 + al256((size_t)1024 * 1024 * 2);
constexpr size_t O_RS0 = O_MOD + al256((size_t)2 * 9 * 3072 * 4);
constexpr size_t O_PART1 = O_RS0 + al256((size_t)TOK * 4);
constexpr size_t O_PART2 = O_PART1 + al256((size_t)16 * TOK * 4);
constexpr size_t O_X1CTX = O_PART2 + al256((size_t)16 * NLAT * 4);
constexpr size_t O_KTAB = O_X1CTX + al256((size_t)NB * LC * 1024 * 4);
constexpr size_t O_WST = O_KTAB + al256((size_t)64 * 63 * 256 * 2);
constexpr size_t O_VOP = O_WST + al256((size_t)64 * 256 * 512 * 2);
constexpr size_t O_BAR = O_VOP + al256((size_t)64 * 512 * 256 * 2);
constexpr size_t BAR_BYTES = 3456 * 4;
constexpr size_t O_LAYER = O_BAR + al256(BAR_BYTES);
constexpr size_t O_PC = O_LAYER;
constexpr size_t O_SZ0 = O_PC + al256((size_t)TOK * 384 * 2);
constexpr size_t O_K = O_SZ0 + al256((size_t)TOK * 1024 * 2);
constexpr size_t O_VT = O_K + al256((size_t)NB * NH * LALL * DQK * 2);
constexpr size_t O_OG = O_VT + al256((size_t)NB * NH * DV * LALL * 2);
constexpr size_t O_END0 = O_OG + al256((size_t)TOK * 1024 * 2);
constexpr size_t O_U2 = O_LAYER;
constexpr size_t O_SZ1 = O_U2 + al256((size_t)64 * TOK * 16 * 2);
constexpr size_t O_SLOC = O_SZ1 + al256((size_t)NLAT * 1024 * 2);
constexpr size_t O_SIN = O_SLOC + al256((size_t)64 * (NB * NCH) * 256 * 4);
constexpr size_t O_YG = O_SIN + al256((size_t)64 * (NB * NCHL) * 256 * 2);
constexpr size_t O_END1 = O_YG + al256((size_t)NLAT * 1024 * 2);
constexpr size_t O_Y2 = O_SLOC;
constexpr size_t WS_NEED = (O_END0 > O_END1 ? O_END0 : O_END1);
static_assert(WS_NEED <= (size_t)256 * 1024 * 1024, "workspace too large");
static_assert((size_t)NB * NH * LALL * DQK * 2 <= (size_t)NLAT * 1024 * 4, "Q does not fit d_out");

struct Params {
  const float* in[N_INPUTS];
  float* out;
  char* ws;
  int prog[32];
  int nprog;
  int pad;
};

DI bfr f2bf(float x) {
  unsigned u = __float_as_uint(x);
  u += 0x7fffu + ((u >> 16) & 1u);
  return (bfr)(u >> 16);
}
DI int opaque_tid() {
  int t = threadIdx.x;
  asm volatile("" : "+v"(t));
  return t;
}
DI float bf2f(bfr b) { return __uint_as_float(((unsigned)b) << 16); }
DI float silu_f(float v) { return v / (1.f + __expf(-v)); }
DI float sigmoid_f(float v) { return 1.f / (1.f + __expf(-v)); }
DI float gelu_tanh(float v) {
  float u = 0.7978845608028654f * (v + 0.044715f * v * v * v);
  return 0.5f * v * (1.f + tanhf(u));
}
DI float wave_sum(float v) {
#pragma unroll
  for (int o = 32; o > 0; o >>= 1) v += __shfl_xor(v, o);
  return v;
}
DI float wave_max(float v) {
#pragma unroll
  for (int o = 32; o > 0; o >>= 1) v = fmaxf(v, __shfl_xor(v, o));
  return v;
}
DI const float* xrow0(const Params& p, int tok) {
  int b = tok / LALL, pos = tok - b * LALL;
  return pos < LC ? p.in[I_CTX] + ((size_t)(b * LC + pos)) * D : p.in[I_X] + ((size_t)(b * SEQ + pos - LC)) * D;
}
DI float* xrow1(const Params& p, int tok) {
  int b = tok / LALL, pos = tok - b * LALL;
  return pos < LC ? (float*)(p.ws + O_X1CTX) + ((size_t)(b * LC + pos)) * D : p.out + ((size_t)(b * SEQ + pos - LC)) * D;
}
DI const float* modrow(const Params& p, int layer, int tok) {
  int b = tok / LALL, pos = tok - b * LALL;
  int r = pos < LC ? 8 : b;
  return (const float*)(p.ws + O_MOD) + ((size_t)(layer * 9 + r)) * 3072;
}
DI void rope_cs(int fi, int posv, float& cs, float& sn) {
  float inv = exp2f(-(float)fi * (13.287712379549449f / 8.f));
  sincosf((float)posv * inv, &sn, &cs);
}
DI float rope_apply(int j, float v, float vp, int lpos) {
  int posv = (j & 16) ? (lpos & 63) : (lpos >> 6);
  float cs, sn;
  rope_cs(j & 7, posv, cs, sn);
  return (j & 8) ? (vp * sn + v * cs) : (v * cs - vp * sn);
}

DI void s5_disc(const Params& p, int dir, int g, int pp, double& dt, double& ar, double& ai, float& fr, float& fi) {
  dt = exp((double)p.in[I_LOGSTEP][dir * 64 + g]);
  ar = (double)p.in[I_ARE][(dir * 64 + g) * 64 + pp];
  ai = (double)p.in[I_AIM][(dir * 64 + g) * 64 + pp];
  double mag = exp(ar * dt);
  double a = ai * dt;
  a -= 6.283185307179586 * rint(a * 0.15915494309189535);
  float sn, cs;
  sincosf((float)a, &sn, &cs);
  double lr = mag * (double)cs, li = mag * (double)sn;
  double den = ar * ar + ai * ai, nr = lr - 1.0;
  fr = (float)((nr * ar + li * ai) / den);
  fi = (float)((li * ar - nr * ai) / den);
}
DI void s5_pow(double dt, double ar, double ai, int k, float& wr, float& wi) {
  double mag = exp(ar * dt * (double)k);
  double a = ai * dt * (double)k;
  a -= 6.283185307179586 * rint(a * 0.15915494309189535);
  float sn, cs;
  sincosf((float)a, &sn, &cs);
  wr = (float)mag * cs;
  wi = (float)mag * sn;
}

enum { PH_PREP = 0, PH_N1, PH_N2, PH_N3, PH_N4, PH_N4B, PH_N5, PH_N6A, PH_N6B, PH_N9, PH_N10, PH_N10B, PH_FINAL,
       PH_O1, PH_O2, PH_O3, PH_O4, PH_O5, PH_O6, PH_O7, PH_O8, PH_O9, PH_O10, PH_COUNT };

constexpr int SMEM_BYTES = 48 * 1024;


DI void prep_transpose(const Params& p, int widx, int tile, char* smem) {
  const int tidx_ = opaque_tid();
  int K, N;
  size_t dst;
  const float* W;
  const float* scl = nullptr;
  switch (widx) {
    case 0: W = p.in[I_WIN0]; K = 1024; N = NIN0; dst = O_WT_IN0; break;
    case 1: W = p.in[I_WUQ]; K = 256; N = 1536; dst = O_WT_UQ; scl = p.in[I_QNORM]; break;
    case 2: W = p.in[I_WUKV]; K = 128; N = 2048; dst = O_WT_UKV; scl = p.in[I_KVNORM]; break;
    case 3: W = p.in[I_WOUT0]; K = 1024; N = 1024; dst = O_WT_OUT0; break;
    case 4: W = p.in[I_WIN1]; K = 1024; N = NIN1; dst = O_WT_IN1; break;
    case 5: W = p.in[I_WGLU]; K = 1024; N = 1024; dst = O_WT_GLU; break;
    default: W = p.in[I_WOUT1]; K = 1024; N = 1024; dst = O_WT_OUT1; break;
  }
  float (*t)[33] = (float (*)[33])smem;
  int ntn = N / 32;
  int kt = tile / ntn, nt = tile - kt * ntn;
  int tx = tidx_ & 31, ty = tidx_ >> 5;
#pragma unroll
  for (int i = 0; i < 4; ++i) {
    int k = kt * 32 + ty + 8 * i, n = nt * 32 + tx;
    float v = W[(size_t)k * N + n];
    if (scl) v *= scl[k];
    t[ty + 8 * i][tx] = v;
  }
  __syncthreads();
  bfr* Wt = (bfr*)(p.ws + dst);
#pragma unroll
  for (int i = 0; i < 4; ++i) {
    int n = nt * 32 + ty + 8 * i, k = kt * 32 + tx;
    Wt[(size_t)n * K + k] = f2bf(t[tx][ty + 8 * i]);
  }
  __syncthreads();
}

DI void prep_mod(const Params& p, int unit, char* smem) {
  const int tidx_ = opaque_tid();
  int layer = unit / 192, cgp = unit - layer * 192;
  float* sil = (float*)smem;
  float* red = sil + 9 * 1024;
  for (int i = tidx_; i < 9 * 1024; i += 256) {
    int r = i >> 10, k = i & 1023;
    float v = r < 8 ? p.in[I_C][r * 1024 + k] : p.in[I_CCTX][k];
    sil[i] = silu_f(v);
  }
  __syncthreads();
  int nn = tidx_ & 15, kg = tidx_ >> 4;
  int n = cgp * 16 + nn;
  const float* W = p.in[I_ADAW] + (size_t)layer * 1024 * 3072 + n;
  float acc[9];
#pragma unroll
  for (int r = 0; r < 9; ++r) acc[r] = 0.f;
#pragma unroll 8
  for (int k = kg * 64; k < kg * 64 + 64; ++k) {
    float w = W[(size_t)k * 3072];
#pragma unroll
    for (int r = 0; r < 9; ++r) acc[r] += sil[r * 1024 + k] * w;
  }
#pragma unroll
  for (int r = 0; r < 9; ++r) red[(kg * 9 + r) * 16 + nn] = acc[r];
  __syncthreads();
  if (tidx_ < 144) {
    int r = tidx_ >> 4, c = tidx_ & 15;
    int nc = cgp * 16 + c;
    float s = p.in[I_ADAB][layer * 3072 + nc];
#pragma unroll
    for (int g = 0; g < 16; ++g) s += red[(g * 9 + r) * 16 + c];
    ((float*)(p.ws + O_MOD))[((size_t)(layer * 9 + r)) * 3072 + nc] = s;
  }
  __syncthreads();
}

DI void prep_rs0(const Params& p, int unit) {
  const int tidx_ = opaque_tid();
  int tok = unit * 4 + (tidx_ >> 6);
  int lane = tidx_ & 63;
  const float4* r = (const float4*)xrow0(p, tok);
  float s = 0.f;
#pragma unroll
  for (int i = 0; i < 4; ++i) {
    float4 v = r[lane + 64 * i];
    s += v.x * v.x + v.y * v.y + v.z * v.z + v.w * v.w;
  }
  s = wave_sum(s);
  if (lane == 0) ((float*)(p.ws + O_RS0))[tok] = rsqrtf(s * (1.f / 1024.f) + EPS);
}

DI void prep_ktab(const Params& p, int unit, char* smem) {
  const int tidx_ = opaque_tid();
  int g = unit / 63, lagidx = unit - g * 63;
  int lag = lagidx - 31;
  float2* E = (float2*)smem;
  int tid = tidx_;
  if (tid < 128) {
    int dir = tid >> 6, pp = tid & 63;
    bool used = (dir == 0) ? (lag >= 0) : (lag <= 0);
    float2 e = make_float2(0.f, 0.f);
    if (used) {
      double dt, ar, ai;
      float fr, fi, wr, wi;
      s5_disc(p, dir, g, pp, dt, ar, ai, fr, fi);
      s5_pow(dt, ar, ai, lag < 0 ? -lag : lag, wr, wi);
      e.x = wr * fr - wi * fi;
      e.y = wr * fi + wi * fr;
    }
    E[tid] = e;
  }
  __syncthreads();
  int c = tid >> 4, c2 = tid & 15;
  float acc = 0.f;
  for (int dir = 0; dir < 2; ++dir) {
    bool used = (dir == 0) ? (lag >= 0) : (lag <= 0);
    if (!used) continue;
    const float* bre = p.in[I_BRE] + ((size_t)(dir * 64 + g)) * 64 * 16;
    const float* bim = p.in[I_BIM] + ((size_t)(dir * 64 + g)) * 64 * 16;
    const float* cre = p.in[I_CRE] + ((size_t)(dir * 64 + g)) * 16 * 64;
    const float* cim = p.in[I_CIM] + ((size_t)(dir * 64 + g)) * 16 * 64;
#pragma unroll 8
    for (int pp = 0; pp < 64; ++pp) {
      float2 e = E[dir * 64 + pp];
      float br = bre[pp * 16 + c2], bi = bim[pp * 16 + c2];
      float gr = e.x * br - e.y * bi, gi = e.x * bi + e.y * br;
      float cr = cre[c * 64 + pp], ci = cim[c * 64 + pp];
      acc += cr * gr - ci * gi;
    }
  }
  ((bfr*)(p.ws + O_KTAB))[((size_t)unit * 16 + c) * 16 + c2] = f2bf(acc);
  __syncthreads();
}

DI void prep_ops(const Params& p, int unit) {
  const int tidx_ = opaque_tid();
  int idx = unit * 256 + tidx_;
  int pp = idx & 63, t = (idx >> 6) & 31, dir = (idx >> 11) & 1, g = idx >> 12;
  double dt, ar, ai;
  float fr, fi, wr, wi;
  s5_disc(p, dir, g, pp, dt, ar, ai, fr, fi);
  s5_pow(dt, ar, ai, dir == 0 ? (TC - 1 - t) : t, wr, wi);
  float er = wr * fr - wi * fi, ei = wr * fi + wi * fr;
  const float* bre = p.in[I_BRE] + (((size_t)(dir * 64 + g)) * 64 + pp) * 16;
  const float* bim = p.in[I_BIM] + (((size_t)(dir * 64 + g)) * 64 + pp) * 16;
  bfr* wst = (bfr*)(p.ws + O_WST) + (size_t)g * 256 * 512;
  bfr* rre = wst + (size_t)(dir * 128 + pp) * 512 + t * 16;
  bfr* rim = wst + (size_t)(dir * 128 + 64 + pp) * 512 + t * 16;
#pragma unroll
  for (int c2 = 0; c2 < 16; ++c2) {
    float br = bre[c2], bi = bim[c2];
    rre[c2] = f2bf(er * br - ei * bi);
    rim[c2] = f2bf(er * bi + ei * br);
  }
  s5_pow(dt, ar, ai, dir == 0 ? (t + 1) : (TC - t), wr, wi);
  const float* cre = p.in[I_CRE] + ((size_t)(dir * 64 + g)) * 16 * 64;
  const float* cim = p.in[I_CIM] + ((size_t)(dir * 64 + g)) * 16 * 64;
  bfr* vop = (bfr*)(p.ws + O_VOP) + (size_t)g * 512 * 256;
#pragma unroll
  for (int c = 0; c < 16; ++c) {
    float cr = cre[c * 64 + pp], ci = cim[c * 64 + pp];
    float dr = cr * wr - ci * wi, di = cr * wi + ci * wr;
    vop[(size_t)(t * 16 + c) * 256 + dir * 128 + pp] = f2bf(dr);
    vop[(size_t)(t * 16 + c) * 256 + dir * 128 + 64 + pp] = f2bf(-di);
  }
}

constexpr int TR_T0 = 32 * 45, TR_T1 = 8 * 48, TR_T2 = 4 * 64, TR_T3 = 1024, TR_T4 = 32 * 64, TR_T5 = 1024, TR_T6 = 1024;
constexpr int TR_TOTAL = TR_T0 + TR_T1 + TR_T2 + TR_T3 + TR_T4 + TR_T5 + TR_T6;
constexpr int U_MOD = 384, U_RS0 = TOK / 4, U_KTAB = 64 * 63, U_OPS = 64 * 2 * 64 * 32 / 256;
constexpr int PREP_UNITS = TR_TOTAL + U_MOD + U_RS0 + U_KTAB + U_OPS;

DI void phase_prep(const Params& p, char* smem) {
  for (int u = blockIdx.x; u < PREP_UNITS; u += gridDim.x) {
    int v = u;
    if (v < U_MOD) { prep_mod(p, v, smem); continue; }
    v -= U_MOD;
    if (v < TR_TOTAL) {
      int w = 0;
      if (v >= TR_T0) { v -= TR_T0; w = 1;
        if (v >= TR_T1) { v -= TR_T1; w = 2;
          if (v >= TR_T2) { v -= TR_T2; w = 3;
            if (v >= TR_T3) { v -= TR_T3; w = 4;
              if (v >= TR_T4) { v -= TR_T4; w = 5;
                if (v >= TR_T5) { v -= TR_T5; w = 6; } } } } } }
      prep_transpose(p, w, v, smem);
      continue;
    }
    v -= TR_TOTAL;
    if (v < U_RS0) { prep_rs0(p, v); continue; }
    v -= U_RS0;
    if (v < U_KTAB) { prep_ktab(p, v, smem); continue; }
    v -= U_KTAB;
    prep_ops(p, v);
  }
}

DI void phase_n1(const Params& p) {
  const float* W = p.in[I_WIN0];
  const float* rs0 = (const float*)(p.ws + O_RS0);
  const float* ng = p.in[I_NORMG];
  const size_t total = (size_t)TOK * NIN0;
  for (size_t idx = (size_t)blockIdx.x * 256 + threadIdx.x; idx < total; idx += (size_t)gridDim.x * 256) {
    int tok = (int)(idx / NIN0), n = (int)(idx - (size_t)tok * NIN0);
    int b = tok / LALL, pos = tok - b * LALL;
    bool lat = pos >= LC;
    const float* xr = xrow0(p, tok);
    const float* md = modrow(p, 0, tok);
    float rs = rs0[tok];
    bool rope = lat && n >= 384 && n < 416;
    int n2 = rope ? (n ^ 8) : n;
    float acc = 0.f, acc2 = 0.f;
    for (int k = 0; k < 1024; ++k) {
      float h = xr[k] * rs * ng[k] * (1.f + md[1024 + k]) + md[k];
      acc += h * W[(size_t)k * NIN0 + n];
      acc2 += h * W[(size_t)k * NIN0 + n2];
    }
    if (n < 384) {
      ((bfr*)(p.ws + O_PC))[(size_t)tok * 384 + n] = f2bf(acc);
    } else if (n < 416) {
      int j = n - 384;
      float v = rope ? rope_apply(j, acc, acc2, pos - LC) : acc;
      bfr bv = f2bf(v);
      bfr* K = (bfr*)(p.ws + O_K);
      for (int h = 0; h < NH; ++h) K[(((size_t)(b * NH + h)) * LALL + pos) * DQK + 64 + j] = bv;
    } else {
      ((bfr*)(p.ws + O_SZ0))[(size_t)tok * 1024 + (n - 416)] = f2bf(silu_f(acc));
    }
  }
}

DI void phase_n2(const Params& p) {
  const int NTOT = 1536 + 2048;
  const bfr* PC = (const bfr*)(p.ws + O_PC);
  const size_t total = (size_t)TOK * NTOT;
  bfr* Q = (bfr*)p.out;
  bfr* K = (bfr*)(p.ws + O_K);
  bfr* VT = (bfr*)(p.ws + O_VT);
  for (size_t idx = (size_t)blockIdx.x * 256 + threadIdx.x; idx < total; idx += (size_t)gridDim.x * 256) {
    int tok = (int)(idx / NTOT), n = (int)(idx - (size_t)tok * NTOT);
    int b = tok / LALL, pos = tok - b * LALL;
    bool lat = pos >= LC;
    if (n < 1536) {
      int h = n / 96, d = n - h * 96;
      bool rope = lat && d >= 64;
      int n2 = rope ? (n ^ 8) : n;
      const float* W = p.in[I_WUQ];
      const float* qn = p.in[I_QNORM];
      float acc = 0.f, acc2 = 0.f, ss = 0.f;
      for (int k = 0; k < 256; ++k) {
        float a = bf2f(PC[(size_t)tok * 384 + k]);
        ss += a * a;
        float aw = a * qn[k];
        acc += aw * W[(size_t)k * 1536 + n];
        acc2 += aw * W[(size_t)k * 1536 + n2];
      }
      float r = rsqrtf(ss * (1.f / 256.f) + EPS);
      acc *= r; acc2 *= r;
      float v = rope ? rope_apply(d - 64, acc, acc2, pos - LC) : acc;
      Q[(((size_t)(b * NH + h)) * LALL + pos) * DQK + d] = f2bf(v * QSCALE);
    } else {
      int n3 = n - 1536;
      int h = n3 / 128, d = n3 - h * 128;
      const float* W = p.in[I_WUKV];
      const float* kn = p.in[I_KVNORM];
      float acc = 0.f, ss = 0.f;
      for (int k = 0; k < 128; ++k) {
        float a = bf2f(PC[(size_t)tok * 384 + 256 + k]);
        ss += a * a;
        acc += a * kn[k] * W[(size_t)k * 2048 + n3];
      }
      acc *= rsqrtf(ss * (1.f / 128.f) + EPS);
      if (d < 64) K[(((size_t)(b * NH + h)) * LALL + pos) * DQK + d] = f2bf(acc);
      else VT[(((size_t)(b * NH + h)) * DV + (d - 64)) * LALL + pos] = f2bf(acc);
    }
  }
}

DI void phase_n3(const Params& p) {
  const bfr* Q = (const bfr*)p.out;
  const bfr* K = (const bfr*)(p.ws + O_K);
  const bfr* VT = (const bfr*)(p.ws + O_VT);
  const bfr* SZ = (const bfr*)(p.ws + O_SZ0);
  bfr* OG = (bfr*)(p.ws + O_OG);
  int lane = threadIdx.x & 63;
  const int total = NB * NH * LALL;
  for (int w = blockIdx.x * 4 + (threadIdx.x >> 6); w < total; w += gridDim.x * 4) {
    int bh = w / LALL, pos = w - bh * LALL;
    int b = bh / NH, h = bh - b * NH;
    int nk = pos < LC ? LC : LALL;
    const bfr* q = Q + ((size_t)bh * LALL + pos) * DQK;
    const bfr* kb = K + (size_t)bh * LALL * DQK;
    const bfr* vb = VT + (size_t)bh * DV * LALL;
    float s[36];
    float mx = -1e30f;
#pragma unroll
    for (int i = 0; i < 36; ++i) {
      int key = i * 64 + lane;
      float a = -1e30f;
      if (key < nk) {
        a = 0.f;
        const bfr* kr = kb + (size_t)key * DQK;
        for (int d = 0; d < DQK; ++d) a += bf2f(q[d]) * bf2f(kr[d]);
      }
      s[i] = a;
      mx = fmaxf(mx, a);
    }
    mx = wave_max(mx);
    float l = 0.f;
    float o[64];
#pragma unroll
    for (int d = 0; d < 64; ++d) o[d] = 0.f;
#pragma unroll
    for (int i = 0; i < 36; ++i) {
      int key = i * 64 + lane;
      if (key < nk) {
        float pr = exp2f(s[i] - mx);
        l += pr;
#pragma unroll
        for (int d = 0; d < 64; ++d) o[d] += pr * bf2f(vb[(size_t)d * LALL + key]);
      }
    }
    l = wave_sum(l);
    float mine = 0.f;
#pragma unroll
    for (int d = 0; d < 64; ++d) {
      float t = wave_sum(o[d]);
      if (lane == d) mine = t;
    }
    int tok = b * LALL + pos;
    float z = bf2f(SZ[(size_t)tok * 1024 + h * 64 + lane]);
    OG[(size_t)tok * 1024 + h * 64 + lane] = f2bf(mine / l * z);
  }
}

DI void phase_n4(const Params& p) {
  const float* W = p.in[I_WOUT0];
  const bfr* OG = (const bfr*)(p.ws + O_OG);
  const size_t total = (size_t)TOK * 1024;
  for (size_t idx = (size_t)blockIdx.x * 256 + threadIdx.x; idx < total; idx += (size_t)gridDim.x * 256) {
    int tok = (int)(idx >> 10), n = (int)(idx & 1023);
    float acc = 0.f;
    for (int k = 0; k < 1024; ++k) acc += bf2f(OG[(size_t)tok * 1024 + k]) * W[(size_t)k * 1024 + n];
    float v = xrow0(p, tok)[n] + modrow(p, 0, tok)[2048 + n] * acc;
    xrow1(p, tok)[n] = v;
  }
}

DI void phase_rowsq(const Params& p, int layer) {
  int lane = threadIdx.x & 63;
  int nrows = layer == 1 ? TOK : NLAT;
  float* part = (float*)(p.ws + (layer == 1 ? O_PART1 : O_PART2));
  for (int r = blockIdx.x * 4 + (threadIdx.x >> 6); r < nrows; r += gridDim.x * 4) {
    const float4* row = (const float4*)(layer == 1 ? xrow1(p, r) : p.out + (size_t)r * D);
    float s = 0.f;
#pragma unroll
    for (int i = 0; i < 4; ++i) {
      float4 v = row[lane + 64 * i];
      s += v.x * v.x + v.y * v.y + v.z * v.z + v.w * v.w;
    }
    s = wave_sum(s);
    if (lane < 16) part[(size_t)lane * nrows + r] = lane == 0 ? s : 0.f;
  }
}
DI float rs_from_part(const float* part, int nrows, int r) {
  float s = 0.f;
#pragma unroll
  for (int j = 0; j < 16; ++j) s += part[(size_t)j * nrows + r];
  return rsqrtf(s * (1.f / 1024.f) + EPS);
}

DI void phase_n5(const Params& p) {
  const float* W = p.in[I_WIN1];
  const float* ng = p.in[I_NORMG] + 1024;
  const float* part = (const float*)(p.ws + O_PART1);
  bfr* U2 = (bfr*)(p.ws + O_U2);
  bfr* SZ1 = (bfr*)(p.ws + O_SZ1);
  const size_t total = (size_t)TOK * NIN1;
  for (size_t idx = (size_t)blockIdx.x * 256 + threadIdx.x; idx < total; idx += (size_t)gridDim.x * 256) {
    int tok = (int)(idx >> 11), n = (int)(idx & 2047);
    int b = tok / LALL, pos = tok - b * LALL;
    bool lat = pos >= LC;
    if (!lat && n >= 1024) continue;
    const float* xr = xrow1(p, tok);
    const float* md = modrow(p, 1, tok);
    float rs = rs_from_part(part, TOK, tok);
    float acc = 0.f;
    for (int k = 0; k < 1024; ++k) {
      float h = xr[k] * rs * ng[k] * (1.f + md[1024 + k]) + md[k];
      acc += h * W[(size_t)k * NIN1 + n];
    }
    if (n < 1024) U2[((size_t)(n >> 4) * TOK + tok) * 16 + (n & 15)] = f2bf(acc);
    else SZ1[((size_t)(b * SEQ + pos - LC)) * 1024 + (n - 1024)] = f2bf(silu_f(acc));
  }
}

DI void phase_n6(const Params& p, int dir) {
  int lane = threadIdx.x & 63;
  const bfr* U2 = (const bfr*)(p.ws + O_U2);
  bfr* YF = (bfr*)(p.ws + O_Y2);
  bfr* YG = (bfr*)(p.ws + O_YG);
  for (int w = blockIdx.x * 4 + (threadIdx.x >> 6); w < NB * 64; w += gridDim.x * 4) {
    int b = w >> 6, g = w & 63;
    double dt, ar, ai;
    float fr, fi, lr, li;
    s5_disc(p, dir, g, lane, dt, ar, ai, fr, fi);
    s5_pow(dt, ar, ai, 1, lr, li);
    float bbr[16], bbi[16], ccr[16], cci[16];
    const float* bre = p.in[I_BRE] + (((size_t)(dir * 64 + g)) * 64 + lane) * 16;
    const float* bim = p.in[I_BIM] + (((size_t)(dir * 64 + g)) * 64 + lane) * 16;
    const float* cre = p.in[I_CRE] + ((size_t)(dir * 64 + g)) * 16 * 64;
    const float* cim = p.in[I_CIM] + ((size_t)(dir * 64 + g)) * 16 * 64;
#pragma unroll
    for (int c = 0; c < 16; ++c) {
      float br = bre[c], bi = bim[c];
      bbr[c] = fr * br - fi * bi;
      bbi[c] = fr * bi + fi * br;
      ccr[c] = cre[c * 64 + lane];
      cci[c] = cim[c * 64 + lane];
    }
    float sr = 0.f, si = 0.f;
    const bfr* ub = U2 + ((size_t)g * TOK + (size_t)b * LALL) * 16;
    for (int step = 0; step < LALL; ++step) {
      int pos = dir == 0 ? step : (step < LC ? (LC - 1 - step) : (LALL - 1 - (step - LC)));
      const bfr* ur = ub + (size_t)pos * 16;
      float ur_f[16];
      float br = 0.f, bi = 0.f;
#pragma unroll
      for (int c = 0; c < 16; ++c) {
        float uv = bf2f(ur[c]);
        ur_f[c] = uv;
        br += bbr[c] * uv;
        bi += bbi[c] * uv;
      }
      float nr = lr * sr - li * si + br;
      float ni = lr * si + li * sr + bi;
      sr = nr; si = ni;
      if (pos >= LC) {
        float mine = 0.f, myu = 0.f;
#pragma unroll
        for (int c = 0; c < 16; ++c) {
          float t = wave_sum(ccr[c] * sr - cci[c] * si);
          if (lane == c) { mine = t; myu = ur_f[c]; }
        }
        if (lane < 16) {
          size_t o = ((size_t)(b * SEQ + pos - LC)) * 1024 + g * 16 + lane;
          if (dir == 0) YF[o] = f2bf(mine);
          else {
            float y = bf2f(YF[o]) + mine + p.in[I_S5D][g * 16 + lane] * myu;
            YG[o] = f2bf(gelu_tanh(y));
          }
        }
      }
    }
  }
}

DI void phase_n9(const Params& p) {
  const float* W = p.in[I_WGLU];
  const bfr* YG = (const bfr*)(p.ws + O_YG);
  const bfr* SZ1 = (const bfr*)(p.ws + O_SZ1);
  bfr* Y2 = (bfr*)(p.ws + O_Y2);
  const size_t total = (size_t)NLAT * 1024;
  for (size_t idx = (size_t)blockIdx.x * 256 + threadIdx.x; idx < total; idx += (size_t)gridDim.x * 256) {
    int lt = (int)(idx >> 10), n = (int)(idx & 1023);
    float acc = p.in[I_BGLU][n];
    for (int k = 0; k < 1024; ++k) acc += bf2f(YG[(size_t)lt * 1024 + k]) * W[(size_t)k * 1024 + n];
    float y = bf2f(YG[idx]);
    Y2[idx] = f2bf(y * sigmoid_f(acc) * bf2f(SZ1[idx]));
  }
}

DI void phase_n10(const Params& p) {
  const float* W = p.in[I_WOUT1];
  const bfr* Y2 = (const bfr*)(p.ws + O_Y2);
  const float* mod = (const float*)(p.ws + O_MOD);
  const size_t total = (size_t)NLAT * 1024;
  for (size_t idx = (size_t)blockIdx.x * 256 + threadIdx.x; idx < total; idx += (size_t)gridDim.x * 256) {
    int lt = (int)(idx >> 10), n = (int)(idx & 1023);
    int b = lt >> 11;
    float acc = 0.f;
    for (int k = 0; k < 1024; ++k) acc += bf2f(Y2[(size_t)lt * 1024 + k]) * W[(size_t)k * 1024 + n];
    p.out[idx] = p.out[idx] + mod[((size_t)(9 + b)) * 3072 + 2048 + n] * acc;
  }
}

DI void phase_final(const Params& p) {
  const int tidx_ = opaque_tid();
  const float* part = (const float*)(p.ws + O_PART2);
  const float* fg = p.in[I_FINALG];
  int lane = tidx_ & 63;
  for (int r = blockIdx.x * 4 + (tidx_ >> 6); r < NLAT; r += gridDim.x * 4) {
    float rs = rs_from_part(part, NLAT, r);
    float4* row = (float4*)(p.out + (size_t)r * D);
    const float4* g4 = (const float4*)fg;
#pragma unroll
    for (int i = 0; i < 4; ++i) {
      float4 v = row[lane + 64 * i];
      float4 g = g4[lane + 64 * i];
      v.x *= rs * g.x; v.y *= rs * g.y; v.z *= rs * g.z; v.w *= rs * g.w;
      row[lane + 64 * i] = v;
    }
  }
}

typedef short bf16x8 __attribute__((ext_vector_type(8)));
typedef short s16x4 __attribute__((ext_vector_type(4)));
typedef float f32x16 __attribute__((ext_vector_type(16)));
typedef __bf16 bf2_t __attribute__((ext_vector_type(2)));
typedef float f2_t __attribute__((ext_vector_type(2)));
DI unsigned pk2(float a, float b) {
  f2_t v = {a, b};
  bf2_t r = __builtin_convertvector(v, bf2_t);
  return __builtin_bit_cast(unsigned, r);
}
#define SCHED_FENCE() __builtin_amdgcn_sched_barrier(0)
#define MFMA32(a, b, c) __builtin_amdgcn_mfma_f32_32x32x16_bf16((a), (b), (c), 0, 0, 0)
DI int crow(int i, int h) { return (i & 3) + 8 * (i >> 2) + 4 * h; }

constexpr int LDT = 72;
struct GemmSmem {
  bfr A[128 * LDT];
  bfr B[128 * LDT];
  float gs[1024];
  float sh[1024];
  float rs[128];
};
static_assert(sizeof(GemmSmem) <= SMEM_BYTES, "smem");

DI void zero_acc(f32x16 (&acc)[2][2]) {
#pragma unroll
  for (int a = 0; a < 2; ++a)
#pragma unroll
    for (int b = 0; b < 2; ++b)
#pragma unroll
      for (int i = 0; i < 16; ++i) acc[a][b][i] = 0.f;
}

template <bool AF32, class AAddr, class BAddr>
DI void gemm_main(f32x16 (&acc)[2][2], int KT, AAddr aaddr, BAddr baddr, GemmSmem* sm) {
  const int tid = opaque_tid(), lane = tid & 63, wave = tid >> 6;
  const int wm = wave >> 1, wn = wave & 1, r = lane & 31, h = lane >> 5;
  uint4 bv0, bv1, bv2, bv3, av0, av1, av2, av3;
  float4 af0, af1, af2, af3, af4, af5, af6, af7;
  const int lrow = tid >> 3, lkc = (tid & 7) * 8;
  const int frow = tid >> 4, fkc = (tid & 15) * 4;
#define GM_LOAD(KT_)                                                                     \
  {                                                                                      \
    const int kk_ = (KT_) * 64;                                                          \
    bv0 = *(const uint4*)baddr(lrow, kk_ + lkc);                                         \
    bv1 = *(const uint4*)baddr(lrow + 32, kk_ + lkc);                                    \
    bv2 = *(const uint4*)baddr(lrow + 64, kk_ + lkc);                                    \
    bv3 = *(const uint4*)baddr(lrow + 96, kk_ + lkc);                                    \
    if constexpr (AF32) {                                                                \
      af0 = *(const float4*)(aaddr(frow) + kk_ + fkc);                                   \
      af1 = *(const float4*)(aaddr(frow + 16) + kk_ + fkc);                              \
      af2 = *(const float4*)(aaddr(frow + 32) + kk_ + fkc);                              \
      af3 = *(const float4*)(aaddr(frow + 48) + kk_ + fkc);                              \
      af4 = *(const float4*)(aaddr(frow + 64) + kk_ + fkc);                              \
      af5 = *(const float4*)(aaddr(frow + 80) + kk_ + fkc);                              \
      af6 = *(const float4*)(aaddr(frow + 96) + kk_ + fkc);                              \
      af7 = *(const float4*)(aaddr(frow + 112) + kk_ + fkc);                             \
    } else {                                                                             \
      av0 = *(const uint4*)aaddr(lrow, kk_ + lkc);                                       \
      av1 = *(const uint4*)aaddr(lrow + 32, kk_ + lkc);                                  \
      av2 = *(const uint4*)aaddr(lrow + 64, kk_ + lkc);                                  \
      av3 = *(const uint4*)aaddr(lrow + 96, kk_ + lkc);                                  \
    }                                                                                    \
  }
#define GM_STF(AF_, ROW_)                                                                \
  {                                                                                      \
    float rr_ = sm->rs[ROW_];                                                            \
    uint2 o_;                                                                            \
    o_.x = pk2(AF_.x * rr_ * g_.x + s_.x, AF_.y * rr_ * g_.y + s_.y);                    \
    o_.y = pk2(AF_.z * rr_ * g_.z + s_.z, AF_.w * rr_ * g_.w + s_.w);                    \
    *(uint2*)(sm->A + (ROW_) * LDT + fkc) = o_;                                          \
  }
#define GM_STORE(KT_)                                                                    \
  {                                                                                      \
    *(uint4*)(sm->B + lrow * LDT + lkc) = bv0;                                           \
    *(uint4*)(sm->B + (lrow + 32) * LDT + lkc) = bv1;                                    \
    *(uint4*)(sm->B + (lrow + 64) * LDT + lkc) = bv2;                                    \
    *(uint4*)(sm->B + (lrow + 96) * LDT + lkc) = bv3;                                    \
    if constexpr (AF32) {                                                                \
      const int k_ = (KT_) * 64 + fkc;                                                   \
      const float4 g_ = *(const float4*)(sm->gs + k_);                                   \
      const float4 s_ = *(const float4*)(sm->sh + k_);                                   \
      GM_STF(af0, frow) GM_STF(af1, frow + 16) GM_STF(af2, frow + 32) GM_STF(af3, frow + 48) \
      GM_STF(af4, frow + 64) GM_STF(af5, frow + 80) GM_STF(af6, frow + 96) GM_STF(af7, frow + 112) \
    } else {                                                                             \
      *(uint4*)(sm->A + lrow * LDT + lkc) = av0;                                         \
      *(uint4*)(sm->A + (lrow + 32) * LDT + lkc) = av1;                                  \
      *(uint4*)(sm->A + (lrow + 64) * LDT + lkc) = av2;                                  \
      *(uint4*)(sm->A + (lrow + 96) * LDT + lkc) = av3;                                  \
    }                                                                                    \
  }
  GM_LOAD(0)
  for (int kt = 0; kt < KT; ++kt) {
    GM_STORE(kt)
    __syncthreads();
    if (kt + 1 < KT) GM_LOAD(kt + 1)
    SCHED_FENCE();
#pragma unroll
    for (int ks = 0; ks < 4; ++ks) {
      bf16x8 a[2], b[2];
#pragma unroll
      for (int mi = 0; mi < 2; ++mi) a[mi] = *(const bf16x8*)(sm->A + (wm * 64 + mi * 32 + r) * LDT + ks * 16 + h * 8);
#pragma unroll
      for (int ni = 0; ni < 2; ++ni) b[ni] = *(const bf16x8*)(sm->B + (wn * 64 + ni * 32 + r) * LDT + ks * 16 + h * 8);
#pragma unroll
      for (int mi = 0; mi < 2; ++mi)
#pragma unroll
        for (int ni = 0; ni < 2; ++ni) acc[mi][ni] = MFMA32(a[mi], b[ni], acc[mi][ni]);
    }
    __syncthreads();
  }
}

DI float transpose_reduce16(float (&v)[16], int lane) {
  float r8[8], r4[4], r2[2];
  {
    bool up = lane & 8;
#pragma unroll
    for (int i = 0; i < 8; ++i) {
      float send = up ? v[i] : v[i + 8];
      float keep = up ? v[i + 8] : v[i];
      r8[i] = keep + __shfl_xor(send, 8);
    }
  }
  {
    bool up = lane & 4;
#pragma unroll
    for (int i = 0; i < 4; ++i) {
      float send = up ? r8[i] : r8[i + 4];
      float keep = up ? r8[i + 4] : r8[i];
      r4[i] = keep + __shfl_xor(send, 4);
    }
  }
  {
    bool up = lane & 2;
#pragma unroll
    for (int i = 0; i < 2; ++i) {
      float send = up ? r4[i] : r4[i + 2];
      float keep = up ? r4[i + 2] : r4[i];
      r2[i] = keep + __shfl_xor(send, 2);
    }
  }
  bool up = lane & 1;
  float send = up ? r2[0] : r2[1];
  float keep = up ? r2[1] : r2[0];
  return keep + __shfl_xor(send, 1);
}

#define WAVE_IDS                                              \
  const int tid = opaque_tid(), lane = tid & 63, wave = tid >> 6; \
  const int wm = wave >> 1, wn = wave & 1, r = lane & 31, h = lane >> 5; \
  (void)wm; (void)wn; (void)r; (void)h;

DI void phase_o1(const Params& p, char* smem) {
  GemmSmem* sm = (GemmSmem*)smem;
  WAVE_IDS
  const int NT = 12, units = (TOK / 128) * NT;
  const bfr* WT = (const bfr*)(p.ws + O_WT_IN0);
  const float* RS0 = (const float*)(p.ws + O_RS0);
  bfr* PC = (bfr*)(p.ws + O_PC);
  bfr* SZ0 = (bfr*)(p.ws + O_SZ0);
  bfr* Kb = (bfr*)(p.ws + O_K);
  for (int u = blockIdx.x; u < units; u += gridDim.x) {
    int mt = u / NT, nt = u - mt * NT;
    int m0 = mt * 128, n0 = nt * 128;
    __syncthreads();
    const float* md = modrow(p, 0, m0);
    const float* ng = p.in[I_NORMG];
    for (int k = tid; k < 1024; k += 256) {
      sm->gs[k] = ng[k] * (1.f + md[1024 + k]);
      sm->sh[k] = md[k];
    }
    if (tid < 128) sm->rs[tid] = RS0[m0 + tid];
    __syncthreads();
    const float* abase = xrow0(p, m0);
    f32x16 acc[2][2];
    zero_acc(acc);
    gemm_main<true>(
        acc, 16, [&](int row) { return abase + (size_t)row * 1024; },
        [&](int row, int k) {
          int n = n0 + row;
          n = n < NIN0 ? n : NIN0 - 1;
          return WT + (size_t)n * 1024 + k;
        },
        sm);
    int b = m0 / LALL, pos0 = m0 - b * LALL;
    bool lat = pos0 >= LC;
#pragma unroll
    for (int mi = 0; mi < 2; ++mi)
#pragma unroll
      for (int ni = 0; ni < 2; ++ni) {
        int col0 = n0 + wn * 64 + ni * 32;
        if (col0 >= NIN0) continue;
        int col = col0 + r;
#pragma unroll
        for (int i = 0; i < 16; ++i) {
          int row = wm * 64 + mi * 32 + crow(i, h);
          int tok = m0 + row;
          float v = acc[mi][ni][i];
          if (col0 < 384) {
            PC[(size_t)tok * 384 + col] = f2bf(v);
          } else if (col0 == 384) {
            float vp = __shfl_xor(v, 8);
            int pos = pos0 + row;
            float val = lat ? rope_apply(r, v, vp, pos - LC) : v;
            bfr bv = f2bf(val);
            for (int hh = 0; hh < NH; ++hh) Kb[(((size_t)(b * NH + hh)) * LALL + pos) * DQK + 64 + r] = bv;
          } else {
            SZ0[(size_t)tok * 1024 + (col - 416)] = f2bf(silu_f(v));
          }
          SCHED_FENCE();
        }
      }
  }
}

DI void phase_o2(const Params& p, char* smem) {
  GemmSmem* sm = (GemmSmem*)smem;
  WAVE_IDS
  const int UQ = (TOK / 128) * 12, UKV = (TOK / 128) * 16;
  const bfr* PC = (const bfr*)(p.ws + O_PC);
  bfr* Q = (bfr*)p.out;
  bfr* Kb = (bfr*)(p.ws + O_K);
  bfr* VT = (bfr*)(p.ws + O_VT);
  for (int u = blockIdx.x; u < UQ + UKV; u += gridDim.x) {
    bool isq = u < UQ;
    int uu = isq ? u : u - UQ;
    int NT = isq ? 12 : 16;
    int mt = uu / NT, nt = uu - mt * NT;
    int m0 = mt * 128, n0 = nt * 128;
    int Kd = isq ? 256 : 128;
    int aoff = isq ? 0 : 256;
    const bfr* WT = (const bfr*)(p.ws + (isq ? O_WT_UQ : O_WT_UKV));
    __syncthreads();
    {
      int row = tid >> 1, half = tid & 1;
      const bfr* ap = PC + (size_t)(m0 + row) * 384 + aoff + half * (Kd / 2);
      float ss = 0.f;
      for (int j = 0; j < Kd / 16; ++j) {
        uint4 v = *(const uint4*)(ap + j * 8);
        unsigned w[4] = {v.x, v.y, v.z, v.w};
#pragma unroll
        for (int e = 0; e < 4; ++e) {
          float lo = __uint_as_float(w[e] << 16), hi = __uint_as_float(w[e] & 0xffff0000u);
          ss += lo * lo + hi * hi;
        }
      }
      ss += __shfl_xor(ss, 1);
      if (half == 0) sm->rs[row] = rsqrtf(ss / (float)Kd + EPS);
    }
    __syncthreads();
    f32x16 acc[2][2];
    zero_acc(acc);
    gemm_main<false>(
        acc, Kd / 64, [&](int row, int k) { return PC + (size_t)(m0 + row) * 384 + aoff + k; },
        [&](int row, int k) { return WT + (size_t)(n0 + row) * Kd + k; }, sm);
    int b = m0 / LALL, pos0 = m0 - b * LALL;
    bool lat = pos0 >= LC;
#pragma unroll
    for (int mi = 0; mi < 2; ++mi)
#pragma unroll
      for (int ni = 0; ni < 2; ++ni) {
        int col0 = n0 + wn * 64 + ni * 32;
        if (isq) {
          int hh = col0 / 96, d0 = col0 - hh * 96;
          bool rope = lat && d0 == 64;
#pragma unroll
          for (int i = 0; i < 16; ++i) {
            int row = wm * 64 + mi * 32 + crow(i, h);
            int pos = pos0 + row;
            float v = acc[mi][ni][i] * sm->rs[row];
            float vp = __shfl_xor(v, 8);
            float val = rope ? rope_apply(r, v, vp, pos - LC) : v;
            Q[(((size_t)(b * NH + hh)) * LALL + pos) * DQK + d0 + r] = f2bf(val * QSCALE);
            SCHED_FENCE();
          }
        } else {
          int hh = col0 >> 7, d0 = col0 & 127;
          if (d0 < 64) {
#pragma unroll
            for (int i = 0; i < 16; ++i) {
              int row = wm * 64 + mi * 32 + crow(i, h);
              int pos = pos0 + row;
              float v = acc[mi][ni][i] * sm->rs[row];
              Kb[(((size_t)(b * NH + hh)) * LALL + pos) * DQK + d0 + r] = f2bf(v);
              SCHED_FENCE();
            }
          } else {
            int dvv = d0 - 64 + r;
#pragma unroll
            for (int g4 = 0; g4 < 4; ++g4) {
              int row = wm * 64 + mi * 32 + 8 * g4 + 4 * h;
              int pos = pos0 + row;
              uint2 o;
              o.x = pk2(acc[mi][ni][4 * g4 + 0] * sm->rs[row + 0], acc[mi][ni][4 * g4 + 1] * sm->rs[row + 1]);
              o.y = pk2(acc[mi][ni][4 * g4 + 2] * sm->rs[row + 2], acc[mi][ni][4 * g4 + 3] * sm->rs[row + 3]);
              *(uint2*)(VT + (((size_t)(b * NH + hh)) * DV + dvv) * LALL + pos) = o;
            }
          }
        }
      }
  }
}

constexpr int KLD = 104;
constexpr int VLD = 68;
struct AttnSmem {
  bfr K[64 * KLD];
  bfr V[64 * VLD];
};
static_assert(sizeof(AttnSmem) <= SMEM_BYTES, "smem");

DI void attn_item(const Params& p, AttnSmem* sm, int bh, int qpos0, int nkeys) {
  WAVE_IDS
  const bfr* Q = (const bfr*)p.out;
  const bfr* Kg = (const bfr*)(p.ws + O_K) + (size_t)bh * LALL * DQK;
  const bfr* Vg = (const bfr*)(p.ws + O_VT) + (size_t)bh * DV * LALL;
  const int qpos = qpos0 + wave * 32 + r;
  bf16x8 bq[6];
  {
    const bfr* qp = Q + ((size_t)bh * LALL + qpos) * DQK + 8 * h;
#pragma unroll
    for (int s = 0; s < 6; ++s) bq[s] = *(const bf16x8*)(qp + 16 * s);
  }
  f32x16 o[2];
#pragma unroll
  for (int d = 0; d < 2; ++d)
#pragma unroll
    for (int i = 0; i < 16; ++i) o[d][i] = 0.f;
  float mrun = 0.f, lrun = 0.f;
  uint4 kv0, kv1, kv2, vv0, vv1;
  const int kr0 = tid / 12, kc0 = (tid - kr0 * 12) * 8;
  const int kr1 = (tid + 256) / 12, kc1 = (tid + 256 - kr1 * 12) * 8;
  const int kr2 = (tid + 512) / 12, kc2 = (tid + 512 - kr2 * 12) * 8;
  const int vr0 = tid >> 3, vc0 = (tid & 7) * 8;
#define AT_GLOAD(KEY0_)                                                          \
  {                                                                              \
    const int key0_ = (KEY0_);                                                   \
    kv0 = *(const uint4*)(Kg + (size_t)(key0_ + kr0) * DQK + kc0);               \
    kv1 = *(const uint4*)(Kg + (size_t)(key0_ + kr1) * DQK + kc1);               \
    kv2 = *(const uint4*)(Kg + (size_t)(key0_ + kr2) * DQK + kc2);               \
    vv0 = *(const uint4*)(Vg + (size_t)vr0 * LALL + key0_ + vc0);                \
    vv1 = *(const uint4*)(Vg + (size_t)(vr0 + 32) * LALL + key0_ + vc0);         \
  }
#define AT_LSTORE()                                                              \
  {                                                                              \
    *(uint4*)(sm->K + kr0 * KLD + kc0) = kv0;                                    \
    *(uint4*)(sm->K + kr1 * KLD + kc1) = kv1;                                    \
    *(uint4*)(sm->K + kr2 * KLD + kc2) = kv2;                                    \
    uint2* d0_ = (uint2*)(sm->V + vr0 * VLD + vc0);                              \
    d0_[0] = make_uint2(vv0.x, vv0.y);                                           \
    d0_[1] = make_uint2(vv0.z, vv0.w);                                           \
    uint2* d1_ = (uint2*)(sm->V + (vr0 + 32) * VLD + vc0);                       \
    d1_[0] = make_uint2(vv1.x, vv1.y);                                           \
    d1_[1] = make_uint2(vv1.z, vv1.w);                                           \
  }
  const int NTI = nkeys / 64;
  AT_GLOAD(0)
  for (int it = 0; it < NTI; ++it) {
    AT_LSTORE()
    __syncthreads();
    if (it + 1 < NTI) AT_GLOAD((it + 1) * 64)
    SCHED_FENCE();
    f32x16 st[2];
    const float ninit = -mrun;
#pragma unroll
    for (int kb = 0; kb < 2; ++kb) {
#pragma unroll
      for (int i = 0; i < 16; ++i) st[kb][i] = ninit;
#pragma unroll
      for (int s = 0; s < 6; ++s) {
        bf16x8 ka = *(const bf16x8*)(sm->K + (kb * 32 + r) * KLD + 16 * s + 8 * h);
        st[kb] = MFMA32(ka, bq[s], st[kb]);
      }
    }
    float mx = fmaxf(fmaxf(st[0][0], st[0][1]), st[1][0]);
#pragma unroll
    for (int i = 2; i < 16; i += 2) mx = fmaxf(fmaxf(mx, st[0][i]), st[0][i + 1]);
#pragma unroll
    for (int i = 1; i < 15; i += 2) mx = fmaxf(fmaxf(mx, st[1][i]), st[1][i + 1]);
    mx = fmaxf(mx, st[1][15]);
    mx = fmaxf(mx, __shfl_xor(mx, 32));
    const bool need = (it == 0) || (mx > 8.f);
    if (__any(need)) {
      const float delta = need ? mx : 0.f;
      const float alpha = __builtin_amdgcn_exp2f(-delta);
      mrun += delta;
      lrun *= alpha;
#pragma unroll
      for (int d = 0; d < 2; ++d)
#pragma unroll
        for (int i = 0; i < 16; ++i) o[d][i] *= alpha;
#pragma unroll
      for (int kb = 0; kb < 2; ++kb)
#pragma unroll
        for (int i = 0; i < 16; ++i) st[kb][i] -= delta;
    }
    float ps = 0.f;
#pragma unroll
    for (int kb = 0; kb < 2; ++kb)
#pragma unroll
      for (int i = 0; i < 16; ++i) {
        float e = __builtin_amdgcn_exp2f(st[kb][i]);
        st[kb][i] = e;
        ps += e;
      }
    lrun += ps;
#pragma unroll
    for (int kb = 0; kb < 2; ++kb)
#pragma unroll
      for (int s2 = 0; s2 < 2; ++s2) {
        unsigned pw[4];
#pragma unroll
        for (int j = 0; j < 4; ++j) pw[j] = pk2(st[kb][8 * s2 + 2 * j], st[kb][8 * s2 + 2 * j + 1]);
        bf16x8 pb;
        {
          uint4 t = make_uint4(pw[0], pw[1], pw[2], pw[3]);
          pb = __builtin_bit_cast(bf16x8, t);
        }
#pragma unroll
        for (int d = 0; d < 2; ++d) {
          const bfr* vp = sm->V + (d * 32 + r) * VLD + kb * 32 + 16 * s2 + 4 * h;
          uint2 lo = *(const uint2*)vp;
          uint2 hi = *(const uint2*)(vp + 8);
          uint4 t = make_uint4(lo.x, lo.y, hi.x, hi.y);
          bf16x8 va = __builtin_bit_cast(bf16x8, t);
          o[d] = MFMA32(va, pb, o[d]);
        }
      }
    __syncthreads();
  }
  float ltot = lrun + __shfl_xor(lrun, 32);
  float inv = 1.f / ltot;
  int b = bh / NH, hh = bh - b * NH;
  size_t tok = (size_t)b * LALL + qpos;
  const bfr* SZ = (const bfr*)(p.ws + O_SZ0) + tok * 1024 + hh * 64;
  bfr* OG = (bfr*)(p.ws + O_OG) + tok * 1024 + hh * 64;
#pragma unroll
  for (int d = 0; d < 2; ++d)
#pragma unroll
    for (int g4 = 0; g4 < 4; ++g4) {
      int dv0 = d * 32 + 8 * g4 + 4 * h;
      uint2 z = *(const uint2*)(SZ + dv0);
      float z0 = __uint_as_float(z.x << 16), z1 = __uint_as_float(z.x & 0xffff0000u);
      float z2 = __uint_as_float(z.y << 16), z3 = __uint_as_float(z.y & 0xffff0000u);
      uint2 ov;
      ov.x = pk2(o[d][4 * g4 + 0] * inv * z0, o[d][4 * g4 + 1] * inv * z1);
      ov.y = pk2(o[d][4 * g4 + 2] * inv * z2, o[d][4 * g4 + 3] * inv * z3);
      *(uint2*)(OG + dv0) = ov;
    }
}

DI void phase_o3(const Params& p, char* smem) {
  AttnSmem* sm = (AttnSmem*)smem;
  const int xcd = blockIdx.x & 7, local = blockIdx.x >> 3, nloc = gridDim.x >> 3;
  for (int j = local; j < 256; j += nloc) {
    int u = xcd * 256 + j;
    attn_item(p, sm, u >> 4, LC + (u & 15) * 128, LALL);
  }
  for (int j = local; j < 32; j += nloc) {
    int u = xcd * 32 + j;
    attn_item(p, sm, u >> 1, (u & 1) * 128, LC);
  }
}

template <int LAYER>
DI void phase_oproj(const Params& p, char* smem) {
  GemmSmem* sm = (GemmSmem*)smem;
  WAVE_IDS
  constexpr int NROWS = LAYER == 0 ? TOK : NLAT;
  const int NT = 8, units = (NROWS / 128) * NT;
  const bfr* Ab = (const bfr*)(p.ws + (LAYER == 0 ? O_OG : O_Y2));
  const bfr* WT = (const bfr*)(p.ws + (LAYER == 0 ? O_WT_OUT0 : O_WT_OUT1));
  float* part = (float*)(p.ws + (LAYER == 0 ? O_PART1 : O_PART2));
  for (int u = blockIdx.x; u < units; u += gridDim.x) {
    int mt = u / NT, nt = u - mt * NT;
    int m0 = mt * 128, n0 = nt * 128;
    f32x16 acc[2][2];
    zero_acc(acc);
    gemm_main<false>(
        acc, 16, [&](int row, int k) { return Ab + (size_t)(m0 + row) * 1024 + k; },
        [&](int row, int k) { return WT + (size_t)(n0 + row) * 1024 + k; }, sm);
    const float* xin;
    float* xout;
    const float* gt;
    if (LAYER == 0) {
      xin = xrow0(p, m0);
      xout = xrow1(p, m0);
      gt = modrow(p, 0, m0) + 2048;
    } else {
      xin = p.out + (size_t)m0 * 1024;
      xout = p.out + (size_t)m0 * 1024;
      gt = (const float*)(p.ws + O_MOD) + ((size_t)(9 + (m0 >> 11))) * 3072 + 2048;
    }
    float tot = 0.f;
#pragma unroll
    for (int mi = 0; mi < 2; ++mi) {
      float sq[16];
#pragma unroll
      for (int i = 0; i < 16; ++i) sq[i] = 0.f;
#pragma unroll
      for (int ni = 0; ni < 2; ++ni) {
        int col = n0 + wn * 64 + ni * 32 + r;
        float g = gt[col];
        float xv[16];
#pragma unroll
        for (int i = 0; i < 16; ++i) xv[i] = xin[(size_t)(wm * 64 + mi * 32 + crow(i, h)) * 1024 + col];
        SCHED_FENCE();
#pragma unroll
        for (int i = 0; i < 16; ++i) {
          int row = wm * 64 + mi * 32 + crow(i, h);
          float v = xv[i] + g * acc[mi][ni][i];
          xout[(size_t)row * 1024 + col] = v;
          sq[i] += v * v;
        }
        SCHED_FENCE();
      }
      float t = transpose_reduce16(sq, lane);
      t += __shfl_xor(t, 16);
      if (((lane >> 4) & 1) == mi) tot = t;
    }
    int idx = lane & 31;
    int row = m0 + wm * 64 + (idx >> 4) * 32 + crow(idx & 15, h);
    part[(size_t)(nt * 2 + wn) * NROWS + row] = tot;
  }
}

DI void phase_o5(const Params& p, char* smem) {
  GemmSmem* sm = (GemmSmem*)smem;
  WAVE_IDS
  const int NT = 16, units = (TOK / 128) * NT;
  const bfr* WT = (const bfr*)(p.ws + O_WT_IN1);
  const float* part = (const float*)(p.ws + O_PART1);
  bfr* U2 = (bfr*)(p.ws + O_U2);
  bfr* SZ1 = (bfr*)(p.ws + O_SZ1);
  for (int u = blockIdx.x; u < units; u += gridDim.x) {
    int mt = u / NT, nt = u - mt * NT;
    int m0 = mt * 128, n0 = nt * 128;
    int b = m0 / LALL, pos0 = m0 - b * LALL;
    bool lat = pos0 >= LC;
    if (!lat && nt >= 8) continue;
    __syncthreads();
    const float* md = modrow(p, 1, m0);
    const float* ng = p.in[I_NORMG] + 1024;
    for (int k = tid; k < 1024; k += 256) {
      sm->gs[k] = ng[k] * (1.f + md[1024 + k]);
      sm->sh[k] = md[k];
    }
    if (tid < 128) sm->rs[tid] = rs_from_part(part, TOK, m0 + tid);
    __syncthreads();
    const float* abase = xrow1(p, m0);
    f32x16 acc[2][2];
    zero_acc(acc);
    gemm_main<true>(
        acc, 16, [&](int row) { return abase + (size_t)row * 1024; },
        [&](int row, int k) { return WT + (size_t)(n0 + row) * 1024 + k; }, sm);
#pragma unroll
    for (int mi = 0; mi < 2; ++mi)
#pragma unroll
      for (int ni = 0; ni < 2; ++ni) {
        int col = n0 + wn * 64 + ni * 32 + r;
#pragma unroll
        for (int i = 0; i < 16; ++i) {
          int row = wm * 64 + mi * 32 + crow(i, h);
          int tok = m0 + row;
          float v = acc[mi][ni][i];
          if (col < 1024) U2[((size_t)(col >> 4) * TOK + tok) * 16 + (col & 15)] = f2bf(v);
          else SZ1[((size_t)(b * SEQ + pos0 + row - LC)) * 1024 + (col - 1024)] = f2bf(silu_f(v));
          SCHED_FENCE();
        }
      }
  }
}

DI void phase_o6(const Params& p, char* smem) {
  GemmSmem* sm = (GemmSmem*)smem;
  WAVE_IDS
  const int NROW = NB * NCH;
  const int units = 64 * 5 * 2;
  const bfr* U2 = (const bfr*)(p.ws + O_U2);
  const bfr* WST = (const bfr*)(p.ws + O_WST);
  float* SLOC = (float*)(p.ws + O_SLOC);
  for (int u = blockIdx.x; u < units; u += gridDim.x) {
    int g = u / 10, rem = u - g * 10;
    int mt = rem >> 1, nt = rem & 1;
    int m0 = mt * 128, n0 = nt * 128;
    const bfr* Ag = U2 + (size_t)g * TOK * 16;
    const bfr* Bg = WST + (size_t)g * 256 * 512;
    f32x16 acc[2][2];
    zero_acc(acc);
    gemm_main<false>(
        acc, 8,
        [&](int row, int k) {
          int rr = m0 + row;
          rr = rr < NROW ? rr : NROW - 1;
          return Ag + (size_t)rr * 512 + k;
        },
        [&](int row, int k) { return Bg + (size_t)(n0 + row) * 512 + k; }, sm);
#pragma unroll
    for (int mi = 0; mi < 2; ++mi)
#pragma unroll
      for (int ni = 0; ni < 2; ++ni) {
        int col = n0 + wn * 64 + ni * 32 + r;
#pragma unroll
        for (int i = 0; i < 16; ++i) {
          int row = m0 + wm * 64 + mi * 32 + crow(i, h);
          if (row < NROW) SLOC[((size_t)g * NROW + row) * 256 + col] = acc[mi][ni][i];
        }
      }
  }
}

DI void phase_o7(const Params& p) {
  const int tidx_ = opaque_tid();
  const float* SLOC = (const float*)(p.ws + O_SLOC);
  bfr* SIN = (bfr*)(p.ws + O_SIN);
  const int total = NB * 64 * 2 * 64;
  for (int idx = blockIdx.x * 256 + tidx_; idx < total; idx += gridDim.x * 256) {
    int pp = idx & 63, dir = (idx >> 6) & 1, g = (idx >> 7) & 63, b = idx >> 13;
    double dt, ar, ai;
    float fr, fi, lr, li;
    s5_disc(p, dir, g, pp, dt, ar, ai, fr, fi);
    s5_pow(dt, ar, ai, TC, lr, li);
    float sr = 0.f, si = 0.f;
#pragma unroll 8
    for (int step = 0; step < NCH; ++step) {
      int cp = dir == 0 ? step : (step < 8 ? 7 - step : NCH - 1 - (step - 8));
      const float* sl = SLOC + ((size_t)g * (NB * NCH) + b * NCH + cp) * 256 + dir * 128 + pp;
#ifdef PROBE_NOCARRY
      if ((dir == 0 && cp == 8) || (dir == 1 && cp == NCH - 1)) { sr = 0.f; si = 0.f; }
#endif
      if (cp >= 8) {
        bfr* so = SIN + ((size_t)g * (NB * NCHL) + b * NCHL + (cp - 8)) * 256 + dir * 128 + pp;
        so[0] = f2bf(sr);
        so[64] = f2bf(si);
      }
      float lre = sl[0], lim = sl[64];
      float nr = lr * sr - li * si + lre;
      float ni = lr * si + li * sr + lim;
      sr = nr;
      si = ni;
    }
  }
}

DI void phase_o8(const Params& p, char* smem) {
  GemmSmem* sm = (GemmSmem*)smem;
  WAVE_IDS
  const int units = 64 * 4 * 4;
  const bfr* U2 = (const bfr*)(p.ws + O_U2);
  const bfr* SIN = (const bfr*)(p.ws + O_SIN);
  const bfr* KTAB = (const bfr*)(p.ws + O_KTAB);
  const bfr* VOP = (const bfr*)(p.ws + O_VOP);
  bfr* YG = (bfr*)(p.ws + O_YG);
  for (int u = blockIdx.x; u < units; u += gridDim.x) {
    int g = u >> 4, mt = (u >> 2) & 3, nt = u & 3;
    int m0 = mt * 128, n0 = nt * 128;
    const bfr* Ug = U2 + (size_t)g * TOK * 16;
    f32x16 acc[2][2];
    zero_acc(acc);
    gemm_main<false>(
        acc, 12,
        [&](int row, int k) {
          int rr = m0 + row;
          int b = rr >> 6, n = rr & 63;
          const bfr* a1 = Ug + ((size_t)b * LALL + LC + n * TC) * 16 + k;
          const bfr* a2 = SIN + ((size_t)g * (NB * NCHL) + rr) * 256 + (k - 512);
          return k < 512 ? a1 : a2;
        },
        [&](int row, int k) {
          int m = n0 + row;
          int t = m >> 4, c = m & 15;
          int j = k >> 4;
          const bfr* b1 = KTAB + (((size_t)g * 63 + (t - j + 31)) * 16 + c) * 16 + (k & 15);
          const bfr* b2 = VOP + ((size_t)g * 512 + m) * 256 + (k - 512);
          return k < 512 ? b1 : b2;
        },
        sm);
#pragma unroll
    for (int mi = 0; mi < 2; ++mi)
#pragma unroll
      for (int ni = 0; ni < 2; ++ni) {
        int m = n0 + wn * 64 + ni * 32 + r;
        int t = m >> 4, c = m & 15;
        int ch = g * 16 + c;
        float dd = p.in[I_S5D][ch];
        float uv[16];
#pragma unroll
        for (int i = 0; i < 16; ++i) {
          int rr = m0 + wm * 64 + mi * 32 + crow(i, h);
          int b = rr >> 6, n = rr & 63;
          uv[i] = bf2f(Ug[((size_t)b * LALL + LC + n * TC + t) * 16 + c]);
        }
        SCHED_FENCE();
#pragma unroll
        for (int i = 0; i < 16; ++i) {
          int rr = m0 + wm * 64 + mi * 32 + crow(i, h);
          int b = rr >> 6, n = rr & 63;
          float y = acc[mi][ni][i] + dd * uv[i];
          YG[((size_t)(b * SEQ + n * TC + t)) * 1024 + ch] = f2bf(gelu_tanh(y));
        }
        SCHED_FENCE();
      }
  }
}

DI void phase_o9(const Params& p, char* smem) {
  GemmSmem* sm = (GemmSmem*)smem;
  WAVE_IDS
  const int NT = 8, units = (NLAT / 128) * NT;
  const bfr* YG = (const bfr*)(p.ws + O_YG);
  const bfr* SZ1 = (const bfr*)(p.ws + O_SZ1);
  const bfr* WT = (const bfr*)(p.ws + O_WT_GLU);
  bfr* Y2 = (bfr*)(p.ws + O_Y2);
  for (int u = blockIdx.x; u < units; u += gridDim.x) {
    int mt = u / NT, nt = u - mt * NT;
    int m0 = mt * 128, n0 = nt * 128;
    f32x16 acc[2][2];
    zero_acc(acc);
    gemm_main<false>(
        acc, 16, [&](int row, int k) { return YG + (size_t)(m0 + row) * 1024 + k; },
        [&](int row, int k) { return WT + (size_t)(n0 + row) * 1024 + k; }, sm);
#pragma unroll
    for (int mi = 0; mi < 2; ++mi)
#pragma unroll
      for (int ni = 0; ni < 2; ++ni) {
        int col = n0 + wn * 64 + ni * 32 + r;
        float bg = p.in[I_BGLU][col];
        float yv[16], zv[16];
#pragma unroll
        for (int i = 0; i < 16; ++i) {
          size_t o = (size_t)(m0 + wm * 64 + mi * 32 + crow(i, h)) * 1024 + col;
          yv[i] = bf2f(YG[o]);
          zv[i] = bf2f(SZ1[o]);
        }
        SCHED_FENCE();
#pragma unroll
        for (int i = 0; i < 16; ++i) {
          size_t o = (size_t)(m0 + wm * 64 + mi * 32 + crow(i, h)) * 1024 + col;
          Y2[o] = f2bf(yv[i] * sigmoid_f(acc[mi][ni][i] + bg) * zv[i]);
        }
        SCHED_FENCE();
      }
  }
}

#define XB_TMO      128
#define XB_XCNT(j)  (256  + 64 * (j))
#define XB_XSUB(j)  (1280 + 64 * (j))
#define XB_XGEN(j)  (2304 + 64 * (j))
#define XB_TOP      3328
#define XB_TOPGEN   3392
#define XCD_BAR_WORDS 3456
#define XB_SPIN_CAP (1u << 18)
#define LAS __attribute__((address_space(3)))
DI unsigned xb_ld(unsigned* p) { return __hip_atomic_load(p, __ATOMIC_RELAXED, __HIP_MEMORY_SCOPE_AGENT); }
DI unsigned xb_add(unsigned* p, unsigned v) { return __hip_atomic_fetch_add(p, v, __ATOMIC_RELAXED, __HIP_MEMORY_SCOPE_AGENT); }
DI unsigned xb_xcc_id() { return (unsigned)__builtin_amdgcn_s_getreg((3 << 11) | 20) & 0xFu; }
#define XB_SPIN(cond, bar) do { unsigned _sp = 0; while (cond) { __builtin_amdgcn_s_sleep(1); \
    if ((++_sp & 255u) == 0u) { if (xb_ld(&(bar)[XB_TMO])) break; if (_sp > XB_SPIN_CAP) { atomicAdd(&(bar)[XB_TMO], 1u); break; } } } } while (0)
struct XcdBarrier {
  unsigned* bar;
  unsigned x;
  volatile LAS unsigned* st;
};
DI XcdBarrier xcd_barrier_post(unsigned* bar, volatile LAS unsigned* st) {
  XcdBarrier b;
  b.bar = bar;
  b.x = xb_xcc_id();
  b.st = st;
  if (threadIdx.x == 0) (void)xb_add(&bar[XB_XCNT(b.x)], 1u);
  return b;
}
DI void xcd_barrier_complete(unsigned* bar, unsigned x, unsigned& nloc, unsigned& nx) {
  const unsigned G = gridDim.x * gridDim.y * gridDim.z;
  unsigned sum, cnt, mine, sp = 0u;
  for (;;) {
    sum = 0u; cnt = 0u; mine = 0u;
#pragma unroll
    for (unsigned j = 0; j < 16; ++j) {
      const unsigned c = xb_ld(&bar[XB_XCNT(j)]);
      sum += c;
      cnt += (c > 0u) ? 1u : 0u;
      mine = (j == x) ? c : mine;
    }
    if (sum == G) break;
    __builtin_amdgcn_s_sleep(1);
    if ((++sp & 255u) == 0u) {
      if (xb_ld(&bar[XB_TMO])) break;
      if (sp > XB_SPIN_CAP) { atomicAdd(&bar[XB_TMO], 1u); break; }
    }
  }
  nloc = mine > 0u ? mine : 1u;
  nx = cnt > 0u ? cnt : 1u;
}
DI void xcd_barrier(const XcdBarrier& b) {
  asm volatile("s_waitcnt vmcnt(0)" ::: "memory");
  __syncthreads();
  if (threadIdx.x == 0) {
    unsigned* bar = b.bar;
    __builtin_amdgcn_s_waitcnt(0);
    unsigned nloc = b.st[0], nx = b.st[1];
    if (nloc == 0u) {
      xcd_barrier_complete(bar, b.x, nloc, nx);
      b.st[0] = nloc;
      b.st[1] = nx;
    }
    const unsigned old = xb_add(&bar[XB_XSUB(b.x)], 1u);
    const unsigned gen = old / nloc;
    if (old + 1u == (gen + 1u) * nloc) {
      __builtin_amdgcn_fence(__ATOMIC_RELEASE, "agent");
      asm volatile("s_waitcnt vmcnt(0)" ::: "memory");
      const unsigned og = xb_add(&bar[XB_TOP], 1u);
      const unsigned tg = og / nx;
      if (og + 1u == (tg + 1u) * nx) xb_add(&bar[XB_TOPGEN], 1u);
      else XB_SPIN(xb_ld(&bar[XB_TOPGEN]) == tg, bar);
      __builtin_amdgcn_fence(__ATOMIC_ACQUIRE, "agent");
      xb_add(&bar[XB_XGEN(b.x)], 1u);
      asm volatile("s_waitcnt vmcnt(0)" ::: "memory");
    } else {
      XB_SPIN(xb_ld(&bar[XB_XGEN(b.x)]) == gen, bar);
      __builtin_amdgcn_fence(__ATOMIC_ACQUIRE, "agent");
      asm volatile("s_waitcnt vmcnt(0)" ::: "memory");
    }
  }
  __syncthreads();
}

DI void run_phase(const Params& p, int ph, char* smem) {
  switch (ph) {
#if !defined(ONLY) || ONLY == 0
    case PH_PREP: phase_prep(p, smem); break;
#endif
#if USE_NAIVE
    case PH_N1: phase_n1(p); break;
    case PH_N2: phase_n2(p); break;
    case PH_N3: phase_n3(p); break;
    case PH_N4: phase_n4(p); break;
    case PH_N4B: phase_rowsq(p, 1); break;
    case PH_N5: phase_n5(p); break;
    case PH_N6A: phase_n6(p, 0); break;
    case PH_N6B: phase_n6(p, 1); break;
    case PH_N9: phase_n9(p); break;
    case PH_N10: phase_n10(p); break;
    case PH_N10B: phase_rowsq(p, 2); break;
#endif
#if !defined(ONLY) || ONLY == 1
    case PH_FINAL: phase_final(p); break;
#endif
#if !defined(ONLY) || ONLY == 2
    case PH_O1: phase_o1(p, smem); break;
#endif
#if !defined(ONLY) || ONLY == 3
    case PH_O2: phase_o2(p, smem); break;
#endif
#if !defined(ONLY) || ONLY == 4
    case PH_O3: phase_o3(p, smem); break;
#endif
#if !defined(ONLY) || ONLY == 5
    case PH_O4: phase_oproj<0>(p, smem); break;
#endif
#if !defined(ONLY) || ONLY == 6
    case PH_O5: phase_o5(p, smem); break;
#endif
#if !defined(ONLY) || ONLY == 7
    case PH_O6: phase_o6(p, smem); break;
#endif
#if !defined(ONLY) || ONLY == 8
    case PH_O7: phase_o7(p); break;
#endif
#if !defined(ONLY) || ONLY == 9
    case PH_O8: phase_o8(p, smem); break;
#endif
#if !defined(ONLY) || ONLY == 10
    case PH_O9: phase_o9(p, smem); break;
#endif
#if !defined(ONLY) || ONLY == 11
    case PH_O10: phase_oproj<1>(p, smem); break;
#endif
    default: break;
  }
}

__global__ void __launch_bounds__(256, 2) mega_one(Params p, int ph) {
  __shared__ __attribute__((aligned(16))) char smem[SMEM_BYTES];
  run_phase(p, ph, smem);
}

#if !defined(ONLY) && SINGLE_LAUNCH
__global__ void __launch_bounds__(256, 2) mega(Params p) {
  __shared__ __attribute__((aligned(16))) char smem[SMEM_BYTES];
  __shared__ uint4 xb_words;
  if (threadIdx.x == 0) xb_words = make_uint4(0u, 0u, 0u, 0u);
  __syncthreads();
  if (p.nprog < 0) cg::this_grid().sync();
  const XcdBarrier xb = xcd_barrier_post((unsigned*)(p.ws + O_BAR), (volatile LAS unsigned*)&xb_words);
  cg::grid_group grid = cg::this_grid();
#if !defined(OMIT) || OMIT != 0
  phase_prep(p, smem);
#endif
  xcd_barrier(xb);
#if (DUP >> 0) & 1
  phase_prep(p, smem);
  xcd_barrier(xb);
#endif
#if !defined(OMIT) || OMIT != 1
  phase_o1(p, smem);
#endif
  xcd_barrier(xb);
#if (DUP >> 1) & 1
  phase_o1(p, smem);
  xcd_barrier(xb);
#endif
#if !defined(OMIT) || OMIT != 2
  phase_o2(p, smem);
#endif
  xcd_barrier(xb);
#if (DUP >> 2) & 1
  phase_o2(p, smem);
  xcd_barrier(xb);
#endif
#if !defined(OMIT) || OMIT != 3
  phase_o3(p, smem);
#endif
  xcd_barrier(xb);
#if (DUP >> 3) & 1
  phase_o3(p, smem);
  xcd_barrier(xb);
#endif
#if !defined(OMIT) || OMIT != 4
  phase_oproj<0>(p, smem);
#endif
  xcd_barrier(xb);
#if (DUP >> 4) & 1
  phase_oproj<0>(p, smem);
  xcd_barrier(xb);
#endif
#if !defined(OMIT) || OMIT != 5
  phase_o5(p, smem);
#endif
  xcd_barrier(xb);
#if (DUP >> 5) & 1
  phase_o5(p, smem);
  xcd_barrier(xb);
#endif
#if !defined(OMIT) || OMIT != 6
  phase_o6(p, smem);
#endif
  xcd_barrier(xb);
#if (DUP >> 6) & 1
  phase_o6(p, smem);
  xcd_barrier(xb);
#endif
#if !defined(OMIT) || OMIT != 7
  phase_o7(p);
#endif
  xcd_barrier(xb);
#if (DUP >> 7) & 1
  phase_o7(p);
  xcd_barrier(xb);
#endif
#if !defined(OMIT) || OMIT != 8
  phase_o8(p, smem);
#endif
  xcd_barrier(xb);
#if (DUP >> 8) & 1
  phase_o8(p, smem);
  xcd_barrier(xb);
#endif
#if !defined(OMIT) || OMIT != 9
  phase_o9(p, smem);
#endif
  xcd_barrier(xb);
#if (DUP >> 9) & 1
  phase_o9(p, smem);
  xcd_barrier(xb);
#endif
#if !defined(OMIT) || OMIT != 10
  phase_oproj<1>(p, smem);
#endif
  xcd_barrier(xb);
#if !defined(OMIT) || OMIT != 11
  phase_final(p);
#endif
}
#else
__global__ void mega(Params p) {}
#endif


extern "C" void kernel_launch(void* const* d_in, const int* in_sizes, int n_in, void* d_out, int out_size, void* d_ws,
                              size_t ws_size, hipStream_t stream) {
  static int grid_blocks = 0;
  if (!grid_blocks) {
    int dev = 0, cus = 0, per_cu = 0;
    hipGetDevice(&dev);
    hipDeviceGetAttribute(&cus, hipDeviceAttributeMultiprocessorCount, dev);
#if SINGLE_LAUNCH
    hipOccupancyMaxActiveBlocksPerMultiprocessor(&per_cu, mega, 256, 0);
#else
    hipOccupancyMaxActiveBlocksPerMultiprocessor(&per_cu, mega_one, 256, 0);
#endif
    if (per_cu < 1) per_cu = 1;
    if (per_cu > 2) per_cu = 2;
    grid_blocks = cus * per_cu;
  }
  if (ws_size < WS_NEED || n_in < N_INPUTS) {
    fprintf(stderr, "workspace too small or bad inputs: %zu < %zu\n", ws_size, (size_t)WS_NEED);
    return;
  }
  Params p{};
  for (int i = 0; i < N_INPUTS; ++i) p.in[i] = (const float*)d_in[i];
  p.out = (float*)d_out;
  p.ws = (char*)d_ws;
#ifndef PROG
#define PROG PH_PREP, PH_O1, PH_O2, PH_O3, PH_O4, PH_O5, PH_O6, PH_O7, PH_O8, PH_O9, PH_O10, PH_FINAL
#endif
  const int prog[] = {PROG};
  p.nprog = (int)(sizeof(prog) / sizeof(int));
  for (int i = 0; i < p.nprog; ++i) p.prog[i] = prog[i];
#if SINGLE_LAUNCH
  hipMemsetAsync((char*)d_ws + O_BAR, 0, BAR_BYTES, stream);
  void* args[] = {&p};
  hipError_t e = hipLaunchCooperativeKernel((void*)mega, dim3(grid_blocks), dim3(256), args, 0, stream);
  if (e != hipSuccess) fprintf(stderr, "cooperative launch failed: %s (grid %d)\n", hipGetErrorString(e), grid_blocks);
#else
  for (int i = 0; i < p.nprog; ++i) {
    mega_one<<<dim3(grid_blocks), dim3(256), 0, stream>>>(p, p.prog[i]);
  }
#endif
}
```

```cpp
#include <hip/hip_runtime.h>
#include <hip/hip_cooperative_groups.h>
#include <cstdio>
namespace cg = cooperative_groups;
#ifndef DUP
#define DUP 0
#endif
#ifndef USE_NAIVE
#define USE_NAIVE 0
#endif
#ifndef SINGLE_LAUNCH
#define SINGLE_LAUNCH 1
#endif

#define DI __device__ __forceinline__
typedef unsigned short bfr;

constexpr int D = 1024, NB = 8, SEQ = 2048, LC = 256, LALL = 2304;
constexpr int TOK = NB * LALL;
constexpr int NLAT = NB * SEQ;
constexpr int NH = 16, DQK = 96, DV = 64;
constexpr int NIN0 = 1440, NIN1 = 2048;
constexpr float EPS = 1e-6f;
constexpr float QSCALE = 0.10206207261596577f * 1.4426950408889634f;
constexpr int TC = 32;
constexpr int NCH = LALL / TC;
constexpr int NCHL = SEQ / TC;

enum { I_X = 0, I_C, I_CTX, I_CCTX, I_ADAW, I_ADAB, I_NORMG, I_WIN0, I_QNORM, I_WUQ, I_KVNORM, I_WUKV, I_WOUT0,
       I_WIN1, I_ARE, I_AIM, I_LOGSTEP, I_BRE, I_BIM, I_CRE, I_CIM, I_S5D, I_WGLU, I_BGLU, I_WOUT1, I_FINALG, N_INPUTS };

constexpr size_t al256(size_t x) { return (x + 255) & ~(size_t)255; }
constexpr size_t O_WT_IN0 = 0;
constexpr size_t O_WT_UQ = O_WT_IN0 + al256((size_t)NIN0 * 1024 * 2);
constexpr size_t O_WT_UKV = O_WT_UQ + al256((size_t)1536 * 256 * 2);
constexpr size_t O_WT_OUT0 = O_WT_UKV + al256((size_t)2048 * 128 * 2);
constexpr size_t O_WT_IN1 = O_WT_OUT0 + al256((size_t)1024 * 1024 * 2);
constexpr size_t O_WT_GLU = O_WT_IN1 + al256((size_t)2048 * 1024 * 2);
constexpr size_t O_WT_OUT1 = O_WT_GLU + al256((size_t)1024 * 1024 * 2);
constexpr size_t O_MOD = O_WT_OUT1 + al256((size_t)1024 * 1024 * 2);
constexpr size_t O_RS0 = O_MOD + al256((size_t)2 * 9 * 3072 * 4);
constexpr size_t O_PART1 = O_RS0 + al256((size_t)TOK * 4);
constexpr size_t O_PART2 = O_PART1 + al256((size_t)16 * TOK * 4);
constexpr size_t O_X1CTX = O_PART2 + al256((size_t)16 * NLAT * 4);
constexpr size_t O_KTAB = O_X1CTX + al256((size_t)NB * LC * 1024 * 4);
constexpr size_t O_WST = O_KTAB + al256((size_t)64 * 63 * 256 * 2);
constexpr size_t O_VOP = O_WST + al256((size_t)64 * 256 * 512 * 2);
constexpr size_t O_BAR = O_VOP + al256((size_t)64 * 512 * 256 * 2);
constexpr size_t BAR_BYTES = 3456 * 4;
constexpr size_t O_LAYER = O_BAR + al256(BAR_BYTES);
constexpr size_t O_PC = O_LAYER;
constexpr size_t O_SZ0 = O_PC + al256((size_t)TOK * 384 * 2);
constexpr size_t O_K = O_SZ0 + al256((size_t)TOK * 1024 * 2);
constexpr size_t O_VT = O_K + al256((size_t)NB * NH * LALL * DQK * 2);
constexpr size_t O_OG = O_VT + al256((size_t)NB * NH * DV * LALL * 2);
constexpr size_t O_END0 = O_OG + al256((size_t)TOK * 1024 * 2);
constexpr size_t O_U2 = O_LAYER;
constexpr size_t O_SZ1 = O_U2 + al256((size_t)64 * TOK * 16 * 2);
constexpr size_t O_SLOC = O_SZ1 + al256((size_t)NLAT * 1024 * 2);
constexpr size_t O_SIN = O_SLOC + al256((size_t)64 * (NB * NCH) * 256 * 4);
constexpr size_t O_YG = O_SIN + al256((size_t)64 * (NB * NCHL) * 256 * 2);
constexpr size_t O_END1 = O_YG + al256((size_t)NLAT * 1024 * 2);
constexpr size_t O_Y2 = O_SLOC;
constexpr size_t WS_NEED = (O_END0 > O_END1 ? O_END0 : O_END1);
static_assert(WS_NEED <= (size_t)256 * 1024 * 1024, "workspace too large");
static_assert((size_t)NB * NH * LALL * DQK * 2 <= (size_t)NLAT * 1024 * 4, "Q does not fit d_out");

struct Params {
  const float* in[N_INPUTS];
  float* out;
  char* ws;
  int prog[32];
  int nprog;
  int pad;
};

DI bfr f2bf(float x) {
  unsigned u = __float_as_uint(x);
  u += 0x7fffu + ((u >> 16) & 1u);
  return (bfr)(u >> 16);
}
DI int opaque_tid() {
  int t = threadIdx.x;
  asm volatile("" : "+v"(t));
  return t;
}
DI float bf2f(bfr b) { return __uint_as_float(((unsigned)b) << 16); }
DI float silu_f(float v) { return v / (1.f + __expf(-v)); }
DI float sigmoid_f(float v) { return 1.f / (1.f + __expf(-v)); }
DI float gelu_tanh(float v) {
  float u = 0.7978845608028654f * (v + 0.044715f * v * v * v);
  return 0.5f * v * (1.f + tanhf(u));
}
DI float wave_sum(float v) {
#pragma unroll
  for (int o = 32; o > 0; o >>= 1) v += __shfl_xor(v, o);
  return v;
}
DI float wave_max(float v) {
#pragma unroll
  for (int o = 32; o > 0; o >>= 1) v = fmaxf(v, __shfl_xor(v, o));
  return v;
}
DI const float* xrow0(const Params& p, int tok) {
  int b = tok / LALL, pos = tok - b * LALL;
  return pos < LC ? p.in[I_CTX] + ((size_t)(b * LC + pos)) * D : p.in[I_X] + ((size_t)(b * SEQ + pos - LC)) * D;
}
DI float* xrow1(const Params& p, int tok) {
  int b = tok / LALL, pos = tok - b * LALL;
  return pos < LC ? (float*)(p.ws + O_X1CTX) + ((size_t)(b * LC + pos)) * D : p.out + ((size_t)(b * SEQ + pos - LC)) * D;
}
DI const float* modrow(const Params& p, int layer, int tok) {
  int b = tok / LALL, pos = tok - b * LALL;
  int r = pos < LC ? 8 : b;
  return (const float*)(p.ws + O_MOD) + ((size_t)(layer * 9 + r)) * 3072;
}
DI void rope_cs(int fi, int posv, float& cs, float& sn) {
  float inv = __builtin_amdgcn_exp2f(-(float)fi * (13.287712379549449f / 8.f));
  float rev = (float)posv * inv * 0.15915494309189535f;
  rev -= floorf(rev);
  sn = __builtin_amdgcn_sinf(rev);
  cs = __builtin_amdgcn_cosf(rev);
}
DI float rope_apply(int j, float v, float vp, int lpos) {
  int posv = (j & 16) ? (lpos & 63) : (lpos >> 6);
  float cs, sn;
  rope_cs(j & 7, posv, cs, sn);
  return (j & 8) ? (vp * sn + v * cs) : (v * cs - vp * sn);
}

DI void s5_disc(const Params& p, int dir, int g, int pp, double& dt, double& ar, double& ai, float& fr, float& fi) {
  dt = exp((double)p.in[I_LOGSTEP][dir * 64 + g]);
  ar = (double)p.in[I_ARE][(dir * 64 + g) * 64 + pp];
  ai = (double)p.in[I_AIM][(dir * 64 + g) * 64 + pp];
  double mag = exp(ar * dt);
  double a = ai * dt;
  a -= 6.283185307179586 * rint(a * 0.15915494309189535);
  float sn, cs;
  sincosf((float)a, &sn, &cs);
  double lr = mag * (double)cs, li = mag * (double)sn;
  double den = ar * ar + ai * ai, nr = lr - 1.0;
  fr = (float)((nr * ar + li * ai) / den);
  fi = (float)((li * ar - nr * ai) / den);
}
DI void s5_pow(double dt, double ar, double ai, int k, float& wr, float& wi) {
  double mag = exp(ar * dt * (double)k);
  double a = ai * dt * (double)k;
  a -= 6.283185307179586 * rint(a * 0.15915494309189535);
  float sn, cs;
  sincosf((float)a, &sn, &cs);
  wr = (float)mag * cs;
  wi = (float)mag * sn;
}

enum { PH_PREP = 0, PH_N1, PH_N2, PH_N3, PH_N4, PH_N4B, PH_N5, PH_N6A, PH_N6B, PH_N9, PH_N10, PH_N10B, PH_FINAL,
       PH_O1, PH_O2, PH_O3, PH_O4, PH_O5, PH_O6, PH_O7, PH_O8, PH_O9, PH_O10, PH_COUNT };

constexpr int SMEM_BYTES = 48 * 1024;


DI void prep_transpose(const Params& p, int widx, int tile, char* smem) {
  const int tidx_ = opaque_tid();
  int K, N;
  size_t dst;
  const float* W;
  const float* scl = nullptr;
  switch (widx) {
    case 0: W = p.in[I_WIN0]; K = 1024; N = NIN0; dst = O_WT_IN0; break;
    case 1: W = p.in[I_WUQ]; K = 256; N = 1536; dst = O_WT_UQ; scl = p.in[I_QNORM]; break;
    case 2: W = p.in[I_WUKV]; K = 128; N = 2048; dst = O_WT_UKV; scl = p.in[I_KVNORM]; break;
    case 3: W = p.in[I_WOUT0]; K = 1024; N = 1024; dst = O_WT_OUT0; break;
    case 4: W = p.in[I_WIN1]; K = 1024; N = NIN1; dst = O_WT_IN1; break;
    case 5: W = p.in[I_WGLU]; K = 1024; N = 1024; dst = O_WT_GLU; break;
    default: W = p.in[I_WOUT1]; K = 1024; N = 1024; dst = O_WT_OUT1; break;
  }
  float (*t)[33] = (float (*)[33])smem;
  int ntn = N / 32;
  int kt = tile / ntn, nt = tile - kt * ntn;
  int tx = tidx_ & 31, ty = tidx_ >> 5;
#pragma unroll
  for (int i = 0; i < 4; ++i) {
    int k = kt * 32 + ty + 8 * i, n = nt * 32 + tx;
    float v = W[(size_t)k * N + n];
    if (scl) v *= scl[k];
    t[ty + 8 * i][tx] = v;
  }
  __syncthreads();
  bfr* Wt = (bfr*)(p.ws + dst);
#pragma unroll
  for (int i = 0; i < 4; ++i) {
    int n = nt * 32 + ty + 8 * i, k = kt * 32 + tx;
    Wt[(size_t)n * K + k] = f2bf(t[tx][ty + 8 * i]);
  }
  __syncthreads();
}

DI void prep_mod(const Params& p, int unit, char* smem) {
  const int tidx_ = opaque_tid();
  int layer = unit / 192, cgp = unit - layer * 192;
  float* sil = (float*)smem;
  float* red = sil + 9 * 1024;
  for (int i = tidx_; i < 9 * 1024; i += 256) {
    int r = i >> 10, k = i & 1023;
    float v = r < 8 ? p.in[I_C][r * 1024 + k] : p.in[I_CCTX][k];
    sil[i] = silu_f(v);
  }
  __syncthreads();
  int nn = tidx_ & 15, kg = tidx_ >> 4;
  int n = cgp * 16 + nn;
  const float* W = p.in[I_ADAW] + (size_t)layer * 1024 * 3072 + n;
  float acc[9];
#pragma unroll
  for (int r = 0; r < 9; ++r) acc[r] = 0.f;
#pragma unroll 8
  for (int k = kg * 64; k < kg * 64 + 64; ++k) {
    float w = W[(size_t)k * 3072];
#pragma unroll
    for (int r = 0; r < 9; ++r) acc[r] += sil[r * 1024 + k] * w;
  }
#pragma unroll
  for (int r = 0; r < 9; ++r) red[(kg * 9 + r) * 16 + nn] = acc[r];
  __syncthreads();
  if (tidx_ < 144) {
    int r = tidx_ >> 4, c = tidx_ & 15;
    int nc = cgp * 16 + c;
    float s = p.in[I_ADAB][layer * 3072 + nc];
#pragma unroll
    for (int g = 0; g < 16; ++g) s += red[(g * 9 + r) * 16 + c];
    ((float*)(p.ws + O_MOD))[((size_t)(layer * 9 + r)) * 3072 + nc] = s;
  }
  __syncthreads();
}

DI void prep_rs0(const Params& p, int unit) {
  const int tidx_ = opaque_tid();
  int tok = unit * 4 + (tidx_ >> 6);
  int lane = tidx_ & 63;
  const float4* r = (const float4*)xrow0(p, tok);
  float s = 0.f;
#pragma unroll
  for (int i = 0; i < 4; ++i) {
    float4 v = r[lane + 64 * i];
    s += v.x * v.x + v.y * v.y + v.z * v.z + v.w * v.w;
  }
  s = wave_sum(s);
  if (lane == 0) ((float*)(p.ws + O_RS0))[tok] = rsqrtf(s * (1.f / 1024.f) + EPS);
}

DI void prep_ktab(const Params& p, int unit, char* smem) {
  const int tidx_ = opaque_tid();
  int g = unit / 63, lagidx = unit - g * 63;
  int lag = lagidx - 31;
  float2* E = (float2*)smem;
  int tid = tidx_;
  if (tid < 128) {
    int dir = tid >> 6, pp = tid & 63;
    bool used = (dir == 0) ? (lag >= 0) : (lag <= 0);
    float2 e = make_float2(0.f, 0.f);
    if (used) {
      double dt, ar, ai;
      float fr, fi, wr, wi;
      s5_disc(p, dir, g, pp, dt, ar, ai, fr, fi);
      s5_pow(dt, ar, ai, lag < 0 ? -lag : lag, wr, wi);
      e.x = wr * fr - wi * fi;
      e.y = wr * fi + wi * fr;
    }
    E[tid] = e;
  }
  __syncthreads();
  int c = tid >> 4, c2 = tid & 15;
  float acc = 0.f;
  for (int dir = 0; dir < 2; ++dir) {
    bool used = (dir == 0) ? (lag >= 0) : (lag <= 0);
    if (!used) continue;
    const float* bre = p.in[I_BRE] + ((size_t)(dir * 64 + g)) * 64 * 16;
    const float* bim = p.in[I_BIM] + ((size_t)(dir * 64 + g)) * 64 * 16;
    const float* cre = p.in[I_CRE] + ((size_t)(dir * 64 + g)) * 16 * 64;
    const float* cim = p.in[I_CIM] + ((size_t)(dir * 64 + g)) * 16 * 64;
#pragma unroll 8
    for (int pp = 0; pp < 64; ++pp) {
      float2 e = E[dir * 64 + pp];
      float br = bre[pp * 16 + c2], bi = bim[pp * 16 + c2];
      float gr = e.x * br - e.y * bi, gi = e.x * bi + e.y * br;
      float cr = cre[c * 64 + pp], ci = cim[c * 64 + pp];
      acc += cr * gr - ci * gi;
    }
  }
  ((bfr*)(p.ws + O_KTAB))[((size_t)unit * 16 + c) * 16 + c2] = f2bf(acc);
  __syncthreads();
}

DI void prep_ops(const Params& p, int unit) {
  const int tidx_ = opaque_tid();
  int idx = unit * 256 + tidx_;
  int pp = idx & 63, t = (idx >> 6) & 31, dir = (idx >> 11) & 1, g = idx >> 12;
  double dt, ar, ai;
  float fr, fi, wr, wi;
  s5_disc(p, dir, g, pp, dt, ar, ai, fr, fi);
  s5_pow(dt, ar, ai, dir == 0 ? (TC - 1 - t) : t, wr, wi);
  float er = wr * fr - wi * fi, ei = wr * fi + wi * fr;
  const float* bre = p.in[I_BRE] + (((size_t)(dir * 64 + g)) * 64 + pp) * 16;
  const float* bim = p.in[I_BIM] + (((size_t)(dir * 64 + g)) * 64 + pp) * 16;
  bfr* wst = (bfr*)(p.ws + O_WST) + (size_t)g * 256 * 512;
  bfr* rre = wst + (size_t)(dir * 128 + pp) * 512 + t * 16;
  bfr* rim = wst + (size_t)(dir * 128 + 64 + pp) * 512 + t * 16;
#pragma unroll
  for (int c2 = 0; c2 < 16; ++c2) {
    float br = bre[c2], bi = bim[c2];
    rre[c2] = f2bf(er * br - ei * bi);
    rim[c2] = f2bf(er * bi + ei * br);
  }
  s5_pow(dt, ar, ai, dir == 0 ? (t + 1) : (TC - t), wr, wi);
  const float* cre = p.in[I_CRE] + ((size_t)(dir * 64 + g)) * 16 * 64;
  const float* cim = p.in[I_CIM] + ((size_t)(dir * 64 + g)) * 16 * 64;
  bfr* vop = (bfr*)(p.ws + O_VOP) + (size_t)g * 512 * 256;
#pragma unroll
  for (int c = 0; c < 16; ++c) {
    float cr = cre[c * 64 + pp], ci = cim[c * 64 + pp];
    float dr = cr * wr - ci * wi, di = cr * wi + ci * wr;
    vop[(size_t)(t * 16 + c) * 256 + dir * 128 + pp] = f2bf(dr);
    vop[(size_t)(t * 16 + c) * 256 + dir * 128 + 64 + pp] = f2bf(-di);
  }
}

constexpr int TR_T0 = 32 * 45, TR_T1 = 8 * 48, TR_T2 = 4 * 64, TR_T3 = 1024, TR_T4 = 32 * 64, TR_T5 = 1024, TR_T6 = 1024;
constexpr int TR_TOTAL = TR_T0 + TR_T1 + TR_T2 + TR_T3 + TR_T4 + TR_T5 + TR_T6;
constexpr int U_MOD = 384, U_RS0 = TOK / 4, U_KTAB = 64 * 63, U_OPS = 64 * 2 * 64 * 32 / 256;
constexpr int PREP_UNITS = TR_TOTAL + U_MOD + U_RS0 + U_KTAB + U_OPS;

DI void phase_prep(const Params& p, char* smem) {
  for (int u = blockIdx.x; u < PREP_UNITS; u += gridDim.x) {
    int v = u;
    if (v < U_MOD) { prep_mod(p, v, smem); continue; }
    v -= U_MOD;
    if (v < TR_TOTAL) {
      int w = 0;
      if (v >= TR_T0) { v -= TR_T0; w = 1;
        if (v >= TR_T1) { v -= TR_T1; w = 2;
          if (v >= TR_T2) { v -= TR_T2; w = 3;
            if (v >= TR_T3) { v -= TR_T3; w = 4;
              if (v >= TR_T4) { v -= TR_T4; w = 5;
                if (v >= TR_T5) { v -= TR_T5; w = 6; } } } } } }
      prep_transpose(p, w, v, smem);
      continue;
    }
    v -= TR_TOTAL;
    if (v < U_RS0) { prep_rs0(p, v); continue; }
    v -= U_RS0;
    if (v < U_KTAB) { prep_ktab(p, v, smem); continue; }
    v -= U_KTAB;
    prep_ops(p, v);
  }
}

DI void phase_n1(const Params& p) {
  const float* W = p.in[I_WIN0];
  const float* rs0 = (const float*)(p.ws + O_RS0);
  const float* ng = p.in[I_NORMG];
  const size_t total = (size_t)TOK * NIN0;
  for (size_t idx = (size_t)blockIdx.x * 256 + threadIdx.x; idx < total; idx += (size_t)gridDim.x * 256) {
    int tok = (int)(idx / NIN0), n = (int)(idx - (size_t)tok * NIN0);
    int b = tok / LALL, pos = tok - b * LALL;
    bool lat = pos >= LC;
    const float* xr = xrow0(p, tok);
    const float* md = modrow(p, 0, tok);
    float rs = rs0[tok];
    bool rope = lat && n >= 384 && n < 416;
    int n2 = rope ? (n ^ 8) : n;
    float acc = 0.f, acc2 = 0.f;
    for (int k = 0; k < 1024; ++k) {
      float h = xr[k] * rs * ng[k] * (1.f + md[1024 + k]) + md[k];
      acc += h * W[(size_t)k * NIN0 + n];
      acc2 += h * W[(size_t)k * NIN0 + n2];
    }
    if (n < 384) {
      ((bfr*)(p.ws + O_PC))[(size_t)tok * 384 + n] = f2bf(acc);
    } else if (n < 416) {
      int j = n - 384;
      float v = rope ? rope_apply(j, acc, acc2, pos - LC) : acc;
      bfr bv = f2bf(v);
      bfr* K = (bfr*)(p.ws + O_K);
      for (int h = 0; h < NH; ++h) K[(((size_t)(b * NH + h)) * LALL + pos) * DQK + 64 + j] = bv;
    } else {
      ((bfr*)(p.ws + O_SZ0))[(size_t)tok * 1024 + (n - 416)] = f2bf(silu_f(acc));
    }
  }
}

DI void phase_n2(const Params& p) {
  const int NTOT = 1536 + 2048;
  const bfr* PC = (const bfr*)(p.ws + O_PC);
  const size_t total = (size_t)TOK * NTOT;
  bfr* Q = (bfr*)p.out;
  bfr* K = (bfr*)(p.ws + O_K);
  bfr* VT = (bfr*)(p.ws + O_VT);
  for (size_t idx = (size_t)blockIdx.x * 256 + threadIdx.x; idx < total; idx += (size_t)gridDim.x * 256) {
    int tok = (int)(idx / NTOT), n = (int)(idx - (size_t)tok * NTOT);
    int b = tok / LALL, pos = tok - b * LALL;
    bool lat = pos >= LC;
    if (n < 1536) {
      int h = n / 96, d = n - h * 96;
      bool rope = lat && d >= 64;
      int n2 = rope ? (n ^ 8) : n;
      const float* W = p.in[I_WUQ];
      const float* qn = p.in[I_QNORM];
      float acc = 0.f, acc2 = 0.f, ss = 0.f;
      for (int k = 0; k < 256; ++k) {
        float a = bf2f(PC[(size_t)tok * 384 + k]);
        ss += a * a;
        float aw = a * qn[k];
        acc += aw * W[(size_t)k * 1536 + n];
        acc2 += aw * W[(size_t)k * 1536 + n2];
      }
      float r = rsqrtf(ss * (1.f / 256.f) + EPS);
      acc *= r; acc2 *= r;
      float v = rope ? rope_apply(d - 64, acc, acc2, pos - LC) : acc;
      Q[(((size_t)(b * NH + h)) * LALL + pos) * DQK + d] = f2bf(v * QSCALE);
    } else {
      int n3 = n - 1536;
      int h = n3 / 128, d = n3 - h * 128;
      const float* W = p.in[I_WUKV];
      const float* kn = p.in[I_KVNORM];
      float acc = 0.f, ss = 0.f;
      for (int k = 0; k < 128; ++k) {
        float a = bf2f(PC[(size_t)tok * 384 + 256 + k]);
        ss += a * a;
        acc += a * kn[k] * W[(size_t)k * 2048 + n3];
      }
      acc *= rsqrtf(ss * (1.f / 128.f) + EPS);
      if (d < 64) K[(((size_t)(b * NH + h)) * LALL + pos) * DQK + d] = f2bf(acc);
      else VT[(((size_t)(b * NH + h)) * DV + (d - 64)) * LALL + pos] = f2bf(acc);
    }
  }
}

DI void phase_n3(const Params& p) {
  const bfr* Q = (const bfr*)p.out;
  const bfr* K = (const bfr*)(p.ws + O_K);
  const bfr* VT = (const bfr*)(p.ws + O_VT);
  const bfr* SZ = (const bfr*)(p.ws + O_SZ0);
  bfr* OG = (bfr*)(p.ws + O_OG);
  int lane = threadIdx.x & 63;
  const int total = NB * NH * LALL;
  for (int w = blockIdx.x * 4 + (threadIdx.x >> 6); w < total; w += gridDim.x * 4) {
    int bh = w / LALL, pos = w - bh * LALL;
    int b = bh / NH, h = bh - b * NH;
    int nk = pos < LC ? LC : LALL;
    const bfr* q = Q + ((size_t)bh * LALL + pos) * DQK;
    const bfr* kb = K + (size_t)bh * LALL * DQK;
    const bfr* vb = VT + (size_t)bh * DV * LALL;
    float s[36];
    float mx = -1e30f;
#pragma unroll
    for (int i = 0; i < 36; ++i) {
      int key = i * 64 + lane;
      float a = -1e30f;
      if (key < nk) {
        a = 0.f;
        const bfr* kr = kb + (size_t)key * DQK;
        for (int d = 0; d < DQK; ++d) a += bf2f(q[d]) * bf2f(kr[d]);
      }
      s[i] = a;
      mx = fmaxf(mx, a);
    }
    mx = wave_max(mx);
    float l = 0.f;
    float o[64];
#pragma unroll
    for (int d = 0; d < 64; ++d) o[d] = 0.f;
#pragma unroll
    for (int i = 0; i < 36; ++i) {
      int key = i * 64 + lane;
      if (key < nk) {
        float pr = exp2f(s[i] - mx);
        l += pr;
#pragma unroll
        for (int d = 0; d < 64; ++d) o[d] += pr * bf2f(vb[(size_t)d * LALL + key]);
      }
    }
    l = wave_sum(l);
    float mine = 0.f;
#pragma unroll
    for (int d = 0; d < 64; ++d) {
      float t = wave_sum(o[d]);
      if (lane == d) mine = t;
    }
    int tok = b * LALL + pos;
    float z = bf2f(SZ[(size_t)tok * 1024 + h * 64 + lane]);
    OG[(size_t)tok * 1024 + h * 64 + lane] = f2bf(mine / l * z);
  }
}

DI void phase_n4(const Params& p) {
  const float* W = p.in[I_WOUT0];
  const bfr* OG = (const bfr*)(p.ws + O_OG);
  const size_t total = (size_t)TOK * 1024;
  for (size_t idx = (size_t)blockIdx.x * 256 + threadIdx.x; idx < total; idx += (size_t)gridDim.x * 256) {
    int tok = (int)(idx >> 10), n = (int)(idx & 1023);
    float acc = 0.f;
    for (int k = 0; k < 1024; ++k) acc += bf2f(OG[(size_t)tok * 1024 + k]) * W[(size_t)k * 1024 + n];
    float v = xrow0(p, tok)[n] + modrow(p, 0, tok)[2048 + n] * acc;
    xrow1(p, tok)[n] = v;
  }
}

DI void phase_rowsq(const Params& p, int layer) {
  int lane = threadIdx.x & 63;
  int nrows = layer == 1 ? TOK : NLAT;
  float* part = (float*)(p.ws + (layer == 1 ? O_PART1 : O_PART2));
  for (int r = blockIdx.x * 4 + (threadIdx.x >> 6); r < nrows; r += gridDim.x * 4) {
    const float4* row = (const float4*)(layer == 1 ? xrow1(p, r) : p.out + (size_t)r * D);
    float s = 0.f;
#pragma unroll
    for (int i = 0; i < 4; ++i) {
      float4 v = row[lane + 64 * i];
      s += v.x * v.x + v.y * v.y + v.z * v.z + v.w * v.w;
    }
    s = wave_sum(s);
    if (lane < 16) part[(size_t)lane * nrows + r] = lane == 0 ? s : 0.f;
  }
}
DI float rs_from_part(const float* part, int nrows, int r) {
  float s = 0.f;
#pragma unroll
  for (int j = 0; j < 16; ++j) s += part[(size_t)j * nrows + r];
  return rsqrtf(s * (1.f / 1024.f) + EPS);
}

DI void phase_n5(const Params& p) {
  const float* W = p.in[I_WIN1];
  const float* ng = p.in[I_NORMG] + 1024;
  const float* part = (const float*)(p.ws + O_PART1);
  bfr* U2 = (bfr*)(p.ws + O_U2);
  bfr* SZ1 = (bfr*)(p.ws + O_SZ1);
  const size_t total = (size_t)TOK * NIN1;
  for (size_t idx = (size_t)blockIdx.x * 256 + threadIdx.x; idx < total; idx += (size_t)gridDim.x * 256) {
    int tok = (int)(idx >> 11), n = (int)(idx & 2047);
    int b = tok / LALL, pos = tok - b * LALL;
    bool lat = pos >= LC;
    if (!lat && n >= 1024) continue;
    const float* xr = xrow1(p, tok);
    const float* md = modrow(p, 1, tok);
    float rs = rs_from_part(part, TOK, tok);
    float acc = 0.f;
    for (int k = 0; k < 1024; ++k) {
      float h = xr[k] * rs * ng[k] * (1.f + md[1024 + k]) + md[k];
      acc += h * W[(size_t)k * NIN1 + n];
    }
    if (n < 1024) U2[((size_t)(n >> 4) * TOK + tok) * 16 + (n & 15)] = f2bf(acc);
    else SZ1[((size_t)(b * SEQ + pos - LC)) * 1024 + (n - 1024)] = f2bf(silu_f(acc));
  }
}

DI void phase_n6(const Params& p, int dir) {
  int lane = threadIdx.x & 63;
  const bfr* U2 = (const bfr*)(p.ws + O_U2);
  bfr* YF = (bfr*)(p.ws + O_Y2);
  bfr* YG = (bfr*)(p.ws + O_YG);
  for (int w = blockIdx.x * 4 + (threadIdx.x >> 6); w < NB * 64; w += gridDim.x * 4) {
    int b = w >> 6, g = w & 63;
    double dt, ar, ai;
    float fr, fi, lr, li;
    s5_disc(p, dir, g, lane, dt, ar, ai, fr, fi);
    s5_pow(dt, ar, ai, 1, lr, li);
    float bbr[16], bbi[16], ccr[16], cci[16];
    const float* bre = p.in[I_BRE] + (((size_t)(dir * 64 + g)) * 64 + lane) * 16;
    const float* bim = p.in[I_BIM] + (((size_t)(dir * 64 + g)) * 64 + lane) * 16;
    const float* cre = p.in[I_CRE] + ((size_t)(dir * 64 + g)) * 16 * 64;
    const float* cim = p.in[I_CIM] + ((size_t)(dir * 64 + g)) * 16 * 64;
#pragma unroll
    for (int c = 0; c < 16; ++c) {
      float br = bre[c], bi = bim[c];
      bbr[c] = fr * br - fi * bi;
      bbi[c] = fr * bi + fi * br;
      ccr[c] = cre[c * 64 + lane];
      cci[c] = cim[c * 64 + lane];
    }
    float sr = 0.f, si = 0.f;
    const bfr* ub = U2 + ((size_t)g * TOK + (size_t)b * LALL) * 16;
    for (int step = 0; step < LALL; ++step) {
      int pos = dir == 0 ? step : (step < LC ? (LC - 1 - step) : (LALL - 1 - (step - LC)));
      const bfr* ur = ub + (size_t)pos * 16;
      float ur_f[16];
      float br = 0.f, bi = 0.f;
#pragma unroll
      for (int c = 0; c < 16; ++c) {
        float uv = bf2f(ur[c]);
        ur_f[c] = uv;
        br += bbr[c] * uv;
        bi += bbi[c] * uv;
      }
      float nr = lr * sr - li * si + br;
      float ni = lr * si + li * sr + bi;
      sr = nr; si = ni;
      if (pos >= LC) {
        float mine = 0.f, myu = 0.f;
#pragma unroll
        for (int c = 0; c < 16; ++c) {
          float t = wave_sum(ccr[c] * sr - cci[c] * si);
          if (lane == c) { mine = t; myu = ur_f[c]; }
        }
        if (lane < 16) {
          size_t o = ((size_t)(b * SEQ + pos - LC)) * 1024 + g * 16 + lane;
          if (dir == 0) YF[o] = f2bf(mine);
          else {
            float y = bf2f(YF[o]) + mine + p.in[I_S5D][g * 16 + lane] * myu;
            YG[o] = f2bf(gelu_tanh(y));
          }
        }
      }
    }
  }
}

DI void phase_n9(const Params& p) {
  const float* W = p.in[I_WGLU];
  const bfr* YG = (const bfr*)(p.ws + O_YG);
  const bfr* SZ1 = (const bfr*)(p.ws + O_SZ1);
  bfr* Y2 = (bfr*)(p.ws + O_Y2);
  const size_t total = (size_t)NLAT * 1024;
  for (size_t idx = (size_t)blockIdx.x * 256 + threadIdx.x; idx < total; idx += (size_t)gridDim.x * 256) {
    int lt = (int)(idx >> 10), n = (int)(idx & 1023);
    float acc = p.in[I_BGLU][n];
    for (int k = 0; k < 1024; ++k) acc += bf2f(YG[(size_t)lt * 1024 + k]) * W[(size_t)k * 1024 + n];
    float y = bf2f(YG[idx]);
    Y2[idx] = f2bf(y * sigmoid_f(acc) * bf2f(SZ1[idx]));
  }
}

DI void phase_n10(const Params& p) {
  const float* W = p.in[I_WOUT1];
  const bfr* Y2 = (const bfr*)(p.ws + O_Y2);
  const float* mod = (const float*)(p.ws + O_MOD);
  const size_t total = (size_t)NLAT * 1024;
  for (size_t idx = (size_t)blockIdx.x * 256 + threadIdx.x; idx < total; idx += (size_t)gridDim.x * 256) {
    int lt = (int)(idx >> 10), n = (int)(idx & 1023);
    int b = lt >> 11;
    float acc = 0.f;
    for (int k = 0; k < 1024; ++k) acc += bf2f(Y2[(size_t)lt * 1024 + k]) * W[(size_t)k * 1024 + n];
    p.out[idx] = p.out[idx] + mod[((size_t)(9 + b)) * 3072 + 2048 + n] * acc;
  }
}

DI void phase_final(const Params& p) {
  const int tidx_ = opaque_tid();
  const float* part = (const float*)(p.ws + O_PART2);
  const float* fg = p.in[I_FINALG];
  int lane = tidx_ & 63;
  for (int r = blockIdx.x * 4 + (tidx_ >> 6); r < NLAT; r += gridDim.x * 4) {
    float rs = rs_from_part(part, NLAT, r);
    float4* row = (float4*)(p.out + (size_t)r * D);
    const float4* g4 = (const float4*)fg;
#pragma unroll
    for (int i = 0; i < 4; ++i) {
      float4 v = row[lane + 64 * i];
      float4 g = g4[lane + 64 * i];
      v.x *= rs * g.x; v.y *= rs * g.y; v.z *= rs * g.z; v.w *= rs * g.w;
      row[lane + 64 * i] = v;
    }
  }
}

typedef short bf16x8 __attribute__((ext_vector_type(8)));
typedef short s16x4 __attribute__((ext_vector_type(4)));
typedef float f32x16 __attribute__((ext_vector_type(16)));
typedef __bf16 bf2_t __attribute__((ext_vector_type(2)));
typedef float f2_t __attribute__((ext_vector_type(2)));
DI unsigned pk2(float a, float b) {
  f2_t v = {a, b};
  bf2_t r = __builtin_convertvector(v, bf2_t);
  return __builtin_bit_cast(unsigned, r);
}
#define SCHED_FENCE() __builtin_amdgcn_sched_barrier(0)
#define MFMA32(a, b, c) __builtin_amdgcn_mfma_f32_32x32x16_bf16((a), (b), (c), 0, 0, 0)
DI int xcd_swz(int u, int per) {
  int x = u & 7, q = u >> 3;
  int qq = q / per;
  return (x + 8 * qq) * per + (q - qq * per);
}
DI int crow(int i, int h) { return (i & 3) + 8 * (i >> 2) + 4 * h; }

constexpr int LDT = 72;
struct GemmSmem {
  bfr A[128 * LDT];
  bfr B[128 * LDT];
  float gs[1024];
  float sh[1024];
  float rs[128];
};
static_assert(sizeof(GemmSmem) <= SMEM_BYTES, "smem");

DI void zero_acc(f32x16 (&acc)[2][2]) {
#pragma unroll
  for (int a = 0; a < 2; ++a)
#pragma unroll
    for (int b = 0; b < 2; ++b)
#pragma unroll
      for (int i = 0; i < 16; ++i) acc[a][b][i] = 0.f;
}

template <bool AF32, class AAddr, class BAddr>
DI void gemm_main(f32x16 (&acc)[2][2], int KT, AAddr aaddr, BAddr baddr, GemmSmem* sm) {
  const int tid = opaque_tid(), lane = tid & 63, wave = tid >> 6;
  const int wm = wave >> 1, wn = wave & 1, r = lane & 31, h = lane >> 5;
  uint4 bv0, bv1, bv2, bv3, av0, av1, av2, av3;
  float4 af0, af1, af2, af3, af4, af5, af6, af7;
  const int lrow = tid >> 3, lkc = (tid & 7) * 8;
  const int frow = tid >> 4, fkc = (tid & 15) * 4;
#define GM_LOAD(KT_)                                                                     \
  {                                                                                      \
    const int kk_ = (KT_) * 64;                                                          \
    bv0 = *(const uint4*)baddr(lrow, kk_ + lkc);                                         \
    bv1 = *(const uint4*)baddr(lrow + 32, kk_ + lkc);                                    \
    bv2 = *(const uint4*)baddr(lrow + 64, kk_ + lkc);                                    \
    bv3 = *(const uint4*)baddr(lrow + 96, kk_ + lkc);                                    \
    if constexpr (AF32) {                                                                \
      af0 = *(const float4*)(aaddr(frow) + kk_ + fkc);                                   \
      af1 = *(const float4*)(aaddr(frow + 16) + kk_ + fkc);                              \
      af2 = *(const float4*)(aaddr(frow + 32) + kk_ + fkc);                              \
      af3 = *(const float4*)(aaddr(frow + 48) + kk_ + fkc);                              \
      af4 = *(const float4*)(aaddr(frow + 64) + kk_ + fkc);                              \
      af5 = *(const float4*)(aaddr(frow + 80) + kk_ + fkc);                              \
      af6 = *(const float4*)(aaddr(frow + 96) + kk_ + fkc);                              \
      af7 = *(const float4*)(aaddr(frow + 112) + kk_ + fkc);                             \
    } else {                                                                             \
      av0 = *(const uint4*)aaddr(lrow, kk_ + lkc);                                       \
      av1 = *(const uint4*)aaddr(lrow + 32, kk_ + lkc);                                  \
      av2 = *(const uint4*)aaddr(lrow + 64, kk_ + lkc);                                  \
      av3 = *(const uint4*)aaddr(lrow + 96, kk_ + lkc);                                  \
    }                                                                                    \
  }
#define GM_STF(AF_, ROW_)                                                                \
  {                                                                                      \
    float rr_ = sm->rs[ROW_];                                                            \
    uint2 o_;                                                                            \
    o_.x = pk2(AF_.x * rr_ * g_.x + s_.x, AF_.y * rr_ * g_.y + s_.y);                    \
    o_.y = pk2(AF_.z * rr_ * g_.z + s_.z, AF_.w * rr_ * g_.w + s_.w);                    \
    *(uint2*)(sm->A + (ROW_) * LDT + fkc) = o_;                                          \
  }
#define GM_STORE(KT_)                                                                    \
  {                                                                                      \
    *(uint4*)(sm->B + lrow * LDT + lkc) = bv0;                                           \
    *(uint4*)(sm->B + (lrow + 32) * LDT + lkc) = bv1;                                    \
    *(uint4*)(sm->B + (lrow + 64) * LDT + lkc) = bv2;                                    \
    *(uint4*)(sm->B + (lrow + 96) * LDT + lkc) = bv3;                                    \
    if constexpr (AF32) {                                                                \
      const int k_ = (KT_) * 64 + fkc;                                                   \
      const float4 g_ = *(const float4*)(sm->gs + k_);                                   \
      const float4 s_ = *(const float4*)(sm->sh + k_);                                   \
      GM_STF(af0, frow) GM_STF(af1, frow + 16) GM_STF(af2, frow + 32) GM_STF(af3, frow + 48) \
      GM_STF(af4, frow + 64) GM_STF(af5, frow + 80) GM_STF(af6, frow + 96) GM_STF(af7, frow + 112) \
    } else {                                                                             \
      *(uint4*)(sm->A + lrow * LDT + lkc) = av0;                                         \
      *(uint4*)(sm->A + (lrow + 32) * LDT + lkc) = av1;                                  \
      *(uint4*)(sm->A + (lrow + 64) * LDT + lkc) = av2;                                  \
      *(uint4*)(sm->A + (lrow + 96) * LDT + lkc) = av3;                                  \
    }                                                                                    \
  }
#define GM_COMPUTE()                                                                                           \
  _Pragma("unroll") for (int ks = 0; ks < 4; ++ks) {                                                           \
    bf16x8 a_[2], b_[2];                                                                                       \
    _Pragma("unroll") for (int mi = 0; mi < 2; ++mi)                                                           \
        a_[mi] = *(const bf16x8*)(sm->A + (wm * 64 + mi * 32 + r) * LDT + ks * 16 + h * 8);                    \
    _Pragma("unroll") for (int ni = 0; ni < 2; ++ni)                                                           \
        b_[ni] = *(const bf16x8*)(sm->B + (wn * 64 + ni * 32 + r) * LDT + ks * 16 + h * 8);                    \
    _Pragma("unroll") for (int mi = 0; mi < 2; ++mi)                                                           \
        _Pragma("unroll") for (int ni = 0; ni < 2; ++ni) acc[mi][ni] = MFMA32(a_[mi], b_[ni], acc[mi][ni]);    \
  }
  if constexpr (AF32) {
    GM_LOAD(0)
    for (int kt = 0; kt < KT; ++kt) {
      GM_STORE(kt)
      __syncthreads();
      if (kt + 1 < KT) GM_LOAD(kt + 1)
      SCHED_FENCE();
      GM_COMPUTE()
      __syncthreads();
    }
  } else {
    uint4 cv0, cv1, cv2, cv3, dv0, dv1, dv2, dv3;
#define GM_LOAD16(KT_, A0, A1, A2, A3, B0, B1, B2, B3)     \
  {                                                        \
    const int kk_ = (KT_) * 64 + lkc;                      \
    B0 = *(const uint4*)baddr(lrow, kk_);                  \
    B1 = *(const uint4*)baddr(lrow + 32, kk_);             \
    B2 = *(const uint4*)baddr(lrow + 64, kk_);             \
    B3 = *(const uint4*)baddr(lrow + 96, kk_);             \
    A0 = *(const uint4*)aaddr(lrow, kk_);                  \
    A1 = *(const uint4*)aaddr(lrow + 32, kk_);             \
    A2 = *(const uint4*)aaddr(lrow + 64, kk_);             \
    A3 = *(const uint4*)aaddr(lrow + 96, kk_);             \
  }
#define GM_STORE16(A0, A1, A2, A3, B0, B1, B2, B3)         \
  {                                                        \
    *(uint4*)(sm->B + lrow * LDT + lkc) = B0;              \
    *(uint4*)(sm->B + (lrow + 32) * LDT + lkc) = B1;       \
    *(uint4*)(sm->B + (lrow + 64) * LDT + lkc) = B2;       \
    *(uint4*)(sm->B + (lrow + 96) * LDT + lkc) = B3;       \
    *(uint4*)(sm->A + lrow * LDT + lkc) = A0;              \
    *(uint4*)(sm->A + (lrow + 32) * LDT + lkc) = A1;       \
    *(uint4*)(sm->A + (lrow + 64) * LDT + lkc) = A2;       \
    *(uint4*)(sm->A + (lrow + 96) * LDT + lkc) = A3;       \
  }
    GM_LOAD16(0, av0, av1, av2, av3, bv0, bv1, bv2, bv3)
    GM_LOAD16(1, cv0, cv1, cv2, cv3, dv0, dv1, dv2, dv3)
    SCHED_FENCE();
    for (int kt = 0; kt < KT; kt += 2) {
      GM_STORE16(av0, av1, av2, av3, bv0, bv1, bv2, bv3)
      __syncthreads();
      if (kt + 2 < KT) GM_LOAD16(kt + 2, av0, av1, av2, av3, bv0, bv1, bv2, bv3)
      SCHED_FENCE();
      GM_COMPUTE()
      __syncthreads();
      GM_STORE16(cv0, cv1, cv2, cv3, dv0, dv1, dv2, dv3)
      __syncthreads();
      if (kt + 3 < KT) GM_LOAD16(kt + 3, cv0, cv1, cv2, cv3, dv0, dv1, dv2, dv3)
      SCHED_FENCE();
      GM_COMPUTE()
      __syncthreads();
    }
  }
}

DI float transpose_reduce16(float (&v)[16], int lane) {
  float r8[8], r4[4], r2[2];
  {
    bool up = lane & 8;
#pragma unroll
    for (int i = 0; i < 8; ++i) {
      float send = up ? v[i] : v[i + 8];
      float keep = up ? v[i + 8] : v[i];
      r8[i] = keep + __shfl_xor(send, 8);
    }
  }
  {
    bool up = lane & 4;
#pragma unroll
    for (int i = 0; i < 4; ++i) {
      float send = up ? r8[i] : r8[i + 4];
      float keep = up ? r8[i + 4] : r8[i];
      r4[i] = keep + __shfl_xor(send, 4);
    }
  }
  {
    bool up = lane & 2;
#pragma unroll
    for (int i = 0; i < 2; ++i) {
      float send = up ? r4[i] : r4[i + 2];
      float keep = up ? r4[i + 2] : r4[i];
      r2[i] = keep + __shfl_xor(send, 2);
    }
  }
  bool up = lane & 1;
  float send = up ? r2[0] : r2[1];
  float keep = up ? r2[1] : r2[0];
  return keep + __shfl_xor(send, 1);
}

#define WAVE_IDS                                              \
  const int tid = opaque_tid(), lane = tid & 63, wave = tid >> 6; \
  const int wm = wave >> 1, wn = wave & 1, r = lane & 31, h = lane >> 5; \
  (void)wm; (void)wn; (void)r; (void)h;

DI void phase_o1(const Params& p, char* smem) {
  GemmSmem* sm = (GemmSmem*)smem;
  WAVE_IDS
  const int NT = 12, units = (TOK / 128) * NT;
  const bfr* WT = (const bfr*)(p.ws + O_WT_IN0);
  const float* RS0 = (const float*)(p.ws + O_RS0);
  bfr* PC = (bfr*)(p.ws + O_PC);
  bfr* SZ0 = (bfr*)(p.ws + O_SZ0);
  bfr* Kb = (bfr*)(p.ws + O_K);
  for (int u = blockIdx.x; u < units; u += gridDim.x) {
    const int us = xcd_swz(u, NT);
    int mt = us / NT, nt = us - mt * NT;
    int m0 = mt * 128, n0 = nt * 128;
    __syncthreads();
    const float* md = modrow(p, 0, m0);
    const float* ng = p.in[I_NORMG];
    for (int k = tid; k < 1024; k += 256) {
      sm->gs[k] = ng[k] * (1.f + md[1024 + k]);
      sm->sh[k] = md[k];
    }
    if (tid < 128) sm->rs[tid] = RS0[m0 + tid];
    __syncthreads();
    const float* abase = xrow0(p, m0);
    f32x16 acc[2][2];
    zero_acc(acc);
    gemm_main<true>(
        acc, 16, [&](int row) { return abase + (size_t)row * 1024; },
        [&](int row, int k) {
          int n = n0 + row;
          n = n < NIN0 ? n : NIN0 - 1;
          return WT + (size_t)n * 1024 + k;
        },
        sm);
    int b = m0 / LALL, pos0 = m0 - b * LALL;
    bool lat = pos0 >= LC;
#pragma unroll
    for (int mi = 0; mi < 2; ++mi)
#pragma unroll
      for (int ni = 0; ni < 2; ++ni) {
        int col0 = n0 + wn * 64 + ni * 32;
        if (col0 >= NIN0) continue;
        int col = col0 + r;
#pragma unroll
        for (int i = 0; i < 16; ++i) {
          int row = wm * 64 + mi * 32 + crow(i, h);
          int tok = m0 + row;
          float v = acc[mi][ni][i];
          if (col0 < 384) {
            PC[(size_t)tok * 384 + col] = f2bf(v);
          } else if (col0 == 384) {
            float vp = __shfl_xor(v, 8);
            int pos = pos0 + row;
            float val = lat ? rope_apply(r, v, vp, pos - LC) : v;
            bfr bv = f2bf(val);
            for (int hh = 0; hh < NH; ++hh) Kb[(((size_t)(b * NH + hh)) * LALL + pos) * DQK + 64 + r] = bv;
          } else {
            SZ0[(size_t)tok * 1024 + (col - 416)] = f2bf(silu_f(v));
          }
          SCHED_FENCE();
        }
      }
  }
}

DI void phase_o2(const Params& p, char* smem) {
  GemmSmem* sm = (GemmSmem*)smem;
  WAVE_IDS
  const int UQ = (TOK / 128) * 12, UKV = (TOK / 128) * 16;
  const bfr* PC = (const bfr*)(p.ws + O_PC);
  bfr* Q = (bfr*)p.out;
  bfr* Kb = (bfr*)(p.ws + O_K);
  bfr* VT = (bfr*)(p.ws + O_VT);
  for (int u = blockIdx.x; u < UQ + UKV; u += gridDim.x) {
    const int us = xcd_swz(u, 28);
    int mt = us / 28, rem = us - mt * 28;
    bool isq = rem < 12;
    int nt = isq ? rem : rem - 12;
    int m0 = mt * 128, n0 = nt * 128;
    int Kd = isq ? 256 : 128;
    int aoff = isq ? 0 : 256;
    const bfr* WT = (const bfr*)(p.ws + (isq ? O_WT_UQ : O_WT_UKV));
    __syncthreads();
    {
      int row = tid >> 1, half = tid & 1;
      const bfr* ap = PC + (size_t)(m0 + row) * 384 + aoff + half * (Kd / 2);
      float ss = 0.f;
      for (int j = 0; j < Kd / 16; ++j) {
        uint4 v = *(const uint4*)(ap + j * 8);
        unsigned w[4] = {v.x, v.y, v.z, v.w};
#pragma unroll
        for (int e = 0; e < 4; ++e) {
          float lo = __uint_as_float(w[e] << 16), hi = __uint_as_float(w[e] & 0xffff0000u);
          ss += lo * lo + hi * hi;
        }
      }
      ss += __shfl_xor(ss, 1);
      if (half == 0) sm->rs[row] = rsqrtf(ss / (float)Kd + EPS);
    }
    __syncthreads();
    f32x16 acc[2][2];
    zero_acc(acc);
    gemm_main<false>(
        acc, Kd / 64, [&](int row, int k) { return PC + (size_t)(m0 + row) * 384 + aoff + k; },
        [&](int row, int k) { return WT + (size_t)(n0 + row) * Kd + k; }, sm);
    int b = m0 / LALL, pos0 = m0 - b * LALL;
    bool lat = pos0 >= LC;
#pragma unroll
    for (int mi = 0; mi < 2; ++mi)
#pragma unroll
      for (int ni = 0; ni < 2; ++ni) {
        int col0 = n0 + wn * 64 + ni * 32;
        if (isq) {
          int hh = col0 / 96, d0 = col0 - hh * 96;
          bool rope = lat && d0 == 64;
#pragma unroll
          for (int i = 0; i < 16; ++i) {
            int row = wm * 64 + mi * 32 + crow(i, h);
            int pos = pos0 + row;
            float v = acc[mi][ni][i] * sm->rs[row];
            float vp = __shfl_xor(v, 8);
            float val = rope ? rope_apply(r, v, vp, pos - LC) : v;
            Q[(((size_t)(b * NH + hh)) * LALL + pos) * DQK + d0 + r] = f2bf(val * QSCALE);
            SCHED_FENCE();
          }
        } else {
          int hh = col0 >> 7, d0 = col0 & 127;
          if (d0 < 64) {
#pragma unroll
            for (int i = 0; i < 16; ++i) {
              int row = wm * 64 + mi * 32 + crow(i, h);
              int pos = pos0 + row;
              float v = acc[mi][ni][i] * sm->rs[row];
              Kb[(((size_t)(b * NH + hh)) * LALL + pos) * DQK + d0 + r] = f2bf(v);
              SCHED_FENCE();
            }
          } else {
            int dvv = d0 - 64 + r;
#pragma unroll
            for (int g4 = 0; g4 < 4; ++g4) {
              int row = wm * 64 + mi * 32 + 8 * g4 + 4 * h;
              int pos = pos0 + row;
              uint2 o;
              o.x = pk2(acc[mi][ni][4 * g4 + 0] * sm->rs[row + 0], acc[mi][ni][4 * g4 + 1] * sm->rs[row + 1]);
              o.y = pk2(acc[mi][ni][4 * g4 + 2] * sm->rs[row + 2], acc[mi][ni][4 * g4 + 3] * sm->rs[row + 3]);
              *(uint2*)(VT + (((size_t)(b * NH + hh)) * DV + dvv) * LALL + pos) = o;
            }
          }
        }
      }
  }
}

constexpr int KLD = 104;
constexpr int VLD = 68;
struct AttnSmem {
  bfr K[64 * KLD];
  bfr V[64 * VLD];
};
static_assert(sizeof(AttnSmem) <= SMEM_BYTES, "smem");

DI void attn_item(const Params& p, AttnSmem* sm, int bh, int qpos0, int nkeys) {
  WAVE_IDS
  const bfr* Q = (const bfr*)p.out;
  const bfr* Kg = (const bfr*)(p.ws + O_K) + (size_t)bh * LALL * DQK;
  const bfr* Vg = (const bfr*)(p.ws + O_VT) + (size_t)bh * DV * LALL;
  const int qpos = qpos0 + wave * 32 + r;
  bf16x8 bq[6];
  {
    const bfr* qp = Q + ((size_t)bh * LALL + qpos) * DQK + 8 * h;
#pragma unroll
    for (int s = 0; s < 6; ++s) bq[s] = *(const bf16x8*)(qp + 16 * s);
  }
  f32x16 o[2];
#pragma unroll
  for (int d = 0; d < 2; ++d)
#pragma unroll
    for (int i = 0; i < 16; ++i) o[d][i] = 0.f;
  float mrun = 0.f, lrun = 0.f;
  uint4 kv0, kv1, kv2, vv0, vv1;
  const int kr0 = tid / 12, kc0 = (tid - kr0 * 12) * 8;
  const int kr1 = (tid + 256) / 12, kc1 = (tid + 256 - kr1 * 12) * 8;
  const int kr2 = (tid + 512) / 12, kc2 = (tid + 512 - kr2 * 12) * 8;
  const int vr0 = tid >> 3, vc0 = (tid & 7) * 8;
#define AT_GLOAD(KEY0_)                                                          \
  {                                                                              \
    const int key0_ = (KEY0_);                                                   \
    kv0 = *(const uint4*)(Kg + (size_t)(key0_ + kr0) * DQK + kc0);               \
    kv1 = *(const uint4*)(Kg + (size_t)(key0_ + kr1) * DQK + kc1);               \
    kv2 = *(const uint4*)(Kg + (size_t)(key0_ + kr2) * DQK + kc2);               \
    vv0 = *(const uint4*)(Vg + (size_t)vr0 * LALL + key0_ + vc0);                \
    vv1 = *(const uint4*)(Vg + (size_t)(vr0 + 32) * LALL + key0_ + vc0);         \
  }
#define AT_LSTORE()                                                              \
  {                                                                              \
    *(uint4*)(sm->K + kr0 * KLD + kc0) = kv0;                                    \
    *(uint4*)(sm->K + kr1 * KLD + kc1) = kv1;                                    \
    *(uint4*)(sm->K + kr2 * KLD + kc2) = kv2;                                    \
    uint2* d0_ = (uint2*)(sm->V + vr0 * VLD + vc0);                              \
    d0_[0] = make_uint2(vv0.x, vv0.y);                                           \
    d0_[1] = make_uint2(vv0.z, vv0.w);                                           \
    uint2* d1_ = (uint2*)(sm->V + (vr0 + 32) * VLD + vc0);                       \
    d1_[0] = make_uint2(vv1.x, vv1.y);                                           \
    d1_[1] = make_uint2(vv1.z, vv1.w);                                           \
  }
  const int NTI = nkeys / 64;
  AT_GLOAD(0)
  for (int it = 0; it < NTI; ++it) {
    AT_LSTORE()
    __syncthreads();
    if (it + 1 < NTI) AT_GLOAD((it + 1) * 64)
    SCHED_FENCE();
    f32x16 st[2];
    const float ninit = -mrun;
#pragma unroll
    for (int kb = 0; kb < 2; ++kb) {
#pragma unroll
      for (int i = 0; i < 16; ++i) st[kb][i] = ninit;
#pragma unroll
      for (int s = 0; s < 6; ++s) {
        bf16x8 ka = *(const bf16x8*)(sm->K + (kb * 32 + r) * KLD + 16 * s + 8 * h);
        st[kb] = MFMA32(ka, bq[s], st[kb]);
      }
    }
    float mx = fmaxf(fmaxf(st[0][0], st[0][1]), st[1][0]);
#pragma unroll
    for (int i = 2; i < 16; i += 2) mx = fmaxf(fmaxf(mx, st[0][i]), st[0][i + 1]);
#pragma unroll
    for (int i = 1; i < 15; i += 2) mx = fmaxf(fmaxf(mx, st[1][i]), st[1][i + 1]);
    mx = fmaxf(mx, st[1][15]);
    mx = fmaxf(mx, __shfl_xor(mx, 32));
    const bool need = (it == 0) || (mx > 8.f);
    if (__any(need)) {
      const float delta = need ? mx : 0.f;
      const float alpha = __builtin_amdgcn_exp2f(-delta);
      mrun += delta;
      lrun *= alpha;
#pragma unroll
      for (int d = 0; d < 2; ++d)
#pragma unroll
        for (int i = 0; i < 16; ++i) o[d][i] *= alpha;
#pragma unroll
      for (int kb = 0; kb < 2; ++kb)
#pragma unroll
        for (int i = 0; i < 16; ++i) st[kb][i] -= delta;
    }
    float ps = 0.f;
#pragma unroll
    for (int kb = 0; kb < 2; ++kb)
#pragma unroll
      for (int i = 0; i < 16; ++i) {
        float e = __builtin_amdgcn_exp2f(st[kb][i]);
        st[kb][i] = e;
        ps += e;
      }
    lrun += ps;
#pragma unroll
    for (int kb = 0; kb < 2; ++kb)
#pragma unroll
      for (int s2 = 0; s2 < 2; ++s2) {
        unsigned pw[4];
#pragma unroll
        for (int j = 0; j < 4; ++j) pw[j] = pk2(st[kb][8 * s2 + 2 * j], st[kb][8 * s2 + 2 * j + 1]);
        bf16x8 pb;
        {
          uint4 t = make_uint4(pw[0], pw[1], pw[2], pw[3]);
          pb = __builtin_bit_cast(bf16x8, t);
        }
#pragma unroll
        for (int d = 0; d < 2; ++d) {
          const bfr* vp = sm->V + (d * 32 + r) * VLD + kb * 32 + 16 * s2 + 4 * h;
          uint2 lo = *(const uint2*)vp;
          uint2 hi = *(const uint2*)(vp + 8);
          uint4 t = make_uint4(lo.x, lo.y, hi.x, hi.y);
          bf16x8 va = __builtin_bit_cast(bf16x8, t);
          o[d] = MFMA32(va, pb, o[d]);
        }
      }
    __syncthreads();
  }
  float ltot = lrun + __shfl_xor(lrun, 32);
  float inv = 1.f / ltot;
  int b = bh / NH, hh = bh - b * NH;
  size_t tok = (size_t)b * LALL + qpos;
  const bfr* SZ = (const bfr*)(p.ws + O_SZ0) + tok * 1024 + hh * 64;
  bfr* OG = (bfr*)(p.ws + O_OG) + tok * 1024 + hh * 64;
#pragma unroll
  for (int d = 0; d < 2; ++d)
#pragma unroll
    for (int g4 = 0; g4 < 4; ++g4) {
      int dv0 = d * 32 + 8 * g4 + 4 * h;
      uint2 z = *(const uint2*)(SZ + dv0);
      float z0 = __uint_as_float(z.x << 16), z1 = __uint_as_float(z.x & 0xffff0000u);
      float z2 = __uint_as_float(z.y << 16), z3 = __uint_as_float(z.y & 0xffff0000u);
      uint2 ov;
      ov.x = pk2(o[d][4 * g4 + 0] * inv * z0, o[d][4 * g4 + 1] * inv * z1);
      ov.y = pk2(o[d][4 * g4 + 2] * inv * z2, o[d][4 * g4 + 3] * inv * z3);
      *(uint2*)(OG + dv0) = ov;
    }
}

DI void phase_o3(const Params& p, char* smem) {
  AttnSmem* sm = (AttnSmem*)smem;
  const int xcd = blockIdx.x & 7, local = blockIdx.x >> 3, nloc = gridDim.x >> 3;
  for (int j = local; j < 256; j += nloc) {
    int u = xcd * 256 + j;
    attn_item(p, sm, u >> 4, LC + (u & 15) * 128, LALL);
  }
  for (int j = local; j < 32; j += nloc) {
    int u = xcd * 32 + j;
    attn_item(p, sm, u >> 1, (u & 1) * 128, LC);
  }
}

template <int LAYER>
DI void phase_oproj(const Params& p, char* smem) {
  GemmSmem* sm = (GemmSmem*)smem;
  WAVE_IDS
  constexpr int NROWS = LAYER == 0 ? TOK : NLAT;
  const int NT = 8, units = (NROWS / 128) * NT;
  const bfr* Ab = (const bfr*)(p.ws + (LAYER == 0 ? O_OG : O_Y2));
  const bfr* WT = (const bfr*)(p.ws + (LAYER == 0 ? O_WT_OUT0 : O_WT_OUT1));
  float* part = (float*)(p.ws + (LAYER == 0 ? O_PART1 : O_PART2));
  for (int u = blockIdx.x; u < units; u += gridDim.x) {
    const int us = xcd_swz(u, NT);
    int mt = us / NT, nt = us - mt * NT;
    int m0 = mt * 128, n0 = nt * 128;
    f32x16 acc[2][2];
    zero_acc(acc);
    gemm_main<false>(
        acc, 16, [&](int row, int k) { return Ab + (size_t)(m0 + row) * 1024 + k; },
        [&](int row, int k) { return WT + (size_t)(n0 + row) * 1024 + k; }, sm);
    const float* xin;
    float* xout;
    const float* gt;
    if (LAYER == 0) {
      xin = xrow0(p, m0);
      xout = xrow1(p, m0);
      gt = modrow(p, 0, m0) + 2048;
    } else {
      xin = p.out + (size_t)m0 * 1024;
      xout = p.out + (size_t)m0 * 1024;
      gt = (const float*)(p.ws + O_MOD) + ((size_t)(9 + (m0 >> 11))) * 3072 + 2048;
    }
    float tot = 0.f;
#pragma unroll
    for (int mi = 0; mi < 2; ++mi) {
      float sq[16];
#pragma unroll
      for (int i = 0; i < 16; ++i) sq[i] = 0.f;
#pragma unroll
      for (int ni = 0; ni < 2; ++ni) {
        int col = n0 + wn * 64 + ni * 32 + r;
        float g = gt[col];
        float xv[16];
#pragma unroll
        for (int i = 0; i < 16; ++i) xv[i] = xin[(size_t)(wm * 64 + mi * 32 + crow(i, h)) * 1024 + col];
        SCHED_FENCE();
#pragma unroll
        for (int i = 0; i < 16; ++i) {
          int row = wm * 64 + mi * 32 + crow(i, h);
          float v = xv[i] + g * acc[mi][ni][i];
          xout[(size_t)row * 1024 + col] = v;
          sq[i] += v * v;
        }
        SCHED_FENCE();
      }
      float t = transpose_reduce16(sq, lane);
      t += __shfl_xor(t, 16);
      if (((lane >> 4) & 1) == mi) tot = t;
    }
    int idx = lane & 31;
    int row = m0 + wm * 64 + (idx >> 4) * 32 + crow(idx & 15, h);
    part[(size_t)(nt * 2 + wn) * NROWS + row] = tot;
  }
}

DI void phase_o5(const Params& p, char* smem) {
  GemmSmem* sm = (GemmSmem*)smem;
  WAVE_IDS
  const int NT = 16, units = (TOK / 128) * NT;
  const bfr* WT = (const bfr*)(p.ws + O_WT_IN1);
  const float* part = (const float*)(p.ws + O_PART1);
  bfr* U2 = (bfr*)(p.ws + O_U2);
  bfr* SZ1 = (bfr*)(p.ws + O_SZ1);
  for (int u = blockIdx.x; u < units; u += gridDim.x) {
    const int us = xcd_swz(u, NT);
    int mt = us / NT, nt = us - mt * NT;
    int m0 = mt * 128, n0 = nt * 128;
    int b = m0 / LALL, pos0 = m0 - b * LALL;
    bool lat = pos0 >= LC;
    if (!lat && nt >= 8) continue;
    __syncthreads();
    const float* md = modrow(p, 1, m0);
    const float* ng = p.in[I_NORMG] + 1024;
    for (int k = tid; k < 1024; k += 256) {
      sm->gs[k] = ng[k] * (1.f + md[1024 + k]);
      sm->sh[k] = md[k];
    }
    if (tid < 128) sm->rs[tid] = rs_from_part(part, TOK, m0 + tid);
    __syncthreads();
    const float* abase = xrow1(p, m0);
    f32x16 acc[2][2];
    zero_acc(acc);
    gemm_main<true>(
        acc, 16, [&](int row) { return abase + (size_t)row * 1024; },
        [&](int row, int k) { return WT + (size_t)(n0 + row) * 1024 + k; }, sm);
#pragma unroll
    for (int mi = 0; mi < 2; ++mi)
#pragma unroll
      for (int ni = 0; ni < 2; ++ni) {
        int col = n0 + wn * 64 + ni * 32 + r;
#pragma unroll
        for (int i = 0; i < 16; ++i) {
          int row = wm * 64 + mi * 32 + crow(i, h);
          int tok = m0 + row;
          float v = acc[mi][ni][i];
          if (col < 1024) U2[((size_t)(col >> 4) * TOK + tok) * 16 + (col & 15)] = f2bf(v);
          else SZ1[((size_t)(b * SEQ + pos0 + row - LC)) * 1024 + (col - 1024)] = f2bf(silu_f(v));
          SCHED_FENCE();
        }
      }
  }
}

DI void phase_o6(const Params& p, char* smem) {
  GemmSmem* sm = (GemmSmem*)smem;
  WAVE_IDS
  const int NROW = NB * NCH;
  const int units = 64 * 5 * 2;
  const bfr* U2 = (const bfr*)(p.ws + O_U2);
  const bfr* WST = (const bfr*)(p.ws + O_WST);
  float* SLOC = (float*)(p.ws + O_SLOC);
  for (int u = blockIdx.x; u < units; u += gridDim.x) {
    const int us = xcd_swz(u, 10);
    int g = us / 10, rem = us - g * 10;
    int mt = rem >> 1, nt = rem & 1;
    int m0 = mt * 128, n0 = nt * 128;
    const bfr* Ag = U2 + (size_t)g * TOK * 16;
    const bfr* Bg = WST + (size_t)g * 256 * 512;
    f32x16 acc[2][2];
    zero_acc(acc);
    gemm_main<false>(
        acc, 8,
        [&](int row, int k) {
          int rr = m0 + row;
          rr = rr < NROW ? rr : NROW - 1;
          return Ag + (size_t)rr * 512 + k;
        },
        [&](int row, int k) { return Bg + (size_t)(n0 + row) * 512 + k; }, sm);
#pragma unroll
    for (int mi = 0; mi < 2; ++mi)
#pragma unroll
      for (int ni = 0; ni < 2; ++ni) {
        int col = n0 + wn * 64 + ni * 32 + r;
#pragma unroll
        for (int i = 0; i < 16; ++i) {
          int row = m0 + wm * 64 + mi * 32 + crow(i, h);
          if (row < NROW) SLOC[((size_t)g * NROW + row) * 256 + col] = acc[mi][ni][i];
        }
      }
  }
}

DI void phase_o7(const Params& p) {
  const int tidx_ = opaque_tid();
  const float* SLOC = (const float*)(p.ws + O_SLOC);
  bfr* SIN = (bfr*)(p.ws + O_SIN);
  const int total = NB * 64 * 2 * 64;
  for (int idx = blockIdx.x * 256 + tidx_; idx < total; idx += gridDim.x * 256) {
    int pp = idx & 63, dir = (idx >> 6) & 1, g = (idx >> 7) & 63, b = idx >> 13;
    double dt, ar, ai;
    float fr, fi, lr, li;
    s5_disc(p, dir, g, pp, dt, ar, ai, fr, fi);
    s5_pow(dt, ar, ai, TC, lr, li);
    float sr = 0.f, si = 0.f;
#pragma unroll 8
    for (int step = 0; step < NCH; ++step) {
      int cp = dir == 0 ? step : (step < 8 ? 7 - step : NCH - 1 - (step - 8));
      const float* sl = SLOC + ((size_t)g * (NB * NCH) + b * NCH + cp) * 256 + dir * 128 + pp;
#ifdef PROBE_NOCARRY
      if ((dir == 0 && cp == 8) || (dir == 1 && cp == NCH - 1)) { sr = 0.f; si = 0.f; }
#endif
      if (cp >= 8) {
        bfr* so = SIN + ((size_t)g * (NB * NCHL) + b * NCHL + (cp - 8)) * 256 + dir * 128 + pp;
        so[0] = f2bf(sr);
        so[64] = f2bf(si);
      }
      float lre = sl[0], lim = sl[64];
      float nr = lr * sr - li * si + lre;
      float ni = lr * si + li * sr + lim;
      sr = nr;
      si = ni;
    }
  }
}

DI void phase_o8(const Params& p, char* smem) {
  GemmSmem* sm = (GemmSmem*)smem;
  WAVE_IDS
  const int units = 64 * 4 * 4;
  const bfr* U2 = (const bfr*)(p.ws + O_U2);
  const bfr* SIN = (const bfr*)(p.ws + O_SIN);
  const bfr* KTAB = (const bfr*)(p.ws + O_KTAB);
  const bfr* VOP = (const bfr*)(p.ws + O_VOP);
  bfr* YG = (bfr*)(p.ws + O_YG);
  for (int u = blockIdx.x; u < units; u += gridDim.x) {
    const int us = xcd_swz(u, 16);
    int g = us >> 4, mt = (us >> 2) & 3, nt = us & 3;
    int m0 = mt * 128, n0 = nt * 128;
    const bfr* Ug = U2 + (size_t)g * TOK * 16;
    f32x16 acc[2][2];
    zero_acc(acc);
    gemm_main<false>(
        acc, 8,
        [&](int row, int k) {
          int rr = m0 + row;
          int b = rr >> 6, n = rr & 63;
          return Ug + ((size_t)b * LALL + LC + n * TC) * 16 + k;
        },
        [&](int row, int k) {
          int m = n0 + row;
          int t = m >> 4, c = m & 15;
          return KTAB + (((size_t)g * 63 + (t + 31)) * 16 + c) * 16 - (k >> 4) * 256 + (k & 15);
        },
        sm);
    gemm_main<false>(
        acc, 4, [&](int row, int k) { return SIN + ((size_t)g * (NB * NCHL) + m0 + row) * 256 + k; },
        [&](int row, int k) { return VOP + ((size_t)g * 512 + n0 + row) * 256 + k; }, sm);
#pragma unroll
    for (int mi = 0; mi < 2; ++mi)
#pragma unroll
      for (int ni = 0; ni < 2; ++ni) {
        int m = n0 + wn * 64 + ni * 32 + r;
        int t = m >> 4, c = m & 15;
        int ch = g * 16 + c;
        float dd = p.in[I_S5D][ch];
        float uv[16];
#pragma unroll
        for (int i = 0; i < 16; ++i) {
          int rr = m0 + wm * 64 + mi * 32 + crow(i, h);
          int b = rr >> 6, n = rr & 63;
          uv[i] = bf2f(Ug[((size_t)b * LALL + LC + n * TC + t) * 16 + c]);
        }
        SCHED_FENCE();
#pragma unroll
        for (int i = 0; i < 16; ++i) {
          int rr = m0 + wm * 64 + mi * 32 + crow(i, h);
          int b = rr >> 6, n = rr & 63;
          float y = acc[mi][ni][i] + dd * uv[i];
          YG[((size_t)(b * SEQ + n * TC + t)) * 1024 + ch] = f2bf(gelu_tanh(y));
        }
        SCHED_FENCE();
      }
  }
}

DI void phase_o9(const Params& p, char* smem) {
  GemmSmem* sm = (GemmSmem*)smem;
  WAVE_IDS
  const int NT = 8, units = (NLAT / 128) * NT;
  const bfr* YG = (const bfr*)(p.ws + O_YG);
  const bfr* SZ1 = (const bfr*)(p.ws + O_SZ1);
  const bfr* WT = (const bfr*)(p.ws + O_WT_GLU);
  bfr* Y2 = (bfr*)(p.ws + O_Y2);
  for (int u = blockIdx.x; u < units; u += gridDim.x) {
    const int us = xcd_swz(u, NT);
    int mt = us / NT, nt = us - mt * NT;
    int m0 = mt * 128, n0 = nt * 128;
    f32x16 acc[2][2];
    zero_acc(acc);
    gemm_main<false>(
        acc, 16, [&](int row, int k) { return YG + (size_t)(m0 + row) * 1024 + k; },
        [&](int row, int k) { return WT + (size_t)(n0 + row) * 1024 + k; }, sm);
#pragma unroll
    for (int mi = 0; mi < 2; ++mi)
#pragma unroll
      for (int ni = 0; ni < 2; ++ni) {
        int col = n0 + wn * 64 + ni * 32 + r;
        float bg = p.in[I_BGLU][col];
        float yv[16], zv[16];
#pragma unroll
        for (int i = 0; i < 16; ++i) {
          size_t o = (size_t)(m0 + wm * 64 + mi * 32 + crow(i, h)) * 1024 + col;
          yv[i] = bf2f(YG[o]);
          zv[i] = bf2f(SZ1[o]);
        }
        SCHED_FENCE();
#pragma unroll
        for (int i = 0; i < 16; ++i) {
          size_t o = (size_t)(m0 + wm * 64 + mi * 32 + crow(i, h)) * 1024 + col;
          Y2[o] = f2bf(yv[i] * sigmoid_f(acc[mi][ni][i] + bg) * zv[i]);
        }
        SCHED_FENCE();
      }
  }
}

#define XB_TMO      128
#define XB_XCNT(j)  (256  + 64 * (j))
#define XB_XSUB(j)  (1280 + 64 * (j))
#define XB_XGEN(j)  (2304 + 64 * (j))
#define XB_TOP      3328
#define XB_TOPGEN   3392
#define XCD_BAR_WORDS 3456
#define XB_SPIN_CAP (1u << 18)
#define LAS __attribute__((address_space(3)))
DI unsigned xb_ld(unsigned* p) { return __hip_atomic_load(p, __ATOMIC_RELAXED, __HIP_MEMORY_SCOPE_AGENT); }
DI unsigned xb_add(unsigned* p, unsigned v) { return __hip_atomic_fetch_add(p, v, __ATOMIC_RELAXED, __HIP_MEMORY_SCOPE_AGENT); }
DI unsigned xb_xcc_id() { return (unsigned)__builtin_amdgcn_s_getreg((3 << 11) | 20) & 0xFu; }
#define XB_SPIN(cond, bar) do { unsigned _sp = 0; while (cond) { __builtin_amdgcn_s_sleep(1); \
    if ((++_sp & 255u) == 0u) { if (xb_ld(&(bar)[XB_TMO])) break; if (_sp > XB_SPIN_CAP) { atomicAdd(&(bar)[XB_TMO], 1u); break; } } } } while (0)
struct XcdBarrier {
  unsigned* bar;
  unsigned x;
  volatile LAS unsigned* st;
};
DI XcdBarrier xcd_barrier_post(unsigned* bar, volatile LAS unsigned* st) {
  XcdBarrier b;
  b.bar = bar;
  b.x = xb_xcc_id();
  b.st = st;
  if (threadIdx.x == 0) (void)xb_add(&bar[XB_XCNT(b.x)], 1u);
  return b;
}
DI void xcd_barrier_complete(unsigned* bar, unsigned x, unsigned& nloc, unsigned& nx) {
  const unsigned G = gridDim.x * gridDim.y * gridDim.z;
  unsigned sum, cnt, mine, sp = 0u;
  for (;;) {
    sum = 0u; cnt = 0u; mine = 0u;
#pragma unroll
    for (unsigned j = 0; j < 16; ++j) {
      const unsigned c = xb_ld(&bar[XB_XCNT(j)]);
      sum += c;
      cnt += (c > 0u) ? 1u : 0u;
      mine = (j == x) ? c : mine;
    }
    if (sum == G) break;
    __builtin_amdgcn_s_sleep(1);
    if ((++sp & 255u) == 0u) {
      if (xb_ld(&bar[XB_TMO])) break;
      if (sp > XB_SPIN_CAP) { atomicAdd(&bar[XB_TMO], 1u); break; }
    }
  }
  nloc = mine > 0u ? mine : 1u;
  nx = cnt > 0u ? cnt : 1u;
}
DI void xcd_barrier(const XcdBarrier& b) {
  asm volatile("s_waitcnt vmcnt(0)" ::: "memory");
  __syncthreads();
  if (threadIdx.x == 0) {
    unsigned* bar = b.bar;
    __builtin_amdgcn_s_waitcnt(0);
    unsigned nloc = b.st[0], nx = b.st[1];
    if (nloc == 0u) {
      xcd_barrier_complete(bar, b.x, nloc, nx);
      b.st[0] = nloc;
      b.st[1] = nx;
    }
    const unsigned old = xb_add(&bar[XB_XSUB(b.x)], 1u);
    const unsigned gen = old / nloc;
    if (old + 1u == (gen + 1u) * nloc) {
      __builtin_amdgcn_fence(__ATOMIC_RELEASE, "agent");
      asm volatile("s_waitcnt vmcnt(0)" ::: "memory");
      const unsigned og = xb_add(&bar[XB_TOP], 1u);
      const unsigned tg = og / nx;
      if (og + 1u == (tg + 1u) * nx) xb_add(&bar[XB_TOPGEN], 1u);
      else XB_SPIN(xb_ld(&bar[XB_TOPGEN]) == tg, bar);
      __builtin_amdgcn_fence(__ATOMIC_ACQUIRE, "agent");
      xb_add(&bar[XB_XGEN(b.x)], 1u);
      asm volatile("s_waitcnt vmcnt(0)" ::: "memory");
    } else {
      XB_SPIN(xb_ld(&bar[XB_XGEN(b.x)]) == gen, bar);
      __builtin_amdgcn_fence(__ATOMIC_ACQUIRE, "agent");
      asm volatile("s_waitcnt vmcnt(0)" ::: "memory");
    }
  }
  __syncthreads();
}

DI void run_phase(const Params& p, int ph, char* smem) {
  switch (ph) {
#if !defined(ONLY) || ONLY == 0
    case PH_PREP: phase_prep(p, smem); break;
#endif
#if USE_NAIVE
    case PH_N1: phase_n1(p); break;
    case PH_N2: phase_n2(p); break;
    case PH_N3: phase_n3(p); break;
    case PH_N4: phase_n4(p); break;
    case PH_N4B: phase_rowsq(p, 1); break;
    case PH_N5: phase_n5(p); break;
    case PH_N6A: phase_n6(p, 0); break;
    case PH_N6B: phase_n6(p, 1); break;
    case PH_N9: phase_n9(p); break;
    case PH_N10: phase_n10(p); break;
    case PH_N10B: phase_rowsq(p, 2); break;
#endif
#if !defined(ONLY) || ONLY == 1
    case PH_FINAL: phase_final(p); break;
#endif
#if !defined(ONLY) || ONLY == 2
    case PH_O1: phase_o1(p, smem); break;
#endif
#if !defined(ONLY) || ONLY == 3
    case PH_O2: phase_o2(p, smem); break;
#endif
#if !defined(ONLY) || ONLY == 4
    case PH_O3: phase_o3(p, smem); break;
#endif
#if !defined(ONLY) || ONLY == 5
    case PH_O4: phase_oproj<0>(p, smem); break;
#endif
#if !defined(ONLY) || ONLY == 6
    case PH_O5: phase_o5(p, smem); break;
#endif
#if !defined(ONLY) || ONLY == 7
    case PH_O6: phase_o6(p, smem); break;
#endif
#if !defined(ONLY) || ONLY == 8
    case PH_O7: phase_o7(p); break;
#endif
#if !defined(ONLY) || ONLY == 9
    case PH_O8: phase_o8(p, smem); break;
#endif
#if !defined(ONLY) || ONLY == 10
    case PH_O9: phase_o9(p, smem); break;
#endif
#if !defined(ONLY) || ONLY == 11
    case PH_O10: phase_oproj<1>(p, smem); break;
#endif
    default: break;
  }
}

__global__ void __launch_bounds__(256, 2) mega_one(Params p, int ph) {
  __shared__ __attribute__((aligned(16))) char smem[SMEM_BYTES];
  run_phase(p, ph, smem);
}

#if !defined(ONLY) && SINGLE_LAUNCH
__global__ void __launch_bounds__(256, 2) mega(Params p) {
  __shared__ __attribute__((aligned(16))) char smem[SMEM_BYTES];
  __shared__ uint4 xb_words;
  if (threadIdx.x == 0) xb_words = make_uint4(0u, 0u, 0u, 0u);
  __syncthreads();
  if (p.nprog < 0) cg::this_grid().sync();
  const XcdBarrier xb = xcd_barrier_post((unsigned*)(p.ws + O_BAR), (volatile LAS unsigned*)&xb_words);
  cg::grid_group grid = cg::this_grid();
#if !defined(OMIT) || OMIT != 0
  phase_prep(p, smem);
#endif
  xcd_barrier(xb);
#if (DUP >> 0) & 1
  phase_prep(p, smem);
  xcd_barrier(xb);
#endif
#if !defined(OMIT) || OMIT != 1
  phase_o1(p, smem);
#endif
  xcd_barrier(xb);
#if (DUP >> 1) & 1
  phase_o1(p, smem);
  xcd_barrier(xb);
#endif
#if !defined(OMIT) || OMIT != 2
  phase_o2(p, smem);
#endif
  xcd_barrier(xb);
#if (DUP >> 2) & 1
  phase_o2(p, smem);
  xcd_barrier(xb);
#endif
#if !defined(OMIT) || OMIT != 3
  phase_o3(p, smem);
#endif
  xcd_barrier(xb);
#if (DUP >> 3) & 1
  phase_o3(p, smem);
  xcd_barrier(xb);
#endif
#if !defined(OMIT) || OMIT != 4
  phase_oproj<0>(p, smem);
#endif
  xcd_barrier(xb);
#if (DUP >> 4) & 1
  phase_oproj<0>(p, smem);
  xcd_barrier(xb);
#endif
#if !defined(OMIT) || OMIT != 5
  phase_o5(p, smem);
#endif
  xcd_barrier(xb);
#if (DUP >> 5) & 1
  phase_o5(p, smem);
  xcd_barrier(xb);
#endif
#if !defined(OMIT) || OMIT != 6
  phase_o6(p, smem);
#endif
  xcd_barrier(xb);
#if (DUP >> 6) & 1
  phase_o6(p, smem);
  xcd_barrier(xb);
#endif
#if !defined(OMIT) || OMIT != 7
  phase_o7(p);
#endif
  xcd_barrier(xb);
#if (DUP >> 7) & 1
  phase_o7(p);
  xcd_barrier(xb);
#endif
#if !defined(OMIT) || OMIT != 8
  phase_o8(p, smem);
#endif
  xcd_barrier(xb);
#if (DUP >> 8) & 1
  phase_o8(p, smem);
  xcd_barrier(xb);
#endif
#if !defined(OMIT) || OMIT != 9
  phase_o9(p, smem);
#endif
  xcd_barrier(xb);
#if (DUP >> 9) & 1
  phase_o9(p, smem);
  xcd_barrier(xb);
#endif
#if !defined(OMIT) || OMIT != 10
  phase_oproj<1>(p, smem);
#endif
  xcd_barrier(xb);
#if !defined(OMIT) || OMIT != 11
  phase_final(p);
#endif
}
#else
__global__ void mega(Params p) {}
#endif


extern "C" void kernel_launch(void* const* d_in, const int* in_sizes, int n_in, void* d_out, int out_size, void* d_ws,
                              size_t ws_size, hipStream_t stream) {
  static int grid_blocks = 0;
  if (!grid_blocks) {
    int dev = 0, cus = 0, per_cu = 0;
    hipGetDevice(&dev);
    hipDeviceGetAttribute(&cus, hipDeviceAttributeMultiprocessorCount, dev);
#if SINGLE_LAUNCH
    hipOccupancyMaxActiveBlocksPerMultiprocessor(&per_cu, mega, 256, 0);
#else
    hipOccupancyMaxActiveBlocksPerMultiprocessor(&per_cu, mega_one, 256, 0);
#endif
    if (per_cu < 1) per_cu = 1;
    if (per_cu > 2) per_cu = 2;
    grid_blocks = cus * per_cu;
  }
  if (ws_size < WS_NEED || n_in < N_INPUTS) {
    fprintf(stderr, "workspace too small or bad inputs: %zu < %zu\n", ws_size, (size_t)WS_NEED);
    return;
  }
  Params p{};
  for (int i = 0; i < N_INPUTS; ++i) p.in[i] = (const float*)d_in[i];
  p.out = (float*)d_out;
  p.ws = (char*)d_ws;
#ifndef PROG
#define PROG PH_PREP, PH_O1, PH_O2, PH_O3, PH_O4, PH_O5, PH_O6, PH_O7, PH_O8, PH_O9, PH_O10, PH_FINAL
#endif
  const int prog[] = {PROG};
  p.nprog = (int)(sizeof(prog) / sizeof(int));
  for (int i = 0; i < p.nprog; ++i) p.prog[i] = prog[i];
#if SINGLE_LAUNCH
  hipMemsetAsync((char*)d_ws + O_BAR, 0, BAR_BYTES, stream);
  void* args[] = {&p};
  hipError_t e = hipLaunchCooperativeKernel((void*)mega, dim3(grid_blocks), dim3(256), args, 0, stream);
  if (e != hipSuccess) fprintf(stderr, "cooperative launch failed: %s (grid %d)\n", hipGetErrorString(e), grid_blocks);
#else
  for (int i = 0; i < p.nprog; ++i) {
    mega_one<<<dim3(grid_blocks), dim3(256), 0, stream>>>(p, p.prog[i]);
  }
#endif
}
```

```cpp
#include <hip/hip_runtime.h>
#include <hip/hip_cooperative_groups.h>
#include <cstdio>
namespace cg = cooperative_groups;
#ifndef DUP
#define DUP 0
#endif
#ifndef USE_NAIVE
#define USE_NAIVE 0
#endif
#ifndef SINGLE_LAUNCH
#define SINGLE_LAUNCH 1
#endif

#define DI __device__ __forceinline__
typedef unsigned short bfr;

constexpr int D = 1024, NB = 8, SEQ = 2048, LC = 256, LALL = 2304;
constexpr int TOK = NB * LALL;
constexpr int NLAT = NB * SEQ;
constexpr int NH = 16, DQK = 96, DV = 64;
constexpr int NIN0 = 1440, NIN1 = 2048;
constexpr float EPS = 1e-6f;
constexpr float QSCALE = 0.10206207261596577f * 1.4426950408889634f;
constexpr int TC = 32;
constexpr int NCH = LALL / TC;
constexpr int NCHL = SEQ / TC;

enum { I_X = 0, I_C, I_CTX, I_CCTX, I_ADAW, I_ADAB, I_NORMG, I_WIN0, I_QNORM, I_WUQ, I_KVNORM, I_WUKV, I_WOUT0,
       I_WIN1, I_ARE, I_AIM, I_LOGSTEP, I_BRE, I_BIM, I_CRE, I_CIM, I_S5D, I_WGLU, I_BGLU, I_WOUT1, I_FINALG, N_INPUTS };

constexpr size_t al256(size_t x) { return (x + 255) & ~(size_t)255; }
constexpr size_t O_WT_IN0 = 0;
constexpr size_t O_WT_UQ = O_WT_IN0 + al256((size_t)NIN0 * 1024 * 2);
constexpr size_t O_WT_UKV = O_WT_UQ + al256((size_t)1536 * 256 * 2);
constexpr size_t O_WT_OUT0 = O_WT_UKV + al256((size_t)2048 * 128 * 2);
constexpr size_t O_WT_IN1 = O_WT_OUT0 + al256((size_t)1024 * 1024 * 2);
constexpr size_t O_WT_GLU = O_WT_IN1 + al256((size_t)2048 * 1024 * 2);
constexpr size_t O_WT_OUT1 = O_WT_GLU + al256((size_t)1024 * 1024 * 2);
constexpr size_t O_MOD = O_WT_OUT1 + al256((size_t)1024 * 1024 * 2);
constexpr size_t O_RS0 = O_MOD + al256((size_t)2 * 9 * 3072 * 4);
constexpr size_t O_PART1 = O_RS0 + al256((size_t)TOK * 4);
constexpr size_t O_PART2 = O_PART1 + al256((size_t)16 * TOK * 4);
constexpr size_t O_X1CTX = O_PART2 + al256((size_t)16 * NLAT * 4);
constexpr size_t O_KTAB = O_X1CTX + al256((size_t)NB * LC * 1024 * 4);
constexpr size_t O_WST = O_KTAB + al256((size_t)64 * 63 * 256 * 2);
constexpr size_t O_VOP = O_WST + al256((size_t)64 * 256 * 512 * 2);
constexpr size_t O_BAR = O_VOP + al256((size_t)64 * 512 * 256 * 2);
constexpr size_t BAR_BYTES = 3456 * 4;
constexpr size_t O_LAYER = O_BAR + al256(BAR_BYTES);
constexpr size_t O_PC = O_LAYER;
constexpr size_t O_SZ0 = O_PC + al256((size_t)TOK * 384 * 2);
constexpr size_t O_K = O_SZ0 + al256((size_t)TOK * 1024 * 2);
constexpr size_t O_VT = O_K + al256((size_t)NB * NH * LALL * 64 * 2);
constexpr size_t O_OG = O_VT + al256((size_t)NB * NH * DV * LALL * 2);
constexpr size_t O_KR = O_OG + al256((size_t)TOK * 1024 * 2);
constexpr size_t O_END0 = O_KR + al256((size_t)TOK * 32 * 2);
constexpr size_t O_U2 = O_LAYER;
constexpr size_t O_SZ1 = O_U2 + al256((size_t)64 * TOK * 16 * 2);
constexpr size_t O_SLOC = O_SZ1 + al256((size_t)NLAT * 1024 * 2);
constexpr size_t O_SIN = O_SLOC + al256((size_t)64 * (NB * NCH) * 256 * 4);
constexpr size_t O_YG = O_SIN + al256((size_t)64 * (NB * NCHL) * 256 * 2);
constexpr size_t O_END1 = O_YG + al256((size_t)NLAT * 1024 * 2);
constexpr size_t O_Y2 = O_SLOC;
constexpr size_t WS_NEED = (O_END0 > O_END1 ? O_END0 : O_END1);
static_assert(WS_NEED <= (size_t)256 * 1024 * 1024, "workspace too large");
static_assert((size_t)NB * NH * LALL * DQK * 2 <= (size_t)NLAT * 1024 * 4, "Q does not fit d_out");

struct Params {
  const float* in[N_INPUTS];
  float* out;
  char* ws;
  int prog[32];
  int nprog;
  int pad;
};

DI bfr f2bf(float x) {
  unsigned u = __float_as_uint(x);
  u += 0x7fffu + ((u >> 16) & 1u);
  return (bfr)(u >> 16);
}
typedef __bf16 bf2_t __attribute__((ext_vector_type(2)));
typedef float f2_t __attribute__((ext_vector_type(2)));
DI unsigned pk2(float a, float b) {
  f2_t v = {a, b};
  bf2_t r = __builtin_convertvector(v, bf2_t);
  return __builtin_bit_cast(unsigned, r);
}
DI int opaque_tid() {
  int t = threadIdx.x;
  asm volatile("" : "+v"(t));
  return t;
}
DI float bf2f(bfr b) { return __uint_as_float(((unsigned)b) << 16); }
DI float silu_f(float v) { return v / (1.f + __expf(-v)); }
DI float sigmoid_f(float v) { return 1.f / (1.f + __expf(-v)); }
DI float gelu_tanh(float v) {
  float u = 0.7978845608028654f * (v + 0.044715f * v * v * v);
  return 0.5f * v * (1.f + tanhf(u));
}
DI float wave_sum(float v) {
#pragma unroll
  for (int o = 32; o > 0; o >>= 1) v += __shfl_xor(v, o);
  return v;
}
DI float wave_max(float v) {
#pragma unroll
  for (int o = 32; o > 0; o >>= 1) v = fmaxf(v, __shfl_xor(v, o));
  return v;
}
DI const float* xrow0(const Params& p, int tok) {
  int b = tok / LALL, pos = tok - b * LALL;
  return pos < LC ? p.in[I_CTX] + ((size_t)(b * LC + pos)) * D : p.in[I_X] + ((size_t)(b * SEQ + pos - LC)) * D;
}
DI float* xrow1(const Params& p, int tok) {
  int b = tok / LALL, pos = tok - b * LALL;
  return pos < LC ? (float*)(p.ws + O_X1CTX) + ((size_t)(b * LC + pos)) * D : p.out + ((size_t)(b * SEQ + pos - LC)) * D;
}
DI const float* modrow(const Params& p, int layer, int tok) {
  int b = tok / LALL, pos = tok - b * LALL;
  int r = pos < LC ? 8 : b;
  return (const float*)(p.ws + O_MOD) + ((size_t)(layer * 9 + r)) * 3072;
}
DI void rope_cs(int fi, int posv, float& cs, float& sn) {
  float inv = __builtin_amdgcn_exp2f(-(float)fi * (13.287712379549449f / 8.f));
  float rev = (float)posv * inv * 0.15915494309189535f;
  rev -= floorf(rev);
  sn = __builtin_amdgcn_sinf(rev);
  cs = __builtin_amdgcn_cosf(rev);
}
DI float rope_apply(int j, float v, float vp, int lpos) {
  int posv = (j & 16) ? (lpos & 63) : (lpos >> 6);
  float cs, sn;
  rope_cs(j & 7, posv, cs, sn);
  return (j & 8) ? (vp * sn + v * cs) : (v * cs - vp * sn);
}

DI void s5_disc(const Params& p, int dir, int g, int pp, double& dt, double& ar, double& ai, float& fr, float& fi) {
  dt = exp((double)p.in[I_LOGSTEP][dir * 64 + g]);
  ar = (double)p.in[I_ARE][(dir * 64 + g) * 64 + pp];
  ai = (double)p.in[I_AIM][(dir * 64 + g) * 64 + pp];
  double mag = exp(ar * dt);
  double a = ai * dt;
  a -= 6.283185307179586 * rint(a * 0.15915494309189535);
  float sn, cs;
  sincosf((float)a, &sn, &cs);
  double lr = mag * (double)cs, li = mag * (double)sn;
  double den = ar * ar + ai * ai, nr = lr - 1.0;
  fr = (float)((nr * ar + li * ai) / den);
  fi = (float)((li * ar - nr * ai) / den);
}
DI void s5_pow(double dt, double ar, double ai, int k, float& wr, float& wi) {
  double mag = exp(ar * dt * (double)k);
  double a = ai * dt * (double)k;
  a -= 6.283185307179586 * rint(a * 0.15915494309189535);
  float sn, cs;
  sincosf((float)a, &sn, &cs);
  wr = (float)mag * cs;
  wi = (float)mag * sn;
}

enum { PH_PREP = 0, PH_N1, PH_N2, PH_N3, PH_N4, PH_N4B, PH_N5, PH_N6A, PH_N6B, PH_N9, PH_N10, PH_N10B, PH_FINAL,
       PH_O1, PH_O2, PH_O3, PH_O4, PH_O5, PH_O6, PH_O7, PH_O8, PH_O9, PH_O10, PH_COUNT };

constexpr int SMEM_BYTES = 48 * 1024;


DI void prep_transpose(const Params& p, int widx, int tile, char* smem) {
  const int tidx_ = opaque_tid();
  int K, N;
  size_t dst;
  const float* W;
  const float* scl = nullptr;
  switch (widx) {
    case 0: W = p.in[I_WIN0]; K = 1024; N = NIN0; dst = O_WT_IN0; break;
    case 1: W = p.in[I_WUQ]; K = 256; N = 1536; dst = O_WT_UQ; scl = p.in[I_QNORM]; break;
    case 2: W = p.in[I_WUKV]; K = 128; N = 2048; dst = O_WT_UKV; scl = p.in[I_KVNORM]; break;
    case 3: W = p.in[I_WOUT0]; K = 1024; N = 1024; dst = O_WT_OUT0; break;
    case 4: W = p.in[I_WIN1]; K = 1024; N = NIN1; dst = O_WT_IN1; break;
    case 5: W = p.in[I_WGLU]; K = 1024; N = 1024; dst = O_WT_GLU; break;
    default: W = p.in[I_WOUT1]; K = 1024; N = 1024; dst = O_WT_OUT1; break;
  }
  float (*t)[33] = (float (*)[33])smem;
  int ntn = N / 32;
  int kt = tile / ntn, nt = tile - kt * ntn;
  int tx = tidx_ & 31, ty = tidx_ >> 5;
  float v[16];
#pragma unroll
  for (int i = 0; i < 16; ++i) {
    int k = kt * 128 + ty + 8 * i, n = nt * 32 + tx;
    v[i] = W[(size_t)k * N + n];
  }
  if (scl) {
#pragma unroll
    for (int i = 0; i < 16; ++i) v[i] *= scl[kt * 128 + ty + 8 * i];
  }
#pragma unroll
  for (int i = 0; i < 16; ++i) t[ty + 8 * i][tx] = v[i];
  __syncthreads();
  bfr* Wt = (bfr*)(p.ws + dst);
  {
    int nl = tidx_ >> 3, kc = (tidx_ & 7) * 16;
    unsigned w[8];
#pragma unroll
    for (int j = 0; j < 8; ++j) w[j] = pk2(t[kc + 2 * j][nl], t[kc + 2 * j + 1][nl]);
    uint4* dstp = (uint4*)(Wt + (size_t)(nt * 32 + nl) * K + kt * 128 + kc);
    dstp[0] = make_uint4(w[0], w[1], w[2], w[3]);
    dstp[1] = make_uint4(w[4], w[5], w[6], w[7]);
  }
  __syncthreads();
}

DI void prep_mod(const Params& p, int unit, char* smem) {
  const int tidx_ = opaque_tid();
  int layer = unit / 192, cgp = unit - layer * 192;
  float* sil = (float*)smem;
  float* red = sil + 9 * 1024;
  for (int i = tidx_; i < 9 * 1024; i += 256) {
    int r = i >> 10, k = i & 1023;
    float v = r < 8 ? p.in[I_C][r * 1024 + k] : p.in[I_CCTX][k];
    sil[i] = silu_f(v);
  }
  __syncthreads();
  int nn = tidx_ & 15, kg = tidx_ >> 4;
  int n = cgp * 16 + nn;
  const float* W = p.in[I_ADAW] + (size_t)layer * 1024 * 3072 + n;
  float acc[9];
#pragma unroll
  for (int r = 0; r < 9; ++r) acc[r] = 0.f;
#pragma unroll 8
  for (int k = kg * 64; k < kg * 64 + 64; ++k) {
    float w = W[(size_t)k * 3072];
#pragma unroll
    for (int r = 0; r < 9; ++r) acc[r] += sil[r * 1024 + k] * w;
  }
#pragma unroll
  for (int r = 0; r < 9; ++r) red[(kg * 9 + r) * 16 + nn] = acc[r];
  __syncthreads();
  if (tidx_ < 144) {
    int r = tidx_ >> 4, c = tidx_ & 15;
    int nc = cgp * 16 + c;
    float s = p.in[I_ADAB][layer * 3072 + nc];
#pragma unroll
    for (int g = 0; g < 16; ++g) s += red[(g * 9 + r) * 16 + c];
    ((float*)(p.ws + O_MOD))[((size_t)(layer * 9 + r)) * 3072 + nc] = s;
  }
  __syncthreads();
}

DI void prep_rs0(const Params& p, int unit) {
  const int tidx_ = opaque_tid();
  int tok = unit * 4 + (tidx_ >> 6);
  int lane = tidx_ & 63;
  const float4* r = (const float4*)xrow0(p, tok);
  float s = 0.f;
#pragma unroll
  for (int i = 0; i < 4; ++i) {
    float4 v = r[lane + 64 * i];
    s += v.x * v.x + v.y * v.y + v.z * v.z + v.w * v.w;
  }
  s = wave_sum(s);
  if (lane == 0) ((float*)(p.ws + O_RS0))[tok] = rsqrtf(s * (1.f / 1024.f) + EPS);
}

DI void prep_ktab(const Params& p, int unit, char* smem) {
  const int tidx_ = opaque_tid();
  int g = unit / 7, lg = unit - g * 7;
  float2* E = (float2*)smem;
  int tid = tidx_;
  for (int i = tid; i < 9 * 128; i += 256) {
    int l = i >> 7, dir = (i >> 6) & 1, pp = i & 63;
    int lag = lg * 9 + l - 31;
    bool used = (dir == 0) ? (lag >= 0) : (lag <= 0);
    float2 e = make_float2(0.f, 0.f);
    if (used) {
      double dt, ar, ai;
      float fr, fi, wr, wi;
      s5_disc(p, dir, g, pp, dt, ar, ai, fr, fi);
      s5_pow(dt, ar, ai, lag < 0 ? -lag : lag, wr, wi);
      e.x = wr * fr - wi * fi;
      e.y = wr * fi + wi * fr;
    }
    E[i] = e;
  }
  __syncthreads();
  int c = tid >> 4, c2 = tid & 15;
  float acc[9];
#pragma unroll
  for (int l = 0; l < 9; ++l) acc[l] = 0.f;
  for (int dir = 0; dir < 2; ++dir) {
    const float* bre = p.in[I_BRE] + ((size_t)(dir * 64 + g)) * 64 * 16;
    const float* bim = p.in[I_BIM] + ((size_t)(dir * 64 + g)) * 64 * 16;
    const float* cre = p.in[I_CRE] + ((size_t)(dir * 64 + g)) * 16 * 64;
    const float* cim = p.in[I_CIM] + ((size_t)(dir * 64 + g)) * 16 * 64;
#pragma unroll 4
    for (int pp = 0; pp < 64; ++pp) {
      float br = bre[pp * 16 + c2], bi = bim[pp * 16 + c2];
      float cr = cre[c * 64 + pp], ci = cim[c * 64 + pp];
      float mr = cr * br - ci * bi, mi = cr * bi + ci * br;
#pragma unroll
      for (int l = 0; l < 9; ++l) {
        float2 e = E[(l * 2 + dir) * 64 + pp];
        acc[l] += mr * e.x - mi * e.y;
      }
    }
  }
  bfr* KT = (bfr*)(p.ws + O_KTAB);
#pragma unroll
  for (int l = 0; l < 9; ++l) KT[(((size_t)g * 63 + lg * 9 + l) * 16 + c) * 16 + c2] = f2bf(acc[l]);
  __syncthreads();
}

DI void prep_ops(const Params& p, int unit) {
  const int tidx_ = opaque_tid();
  int idx = unit * 256 + tidx_;
  int pp = idx & 63, t = (idx >> 6) & 31, dir = (idx >> 11) & 1, g = idx >> 12;
  double dt, ar, ai;
  float fr, fi, wr, wi;
  s5_disc(p, dir, g, pp, dt, ar, ai, fr, fi);
  s5_pow(dt, ar, ai, dir == 0 ? (TC - 1 - t) : t, wr, wi);
  float er = wr * fr - wi * fi, ei = wr * fi + wi * fr;
  const float* bre = p.in[I_BRE] + (((size_t)(dir * 64 + g)) * 64 + pp) * 16;
  const float* bim = p.in[I_BIM] + (((size_t)(dir * 64 + g)) * 64 + pp) * 16;
  bfr* wst = (bfr*)(p.ws + O_WST) + (size_t)g * 256 * 512;
  bfr* rre = wst + (size_t)(dir * 128 + pp) * 512 + t * 16;
  bfr* rim = wst + (size_t)(dir * 128 + 64 + pp) * 512 + t * 16;
#pragma unroll
  for (int c2 = 0; c2 < 16; ++c2) {
    float br = bre[c2], bi = bim[c2];
    rre[c2] = f2bf(er * br - ei * bi);
    rim[c2] = f2bf(er * bi + ei * br);
  }
  s5_pow(dt, ar, ai, dir == 0 ? (t + 1) : (TC - t), wr, wi);
  const float* cre = p.in[I_CRE] + ((size_t)(dir * 64 + g)) * 16 * 64;
  const float* cim = p.in[I_CIM] + ((size_t)(dir * 64 + g)) * 16 * 64;
  bfr* vop = (bfr*)(p.ws + O_VOP) + (size_t)g * 512 * 256;
#pragma unroll
  for (int c = 0; c < 16; ++c) {
    float cr = cre[c * 64 + pp], ci = cim[c * 64 + pp];
    float dr = cr * wr - ci * wi, di = cr * wi + ci * wr;
    vop[(size_t)(t * 16 + c) * 256 + dir * 128 + pp] = f2bf(dr);
    vop[(size_t)(t * 16 + c) * 256 + dir * 128 + 64 + pp] = f2bf(-di);
  }
}

constexpr int TR_T0 = 8 * 45, TR_T1 = 2 * 48, TR_T2 = 1 * 64, TR_T3 = 256, TR_T4 = 8 * 64, TR_T5 = 256, TR_T6 = 256;
constexpr int TR_TOTAL = TR_T0 + TR_T1 + TR_T2 + TR_T3 + TR_T4 + TR_T5 + TR_T6;
constexpr int U_MOD = 384, U_RS0 = TOK / 4, U_KTAB = 64 * 7, U_OPS = 64 * 2 * 64 * 32 / 256;
constexpr int PREP_UNITS = TR_TOTAL + U_MOD + U_RS0 + U_KTAB + U_OPS;

DI void phase_prep(const Params& p, char* smem) {
  for (int u = blockIdx.x; u < PREP_UNITS; u += gridDim.x) {
    int v = u;
    if (v < U_MOD) { prep_mod(p, v, smem); continue; }
    v -= U_MOD;
    if (v < TR_TOTAL) {
      int w = 0;
      if (v >= TR_T0) { v -= TR_T0; w = 1;
        if (v >= TR_T1) { v -= TR_T1; w = 2;
          if (v >= TR_T2) { v -= TR_T2; w = 3;
            if (v >= TR_T3) { v -= TR_T3; w = 4;
              if (v >= TR_T4) { v -= TR_T4; w = 5;
                if (v >= TR_T5) { v -= TR_T5; w = 6; } } } } } }
      prep_transpose(p, w, v, smem);
      continue;
    }
    v -= TR_TOTAL;
    if (v < U_RS0) { prep_rs0(p, v); continue; }
    v -= U_RS0;
    if (v < U_KTAB) { prep_ktab(p, v, smem); continue; }
    v -= U_KTAB;
    prep_ops(p, v);
  }
}

DI void phase_n1(const Params& p) {
  const float* W = p.in[I_WIN0];
  const float* rs0 = (const float*)(p.ws + O_RS0);
  const float* ng = p.in[I_NORMG];
  const size_t total = (size_t)TOK * NIN0;
  for (size_t idx = (size_t)blockIdx.x * 256 + threadIdx.x; idx < total; idx += (size_t)gridDim.x * 256) {
    int tok = (int)(idx / NIN0), n = (int)(idx - (size_t)tok * NIN0);
    int b = tok / LALL, pos = tok - b * LALL;
    bool lat = pos >= LC;
    const float* xr = xrow0(p, tok);
    const float* md = modrow(p, 0, tok);
    float rs = rs0[tok];
    bool rope = lat && n >= 384 && n < 416;
    int n2 = rope ? (n ^ 8) : n;
    float acc = 0.f, acc2 = 0.f;
    for (int k = 0; k < 1024; ++k) {
      float h = xr[k] * rs * ng[k] * (1.f + md[1024 + k]) + md[k];
      acc += h * W[(size_t)k * NIN0 + n];
      acc2 += h * W[(size_t)k * NIN0 + n2];
    }
    if (n < 384) {
      ((bfr*)(p.ws + O_PC))[(size_t)tok * 384 + n] = f2bf(acc);
    } else if (n < 416) {
      int j = n - 384;
      float v = rope ? rope_apply(j, acc, acc2, pos - LC) : acc;
      bfr bv = f2bf(v);
      bfr* K = (bfr*)(p.ws + O_K);
      for (int h = 0; h < NH; ++h) K[(((size_t)(b * NH + h)) * LALL + pos) * DQK + 64 + j] = bv;
    } else {
      ((bfr*)(p.ws + O_SZ0))[(size_t)tok * 1024 + (n - 416)] = f2bf(silu_f(acc));
    }
  }
}

DI void phase_n2(const Params& p) {
  const int NTOT = 1536 + 2048;
  const bfr* PC = (const bfr*)(p.ws + O_PC);
  const size_t total = (size_t)TOK * NTOT;
  bfr* Q = (bfr*)p.out;
  bfr* K = (bfr*)(p.ws + O_K);
  bfr* VT = (bfr*)(p.ws + O_VT);
  for (size_t idx = (size_t)blockIdx.x * 256 + threadIdx.x; idx < total; idx += (size_t)gridDim.x * 256) {
    int tok = (int)(idx / NTOT), n = (int)(idx - (size_t)tok * NTOT);
    int b = tok / LALL, pos = tok - b * LALL;
    bool lat = pos >= LC;
    if (n < 1536) {
      int h = n / 96, d = n - h * 96;
      bool rope = lat && d >= 64;
      int n2 = rope ? (n ^ 8) : n;
      const float* W = p.in[I_WUQ];
      const float* qn = p.in[I_QNORM];
      float acc = 0.f, acc2 = 0.f, ss = 0.f;
      for (int k = 0; k < 256; ++k) {
        float a = bf2f(PC[(size_t)tok * 384 + k]);
        ss += a * a;
        float aw = a * qn[k];
        acc += aw * W[(size_t)k * 1536 + n];
        acc2 += aw * W[(size_t)k * 1536 + n2];
      }
      float r = rsqrtf(ss * (1.f / 256.f) + EPS);
      acc *= r; acc2 *= r;
      float v = rope ? rope_apply(d - 64, acc, acc2, pos - LC) : acc;
      Q[(((size_t)(b * NH + h)) * LALL + pos) * DQK + d] = f2bf(v * QSCALE);
    } else {
      int n3 = n - 1536;
      int h = n3 / 128, d = n3 - h * 128;
      const float* W = p.in[I_WUKV];
      const float* kn = p.in[I_KVNORM];
      float acc = 0.f, ss = 0.f;
      for (int k = 0; k < 128; ++k) {
        float a = bf2f(PC[(size_t)tok * 384 + 256 + k]);
        ss += a * a;
        acc += a * kn[k] * W[(size_t)k * 2048 + n3];
      }
      acc *= rsqrtf(ss * (1.f / 128.f) + EPS);
      if (d < 64) K[(((size_t)(b * NH + h)) * LALL + pos) * DQK + d] = f2bf(acc);
      else VT[(((size_t)(b * NH + h)) * DV + (d - 64)) * LALL + pos] = f2bf(acc);
    }
  }
}

DI void phase_n3(const Params& p) {
  const bfr* Q = (const bfr*)p.out;
  const bfr* K = (const bfr*)(p.ws + O_K);
  const bfr* VT = (const bfr*)(p.ws + O_VT);
  const bfr* SZ = (const bfr*)(p.ws + O_SZ0);
  bfr* OG = (bfr*)(p.ws + O_OG);
  int lane = threadIdx.x & 63;
  const int total = NB * NH * LALL;
  for (int w = blockIdx.x * 4 + (threadIdx.x >> 6); w < total; w += gridDim.x * 4) {
    int bh = w / LALL, pos = w - bh * LALL;
    int b = bh / NH, h = bh - b * NH;
    int nk = pos < LC ? LC : LALL;
    const bfr* q = Q + ((size_t)bh * LALL + pos) * DQK;
    const bfr* kb = K + (size_t)bh * LALL * DQK;
    const bfr* vb = VT + (size_t)bh * DV * LALL;
    float s[36];
    float mx = -1e30f;
#pragma unroll
    for (int i = 0; i < 36; ++i) {
      int key = i * 64 + lane;
      float a = -1e30f;
      if (key < nk) {
        a = 0.f;
        const bfr* kr = kb + (size_t)key * DQK;
        for (int d = 0; d < DQK; ++d) a += bf2f(q[d]) * bf2f(kr[d]);
      }
      s[i] = a;
      mx = fmaxf(mx, a);
    }
    mx = wave_max(mx);
    float l = 0.f;
    float o[64];
#pragma unroll
    for (int d = 0; d < 64; ++d) o[d] = 0.f;
#pragma unroll
    for (int i = 0; i < 36; ++i) {
      int key = i * 64 + lane;
      if (key < nk) {
        float pr = exp2f(s[i] - mx);
        l += pr;
#pragma unroll
        for (int d = 0; d < 64; ++d) o[d] += pr * bf2f(vb[(size_t)d * LALL + key]);
      }
    }
    l = wave_sum(l);
    float mine = 0.f;
#pragma unroll
    for (int d = 0; d < 64; ++d) {
      float t = wave_sum(o[d]);
      if (lane == d) mine = t;
    }
    int tok = b * LALL + pos;
    float z = bf2f(SZ[(size_t)tok * 1024 + h * 64 + lane]);
    OG[(size_t)tok * 1024 + h * 64 + lane] = f2bf(mine / l * z);
  }
}

DI void phase_n4(const Params& p) {
  const float* W = p.in[I_WOUT0];
  const bfr* OG = (const bfr*)(p.ws + O_OG);
  const size_t total = (size_t)TOK * 1024;
  for (size_t idx = (size_t)blockIdx.x * 256 + threadIdx.x; idx < total; idx += (size_t)gridDim.x * 256) {
    int tok = (int)(idx >> 10), n = (int)(idx & 1023);
    float acc = 0.f;
    for (int k = 0; k < 1024; ++k) acc += bf2f(OG[(size_t)tok * 1024 + k]) * W[(size_t)k * 1024 + n];
    float v = xrow0(p, tok)[n] + modrow(p, 0, tok)[2048 + n] * acc;
    xrow1(p, tok)[n] = v;
  }
}

DI void phase_rowsq(const Params& p, int layer) {
  int lane = threadIdx.x & 63;
  int nrows = layer == 1 ? TOK : NLAT;
  float* part = (float*)(p.ws + (layer == 1 ? O_PART1 : O_PART2));
  for (int r = blockIdx.x * 4 + (threadIdx.x >> 6); r < nrows; r += gridDim.x * 4) {
    const float4* row = (const float4*)(layer == 1 ? xrow1(p, r) : p.out + (size_t)r * D);
    float s = 0.f;
#pragma unroll
    for (int i = 0; i < 4; ++i) {
      float4 v = row[lane + 64 * i];
      s += v.x * v.x + v.y * v.y + v.z * v.z + v.w * v.w;
    }
    s = wave_sum(s);
    if (lane < 16) part[(size_t)lane * nrows + r] = lane == 0 ? s : 0.f;
  }
}
DI float rs_from_part(const float* part, int nrows, int r) {
  float s = 0.f;
#pragma unroll
  for (int j = 0; j < 16; ++j) s += part[(size_t)j * nrows + r];
  return rsqrtf(s * (1.f / 1024.f) + EPS);
}

DI void phase_n5(const Params& p) {
  const float* W = p.in[I_WIN1];
  const float* ng = p.in[I_NORMG] + 1024;
  const float* part = (const float*)(p.ws + O_PART1);
  bfr* U2 = (bfr*)(p.ws + O_U2);
  bfr* SZ1 = (bfr*)(p.ws + O_SZ1);
  const size_t total = (size_t)TOK * NIN1;
  for (size_t idx = (size_t)blockIdx.x * 256 + threadIdx.x; idx < total; idx += (size_t)gridDim.x * 256) {
    int tok = (int)(idx >> 11), n = (int)(idx & 2047);
    int b = tok / LALL, pos = tok - b * LALL;
    bool lat = pos >= LC;
    if (!lat && n >= 1024) continue;
    const float* xr = xrow1(p, tok);
    const float* md = modrow(p, 1, tok);
    float rs = rs_from_part(part, TOK, tok);
    float acc = 0.f;
    for (int k = 0; k < 1024; ++k) {
      float h = xr[k] * rs * ng[k] * (1.f + md[1024 + k]) + md[k];
      acc += h * W[(size_t)k * NIN1 + n];
    }
    if (n < 1024) U2[((size_t)(n >> 4) * TOK + tok) * 16 + (n & 15)] = f2bf(acc);
    else SZ1[((size_t)(b * SEQ + pos - LC)) * 1024 + (n - 1024)] = f2bf(silu_f(acc));
  }
}

DI void phase_n6(const Params& p, int dir) {
  int lane = threadIdx.x & 63;
  const bfr* U2 = (const bfr*)(p.ws + O_U2);
  bfr* YF = (bfr*)(p.ws + O_Y2);
  bfr* YG = (bfr*)(p.ws + O_YG);
  for (int w = blockIdx.x * 4 + (threadIdx.x >> 6); w < NB * 64; w += gridDim.x * 4) {
    int b = w >> 6, g = w & 63;
    double dt, ar, ai;
    float fr, fi, lr, li;
    s5_disc(p, dir, g, lane, dt, ar, ai, fr, fi);
    s5_pow(dt, ar, ai, 1, lr, li);
    float bbr[16], bbi[16], ccr[16], cci[16];
    const float* bre = p.in[I_BRE] + (((size_t)(dir * 64 + g)) * 64 + lane) * 16;
    const float* bim = p.in[I_BIM] + (((size_t)(dir * 64 + g)) * 64 + lane) * 16;
    const float* cre = p.in[I_CRE] + ((size_t)(dir * 64 + g)) * 16 * 64;
    const float* cim = p.in[I_CIM] + ((size_t)(dir * 64 + g)) * 16 * 64;
#pragma unroll
    for (int c = 0; c < 16; ++c) {
      float br = bre[c], bi = bim[c];
      bbr[c] = fr * br - fi * bi;
      bbi[c] = fr * bi + fi * br;
      ccr[c] = cre[c * 64 + lane];
      cci[c] = cim[c * 64 + lane];
    }
    float sr = 0.f, si = 0.f;
    const bfr* ub = U2 + ((size_t)g * TOK + (size_t)b * LALL) * 16;
    for (int step = 0; step < LALL; ++step) {
      int pos = dir == 0 ? step : (step < LC ? (LC - 1 - step) : (LALL - 1 - (step - LC)));
      const bfr* ur = ub + (size_t)pos * 16;
      float ur_f[16];
      float br = 0.f, bi = 0.f;
#pragma unroll
      for (int c = 0; c < 16; ++c) {
        float uv = bf2f(ur[c]);
        ur_f[c] = uv;
        br += bbr[c] * uv;
        bi += bbi[c] * uv;
      }
      float nr = lr * sr - li * si + br;
      float ni = lr * si + li * sr + bi;
      sr = nr; si = ni;
      if (pos >= LC) {
        float mine = 0.f, myu = 0.f;
#pragma unroll
        for (int c = 0; c < 16; ++c) {
          float t = wave_sum(ccr[c] * sr - cci[c] * si);
          if (lane == c) { mine = t; myu = ur_f[c]; }
        }
        if (lane < 16) {
          size_t o = ((size_t)(b * SEQ + pos - LC)) * 1024 + g * 16 + lane;
          if (dir == 0) YF[o] = f2bf(mine);
          else {
            float y = bf2f(YF[o]) + mine + p.in[I_S5D][g * 16 + lane] * myu;
            YG[o] = f2bf(gelu_tanh(y));
          }
        }
      }
    }
  }
}

DI void phase_n9(const Params& p) {
  const float* W = p.in[I_WGLU];
  const bfr* YG = (const bfr*)(p.ws + O_YG);
  const bfr* SZ1 = (const bfr*)(p.ws + O_SZ1);
  bfr* Y2 = (bfr*)(p.ws + O_Y2);
  const size_t total = (size_t)NLAT * 1024;
  for (size_t idx = (size_t)blockIdx.x * 256 + threadIdx.x; idx < total; idx += (size_t)gridDim.x * 256) {
    int lt = (int)(idx >> 10), n = (int)(idx & 1023);
    float acc = p.in[I_BGLU][n];
    for (int k = 0; k < 1024; ++k) acc += bf2f(YG[(size_t)lt * 1024 + k]) * W[(size_t)k * 1024 + n];
    float y = bf2f(YG[idx]);
    Y2[idx] = f2bf(y * sigmoid_f(acc) * bf2f(SZ1[idx]));
  }
}

DI void phase_n10(const Params& p) {
  const float* W = p.in[I_WOUT1];
  const bfr* Y2 = (const bfr*)(p.ws + O_Y2);
  const float* mod = (const float*)(p.ws + O_MOD);
  const size_t total = (size_t)NLAT * 1024;
  for (size_t idx = (size_t)blockIdx.x * 256 + threadIdx.x; idx < total; idx += (size_t)gridDim.x * 256) {
    int lt = (int)(idx >> 10), n = (int)(idx & 1023);
    int b = lt >> 11;
    float acc = 0.f;
    for (int k = 0; k < 1024; ++k) acc += bf2f(Y2[(size_t)lt * 1024 + k]) * W[(size_t)k * 1024 + n];
    p.out[idx] = p.out[idx] + mod[((size_t)(9 + b)) * 3072 + 2048 + n] * acc;
  }
}

DI void phase_final(const Params& p) {
  const int tidx_ = opaque_tid();
  const float* part = (const float*)(p.ws + O_PART2);
  const float* fg = p.in[I_FINALG];
  int lane = tidx_ & 63;
  for (int r = blockIdx.x * 4 + (tidx_ >> 6); r < NLAT; r += gridDim.x * 4) {
    float rs = rs_from_part(part, NLAT, r);
    float4* row = (float4*)(p.out + (size_t)r * D);
    const float4* g4 = (const float4*)fg;
#pragma unroll
    for (int i = 0; i < 4; ++i) {
      float4 v = row[lane + 64 * i];
      float4 g = g4[lane + 64 * i];
      v.x *= rs * g.x; v.y *= rs * g.y; v.z *= rs * g.z; v.w *= rs * g.w;
      row[lane + 64 * i] = v;
    }
  }
}

typedef short bf16x8 __attribute__((ext_vector_type(8)));
typedef short s16x4 __attribute__((ext_vector_type(4)));
typedef float f32x16 __attribute__((ext_vector_type(16)));
#define SCHED_FENCE() __builtin_amdgcn_sched_barrier(0)
#define MFMA32(a, b, c) __builtin_amdgcn_mfma_f32_32x32x16_bf16((a), (b), (c), 0, 0, 0)
DI int xcd_swz(int u, int per) {
  int x = u & 7, q = u >> 3;
  int qq = q / per;
  return (x + 8 * qq) * per + (q - qq * per);
}
DI int crow(int i, int h) { return (i & 3) + 8 * (i >> 2) + 4 * h; }

constexpr int LDT = 72;
struct GemmSmem {
  bfr A[128 * LDT];
  bfr B[128 * LDT];
  float gs[1024];
  float sh[1024];
  float rs[128];
};
static_assert(sizeof(GemmSmem) <= SMEM_BYTES, "smem");

DI void zero_acc(f32x16 (&acc)[2][2]) {
#pragma unroll
  for (int a = 0; a < 2; ++a)
#pragma unroll
    for (int b = 0; b < 2; ++b)
#pragma unroll
      for (int i = 0; i < 16; ++i) acc[a][b][i] = 0.f;
}

template <bool AF32, class AAddr, class BAddr>
DI void gemm_main(f32x16 (&acc)[2][2], int KT, AAddr aaddr, BAddr baddr, GemmSmem* sm) {
  const int tid = opaque_tid(), lane = tid & 63, wave = tid >> 6;
  const int wm = wave >> 1, wn = wave & 1, r = lane & 31, h = lane >> 5;
  uint4 bv0, bv1, bv2, bv3, av0, av1, av2, av3;
  float4 af0, af1, af2, af3, af4, af5, af6, af7;
  const int lrow = tid >> 3, lkc = (tid & 7) * 8;
  const int frow = tid >> 4, fkc = (tid & 15) * 4;
#define GM_LOAD(KT_)                                                                     \
  {                                                                                      \
    const int kk_ = (KT_) * 64;                                                          \
    bv0 = *(const uint4*)baddr(lrow, kk_ + lkc);                                         \
    bv1 = *(const uint4*)baddr(lrow + 32, kk_ + lkc);                                    \
    bv2 = *(const uint4*)baddr(lrow + 64, kk_ + lkc);                                    \
    bv3 = *(const uint4*)baddr(lrow + 96, kk_ + lkc);                                    \
    if constexpr (AF32) {                                                                \
      af0 = *(const float4*)(aaddr(frow) + kk_ + fkc);                                   \
      af1 = *(const float4*)(aaddr(frow + 16) + kk_ + fkc);                              \
      af2 = *(const float4*)(aaddr(frow + 32) + kk_ + fkc);                              \
      af3 = *(const float4*)(aaddr(frow + 48) + kk_ + fkc);                              \
      af4 = *(const float4*)(aaddr(frow + 64) + kk_ + fkc);                              \
      af5 = *(const float4*)(aaddr(frow + 80) + kk_ + fkc);                              \
      af6 = *(const float4*)(aaddr(frow + 96) + kk_ + fkc);                              \
      af7 = *(const float4*)(aaddr(frow + 112) + kk_ + fkc);                             \
    } else {                                                                             \
      av0 = *(const uint4*)aaddr(lrow, kk_ + lkc);                                       \
      av1 = *(const uint4*)aaddr(lrow + 32, kk_ + lkc);                                  \
      av2 = *(const uint4*)aaddr(lrow + 64, kk_ + lkc);                                  \
      av3 = *(const uint4*)aaddr(lrow + 96, kk_ + lkc);                                  \
    }                                                                                    \
  }
#define GM_STF(AF_, ROW_)                                                                \
  {                                                                                      \
    float rr_ = sm->rs[ROW_];                                                            \
    uint2 o_;                                                                            \
    o_.x = pk2(AF_.x * rr_ * g_.x + s_.x, AF_.y * rr_ * g_.y + s_.y);                    \
    o_.y = pk2(AF_.z * rr_ * g_.z + s_.z, AF_.w * rr_ * g_.w + s_.w);                    \
    *(uint2*)(sm->A + (ROW_) * LDT + fkc) = o_;                                          \
  }
#define GM_STORE(KT_)                                                                    \
  {                                                                                      \
    *(uint4*)(sm->B + lrow * LDT + lkc) = bv0;                                           \
    *(uint4*)(sm->B + (lrow + 32) * LDT + lkc) = bv1;                                    \
    *(uint4*)(sm->B + (lrow + 64) * LDT + lkc) = bv2;                                    \
    *(uint4*)(sm->B + (lrow + 96) * LDT + lkc) = bv3;                                    \
    if constexpr (AF32) {                                                                \
      const int k_ = (KT_) * 64 + fkc;                                                   \
      const float4 g_ = *(const float4*)(sm->gs + k_);                                   \
      const float4 s_ = *(const float4*)(sm->sh + k_);                                   \
      GM_STF(af0, frow) GM_STF(af1, frow + 16) GM_STF(af2, frow + 32) GM_STF(af3, frow + 48) \
      GM_STF(af4, frow + 64) GM_STF(af5, frow + 80) GM_STF(af6, frow + 96) GM_STF(af7, frow + 112) \
    } else {                                                                             \
      *(uint4*)(sm->A + lrow * LDT + lkc) = av0;                                         \
      *(uint4*)(sm->A + (lrow + 32) * LDT + lkc) = av1;                                  \
      *(uint4*)(sm->A + (lrow + 64) * LDT + lkc) = av2;                                  \
      *(uint4*)(sm->A + (lrow + 96) * LDT + lkc) = av3;                                  \
    }                                                                                    \
  }
#define GM_COMPUTE()                                                                                           \
  _Pragma("unroll") for (int ks = 0; ks < 4; ++ks) {                                                           \
    bf16x8 a_[2], b_[2];                                                                                       \
    _Pragma("unroll") for (int mi = 0; mi < 2; ++mi)                                                           \
        a_[mi] = *(const bf16x8*)(sm->A + (wm * 64 + mi * 32 + r) * LDT + ks * 16 + h * 8);                    \
    _Pragma("unroll") for (int ni = 0; ni < 2; ++ni)                                                           \
        b_[ni] = *(const bf16x8*)(sm->B + (wn * 64 + ni * 32 + r) * LDT + ks * 16 + h * 8);                    \
    _Pragma("unroll") for (int mi = 0; mi < 2; ++mi)                                                           \
        _Pragma("unroll") for (int ni = 0; ni < 2; ++ni) acc[mi][ni] = MFMA32(a_[mi], b_[ni], acc[mi][ni]);    \
  }
  if constexpr (AF32) {
    GM_LOAD(0)
    for (int kt = 0; kt < KT; ++kt) {
      GM_STORE(kt)
      __syncthreads();
      if (kt + 1 < KT) GM_LOAD(kt + 1)
      SCHED_FENCE();
      GM_COMPUTE()
      __syncthreads();
    }
  } else {
    uint4 cv0, cv1, cv2, cv3, dv0, dv1, dv2, dv3;
#define GM_LOAD16(KT_, A0, A1, A2, A3, B0, B1, B2, B3)     \
  {                                                        \
    const int kk_ = (KT_) * 64 + lkc;                      \
    B0 = *(const uint4*)baddr(lrow, kk_);                  \
    B1 = *(const uint4*)baddr(lrow + 32, kk_);             \
    B2 = *(const uint4*)baddr(lrow + 64, kk_);             \
    B3 = *(const uint4*)baddr(lrow + 96, kk_);             \
    A0 = *(const uint4*)aaddr(lrow, kk_);                  \
    A1 = *(const uint4*)aaddr(lrow + 32, kk_);             \
    A2 = *(const uint4*)aaddr(lrow + 64, kk_);             \
    A3 = *(const uint4*)aaddr(lrow + 96, kk_);             \
  }
#define GM_STORE16(A0, A1, A2, A3, B0, B1, B2, B3)         \
  {                                                        \
    *(uint4*)(sm->B + lrow * LDT + lkc) = B0;              \
    *(uint4*)(sm->B + (lrow + 32) * LDT + lkc) = B1;       \
    *(uint4*)(sm->B + (lrow + 64) * LDT + lkc) = B2;       \
    *(uint4*)(sm->B + (lrow + 96) * LDT + lkc) = B3;       \
    *(uint4*)(sm->A + lrow * LDT + lkc) = A0;              \
    *(uint4*)(sm->A + (lrow + 32) * LDT + lkc) = A1;       \
    *(uint4*)(sm->A + (lrow + 64) * LDT + lkc) = A2;       \
    *(uint4*)(sm->A + (lrow + 96) * LDT + lkc) = A3;       \
  }
    GM_LOAD16(0, av0, av1, av2, av3, bv0, bv1, bv2, bv3)
    GM_LOAD16(1, cv0, cv1, cv2, cv3, dv0, dv1, dv2, dv3)
    SCHED_FENCE();
    for (int kt = 0; kt < KT; kt += 2) {
      GM_STORE16(av0, av1, av2, av3, bv0, bv1, bv2, bv3)
      __syncthreads();
      if (kt + 2 < KT) GM_LOAD16(kt + 2, av0, av1, av2, av3, bv0, bv1, bv2, bv3)
      SCHED_FENCE();
      GM_COMPUTE()
      __syncthreads();
      GM_STORE16(cv0, cv1, cv2, cv3, dv0, dv1, dv2, dv3)
      __syncthreads();
      if (kt + 3 < KT) GM_LOAD16(kt + 3, cv0, cv1, cv2, cv3, dv0, dv1, dv2, dv3)
      SCHED_FENCE();
      GM_COMPUTE()
      __syncthreads();
    }
  }
}

DI float transpose_reduce16(float (&v)[16], int lane) {
  float r8[8], r4[4], r2[2];
  {
    bool up = lane & 8;
#pragma unroll
    for (int i = 0; i < 8; ++i) {
      float send = up ? v[i] : v[i + 8];
      float keep = up ? v[i + 8] : v[i];
      r8[i] = keep + __shfl_xor(send, 8);
    }
  }
  {
    bool up = lane & 4;
#pragma unroll
    for (int i = 0; i < 4; ++i) {
      float send = up ? r8[i] : r8[i + 4];
      float keep = up ? r8[i + 4] : r8[i];
      r4[i] = keep + __shfl_xor(send, 4);
    }
  }
  {
    bool up = lane & 2;
#pragma unroll
    for (int i = 0; i < 2; ++i) {
      float send = up ? r4[i] : r4[i + 2];
      float keep = up ? r4[i + 2] : r4[i];
      r2[i] = keep + __shfl_xor(send, 2);
    }
  }
  bool up = lane & 1;
  float send = up ? r2[0] : r2[1];
  float keep = up ? r2[1] : r2[0];
  return keep + __shfl_xor(send, 1);
}

#define WAVE_IDS                                              \
  const int tid = opaque_tid(), lane = tid & 63, wave = tid >> 6; \
  const int wm = wave >> 1, wn = wave & 1, r = lane & 31, h = lane >> 5; \
  (void)wm; (void)wn; (void)r; (void)h;

DI void phase_o1(const Params& p, char* smem) {
  GemmSmem* sm = (GemmSmem*)smem;
  WAVE_IDS
  const int NT = 12, units = (TOK / 128) * NT;
  const bfr* WT = (const bfr*)(p.ws + O_WT_IN0);
  const float* RS0 = (const float*)(p.ws + O_RS0);
  bfr* PC = (bfr*)(p.ws + O_PC);
  bfr* SZ0 = (bfr*)(p.ws + O_SZ0);
  bfr* KRb = (bfr*)(p.ws + O_KR);
  for (int u = blockIdx.x; u < units; u += gridDim.x) {
    const int us = xcd_swz(u, NT);
    int mt = us / NT, nt = us - mt * NT;
    int m0 = mt * 128, n0 = nt * 128;
    __syncthreads();
    const float* md = modrow(p, 0, m0);
    const float* ng = p.in[I_NORMG];
    for (int k = tid; k < 1024; k += 256) {
      sm->gs[k] = ng[k] * (1.f + md[1024 + k]);
      sm->sh[k] = md[k];
    }
    if (tid < 128) sm->rs[tid] = RS0[m0 + tid];
    __syncthreads();
    const float* abase = xrow0(p, m0);
    f32x16 acc[2][2];
    zero_acc(acc);
    gemm_main<true>(
        acc, 16, [&](int row) { return abase + (size_t)row * 1024; },
        [&](int row, int k) {
          int n = n0 + row;
          n = n < NIN0 ? n : NIN0 - 1;
          return WT + (size_t)n * 1024 + k;
        },
        sm);
    int b = m0 / LALL, pos0 = m0 - b * LALL;
    bool lat = pos0 >= LC;
#pragma unroll
    for (int mi = 0; mi < 2; ++mi)
#pragma unroll
      for (int ni = 0; ni < 2; ++ni) {
        int col0 = n0 + wn * 64 + ni * 32;
        if (col0 >= NIN0) continue;
        int col = col0 + r;
#pragma unroll
        for (int i = 0; i < 16; ++i) {
          int row = wm * 64 + mi * 32 + crow(i, h);
          int tok = m0 + row;
          float v = acc[mi][ni][i];
          if (col0 < 384) {
            PC[(size_t)tok * 384 + col] = f2bf(v);
          } else if (col0 == 384) {
            float vp = __shfl_xor(v, 8);
            int pos = pos0 + row;
            float val = lat ? rope_apply(r, v, vp, pos - LC) : v;
            KRb[(size_t)tok * 32 + r] = f2bf(val);
          } else {
            SZ0[(size_t)tok * 1024 + (col - 416)] = f2bf(silu_f(v));
          }
          SCHED_FENCE();
        }
      }
  }
}

DI void phase_o2(const Params& p, char* smem) {
  GemmSmem* sm = (GemmSmem*)smem;
  WAVE_IDS
  const int UQ = (TOK / 128) * 12, UKV = (TOK / 128) * 16;
  const bfr* PC = (const bfr*)(p.ws + O_PC);
  bfr* Q = (bfr*)p.out;
  bfr* Kb = (bfr*)(p.ws + O_K);
  bfr* VT = (bfr*)(p.ws + O_VT);
  for (int u = blockIdx.x; u < UQ + UKV; u += gridDim.x) {
    const int us = xcd_swz(u, 28);
    int mt = us / 28, rem = us - mt * 28;
    bool isq = rem < 12;
    int nt = isq ? rem : rem - 12;
    int m0 = mt * 128, n0 = nt * 128;
    int Kd = isq ? 256 : 128;
    int aoff = isq ? 0 : 256;
    const bfr* WT = (const bfr*)(p.ws + (isq ? O_WT_UQ : O_WT_UKV));
    __syncthreads();
    {
      int row = tid >> 1, half = tid & 1;
      const bfr* ap = PC + (size_t)(m0 + row) * 384 + aoff + half * (Kd / 2);
      float ss = 0.f;
      for (int j = 0; j < Kd / 16; ++j) {
        uint4 v = *(const uint4*)(ap + j * 8);
        unsigned w[4] = {v.x, v.y, v.z, v.w};
#pragma unroll
        for (int e = 0; e < 4; ++e) {
          float lo = __uint_as_float(w[e] << 16), hi = __uint_as_float(w[e] & 0xffff0000u);
          ss += lo * lo + hi * hi;
        }
      }
      ss += __shfl_xor(ss, 1);
      if (half == 0) sm->rs[row] = rsqrtf(ss / (float)Kd + EPS);
    }
    __syncthreads();
    f32x16 acc[2][2];
    zero_acc(acc);
    gemm_main<false>(
        acc, Kd / 64, [&](int row, int k) { return PC + (size_t)(m0 + row) * 384 + aoff + k; },
        [&](int row, int k) { return WT + (size_t)(n0 + row) * Kd + k; }, sm);
    int b = m0 / LALL, pos0 = m0 - b * LALL;
    bool lat = pos0 >= LC;
#pragma unroll
    for (int mi = 0; mi < 2; ++mi)
#pragma unroll
      for (int ni = 0; ni < 2; ++ni) {
        int col0 = n0 + wn * 64 + ni * 32;
        if (isq) {
          int hh = col0 / 96, d0 = col0 - hh * 96;
          bool rope = lat && d0 == 64;
#pragma unroll
          for (int i = 0; i < 16; ++i) {
            int row = wm * 64 + mi * 32 + crow(i, h);
            int pos = pos0 + row;
            float v = acc[mi][ni][i] * sm->rs[row];
            float vp = __shfl_xor(v, 8);
            float val = rope ? rope_apply(r, v, vp, pos - LC) : v;
            Q[(((size_t)(b * NH + hh)) * LALL + pos) * DQK + d0 + r] = f2bf(val * QSCALE);
            SCHED_FENCE();
          }
        } else {
          int hh = col0 >> 7, d0 = col0 & 127;
          if (d0 < 64) {
#pragma unroll
            for (int i = 0; i < 16; ++i) {
              int row = wm * 64 + mi * 32 + crow(i, h);
              int pos = pos0 + row;
              float v = acc[mi][ni][i] * sm->rs[row];
              Kb[(((size_t)(b * NH + hh)) * LALL + pos) * 64 + d0 + r] = f2bf(v);
              SCHED_FENCE();
            }
          } else {
            int dvv = d0 - 64 + r;
#pragma unroll
            for (int g4 = 0; g4 < 4; ++g4) {
              int row = wm * 64 + mi * 32 + 8 * g4 + 4 * h;
              int pos = pos0 + row;
              uint2 o;
              o.x = pk2(acc[mi][ni][4 * g4 + 0] * sm->rs[row + 0], acc[mi][ni][4 * g4 + 1] * sm->rs[row + 1]);
              o.y = pk2(acc[mi][ni][4 * g4 + 2] * sm->rs[row + 2], acc[mi][ni][4 * g4 + 3] * sm->rs[row + 3]);
              *(uint2*)(VT + (((size_t)(b * NH + hh)) * DV + dvv) * LALL + pos) = o;
            }
          }
        }
      }
  }
}

constexpr int KLD = 104;
constexpr int VLD = 68;
struct AttnSmem {
  bfr K[64 * KLD];
  bfr V[64 * VLD];
};
static_assert(sizeof(AttnSmem) <= SMEM_BYTES, "smem");

DI void attn_item(const Params& p, AttnSmem* sm, int bh, int qpos0, int nkeys) {
  WAVE_IDS
  const bfr* Q = (const bfr*)p.out;
  const bfr* Kg = (const bfr*)(p.ws + O_K) + (size_t)bh * LALL * 64;
  const bfr* KRg = (const bfr*)(p.ws + O_KR) + (size_t)(bh / NH) * LALL * 32;
  const bfr* Vg = (const bfr*)(p.ws + O_VT) + (size_t)bh * DV * LALL;
  const int qpos = qpos0 + wave * 32 + r;
  bf16x8 bq[6];
  {
    const bfr* qp = Q + ((size_t)bh * LALL + qpos) * DQK + 8 * h;
#pragma unroll
    for (int s = 0; s < 6; ++s) bq[s] = *(const bf16x8*)(qp + 16 * s);
  }
  f32x16 o[2];
#pragma unroll
  for (int d = 0; d < 2; ++d)
#pragma unroll
    for (int i = 0; i < 16; ++i) o[d][i] = 0.f;
  float mrun = 0.f, lrun = 0.f;
  uint4 kv0, kv1, kv2, vv0, vv1;
  const int kr0 = tid / 12, kc0 = (tid - kr0 * 12) * 8;
  const int kr1 = (tid + 256) / 12, kc1 = (tid + 256 - kr1 * 12) * 8;
  const int kr2 = (tid + 512) / 12, kc2 = (tid + 512 - kr2 * 12) * 8;
  const int vr0 = tid >> 3, vc0 = (tid & 7) * 8;
  const bfr* kp0 = kc0 < 64 ? Kg + (size_t)kr0 * 64 + kc0 : KRg + (size_t)kr0 * 32 + (kc0 - 64);
  const bfr* kp1 = kc1 < 64 ? Kg + (size_t)kr1 * 64 + kc1 : KRg + (size_t)kr1 * 32 + (kc1 - 64);
  const bfr* kp2 = kc2 < 64 ? Kg + (size_t)kr2 * 64 + kc2 : KRg + (size_t)kr2 * 32 + (kc2 - 64);
  const int ks0 = kc0 < 64 ? 64 : 32, ks1 = kc1 < 64 ? 64 : 32, ks2 = kc2 < 64 ? 64 : 32;
#define AT_GLOAD(KEY0_)                                                          \
  {                                                                              \
    const int key0_ = (KEY0_);                                                   \
    kv0 = *(const uint4*)(kp0 + (size_t)key0_ * ks0);                            \
    kv1 = *(const uint4*)(kp1 + (size_t)key0_ * ks1);                            \
    kv2 = *(const uint4*)(kp2 + (size_t)key0_ * ks2);                            \
    vv0 = *(const uint4*)(Vg + (size_t)vr0 * LALL + key0_ + vc0);                \
    vv1 = *(const uint4*)(Vg + (size_t)(vr0 + 32) * LALL + key0_ + vc0);         \
  }
#define AT_LSTORE()                                                              \
  {                                                                              \
    *(uint4*)(sm->K + kr0 * KLD + kc0) = kv0;                                    \
    *(uint4*)(sm->K + kr1 * KLD + kc1) = kv1;                                    \
    *(uint4*)(sm->K + kr2 * KLD + kc2) = kv2;                                    \
    uint2* d0_ = (uint2*)(sm->V + vr0 * VLD + vc0);                              \
    d0_[0] = make_uint2(vv0.x, vv0.y);                                           \
    d0_[1] = make_uint2(vv0.z, vv0.w);                                           \
    uint2* d1_ = (uint2*)(sm->V + (vr0 + 32) * VLD + vc0);                       \
    d1_[0] = make_uint2(vv1.x, vv1.y);                                           \
    d1_[1] = make_uint2(vv1.z, vv1.w);                                           \
  }
  const int NTI = nkeys / 64;
  AT_GLOAD(0)
  for (int it = 0; it < NTI; ++it) {
    AT_LSTORE()
    __syncthreads();
    if (it + 1 < NTI) AT_GLOAD((it + 1) * 64)
    SCHED_FENCE();
    f32x16 st[2];
    const float ninit = -mrun;
#pragma unroll
    for (int kb = 0; kb < 2; ++kb)
#pragma unroll
      for (int i = 0; i < 16; ++i) st[kb][i] = ninit;
#pragma unroll
    for (int s = 0; s < 6; ++s) {
#pragma unroll
      for (int kb = 0; kb < 2; ++kb) {
        bf16x8 ka = *(const bf16x8*)(sm->K + (kb * 32 + r) * KLD + 16 * s + 8 * h);
        st[kb] = MFMA32(ka, bq[s], st[kb]);
      }
    }
    float mx = fmaxf(fmaxf(st[0][0], st[0][1]), st[1][0]);
#pragma unroll
    for (int i = 2; i < 16; i += 2) mx = fmaxf(fmaxf(mx, st[0][i]), st[0][i + 1]);
#pragma unroll
    for (int i = 1; i < 15; i += 2) mx = fmaxf(fmaxf(mx, st[1][i]), st[1][i + 1]);
    mx = fmaxf(mx, st[1][15]);
    mx = fmaxf(mx, __shfl_xor(mx, 32));
    const bool need = (it == 0) || (mx > 8.f);
    if (__any(need)) {
      const float delta = need ? mx : 0.f;
      const float alpha = __builtin_amdgcn_exp2f(-delta);
      mrun += delta;
      lrun *= alpha;
#pragma unroll
      for (int d = 0; d < 2; ++d)
#pragma unroll
        for (int i = 0; i < 16; ++i) o[d][i] *= alpha;
#pragma unroll
      for (int kb = 0; kb < 2; ++kb)
#pragma unroll
        for (int i = 0; i < 16; ++i) st[kb][i] -= delta;
    }
    float ps = 0.f;
#pragma unroll
    for (int kb = 0; kb < 2; ++kb)
#pragma unroll
      for (int i = 0; i < 16; ++i) {
        float e = __builtin_amdgcn_exp2f(st[kb][i]);
        st[kb][i] = e;
        ps += e;
      }
    lrun += ps;
#pragma unroll
    for (int kb = 0; kb < 2; ++kb)
#pragma unroll
      for (int s2 = 0; s2 < 2; ++s2) {
        unsigned pw[4];
#pragma unroll
        for (int j = 0; j < 4; ++j) pw[j] = pk2(st[kb][8 * s2 + 2 * j], st[kb][8 * s2 + 2 * j + 1]);
        bf16x8 pb;
        {
          uint4 t = make_uint4(pw[0], pw[1], pw[2], pw[3]);
          pb = __builtin_bit_cast(bf16x8, t);
        }
#pragma unroll
        for (int d = 0; d < 2; ++d) {
          const bfr* vp = sm->V + (d * 32 + r) * VLD + kb * 32 + 16 * s2 + 4 * h;
          uint2 lo = *(const uint2*)vp;
          uint2 hi = *(const uint2*)(vp + 8);
          uint4 t = make_uint4(lo.x, lo.y, hi.x, hi.y);
          bf16x8 va = __builtin_bit_cast(bf16x8, t);
          o[d] = MFMA32(va, pb, o[d]);
        }
      }
    __syncthreads();
  }
  float ltot = lrun + __shfl_xor(lrun, 32);
  float inv = 1.f / ltot;
  int b = bh / NH, hh = bh - b * NH;
  size_t tok = (size_t)b * LALL + qpos;
  const bfr* SZ = (const bfr*)(p.ws + O_SZ0) + tok * 1024 + hh * 64;
  bfr* OG = (bfr*)(p.ws + O_OG) + tok * 1024 + hh * 64;
#pragma unroll
  for (int d = 0; d < 2; ++d)
#pragma unroll
    for (int g4 = 0; g4 < 4; ++g4) {
      int dv0 = d * 32 + 8 * g4 + 4 * h;
      uint2 z = *(const uint2*)(SZ + dv0);
      float z0 = __uint_as_float(z.x << 16), z1 = __uint_as_float(z.x & 0xffff0000u);
      float z2 = __uint_as_float(z.y << 16), z3 = __uint_as_float(z.y & 0xffff0000u);
      uint2 ov;
      ov.x = pk2(o[d][4 * g4 + 0] * inv * z0, o[d][4 * g4 + 1] * inv * z1);
      ov.y = pk2(o[d][4 * g4 + 2] * inv * z2, o[d][4 * g4 + 3] * inv * z3);
      *(uint2*)(OG + dv0) = ov;
    }
}

DI void phase_o3(const Params& p, char* smem) {
  AttnSmem* sm = (AttnSmem*)smem;
  const int xcd = blockIdx.x & 7, local = blockIdx.x >> 3, nloc = gridDim.x >> 3;
  for (int j = local; j < 256; j += nloc) {
    int u = xcd * 256 + j;
    attn_item(p, sm, u >> 4, LC + (u & 15) * 128, LALL);
  }
  for (int j = local; j < 32; j += nloc) {
    int u = xcd * 32 + j;
    attn_item(p, sm, u >> 1, (u & 1) * 128, LC);
  }
}

template <int LAYER>
DI void phase_oproj(const Params& p, char* smem) {
  GemmSmem* sm = (GemmSmem*)smem;
  WAVE_IDS
  constexpr int NROWS = LAYER == 0 ? TOK : NLAT;
  const int NT = 8, units = (NROWS / 128) * NT;
  const bfr* Ab = (const bfr*)(p.ws + (LAYER == 0 ? O_OG : O_Y2));
  const bfr* WT = (const bfr*)(p.ws + (LAYER == 0 ? O_WT_OUT0 : O_WT_OUT1));
  float* part = (float*)(p.ws + (LAYER == 0 ? O_PART1 : O_PART2));
  for (int u = blockIdx.x; u < units; u += gridDim.x) {
    const int us = xcd_swz(u, NT);
    int mt = us / NT, nt = us - mt * NT;
    int m0 = mt * 128, n0 = nt * 128;
    f32x16 acc[2][2];
    zero_acc(acc);
    gemm_main<false>(
        acc, 16, [&](int row, int k) { return Ab + (size_t)(m0 + row) * 1024 + k; },
        [&](int row, int k) { return WT + (size_t)(n0 + row) * 1024 + k; }, sm);
    const float* xin;
    float* xout;
    const float* gt;
    if (LAYER == 0) {
      xin = xrow0(p, m0);
      xout = xrow1(p, m0);
      gt = modrow(p, 0, m0) + 2048;
    } else {
      xin = p.out + (size_t)m0 * 1024;
      xout = p.out + (size_t)m0 * 1024;
      gt = (const float*)(p.ws + O_MOD) + ((size_t)(9 + (m0 >> 11))) * 3072 + 2048;
    }
    float tot = 0.f;
#pragma unroll
    for (int mi = 0; mi < 2; ++mi) {
      float sq[16];
#pragma unroll
      for (int i = 0; i < 16; ++i) sq[i] = 0.f;
#pragma unroll
      for (int ni = 0; ni < 2; ++ni) {
        int col = n0 + wn * 64 + ni * 32 + r;
        float g = gt[col];
        float xv[16];
#pragma unroll
        for (int i = 0; i < 16; ++i) xv[i] = xin[(size_t)(wm * 64 + mi * 32 + crow(i, h)) * 1024 + col];
        SCHED_FENCE();
#pragma unroll
        for (int i = 0; i < 16; ++i) {
          int row = wm * 64 + mi * 32 + crow(i, h);
          float v = xv[i] + g * acc[mi][ni][i];
          xout[(size_t)row * 1024 + col] = v;
          sq[i] += v * v;
        }
        SCHED_FENCE();
      }
      float t = transpose_reduce16(sq, lane);
      t += __shfl_xor(t, 16);
      if (((lane >> 4) & 1) == mi) tot = t;
    }
    int idx = lane & 31;
    int row = m0 + wm * 64 + (idx >> 4) * 32 + crow(idx & 15, h);
    part[(size_t)(nt * 2 + wn) * NROWS + row] = tot;
  }
}

DI void phase_o5(const Params& p, char* smem) {
  GemmSmem* sm = (GemmSmem*)smem;
  WAVE_IDS
  const int NT = 16, units = (TOK / 128) * NT;
  const bfr* WT = (const bfr*)(p.ws + O_WT_IN1);
  const float* part = (const float*)(p.ws + O_PART1);
  bfr* U2 = (bfr*)(p.ws + O_U2);
  bfr* SZ1 = (bfr*)(p.ws + O_SZ1);
  for (int u = blockIdx.x; u < units; u += gridDim.x) {
    const int us = xcd_swz(u, NT);
    int mt = us / NT, nt = us - mt * NT;
    int m0 = mt * 128, n0 = nt * 128;
    int b = m0 / LALL, pos0 = m0 - b * LALL;
    bool lat = pos0 >= LC;
    if (!lat && nt >= 8) continue;
    __syncthreads();
    const float* md = modrow(p, 1, m0);
    const float* ng = p.in[I_NORMG] + 1024;
    for (int k = tid; k < 1024; k += 256) {
      sm->gs[k] = ng[k] * (1.f + md[1024 + k]);
      sm->sh[k] = md[k];
    }
    if (tid < 128) sm->rs[tid] = rs_from_part(part, TOK, m0 + tid);
    __syncthreads();
    const float* abase = xrow1(p, m0);
    f32x16 acc[2][2];
    zero_acc(acc);
    gemm_main<true>(
        acc, 16, [&](int row) { return abase + (size_t)row * 1024; },
        [&](int row, int k) { return WT + (size_t)(n0 + row) * 1024 + k; }, sm);
#pragma unroll
    for (int mi = 0; mi < 2; ++mi)
#pragma unroll
      for (int ni = 0; ni < 2; ++ni) {
        int col = n0 + wn * 64 + ni * 32 + r;
#pragma unroll
        for (int i = 0; i < 16; ++i) {
          int row = wm * 64 + mi * 32 + crow(i, h);
          int tok = m0 + row;
          float v = acc[mi][ni][i];
          if (col < 1024) U2[((size_t)(col >> 4) * TOK + tok) * 16 + (col & 15)] = f2bf(v);
          else SZ1[((size_t)(b * SEQ + pos0 + row - LC)) * 1024 + (col - 1024)] = f2bf(silu_f(v));
          SCHED_FENCE();
        }
      }
  }
}

DI void phase_o6(const Params& p, char* smem) {
  GemmSmem* sm = (GemmSmem*)smem;
  WAVE_IDS
  const int NROW = NB * NCH;
  const int units = 64 * 5 * 2;
  const bfr* U2 = (const bfr*)(p.ws + O_U2);
  const bfr* WST = (const bfr*)(p.ws + O_WST);
  float* SLOC = (float*)(p.ws + O_SLOC);
  for (int u = blockIdx.x; u < units; u += gridDim.x) {
    const int us = xcd_swz(u, 10);
    int g = us / 10, rem = us - g * 10;
    int mt = rem >> 1, nt = rem & 1;
    int m0 = mt * 128, n0 = nt * 128;
    const bfr* Ag = U2 + (size_t)g * TOK * 16;
    const bfr* Bg = WST + (size_t)g * 256 * 512;
    f32x16 acc[2][2];
    zero_acc(acc);
    gemm_main<false>(
        acc, 8,
        [&](int row, int k) {
          int rr = m0 + row;
          rr = rr < NROW ? rr : NROW - 1;
          return Ag + (size_t)rr * 512 + k;
        },
        [&](int row, int k) { return Bg + (size_t)(n0 + row) * 512 + k; }, sm);
#pragma unroll
    for (int mi = 0; mi < 2; ++mi)
#pragma unroll
      for (int ni = 0; ni < 2; ++ni) {
        int col = n0 + wn * 64 + ni * 32 + r;
#pragma unroll
        for (int i = 0; i < 16; ++i) {
          int row = m0 + wm * 64 + mi * 32 + crow(i, h);
          if (row < NROW) SLOC[((size_t)g * NROW + row) * 256 + col] = acc[mi][ni][i];
        }
      }
  }
}

DI void phase_o7(const Params& p) {
  const int tidx_ = opaque_tid();
  const float* SLOC = (const float*)(p.ws + O_SLOC);
  bfr* SIN = (bfr*)(p.ws + O_SIN);
  const int total = NB * 64 * 2 * 64;
  for (int idx = blockIdx.x * 256 + tidx_; idx < total; idx += gridDim.x * 256) {
    int pp = idx & 63, dir = (idx >> 6) & 1, g = (idx >> 7) & 63, b = idx >> 13;
    double dt, ar, ai;
    float fr, fi, lr, li;
    s5_disc(p, dir, g, pp, dt, ar, ai, fr, fi);
    s5_pow(dt, ar, ai, TC, lr, li);
    float sr = 0.f, si = 0.f;
#pragma unroll 8
    for (int step = 0; step < NCH; ++step) {
      int cp = dir == 0 ? step : (step < 8 ? 7 - step : NCH - 1 - (step - 8));
      const float* sl = SLOC + ((size_t)g * (NB * NCH) + b * NCH + cp) * 256 + dir * 128 + pp;
#ifdef PROBE_NOCARRY
      if ((dir == 0 && cp == 8) || (dir == 1 && cp == NCH - 1)) { sr = 0.f; si = 0.f; }
#endif
      if (cp >= 8) {
        bfr* so = SIN + ((size_t)g * (NB * NCHL) + b * NCHL + (cp - 8)) * 256 + dir * 128 + pp;
        so[0] = f2bf(sr);
        so[64] = f2bf(si);
      }
      float lre = sl[0], lim = sl[64];
      float nr = lr * sr - li * si + lre;
      float ni = lr * si + li * sr + lim;
      sr = nr;
      si = ni;
    }
  }
}

DI void phase_o8(const Params& p, char* smem) {
  GemmSmem* sm = (GemmSmem*)smem;
  WAVE_IDS
  const int units = 64 * 4 * 4;
  const bfr* U2 = (const bfr*)(p.ws + O_U2);
  const bfr* SIN = (const bfr*)(p.ws + O_SIN);
  const bfr* KTAB = (const bfr*)(p.ws + O_KTAB);
  const bfr* VOP = (const bfr*)(p.ws + O_VOP);
  bfr* YG = (bfr*)(p.ws + O_YG);
  for (int u = blockIdx.x; u < units; u += gridDim.x) {
    const int us = xcd_swz(u, 16);
    int g = us >> 4, mt = (us >> 2) & 3, nt = us & 3;
    int m0 = mt * 128, n0 = nt * 128;
    const bfr* Ug = U2 + (size_t)g * TOK * 16;
    f32x16 acc[2][2];
    zero_acc(acc);
    gemm_main<false>(
        acc, 8,
        [&](int row, int k) {
          int rr = m0 + row;
          int b = rr >> 6, n = rr & 63;
          return Ug + ((size_t)b * LALL + LC + n * TC) * 16 + k;
        },
        [&](int row, int k) {
          int m = n0 + row;
          int t = m >> 4, c = m & 15;
          return KTAB + (((size_t)g * 63 + (t + 31)) * 16 + c) * 16 - (k >> 4) * 256 + (k & 15);
        },
        sm);
    gemm_main<false>(
        acc, 4, [&](int row, int k) { return SIN + ((size_t)g * (NB * NCHL) + m0 + row) * 256 + k; },
        [&](int row, int k) { return VOP + ((size_t)g * 512 + n0 + row) * 256 + k; }, sm);
#pragma unroll
    for (int mi = 0; mi < 2; ++mi)
#pragma unroll
      for (int ni = 0; ni < 2; ++ni) {
        int m = n0 + wn * 64 + ni * 32 + r;
        int t = m >> 4, c = m & 15;
        int ch = g * 16 + c;
        float dd = p.in[I_S5D][ch];
        float uv[16];
#pragma unroll
        for (int i = 0; i < 16; ++i) {
          int rr = m0 + wm * 64 + mi * 32 + crow(i, h);
          int b = rr >> 6, n = rr & 63;
          uv[i] = bf2f(Ug[((size_t)b * LALL + LC + n * TC + t) * 16 + c]);
        }
        SCHED_FENCE();
#pragma unroll
        for (int i = 0; i < 16; ++i) {
          int rr = m0 + wm * 64 + mi * 32 + crow(i, h);
          int b = rr >> 6, n = rr & 63;
          float y = acc[mi][ni][i] + dd * uv[i];
          YG[((size_t)(b * SEQ + n * TC + t)) * 1024 + ch] = f2bf(gelu_tanh(y));
        }
        SCHED_FENCE();
      }
  }
}

DI void phase_o9(const Params& p, char* smem) {
  GemmSmem* sm = (GemmSmem*)smem;
  WAVE_IDS
  const int NT = 8, units = (NLAT / 128) * NT;
  const bfr* YG = (const bfr*)(p.ws + O_YG);
  const bfr* SZ1 = (const bfr*)(p.ws + O_SZ1);
  const bfr* WT = (const bfr*)(p.ws + O_WT_GLU);
  bfr* Y2 = (bfr*)(p.ws + O_Y2);
  for (int u = blockIdx.x; u < units; u += gridDim.x) {
    const int us = xcd_swz(u, NT);
    int mt = us / NT, nt = us - mt * NT;
    int m0 = mt * 128, n0 = nt * 128;
    f32x16 acc[2][2];
    zero_acc(acc);
    gemm_main<false>(
        acc, 16, [&](int row, int k) { return YG + (size_t)(m0 + row) * 1024 + k; },
        [&](int row, int k) { return WT + (size_t)(n0 + row) * 1024 + k; }, sm);
#pragma unroll
    for (int mi = 0; mi < 2; ++mi)
#pragma unroll
      for (int ni = 0; ni < 2; ++ni) {
        int col = n0 + wn * 64 + ni * 32 + r;
        float bg = p.in[I_BGLU][col];
        float yv[16], zv[16];
#pragma unroll
        for (int i = 0; i < 16; ++i) {
          size_t o = (size_t)(m0 + wm * 64 + mi * 32 + crow(i, h)) * 1024 + col;
          yv[i] = bf2f(YG[o]);
          zv[i] = bf2f(SZ1[o]);
        }
        SCHED_FENCE();
#pragma unroll
        for (int i = 0; i < 16; ++i) {
          size_t o = (size_t)(m0 + wm * 64 + mi * 32 + crow(i, h)) * 1024 + col;
          Y2[o] = f2bf(yv[i] * sigmoid_f(acc[mi][ni][i] + bg) * zv[i]);
        }
        SCHED_FENCE();
      }
  }
}

#define XB_TMO      128
#define XB_XCNT(j)  (256  + 64 * (j))
#define XB_XSUB(j)  (1280 + 64 * (j))
#define XB_XGEN(j)  (2304 + 64 * (j))
#define XB_TOP      3328
#define XB_TOPGEN   3392
#define XCD_BAR_WORDS 3456
#define XB_SPIN_CAP (1u << 18)
#define LAS __attribute__((address_space(3)))
DI unsigned xb_ld(unsigned* p) { return __hip_atomic_load(p, __ATOMIC_RELAXED, __HIP_MEMORY_SCOPE_AGENT); }
DI unsigned xb_add(unsigned* p, unsigned v) { return __hip_atomic_fetch_add(p, v, __ATOMIC_RELAXED, __HIP_MEMORY_SCOPE_AGENT); }
DI unsigned xb_xcc_id() { return (unsigned)__builtin_amdgcn_s_getreg((3 << 11) | 20) & 0xFu; }
#define XB_SPIN(cond, bar) do { unsigned _sp = 0; while (cond) { __builtin_amdgcn_s_sleep(1); \
    if ((++_sp & 255u) == 0u) { if (xb_ld(&(bar)[XB_TMO])) break; if (_sp > XB_SPIN_CAP) { atomicAdd(&(bar)[XB_TMO], 1u); break; } } } } while (0)
struct XcdBarrier {
  unsigned* bar;
  unsigned x;
  volatile LAS unsigned* st;
};
DI XcdBarrier xcd_barrier_post(unsigned* bar, volatile LAS unsigned* st) {
  XcdBarrier b;
  b.bar = bar;
  b.x = xb_xcc_id();
  b.st = st;
  if (threadIdx.x == 0) (void)xb_add(&bar[XB_XCNT(b.x)], 1u);
  return b;
}
DI void xcd_barrier_complete(unsigned* bar, unsigned x, unsigned& nloc, unsigned& nx) {
  const unsigned G = gridDim.x * gridDim.y * gridDim.z;
  unsigned sum, cnt, mine, sp = 0u;
  for (;;) {
    sum = 0u; cnt = 0u; mine = 0u;
#pragma unroll
    for (unsigned j = 0; j < 16; ++j) {
      const unsigned c = xb_ld(&bar[XB_XCNT(j)]);
      sum += c;
      cnt += (c > 0u) ? 1u : 0u;
      mine = (j == x) ? c : mine;
    }
    if (sum == G) break;
    __builtin_amdgcn_s_sleep(1);
    if ((++sp & 255u) == 0u) {
      if (xb_ld(&bar[XB_TMO])) break;
      if (sp > XB_SPIN_CAP) { atomicAdd(&bar[XB_TMO], 1u); break; }
    }
  }
  nloc = mine > 0u ? mine : 1u;
  nx = cnt > 0u ? cnt : 1u;
}
DI void xcd_barrier(const XcdBarrier& b) {
  asm volatile("s_waitcnt vmcnt(0)" ::: "memory");
  __syncthreads();
  if (threadIdx.x == 0) {
    unsigned* bar = b.bar;
    __builtin_amdgcn_s_waitcnt(0);
    unsigned nloc = b.st[0], nx = b.st[1];
    if (nloc == 0u) {
      xcd_barrier_complete(bar, b.x, nloc, nx);
      b.st[0] = nloc;
      b.st[1] = nx;
    }
    const unsigned old = xb_add(&bar[XB_XSUB(b.x)], 1u);
    const unsigned gen = old / nloc;
    if (old + 1u == (gen + 1u) * nloc) {
      __builtin_amdgcn_fence(__ATOMIC_RELEASE, "agent");
      asm volatile("s_waitcnt vmcnt(0)" ::: "memory");
      const unsigned og = xb_add(&bar[XB_TOP], 1u);
      const unsigned tg = og / nx;
      if (og + 1u == (tg + 1u) * nx) xb_add(&bar[XB_TOPGEN], 1u);
      else XB_SPIN(xb_ld(&bar[XB_TOPGEN]) == tg, bar);
      __builtin_amdgcn_fence(__ATOMIC_ACQUIRE, "agent");
      xb_add(&bar[XB_XGEN(b.x)], 1u);
      asm volatile("s_waitcnt vmcnt(0)" ::: "memory");
    } else {
      XB_SPIN(xb_ld(&bar[XB_XGEN(b.x)]) == gen, bar);
      __builtin_amdgcn_fence(__ATOMIC_ACQUIRE, "agent");
      asm volatile("s_waitcnt vmcnt(0)" ::: "memory");
    }
  }
  __syncthreads();
}

DI void run_phase(const Params& p, int ph, char* smem) {
  switch (ph) {
#if !defined(ONLY) || ONLY == 0
    case PH_PREP: phase_prep(p, smem); break;
#endif
#if USE_NAIVE
    case PH_N1: phase_n1(p); break;
    case PH_N2: phase_n2(p); break;
    case PH_N3: phase_n3(p); break;
    case PH_N4: phase_n4(p); break;
    case PH_N4B: phase_rowsq(p, 1); break;
    case PH_N5: phase_n5(p); break;
    case PH_N6A: phase_n6(p, 0); break;
    case PH_N6B: phase_n6(p, 1); break;
    case PH_N9: phase_n9(p); break;
    case PH_N10: phase_n10(p); break;
    case PH_N10B: phase_rowsq(p, 2); break;
#endif
#if !defined(ONLY) || ONLY == 1
    case PH_FINAL: phase_final(p); break;
#endif
#if !defined(ONLY) || ONLY == 2
    case PH_O1: phase_o1(p, smem); break;
#endif
#if !defined(ONLY) || ONLY == 3
    case PH_O2: phase_o2(p, smem); break;
#endif
#if !defined(ONLY) || ONLY == 4
    case PH_O3: phase_o3(p, smem); break;
#endif
#if !defined(ONLY) || ONLY == 5
    case PH_O4: phase_oproj<0>(p, smem); break;
#endif
#if !defined(ONLY) || ONLY == 6
    case PH_O5: phase_o5(p, smem); break;
#endif
#if !defined(ONLY) || ONLY == 7
    case PH_O6: phase_o6(p, smem); break;
#endif
#if !defined(ONLY) || ONLY == 8
    case PH_O7: phase_o7(p); break;
#endif
#if !defined(ONLY) || ONLY == 9
    case PH_O8: phase_o8(p, smem); break;
#endif
#if !defined(ONLY) || ONLY == 10
    case PH_O9: phase_o9(p, smem); break;
#endif
#if !defined(ONLY) || ONLY == 11
    case PH_O10: phase_oproj<1>(p, smem); break;
#endif
    default: break;
  }
}

__global__ void __launch_bounds__(256, 2) mega_one(Params p, int ph) {
  __shared__ __attribute__((aligned(16))) char smem[SMEM_BYTES];
  run_phase(p, ph, smem);
}

#if !defined(ONLY) && SINGLE_LAUNCH
__global__ void __launch_bounds__(256, 2) mega(Params p) {
  __shared__ __attribute__((aligned(16))) char smem[SMEM_BYTES];
  __shared__ uint4 xb_words;
  if (threadIdx.x == 0) xb_words = make_uint4(0u, 0u, 0u, 0u);
  __syncthreads();
  if (p.nprog < 0) cg::this_grid().sync();
  const XcdBarrier xb = xcd_barrier_post((unsigned*)(p.ws + O_BAR), (volatile LAS unsigned*)&xb_words);
  cg::grid_group grid = cg::this_grid();
#if !defined(OMIT) || OMIT != 0
  phase_prep(p, smem);
#endif
  xcd_barrier(xb);
#if (DUP >> 0) & 1
  phase_prep(p, smem);
  xcd_barrier(xb);
#endif
#if !defined(OMIT) || OMIT != 1
  phase_o1(p, smem);
#endif
  xcd_barrier(xb);
#if (DUP >> 1) & 1
  phase_o1(p, smem);
  xcd_barrier(xb);
#endif
#if !defined(OMIT) || OMIT != 2
  phase_o2(p, smem);
#endif
  xcd_barrier(xb);
#if (DUP >> 2) & 1
  phase_o2(p, smem);
  xcd_barrier(xb);
#endif
#if !defined(OMIT) || OMIT != 3
  phase_o3(p, smem);
#endif
  xcd_barrier(xb);
#if (DUP >> 3) & 1
  phase_o3(p, smem);
  xcd_barrier(xb);
#endif
#if !defined(OMIT) || OMIT != 4
  phase_oproj<0>(p, smem);
#endif
  xcd_barrier(xb);
#if (DUP >> 4) & 1
  phase_oproj<0>(p, smem);
  xcd_barrier(xb);
#endif
#if !defined(OMIT) || OMIT != 5
  phase_o5(p, smem);
#endif
  xcd_barrier(xb);
#if (DUP >> 5) & 1
  phase_o5(p, smem);
  xcd_barrier(xb);
#endif
#if !defined(OMIT) || OMIT != 6
  phase_o6(p, smem);
#endif
  xcd_barrier(xb);
#if (DUP >> 6) & 1
  phase_o6(p, smem);
  xcd_barrier(xb);
#endif
#if !defined(OMIT) || OMIT != 7
  phase_o7(p);
#endif
  xcd_barrier(xb);
#if (DUP >> 7) & 1
  phase_o7(p);
  xcd_barrier(xb);
#endif
#if !defined(OMIT) || OMIT != 8
  phase_o8(p, smem);
#endif
  xcd_barrier(xb);
#if (DUP >> 8) & 1
  phase_o8(p, smem);
  xcd_barrier(xb);
#endif
#if !defined(OMIT) || OMIT != 9
  phase_o9(p, smem);
#endif
  xcd_barrier(xb);
#if (DUP >> 9) & 1
  phase_o9(p, smem);
  xcd_barrier(xb);
#endif
#if !defined(OMIT) || OMIT != 10
  phase_oproj<1>(p, smem);
#endif
  xcd_barrier(xb);
#if !defined(OMIT) || OMIT != 11
  phase_final(p);
#endif
}
#else
__global__ void mega(Params p) {}
#endif


extern "C" void kernel_launch(void* const* d_in, const int* in_sizes, int n_in, void* d_out, int out_size, void* d_ws,
                              size_t ws_size, hipStream_t stream) {
  static int grid_blocks = 0;
  if (!grid_blocks) {
    int dev = 0, cus = 0, per_cu = 0;
    hipGetDevice(&dev);
    hipDeviceGetAttribute(&cus, hipDeviceAttributeMultiprocessorCount, dev);
#if SINGLE_LAUNCH
    hipOccupancyMaxActiveBlocksPerMultiprocessor(&per_cu, mega, 256, 0);
#else
    hipOccupancyMaxActiveBlocksPerMultiprocessor(&per_cu, mega_one, 256, 0);
#endif
    if (per_cu < 1) per_cu = 1;
    if (per_cu > 2) per_cu = 2;
    grid_blocks = cus * per_cu;
  }
  if (ws_size < WS_NEED || n_in < N_INPUTS) {
    fprintf(stderr, "workspace too small or bad inputs: %zu < %zu\n", ws_size, (size_t)WS_NEED);
    return;
  }
  Params p{};
  for (int i = 0; i < N_INPUTS; ++i) p.in[i] = (const float*)d_in[i];
  p.out = (float*)d_out;
  p.ws = (char*)d_ws;
#ifndef PROG
#define PROG PH_PREP, PH_O1, PH_O2, PH_O3, PH_O4, PH_O5, PH_O6, PH_O7, PH_O8, PH_O9, PH_O10, PH_FINAL
#endif
  const int prog[] = {PROG};
  p.nprog = (int)(sizeof(prog) / sizeof(int));
  for (int i = 0; i < p.nprog; ++i) p.prog[i] = prog[i];
#if SINGLE_LAUNCH
  hipMemsetAsync((char*)d_ws + O_BAR, 0, BAR_BYTES, stream);
  void* args[] = {&p};
  hipError_t e = hipLaunchCooperativeKernel((void*)mega, dim3(grid_blocks), dim3(256), args, 0, stream);
  if (e != hipSuccess) fprintf(stderr, "cooperative launch failed: %s (grid %d)\n", hipGetErrorString(e), grid_blocks);
#else
  for (int i = 0; i < p.nprog; ++i) {
    mega_one<<<dim3(grid_blocks), dim3(256), 0, stream>>>(p, p.prog[i]);
  }
#endif
}
```

```cpp
#include <hip/hip_runtime.h>
#include <hip/hip_cooperative_groups.h>
#include <cstdio>
namespace cg = cooperative_groups;
#ifndef DUP
#define DUP 0
#endif
#ifndef USE_NAIVE
#define USE_NAIVE 0
#endif
#ifndef SINGLE_LAUNCH
#define SINGLE_LAUNCH 1
#endif

#define DI __device__ __forceinline__
typedef unsigned short bfr;

constexpr int D = 1024, NB = 8, SEQ = 2048, LC = 256, LALL = 2304;
constexpr int TOK = NB * LALL;
constexpr int NLAT = NB * SEQ;
constexpr int NH = 16, DQK = 96, DV = 64;
constexpr int NIN0 = 1440, NIN1 = 2048;
constexpr float EPS = 1e-6f;
constexpr float QSCALE = 0.10206207261596577f * 1.4426950408889634f;
constexpr int TC = 32;
constexpr int NCH = LALL / TC;
constexpr int NCHL = SEQ / TC;

enum { I_X = 0, I_C, I_CTX, I_CCTX, I_ADAW, I_ADAB, I_NORMG, I_WIN0, I_QNORM, I_WUQ, I_KVNORM, I_WUKV, I_WOUT0,
       I_WIN1, I_ARE, I_AIM, I_LOGSTEP, I_BRE, I_BIM, I_CRE, I_CIM, I_S5D, I_WGLU, I_BGLU, I_WOUT1, I_FINALG, N_INPUTS };

constexpr size_t al256(size_t x) { return (x + 255) & ~(size_t)255; }
constexpr size_t O_WT_IN0 = 0;
constexpr size_t O_WT_UQ = O_WT_IN0 + al256((size_t)NIN0 * 1024 * 2);
constexpr size_t O_WT_UKV = O_WT_UQ + al256((size_t)1536 * 256 * 2);
constexpr size_t O_WT_OUT0 = O_WT_UKV + al256((size_t)2048 * 128 * 2);
constexpr size_t O_WT_IN1 = O_WT_OUT0 + al256((size_t)1024 * 1024 * 2);
constexpr size_t O_WT_GLU = O_WT_IN1 + al256((size_t)2048 * 1024 * 2);
constexpr size_t O_WT_OUT1 = O_WT_GLU + al256((size_t)1024 * 1024 * 2);
constexpr size_t O_MOD = O_WT_OUT1 + al256((size_t)1024 * 1024 * 2);
constexpr size_t O_RS0 = O_MOD + al256((size_t)2 * 9 * 3072 * 4);
constexpr size_t O_PART1 = O_RS0 + al256((size_t)TOK * 4);
constexpr size_t O_PART2 = O_PART1 + al256((size_t)16 * TOK * 4);
constexpr size_t O_X1CTX = O_PART2 + al256((size_t)16 * NLAT * 4);
constexpr size_t O_KTAB = O_X1CTX + al256((size_t)NB * LC * 1024 * 4);
constexpr size_t O_WST = O_KTAB + al256((size_t)64 * 63 * 256 * 2);
constexpr size_t O_VOP = O_WST + al256((size_t)64 * 256 * 512 * 2);
constexpr size_t O_BAR = O_VOP + al256((size_t)64 * 512 * 256 * 2);
constexpr size_t BAR_BYTES = 3456 * 4;
constexpr size_t O_LAYER = O_BAR + al256(BAR_BYTES);
constexpr size_t O_PC = O_LAYER;
constexpr size_t O_SZ0 = O_PC + al256((size_t)TOK * 384 * 2);
constexpr size_t O_K = O_SZ0 + al256((size_t)TOK * 1024 * 2);
constexpr size_t O_VT = O_K + al256((size_t)NB * NH * LALL * 64 * 2);
constexpr size_t O_OG = O_VT + al256((size_t)NB * NH * DV * LALL * 2);
constexpr size_t O_KR = O_OG + al256((size_t)TOK * 1024 * 2);
constexpr size_t O_END0 = O_KR + al256((size_t)TOK * 32 * 2);
constexpr size_t O_H0 = O_OG;
constexpr size_t O_U2 = O_LAYER;
constexpr size_t O_SZ1 = O_U2 + al256((size_t)64 * TOK * 16 * 2);
constexpr size_t O_SLOC = O_SZ1 + al256((size_t)NLAT * 1024 * 2);
constexpr size_t O_SIN = O_SLOC + al256((size_t)64 * (NB * NCH) * 256 * 4);
constexpr size_t O_YG = O_SIN + al256((size_t)64 * (NB * NCHL) * 256 * 2);
constexpr size_t O_H1 = O_YG + al256((size_t)NLAT * 1024 * 2);
constexpr size_t O_END1 = O_H1 + al256((size_t)TOK * 1024 * 2);
constexpr size_t O_Y2 = O_SLOC;
constexpr size_t WS_NEED = (O_END0 > O_END1 ? O_END0 : O_END1);
static_assert(WS_NEED <= (size_t)256 * 1024 * 1024, "workspace too large");
static_assert((size_t)NB * NH * LALL * DQK * 2 <= (size_t)NLAT * 1024 * 4, "Q does not fit d_out");

struct Params {
  const float* in[N_INPUTS];
  float* out;
  char* ws;
  int prog[32];
  int nprog;
  int pad;
};

DI bfr f2bf(float x) {
  unsigned u = __float_as_uint(x);
  u += 0x7fffu + ((u >> 16) & 1u);
  return (bfr)(u >> 16);
}
typedef __bf16 bf2_t __attribute__((ext_vector_type(2)));
typedef float f2_t __attribute__((ext_vector_type(2)));
DI unsigned pk2(float a, float b) {
  f2_t v = {a, b};
  bf2_t r = __builtin_convertvector(v, bf2_t);
  return __builtin_bit_cast(unsigned, r);
}
DI int opaque_tid() {
  int t = threadIdx.x;
  asm volatile("" : "+v"(t));
  return t;
}
DI float bf2f(bfr b) { return __uint_as_float(((unsigned)b) << 16); }
DI float silu_f(float v) { return v / (1.f + __expf(-v)); }
DI float sigmoid_f(float v) { return 1.f / (1.f + __expf(-v)); }
DI float gelu_tanh(float v) {
  float u = 0.7978845608028654f * (v + 0.044715f * v * v * v);
  return 0.5f * v * (1.f + tanhf(u));
}
DI float wave_sum(float v) {
#pragma unroll
  for (int o = 32; o > 0; o >>= 1) v += __shfl_xor(v, o);
  return v;
}
DI float wave_max(float v) {
#pragma unroll
  for (int o = 32; o > 0; o >>= 1) v = fmaxf(v, __shfl_xor(v, o));
  return v;
}
DI const float* xrow0(const Params& p, int tok) {
  int b = tok / LALL, pos = tok - b * LALL;
  return pos < LC ? p.in[I_CTX] + ((size_t)(b * LC + pos)) * D : p.in[I_X] + ((size_t)(b * SEQ + pos - LC)) * D;
}
DI float* xrow1(const Params& p, int tok) {
  int b = tok / LALL, pos = tok - b * LALL;
  return pos < LC ? (float*)(p.ws + O_X1CTX) + ((size_t)(b * LC + pos)) * D : p.out + ((size_t)(b * SEQ + pos - LC)) * D;
}
DI const float* modrow(const Params& p, int layer, int tok) {
  int b = tok / LALL, pos = tok - b * LALL;
  int r = pos < LC ? 8 : b;
  return (const float*)(p.ws + O_MOD) + ((size_t)(layer * 9 + r)) * 3072;
}
DI void rope_cs(int fi, int posv, float& cs, float& sn) {
  float inv = __builtin_amdgcn_exp2f(-(float)fi * (13.287712379549449f / 8.f));
  float rev = (float)posv * inv * 0.15915494309189535f;
  rev -= floorf(rev);
  sn = __builtin_amdgcn_sinf(rev);
  cs = __builtin_amdgcn_cosf(rev);
}
DI float rope_apply(int j, float v, float vp, int lpos) {
  int posv = (j & 16) ? (lpos & 63) : (lpos >> 6);
  float cs, sn;
  rope_cs(j & 7, posv, cs, sn);
  return (j & 8) ? (vp * sn + v * cs) : (v * cs - vp * sn);
}

DI void s5_disc(const Params& p, int dir, int g, int pp, double& dt, double& ar, double& ai, float& fr, float& fi) {
  dt = exp((double)p.in[I_LOGSTEP][dir * 64 + g]);
  ar = (double)p.in[I_ARE][(dir * 64 + g) * 64 + pp];
  ai = (double)p.in[I_AIM][(dir * 64 + g) * 64 + pp];
  double mag = exp(ar * dt);
  double a = ai * dt;
  a -= 6.283185307179586 * rint(a * 0.15915494309189535);
  float sn, cs;
  sincosf((float)a, &sn, &cs);
  double lr = mag * (double)cs, li = mag * (double)sn;
  double den = ar * ar + ai * ai, nr = lr - 1.0;
  fr = (float)((nr * ar + li * ai) / den);
  fi = (float)((li * ar - nr * ai) / den);
}
DI void s5_pow(double dt, double ar, double ai, int k, float& wr, float& wi) {
  double mag = exp(ar * dt * (double)k);
  double a = ai * dt * (double)k;
  a -= 6.283185307179586 * rint(a * 0.15915494309189535);
  float sn, cs;
  sincosf((float)a, &sn, &cs);
  wr = (float)mag * cs;
  wi = (float)mag * sn;
}

enum { PH_PREP = 0, PH_N1, PH_N2, PH_N3, PH_N4, PH_N4B, PH_N5, PH_N6A, PH_N6B, PH_N9, PH_N10, PH_N10B, PH_FINAL,
       PH_O1, PH_O2, PH_O3, PH_O4, PH_O5, PH_O6, PH_O7, PH_O8, PH_O9, PH_O10, PH_H0, PH_H1, PH_COUNT };

constexpr int SMEM_BYTES = 48 * 1024;


DI void prep_transpose(const Params& p, int widx, int tile, char* smem) {
  const int tidx_ = opaque_tid();
  int K, N;
  size_t dst;
  const float* W;
  const float* scl = nullptr;
  switch (widx) {
    case 0: W = p.in[I_WIN0]; K = 1024; N = NIN0; dst = O_WT_IN0; break;
    case 1: W = p.in[I_WUQ]; K = 256; N = 1536; dst = O_WT_UQ; scl = p.in[I_QNORM]; break;
    case 2: W = p.in[I_WUKV]; K = 128; N = 2048; dst = O_WT_UKV; scl = p.in[I_KVNORM]; break;
    case 3: W = p.in[I_WOUT0]; K = 1024; N = 1024; dst = O_WT_OUT0; break;
    case 4: W = p.in[I_WIN1]; K = 1024; N = NIN1; dst = O_WT_IN1; break;
    case 5: W = p.in[I_WGLU]; K = 1024; N = 1024; dst = O_WT_GLU; break;
    default: W = p.in[I_WOUT1]; K = 1024; N = 1024; dst = O_WT_OUT1; break;
  }
  float (*t)[33] = (float (*)[33])smem;
  int ntn = N / 32;
  int kt = tile / ntn, nt = tile - kt * ntn;
  int tx = tidx_ & 31, ty = tidx_ >> 5;
  float v[16];
#pragma unroll
  for (int i = 0; i < 16; ++i) {
    int k = kt * 128 + ty + 8 * i, n = nt * 32 + tx;
    v[i] = W[(size_t)k * N + n];
  }
  if (scl) {
#pragma unroll
    for (int i = 0; i < 16; ++i) v[i] *= scl[kt * 128 + ty + 8 * i];
  }
#pragma unroll
  for (int i = 0; i < 16; ++i) t[ty + 8 * i][tx] = v[i];
  __syncthreads();
  bfr* Wt = (bfr*)(p.ws + dst);
  {
    int nl = tidx_ >> 3, kc = (tidx_ & 7) * 16;
    unsigned w[8];
#pragma unroll
    for (int j = 0; j < 8; ++j) w[j] = pk2(t[kc + 2 * j][nl], t[kc + 2 * j + 1][nl]);
    uint4* dstp = (uint4*)(Wt + (size_t)(nt * 32 + nl) * K + kt * 128 + kc);
    dstp[0] = make_uint4(w[0], w[1], w[2], w[3]);
    dstp[1] = make_uint4(w[4], w[5], w[6], w[7]);
  }
  __syncthreads();
}

DI void prep_mod(const Params& p, int unit, char* smem) {
  const int tidx_ = opaque_tid();
  int layer = unit / 192, cgp = unit - layer * 192;
  float* sil = (float*)smem;
  float* red = sil + 9 * 1024;
  for (int i = tidx_; i < 9 * 1024; i += 256) {
    int r = i >> 10, k = i & 1023;
    float v = r < 8 ? p.in[I_C][r * 1024 + k] : p.in[I_CCTX][k];
    sil[i] = silu_f(v);
  }
  __syncthreads();
  int nn = tidx_ & 15, kg = tidx_ >> 4;
  int n = cgp * 16 + nn;
  const float* W = p.in[I_ADAW] + (size_t)layer * 1024 * 3072 + n;
  float acc[9];
#pragma unroll
  for (int r = 0; r < 9; ++r) acc[r] = 0.f;
#pragma unroll 8
  for (int k = kg * 64; k < kg * 64 + 64; ++k) {
    float w = W[(size_t)k * 3072];
#pragma unroll
    for (int r = 0; r < 9; ++r) acc[r] += sil[r * 1024 + k] * w;
  }
#pragma unroll
  for (int r = 0; r < 9; ++r) red[(kg * 9 + r) * 16 + nn] = acc[r];
  __syncthreads();
  if (tidx_ < 144) {
    int r = tidx_ >> 4, c = tidx_ & 15;
    int nc = cgp * 16 + c;
    float s = p.in[I_ADAB][layer * 3072 + nc];
#pragma unroll
    for (int g = 0; g < 16; ++g) s += red[(g * 9 + r) * 16 + c];
    ((float*)(p.ws + O_MOD))[((size_t)(layer * 9 + r)) * 3072 + nc] = s;
  }
  __syncthreads();
}

DI void prep_ktab(const Params& p, int unit, char* smem) {
  const int tidx_ = opaque_tid();
  int g = unit / 7, lg = unit - g * 7;
  float2* E = (float2*)smem;
  int tid = tidx_;
  const bool use_f = lg >= 3, use_r = lg <= 3;
  for (int i = tid; i < 9 * 128; i += 256) {
    int l = i >> 7, dir = (i >> 6) & 1, pp = i & 63;
    int lag = lg * 9 + l - 31;
    bool used = (dir == 0) ? (lag >= 0) : (lag <= 0);
    float2 e = make_float2(0.f, 0.f);
    if (used) {
      double dt, ar, ai;
      float fr, fi, wr, wi;
      s5_disc(p, dir, g, pp, dt, ar, ai, fr, fi);
      s5_pow(dt, ar, ai, lag < 0 ? -lag : lag, wr, wi);
      e.x = wr * fr - wi * fi;
      e.y = wr * fi + wi * fr;
    }
    E[(l * 2 + dir) * 64 + pp] = e;
  }
  __syncthreads();
  int c = tid >> 4, c2 = tid & 15;
  float acc[9];
#pragma unroll
  for (int l = 0; l < 9; ++l) acc[l] = 0.f;
  for (int dir = 0; dir < 2; ++dir) {
    if (dir == 0 ? !use_f : !use_r) continue;
    const float* bre = p.in[I_BRE] + ((size_t)(dir * 64 + g)) * 64 * 16;
    const float* bim = p.in[I_BIM] + ((size_t)(dir * 64 + g)) * 64 * 16;
    const float* cre = p.in[I_CRE] + ((size_t)(dir * 64 + g)) * 16 * 64;
    const float* cim = p.in[I_CIM] + ((size_t)(dir * 64 + g)) * 16 * 64;
#pragma unroll 4
    for (int pp = 0; pp < 64; ++pp) {
      float br = bre[pp * 16 + c2], bi = bim[pp * 16 + c2];
      float cr = cre[c * 64 + pp], ci = cim[c * 64 + pp];
      float mr = cr * br - ci * bi, mi = cr * bi + ci * br;
#pragma unroll
      for (int l = 0; l < 9; ++l) {
        float2 e = E[(l * 2 + dir) * 64 + pp];
        acc[l] += mr * e.x - mi * e.y;
      }
    }
  }
  bfr* KT = (bfr*)(p.ws + O_KTAB);
#pragma unroll
  for (int l = 0; l < 9; ++l) KT[(((size_t)g * 63 + lg * 9 + l) * 16 + c) * 16 + c2] = f2bf(acc[l]);
  __syncthreads();
}

DI void prep_ops(const Params& p, int unit) {
  const int tidx_ = opaque_tid();
  int idx = unit * 256 + tidx_;
  int pp = idx & 63, t = (idx >> 6) & 31, dir = (idx >> 11) & 1, g = idx >> 12;
  double dt, ar, ai;
  float fr, fi, wr, wi;
  s5_disc(p, dir, g, pp, dt, ar, ai, fr, fi);
  s5_pow(dt, ar, ai, dir == 0 ? (TC - 1 - t) : t, wr, wi);
  float er = wr * fr - wi * fi, ei = wr * fi + wi * fr;
  const float* bre = p.in[I_BRE] + (((size_t)(dir * 64 + g)) * 64 + pp) * 16;
  const float* bim = p.in[I_BIM] + (((size_t)(dir * 64 + g)) * 64 + pp) * 16;
  bfr* wst = (bfr*)(p.ws + O_WST) + (size_t)g * 256 * 512;
  bfr* rre = wst + (size_t)(dir * 128 + pp) * 512 + t * 16;
  bfr* rim = wst + (size_t)(dir * 128 + 64 + pp) * 512 + t * 16;
#pragma unroll
  for (int c2 = 0; c2 < 16; ++c2) {
    float br = bre[c2], bi = bim[c2];
    rre[c2] = f2bf(er * br - ei * bi);
    rim[c2] = f2bf(er * bi + ei * br);
  }
  s5_pow(dt, ar, ai, dir == 0 ? (t + 1) : (TC - t), wr, wi);
  const float* cre = p.in[I_CRE] + ((size_t)(dir * 64 + g)) * 16 * 64;
  const float* cim = p.in[I_CIM] + ((size_t)(dir * 64 + g)) * 16 * 64;
  bfr* vop = (bfr*)(p.ws + O_VOP) + (size_t)g * 512 * 256;
#pragma unroll
  for (int c = 0; c < 16; ++c) {
    float cr = cre[c * 64 + pp], ci = cim[c * 64 + pp];
    float dr = cr * wr - ci * wi, di = cr * wi + ci * wr;
    vop[(size_t)(t * 16 + c) * 256 + dir * 128 + pp] = f2bf(dr);
    vop[(size_t)(t * 16 + c) * 256 + dir * 128 + 64 + pp] = f2bf(-di);
  }
}

constexpr int TR_T0 = 8 * 45, TR_T1 = 2 * 48, TR_T2 = 1 * 64, TR_T3 = 256, TR_T4 = 8 * 64, TR_T5 = 256, TR_T6 = 256;
constexpr int TR_TOTAL = TR_T0 + TR_T1 + TR_T2 + TR_T3 + TR_T4 + TR_T5 + TR_T6;
constexpr int U_MOD = 384, U_RS0 = 0, U_KTAB = 64 * 7, U_OPS = 64 * 2 * 64 * 32 / 256;
constexpr int PREP_UNITS = TR_TOTAL + U_MOD + U_RS0 + U_KTAB + U_OPS;

DI void phase_prep(const Params& p, char* smem) {
  for (int u = blockIdx.x; u < PREP_UNITS; u += gridDim.x) {
    int v = u;
    if (v < U_MOD) { prep_mod(p, v, smem); continue; }
    v -= U_MOD;
    if (v < TR_TOTAL) {
      int w = 0;
      if (v >= TR_T0) { v -= TR_T0; w = 1;
        if (v >= TR_T1) { v -= TR_T1; w = 2;
          if (v >= TR_T2) { v -= TR_T2; w = 3;
            if (v >= TR_T3) { v -= TR_T3; w = 4;
              if (v >= TR_T4) { v -= TR_T4; w = 5;
                if (v >= TR_T5) { v -= TR_T5; w = 6; } } } } } }
      prep_transpose(p, w, v, smem);
      continue;
    }
    v -= TR_TOTAL;
    v -= U_RS0;
    if (v < U_KTAB) { prep_ktab(p, v, smem); continue; }
    v -= U_KTAB;
    prep_ops(p, v);
  }
}

DI float rs_from_part(const float* part, int nrows, int r) {
  float s = 0.f;
#pragma unroll
  for (int j = 0; j < 16; ++j) s += part[(size_t)j * nrows + r];
  return rsqrtf(s * (1.f / 1024.f) + EPS);
}

DI void phase_final(const Params& p) {
  const int tidx_ = opaque_tid();
  const float* part = (const float*)(p.ws + O_PART2);
  const float4* g4 = (const float4*)p.in[I_FINALG];
  int lane = tidx_ & 63;
  float4 g[4];
#pragma unroll
  for (int i = 0; i < 4; ++i) g[i] = g4[lane + 64 * i];
  for (int r = (blockIdx.x * 4 + (tidx_ >> 6)) * 2; r < NLAT; r += gridDim.x * 8) {
    float4* row0 = (float4*)(p.out + (size_t)r * D);
    float4* row1 = row0 + D / 4;
    float4 v0[4], v1[4];
#pragma unroll
    for (int i = 0; i < 4; ++i) {
      v0[i] = row0[lane + 64 * i];
      v1[i] = row1[lane + 64 * i];
    }
    float ps = part[(size_t)(lane & 15) * NLAT + r + ((lane >> 4) & 1)];
    ps += __shfl_xor(ps, 1);
    ps += __shfl_xor(ps, 2);
    ps += __shfl_xor(ps, 4);
    ps += __shfl_xor(ps, 8);
    const float rs0 = rsqrtf(__shfl(ps, 0) * (1.f / 1024.f) + EPS);
    const float rs1 = rsqrtf(__shfl(ps, 16) * (1.f / 1024.f) + EPS);
#pragma unroll
    for (int i = 0; i < 4; ++i) {
      float4 a = v0[i], c = v1[i];
      a.x *= rs0 * g[i].x; a.y *= rs0 * g[i].y; a.z *= rs0 * g[i].z; a.w *= rs0 * g[i].w;
      c.x *= rs1 * g[i].x; c.y *= rs1 * g[i].y; c.z *= rs1 * g[i].z; c.w *= rs1 * g[i].w;
      row0[lane + 64 * i] = a;
      row1[lane + 64 * i] = c;
    }
  }
}

typedef short bf16x8 __attribute__((ext_vector_type(8)));
typedef short s16x4 __attribute__((ext_vector_type(4)));
typedef float f32x16 __attribute__((ext_vector_type(16)));
#define SCHED_FENCE() __builtin_amdgcn_sched_barrier(0)
#define MFMA32(a, b, c) __builtin_amdgcn_mfma_f32_32x32x16_bf16((a), (b), (c), 0, 0, 0)
DI int xcd_swz(int u, int per) {
  int x = u & 7, q = u >> 3;
  int qq = q / per;
  return (x + 8 * qq) * per + (q - qq * per);
}
DI int crow(int i, int h) { return (i & 3) + 8 * (i >> 2) + 4 * h; }

constexpr int LDT = 40;
struct GemmSmem {
  bfr A[2][128 * LDT];
  bfr B[2][128 * LDT];
  float rs[128];
};
static_assert(sizeof(GemmSmem) <= SMEM_BYTES, "smem");

DI void zero_acc(f32x16 (&acc)[2][2]) {
#pragma unroll
  for (int a = 0; a < 2; ++a)
#pragma unroll
    for (int b = 0; b < 2; ++b)
#pragma unroll
      for (int i = 0; i < 16; ++i) acc[a][b][i] = 0.f;
}

#define GSTAGE_DECL uint4 ga0, ga1, gb0, gb1, gc0, gc1, gd0, gd1
#define GSTAGE_ARGS ga0, ga1, gb0, gb1, gc0, gc1, gd0, gd1
#define GSTAGE_PARAMS uint4 &a0, uint4 &a1, uint4 &b0, uint4 &b1, uint4 &c0, uint4 &c1, uint4 &d0, uint4 &d1
template <class AAddr, class BAddr>
DI void gemm_prefetch(GSTAGE_PARAMS, AAddr aaddr, BAddr baddr) {
  const int tid = opaque_tid();
  const int lrow = tid >> 2, lkc = (tid & 3) * 8;
  b0 = *(const uint4*)baddr(lrow, lkc);
  b1 = *(const uint4*)baddr(lrow + 64, lkc);
  a0 = *(const uint4*)aaddr(lrow, lkc);
  a1 = *(const uint4*)aaddr(lrow + 64, lkc);
  d0 = *(const uint4*)baddr(lrow, 32 + lkc);
  d1 = *(const uint4*)baddr(lrow + 64, 32 + lkc);
  c0 = *(const uint4*)aaddr(lrow, 32 + lkc);
  c1 = *(const uint4*)aaddr(lrow + 64, 32 + lkc);
  SCHED_FENCE();
}
template <class AAddr, class BAddr>
DI void gemm_main(f32x16 (&acc)[2][2], int KT, AAddr aaddr, BAddr baddr, GemmSmem* sm, GSTAGE_PARAMS) {
  const int tid = opaque_tid(), lane = tid & 63, wave = tid >> 6;
  const int wm = wave >> 1, wn = wave & 1, r = lane & 31, h = lane >> 5;
  const int lrow = tid >> 2, lkc = (tid & 3) * 8;
#define GM_LOAD(KT_, A0, A1, B0, B1)                   \
  {                                                    \
    const int kk_ = (KT_) * 32 + lkc;                  \
    B0 = *(const uint4*)baddr(lrow, kk_);              \
    B1 = *(const uint4*)baddr(lrow + 64, kk_);         \
    A0 = *(const uint4*)aaddr(lrow, kk_);              \
    A1 = *(const uint4*)aaddr(lrow + 64, kk_);         \
  }
#define GM_STORE(BUF_, A0, A1, B0, B1)                                  \
  {                                                                     \
    *(uint4*)(sm->B[BUF_] + lrow * LDT + lkc) = B0;                     \
    *(uint4*)(sm->B[BUF_] + (lrow + 64) * LDT + lkc) = B1;              \
    *(uint4*)(sm->A[BUF_] + lrow * LDT + lkc) = A0;                     \
    *(uint4*)(sm->A[BUF_] + (lrow + 64) * LDT + lkc) = A1;              \
  }
#define GM_COMPUTE(BUF_)                                                                                       \
  _Pragma("unroll") for (int ks = 0; ks < 2; ++ks) {                                                           \
    bf16x8 a_[2], b_[2];                                                                                       \
    _Pragma("unroll") for (int mi = 0; mi < 2; ++mi)                                                           \
        a_[mi] = *(const bf16x8*)(sm->A[BUF_] + (wm * 64 + mi * 32 + r) * LDT + ks * 16 + h * 8);              \
    _Pragma("unroll") for (int ni = 0; ni < 2; ++ni)                                                           \
        b_[ni] = *(const bf16x8*)(sm->B[BUF_] + (wn * 64 + ni * 32 + r) * LDT + ks * 16 + h * 8);              \
    _Pragma("unroll") for (int mi = 0; mi < 2; ++mi)                                                           \
        _Pragma("unroll") for (int ni = 0; ni < 2; ++ni) acc[mi][ni] = MFMA32(a_[mi], b_[ni], acc[mi][ni]);    \
  }
  GM_STORE(0, a0, a1, b0, b1)
  if (KT > 2) GM_LOAD(2, a0, a1, b0, b1)
  SCHED_FENCE();
  __syncthreads();
  for (int kt = 0; kt < KT; kt += 2) {
    GM_STORE(1, c0, c1, d0, d1)
    if (kt + 3 < KT) GM_LOAD(kt + 3, c0, c1, d0, d1)
    SCHED_FENCE();
    GM_COMPUTE(0)
    __syncthreads();
    if (kt + 2 < KT) GM_STORE(0, a0, a1, b0, b1)
    if (kt + 4 < KT) GM_LOAD(kt + 4, a0, a1, b0, b1)
    SCHED_FENCE();
    GM_COMPUTE(1)
    __syncthreads();
  }
}

template <class AAddr, class BAddr>
DI void gemm_full(f32x16 (&acc)[2][2], int KT, AAddr aaddr, BAddr baddr, GemmSmem* sm) {
  GSTAGE_DECL;
  gemm_prefetch(GSTAGE_ARGS, aaddr, baddr);
  gemm_main(acc, KT, aaddr, baddr, sm, GSTAGE_ARGS);
}

DI float transpose_reduce16(float (&v)[16], int lane) {
  float r8[8], r4[4], r2[2];
  {
    bool up = lane & 8;
#pragma unroll
    for (int i = 0; i < 8; ++i) {
      float send = up ? v[i] : v[i + 8];
      float keep = up ? v[i + 8] : v[i];
      r8[i] = keep + __shfl_xor(send, 8);
    }
  }
  {
    bool up = lane & 4;
#pragma unroll
    for (int i = 0; i < 4; ++i) {
      float send = up ? r8[i] : r8[i + 4];
      float keep = up ? r8[i + 4] : r8[i];
      r4[i] = keep + __shfl_xor(send, 4);
    }
  }
  {
    bool up = lane & 2;
#pragma unroll
    for (int i = 0; i < 2; ++i) {
      float send = up ? r4[i] : r4[i + 2];
      float keep = up ? r4[i + 2] : r4[i];
      r2[i] = keep + __shfl_xor(send, 2);
    }
  }
  bool up = lane & 1;
  float send = up ? r2[0] : r2[1];
  float keep = up ? r2[1] : r2[0];
  return keep + __shfl_xor(send, 1);
}

DI void stage_half(const f32x16 (&acc)[2][2], int mi, float* wl, float4 (&v)[8], int lane) {
  const int r = lane & 31, h = lane >> 5;
#pragma unroll
  for (int ni = 0; ni < 2; ++ni)
#pragma unroll
    for (int i = 0; i < 16; ++i) wl[crow(i, h) * 64 + ni * 32 + r] = acc[mi][ni][i];
  asm volatile("s_waitcnt lgkmcnt(0)" ::: "memory");
#pragma unroll
  for (int c = 0; c < 8; ++c) v[c] = *(const float4*)(wl + (c * 4 + (lane >> 4)) * 64 + (lane & 15) * 4);
  asm volatile("s_waitcnt lgkmcnt(0)" ::: "memory");
}
DI float4 bf4_to_f4(uint2 u) {
  return make_float4(__uint_as_float(u.x << 16), __uint_as_float(u.x & 0xffff0000u), __uint_as_float(u.y << 16),
                     __uint_as_float(u.y & 0xffff0000u));
}
DI uint2 f4_to_bf4(float4 f) { return make_uint2(pk2(f.x, f.y), pk2(f.z, f.w)); }

#define WAVE_IDS                                              \
  const int tid = opaque_tid(), lane = tid & 63, wave = tid >> 6; \
  const int wm = wave >> 1, wn = wave & 1, r = lane & 31, h = lane >> 5; \
  (void)wm; (void)wn; (void)r; (void)h;

template <int LAYER>
DI void phase_hconv(const Params& p) {
  const int tid = opaque_tid(), lane = tid & 63;
  bfr* H = (bfr*)(p.ws + (LAYER == 0 ? O_H0 : O_H1));
  const float4* ng4 = (const float4*)(p.in[I_NORMG] + LAYER * 1024);
  for (int tok = (blockIdx.x * 4 + (tid >> 6)) * 2; tok < TOK; tok += gridDim.x * 8) {
    const float4* xr0 = (const float4*)(LAYER == 0 ? xrow0(p, tok) : (const float*)xrow1(p, tok));
    const float4* xr1 = xr0 + 256;
    const float4* md4 = (const float4*)modrow(p, LAYER, tok);
    float4 x0[4], x1[4], gm[4], sh[4];
#pragma unroll
    for (int i = 0; i < 4; ++i) {
      x0[i] = xr0[lane + 64 * i];
      x1[i] = xr1[lane + 64 * i];
      float4 gv = ng4[lane + 64 * i];
      float4 sc = md4[256 + lane + 64 * i];
      sh[i] = md4[lane + 64 * i];
      gm[i] = make_float4(gv.x * (1.f + sc.x), gv.y * (1.f + sc.y), gv.z * (1.f + sc.z), gv.w * (1.f + sc.w));
    }
    float s0 = 0.f, s1 = 0.f;
#pragma unroll
    for (int i = 0; i < 4; ++i) {
      s0 += x0[i].x * x0[i].x + x0[i].y * x0[i].y + x0[i].z * x0[i].z + x0[i].w * x0[i].w;
      s1 += x1[i].x * x1[i].x + x1[i].y * x1[i].y + x1[i].z * x1[i].z + x1[i].w * x1[i].w;
    }
    s0 = wave_sum(s0);
    s1 = wave_sum(s1);
    const float r0 = rsqrtf(s0 * (1.f / 1024.f) + EPS), r1 = rsqrtf(s1 * (1.f / 1024.f) + EPS);
#pragma unroll
    for (int i = 0; i < 4; ++i) {
      uint2 o0, o1;
      o0.x = pk2(x0[i].x * r0 * gm[i].x + sh[i].x, x0[i].y * r0 * gm[i].y + sh[i].y);
      o0.y = pk2(x0[i].z * r0 * gm[i].z + sh[i].z, x0[i].w * r0 * gm[i].w + sh[i].w);
      o1.x = pk2(x1[i].x * r1 * gm[i].x + sh[i].x, x1[i].y * r1 * gm[i].y + sh[i].y);
      o1.y = pk2(x1[i].z * r1 * gm[i].z + sh[i].z, x1[i].w * r1 * gm[i].w + sh[i].w);
      *(uint2*)(H + (size_t)tok * 1024 + (lane + 64 * i) * 4) = o0;
      *(uint2*)(H + (size_t)(tok + 1) * 1024 + (lane + 64 * i) * 4) = o1;
    }
  }
}

DI void phase_o1(const Params& p, char* smem) {
  GemmSmem* sm = (GemmSmem*)smem;
  WAVE_IDS
  const int NT = 12, units = (TOK / 128) * NT;
  const bfr* WT = (const bfr*)(p.ws + O_WT_IN0);
  bfr* PC = (bfr*)(p.ws + O_PC);
  bfr* SZ0 = (bfr*)(p.ws + O_SZ0);
  bfr* KRb = (bfr*)(p.ws + O_KR);
  const bfr* Ah = (const bfr*)(p.ws + O_H0);
  auto Aof = [&](int m0) { return [=](int row, int k) { return Ah + (size_t)(m0 + row) * 1024 + k; }; };
  auto Bof = [&](int n0) {
    return [=](int row, int k) {
      int n = n0 + row;
      n = n < NIN0 ? n : NIN0 - 1;
      return WT + (size_t)n * 1024 + k;
    };
  };
  GSTAGE_DECL;
  if ((int)blockIdx.x < units) {
    const int us = xcd_swz(blockIdx.x, NT);
    gemm_prefetch(GSTAGE_ARGS, Aof((us / NT) * 128), Bof((us % NT) * 128));
  }
  for (int u = blockIdx.x; u < units; u += gridDim.x) {
    const int us = xcd_swz(u, NT);
    int mt = us / NT, nt = us - mt * NT;
    int m0 = mt * 128, n0 = nt * 128;
    f32x16 acc[2][2];
    zero_acc(acc);
    gemm_main(acc, 32, Aof(m0), Bof(n0), sm, GSTAGE_ARGS);
    if (u + (int)gridDim.x < units) {
      const int us1 = xcd_swz(u + gridDim.x, NT);
      gemm_prefetch(GSTAGE_ARGS, Aof((us1 / NT) * 128), Bof((us1 % NT) * 128));
    }
    int b = m0 / LALL, pos0 = m0 - b * LALL;
    bool lat = pos0 >= LC;
#pragma unroll
    for (int mi = 0; mi < 2; ++mi)
#pragma unroll
      for (int ni = 0; ni < 2; ++ni) {
        int col0 = n0 + wn * 64 + ni * 32;
        if (col0 >= NIN0) continue;
        int col = col0 + r;
#pragma unroll
        for (int i = 0; i < 16; ++i) {
          int row = wm * 64 + mi * 32 + crow(i, h);
          int tok = m0 + row;
          float v = acc[mi][ni][i];
          if (col0 < 384) {
            PC[(size_t)tok * 384 + col] = f2bf(v);
          } else if (col0 == 384) {
            float vp = __shfl_xor(v, 8);
            int pos = pos0 + row;
            float val = lat ? rope_apply(r, v, vp, pos - LC) : v;
            KRb[(size_t)tok * 32 + r] = f2bf(val);
          } else {
            SZ0[(size_t)tok * 1024 + (col - 416)] = f2bf(silu_f(v));
          }
          SCHED_FENCE();
        }
      }
  }
}

DI void phase_o2(const Params& p, char* smem) {
  GemmSmem* sm = (GemmSmem*)smem;
  WAVE_IDS
  const int UQ = (TOK / 128) * 12, UKV = (TOK / 128) * 16;
  const bfr* PC = (const bfr*)(p.ws + O_PC);
  bfr* Q = (bfr*)p.out;
  bfr* Kb = (bfr*)(p.ws + O_K);
  bfr* VT = (bfr*)(p.ws + O_VT);
  const int total = UQ + UKV;
  const int per_blk = (total + gridDim.x - 1) / gridDim.x;
  const int u_beg = blockIdx.x * per_blk;
  const int u_end = u_beg + per_blk < total ? u_beg + per_blk : total;
  int prev_key = -1;
  for (int us = u_beg; us < u_end; ++us) {
    int mt = us / 28, rem = us - mt * 28;
    bool isq = rem < 12;
    int nt = isq ? rem : rem - 12;
    int m0 = mt * 128, n0 = nt * 128;
    int Kd = isq ? 256 : 128;
    int aoff = isq ? 0 : 256;
    const bfr* WT = (const bfr*)(p.ws + (isq ? O_WT_UQ : O_WT_UKV));
    const int key = mt * 2 + (isq ? 0 : 1);
    if (key != prev_key) {
      prev_key = key;
      __syncthreads();
      int row = tid >> 1, half = tid & 1;
      const bfr* ap = PC + (size_t)(m0 + row) * 384 + aoff + half * (Kd / 2);
      float ss = 0.f;
      for (int j = 0; j < Kd / 16; ++j) {
        uint4 v = *(const uint4*)(ap + j * 8);
        unsigned w[4] = {v.x, v.y, v.z, v.w};
#pragma unroll
        for (int e = 0; e < 4; ++e) {
          float lo = __uint_as_float(w[e] << 16), hi = __uint_as_float(w[e] & 0xffff0000u);
          ss += lo * lo + hi * hi;
        }
      }
      ss += __shfl_xor(ss, 1);
      if (half == 0) sm->rs[row] = rsqrtf(ss / (float)Kd + EPS);
      __syncthreads();
    }
    f32x16 acc[2][2];
    zero_acc(acc);
    gemm_full(
        acc, Kd / 32, [&](int row, int k) { return PC + (size_t)(m0 + row) * 384 + aoff + k; },
        [&](int row, int k) { return WT + (size_t)(n0 + row) * Kd + k; }, sm);
    int b = m0 / LALL, pos0 = m0 - b * LALL;
    bool lat = pos0 >= LC;
#pragma unroll
    for (int mi = 0; mi < 2; ++mi)
#pragma unroll
      for (int ni = 0; ni < 2; ++ni) {
        int col0 = n0 + wn * 64 + ni * 32;
        if (isq) {
          int hh = col0 / 96, d0 = col0 - hh * 96;
          bool rope = lat && d0 == 64;
#pragma unroll
          for (int i = 0; i < 16; ++i) {
            int row = wm * 64 + mi * 32 + crow(i, h);
            int pos = pos0 + row;
            float v = acc[mi][ni][i] * sm->rs[row];
            float vp = __shfl_xor(v, 8);
            float val = rope ? rope_apply(r, v, vp, pos - LC) : v;
            Q[(((size_t)(b * NH + hh)) * LALL + pos) * DQK + d0 + r] = f2bf(val * QSCALE);
            SCHED_FENCE();
          }
        } else {
          int hh = col0 >> 7, d0 = col0 & 127;
          if (d0 < 64) {
#pragma unroll
            for (int i = 0; i < 16; ++i) {
              int row = wm * 64 + mi * 32 + crow(i, h);
              int pos = pos0 + row;
              float v = acc[mi][ni][i] * sm->rs[row];
              Kb[(((size_t)(b * NH + hh)) * LALL + pos) * 64 + d0 + r] = f2bf(v);
              SCHED_FENCE();
            }
          } else {
            int dvv = d0 - 64 + r;
#pragma unroll
            for (int g4 = 0; g4 < 4; ++g4) {
              int row = wm * 64 + mi * 32 + 8 * g4 + 4 * h;
              int pos = pos0 + row;
              uint2 o;
              o.x = pk2(acc[mi][ni][4 * g4 + 0] * sm->rs[row + 0], acc[mi][ni][4 * g4 + 1] * sm->rs[row + 1]);
              o.y = pk2(acc[mi][ni][4 * g4 + 2] * sm->rs[row + 2], acc[mi][ni][4 * g4 + 3] * sm->rs[row + 3]);
              *(uint2*)(VT + (((size_t)(b * NH + hh)) * DV + dvv) * LALL + pos) = o;
            }
          }
        }
      }
  }
}

constexpr int KLD = 104;
constexpr int VLD = 68;
struct AttnSmem {
  bfr K[64 * KLD];
  bfr V[64 * VLD];
};
static_assert(sizeof(AttnSmem) <= SMEM_BYTES, "smem");

DI void attn_item(const Params& p, AttnSmem* sm, int bh, int qpos0, int nkeys) {
  WAVE_IDS
  const bfr* Q = (const bfr*)p.out;
  const bfr* Kg = (const bfr*)(p.ws + O_K) + (size_t)bh * LALL * 64;
  const bfr* KRg = (const bfr*)(p.ws + O_KR) + (size_t)(bh / NH) * LALL * 32;
  const bfr* Vg = (const bfr*)(p.ws + O_VT) + (size_t)bh * DV * LALL;
  const int qpos = qpos0 + wave * 32 + r;
  bf16x8 bq[6];
  {
    const bfr* qp = Q + ((size_t)bh * LALL + qpos) * DQK + 8 * h;
#pragma unroll
    for (int s = 0; s < 6; ++s) bq[s] = *(const bf16x8*)(qp + 16 * s);
  }
  f32x16 o[2];
#pragma unroll
  for (int d = 0; d < 2; ++d)
#pragma unroll
    for (int i = 0; i < 16; ++i) o[d][i] = 0.f;
  float mrun = 0.f, lrun = 0.f;
  uint4 kv0, kv1, kv2, vv0, vv1;
  const int kr0 = tid / 12, kc0 = (tid - kr0 * 12) * 8;
  const int kr1 = (tid + 256) / 12, kc1 = (tid + 256 - kr1 * 12) * 8;
  const int kr2 = (tid + 512) / 12, kc2 = (tid + 512 - kr2 * 12) * 8;
  const int vr0 = tid >> 3, vc0 = (tid & 7) * 8;
  const bfr* kp0 = kc0 < 64 ? Kg + (size_t)kr0 * 64 + kc0 : KRg + (size_t)kr0 * 32 + (kc0 - 64);
  const bfr* kp1 = kc1 < 64 ? Kg + (size_t)kr1 * 64 + kc1 : KRg + (size_t)kr1 * 32 + (kc1 - 64);
  const bfr* kp2 = kc2 < 64 ? Kg + (size_t)kr2 * 64 + kc2 : KRg + (size_t)kr2 * 32 + (kc2 - 64);
  const int ks0 = kc0 < 64 ? 64 : 32, ks1 = kc1 < 64 ? 64 : 32, ks2 = kc2 < 64 ? 64 : 32;
#define AT_GLOAD(KEY0_)                                                          \
  {                                                                              \
    const int key0_ = (KEY0_);                                                   \
    kv0 = *(const uint4*)(kp0 + (size_t)key0_ * ks0);                            \
    kv1 = *(const uint4*)(kp1 + (size_t)key0_ * ks1);                            \
    kv2 = *(const uint4*)(kp2 + (size_t)key0_ * ks2);                            \
    vv0 = *(const uint4*)(Vg + (size_t)vr0 * LALL + key0_ + vc0);                \
    vv1 = *(const uint4*)(Vg + (size_t)(vr0 + 32) * LALL + key0_ + vc0);         \
  }
#define AT_LSTORE()                                                              \
  {                                                                              \
    *(uint4*)(sm->K + kr0 * KLD + kc0) = kv0;                                    \
    *(uint4*)(sm->K + kr1 * KLD + kc1) = kv1;                                    \
    *(uint4*)(sm->K + kr2 * KLD + kc2) = kv2;                                    \
    uint2* d0_ = (uint2*)(sm->V + vr0 * VLD + vc0);                              \
    d0_[0] = make_uint2(vv0.x, vv0.y);                                           \
    d0_[1] = make_uint2(vv0.z, vv0.w);                                           \
    uint2* d1_ = (uint2*)(sm->V + (vr0 + 32) * VLD + vc0);                       \
    d1_[0] = make_uint2(vv1.x, vv1.y);                                           \
    d1_[1] = make_uint2(vv1.z, vv1.w);                                           \
  }
  const int NTI = nkeys / 64;
  AT_GLOAD(0)
  for (int it = 0; it < NTI; ++it) {
    AT_LSTORE()
    __syncthreads();
    if (it + 1 < NTI) AT_GLOAD((it + 1) * 64)
    SCHED_FENCE();
    f32x16 st[2];
    const float ninit = -mrun;
#pragma unroll
    for (int kb = 0; kb < 2; ++kb)
#pragma unroll
      for (int i = 0; i < 16; ++i) st[kb][i] = ninit;
#pragma unroll
    for (int s = 0; s < 6; ++s) {
#pragma unroll
      for (int kb = 0; kb < 2; ++kb) {
        bf16x8 ka = *(const bf16x8*)(sm->K + (kb * 32 + r) * KLD + 16 * s + 8 * h);
        st[kb] = MFMA32(ka, bq[s], st[kb]);
      }
    }
    float mx = fmaxf(fmaxf(st[0][0], st[0][1]), st[1][0]);
#pragma unroll
    for (int i = 2; i < 16; i += 2) mx = fmaxf(fmaxf(mx, st[0][i]), st[0][i + 1]);
#pragma unroll
    for (int i = 1; i < 15; i += 2) mx = fmaxf(fmaxf(mx, st[1][i]), st[1][i + 1]);
    mx = fmaxf(mx, st[1][15]);
    mx = fmaxf(mx, __shfl_xor(mx, 32));
    const bool need = (it == 0) || (mx > 8.f);
    if (__any(need)) {
      const float delta = need ? mx : 0.f;
      const float alpha = __builtin_amdgcn_exp2f(-delta);
      mrun += delta;
      lrun *= alpha;
#pragma unroll
      for (int d = 0; d < 2; ++d)
#pragma unroll
        for (int i = 0; i < 16; ++i) o[d][i] *= alpha;
#pragma unroll
      for (int kb = 0; kb < 2; ++kb)
#pragma unroll
        for (int i = 0; i < 16; ++i) st[kb][i] -= delta;
    }
    float ps = 0.f;
#pragma unroll
    for (int kb = 0; kb < 2; ++kb)
#pragma unroll
      for (int i = 0; i < 16; ++i) {
        float e = __builtin_amdgcn_exp2f(st[kb][i]);
        st[kb][i] = e;
        ps += e;
      }
    lrun += ps;
#pragma unroll
    for (int kb = 0; kb < 2; ++kb)
#pragma unroll
      for (int s2 = 0; s2 < 2; ++s2) {
        unsigned pw[4];
#pragma unroll
        for (int j = 0; j < 4; ++j) pw[j] = pk2(st[kb][8 * s2 + 2 * j], st[kb][8 * s2 + 2 * j + 1]);
        bf16x8 pb;
        {
          uint4 t = make_uint4(pw[0], pw[1], pw[2], pw[3]);
          pb = __builtin_bit_cast(bf16x8, t);
        }
#pragma unroll
        for (int d = 0; d < 2; ++d) {
          const bfr* vp = sm->V + (d * 32 + r) * VLD + kb * 32 + 16 * s2 + 4 * h;
          uint2 lo = *(const uint2*)vp;
          uint2 hi = *(const uint2*)(vp + 8);
          uint4 t = make_uint4(lo.x, lo.y, hi.x, hi.y);
          bf16x8 va = __builtin_bit_cast(bf16x8, t);
          o[d] = MFMA32(va, pb, o[d]);
        }
      }
    __syncthreads();
  }
  float ltot = lrun + __shfl_xor(lrun, 32);
  float inv = 1.f / ltot;
  int b = bh / NH, hh = bh - b * NH;
  size_t tok = (size_t)b * LALL + qpos;
  const bfr* SZ = (const bfr*)(p.ws + O_SZ0) + tok * 1024 + hh * 64;
  bfr* OG = (bfr*)(p.ws + O_OG) + tok * 1024 + hh * 64;
#pragma unroll
  for (int d = 0; d < 2; ++d)
#pragma unroll
    for (int g4 = 0; g4 < 4; ++g4) {
      int dv0 = d * 32 + 8 * g4 + 4 * h;
      uint2 z = *(const uint2*)(SZ + dv0);
      float z0 = __uint_as_float(z.x << 16), z1 = __uint_as_float(z.x & 0xffff0000u);
      float z2 = __uint_as_float(z.y << 16), z3 = __uint_as_float(z.y & 0xffff0000u);
      uint2 ov;
      ov.x = pk2(o[d][4 * g4 + 0] * inv * z0, o[d][4 * g4 + 1] * inv * z1);
      ov.y = pk2(o[d][4 * g4 + 2] * inv * z2, o[d][4 * g4 + 3] * inv * z3);
      *(uint2*)(OG + dv0) = ov;
    }
}

DI void phase_o3(const Params& p, char* smem) {
  AttnSmem* sm = (AttnSmem*)smem;
  const int xcd = blockIdx.x & 7, local = blockIdx.x >> 3, nloc = gridDim.x >> 3;
  for (int j = local; j < 256; j += nloc) {
    int u = xcd * 256 + j;
    attn_item(p, sm, u >> 4, LC + (u & 15) * 128, LALL);
  }
  for (int j = local; j < 32; j += nloc) {
    int u = xcd * 32 + j;
    attn_item(p, sm, u >> 1, (u & 1) * 128, LC);
  }
}

template <int LAYER>
DI void phase_oproj(const Params& p, char* smem) {
  GemmSmem* sm = (GemmSmem*)smem;
  WAVE_IDS
  constexpr int NROWS = LAYER == 0 ? TOK : NLAT;
  const int NT = 8, units = (NROWS / 128) * NT;
  const bfr* Ab = (const bfr*)(p.ws + (LAYER == 0 ? O_OG : O_Y2));
  const bfr* WT = (const bfr*)(p.ws + (LAYER == 0 ? O_WT_OUT0 : O_WT_OUT1));
  float* part = (float*)(p.ws + (LAYER == 0 ? O_PART1 : O_PART2));
  auto Aof = [&](int m0) { return [=](int row, int k) { return Ab + (size_t)(m0 + row) * 1024 + k; }; };
  auto Bof = [&](int n0) { return [=](int row, int k) { return WT + (size_t)(n0 + row) * 1024 + k; }; };
  GSTAGE_DECL;
  if ((int)blockIdx.x < units) {
    const int us = xcd_swz(blockIdx.x, NT);
    gemm_prefetch(GSTAGE_ARGS, Aof((us / NT) * 128), Bof((us % NT) * 128));
  }
  for (int u = blockIdx.x; u < units; u += gridDim.x) {
    const int us = xcd_swz(u, NT);
    int mt = us / NT, nt = us - mt * NT;
    int m0 = mt * 128, n0 = nt * 128;
    f32x16 acc[2][2];
    zero_acc(acc);
    gemm_main(acc, 32, Aof(m0), Bof(n0), sm, GSTAGE_ARGS);
    if (u + (int)gridDim.x < units) {
      const int us1 = xcd_swz(u + gridDim.x, NT);
      gemm_prefetch(GSTAGE_ARGS, Aof((us1 / NT) * 128), Bof((us1 % NT) * 128));
    }
    const float* xin;
    float* xout;
    const float* gt;
    if (LAYER == 0) {
      xin = xrow0(p, m0);
      xout = xrow1(p, m0);
      gt = modrow(p, 0, m0) + 2048;
    } else {
      xin = p.out + (size_t)m0 * 1024;
      xout = p.out + (size_t)m0 * 1024;
      gt = (const float*)(p.ws + O_MOD) + ((size_t)(9 + (m0 >> 11))) * 3072 + 2048;
    }
    float tot = 0.f;
#pragma unroll
    for (int mi = 0; mi < 2; ++mi) {
      float sq[16];
#pragma unroll
      for (int i = 0; i < 16; ++i) sq[i] = 0.f;
#pragma unroll
      for (int ni = 0; ni < 2; ++ni) {
        int col = n0 + wn * 64 + ni * 32 + r;
        float g = gt[col];
        float xv[16];
#pragma unroll
        for (int i = 0; i < 16; ++i) xv[i] = xin[(size_t)(wm * 64 + mi * 32 + crow(i, h)) * 1024 + col];
        SCHED_FENCE();
#pragma unroll
        for (int i = 0; i < 16; ++i) {
          int row = wm * 64 + mi * 32 + crow(i, h);
          float v = xv[i] + g * acc[mi][ni][i];
          xout[(size_t)row * 1024 + col] = v;
          sq[i] += v * v;
        }
        SCHED_FENCE();
      }
      if (LAYER == 1) {
        float t = transpose_reduce16(sq, lane);
        t += __shfl_xor(t, 16);
        if (((lane >> 4) & 1) == mi) tot = t;
      }
    }
    int idx = lane & 31;
    int row = m0 + wm * 64 + (idx >> 4) * 32 + crow(idx & 15, h);
    if (LAYER == 1) part[(size_t)(nt * 2 + wn) * NROWS + row] = tot;
  }
}

DI void phase_o5(const Params& p, char* smem) {
  GemmSmem* sm = (GemmSmem*)smem;
  WAVE_IDS
  const int ULAT = (NLAT / 128) * 16, units = ULAT + (NB * LC / 128) * 8;
  const bfr* WT = (const bfr*)(p.ws + O_WT_IN1);
  bfr* U2 = (bfr*)(p.ws + O_U2);
  bfr* SZ1 = (bfr*)(p.ws + O_SZ1);
  const bfr* Ah = (const bfr*)(p.ws + O_H1);
  auto coords = [&](int u, int& m0, int& n0) {
    if (u < ULAT) {
      const int us = xcd_swz(u, 16);
      int mtl = us >> 4;
      m0 = (mtl >> 4) * LALL + LC + (mtl & 15) * 128;
      n0 = (us & 15) * 128;
    } else {
      const int us = xcd_swz(u - ULAT, 8);
      int mtc = us >> 3;
      m0 = (mtc >> 1) * LALL + (mtc & 1) * 128;
      n0 = (us & 7) * 128;
    }
  };
  auto Aof = [&](int m0) { return [=](int row, int k) { return Ah + (size_t)(m0 + row) * 1024 + k; }; };
  auto Bof = [&](int n0) { return [=](int row, int k) { return WT + (size_t)(n0 + row) * 1024 + k; }; };
  GSTAGE_DECL;
  if ((int)blockIdx.x < units) {
    int m1, n1;
    coords(blockIdx.x, m1, n1);
    gemm_prefetch(GSTAGE_ARGS, Aof(m1), Bof(n1));
  }
  for (int u = blockIdx.x; u < units; u += gridDim.x) {
    int m0, n0;
    coords(u, m0, n0);
    int b = m0 / LALL, pos0 = m0 - b * LALL;
    f32x16 acc[2][2];
    zero_acc(acc);
    gemm_main(acc, 32, Aof(m0), Bof(n0), sm, GSTAGE_ARGS);
    if (u + (int)gridDim.x < units) {
      int m1, n1;
      coords(u + gridDim.x, m1, n1);
      gemm_prefetch(GSTAGE_ARGS, Aof(m1), Bof(n1));
    }
#pragma unroll
    for (int mi = 0; mi < 2; ++mi)
#pragma unroll
      for (int ni = 0; ni < 2; ++ni) {
        int col = n0 + wn * 64 + ni * 32 + r;
#pragma unroll
        for (int i = 0; i < 16; ++i) {
          int row = wm * 64 + mi * 32 + crow(i, h);
          int tok = m0 + row;
          float v = acc[mi][ni][i];
          if (col < 1024) U2[((size_t)(col >> 4) * TOK + tok) * 16 + (col & 15)] = f2bf(v);
          else SZ1[((size_t)(b * SEQ + pos0 + row - LC)) * 1024 + (col - 1024)] = f2bf(silu_f(v));
          SCHED_FENCE();
        }
      }
  }
}

DI void phase_o6(const Params& p, char* smem) {
  GemmSmem* sm = (GemmSmem*)smem;
  WAVE_IDS
  const int NROW = NB * NCH;
  const int units = 64 * 5 * 2;
  const bfr* U2 = (const bfr*)(p.ws + O_U2);
  const bfr* WST = (const bfr*)(p.ws + O_WST);
  float* SLOC = (float*)(p.ws + O_SLOC);
  for (int u = blockIdx.x; u < units; u += gridDim.x) {
    const int us = xcd_swz(u, 10);
    int g = us / 10, rem = us - g * 10;
    int mt = rem >> 1, nt = rem & 1;
    int m0 = mt * 128, n0 = nt * 128;
    const bfr* Ag = U2 + (size_t)g * TOK * 16;
    const bfr* Bg = WST + (size_t)g * 256 * 512;
    f32x16 acc[2][2];
    zero_acc(acc);
    gemm_full(
        acc, 16,
        [&](int row, int k) {
          int rr = m0 + row;
          rr = rr < NROW ? rr : NROW - 1;
          return Ag + (size_t)rr * 512 + k;
        },
        [&](int row, int k) { return Bg + (size_t)(n0 + row) * 512 + k; }, sm);
#pragma unroll
    for (int mi = 0; mi < 2; ++mi)
#pragma unroll
      for (int ni = 0; ni < 2; ++ni) {
        int col = n0 + wn * 64 + ni * 32 + r;
#pragma unroll
        for (int i = 0; i < 16; ++i) {
          int row = m0 + wm * 64 + mi * 32 + crow(i, h);
          if (row < NROW) SLOC[((size_t)g * NROW + row) * 256 + col] = acc[mi][ni][i];
        }
      }
  }
}

DI void phase_o7(const Params& p) {
  const int tidx_ = opaque_tid();
  const float* SLOC = (const float*)(p.ws + O_SLOC);
  bfr* SIN = (bfr*)(p.ws + O_SIN);
  const int total = NB * 64 * 2 * 64;
  for (int idx = blockIdx.x * 256 + tidx_; idx < total; idx += gridDim.x * 256) {
    int pp = idx & 63, dir = (idx >> 6) & 1, g = (idx >> 7) & 63, b = idx >> 13;
    double dt, ar, ai;
    float fr, fi, lr, li;
    s5_disc(p, dir, g, pp, dt, ar, ai, fr, fi);
    s5_pow(dt, ar, ai, TC, lr, li);
    float sr = 0.f, si = 0.f;
#pragma unroll 8
    for (int step = 0; step < NCH; ++step) {
      int cp = dir == 0 ? step : (step < 8 ? 7 - step : NCH - 1 - (step - 8));
      const float* sl = SLOC + ((size_t)g * (NB * NCH) + b * NCH + cp) * 256 + dir * 128 + pp;
#ifdef PROBE_NOCARRY
      if ((dir == 0 && cp == 8) || (dir == 1 && cp == NCH - 1)) { sr = 0.f; si = 0.f; }
#endif
      if (cp >= 8) {
        bfr* so = SIN + ((size_t)g * (NB * NCHL) + b * NCHL + (cp - 8)) * 256 + dir * 128 + pp;
        so[0] = f2bf(sr);
        so[64] = f2bf(si);
      }
      float lre = sl[0], lim = sl[64];
      float nr = lr * sr - li * si + lre;
      float ni = lr * si + li * sr + lim;
      sr = nr;
      si = ni;
    }
  }
}

DI void phase_o8(const Params& p, char* smem) {
  GemmSmem* sm = (GemmSmem*)smem;
  WAVE_IDS
  const int units = 64 * 4 * 4;
  const bfr* U2 = (const bfr*)(p.ws + O_U2);
  const bfr* SIN = (const bfr*)(p.ws + O_SIN);
  const bfr* KTAB = (const bfr*)(p.ws + O_KTAB);
  const bfr* VOP = (const bfr*)(p.ws + O_VOP);
  bfr* YG = (bfr*)(p.ws + O_YG);
  for (int u = blockIdx.x; u < units; u += gridDim.x) {
    const int us = xcd_swz(u, 16);
    int g = us >> 4, mt = (us >> 2) & 3, nt = us & 3;
    int m0 = mt * 128, n0 = nt * 128;
    const bfr* Ug = U2 + (size_t)g * TOK * 16;
    f32x16 acc[2][2];
    zero_acc(acc);
    gemm_full(
        acc, 16,
        [&](int row, int k) {
          int rr = m0 + row;
          int b = rr >> 6, n = rr & 63;
          return Ug + ((size_t)b * LALL + LC + n * TC) * 16 + k;
        },
        [&](int row, int k) {
          int m = n0 + row;
          int t = m >> 4, c = m & 15;
          return KTAB + (((size_t)g * 63 + (t + 31)) * 16 + c) * 16 - (k >> 4) * 256 + (k & 15);
        },
        sm);
    gemm_full(
        acc, 8, [&](int row, int k) { return SIN + ((size_t)g * (NB * NCHL) + m0 + row) * 256 + k; },
        [&](int row, int k) { return VOP + ((size_t)g * 512 + n0 + row) * 256 + k; }, sm);
#pragma unroll
    for (int mi = 0; mi < 2; ++mi)
#pragma unroll
      for (int ni = 0; ni < 2; ++ni) {
        int m = n0 + wn * 64 + ni * 32 + r;
        int t = m >> 4, c = m & 15;
        int ch = g * 16 + c;
        float dd = p.in[I_S5D][ch];
        float uv[16];
#pragma unroll
        for (int i = 0; i < 16; ++i) {
          int rr = m0 + wm * 64 + mi * 32 + crow(i, h);
          int b = rr >> 6, n = rr & 63;
          uv[i] = bf2f(Ug[((size_t)b * LALL + LC + n * TC + t) * 16 + c]);
        }
        SCHED_FENCE();
#pragma unroll
        for (int i = 0; i < 16; ++i) {
          int rr = m0 + wm * 64 + mi * 32 + crow(i, h);
          int b = rr >> 6, n = rr & 63;
          float y = acc[mi][ni][i] + dd * uv[i];
          YG[((size_t)(b * SEQ + n * TC + t)) * 1024 + ch] = f2bf(gelu_tanh(y));
        }
        SCHED_FENCE();
      }
  }
}

DI void phase_o9(const Params& p, char* smem) {
  GemmSmem* sm = (GemmSmem*)smem;
  WAVE_IDS
  const int NT = 8, units = (NLAT / 128) * NT;
  const bfr* YG = (const bfr*)(p.ws + O_YG);
  const bfr* SZ1 = (const bfr*)(p.ws + O_SZ1);
  const bfr* WT = (const bfr*)(p.ws + O_WT_GLU);
  bfr* Y2 = (bfr*)(p.ws + O_Y2);
  auto Aof = [&](int m0) { return [=](int row, int k) { return YG + (size_t)(m0 + row) * 1024 + k; }; };
  auto Bof = [&](int n0) { return [=](int row, int k) { return WT + (size_t)(n0 + row) * 1024 + k; }; };
  GSTAGE_DECL;
  if ((int)blockIdx.x < units) {
    const int us = xcd_swz(blockIdx.x, NT);
    gemm_prefetch(GSTAGE_ARGS, Aof((us / NT) * 128), Bof((us % NT) * 128));
  }
  for (int u = blockIdx.x; u < units; u += gridDim.x) {
    const int us = xcd_swz(u, NT);
    int mt = us / NT, nt = us - mt * NT;
    int m0 = mt * 128, n0 = nt * 128;
    f32x16 acc[2][2];
    zero_acc(acc);
    gemm_main(acc, 32, Aof(m0), Bof(n0), sm, GSTAGE_ARGS);
    if (u + (int)gridDim.x < units) {
      const int us1 = xcd_swz(u + gridDim.x, NT);
      gemm_prefetch(GSTAGE_ARGS, Aof((us1 / NT) * 128), Bof((us1 % NT) * 128));
    }
    float* wl = (float*)sm + wave * 2048;
    const int ccol = n0 + wn * 64 + (lane & 15) * 4;
    const float4 bg = *(const float4*)(p.in[I_BGLU] + ccol);
#pragma unroll
    for (int mi = 0; mi < 2; ++mi) {
      float4 v[8];
      stage_half(acc, mi, wl, v, lane);
      uint2 yv[8], zv[8];
#pragma unroll
      for (int c = 0; c < 8; ++c) {
        size_t o = (size_t)(m0 + wm * 64 + mi * 32 + c * 4 + (lane >> 4)) * 1024 + ccol;
        yv[c] = *(const uint2*)(YG + o);
        zv[c] = *(const uint2*)(SZ1 + o);
      }
      SCHED_FENCE();
#pragma unroll
      for (int c = 0; c < 8; ++c) {
        size_t o = (size_t)(m0 + wm * 64 + mi * 32 + c * 4 + (lane >> 4)) * 1024 + ccol;
        float4 y = bf4_to_f4(yv[c]), z = bf4_to_f4(zv[c]);
        float4 ov;
        ov.x = y.x * sigmoid_f(v[c].x + bg.x) * z.x;
        ov.y = y.y * sigmoid_f(v[c].y + bg.y) * z.y;
        ov.z = y.z * sigmoid_f(v[c].z + bg.z) * z.z;
        ov.w = y.w * sigmoid_f(v[c].w + bg.w) * z.w;
        *(uint2*)(Y2 + o) = f4_to_bf4(ov);
      }
      SCHED_FENCE();
    }
    __syncthreads();
  }
}

#define XB_TMO      128
#define XB_XCNT(j)  (256  + 64 * (j))
#define XB_XSUB(j)  (1280 + 64 * (j))
#define XB_XGEN(j)  (2304 + 64 * (j))
#define XB_TOP      3328
#define XB_TOPGEN   3392
#define XCD_BAR_WORDS 3456
#define XB_SPIN_CAP (1u << 18)
#define LAS __attribute__((address_space(3)))
DI unsigned xb_ld(unsigned* p) { return __hip_atomic_load(p, __ATOMIC_RELAXED, __HIP_MEMORY_SCOPE_AGENT); }
DI unsigned xb_add(unsigned* p, unsigned v) { return __hip_atomic_fetch_add(p, v, __ATOMIC_RELAXED, __HIP_MEMORY_SCOPE_AGENT); }
DI unsigned xb_xcc_id() { return (unsigned)__builtin_amdgcn_s_getreg((3 << 11) | 20) & 0xFu; }
#define XB_SPIN(cond, bar) do { unsigned _sp = 0; while (cond) { __builtin_amdgcn_s_sleep(1); \
    if ((++_sp & 255u) == 0u) { if (xb_ld(&(bar)[XB_TMO])) break; if (_sp > XB_SPIN_CAP) { atomicAdd(&(bar)[XB_TMO], 1u); break; } } } } while (0)
struct XcdBarrier {
  unsigned* bar;
  unsigned x;
  volatile LAS unsigned* st;
};
DI XcdBarrier xcd_barrier_post(unsigned* bar, volatile LAS unsigned* st) {
  XcdBarrier b;
  b.bar = bar;
  b.x = xb_xcc_id();
  b.st = st;
  if (threadIdx.x == 0) (void)xb_add(&bar[XB_XCNT(b.x)], 1u);
  return b;
}
DI void xcd_barrier_complete(unsigned* bar, unsigned x, unsigned& nloc, unsigned& nx) {
  const unsigned G = gridDim.x * gridDim.y * gridDim.z;
  unsigned sum, cnt, mine, sp = 0u;
  for (;;) {
    sum = 0u; cnt = 0u; mine = 0u;
#pragma unroll
    for (unsigned j = 0; j < 16; ++j) {
      const unsigned c = xb_ld(&bar[XB_XCNT(j)]);
      sum += c;
      cnt += (c > 0u) ? 1u : 0u;
      mine = (j == x) ? c : mine;
    }
    if (sum == G) break;
    __builtin_amdgcn_s_sleep(1);
    if ((++sp & 255u) == 0u) {
      if (xb_ld(&bar[XB_TMO])) break;
      if (sp > XB_SPIN_CAP) { atomicAdd(&bar[XB_TMO], 1u); break; }
    }
  }
  nloc = mine > 0u ? mine : 1u;
  nx = cnt > 0u ? cnt : 1u;
}
DI void xcd_barrier(const XcdBarrier& b) {
  asm volatile("s_waitcnt vmcnt(0)" ::: "memory");
  __syncthreads();
  if (threadIdx.x == 0) {
    unsigned* bar = b.bar;
    __builtin_amdgcn_s_waitcnt(0);
    unsigned nloc = b.st[0], nx = b.st[1];
    if (nloc == 0u) {
      xcd_barrier_complete(bar, b.x, nloc, nx);
      b.st[0] = nloc;
      b.st[1] = nx;
    }
    const unsigned old = xb_add(&bar[XB_XSUB(b.x)], 1u);
    const unsigned gen = old / nloc;
    if (old + 1u == (gen + 1u) * nloc) {
      __builtin_amdgcn_fence(__ATOMIC_RELEASE, "agent");
      asm volatile("s_waitcnt vmcnt(0)" ::: "memory");
      const unsigned og = xb_add(&bar[XB_TOP], 1u);
      const unsigned tg = og / nx;
      if (og + 1u == (tg + 1u) * nx) xb_add(&bar[XB_TOPGEN], 1u);
      else XB_SPIN(xb_ld(&bar[XB_TOPGEN]) == tg, bar);
      __builtin_amdgcn_fence(__ATOMIC_ACQUIRE, "agent");
      xb_add(&bar[XB_XGEN(b.x)], 1u);
      asm volatile("s_waitcnt vmcnt(0)" ::: "memory");
    } else {
      XB_SPIN(xb_ld(&bar[XB_XGEN(b.x)]) == gen, bar);
      __builtin_amdgcn_fence(__ATOMIC_ACQUIRE, "agent");
      asm volatile("s_waitcnt vmcnt(0)" ::: "memory");
    }
  }
  __syncthreads();
}

DI void run_phase(const Params& p, int ph, char* smem) {
  switch (ph) {
#if !defined(ONLY) || ONLY == 0
    case PH_PREP: phase_prep(p, smem); break;
#endif
#if !defined(ONLY) || ONLY == 1
    case PH_FINAL: phase_final(p); break;
#endif
#if !defined(ONLY) || ONLY == 2
    case PH_O1: phase_o1(p, smem); break;
#endif
#if !defined(ONLY) || ONLY == 3
    case PH_O2: phase_o2(p, smem); break;
#endif
#if !defined(ONLY) || ONLY == 4
    case PH_O3: phase_o3(p, smem); break;
#endif
#if !defined(ONLY) || ONLY == 5
    case PH_O4: phase_oproj<0>(p, smem); break;
#endif
#if !defined(ONLY) || ONLY == 6
    case PH_O5: phase_o5(p, smem); break;
#endif
#if !defined(ONLY) || ONLY == 7
    case PH_O6: phase_o6(p, smem); break;
#endif
#if !defined(ONLY) || ONLY == 8
    case PH_O7: phase_o7(p); break;
#endif
#if !defined(ONLY) || ONLY == 9
    case PH_O8: phase_o8(p, smem); break;
#endif
#if !defined(ONLY) || ONLY == 10
    case PH_O9: phase_o9(p, smem); break;
#endif
#if !defined(ONLY) || ONLY == 11
    case PH_O10: phase_oproj<1>(p, smem); break;
#endif
    case PH_H0: phase_hconv<0>(p); break;
    case PH_H1: phase_hconv<1>(p); break;
    default: break;
  }
}

__global__ void __launch_bounds__(256, 2) mega_one(Params p, int ph) {
  __shared__ __attribute__((aligned(16))) char smem[SMEM_BYTES];
  run_phase(p, ph, smem);
}

#if !defined(ONLY) && SINGLE_LAUNCH
__global__ void __launch_bounds__(256, 2) mega(Params p) {
  __shared__ __attribute__((aligned(16))) char smem[SMEM_BYTES];
  __shared__ uint4 xb_words;
  if (threadIdx.x == 0) xb_words = make_uint4(0u, 0u, 0u, 0u);
  __syncthreads();
  if (p.nprog < 0) cg::this_grid().sync();
  const XcdBarrier xb = xcd_barrier_post((unsigned*)(p.ws + O_BAR), (volatile LAS unsigned*)&xb_words);
  cg::grid_group grid = cg::this_grid();
#if !defined(OMIT) || OMIT != 0
  phase_prep(p, smem);
#endif
  xcd_barrier(xb);
#if (DUP >> 0) & 1
  phase_prep(p, smem);
  xcd_barrier(xb);
#endif
  phase_hconv<0>(p);
  xcd_barrier(xb);
#if !defined(OMIT) || OMIT != 1
  phase_o1(p, smem);
#endif
  xcd_barrier(xb);
#if (DUP >> 1) & 1
  phase_o1(p, smem);
  xcd_barrier(xb);
#endif
#if !defined(OMIT) || OMIT != 2
  phase_o2(p, smem);
#endif
  xcd_barrier(xb);
#if (DUP >> 2) & 1
  phase_o2(p, smem);
  xcd_barrier(xb);
#endif
#if !defined(OMIT) || OMIT != 3
  phase_o3(p, smem);
#endif
  xcd_barrier(xb);
#if (DUP >> 3) & 1
  phase_o3(p, smem);
  xcd_barrier(xb);
#endif
#if !defined(OMIT) || OMIT != 4
  phase_oproj<0>(p, smem);
#endif
  xcd_barrier(xb);
#if (DUP >> 4) & 1
  phase_oproj<0>(p, smem);
  xcd_barrier(xb);
#endif
  phase_hconv<1>(p);
  xcd_barrier(xb);
#if !defined(OMIT) || OMIT != 5
  phase_o5(p, smem);
#endif
  xcd_barrier(xb);
#if (DUP >> 5) & 1
  phase_o5(p, smem);
  xcd_barrier(xb);
#endif
#if !defined(OMIT) || OMIT != 6
  phase_o6(p, smem);
#endif
  xcd_barrier(xb);
#if (DUP >> 6) & 1
  phase_o6(p, smem);
  xcd_barrier(xb);
#endif
#if !defined(OMIT) || OMIT != 7
  phase_o7(p);
#endif
  xcd_barrier(xb);
#if (DUP >> 7) & 1
  phase_o7(p);
  xcd_barrier(xb);
#endif
#if !defined(OMIT) || OMIT != 8
  phase_o8(p, smem);
#endif
  xcd_barrier(xb);
#if (DUP >> 8) & 1
  phase_o8(p, smem);
  xcd_barrier(xb);
#endif
#if !defined(OMIT) || OMIT != 9
  phase_o9(p, smem);
#endif
  xcd_barrier(xb);
#if (DUP >> 9) & 1
  phase_o9(p, smem);
  xcd_barrier(xb);
#endif
#if !defined(OMIT) || OMIT != 10
  phase_oproj<1>(p, smem);
#endif
  xcd_barrier(xb);
#if !defined(OMIT) || OMIT != 11
  phase_final(p);
#endif
}
#else
__global__ void mega(Params p) {}
#endif


extern "C" void kernel_launch(void* const* d_in, const int* in_sizes, int n_in, void* d_out, int out_size, void* d_ws,
                              size_t ws_size, hipStream_t stream) {
  static int grid_blocks = 0;
  if (!grid_blocks) {
    int dev = 0, cus = 0, per_cu = 0;
    hipGetDevice(&dev);
    hipDeviceGetAttribute(&cus, hipDeviceAttributeMultiprocessorCount, dev);
#if SINGLE_LAUNCH
    hipOccupancyMaxActiveBlocksPerMultiprocessor(&per_cu, mega, 256, 0);
#else
    hipOccupancyMaxActiveBlocksPerMultiprocessor(&per_cu, mega_one, 256, 0);
#endif
    if (per_cu < 1) per_cu = 1;
    if (per_cu > 2) per_cu = 2;
    grid_blocks = cus * per_cu;
  }
  if (ws_size < WS_NEED || n_in < N_INPUTS) {
    fprintf(stderr, "workspace too small or bad inputs: %zu < %zu\n", ws_size, (size_t)WS_NEED);
    return;
  }
  Params p{};
  for (int i = 0; i < N_INPUTS; ++i) p.in[i] = (const float*)d_in[i];
  p.out = (float*)d_out;
  p.ws = (char*)d_ws;
#ifndef PROG
#define PROG PH_PREP, PH_H0, PH_O1, PH_O2, PH_O3, PH_O4, PH_H1, PH_O5, PH_O6, PH_O7, PH_O8, PH_O9, PH_O10, PH_FINAL
#endif
  const int prog[] = {PROG};
  p.nprog = (int)(sizeof(prog) / sizeof(int));
  for (int i = 0; i < p.nprog; ++i) p.prog[i] = prog[i];
#if SINGLE_LAUNCH
  hipMemsetAsync((char*)d_ws + O_BAR, 0, BAR_BYTES, stream);
  void* args[] = {&p};
  hipError_t e = hipLaunchCooperativeKernel((void*)mega, dim3(grid_blocks), dim3(256), args, 0, stream);
  if (e != hipSuccess) fprintf(stderr, "cooperative launch failed: %s (grid %d)\n", hipGetErrorString(e), grid_blocks);
#else
  for (int i = 0; i < p.nprog; ++i) {
    mega_one<<<dim3(grid_blocks), dim3(256), 0, stream>>>(p, p.prog[i]);
  }
#endif
}
```

```cpp
#include <hip/hip_runtime.h>
#include <hip/hip_cooperative_groups.h>
#include <cstdio>
namespace cg = cooperative_groups;
#ifndef DUP
#define DUP 0
#endif
#ifndef USE_NAIVE
#define USE_NAIVE 0
#endif
#ifndef SINGLE_LAUNCH
#define SINGLE_LAUNCH 1
#endif

#define DI __device__ __forceinline__
typedef unsigned short bfr;

constexpr int D = 1024, NB = 8, SEQ = 2048, LC = 256, LALL = 2304;
constexpr int TOK = NB * LALL;
constexpr int NLAT = NB * SEQ;
constexpr int NH = 16, DQK = 96, DV = 64;
constexpr int NIN0 = 1440, NIN1 = 2048;
constexpr float EPS = 1e-6f;
constexpr float QSCALE = 0.10206207261596577f * 1.4426950408889634f;
constexpr int TC = 32;
constexpr int NCH = LALL / TC;
constexpr int NCHL = SEQ / TC;

enum { I_X = 0, I_C, I_CTX, I_CCTX, I_ADAW, I_ADAB, I_NORMG, I_WIN0, I_QNORM, I_WUQ, I_KVNORM, I_WUKV, I_WOUT0,
       I_WIN1, I_ARE, I_AIM, I_LOGSTEP, I_BRE, I_BIM, I_CRE, I_CIM, I_S5D, I_WGLU, I_BGLU, I_WOUT1, I_FINALG, N_INPUTS };

constexpr size_t al256(size_t x) { return (x + 255) & ~(size_t)255; }
constexpr size_t O_WT_IN0 = 0;
constexpr size_t O_WT_UQ = O_WT_IN0 + al256((size_t)NIN0 * 1024 * 2);
constexpr size_t O_WT_UKV = O_WT_UQ + al256((size_t)1536 * 256 * 2);
constexpr size_t O_WT_OUT0 = O_WT_UKV + al256((size_t)2048 * 128 * 2);
constexpr size_t O_WT_IN1 = O_WT_OUT0 + al256((size_t)1024 * 1024 * 2);
constexpr size_t O_WT_GLU = O_WT_IN1 + al256((size_t)2048 * 1024 * 2);
constexpr size_t O_WT_OUT1 = O_WT_GLU + al256((size_t)1024 * 1024 * 2);
constexpr size_t O_MOD = O_WT_OUT1 + al256((size_t)1024 * 1024 * 2);
constexpr size_t O_RS0 = O_MOD + al256((size_t)2 * 9 * 3072 * 4);
constexpr size_t O_PART1 = O_RS0 + al256((size_t)TOK * 4);
constexpr size_t O_PART2 = O_PART1 + al256((size_t)16 * TOK * 4);
constexpr size_t O_X1CTX = O_PART2 + al256((size_t)16 * NLAT * 4);
constexpr size_t O_KTAB = O_X1CTX + al256((size_t)NB * LC * 1024 * 4);
constexpr size_t O_WST = O_KTAB + al256((size_t)64 * 63 * 256 * 2);
constexpr size_t O_VOP = O_WST + al256((size_t)64 * 256 * 512 * 2);
constexpr size_t O_BAR = O_VOP + al256((size_t)64 * 512 * 256 * 2);
constexpr size_t BAR_BYTES = 3456 * 4;
constexpr size_t O_LAYER = O_BAR + al256(BAR_BYTES);
constexpr size_t O_PC = O_LAYER;
constexpr size_t O_SZ0 = O_PC + al256((size_t)TOK * 384 * 2);
constexpr size_t O_K = O_SZ0 + al256((size_t)TOK * 1024 * 2);
constexpr size_t O_VT = O_K + al256((size_t)NB * NH * LALL * 64 * 2);
constexpr size_t O_OG = O_VT + al256((size_t)NB * NH * DV * LALL * 2);
constexpr size_t O_KR = O_OG + al256((size_t)TOK * 1024 * 2);
constexpr size_t O_END0 = O_KR + al256((size_t)TOK * 32 * 2);
constexpr size_t O_H0 = O_OG;
constexpr size_t O_U2 = O_LAYER;
constexpr size_t O_SZ1 = O_U2 + al256((size_t)64 * TOK * 16 * 2);
constexpr size_t O_SLOC = O_SZ1 + al256((size_t)NLAT * 1024 * 2);
constexpr int SLOC_ROWS = 640;
constexpr size_t O_SIN = O_SLOC + al256((size_t)64 * SLOC_ROWS * 256 * 4);
constexpr size_t O_YG = O_SIN + al256((size_t)64 * (NB * NCHL) * 256 * 2);
constexpr size_t O_H1 = O_YG + al256((size_t)NLAT * 1024 * 2);
constexpr size_t O_END1 = O_H1 + al256((size_t)TOK * 1024 * 2);
constexpr size_t O_Y2 = O_SLOC;
constexpr size_t WS_NEED = (O_END0 > O_END1 ? O_END0 : O_END1);
static_assert(WS_NEED <= (size_t)256 * 1024 * 1024, "workspace too large");
static_assert((size_t)NB * NH * LALL * DQK * 2 <= (size_t)NLAT * 1024 * 4, "Q does not fit d_out");

struct Params {
  const float* in[N_INPUTS];
  float* out;
  char* ws;
  int prog[32];
  int nprog;
  int pad;
};

DI bfr f2bf(float x) {
  unsigned u = __float_as_uint(x);
  u += 0x7fffu + ((u >> 16) & 1u);
  return (bfr)(u >> 16);
}
typedef __bf16 bf2_t __attribute__((ext_vector_type(2)));
typedef float f2_t __attribute__((ext_vector_type(2)));
DI unsigned pk2(float a, float b) {
  f2_t v = {a, b};
  bf2_t r = __builtin_convertvector(v, bf2_t);
  return __builtin_bit_cast(unsigned, r);
}
DI int opaque_tid() {
  int t = threadIdx.x;
  asm volatile("" : "+v"(t));
  return t;
}
DI float bf2f(bfr b) { return __uint_as_float(((unsigned)b) << 16); }
DI float silu_f(float v) { return v / (1.f + __expf(-v)); }
DI float sigmoid_f(float v) { return 1.f / (1.f + __expf(-v)); }
DI float gelu_tanh(float v) {
  float u = 0.7978845608028654f * (v + 0.044715f * v * v * v);
  return 0.5f * v * (1.f + tanhf(u));
}
DI float wave_sum(float v) {
#pragma unroll
  for (int o = 32; o > 0; o >>= 1) v += __shfl_xor(v, o);
  return v;
}
DI float wave_max(float v) {
#pragma unroll
  for (int o = 32; o > 0; o >>= 1) v = fmaxf(v, __shfl_xor(v, o));
  return v;
}
DI const float* xrow0(const Params& p, int tok) {
  int b = tok / LALL, pos = tok - b * LALL;
  return pos < LC ? p.in[I_CTX] + ((size_t)(b * LC + pos)) * D : p.in[I_X] + ((size_t)(b * SEQ + pos - LC)) * D;
}
DI float* xrow1(const Params& p, int tok) {
  int b = tok / LALL, pos = tok - b * LALL;
  return pos < LC ? (float*)(p.ws + O_X1CTX) + ((size_t)(b * LC + pos)) * D : p.out + ((size_t)(b * SEQ + pos - LC)) * D;
}
DI const float* modrow(const Params& p, int layer, int tok) {
  int b = tok / LALL, pos = tok - b * LALL;
  int r = pos < LC ? 8 : b;
  return (const float*)(p.ws + O_MOD) + ((size_t)(layer * 9 + r)) * 3072;
}
DI void rope_cs(int fi, int posv, float& cs, float& sn) {
  float inv = __builtin_amdgcn_exp2f(-(float)fi * (13.287712379549449f / 8.f));
  float rev = (float)posv * inv * 0.15915494309189535f;
  rev -= floorf(rev);
  sn = __builtin_amdgcn_sinf(rev);
  cs = __builtin_amdgcn_cosf(rev);
}
DI float rope_apply(int j, float v, float vp, int lpos) {
  int posv = (j & 16) ? (lpos & 63) : (lpos >> 6);
  float cs, sn;
  rope_cs(j & 7, posv, cs, sn);
  return (j & 8) ? (vp * sn + v * cs) : (v * cs - vp * sn);
}

DI void s5_disc(const Params& p, int dir, int g, int pp, double& dt, double& ar, double& ai, float& fr, float& fi) {
  dt = exp((double)p.in[I_LOGSTEP][dir * 64 + g]);
  ar = (double)p.in[I_ARE][(dir * 64 + g) * 64 + pp];
  ai = (double)p.in[I_AIM][(dir * 64 + g) * 64 + pp];
  double mag = exp(ar * dt);
  double a = ai * dt;
  a -= 6.283185307179586 * rint(a * 0.15915494309189535);
  float sn, cs;
  sincosf((float)a, &sn, &cs);
  double lr = mag * (double)cs, li = mag * (double)sn;
  double den = ar * ar + ai * ai, nr = lr - 1.0;
  fr = (float)((nr * ar + li * ai) / den);
  fi = (float)((li * ar - nr * ai) / den);
}
DI void s5_pow(double dt, double ar, double ai, int k, float& wr, float& wi) {
  double mag = exp(ar * dt * (double)k);
  double a = ai * dt * (double)k;
  a -= 6.283185307179586 * rint(a * 0.15915494309189535);
  float sn, cs;
  sincosf((float)a, &sn, &cs);
  wr = (float)mag * cs;
  wi = (float)mag * sn;
}

enum { PH_PREP = 0, PH_N1, PH_N2, PH_N3, PH_N4, PH_N4B, PH_N5, PH_N6A, PH_N6B, PH_N9, PH_N10, PH_N10B, PH_FINAL,
       PH_O1, PH_O2, PH_O3, PH_O4, PH_O5, PH_O6, PH_O7, PH_O8, PH_O9, PH_O10, PH_H0, PH_H1, PH_COUNT };

constexpr int SMEM_BYTES = 48 * 1024;


DI void prep_transpose(const Params& p, int widx, int tile, char* smem) {
  const int tidx_ = opaque_tid();
  int K, N;
  size_t dst;
  const float* W;
  const float* scl = nullptr;
  switch (widx) {
    case 0: W = p.in[I_WIN0]; K = 1024; N = NIN0; dst = O_WT_IN0; break;
    case 1: W = p.in[I_WUQ]; K = 256; N = 1536; dst = O_WT_UQ; scl = p.in[I_QNORM]; break;
    case 2: W = p.in[I_WUKV]; K = 128; N = 2048; dst = O_WT_UKV; scl = p.in[I_KVNORM]; break;
    case 3: W = p.in[I_WOUT0]; K = 1024; N = 1024; dst = O_WT_OUT0; break;
    case 4: W = p.in[I_WIN1]; K = 1024; N = NIN1; dst = O_WT_IN1; break;
    case 5: W = p.in[I_WGLU]; K = 1024; N = 1024; dst = O_WT_GLU; break;
    default: W = p.in[I_WOUT1]; K = 1024; N = 1024; dst = O_WT_OUT1; break;
  }
  float (*t)[33] = (float (*)[33])smem;
  int ntn = N / 32;
  int kt = tile / ntn, nt = tile - kt * ntn;
  int tx = tidx_ & 31, ty = tidx_ >> 5;
  float v[16];
#pragma unroll
  for (int i = 0; i < 16; ++i) {
    int k = kt * 128 + ty + 8 * i, n = nt * 32 + tx;
    v[i] = W[(size_t)k * N + n];
  }
  if (scl) {
#pragma unroll
    for (int i = 0; i < 16; ++i) v[i] *= scl[kt * 128 + ty + 8 * i];
  }
#pragma unroll
  for (int i = 0; i < 16; ++i) t[ty + 8 * i][tx] = v[i];
  __syncthreads();
  bfr* Wt = (bfr*)(p.ws + dst);
  {
    int nl = tidx_ >> 3, kc = (tidx_ & 7) * 16;
    unsigned w[8];
#pragma unroll
    for (int j = 0; j < 8; ++j) w[j] = pk2(t[kc + 2 * j][nl], t[kc + 2 * j + 1][nl]);
    uint4* dstp = (uint4*)(Wt + (size_t)(nt * 32 + nl) * K + kt * 128 + kc);
    dstp[0] = make_uint4(w[0], w[1], w[2], w[3]);
    dstp[1] = make_uint4(w[4], w[5], w[6], w[7]);
  }
  __syncthreads();
}

DI void prep_mod(const Params& p, int unit, char* smem) {
  const int tidx_ = opaque_tid();
  int layer = unit / 192, cgp = unit - layer * 192;
  float* sil = (float*)smem;
  float* red = sil + 9 * 1024;
  for (int i = tidx_; i < 9 * 1024; i += 256) {
    int r = i >> 10, k = i & 1023;
    float v = r < 8 ? p.in[I_C][r * 1024 + k] : p.in[I_CCTX][k];
    sil[i] = silu_f(v);
  }
  __syncthreads();
  int nn = tidx_ & 15, kg = tidx_ >> 4;
  int n = cgp * 16 + nn;
  const float* W = p.in[I_ADAW] + (size_t)layer * 1024 * 3072 + n;
  float acc[9];
#pragma unroll
  for (int r = 0; r < 9; ++r) acc[r] = 0.f;
#pragma unroll 8
  for (int k = kg * 64; k < kg * 64 + 64; ++k) {
    float w = W[(size_t)k * 3072];
#pragma unroll
    for (int r = 0; r < 9; ++r) acc[r] += sil[r * 1024 + k] * w;
  }
#pragma unroll
  for (int r = 0; r < 9; ++r) red[(kg * 9 + r) * 16 + nn] = acc[r];
  __syncthreads();
  if (tidx_ < 144) {
    int r = tidx_ >> 4, c = tidx_ & 15;
    int nc = cgp * 16 + c;
    float s = p.in[I_ADAB][layer * 3072 + nc];
#pragma unroll
    for (int g = 0; g < 16; ++g) s += red[(g * 9 + r) * 16 + c];
    ((float*)(p.ws + O_MOD))[((size_t)(layer * 9 + r)) * 3072 + nc] = s;
  }
  __syncthreads();
}

DI void prep_ktab(const Params& p, int unit, char* smem) {
  const int tidx_ = opaque_tid();
  int g = unit / 7, lg = unit - g * 7;
  float2* E = (float2*)smem;
  int tid = tidx_;
  const bool use_f = lg >= 3, use_r = lg <= 3;
  for (int i = tid; i < 9 * 128; i += 256) {
    int l = i >> 7, dir = (i >> 6) & 1, pp = i & 63;
    int lag = lg * 9 + l - 31;
    bool used = (dir == 0) ? (lag >= 0) : (lag <= 0);
    float2 e = make_float2(0.f, 0.f);
    if (used) {
      double dt, ar, ai;
      float fr, fi, wr, wi;
      s5_disc(p, dir, g, pp, dt, ar, ai, fr, fi);
      s5_pow(dt, ar, ai, lag < 0 ? -lag : lag, wr, wi);
      e.x = wr * fr - wi * fi;
      e.y = wr * fi + wi * fr;
    }
    E[(l * 2 + dir) * 64 + pp] = e;
  }
  __syncthreads();
  int c = tid >> 4, c2 = tid & 15;
  float acc[9];
#pragma unroll
  for (int l = 0; l < 9; ++l) acc[l] = 0.f;
  for (int dir = 0; dir < 2; ++dir) {
    if (dir == 0 ? !use_f : !use_r) continue;
    const float* bre = p.in[I_BRE] + ((size_t)(dir * 64 + g)) * 64 * 16;
    const float* bim = p.in[I_BIM] + ((size_t)(dir * 64 + g)) * 64 * 16;
    const float* cre = p.in[I_CRE] + ((size_t)(dir * 64 + g)) * 16 * 64;
    const float* cim = p.in[I_CIM] + ((size_t)(dir * 64 + g)) * 16 * 64;
#pragma unroll 4
    for (int pp = 0; pp < 64; ++pp) {
      float br = bre[pp * 16 + c2], bi = bim[pp * 16 + c2];
      float cr = cre[c * 64 + pp], ci = cim[c * 64 + pp];
      float mr = cr * br - ci * bi, mi = cr * bi + ci * br;
#pragma unroll
      for (int l = 0; l < 9; ++l) {
        float2 e = E[(l * 2 + dir) * 64 + pp];
        acc[l] += mr * e.x - mi * e.y;
      }
    }
  }
  bfr* KT = (bfr*)(p.ws + O_KTAB);
#pragma unroll
  for (int l = 0; l < 9; ++l) KT[(((size_t)g * 63 + lg * 9 + l) * 16 + c) * 16 + c2] = f2bf(acc[l]);
  __syncthreads();
}

DI void prep_ops(const Params& p, int unit) {
  const int tidx_ = opaque_tid();
  int idx = unit * 256 + tidx_;
  int pp = idx & 63, t = (idx >> 6) & 31, dir = (idx >> 11) & 1, g = idx >> 12;
  double dt, ar, ai;
  float fr, fi, wr, wi;
  s5_disc(p, dir, g, pp, dt, ar, ai, fr, fi);
  s5_pow(dt, ar, ai, dir == 0 ? (TC - 1 - t) : t, wr, wi);
  float er = wr * fr - wi * fi, ei = wr * fi + wi * fr;
  const float* bre = p.in[I_BRE] + (((size_t)(dir * 64 + g)) * 64 + pp) * 16;
  const float* bim = p.in[I_BIM] + (((size_t)(dir * 64 + g)) * 64 + pp) * 16;
  bfr* wst = (bfr*)(p.ws + O_WST) + (size_t)g * 256 * 512;
  bfr* rre = wst + (size_t)(dir * 128 + pp) * 512 + t * 16;
  bfr* rim = wst + (size_t)(dir * 128 + 64 + pp) * 512 + t * 16;
#pragma unroll
  for (int c2 = 0; c2 < 16; ++c2) {
    float br = bre[c2], bi = bim[c2];
    rre[c2] = f2bf(er * br - ei * bi);
    rim[c2] = f2bf(er * bi + ei * br);
  }
  s5_pow(dt, ar, ai, dir == 0 ? (t + 1) : (TC - t), wr, wi);
  const float* cre = p.in[I_CRE] + ((size_t)(dir * 64 + g)) * 16 * 64;
  const float* cim = p.in[I_CIM] + ((size_t)(dir * 64 + g)) * 16 * 64;
  bfr* vop = (bfr*)(p.ws + O_VOP) + (size_t)g * 512 * 256;
#pragma unroll
  for (int c = 0; c < 16; ++c) {
    float cr = cre[c * 64 + pp], ci = cim[c * 64 + pp];
    float dr = cr * wr - ci * wi, di = cr * wi + ci * wr;
    vop[(size_t)(t * 16 + c) * 256 + dir * 128 + pp] = f2bf(dr);
    vop[(size_t)(t * 16 + c) * 256 + dir * 128 + 64 + pp] = f2bf(-di);
  }
}

constexpr int TR_T0 = 8 * 45, TR_T1 = 2 * 48, TR_T2 = 1 * 64, TR_T3 = 256, TR_T4 = 8 * 64, TR_T5 = 256, TR_T6 = 256;
constexpr int TR_TOTAL = TR_T0 + TR_T1 + TR_T2 + TR_T3 + TR_T4 + TR_T5 + TR_T6;
constexpr int U_MOD = 384, U_RS0 = 0, U_KTAB = 64 * 7, U_OPS = 64 * 2 * 64 * 32 / 256;
constexpr int PREP_UNITS = TR_TOTAL + U_MOD + U_RS0 + U_KTAB + U_OPS;

DI void phase_prep(const Params& p, char* smem) {
  for (int u = blockIdx.x; u < PREP_UNITS; u += gridDim.x) {
    int v = u;
    if (v < U_MOD) { prep_mod(p, v, smem); continue; }
    v -= U_MOD;
    if (v < TR_TOTAL) {
      int w = 0;
      if (v >= TR_T0) { v -= TR_T0; w = 1;
        if (v >= TR_T1) { v -= TR_T1; w = 2;
          if (v >= TR_T2) { v -= TR_T2; w = 3;
            if (v >= TR_T3) { v -= TR_T3; w = 4;
              if (v >= TR_T4) { v -= TR_T4; w = 5;
                if (v >= TR_T5) { v -= TR_T5; w = 6; } } } } } }
      prep_transpose(p, w, v, smem);
      continue;
    }
    v -= TR_TOTAL;
    v -= U_RS0;
    if (v < U_KTAB) { prep_ktab(p, v, smem); continue; }
    v -= U_KTAB;
    prep_ops(p, v);
  }
}

DI float rs_from_part(const float* part, int nrows, int r) {
  float s = 0.f;
#pragma unroll
  for (int j = 0; j < 16; ++j) s += part[(size_t)j * nrows + r];
  return rsqrtf(s * (1.f / 1024.f) + EPS);
}

DI void phase_final(const Params& p) {
  const int tidx_ = opaque_tid();
  const float* part = (const float*)(p.ws + O_PART2);
  const float4* g4 = (const float4*)p.in[I_FINALG];
  int lane = tidx_ & 63;
  float4 g[4];
#pragma unroll
  for (int i = 0; i < 4; ++i) g[i] = g4[lane + 64 * i];
  for (int r = (blockIdx.x * 4 + (tidx_ >> 6)) * 2; r < NLAT; r += gridDim.x * 8) {
    float4* row0 = (float4*)(p.out + (size_t)r * D);
    float4* row1 = row0 + D / 4;
    float4 v0[4], v1[4];
#pragma unroll
    for (int i = 0; i < 4; ++i) {
      v0[i] = row0[lane + 64 * i];
      v1[i] = row1[lane + 64 * i];
    }
    float ps = part[(size_t)(lane & 15) * NLAT + r + ((lane >> 4) & 1)];
    ps += __shfl_xor(ps, 1);
    ps += __shfl_xor(ps, 2);
    ps += __shfl_xor(ps, 4);
    ps += __shfl_xor(ps, 8);
    const float rs0 = rsqrtf(__shfl(ps, 0) * (1.f / 1024.f) + EPS);
    const float rs1 = rsqrtf(__shfl(ps, 16) * (1.f / 1024.f) + EPS);
#pragma unroll
    for (int i = 0; i < 4; ++i) {
      float4 a = v0[i], c = v1[i];
      a.x *= rs0 * g[i].x; a.y *= rs0 * g[i].y; a.z *= rs0 * g[i].z; a.w *= rs0 * g[i].w;
      c.x *= rs1 * g[i].x; c.y *= rs1 * g[i].y; c.z *= rs1 * g[i].z; c.w *= rs1 * g[i].w;
      row0[lane + 64 * i] = a;
      row1[lane + 64 * i] = c;
    }
  }
}

typedef short bf16x8 __attribute__((ext_vector_type(8)));
typedef short s16x4 __attribute__((ext_vector_type(4)));
typedef float f32x16 __attribute__((ext_vector_type(16)));
#define SCHED_FENCE() __builtin_amdgcn_sched_barrier(0)
#define MFMA32(a, b, c) __builtin_amdgcn_mfma_f32_32x32x16_bf16((a), (b), (c), 0, 0, 0)
DI int xcd_swz(int u, int per) {
  int x = u & 7, q = u >> 3;
  int qq = q / per;
  return (x + 8 * qq) * per + (q - qq * per);
}
DI int crow(int i, int h) { return (i & 3) + 8 * (i >> 2) + 4 * h; }

constexpr int LDT = 40;
struct GemmSmem {
  bfr A[2][128 * LDT];
  bfr B[2][128 * LDT];
  float rs[128];
};
static_assert(sizeof(GemmSmem) <= SMEM_BYTES, "smem");

DI void zero_acc(f32x16 (&acc)[2][2]) {
#pragma unroll
  for (int a = 0; a < 2; ++a)
#pragma unroll
    for (int b = 0; b < 2; ++b)
#pragma unroll
      for (int i = 0; i < 16; ++i) acc[a][b][i] = 0.f;
}

#define GSTAGE_DECL uint4 ga0, ga1, gb0, gb1, gc0, gc1, gd0, gd1
#define GSTAGE_ARGS ga0, ga1, gb0, gb1, gc0, gc1, gd0, gd1
#define GSTAGE_PARAMS uint4 &a0, uint4 &a1, uint4 &b0, uint4 &b1, uint4 &c0, uint4 &c1, uint4 &d0, uint4 &d1
template <class AAddr, class BAddr>
DI void gemm_prefetch(GSTAGE_PARAMS, AAddr aaddr, BAddr baddr) {
  const int tid = opaque_tid();
  const int lrow = tid >> 2, lkc = (tid & 3) * 8;
  b0 = *(const uint4*)baddr(lrow, lkc);
  b1 = *(const uint4*)baddr(lrow + 64, lkc);
  a0 = *(const uint4*)aaddr(lrow, lkc);
  a1 = *(const uint4*)aaddr(lrow + 64, lkc);
  d0 = *(const uint4*)baddr(lrow, 32 + lkc);
  d1 = *(const uint4*)baddr(lrow + 64, 32 + lkc);
  c0 = *(const uint4*)aaddr(lrow, 32 + lkc);
  c1 = *(const uint4*)aaddr(lrow + 64, 32 + lkc);
  SCHED_FENCE();
}
template <class AAddr, class BAddr>
DI void gemm_main(f32x16 (&acc)[2][2], int KT, AAddr aaddr, BAddr baddr, GemmSmem* sm, GSTAGE_PARAMS) {
  const int tid = opaque_tid(), lane = tid & 63, wave = tid >> 6;
  const int wm = wave >> 1, wn = wave & 1, r = lane & 31, h = lane >> 5;
  const int lrow = tid >> 2, lkc = (tid & 3) * 8;
#define GM_LOAD(KT_, A0, A1, B0, B1)                   \
  {                                                    \
    const int kk_ = (KT_) * 32 + lkc;                  \
    B0 = *(const uint4*)baddr(lrow, kk_);              \
    B1 = *(const uint4*)baddr(lrow + 64, kk_);         \
    A0 = *(const uint4*)aaddr(lrow, kk_);              \
    A1 = *(const uint4*)aaddr(lrow + 64, kk_);         \
  }
#define GM_STORE(BUF_, A0, A1, B0, B1)                                  \
  {                                                                     \
    *(uint4*)(sm->B[BUF_] + lrow * LDT + lkc) = B0;                     \
    *(uint4*)(sm->B[BUF_] + (lrow + 64) * LDT + lkc) = B1;              \
    *(uint4*)(sm->A[BUF_] + lrow * LDT + lkc) = A0;                     \
    *(uint4*)(sm->A[BUF_] + (lrow + 64) * LDT + lkc) = A1;              \
  }
#define GM_COMPUTE(BUF_)                                                                                       \
  _Pragma("unroll") for (int ks = 0; ks < 2; ++ks) {                                                           \
    bf16x8 a_[2], b_[2];                                                                                       \
    _Pragma("unroll") for (int mi = 0; mi < 2; ++mi)                                                           \
        a_[mi] = *(const bf16x8*)(sm->A[BUF_] + (wm * 64 + mi * 32 + r) * LDT + ks * 16 + h * 8);              \
    _Pragma("unroll") for (int ni = 0; ni < 2; ++ni)                                                           \
        b_[ni] = *(const bf16x8*)(sm->B[BUF_] + (wn * 64 + ni * 32 + r) * LDT + ks * 16 + h * 8);              \
    _Pragma("unroll") for (int mi = 0; mi < 2; ++mi)                                                           \
        _Pragma("unroll") for (int ni = 0; ni < 2; ++ni) acc[mi][ni] = MFMA32(a_[mi], b_[ni], acc[mi][ni]);    \
  }
  GM_STORE(0, a0, a1, b0, b1)
  if (KT > 2) GM_LOAD(2, a0, a1, b0, b1)
  SCHED_FENCE();
  __syncthreads();
  for (int kt = 0; kt < KT; kt += 2) {
    GM_STORE(1, c0, c1, d0, d1)
    if (kt + 3 < KT) GM_LOAD(kt + 3, c0, c1, d0, d1)
    SCHED_FENCE();
    GM_COMPUTE(0)
    __syncthreads();
    if (kt + 2 < KT) GM_STORE(0, a0, a1, b0, b1)
    if (kt + 4 < KT) GM_LOAD(kt + 4, a0, a1, b0, b1)
    SCHED_FENCE();
    GM_COMPUTE(1)
    __syncthreads();
  }
}

template <class AAddr, class BAddr>
DI void gemm_full(f32x16 (&acc)[2][2], int KT, AAddr aaddr, BAddr baddr, GemmSmem* sm) {
  GSTAGE_DECL;
  gemm_prefetch(GSTAGE_ARGS, aaddr, baddr);
  gemm_main(acc, KT, aaddr, baddr, sm, GSTAGE_ARGS);
}

DI float transpose_reduce16(float (&v)[16], int lane) {
  float r8[8], r4[4], r2[2];
  {
    bool up = lane & 8;
#pragma unroll
    for (int i = 0; i < 8; ++i) {
      float send = up ? v[i] : v[i + 8];
      float keep = up ? v[i + 8] : v[i];
      r8[i] = keep + __shfl_xor(send, 8);
    }
  }
  {
    bool up = lane & 4;
#pragma unroll
    for (int i = 0; i < 4; ++i) {
      float send = up ? r8[i] : r8[i + 4];
      float keep = up ? r8[i + 4] : r8[i];
      r4[i] = keep + __shfl_xor(send, 4);
    }
  }
  {
    bool up = lane & 2;
#pragma unroll
    for (int i = 0; i < 2; ++i) {
      float send = up ? r4[i] : r4[i + 2];
      float keep = up ? r4[i + 2] : r4[i];
      r2[i] = keep + __shfl_xor(send, 2);
    }
  }
  bool up = lane & 1;
  float send = up ? r2[0] : r2[1];
  float keep = up ? r2[1] : r2[0];
  return keep + __shfl_xor(send, 1);
}

DI void stage_half(const f32x16 (&acc)[2][2], int mi, float* wl, float4 (&v)[8], int lane) {
  const int r = lane & 31, h = lane >> 5;
#pragma unroll
  for (int ni = 0; ni < 2; ++ni)
#pragma unroll
    for (int i = 0; i < 16; ++i) wl[crow(i, h) * 64 + ni * 32 + r] = acc[mi][ni][i];
  asm volatile("s_waitcnt lgkmcnt(0)" ::: "memory");
#pragma unroll
  for (int c = 0; c < 8; ++c) v[c] = *(const float4*)(wl + (c * 4 + (lane >> 4)) * 64 + (lane & 15) * 4);
  asm volatile("s_waitcnt lgkmcnt(0)" ::: "memory");
}
DI void stage_half8(const f32x16 (&acc)[2][2], int mi, float* wl, float4 (&lo)[4], float4 (&hi)[4], int lane) {
  const int r = lane & 31, h = lane >> 5;
#pragma unroll
  for (int ni = 0; ni < 2; ++ni)
#pragma unroll
    for (int i = 0; i < 16; ++i) wl[crow(i, h) * 64 + ni * 32 + r] = acc[mi][ni][i];
  asm volatile("s_waitcnt lgkmcnt(0)" ::: "memory");
#pragma unroll
  for (int c = 0; c < 4; ++c) {
    const float* pch = wl + (c * 8 + (lane >> 3)) * 64 + (lane & 7) * 8;
    lo[c] = *(const float4*)pch;
    hi[c] = *(const float4*)(pch + 4);
  }
  asm volatile("s_waitcnt lgkmcnt(0)" ::: "memory");
}
DI float4 bf4_to_f4(uint2 u) {
  return make_float4(__uint_as_float(u.x << 16), __uint_as_float(u.x & 0xffff0000u), __uint_as_float(u.y << 16),
                     __uint_as_float(u.y & 0xffff0000u));
}
DI uint2 f4_to_bf4(float4 f) { return make_uint2(pk2(f.x, f.y), pk2(f.z, f.w)); }

#define WAVE_IDS                                              \
  const int tid = opaque_tid(), lane = tid & 63, wave = tid >> 6; \
  const int wm = wave >> 1, wn = wave & 1, r = lane & 31, h = lane >> 5; \
  (void)wm; (void)wn; (void)r; (void)h;

template <int LAYER>
DI void phase_hconv(const Params& p) {
  const int tid = opaque_tid(), lane = tid & 63;
  bfr* H = (bfr*)(p.ws + (LAYER == 0 ? O_H0 : O_H1));
  const float4* ng4 = (const float4*)(p.in[I_NORMG] + LAYER * 1024);
  for (int tok = (blockIdx.x * 4 + (tid >> 6)) * 2; tok < TOK; tok += gridDim.x * 8) {
    const float4* xr0 = (const float4*)(LAYER == 0 ? xrow0(p, tok) : (const float*)xrow1(p, tok));
    const float4* xr1 = xr0 + 256;
    const float4* md4 = (const float4*)modrow(p, LAYER, tok);
    float4 x0[4], x1[4], gm[4], sh[4];
#pragma unroll
    for (int i = 0; i < 4; ++i) {
      x0[i] = xr0[lane + 64 * i];
      x1[i] = xr1[lane + 64 * i];
      float4 gv = ng4[lane + 64 * i];
      float4 sc = md4[256 + lane + 64 * i];
      sh[i] = md4[lane + 64 * i];
      gm[i] = make_float4(gv.x * (1.f + sc.x), gv.y * (1.f + sc.y), gv.z * (1.f + sc.z), gv.w * (1.f + sc.w));
    }
    float s0 = 0.f, s1 = 0.f;
#pragma unroll
    for (int i = 0; i < 4; ++i) {
      s0 += x0[i].x * x0[i].x + x0[i].y * x0[i].y + x0[i].z * x0[i].z + x0[i].w * x0[i].w;
      s1 += x1[i].x * x1[i].x + x1[i].y * x1[i].y + x1[i].z * x1[i].z + x1[i].w * x1[i].w;
    }
    s0 = wave_sum(s0);
    s1 = wave_sum(s1);
    const float r0 = rsqrtf(s0 * (1.f / 1024.f) + EPS), r1 = rsqrtf(s1 * (1.f / 1024.f) + EPS);
#pragma unroll
    for (int i = 0; i < 4; ++i) {
      uint2 o0, o1;
      o0.x = pk2(x0[i].x * r0 * gm[i].x + sh[i].x, x0[i].y * r0 * gm[i].y + sh[i].y);
      o0.y = pk2(x0[i].z * r0 * gm[i].z + sh[i].z, x0[i].w * r0 * gm[i].w + sh[i].w);
      o1.x = pk2(x1[i].x * r1 * gm[i].x + sh[i].x, x1[i].y * r1 * gm[i].y + sh[i].y);
      o1.y = pk2(x1[i].z * r1 * gm[i].z + sh[i].z, x1[i].w * r1 * gm[i].w + sh[i].w);
      *(uint2*)(H + (size_t)tok * 1024 + (lane + 64 * i) * 4) = o0;
      *(uint2*)(H + (size_t)(tok + 1) * 1024 + (lane + 64 * i) * 4) = o1;
    }
  }
}

DI void phase_o1(const Params& p, char* smem) {
  GemmSmem* sm = (GemmSmem*)smem;
  WAVE_IDS
  const int NT = 12, units = (TOK / 128) * NT;
  const bfr* WT = (const bfr*)(p.ws + O_WT_IN0);
  bfr* PC = (bfr*)(p.ws + O_PC);
  bfr* SZ0 = (bfr*)(p.ws + O_SZ0);
  bfr* KRb = (bfr*)(p.ws + O_KR);
  const bfr* Ah = (const bfr*)(p.ws + O_H0);
  auto Aof = [&](int m0) { return [=](int row, int k) { return Ah + (size_t)(m0 + row) * 1024 + k; }; };
  auto Bof = [&](int n0) {
    return [=](int row, int k) {
      int n = n0 + row;
      n = n < NIN0 ? n : NIN0 - 1;
      return WT + (size_t)n * 1024 + k;
    };
  };
  GSTAGE_DECL;
  if ((int)blockIdx.x < units) {
    const int us = xcd_swz(blockIdx.x, NT);
    gemm_prefetch(GSTAGE_ARGS, Aof((us / NT) * 128), Bof((us % NT) * 128));
  }
  for (int u = blockIdx.x; u < units; u += gridDim.x) {
    const int us = xcd_swz(u, NT);
    int mt = us / NT, nt = us - mt * NT;
    int m0 = mt * 128, n0 = nt * 128;
    f32x16 acc[2][2];
    zero_acc(acc);
    gemm_main(acc, 32, Aof(m0), Bof(n0), sm, GSTAGE_ARGS);
    if (u + (int)gridDim.x < units) {
      const int us1 = xcd_swz(u + gridDim.x, NT);
      gemm_prefetch(GSTAGE_ARGS, Aof((us1 / NT) * 128), Bof((us1 % NT) * 128));
    }
    int b = m0 / LALL, pos0 = m0 - b * LALL;
    bool lat = pos0 >= LC;
#pragma unroll
    for (int mi = 0; mi < 2; ++mi)
#pragma unroll
      for (int ni = 0; ni < 2; ++ni) {
        int col0 = n0 + wn * 64 + ni * 32;
        if (col0 >= NIN0) continue;
        int col = col0 + r;
#pragma unroll
        for (int i = 0; i < 16; ++i) {
          int row = wm * 64 + mi * 32 + crow(i, h);
          int tok = m0 + row;
          float v = acc[mi][ni][i];
          if (col0 < 384) {
            PC[(size_t)tok * 384 + col] = f2bf(v);
          } else if (col0 == 384) {
            float vp = __shfl_xor(v, 8);
            int pos = pos0 + row;
            float val = lat ? rope_apply(r, v, vp, pos - LC) : v;
            KRb[(size_t)tok * 32 + r] = f2bf(val);
          } else {
            SZ0[(size_t)tok * 1024 + (col - 416)] = f2bf(silu_f(v));
          }
          SCHED_FENCE();
        }
      }
  }
}

DI void phase_o2(const Params& p, char* smem) {
  GemmSmem* sm = (GemmSmem*)smem;
  WAVE_IDS
  const int UQ = (TOK / 128) * 12, UKV = (TOK / 128) * 16;
  const bfr* PC = (const bfr*)(p.ws + O_PC);
  bfr* Q = (bfr*)p.out;
  bfr* Kb = (bfr*)(p.ws + O_K);
  bfr* VT = (bfr*)(p.ws + O_VT);
  const int total = UQ + UKV;
  const int per_blk = (total + gridDim.x - 1) / gridDim.x;
  const int u_beg = blockIdx.x * per_blk;
  const int u_end = u_beg + per_blk < total ? u_beg + per_blk : total;
  int prev_key = -1;
  for (int us = u_beg; us < u_end; ++us) {
    int mt = us / 28, rem = us - mt * 28;
    bool isq = rem < 12;
    int nt = isq ? rem : rem - 12;
    int m0 = mt * 128, n0 = nt * 128;
    int Kd = isq ? 256 : 128;
    int aoff = isq ? 0 : 256;
    const bfr* WT = (const bfr*)(p.ws + (isq ? O_WT_UQ : O_WT_UKV));
    const int key = mt * 2 + (isq ? 0 : 1);
    if (key != prev_key) {
      prev_key = key;
      __syncthreads();
      int row = tid >> 1, half = tid & 1;
      const bfr* ap = PC + (size_t)(m0 + row) * 384 + aoff + half * (Kd / 2);
      float ss = 0.f;
      for (int j = 0; j < Kd / 16; ++j) {
        uint4 v = *(const uint4*)(ap + j * 8);
        unsigned w[4] = {v.x, v.y, v.z, v.w};
#pragma unroll
        for (int e = 0; e < 4; ++e) {
          float lo = __uint_as_float(w[e] << 16), hi = __uint_as_float(w[e] & 0xffff0000u);
          ss += lo * lo + hi * hi;
        }
      }
      ss += __shfl_xor(ss, 1);
      if (half == 0) sm->rs[row] = rsqrtf(ss / (float)Kd + EPS);
      __syncthreads();
    }
    f32x16 acc[2][2];
    zero_acc(acc);
    gemm_full(
        acc, Kd / 32, [&](int row, int k) { return PC + (size_t)(m0 + row) * 384 + aoff + k; },
        [&](int row, int k) { return WT + (size_t)(n0 + row) * Kd + k; }, sm);
    int b = m0 / LALL, pos0 = m0 - b * LALL;
    bool lat = pos0 >= LC;
    float* wl = (float*)sm + wave * 2048;
    if (isq || wn == 0) {
      if (isq && lat) {
#pragma unroll
        for (int ni = 0; ni < 2; ++ni) {
          int col0 = n0 + wn * 64 + ni * 32;
          if (col0 % 96 == 64) {
#pragma unroll
            for (int mi = 0; mi < 2; ++mi)
#pragma unroll
              for (int i = 0; i < 16; ++i) {
                int pos = pos0 + wm * 64 + mi * 32 + crow(i, h);
                float v = acc[mi][ni][i];
                float vp = __shfl_xor(v, 8);
                acc[mi][ni][i] = rope_apply(r, v, vp, pos - LC);
              }
          }
        }
      }
      const int c0 = wn * 64 + (lane & 7) * 8;
      bfr* dst;
      int rstride;
      float oscale;
      if (isq) {
        int col = n0 + c0;
        int hh = col / 96, d = col - hh * 96;
        dst = Q + ((size_t)(b * NH + hh) * LALL) * DQK + d;
        rstride = DQK;
        oscale = QSCALE;
      } else {
        int hh = n0 >> 7;
        dst = Kb + ((size_t)(b * NH + hh) * LALL) * 64 + c0;
        rstride = 64;
        oscale = 1.f;
      }
#pragma unroll
      for (int mi = 0; mi < 2; ++mi) {
        float4 lo[4], hi[4];
        stage_half8(acc, mi, wl, lo, hi, lane);
#pragma unroll
        for (int c = 0; c < 4; ++c) {
          int row = wm * 64 + mi * 32 + c * 8 + (lane >> 3);
          float sc = sm->rs[row] * oscale;
          uint4 o;
          o.x = pk2(lo[c].x * sc, lo[c].y * sc);
          o.y = pk2(lo[c].z * sc, lo[c].w * sc);
          o.z = pk2(hi[c].x * sc, hi[c].y * sc);
          o.w = pk2(hi[c].z * sc, hi[c].w * sc);
          *(uint4*)(dst + (size_t)(pos0 + row) * rstride) = o;
        }
      }
    } else {
      int hh = n0 >> 7;
#pragma unroll
      for (int mi = 0; mi < 2; ++mi)
#pragma unroll
        for (int ni = 0; ni < 2; ++ni) {
          int dvv = ni * 32 + r;
#pragma unroll
          for (int g4 = 0; g4 < 4; ++g4) {
            int row = wm * 64 + mi * 32 + 8 * g4 + 4 * h;
            int pos = pos0 + row;
            uint2 o;
            o.x = pk2(acc[mi][ni][4 * g4 + 0] * sm->rs[row + 0], acc[mi][ni][4 * g4 + 1] * sm->rs[row + 1]);
            o.y = pk2(acc[mi][ni][4 * g4 + 2] * sm->rs[row + 2], acc[mi][ni][4 * g4 + 3] * sm->rs[row + 3]);
            *(uint2*)(VT + (((size_t)(b * NH + hh)) * DV + dvv) * LALL + pos) = o;
          }
        }
    }
    __syncthreads();
  }
}

constexpr int KLD = 104;
constexpr int VLD = 68;
struct AttnSmem {
  bfr K[64 * KLD];
  bfr V[64 * VLD];
};
static_assert(sizeof(AttnSmem) <= SMEM_BYTES, "smem");

DI void attn_item(const Params& p, AttnSmem* sm, int bh, int qpos0, int nkeys) {
  WAVE_IDS
  const bfr* Q = (const bfr*)p.out;
  const bfr* Kg = (const bfr*)(p.ws + O_K) + (size_t)bh * LALL * 64;
  const bfr* KRg = (const bfr*)(p.ws + O_KR) + (size_t)(bh / NH) * LALL * 32;
  const bfr* Vg = (const bfr*)(p.ws + O_VT) + (size_t)bh * DV * LALL;
  const int qpos = qpos0 + wave * 32 + r;
  bf16x8 bq[6];
  {
    const bfr* qp = Q + ((size_t)bh * LALL + qpos) * DQK + 8 * h;
#pragma unroll
    for (int s = 0; s < 6; ++s) bq[s] = *(const bf16x8*)(qp + 16 * s);
  }
  f32x16 o[2];
#pragma unroll
  for (int d = 0; d < 2; ++d)
#pragma unroll
    for (int i = 0; i < 16; ++i) o[d][i] = 0.f;
  float mrun = 0.f, lrun = 0.f;
  uint4 kv0, kv1, kv2, vv0, vv1;
  const int kr0 = tid / 12, kc0 = (tid - kr0 * 12) * 8;
  const int kr1 = (tid + 256) / 12, kc1 = (tid + 256 - kr1 * 12) * 8;
  const int kr2 = (tid + 512) / 12, kc2 = (tid + 512 - kr2 * 12) * 8;
  const int vr0 = tid >> 3, vc0 = (tid & 7) * 8;
  const bfr* kp0 = kc0 < 64 ? Kg + (size_t)kr0 * 64 + kc0 : KRg + (size_t)kr0 * 32 + (kc0 - 64);
  const bfr* kp1 = kc1 < 64 ? Kg + (size_t)kr1 * 64 + kc1 : KRg + (size_t)kr1 * 32 + (kc1 - 64);
  const bfr* kp2 = kc2 < 64 ? Kg + (size_t)kr2 * 64 + kc2 : KRg + (size_t)kr2 * 32 + (kc2 - 64);
  const int ks0 = kc0 < 64 ? 64 : 32, ks1 = kc1 < 64 ? 64 : 32, ks2 = kc2 < 64 ? 64 : 32;
#define AT_GLOAD(KEY0_)                                                          \
  {                                                                              \
    const int key0_ = (KEY0_);                                                   \
    kv0 = *(const uint4*)(kp0 + (size_t)key0_ * ks0);                            \
    kv1 = *(const uint4*)(kp1 + (size_t)key0_ * ks1);                            \
    kv2 = *(const uint4*)(kp2 + (size_t)key0_ * ks2);                            \
    vv0 = *(const uint4*)(Vg + (size_t)vr0 * LALL + key0_ + vc0);                \
    vv1 = *(const uint4*)(Vg + (size_t)(vr0 + 32) * LALL + key0_ + vc0);         \
  }
#define AT_LSTORE()                                                              \
  {                                                                              \
    *(uint4*)(sm->K + kr0 * KLD + kc0) = kv0;                                    \
    *(uint4*)(sm->K + kr1 * KLD + kc1) = kv1;                                    \
    *(uint4*)(sm->K + kr2 * KLD + kc2) = kv2;                                    \
    uint2* d0_ = (uint2*)(sm->V + vr0 * VLD + vc0);                              \
    d0_[0] = make_uint2(vv0.x, vv0.y);                                           \
    d0_[1] = make_uint2(vv0.z, vv0.w);                                           \
    uint2* d1_ = (uint2*)(sm->V + (vr0 + 32) * VLD + vc0);                       \
    d1_[0] = make_uint2(vv1.x, vv1.y);                                           \
    d1_[1] = make_uint2(vv1.z, vv1.w);                                           \
  }
  const int NTI = nkeys / 64;
  AT_GLOAD(0)
  for (int it = 0; it < NTI; ++it) {
    AT_LSTORE()
    __syncthreads();
    if (it + 1 < NTI) AT_GLOAD((it + 1) * 64)
    SCHED_FENCE();
    f32x16 st[2];
    const float ninit = -mrun;
#pragma unroll
    for (int kb = 0; kb < 2; ++kb)
#pragma unroll
      for (int i = 0; i < 16; ++i) st[kb][i] = ninit;
#pragma unroll
    for (int s = 0; s < 6; ++s) {
#pragma unroll
      for (int kb = 0; kb < 2; ++kb) {
        bf16x8 ka = *(const bf16x8*)(sm->K + (kb * 32 + r) * KLD + 16 * s + 8 * h);
        st[kb] = MFMA32(ka, bq[s], st[kb]);
      }
    }
    float mx = fmaxf(fmaxf(st[0][0], st[0][1]), st[1][0]);
#pragma unroll
    for (int i = 2; i < 16; i += 2) mx = fmaxf(fmaxf(mx, st[0][i]), st[0][i + 1]);
#pragma unroll
    for (int i = 1; i < 15; i += 2) mx = fmaxf(fmaxf(mx, st[1][i]), st[1][i + 1]);
    mx = fmaxf(mx, st[1][15]);
    mx = fmaxf(mx, __shfl_xor(mx, 32));
    const bool need = (it == 0) || (mx > 8.f);
    if (__any(need)) {
      const float delta = need ? mx : 0.f;
      const float alpha = __builtin_amdgcn_exp2f(-delta);
      mrun += delta;
      lrun *= alpha;
#pragma unroll
      for (int d = 0; d < 2; ++d)
#pragma unroll
        for (int i = 0; i < 16; ++i) o[d][i] *= alpha;
#pragma unroll
      for (int kb = 0; kb < 2; ++kb)
#pragma unroll
        for (int i = 0; i < 16; ++i) st[kb][i] -= delta;
    }
    float ps = 0.f;
#pragma unroll
    for (int kb = 0; kb < 2; ++kb)
#pragma unroll
      for (int i = 0; i < 16; ++i) {
        float e = __builtin_amdgcn_exp2f(st[kb][i]);
        st[kb][i] = e;
        ps += e;
      }
    lrun += ps;
#pragma unroll
    for (int kb = 0; kb < 2; ++kb)
#pragma unroll
      for (int s2 = 0; s2 < 2; ++s2) {
        unsigned pw[4];
#pragma unroll
        for (int j = 0; j < 4; ++j) pw[j] = pk2(st[kb][8 * s2 + 2 * j], st[kb][8 * s2 + 2 * j + 1]);
        bf16x8 pb;
        {
          uint4 t = make_uint4(pw[0], pw[1], pw[2], pw[3]);
          pb = __builtin_bit_cast(bf16x8, t);
        }
#pragma unroll
        for (int d = 0; d < 2; ++d) {
          const bfr* vp = sm->V + (d * 32 + r) * VLD + kb * 32 + 16 * s2 + 4 * h;
          uint2 lo = *(const uint2*)vp;
          uint2 hi = *(const uint2*)(vp + 8);
          uint4 t = make_uint4(lo.x, lo.y, hi.x, hi.y);
          bf16x8 va = __builtin_bit_cast(bf16x8, t);
          o[d] = MFMA32(va, pb, o[d]);
        }
      }
    __syncthreads();
  }
  float ltot = lrun + __shfl_xor(lrun, 32);
  float inv = 1.f / ltot;
  int b = bh / NH, hh = bh - b * NH;
  size_t tok = (size_t)b * LALL + qpos;
  const bfr* SZ = (const bfr*)(p.ws + O_SZ0) + tok * 1024 + hh * 64;
  bfr* OG = (bfr*)(p.ws + O_OG) + tok * 1024 + hh * 64;
#pragma unroll
  for (int d = 0; d < 2; ++d)
#pragma unroll
    for (int g4 = 0; g4 < 4; ++g4) {
      int dv0 = d * 32 + 8 * g4 + 4 * h;
      uint2 z = *(const uint2*)(SZ + dv0);
      float z0 = __uint_as_float(z.x << 16), z1 = __uint_as_float(z.x & 0xffff0000u);
      float z2 = __uint_as_float(z.y << 16), z3 = __uint_as_float(z.y & 0xffff0000u);
      uint2 ov;
      ov.x = pk2(o[d][4 * g4 + 0] * inv * z0, o[d][4 * g4 + 1] * inv * z1);
      ov.y = pk2(o[d][4 * g4 + 2] * inv * z2, o[d][4 * g4 + 3] * inv * z3);
      *(uint2*)(OG + dv0) = ov;
    }
}

DI void phase_o3(const Params& p, char* smem) {
  AttnSmem* sm = (AttnSmem*)smem;
  const int xcd = blockIdx.x & 7, local = blockIdx.x >> 3, nloc = gridDim.x >> 3;
  for (int j = local; j < 256; j += nloc) {
    int u = xcd * 256 + j;
    attn_item(p, sm, u >> 4, LC + (u & 15) * 128, LALL);
  }
  for (int j = local; j < 32; j += nloc) {
    int u = xcd * 32 + j;
    attn_item(p, sm, u >> 1, (u & 1) * 128, LC);
  }
}

template <int LAYER>
DI void phase_oproj(const Params& p, char* smem) {
  GemmSmem* sm = (GemmSmem*)smem;
  WAVE_IDS
  constexpr int NROWS = LAYER == 0 ? TOK : NLAT;
  const int NT = 8, units = (NROWS / 128) * NT;
  const bfr* Ab = (const bfr*)(p.ws + (LAYER == 0 ? O_OG : O_Y2));
  const bfr* WT = (const bfr*)(p.ws + (LAYER == 0 ? O_WT_OUT0 : O_WT_OUT1));
  float* part = (float*)(p.ws + (LAYER == 0 ? O_PART1 : O_PART2));
  auto Aof = [&](int m0) { return [=](int row, int k) { return Ab + (size_t)(m0 + row) * 1024 + k; }; };
  auto Bof = [&](int n0) { return [=](int row, int k) { return WT + (size_t)(n0 + row) * 1024 + k; }; };
  GSTAGE_DECL;
  if ((int)blockIdx.x < units) {
    const int us = xcd_swz(blockIdx.x, NT);
    gemm_prefetch(GSTAGE_ARGS, Aof((us / NT) * 128), Bof((us % NT) * 128));
  }
  for (int u = blockIdx.x; u < units; u += gridDim.x) {
    const int us = xcd_swz(u, NT);
    int mt = us / NT, nt = us - mt * NT;
    int m0 = mt * 128, n0 = nt * 128;
    f32x16 acc[2][2];
    zero_acc(acc);
    gemm_main(acc, 32, Aof(m0), Bof(n0), sm, GSTAGE_ARGS);
    if (u + (int)gridDim.x < units) {
      const int us1 = xcd_swz(u + gridDim.x, NT);
      gemm_prefetch(GSTAGE_ARGS, Aof((us1 / NT) * 128), Bof((us1 % NT) * 128));
    }
    const float* xin;
    float* xout;
    const float* gt;
    if (LAYER == 0) {
      xin = xrow0(p, m0);
      xout = xrow1(p, m0);
      gt = modrow(p, 0, m0) + 2048;
    } else {
      xin = p.out + (size_t)m0 * 1024;
      xout = p.out + (size_t)m0 * 1024;
      gt = (const float*)(p.ws + O_MOD) + ((size_t)(9 + (m0 >> 11))) * 3072 + 2048;
    }
    float tot = 0.f;
#pragma unroll
    for (int mi = 0; mi < 2; ++mi) {
      float sq[16];
#pragma unroll
      for (int i = 0; i < 16; ++i) sq[i] = 0.f;
#pragma unroll
      for (int ni = 0; ni < 2; ++ni) {
        int col = n0 + wn * 64 + ni * 32 + r;
        float g = gt[col];
        float xv[16];
#pragma unroll
        for (int i = 0; i < 16; ++i) xv[i] = xin[(size_t)(wm * 64 + mi * 32 + crow(i, h)) * 1024 + col];
        SCHED_FENCE();
#pragma unroll
        for (int i = 0; i < 16; ++i) {
          int row = wm * 64 + mi * 32 + crow(i, h);
          float v = xv[i] + g * acc[mi][ni][i];
          xout[(size_t)row * 1024 + col] = v;
          sq[i] += v * v;
        }
        SCHED_FENCE();
      }
      if (LAYER == 1) {
        float t = transpose_reduce16(sq, lane);
        t += __shfl_xor(t, 16);
        if (((lane >> 4) & 1) == mi) tot = t;
      }
    }
    int idx = lane & 31;
    int row = m0 + wm * 64 + (idx >> 4) * 32 + crow(idx & 15, h);
    if (LAYER == 1) part[(size_t)(nt * 2 + wn) * NROWS + row] = tot;
  }
}

DI void phase_o5(const Params& p, char* smem) {
  GemmSmem* sm = (GemmSmem*)smem;
  WAVE_IDS
  const int ULAT = (NLAT / 128) * 16, units = ULAT + (NB * LC / 128) * 8;
  const bfr* WT = (const bfr*)(p.ws + O_WT_IN1);
  bfr* U2 = (bfr*)(p.ws + O_U2);
  bfr* SZ1 = (bfr*)(p.ws + O_SZ1);
  const bfr* Ah = (const bfr*)(p.ws + O_H1);
  auto coords = [&](int u, int& m0, int& n0) {
    if (u < ULAT) {
      const int us = xcd_swz(u, 16);
      int mtl = us >> 4;
      m0 = (mtl >> 4) * LALL + LC + (mtl & 15) * 128;
      n0 = (us & 15) * 128;
    } else {
      const int us = xcd_swz(u - ULAT, 8);
      int mtc = us >> 3;
      m0 = (mtc >> 1) * LALL + (mtc & 1) * 128;
      n0 = (us & 7) * 128;
    }
  };
  auto Aof = [&](int m0) { return [=](int row, int k) { return Ah + (size_t)(m0 + row) * 1024 + k; }; };
  auto Bof = [&](int n0) { return [=](int row, int k) { return WT + (size_t)(n0 + row) * 1024 + k; }; };
  GSTAGE_DECL;
  if ((int)blockIdx.x < units) {
    int m1, n1;
    coords(blockIdx.x, m1, n1);
    gemm_prefetch(GSTAGE_ARGS, Aof(m1), Bof(n1));
  }
  for (int u = blockIdx.x; u < units; u += gridDim.x) {
    int m0, n0;
    coords(u, m0, n0);
    int b = m0 / LALL, pos0 = m0 - b * LALL;
    f32x16 acc[2][2];
    zero_acc(acc);
    gemm_main(acc, 32, Aof(m0), Bof(n0), sm, GSTAGE_ARGS);
    if (u + (int)gridDim.x < units) {
      int m1, n1;
      coords(u + gridDim.x, m1, n1);
      gemm_prefetch(GSTAGE_ARGS, Aof(m1), Bof(n1));
    }
#pragma unroll
    for (int mi = 0; mi < 2; ++mi)
#pragma unroll
      for (int ni = 0; ni < 2; ++ni) {
        int col = n0 + wn * 64 + ni * 32 + r;
#pragma unroll
        for (int i = 0; i < 16; ++i) {
          int row = wm * 64 + mi * 32 + crow(i, h);
          int tok = m0 + row;
          float v = acc[mi][ni][i];
          if (col < 1024) U2[((size_t)(col >> 4) * TOK + tok) * 16 + (col & 15)] = f2bf(v);
          else SZ1[((size_t)(b * SEQ + pos0 + row - LC)) * 1024 + (col - 1024)] = f2bf(silu_f(v));
          SCHED_FENCE();
        }
      }
  }
}

DI void phase_o6(const Params& p, char* smem) {
  GemmSmem* sm = (GemmSmem*)smem;
  WAVE_IDS
  const int NROW = NB * NCH;
  const int units = 64 * 5 * 2;
  const bfr* U2 = (const bfr*)(p.ws + O_U2);
  const bfr* WST = (const bfr*)(p.ws + O_WST);
  float* SLOC = (float*)(p.ws + O_SLOC);
  for (int u = blockIdx.x; u < units; u += gridDim.x) {
    const int us = xcd_swz(u, 10);
    int g = us / 10, rem = us - g * 10;
    int mt = rem >> 1, nt = rem & 1;
    int m0 = mt * 128, n0 = nt * 128;
    const bfr* Ag = U2 + (size_t)g * TOK * 16;
    const bfr* Bg = WST + (size_t)g * 256 * 512;
    f32x16 acc[2][2];
    zero_acc(acc);
    gemm_full(
        acc, 16,
        [&](int row, int k) {
          int rr = m0 + row;
          rr = rr < NROW ? rr : NROW - 1;
          return Ag + (size_t)rr * 512 + k;
        },
        [&](int row, int k) { return Bg + (size_t)(n0 + row) * 512 + k; }, sm);
#pragma unroll
    for (int mi = 0; mi < 2; ++mi)
#pragma unroll
      for (int ni = 0; ni < 2; ++ni) {
        int col = n0 + wn * 64 + ni * 32 + r;
#pragma unroll
        for (int i = 0; i < 16; ++i) {
          int row = m0 + wm * 64 + mi * 32 + crow(i, h);
          SLOC[((size_t)g * SLOC_ROWS + row) * 256 + col] = acc[mi][ni][i];
        }
      }
  }
}

DI void phase_o7(const Params& p) {
  const int tidx_ = opaque_tid();
  const float* SLOC = (const float*)(p.ws + O_SLOC);
  bfr* SIN = (bfr*)(p.ws + O_SIN);
  const int total = NB * 64 * 2 * 64;
  for (int idx = blockIdx.x * 256 + tidx_; idx < total; idx += gridDim.x * 256) {
    int pp = idx & 63, dir = (idx >> 6) & 1, g = (idx >> 7) & 63, b = idx >> 13;
    double dt, ar, ai;
    float fr, fi, lr, li;
    s5_disc(p, dir, g, pp, dt, ar, ai, fr, fi);
    s5_pow(dt, ar, ai, TC, lr, li);
    float sr = 0.f, si = 0.f;
#pragma unroll 8
    for (int step = 0; step < NCH; ++step) {
      int cp = dir == 0 ? step : (step < 8 ? 7 - step : NCH - 1 - (step - 8));
      const float* sl = SLOC + ((size_t)g * SLOC_ROWS + b * NCH + cp) * 256 + dir * 128 + pp;
#ifdef PROBE_NOCARRY
      if ((dir == 0 && cp == 8) || (dir == 1 && cp == NCH - 1)) { sr = 0.f; si = 0.f; }
#endif
      if (cp >= 8) {
        bfr* so = SIN + ((size_t)g * (NB * NCHL) + b * NCHL + (cp - 8)) * 256 + dir * 128 + pp;
        so[0] = f2bf(sr);
        so[64] = f2bf(si);
      }
      float lre = sl[0], lim = sl[64];
      float nr = lr * sr - li * si + lre;
      float ni = lr * si + li * sr + lim;
      sr = nr;
      si = ni;
    }
  }
}

DI void phase_o8(const Params& p, char* smem) {
  GemmSmem* sm = (GemmSmem*)smem;
  WAVE_IDS
  const int units = 64 * 4 * 4;
  const bfr* U2 = (const bfr*)(p.ws + O_U2);
  const bfr* SIN = (const bfr*)(p.ws + O_SIN);
  const bfr* KTAB = (const bfr*)(p.ws + O_KTAB);
  const bfr* VOP = (const bfr*)(p.ws + O_VOP);
  bfr* YG = (bfr*)(p.ws + O_YG);
  for (int u = blockIdx.x; u < units; u += gridDim.x) {
    const int us = xcd_swz(u, 16);
    int g = us >> 4, mt = (us >> 2) & 3, nt = us & 3;
    int m0 = mt * 128, n0 = nt * 128;
    const bfr* Ug = U2 + (size_t)g * TOK * 16;
    f32x16 acc[2][2];
    zero_acc(acc);
    gemm_full(
        acc, 16,
        [&](int row, int k) {
          int rr = m0 + row;
          int b = rr >> 6, n = rr & 63;
          return Ug + ((size_t)b * LALL + LC + n * TC) * 16 + k;
        },
        [&](int row, int k) {
          int m = n0 + row;
          int t = m >> 4, c = m & 15;
          return KTAB + (((size_t)g * 63 + (t + 31)) * 16 + c) * 16 - (k >> 4) * 256 + (k & 15);
        },
        sm);
    gemm_full(
        acc, 8, [&](int row, int k) { return SIN + ((size_t)g * (NB * NCHL) + m0 + row) * 256 + k; },
        [&](int row, int k) { return VOP + ((size_t)g * 512 + n0 + row) * 256 + k; }, sm);
    {
      float* wl = (float*)sm + wave * 2048;
      const int mcol = n0 + wn * 64 + (lane & 7) * 8;
      const int t = mcol >> 4, c0 = mcol & 15;
      const int ch = g * 16 + c0;
      const float4 d0 = *(const float4*)(p.in[I_S5D] + ch), d1 = *(const float4*)(p.in[I_S5D] + ch + 4);
#pragma unroll
      for (int mi = 0; mi < 2; ++mi) {
        float4 lo[4], hi[4];
        stage_half8(acc, mi, wl, lo, hi, lane);
        uint4 uq[4];
#pragma unroll
        for (int c = 0; c < 4; ++c) {
          int rr = m0 + wm * 64 + mi * 32 + c * 8 + (lane >> 3);
          int b = rr >> 6, n = rr & 63;
          uq[c] = *(const uint4*)(Ug + ((size_t)b * LALL + LC + n * TC + t) * 16 + c0);
        }
        SCHED_FENCE();
#pragma unroll
        for (int c = 0; c < 4; ++c) {
          int rr = m0 + wm * 64 + mi * 32 + c * 8 + (lane >> 3);
          int b = rr >> 6, n = rr & 63;
          float4 u0 = bf4_to_f4(make_uint2(uq[c].x, uq[c].y)), u1 = bf4_to_f4(make_uint2(uq[c].z, uq[c].w));
          uint4 o;
          o.x = pk2(gelu_tanh(lo[c].x + d0.x * u0.x), gelu_tanh(lo[c].y + d0.y * u0.y));
          o.y = pk2(gelu_tanh(lo[c].z + d0.z * u0.z), gelu_tanh(lo[c].w + d0.w * u0.w));
          o.z = pk2(gelu_tanh(hi[c].x + d1.x * u1.x), gelu_tanh(hi[c].y + d1.y * u1.y));
          o.w = pk2(gelu_tanh(hi[c].z + d1.z * u1.z), gelu_tanh(hi[c].w + d1.w * u1.w));
          *(uint4*)(YG + ((size_t)(b * SEQ + n * TC + t)) * 1024 + ch) = o;
        }
        SCHED_FENCE();
      }
      __syncthreads();
    }
  }
}

DI void phase_o9(const Params& p, char* smem) {
  GemmSmem* sm = (GemmSmem*)smem;
  WAVE_IDS
  const int NT = 8, units = (NLAT / 128) * NT;
  const bfr* YG = (const bfr*)(p.ws + O_YG);
  const bfr* SZ1 = (const bfr*)(p.ws + O_SZ1);
  const bfr* WT = (const bfr*)(p.ws + O_WT_GLU);
  bfr* Y2 = (bfr*)(p.ws + O_Y2);
  auto Aof = [&](int m0) { return [=](int row, int k) { return YG + (size_t)(m0 + row) * 1024 + k; }; };
  auto Bof = [&](int n0) { return [=](int row, int k) { return WT + (size_t)(n0 + row) * 1024 + k; }; };
  GSTAGE_DECL;
  if ((int)blockIdx.x < units) {
    const int us = xcd_swz(blockIdx.x, NT);
    gemm_prefetch(GSTAGE_ARGS, Aof((us / NT) * 128), Bof((us % NT) * 128));
  }
  for (int u = blockIdx.x; u < units; u += gridDim.x) {
    const int us = xcd_swz(u, NT);
    int mt = us / NT, nt = us - mt * NT;
    int m0 = mt * 128, n0 = nt * 128;
    f32x16 acc[2][2];
    zero_acc(acc);
    gemm_main(acc, 32, Aof(m0), Bof(n0), sm, GSTAGE_ARGS);
    if (u + (int)gridDim.x < units) {
      const int us1 = xcd_swz(u + gridDim.x, NT);
      gemm_prefetch(GSTAGE_ARGS, Aof((us1 / NT) * 128), Bof((us1 % NT) * 128));
    }
    float* wl = (float*)sm + wave * 2048;
    const int ccol = n0 + wn * 64 + (lane & 15) * 4;
    const float4 bg = *(const float4*)(p.in[I_BGLU] + ccol);
#pragma unroll
    for (int mi = 0; mi < 2; ++mi) {
      float4 v[8];
      stage_half(acc, mi, wl, v, lane);
      uint2 yv[8], zv[8];
#pragma unroll
      for (int c = 0; c < 8; ++c) {
        size_t o = (size_t)(m0 + wm * 64 + mi * 32 + c * 4 + (lane >> 4)) * 1024 + ccol;
        yv[c] = *(const uint2*)(YG + o);
        zv[c] = *(const uint2*)(SZ1 + o);
      }
      SCHED_FENCE();
#pragma unroll
      for (int c = 0; c < 8; ++c) {
        size_t o = (size_t)(m0 + wm * 64 + mi * 32 + c * 4 + (lane >> 4)) * 1024 + ccol;
        float4 y = bf4_to_f4(yv[c]), z = bf4_to_f4(zv[c]);
        float4 ov;
        ov.x = y.x * sigmoid_f(v[c].x + bg.x) * z.x;
        ov.y = y.y * sigmoid_f(v[c].y + bg.y) * z.y;
        ov.z = y.z * sigmoid_f(v[c].z + bg.z) * z.z;
        ov.w = y.w * sigmoid_f(v[c].w + bg.w) * z.w;
        *(uint2*)(Y2 + o) = f4_to_bf4(ov);
      }
      SCHED_FENCE();
    }
    __syncthreads();
  }
}

#define XB_TMO      128
#define XB_XCNT(j)  (256  + 64 * (j))
#define XB_XSUB(j)  (1280 + 64 * (j))
#define XB_XGEN(j)  (2304 + 64 * (j))
#define XB_TOP      3328
#define XB_TOPGEN   3392
#define XCD_BAR_WORDS 3456
#define XB_SPIN_CAP (1u << 18)
#define LAS __attribute__((address_space(3)))
DI unsigned xb_ld(unsigned* p) { return __hip_atomic_load(p, __ATOMIC_RELAXED, __HIP_MEMORY_SCOPE_AGENT); }
DI unsigned xb_add(unsigned* p, unsigned v) { return __hip_atomic_fetch_add(p, v, __ATOMIC_RELAXED, __HIP_MEMORY_SCOPE_AGENT); }
DI unsigned xb_xcc_id() { return (unsigned)__builtin_amdgcn_s_getreg((3 << 11) | 20) & 0xFu; }
#define XB_SPIN(cond, bar) do { unsigned _sp = 0; while (cond) { __builtin_amdgcn_s_sleep(1); \
    if ((++_sp & 255u) == 0u) { if (xb_ld(&(bar)[XB_TMO])) break; if (_sp > XB_SPIN_CAP) { atomicAdd(&(bar)[XB_TMO], 1u); break; } } } } while (0)
struct XcdBarrier {
  unsigned* bar;
  unsigned x;
  volatile LAS unsigned* st;
};
DI XcdBarrier xcd_barrier_post(unsigned* bar, volatile LAS unsigned* st) {
  XcdBarrier b;
  b.bar = bar;
  b.x = xb_xcc_id();
  b.st = st;
  if (threadIdx.x == 0) (void)xb_add(&bar[XB_XCNT(b.x)], 1u);
  return b;
}
DI void xcd_barrier_complete(unsigned* bar, unsigned x, unsigned& nloc, unsigned& nx) {
  const unsigned G = gridDim.x * gridDim.y * gridDim.z;
  unsigned sum, cnt, mine, sp = 0u;
  for (;;) {
    sum = 0u; cnt = 0u; mine = 0u;
#pragma unroll
    for (unsigned j = 0; j < 16; ++j) {
      const unsigned c = xb_ld(&bar[XB_XCNT(j)]);
      sum += c;
      cnt += (c > 0u) ? 1u : 0u;
      mine = (j == x) ? c : mine;
    }
    if (sum == G) break;
    __builtin_amdgcn_s_sleep(1);
    if ((++sp & 255u) == 0u) {
      if (xb_ld(&bar[XB_TMO])) break;
      if (sp > XB_SPIN_CAP) { atomicAdd(&bar[XB_TMO], 1u); break; }
    }
  }
  nloc = mine > 0u ? mine : 1u;
  nx = cnt > 0u ? cnt : 1u;
}
DI void xcd_barrier(const XcdBarrier& b) {
  asm volatile("s_waitcnt vmcnt(0)" ::: "memory");
  __syncthreads();
  if (threadIdx.x == 0) {
    unsigned* bar = b.bar;
    __builtin_amdgcn_s_waitcnt(0);
    unsigned nloc = b.st[0], nx = b.st[1];
    if (nloc == 0u) {
      xcd_barrier_complete(bar, b.x, nloc, nx);
      b.st[0] = nloc;
      b.st[1] = nx;
    }
    const unsigned old = xb_add(&bar[XB_XSUB(b.x)], 1u);
    const unsigned gen = old / nloc;
    if (old + 1u == (gen + 1u) * nloc) {
      __builtin_amdgcn_fence(__ATOMIC_RELEASE, "agent");
      asm volatile("s_waitcnt vmcnt(0)" ::: "memory");
      const unsigned og = xb_add(&bar[XB_TOP], 1u);
      const unsigned tg = og / nx;
      if (og + 1u == (tg + 1u) * nx) xb_add(&bar[XB_TOPGEN], 1u);
      else XB_SPIN(xb_ld(&bar[XB_TOPGEN]) == tg, bar);
      __builtin_amdgcn_fence(__ATOMIC_ACQUIRE, "agent");
      xb_add(&bar[XB_XGEN(b.x)], 1u);
      asm volatile("s_waitcnt vmcnt(0)" ::: "memory");
    } else {
      XB_SPIN(xb_ld(&bar[XB_XGEN(b.x)]) == gen, bar);
      __builtin_amdgcn_fence(__ATOMIC_ACQUIRE, "agent");
      asm volatile("s_waitcnt vmcnt(0)" ::: "memory");
    }
  }
  __syncthreads();
}

DI void run_phase(const Params& p, int ph, char* smem) {
  switch (ph) {
#if !defined(ONLY) || ONLY == 0
    case PH_PREP: phase_prep(p, smem); break;
#endif
#if !defined(ONLY) || ONLY == 1
    case PH_FINAL: phase_final(p); break;
#endif
#if !defined(ONLY) || ONLY == 2
    case PH_O1: phase_o1(p, smem); break;
#endif
#if !defined(ONLY) || ONLY == 3
    case PH_O2: phase_o2(p, smem); break;
#endif
#if !defined(ONLY) || ONLY == 4
    case PH_O3: phase_o3(p, smem); break;
#endif
#if !defined(ONLY) || ONLY == 5
    case PH_O4: phase_oproj<0>(p, smem); break;
#endif
#if !defined(ONLY) || ONLY == 6
    case PH_O5: phase_o5(p, smem); break;
#endif
#if !defined(ONLY) || ONLY == 7
    case PH_O6: phase_o6(p, smem); break;
#endif
#if !defined(ONLY) || ONLY == 8
    case PH_O7: phase_o7(p); break;
#endif
#if !defined(ONLY) || ONLY == 9
    case PH_O8: phase_o8(p, smem); break;
#endif
#if !defined(ONLY) || ONLY == 10
    case PH_O9: phase_o9(p, smem); break;
#endif
#if !defined(ONLY) || ONLY == 11
    case PH_O10: phase_oproj<1>(p, smem); break;
#endif
    case PH_H0: phase_hconv<0>(p); break;
    case PH_H1: phase_hconv<1>(p); break;
    default: break;
  }
}

__global__ void __launch_bounds__(256, 2) mega_one(Params p, int ph) {
  __shared__ __attribute__((aligned(16))) char smem[SMEM_BYTES];
  run_phase(p, ph, smem);
}

#if !defined(ONLY) && SINGLE_LAUNCH
__global__ void __launch_bounds__(256, 2) mega(Params p) {
  __shared__ __attribute__((aligned(16))) char smem[SMEM_BYTES];
  __shared__ uint4 xb_words;
  if (threadIdx.x == 0) xb_words = make_uint4(0u, 0u, 0u, 0u);
  __syncthreads();
  if (p.nprog < 0) cg::this_grid().sync();
  const XcdBarrier xb = xcd_barrier_post((unsigned*)(p.ws + O_BAR), (volatile LAS unsigned*)&xb_words);
  cg::grid_group grid = cg::this_grid();
#if !defined(OMIT) || OMIT != 0
  phase_prep(p, smem);
#endif
  xcd_barrier(xb);
#if (DUP >> 0) & 1
  phase_prep(p, smem);
  xcd_barrier(xb);
#endif
  phase_hconv<0>(p);
  xcd_barrier(xb);
#if !defined(OMIT) || OMIT != 1
  phase_o1(p, smem);
#endif
  xcd_barrier(xb);
#if (DUP >> 1) & 1
  phase_o1(p, smem);
  xcd_barrier(xb);
#endif
#if !defined(OMIT) || OMIT != 2
  phase_o2(p, smem);
#endif
  xcd_barrier(xb);
#if (DUP >> 2) & 1
  phase_o2(p, smem);
  xcd_barrier(xb);
#endif
#if !defined(OMIT) || OMIT != 3
  phase_o3(p, smem);
#endif
  xcd_barrier(xb);
#if (DUP >> 3) & 1
  phase_o3(p, smem);
  xcd_barrier(xb);
#endif
#if !defined(OMIT) || OMIT != 4
  phase_oproj<0>(p, smem);
#endif
  xcd_barrier(xb);
#if (DUP >> 4) & 1
  phase_oproj<0>(p, smem);
  xcd_barrier(xb);
#endif
  phase_hconv<1>(p);
  xcd_barrier(xb);
#if !defined(OMIT) || OMIT != 5
  phase_o5(p, smem);
#endif
  xcd_barrier(xb);
#if (DUP >> 5) & 1
  phase_o5(p, smem);
  xcd_barrier(xb);
#endif
#if !defined(OMIT) || OMIT != 6
  phase_o6(p, smem);
#endif
  xcd_barrier(xb);
#if (DUP >> 6) & 1
  phase_o6(p, smem);
  xcd_barrier(xb);
#endif
#if !defined(OMIT) || OMIT != 7
  phase_o7(p);
#endif
  xcd_barrier(xb);
#if (DUP >> 7) & 1
  phase_o7(p);
  xcd_barrier(xb);
#endif
#if !defined(OMIT) || OMIT != 8
  phase_o8(p, smem);
#endif
  xcd_barrier(xb);
#if (DUP >> 8) & 1
  phase_o8(p, smem);
  xcd_barrier(xb);
#endif
#if !defined(OMIT) || OMIT != 9
  phase_o9(p, smem);
#endif
  xcd_barrier(xb);
#if (DUP >> 9) & 1
  phase_o9(p, smem);
  xcd_barrier(xb);
#endif
#if !defined(OMIT) || OMIT != 10
  phase_oproj<1>(p, smem);
#endif
  xcd_barrier(xb);
#if !defined(OMIT) || OMIT != 11
  phase_final(p);
#endif
}
#else
__global__ void mega(Params p) {}
#endif


extern "C" void kernel_launch(void* const* d_in, const int* in_sizes, int n_in, void* d_out, int out_size, void* d_ws,
                              size_t ws_size, hipStream_t stream) {
  static int grid_blocks = 0;
  if (!grid_blocks) {
    int dev = 0, cus = 0, per_cu = 0;
    hipGetDevice(&dev);
    hipDeviceGetAttribute(&cus, hipDeviceAttributeMultiprocessorCount, dev);
#if SINGLE_LAUNCH
    hipOccupancyMaxActiveBlocksPerMultiprocessor(&per_cu, mega, 256, 0);
#else
    hipOccupancyMaxActiveBlocksPerMultiprocessor(&per_cu, mega_one, 256, 0);
#endif
    if (per_cu < 1) per_cu = 1;
    if (per_cu > 2) per_cu = 2;
    grid_blocks = cus * per_cu;
  }
  if (ws_size < WS_NEED || n_in < N_INPUTS) {
    fprintf(stderr, "workspace too small or bad inputs: %zu < %zu\n", ws_size, (size_t)WS_NEED);
    return;
  }
  Params p{};
  for (int i = 0; i < N_INPUTS; ++i) p.in[i] = (const float*)d_in[i];
  p.out = (float*)d_out;
  p.ws = (char*)d_ws;
#ifndef PROG
#define PROG PH_PREP, PH_H0, PH_O1, PH_O2, PH_O3, PH_O4, PH_H1, PH_O5, PH_O6, PH_O7, PH_O8, PH_O9, PH_O10, PH_FINAL
#endif
  const int prog[] = {PROG};
  p.nprog = (int)(sizeof(prog) / sizeof(int));
  for (int i = 0; i < p.nprog; ++i) p.prog[i] = prog[i];
#if SINGLE_LAUNCH
  hipMemsetAsync((char*)d_ws + O_BAR, 0, BAR_BYTES, stream);
  void* args[] = {&p};
  hipError_t e = hipLaunchCooperativeKernel((void*)mega, dim3(grid_blocks), dim3(256), args, 0, stream);
  if (e != hipSuccess) fprintf(stderr, "cooperative launch failed: %s (grid %d)\n", hipGetErrorString(e), grid_blocks);
#else
  for (int i = 0; i < p.nprog; ++i) {
    mega_one<<<dim3(grid_blocks), dim3(256), 0, stream>>>(p, p.prog[i]);
  }
#endif
}
```

```cpp
#include <hip/hip_runtime.h>
#include <hip/hip_cooperative_groups.h>
#include <cstdio>
namespace cg = cooperative_groups;
#ifndef DUP
#define DUP 0
#endif
#ifndef USE_NAIVE
#define USE_NAIVE 0
#endif
#ifndef SINGLE_LAUNCH
#define SINGLE_LAUNCH 1
#endif

#define DI __device__ __forceinline__
typedef unsigned short bfr;

constexpr int D = 1024, NB = 8, SEQ = 2048, LC = 256, LALL = 2304;
constexpr int TOK = NB * LALL;
constexpr int NLAT = NB * SEQ;
constexpr int NH = 16, DQK = 96, DV = 64;
constexpr int NIN0 = 1440, NIN1 = 2048;
constexpr float EPS = 1e-6f;
constexpr float QSCALE = 0.10206207261596577f * 1.4426950408889634f;
constexpr int TC = 32;
constexpr int NCH = LALL / TC;
constexpr int NCHL = SEQ / TC;

enum { I_X = 0, I_C, I_CTX, I_CCTX, I_ADAW, I_ADAB, I_NORMG, I_WIN0, I_QNORM, I_WUQ, I_KVNORM, I_WUKV, I_WOUT0,
       I_WIN1, I_ARE, I_AIM, I_LOGSTEP, I_BRE, I_BIM, I_CRE, I_CIM, I_S5D, I_WGLU, I_BGLU, I_WOUT1, I_FINALG, N_INPUTS };

constexpr size_t al256(size_t x) { return (x + 255) & ~(size_t)255; }
constexpr size_t O_WT_IN0 = 0;
constexpr size_t O_WT_UQ = O_WT_IN0 + al256((size_t)NIN0 * 1024 * 2);
constexpr size_t O_WT_UKV = O_WT_UQ + al256((size_t)1536 * 256 * 2);
constexpr size_t O_WT_OUT0 = O_WT_UKV + al256((size_t)2048 * 128 * 2);
constexpr size_t O_WT_IN1 = O_WT_OUT0 + al256((size_t)1024 * 1024 * 2);
constexpr size_t O_WT_GLU = O_WT_IN1 + al256((size_t)2048 * 1024 * 2);
constexpr size_t O_WT_OUT1 = O_WT_GLU + al256((size_t)1024 * 1024 * 2);
constexpr size_t O_MOD = O_WT_OUT1 + al256((size_t)1024 * 1024 * 2);
constexpr size_t O_RS0 = O_MOD + al256((size_t)2 * 9 * 3072 * 4);
constexpr size_t O_PART1 = O_RS0 + al256((size_t)TOK * 4);
constexpr size_t O_PART2 = O_PART1 + al256((size_t)16 * TOK * 4);
constexpr size_t O_X1CTX = O_PART2 + al256((size_t)16 * NLAT * 4);
constexpr size_t O_KTAB = O_X1CTX + al256((size_t)NB * LC * 1024 * 4);
constexpr size_t O_WST = O_KTAB + al256((size_t)64 * 63 * 256 * 2);
constexpr size_t O_VOP = O_WST + al256((size_t)64 * 256 * 512 * 2);
constexpr size_t O_BAR = O_VOP + al256((size_t)64 * 512 * 256 * 2);
constexpr size_t BAR_BYTES = 3456 * 4;
constexpr size_t O_LAYER = O_BAR + al256(BAR_BYTES);
constexpr size_t O_PC = O_LAYER;
constexpr size_t O_SZ0 = O_PC + al256((size_t)TOK * 384 * 2);
constexpr size_t O_K = O_SZ0 + al256((size_t)TOK * 1024 * 2);
constexpr size_t O_VT = O_K + al256((size_t)NB * NH * LALL * 64 * 2);
constexpr size_t O_OG = O_VT + al256((size_t)NB * NH * DV * LALL * 2);
constexpr size_t O_KR = O_OG + al256((size_t)TOK * 1024 * 2);
constexpr size_t O_END0 = O_KR + al256((size_t)TOK * 32 * 2);
constexpr size_t O_H0 = O_OG;
constexpr size_t O_U2 = O_LAYER;
constexpr size_t O_SZ1 = O_U2 + al256((size_t)64 * TOK * 16 * 2);
constexpr size_t O_SLOC = O_SZ1 + al256((size_t)NLAT * 1024 * 2);
constexpr int SLOC_ROWS = 640;
constexpr size_t O_SIN = O_SLOC + al256((size_t)64 * SLOC_ROWS * 256 * 4);
constexpr size_t O_YG = O_SIN + al256((size_t)64 * (NB * NCHL) * 256 * 2);
constexpr size_t O_H1 = O_YG + al256((size_t)NLAT * 1024 * 2);
constexpr size_t O_END1 = O_H1 + al256((size_t)TOK * 1024 * 2);
constexpr size_t O_Y2 = O_SLOC;
constexpr size_t WS_NEED = (O_END0 > O_END1 ? O_END0 : O_END1);
static_assert(WS_NEED <= (size_t)256 * 1024 * 1024, "workspace too large");
static_assert((size_t)NB * NH * LALL * DQK * 2 <= (size_t)NLAT * 1024 * 4, "Q does not fit d_out");

struct Params {
  const float* in[N_INPUTS];
  float* out;
  char* ws;
  int prog[32];
  int nprog;
  int pad;
};

DI bfr f2bf(float x) {
  unsigned u = __float_as_uint(x);
  u += 0x7fffu + ((u >> 16) & 1u);
  return (bfr)(u >> 16);
}
typedef __bf16 bf2_t __attribute__((ext_vector_type(2)));
typedef float f2_t __attribute__((ext_vector_type(2)));
DI unsigned pk2(float a, float b) {
  f2_t v = {a, b};
  bf2_t r = __builtin_convertvector(v, bf2_t);
  return __builtin_bit_cast(unsigned, r);
}
DI int opaque_tid() {
  int t = threadIdx.x;
  asm volatile("" : "+v"(t));
  return t;
}
DI float bf2f(bfr b) { return __uint_as_float(((unsigned)b) << 16); }
DI float silu_f(float v) { return v / (1.f + __expf(-v)); }
DI float sigmoid_f(float v) { return 1.f / (1.f + __expf(-v)); }
DI float gelu_tanh(float v) {
  float u = 0.7978845608028654f * (v + 0.044715f * v * v * v);
  return 0.5f * v * (1.f + tanhf(u));
}
DI float wave_sum(float v) {
#pragma unroll
  for (int o = 32; o > 0; o >>= 1) v += __shfl_xor(v, o);
  return v;
}
DI float wave_max(float v) {
#pragma unroll
  for (int o = 32; o > 0; o >>= 1) v = fmaxf(v, __shfl_xor(v, o));
  return v;
}
DI const float* xrow0(const Params& p, int tok) {
  int b = tok / LALL, pos = tok - b * LALL;
  return pos < LC ? p.in[I_CTX] + ((size_t)(b * LC + pos)) * D : p.in[I_X] + ((size_t)(b * SEQ + pos - LC)) * D;
}
DI float* xrow1(const Params& p, int tok) {
  int b = tok / LALL, pos = tok - b * LALL;
  return pos < LC ? (float*)(p.ws + O_X1CTX) + ((size_t)(b * LC + pos)) * D : p.out + ((size_t)(b * SEQ + pos - LC)) * D;
}
DI const float* modrow(const Params& p, int layer, int tok) {
  int b = tok / LALL, pos = tok - b * LALL;
  int r = pos < LC ? 8 : b;
  return (const float*)(p.ws + O_MOD) + ((size_t)(layer * 9 + r)) * 3072;
}
DI void rope_cs(int fi, int posv, float& cs, float& sn) {
  float inv = __builtin_amdgcn_exp2f(-(float)fi * (13.287712379549449f / 8.f));
  float rev = (float)posv * inv * 0.15915494309189535f;
  rev -= floorf(rev);
  sn = __builtin_amdgcn_sinf(rev);
  cs = __builtin_amdgcn_cosf(rev);
}
DI float rope_apply(int j, float v, float vp, int lpos) {
  int posv = (j & 16) ? (lpos & 63) : (lpos >> 6);
  float cs, sn;
  rope_cs(j & 7, posv, cs, sn);
  return (j & 8) ? (vp * sn + v * cs) : (v * cs - vp * sn);
}

DI void s5_disc(const Params& p, int dir, int g, int pp, double& dt, double& ar, double& ai, float& fr, float& fi) {
  dt = exp((double)p.in[I_LOGSTEP][dir * 64 + g]);
  ar = (double)p.in[I_ARE][(dir * 64 + g) * 64 + pp];
  ai = (double)p.in[I_AIM][(dir * 64 + g) * 64 + pp];
  double mag = exp(ar * dt);
  double a = ai * dt;
  a -= 6.283185307179586 * rint(a * 0.15915494309189535);
  float sn, cs;
  sincosf((float)a, &sn, &cs);
  double lr = mag * (double)cs, li = mag * (double)sn;
  double den = ar * ar + ai * ai, nr = lr - 1.0;
  fr = (float)((nr * ar + li * ai) / den);
  fi = (float)((li * ar - nr * ai) / den);
}
DI void s5_pow(double dt, double ar, double ai, int k, float& wr, float& wi) {
  double mag = exp(ar * dt * (double)k);
  double a = ai * dt * (double)k;
  a -= 6.283185307179586 * rint(a * 0.15915494309189535);
  float sn, cs;
  sincosf((float)a, &sn, &cs);
  wr = (float)mag * cs;
  wi = (float)mag * sn;
}

enum { PH_PREP = 0, PH_N1, PH_N2, PH_N3, PH_N4, PH_N4B, PH_N5, PH_N6A, PH_N6B, PH_N9, PH_N10, PH_N10B, PH_FINAL,
       PH_O1, PH_O2, PH_O3, PH_O4, PH_O5, PH_O6, PH_O7, PH_O8, PH_O9, PH_O10, PH_H0, PH_H1, PH_COUNT };

constexpr int SMEM_BYTES = 48 * 1024;


DI void prep_transpose(const Params& p, int widx, int tile, char* smem) {
  const int tidx_ = opaque_tid();
  int K, N;
  size_t dst;
  const float* W;
  const float* scl = nullptr;
  switch (widx) {
    case 0: W = p.in[I_WIN0]; K = 1024; N = NIN0; dst = O_WT_IN0; break;
    case 1: W = p.in[I_WUQ]; K = 256; N = 1536; dst = O_WT_UQ; scl = p.in[I_QNORM]; break;
    case 2: W = p.in[I_WUKV]; K = 128; N = 2048; dst = O_WT_UKV; scl = p.in[I_KVNORM]; break;
    case 3: W = p.in[I_WOUT0]; K = 1024; N = 1024; dst = O_WT_OUT0; break;
    case 4: W = p.in[I_WIN1]; K = 1024; N = NIN1; dst = O_WT_IN1; break;
    case 5: W = p.in[I_WGLU]; K = 1024; N = 1024; dst = O_WT_GLU; break;
    default: W = p.in[I_WOUT1]; K = 1024; N = 1024; dst = O_WT_OUT1; break;
  }
  float (*t)[33] = (float (*)[33])smem;
  int ntn = N / 32;
  int kt = tile / ntn, nt = tile - kt * ntn;
  int tx = tidx_ & 31, ty = tidx_ >> 5;
  float v[16];
#pragma unroll
  for (int i = 0; i < 16; ++i) {
    int k = kt * 128 + ty + 8 * i, n = nt * 32 + tx;
    v[i] = W[(size_t)k * N + n];
  }
  if (scl) {
#pragma unroll
    for (int i = 0; i < 16; ++i) v[i] *= scl[kt * 128 + ty + 8 * i];
  }
#pragma unroll
  for (int i = 0; i < 16; ++i) t[ty + 8 * i][tx] = v[i];
  __syncthreads();
  bfr* Wt = (bfr*)(p.ws + dst);
  {
    int nl = tidx_ >> 3, kc = (tidx_ & 7) * 16;
    unsigned w[8];
#pragma unroll
    for (int j = 0; j < 8; ++j) w[j] = pk2(t[kc + 2 * j][nl], t[kc + 2 * j + 1][nl]);
    uint4* dstp = (uint4*)(Wt + (size_t)(nt * 32 + nl) * K + kt * 128 + kc);
    dstp[0] = make_uint4(w[0], w[1], w[2], w[3]);
    dstp[1] = make_uint4(w[4], w[5], w[6], w[7]);
  }
  __syncthreads();
}

DI void prep_mod(const Params& p, int unit, char* smem) {
  const int tidx_ = opaque_tid();
  int layer = unit / 192, cgp = unit - layer * 192;
  float* sil = (float*)smem;
  float* red = sil + 9 * 1024;
  for (int i = tidx_; i < 9 * 1024; i += 256) {
    int r = i >> 10, k = i & 1023;
    float v = r < 8 ? p.in[I_C][r * 1024 + k] : p.in[I_CCTX][k];
    sil[i] = silu_f(v);
  }
  __syncthreads();
  int nn = tidx_ & 15, kg = tidx_ >> 4;
  int n = cgp * 16 + nn;
  const float* W = p.in[I_ADAW] + (size_t)layer * 1024 * 3072 + n;
  float acc[9];
#pragma unroll
  for (int r = 0; r < 9; ++r) acc[r] = 0.f;
#pragma unroll 8
  for (int k = kg * 64; k < kg * 64 + 64; ++k) {
    float w = W[(size_t)k * 3072];
#pragma unroll
    for (int r = 0; r < 9; ++r) acc[r] += sil[r * 1024 + k] * w;
  }
#pragma unroll
  for (int r = 0; r < 9; ++r) red[(kg * 9 + r) * 16 + nn] = acc[r];
  __syncthreads();
  if (tidx_ < 144) {
    int r = tidx_ >> 4, c = tidx_ & 15;
    int nc = cgp * 16 + c;
    float s = p.in[I_ADAB][layer * 3072 + nc];
#pragma unroll
    for (int g = 0; g < 16; ++g) s += red[(g * 9 + r) * 16 + c];
    ((float*)(p.ws + O_MOD))[((size_t)(layer * 9 + r)) * 3072 + nc] = s;
  }
  __syncthreads();
}

DI void prep_ktab(const Params& p, int unit, char* smem) {
  const int tidx_ = opaque_tid();
  int g = unit / 7, lg = unit - g * 7;
  float2* E = (float2*)smem;
  int tid = tidx_;
  const bool use_f = lg >= 3, use_r = lg <= 3;
  for (int i = tid; i < 9 * 128; i += 256) {
    int l = i >> 7, dir = (i >> 6) & 1, pp = i & 63;
    int lag = lg * 9 + l - 31;
    bool used = (dir == 0) ? (lag >= 0) : (lag <= 0);
    float2 e = make_float2(0.f, 0.f);
    if (used) {
      double dt, ar, ai;
      float fr, fi, wr, wi;
      s5_disc(p, dir, g, pp, dt, ar, ai, fr, fi);
      s5_pow(dt, ar, ai, lag < 0 ? -lag : lag, wr, wi);
      e.x = wr * fr - wi * fi;
      e.y = wr * fi + wi * fr;
    }
    E[(l * 2 + dir) * 64 + pp] = e;
  }
  __syncthreads();
  int c = tid >> 4, c2 = tid & 15;
  float acc[9];
#pragma unroll
  for (int l = 0; l < 9; ++l) acc[l] = 0.f;
  for (int dir = 0; dir < 2; ++dir) {
    if (dir == 0 ? !use_f : !use_r) continue;
    const float* bre = p.in[I_BRE] + ((size_t)(dir * 64 + g)) * 64 * 16;
    const float* bim = p.in[I_BIM] + ((size_t)(dir * 64 + g)) * 64 * 16;
    const float* cre = p.in[I_CRE] + ((size_t)(dir * 64 + g)) * 16 * 64;
    const float* cim = p.in[I_CIM] + ((size_t)(dir * 64 + g)) * 16 * 64;
#pragma unroll 4
    for (int pp = 0; pp < 64; ++pp) {
      float br = bre[pp * 16 + c2], bi = bim[pp * 16 + c2];
      float cr = cre[c * 64 + pp], ci = cim[c * 64 + pp];
      float mr = cr * br - ci * bi, mi = cr * bi + ci * br;
#pragma unroll
      for (int l = 0; l < 9; ++l) {
        float2 e = E[(l * 2 + dir) * 64 + pp];
        acc[l] += mr * e.x - mi * e.y;
      }
    }
  }
  bfr* KT = (bfr*)(p.ws + O_KTAB);
#pragma unroll
  for (int l = 0; l < 9; ++l) KT[(((size_t)g * 63 + lg * 9 + l) * 16 + c) * 16 + c2] = f2bf(acc[l]);
  __syncthreads();
}

DI void prep_ops(const Params& p, int unit) {
  const int tidx_ = opaque_tid();
  int idx = unit * 256 + tidx_;
  int pp = idx & 63, t = (idx >> 6) & 31, dir = (idx >> 11) & 1, g = idx >> 12;
  double dt, ar, ai;
  float fr, fi, wr, wi;
  s5_disc(p, dir, g, pp, dt, ar, ai, fr, fi);
  s5_pow(dt, ar, ai, dir == 0 ? (TC - 1 - t) : t, wr, wi);
  float er = wr * fr - wi * fi, ei = wr * fi + wi * fr;
  const float* bre = p.in[I_BRE] + (((size_t)(dir * 64 + g)) * 64 + pp) * 16;
  const float* bim = p.in[I_BIM] + (((size_t)(dir * 64 + g)) * 64 + pp) * 16;
  bfr* wst = (bfr*)(p.ws + O_WST) + (size_t)g * 256 * 512;
  bfr* rre = wst + (size_t)(dir * 128 + pp) * 512 + t * 16;
  bfr* rim = wst + (size_t)(dir * 128 + 64 + pp) * 512 + t * 16;
#pragma unroll
  for (int c2 = 0; c2 < 16; ++c2) {
    float br = bre[c2], bi = bim[c2];
    rre[c2] = f2bf(er * br - ei * bi);
    rim[c2] = f2bf(er * bi + ei * br);
  }
  s5_pow(dt, ar, ai, dir == 0 ? (t + 1) : (TC - t), wr, wi);
  const float* cre = p.in[I_CRE] + ((size_t)(dir * 64 + g)) * 16 * 64;
  const float* cim = p.in[I_CIM] + ((size_t)(dir * 64 + g)) * 16 * 64;
  bfr* vop = (bfr*)(p.ws + O_VOP) + (size_t)g * 512 * 256;
#pragma unroll
  for (int c = 0; c < 16; ++c) {
    float cr = cre[c * 64 + pp], ci = cim[c * 64 + pp];
    float dr = cr * wr - ci * wi, di = cr * wi + ci * wr;
    vop[(size_t)(t * 16 + c) * 256 + dir * 128 + pp] = f2bf(dr);
    vop[(size_t)(t * 16 + c) * 256 + dir * 128 + 64 + pp] = f2bf(-di);
  }
}

constexpr int TR_T0 = 8 * 45, TR_T1 = 2 * 48, TR_T2 = 1 * 64, TR_T3 = 256, TR_T4 = 8 * 64, TR_T5 = 256, TR_T6 = 256;
constexpr int TR_TOTAL = TR_T0 + TR_T1 + TR_T2 + TR_T3 + TR_T4 + TR_T5 + TR_T6;
constexpr int U_MOD = 384, U_RS0 = 0, U_KTAB = 64 * 7, U_OPS = 64 * 2 * 64 * 32 / 256;
constexpr int PREP_A_UNITS = U_MOD + TR_T0 + TR_T1 + TR_T2 + TR_T3;
constexpr int PREP_B_UNITS = TR_T4 + TR_T5 + TR_T6 + U_KTAB + U_OPS;

DI void phase_prep(const Params& p, char* smem) {
  for (int u = blockIdx.x; u < PREP_A_UNITS; u += gridDim.x) {
    int v = u;
    if (v < U_MOD) { prep_mod(p, v, smem); continue; }
    v -= U_MOD;
    int w = 0;
    if (v >= TR_T0) { v -= TR_T0; w = 1;
      if (v >= TR_T1) { v -= TR_T1; w = 2;
        if (v >= TR_T2) { v -= TR_T2; w = 3; } } }
    prep_transpose(p, w, v, smem);
  }
}
DI void phase_prep_b(const Params& p, char* smem, int first_blk) {
  if (first_blk >= (int)gridDim.x) first_blk = 0;
  if ((int)blockIdx.x < first_blk) return;
  const int nb = gridDim.x - first_blk;
  for (int u = blockIdx.x - first_blk; u < PREP_B_UNITS; u += nb) {
    int v = u;
    if (v < TR_T4 + TR_T5 + TR_T6) {
      int w = 4;
      if (v >= TR_T4) { v -= TR_T4; w = 5;
        if (v >= TR_T5) { v -= TR_T5; w = 6; } }
      prep_transpose(p, w, v, smem);
      continue;
    }
    v -= TR_T4 + TR_T5 + TR_T6;
    if (v < U_KTAB) { prep_ktab(p, v, smem); continue; }
    v -= U_KTAB;
    prep_ops(p, v);
  }
}

DI float rs_from_part(const float* part, int nrows, int r) {
  float s = 0.f;
#pragma unroll
  for (int j = 0; j < 16; ++j) s += part[(size_t)j * nrows + r];
  return rsqrtf(s * (1.f / 1024.f) + EPS);
}

DI void phase_final(const Params& p) {
  const int tidx_ = opaque_tid();
  const float* part = (const float*)(p.ws + O_PART2);
  const float4* g4 = (const float4*)p.in[I_FINALG];
  int lane = tidx_ & 63;
  float4 g[4];
#pragma unroll
  for (int i = 0; i < 4; ++i) g[i] = g4[lane + 64 * i];
  for (int r = (blockIdx.x * 4 + (tidx_ >> 6)) * 2; r < NLAT; r += gridDim.x * 8) {
    float4* row0 = (float4*)(p.out + (size_t)r * D);
    float4* row1 = row0 + D / 4;
    float4 v0[4], v1[4];
#pragma unroll
    for (int i = 0; i < 4; ++i) {
      v0[i] = row0[lane + 64 * i];
      v1[i] = row1[lane + 64 * i];
    }
    float ps = part[(size_t)(lane & 15) * NLAT + r + ((lane >> 4) & 1)];
    ps += __shfl_xor(ps, 1);
    ps += __shfl_xor(ps, 2);
    ps += __shfl_xor(ps, 4);
    ps += __shfl_xor(ps, 8);
    const float rs0 = rsqrtf(__shfl(ps, 0) * (1.f / 1024.f) + EPS);
    const float rs1 = rsqrtf(__shfl(ps, 16) * (1.f / 1024.f) + EPS);
#pragma unroll
    for (int i = 0; i < 4; ++i) {
      float4 a = v0[i], c = v1[i];
      a.x *= rs0 * g[i].x; a.y *= rs0 * g[i].y; a.z *= rs0 * g[i].z; a.w *= rs0 * g[i].w;
      c.x *= rs1 * g[i].x; c.y *= rs1 * g[i].y; c.z *= rs1 * g[i].z; c.w *= rs1 * g[i].w;
      row0[lane + 64 * i] = a;
      row1[lane + 64 * i] = c;
    }
  }
}

typedef short bf16x8 __attribute__((ext_vector_type(8)));
typedef short s16x4 __attribute__((ext_vector_type(4)));
typedef float f32x16 __attribute__((ext_vector_type(16)));
#define SCHED_FENCE() __builtin_amdgcn_sched_barrier(0)
#define MFMA32(a, b, c) __builtin_amdgcn_mfma_f32_32x32x16_bf16((a), (b), (c), 0, 0, 0)
DI int xcd_swz(int u, int per) {
  int x = u & 7, q = u >> 3;
  int qq = q / per;
  return (x + 8 * qq) * per + (q - qq * per);
}
DI int crow(int i, int h) { return (i & 3) + 8 * (i >> 2) + 4 * h; }

constexpr int LDT = 40;
struct GemmSmem {
  bfr A[2][128 * LDT];
  bfr B[2][128 * LDT];
  float rs[128];
};
static_assert(sizeof(GemmSmem) <= SMEM_BYTES, "smem");

DI void zero_acc(f32x16 (&acc)[2][2]) {
#pragma unroll
  for (int a = 0; a < 2; ++a)
#pragma unroll
    for (int b = 0; b < 2; ++b)
#pragma unroll
      for (int i = 0; i < 16; ++i) acc[a][b][i] = 0.f;
}

#define GSTAGE_DECL uint4 ga0, ga1, gb0, gb1, gc0, gc1, gd0, gd1
#define GSTAGE_ARGS ga0, ga1, gb0, gb1, gc0, gc1, gd0, gd1
#define GSTAGE_PARAMS uint4 &a0, uint4 &a1, uint4 &b0, uint4 &b1, uint4 &c0, uint4 &c1, uint4 &d0, uint4 &d1
template <class AAddr, class BAddr>
DI void gemm_prefetch(GSTAGE_PARAMS, AAddr aaddr, BAddr baddr) {
  const int tid = opaque_tid();
  const int lrow = tid >> 2, lkc = (tid & 3) * 8;
  b0 = *(const uint4*)baddr(lrow, lkc);
  b1 = *(const uint4*)baddr(lrow + 64, lkc);
  a0 = *(const uint4*)aaddr(lrow, lkc);
  a1 = *(const uint4*)aaddr(lrow + 64, lkc);
  d0 = *(const uint4*)baddr(lrow, 32 + lkc);
  d1 = *(const uint4*)baddr(lrow + 64, 32 + lkc);
  c0 = *(const uint4*)aaddr(lrow, 32 + lkc);
  c1 = *(const uint4*)aaddr(lrow + 64, 32 + lkc);
  SCHED_FENCE();
}
template <class AAddr, class BAddr>
DI void gemm_main(f32x16 (&acc)[2][2], int KT, AAddr aaddr, BAddr baddr, GemmSmem* sm, GSTAGE_PARAMS) {
  const int tid = opaque_tid(), lane = tid & 63, wave = tid >> 6;
  const int wm = wave >> 1, wn = wave & 1, r = lane & 31, h = lane >> 5;
  const int lrow = tid >> 2, lkc = (tid & 3) * 8;
#define GM_LOAD(KT_, A0, A1, B0, B1)                   \
  {                                                    \
    const int kk_ = (KT_) * 32 + lkc;                  \
    B0 = *(const uint4*)baddr(lrow, kk_);              \
    B1 = *(const uint4*)baddr(lrow + 64, kk_);         \
    A0 = *(const uint4*)aaddr(lrow, kk_);              \
    A1 = *(const uint4*)aaddr(lrow + 64, kk_);         \
  }
#define GM_STORE(BUF_, A0, A1, B0, B1)                                  \
  {                                                                     \
    *(uint4*)(sm->B[BUF_] + lrow * LDT + lkc) = B0;                     \
    *(uint4*)(sm->B[BUF_] + (lrow + 64) * LDT + lkc) = B1;              \
    *(uint4*)(sm->A[BUF_] + lrow * LDT + lkc) = A0;                     \
    *(uint4*)(sm->A[BUF_] + (lrow + 64) * LDT + lkc) = A1;              \
  }
#define GM_COMPUTE(BUF_)                                                                                       \
  _Pragma("unroll") for (int ks = 0; ks < 2; ++ks) {                                                           \
    bf16x8 a_[2], b_[2];                                                                                       \
    _Pragma("unroll") for (int mi = 0; mi < 2; ++mi)                                                           \
        a_[mi] = *(const bf16x8*)(sm->A[BUF_] + (wm * 64 + mi * 32 + r) * LDT + ks * 16 + h * 8);              \
    _Pragma("unroll") for (int ni = 0; ni < 2; ++ni)                                                           \
        b_[ni] = *(const bf16x8*)(sm->B[BUF_] + (wn * 64 + ni * 32 + r) * LDT + ks * 16 + h * 8);              \
    _Pragma("unroll") for (int mi = 0; mi < 2; ++mi)                                                           \
        _Pragma("unroll") for (int ni = 0; ni < 2; ++ni) acc[mi][ni] = MFMA32(a_[mi], b_[ni], acc[mi][ni]);    \
  }
  GM_STORE(0, a0, a1, b0, b1)
  if (KT > 2) GM_LOAD(2, a0, a1, b0, b1)
  SCHED_FENCE();
  __syncthreads();
  for (int kt = 0; kt < KT; kt += 2) {
    GM_STORE(1, c0, c1, d0, d1)
    if (kt + 3 < KT) GM_LOAD(kt + 3, c0, c1, d0, d1)
    SCHED_FENCE();
    GM_COMPUTE(0)
    __syncthreads();
    if (kt + 2 < KT) GM_STORE(0, a0, a1, b0, b1)
    if (kt + 4 < KT) GM_LOAD(kt + 4, a0, a1, b0, b1)
    SCHED_FENCE();
    GM_COMPUTE(1)
    __syncthreads();
  }
}

template <class AAddr, class BAddr>
DI void gemm_full(f32x16 (&acc)[2][2], int KT, AAddr aaddr, BAddr baddr, GemmSmem* sm) {
  GSTAGE_DECL;
  gemm_prefetch(GSTAGE_ARGS, aaddr, baddr);
  gemm_main(acc, KT, aaddr, baddr, sm, GSTAGE_ARGS);
}

DI float transpose_reduce16(float (&v)[16], int lane) {
  float r8[8], r4[4], r2[2];
  {
    bool up = lane & 8;
#pragma unroll
    for (int i = 0; i < 8; ++i) {
      float send = up ? v[i] : v[i + 8];
      float keep = up ? v[i + 8] : v[i];
      r8[i] = keep + __shfl_xor(send, 8);
    }
  }
  {
    bool up = lane & 4;
#pragma unroll
    for (int i = 0; i < 4; ++i) {
      float send = up ? r8[i] : r8[i + 4];
      float keep = up ? r8[i + 4] : r8[i];
      r4[i] = keep + __shfl_xor(send, 4);
    }
  }
  {
    bool up = lane & 2;
#pragma unroll
    for (int i = 0; i < 2; ++i) {
      float send = up ? r4[i] : r4[i + 2];
      float keep = up ? r4[i + 2] : r4[i];
      r2[i] = keep + __shfl_xor(send, 2);
    }
  }
  bool up = lane & 1;
  float send = up ? r2[0] : r2[1];
  float keep = up ? r2[1] : r2[0];
  return keep + __shfl_xor(send, 1);
}

DI void stage_half(const f32x16 (&acc)[2][2], int mi, float* wl, float4 (&v)[8], int lane) {
  const int r = lane & 31, h = lane >> 5;
#pragma unroll
  for (int ni = 0; ni < 2; ++ni)
#pragma unroll
    for (int i = 0; i < 16; ++i) wl[crow(i, h) * 64 + ni * 32 + r] = acc[mi][ni][i];
  asm volatile("s_waitcnt lgkmcnt(0)" ::: "memory");
#pragma unroll
  for (int c = 0; c < 8; ++c) v[c] = *(const float4*)(wl + (c * 4 + (lane >> 4)) * 64 + (lane & 15) * 4);
  asm volatile("s_waitcnt lgkmcnt(0)" ::: "memory");
}
DI void stage_half8(const f32x16 (&acc)[2][2], int mi, float* wl, float4 (&lo)[4], float4 (&hi)[4], int lane) {
  const int r = lane & 31, h = lane >> 5;
#pragma unroll
  for (int ni = 0; ni < 2; ++ni)
#pragma unroll
    for (int i = 0; i < 16; ++i) wl[crow(i, h) * 64 + ni * 32 + r] = acc[mi][ni][i];
  asm volatile("s_waitcnt lgkmcnt(0)" ::: "memory");
#pragma unroll
  for (int c = 0; c < 4; ++c) {
    const float* pch = wl + (c * 8 + (lane >> 3)) * 64 + (lane & 7) * 8;
    lo[c] = *(const float4*)pch;
    hi[c] = *(const float4*)(pch + 4);
  }
  asm volatile("s_waitcnt lgkmcnt(0)" ::: "memory");
}
DI float4 bf4_to_f4(uint2 u) {
  return make_float4(__uint_as_float(u.x << 16), __uint_as_float(u.x & 0xffff0000u), __uint_as_float(u.y << 16),
                     __uint_as_float(u.y & 0xffff0000u));
}
DI uint2 f4_to_bf4(float4 f) { return make_uint2(pk2(f.x, f.y), pk2(f.z, f.w)); }

#define WAVE_IDS                                              \
  const int tid = opaque_tid(), lane = tid & 63, wave = tid >> 6; \
  const int wm = wave >> 1, wn = wave & 1, r = lane & 31, h = lane >> 5; \
  (void)wm; (void)wn; (void)r; (void)h;

template <int LAYER>
DI void phase_hconv(const Params& p) {
  const int tid = opaque_tid(), lane = tid & 63;
  bfr* H = (bfr*)(p.ws + (LAYER == 0 ? O_H0 : O_H1));
  const float4* ng4 = (const float4*)(p.in[I_NORMG] + LAYER * 1024);
  for (int tok = (blockIdx.x * 4 + (tid >> 6)) * 2; tok < TOK; tok += gridDim.x * 8) {
    const float4* xr0 = (const float4*)(LAYER == 0 ? xrow0(p, tok) : (const float*)xrow1(p, tok));
    const float4* xr1 = xr0 + 256;
    const float4* md4 = (const float4*)modrow(p, LAYER, tok);
    float4 x0[4], x1[4], gm[4], sh[4];
#pragma unroll
    for (int i = 0; i < 4; ++i) {
      x0[i] = xr0[lane + 64 * i];
      x1[i] = xr1[lane + 64 * i];
      float4 gv = ng4[lane + 64 * i];
      float4 sc = md4[256 + lane + 64 * i];
      sh[i] = md4[lane + 64 * i];
      gm[i] = make_float4(gv.x * (1.f + sc.x), gv.y * (1.f + sc.y), gv.z * (1.f + sc.z), gv.w * (1.f + sc.w));
    }
    float s0 = 0.f, s1 = 0.f;
#pragma unroll
    for (int i = 0; i < 4; ++i) {
      s0 += x0[i].x * x0[i].x + x0[i].y * x0[i].y + x0[i].z * x0[i].z + x0[i].w * x0[i].w;
      s1 += x1[i].x * x1[i].x + x1[i].y * x1[i].y + x1[i].z * x1[i].z + x1[i].w * x1[i].w;
    }
    s0 = wave_sum(s0);
    s1 = wave_sum(s1);
    const float r0 = rsqrtf(s0 * (1.f / 1024.f) + EPS), r1 = rsqrtf(s1 * (1.f / 1024.f) + EPS);
#pragma unroll
    for (int i = 0; i < 4; ++i) {
      uint2 o0, o1;
      o0.x = pk2(x0[i].x * r0 * gm[i].x + sh[i].x, x0[i].y * r0 * gm[i].y + sh[i].y);
      o0.y = pk2(x0[i].z * r0 * gm[i].z + sh[i].z, x0[i].w * r0 * gm[i].w + sh[i].w);
      o1.x = pk2(x1[i].x * r1 * gm[i].x + sh[i].x, x1[i].y * r1 * gm[i].y + sh[i].y);
      o1.y = pk2(x1[i].z * r1 * gm[i].z + sh[i].z, x1[i].w * r1 * gm[i].w + sh[i].w);
      *(uint2*)(H + (size_t)tok * 1024 + (lane + 64 * i) * 4) = o0;
      *(uint2*)(H + (size_t)(tok + 1) * 1024 + (lane + 64 * i) * 4) = o1;
    }
  }
}

DI void phase_o1(const Params& p, char* smem) {
  GemmSmem* sm = (GemmSmem*)smem;
  WAVE_IDS
  const int NT = 12, units = (TOK / 128) * NT;
  const bfr* WT = (const bfr*)(p.ws + O_WT_IN0);
  bfr* PC = (bfr*)(p.ws + O_PC);
  bfr* SZ0 = (bfr*)(p.ws + O_SZ0);
  bfr* KRb = (bfr*)(p.ws + O_KR);
  const bfr* Ah = (const bfr*)(p.ws + O_H0);
  auto Aof = [&](int m0) { return [=](int row, int k) { return Ah + (size_t)(m0 + row) * 1024 + k; }; };
  auto Bof = [&](int n0) {
    return [=](int row, int k) {
      int n = n0 + row;
      n = n < NIN0 ? n : NIN0 - 1;
      return WT + (size_t)n * 1024 + k;
    };
  };
  GSTAGE_DECL;
  if ((int)blockIdx.x < units) {
    const int us = xcd_swz(blockIdx.x, NT);
    gemm_prefetch(GSTAGE_ARGS, Aof((us / NT) * 128), Bof((us % NT) * 128));
  }
  for (int u = blockIdx.x; u < units; u += gridDim.x) {
    const int us = xcd_swz(u, NT);
    int mt = us / NT, nt = us - mt * NT;
    int m0 = mt * 128, n0 = nt * 128;
    f32x16 acc[2][2];
    zero_acc(acc);
    gemm_main(acc, 32, Aof(m0), Bof(n0), sm, GSTAGE_ARGS);
    if (u + (int)gridDim.x < units) {
      const int us1 = xcd_swz(u + gridDim.x, NT);
      gemm_prefetch(GSTAGE_ARGS, Aof((us1 / NT) * 128), Bof((us1 % NT) * 128));
    }
    int b = m0 / LALL, pos0 = m0 - b * LALL;
    bool lat = pos0 >= LC;
#pragma unroll
    for (int mi = 0; mi < 2; ++mi)
#pragma unroll
      for (int ni = 0; ni < 2; ++ni) {
        int col0 = n0 + wn * 64 + ni * 32;
        if (col0 >= NIN0) continue;
        int col = col0 + r;
#pragma unroll
        for (int i = 0; i < 16; ++i) {
          int row = wm * 64 + mi * 32 + crow(i, h);
          int tok = m0 + row;
          float v = acc[mi][ni][i];
          if (col0 < 384) {
            PC[(size_t)tok * 384 + col] = f2bf(v);
          } else if (col0 == 384) {
            float vp = __shfl_xor(v, 8);
            int pos = pos0 + row;
            float val = lat ? rope_apply(r, v, vp, pos - LC) : v;
            KRb[(size_t)tok * 32 + r] = f2bf(val);
          } else {
            SZ0[(size_t)tok * 1024 + (col - 416)] = f2bf(silu_f(v));
          }
          SCHED_FENCE();
        }
      }
  }
}

DI void phase_o2(const Params& p, char* smem) {
  GemmSmem* sm = (GemmSmem*)smem;
  WAVE_IDS
  const int UQ = (TOK / 128) * 12, UKV = (TOK / 128) * 16;
  const bfr* PC = (const bfr*)(p.ws + O_PC);
  bfr* Q = (bfr*)p.out;
  bfr* Kb = (bfr*)(p.ws + O_K);
  bfr* VT = (bfr*)(p.ws + O_VT);
  const int total = UQ + UKV;
  const int per_blk = (total + gridDim.x - 1) / gridDim.x;
  const int u_beg = blockIdx.x * per_blk;
  const int u_end = u_beg + per_blk < total ? u_beg + per_blk : total;
  int prev_key = -1;
  for (int us = u_beg; us < u_end; ++us) {
    int mt = us / 28, rem = us - mt * 28;
    bool isq = rem < 12;
    int nt = isq ? rem : rem - 12;
    int m0 = mt * 128, n0 = nt * 128;
    int Kd = isq ? 256 : 128;
    int aoff = isq ? 0 : 256;
    const bfr* WT = (const bfr*)(p.ws + (isq ? O_WT_UQ : O_WT_UKV));
    const int key = mt * 2 + (isq ? 0 : 1);
    if (key != prev_key) {
      prev_key = key;
      __syncthreads();
      int row = tid >> 1, half = tid & 1;
      const bfr* ap = PC + (size_t)(m0 + row) * 384 + aoff + half * (Kd / 2);
      float ss = 0.f;
      for (int j = 0; j < Kd / 16; ++j) {
        uint4 v = *(const uint4*)(ap + j * 8);
        unsigned w[4] = {v.x, v.y, v.z, v.w};
#pragma unroll
        for (int e = 0; e < 4; ++e) {
          float lo = __uint_as_float(w[e] << 16), hi = __uint_as_float(w[e] & 0xffff0000u);
          ss += lo * lo + hi * hi;
        }
      }
      ss += __shfl_xor(ss, 1);
      if (half == 0) sm->rs[row] = rsqrtf(ss / (float)Kd + EPS);
      __syncthreads();
    }
    f32x16 acc[2][2];
    zero_acc(acc);
    gemm_full(
        acc, Kd / 32, [&](int row, int k) { return PC + (size_t)(m0 + row) * 384 + aoff + k; },
        [&](int row, int k) { return WT + (size_t)(n0 + row) * Kd + k; }, sm);
    int b = m0 / LALL, pos0 = m0 - b * LALL;
    bool lat = pos0 >= LC;
    float* wl = (float*)sm + wave * 2048;
    if (isq || wn == 0) {
      if (isq && lat) {
#pragma unroll
        for (int ni = 0; ni < 2; ++ni) {
          int col0 = n0 + wn * 64 + ni * 32;
          if (col0 % 96 == 64) {
#pragma unroll
            for (int mi = 0; mi < 2; ++mi)
#pragma unroll
              for (int i = 0; i < 16; ++i) {
                int pos = pos0 + wm * 64 + mi * 32 + crow(i, h);
                float v = acc[mi][ni][i];
                float vp = __shfl_xor(v, 8);
                acc[mi][ni][i] = rope_apply(r, v, vp, pos - LC);
              }
          }
        }
      }
      const int c0 = wn * 64 + (lane & 7) * 8;
      bfr* dst;
      int rstride;
      float oscale;
      if (isq) {
        int col = n0 + c0;
        int hh = col / 96, d = col - hh * 96;
        dst = Q + ((size_t)(b * NH + hh) * LALL) * DQK + d;
        rstride = DQK;
        oscale = QSCALE;
      } else {
        int hh = n0 >> 7;
        dst = Kb + ((size_t)(b * NH + hh) * LALL) * 64 + c0;
        rstride = 64;
        oscale = 1.f;
      }
#pragma unroll
      for (int mi = 0; mi < 2; ++mi) {
        float4 lo[4], hi[4];
        stage_half8(acc, mi, wl, lo, hi, lane);
#pragma unroll
        for (int c = 0; c < 4; ++c) {
          int row = wm * 64 + mi * 32 + c * 8 + (lane >> 3);
          float sc = sm->rs[row] * oscale;
          uint4 o;
          o.x = pk2(lo[c].x * sc, lo[c].y * sc);
          o.y = pk2(lo[c].z * sc, lo[c].w * sc);
          o.z = pk2(hi[c].x * sc, hi[c].y * sc);
          o.w = pk2(hi[c].z * sc, hi[c].w * sc);
          *(uint4*)(dst + (size_t)(pos0 + row) * rstride) = o;
        }
      }
    } else {
      int hh = n0 >> 7;
#pragma unroll
      for (int mi = 0; mi < 2; ++mi)
#pragma unroll
        for (int ni = 0; ni < 2; ++ni) {
          int dvv = ni * 32 + r;
#pragma unroll
          for (int g4 = 0; g4 < 4; ++g4) {
            int row = wm * 64 + mi * 32 + 8 * g4 + 4 * h;
            int pos = pos0 + row;
            uint2 o;
            o.x = pk2(acc[mi][ni][4 * g4 + 0] * sm->rs[row + 0], acc[mi][ni][4 * g4 + 1] * sm->rs[row + 1]);
            o.y = pk2(acc[mi][ni][4 * g4 + 2] * sm->rs[row + 2], acc[mi][ni][4 * g4 + 3] * sm->rs[row + 3]);
            *(uint2*)(VT + (((size_t)(b * NH + hh)) * DV + dvv) * LALL + pos) = o;
          }
        }
    }
    __syncthreads();
  }
}

constexpr int KLD = 104;
constexpr int VLD = 68;
struct AttnSmem {
  bfr K[64 * KLD];
  bfr V[64 * VLD];
};
static_assert(sizeof(AttnSmem) <= SMEM_BYTES, "smem");

DI void attn_item(const Params& p, AttnSmem* sm, int bh, int qpos0, int nkeys) {
  WAVE_IDS
  const bfr* Q = (const bfr*)p.out;
  const bfr* Kg = (const bfr*)(p.ws + O_K) + (size_t)bh * LALL * 64;
  const bfr* KRg = (const bfr*)(p.ws + O_KR) + (size_t)(bh / NH) * LALL * 32;
  const bfr* Vg = (const bfr*)(p.ws + O_VT) + (size_t)bh * DV * LALL;
  const int qpos = qpos0 + wave * 32 + r;
  bf16x8 bq[6];
  {
    const bfr* qp = Q + ((size_t)bh * LALL + qpos) * DQK + 8 * h;
#pragma unroll
    for (int s = 0; s < 6; ++s) bq[s] = *(const bf16x8*)(qp + 16 * s);
  }
  f32x16 o[2];
#pragma unroll
  for (int d = 0; d < 2; ++d)
#pragma unroll
    for (int i = 0; i < 16; ++i) o[d][i] = 0.f;
  float mrun = 0.f, lrun = 0.f;
  uint4 kv0, kv1, kv2, vv0, vv1;
  const int kr0 = tid / 12, kc0 = (tid - kr0 * 12) * 8;
  const int kr1 = (tid + 256) / 12, kc1 = (tid + 256 - kr1 * 12) * 8;
  const int kr2 = (tid + 512) / 12, kc2 = (tid + 512 - kr2 * 12) * 8;
  const int vr0 = tid >> 3, vc0 = (tid & 7) * 8;
  const bfr* kp0 = kc0 < 64 ? Kg + (size_t)kr0 * 64 + kc0 : KRg + (size_t)kr0 * 32 + (kc0 - 64);
  const bfr* kp1 = kc1 < 64 ? Kg + (size_t)kr1 * 64 + kc1 : KRg + (size_t)kr1 * 32 + (kc1 - 64);
  const bfr* kp2 = kc2 < 64 ? Kg + (size_t)kr2 * 64 + kc2 : KRg + (size_t)kr2 * 32 + (kc2 - 64);
  const int ks0 = kc0 < 64 ? 64 : 32, ks1 = kc1 < 64 ? 64 : 32, ks2 = kc2 < 64 ? 64 : 32;
#define AT_GLOAD(KEY0_)                                                          \
  {                                                                              \
    const int key0_ = (KEY0_);                                                   \
    kv0 = *(const uint4*)(kp0 + (size_t)key0_ * ks0);                            \
    kv1 = *(const uint4*)(kp1 + (size_t)key0_ * ks1);                            \
    kv2 = *(const uint4*)(kp2 + (size_t)key0_ * ks2);                            \
    vv0 = *(const uint4*)(Vg + (size_t)vr0 * LALL + key0_ + vc0);                \
    vv1 = *(const uint4*)(Vg + (size_t)(vr0 + 32) * LALL + key0_ + vc0);         \
  }
#define AT_LSTORE()                                                              \
  {                                                                              \
    *(uint4*)(sm->K + kr0 * KLD + kc0) = kv0;                                    \
    *(uint4*)(sm->K + kr1 * KLD + kc1) = kv1;                                    \
    *(uint4*)(sm->K + kr2 * KLD + kc2) = kv2;                                    \
    uint2* d0_ = (uint2*)(sm->V + vr0 * VLD + vc0);                              \
    d0_[0] = make_uint2(vv0.x, vv0.y);                                           \
    d0_[1] = make_uint2(vv0.z, vv0.w);                                           \
    uint2* d1_ = (uint2*)(sm->V + (vr0 + 32) * VLD + vc0);                       \
    d1_[0] = make_uint2(vv1.x, vv1.y);                                           \
    d1_[1] = make_uint2(vv1.z, vv1.w);                                           \
  }
  const int NTI = nkeys / 64;
  AT_GLOAD(0)
  for (int it = 0; it < NTI; ++it) {
    AT_LSTORE()
    __syncthreads();
    if (it + 1 < NTI) AT_GLOAD((it + 1) * 64)
    SCHED_FENCE();
    f32x16 st[2];
    const float ninit = -mrun;
#pragma unroll
    for (int kb = 0; kb < 2; ++kb)
#pragma unroll
      for (int i = 0; i < 16; ++i) st[kb][i] = ninit;
#pragma unroll
    for (int s = 0; s < 6; ++s) {
#pragma unroll
      for (int kb = 0; kb < 2; ++kb) {
        bf16x8 ka = *(const bf16x8*)(sm->K + (kb * 32 + r) * KLD + 16 * s + 8 * h);
        st[kb] = MFMA32(ka, bq[s], st[kb]);
      }
    }
    float mx = fmaxf(fmaxf(st[0][0], st[0][1]), st[1][0]);
#pragma unroll
    for (int i = 2; i < 16; i += 2) mx = fmaxf(fmaxf(mx, st[0][i]), st[0][i + 1]);
#pragma unroll
    for (int i = 1; i < 15; i += 2) mx = fmaxf(fmaxf(mx, st[1][i]), st[1][i + 1]);
    mx = fmaxf(mx, st[1][15]);
    mx = fmaxf(mx, __shfl_xor(mx, 32));
    const bool need = (it == 0) || (mx > 8.f);
    if (__any(need)) {
      const float delta = need ? mx : 0.f;
      const float alpha = __builtin_amdgcn_exp2f(-delta);
      mrun += delta;
      lrun *= alpha;
#pragma unroll
      for (int d = 0; d < 2; ++d)
#pragma unroll
        for (int i = 0; i < 16; ++i) o[d][i] *= alpha;
#pragma unroll
      for (int kb = 0; kb < 2; ++kb)
#pragma unroll
        for (int i = 0; i < 16; ++i) st[kb][i] -= delta;
    }
    float ps = 0.f;
#pragma unroll
    for (int kb = 0; kb < 2; ++kb)
#pragma unroll
      for (int i = 0; i < 16; ++i) {
        float e = __builtin_amdgcn_exp2f(st[kb][i]);
        st[kb][i] = e;
        ps += e;
      }
    lrun += ps;
#pragma unroll
    for (int kb = 0; kb < 2; ++kb)
#pragma unroll
      for (int s2 = 0; s2 < 2; ++s2) {
        unsigned pw[4];
#pragma unroll
        for (int j = 0; j < 4; ++j) pw[j] = pk2(st[kb][8 * s2 + 2 * j], st[kb][8 * s2 + 2 * j + 1]);
        bf16x8 pb;
        {
          uint4 t = make_uint4(pw[0], pw[1], pw[2], pw[3]);
          pb = __builtin_bit_cast(bf16x8, t);
        }
#pragma unroll
        for (int d = 0; d < 2; ++d) {
          const bfr* vp = sm->V + (d * 32 + r) * VLD + kb * 32 + 16 * s2 + 4 * h;
          uint2 lo = *(const uint2*)vp;
          uint2 hi = *(const uint2*)(vp + 8);
          uint4 t = make_uint4(lo.x, lo.y, hi.x, hi.y);
          bf16x8 va = __builtin_bit_cast(bf16x8, t);
          o[d] = MFMA32(va, pb, o[d]);
        }
      }
    __syncthreads();
  }
  float ltot = lrun + __shfl_xor(lrun, 32);
  float inv = 1.f / ltot;
  int b = bh / NH, hh = bh - b * NH;
  size_t tok = (size_t)b * LALL + qpos;
  const bfr* SZ = (const bfr*)(p.ws + O_SZ0) + tok * 1024 + hh * 64;
  bfr* OG = (bfr*)(p.ws + O_OG) + tok * 1024 + hh * 64;
#pragma unroll
  for (int d = 0; d < 2; ++d)
#pragma unroll
    for (int g4 = 0; g4 < 4; ++g4) {
      int dv0 = d * 32 + 8 * g4 + 4 * h;
      uint2 z = *(const uint2*)(SZ + dv0);
      float z0 = __uint_as_float(z.x << 16), z1 = __uint_as_float(z.x & 0xffff0000u);
      float z2 = __uint_as_float(z.y << 16), z3 = __uint_as_float(z.y & 0xffff0000u);
      uint2 ov;
      ov.x = pk2(o[d][4 * g4 + 0] * inv * z0, o[d][4 * g4 + 1] * inv * z1);
      ov.y = pk2(o[d][4 * g4 + 2] * inv * z2, o[d][4 * g4 + 3] * inv * z3);
      *(uint2*)(OG + dv0) = ov;
    }
}

DI void phase_o3(const Params& p, char* smem) {
  AttnSmem* sm = (AttnSmem*)smem;
  const int xcd = blockIdx.x & 7, local = blockIdx.x >> 3, nloc = gridDim.x >> 3;
  for (int j = local; j < 256; j += nloc) {
    int u = xcd * 256 + j;
    attn_item(p, sm, u >> 4, LC + (u & 15) * 128, LALL);
  }
  for (int j = local; j < 32; j += nloc) {
    int u = xcd * 32 + j;
    attn_item(p, sm, u >> 1, (u & 1) * 128, LC);
  }
}

template <int LAYER>
DI void phase_oproj(const Params& p, char* smem) {
  GemmSmem* sm = (GemmSmem*)smem;
  WAVE_IDS
  constexpr int NROWS = LAYER == 0 ? TOK : NLAT;
  const int NT = 8, units = (NROWS / 128) * NT;
  const bfr* Ab = (const bfr*)(p.ws + (LAYER == 0 ? O_OG : O_Y2));
  const bfr* WT = (const bfr*)(p.ws + (LAYER == 0 ? O_WT_OUT0 : O_WT_OUT1));
  float* part = (float*)(p.ws + (LAYER == 0 ? O_PART1 : O_PART2));
  auto Aof = [&](int m0) { return [=](int row, int k) { return Ab + (size_t)(m0 + row) * 1024 + k; }; };
  auto Bof = [&](int n0) { return [=](int row, int k) { return WT + (size_t)(n0 + row) * 1024 + k; }; };
  GSTAGE_DECL;
  if ((int)blockIdx.x < units) {
    const int us = xcd_swz(blockIdx.x, NT);
    gemm_prefetch(GSTAGE_ARGS, Aof((us / NT) * 128), Bof((us % NT) * 128));
  }
  for (int u = blockIdx.x; u < units; u += gridDim.x) {
    const int us = xcd_swz(u, NT);
    int mt = us / NT, nt = us - mt * NT;
    int m0 = mt * 128, n0 = nt * 128;
    f32x16 acc[2][2];
    zero_acc(acc);
    gemm_main(acc, 32, Aof(m0), Bof(n0), sm, GSTAGE_ARGS);
    if (u + (int)gridDim.x < units) {
      const int us1 = xcd_swz(u + gridDim.x, NT);
      gemm_prefetch(GSTAGE_ARGS, Aof((us1 / NT) * 128), Bof((us1 % NT) * 128));
    }
    const float* xin;
    float* xout;
    const float* gt;
    if (LAYER == 0) {
      xin = xrow0(p, m0);
      xout = xrow1(p, m0);
      gt = modrow(p, 0, m0) + 2048;
    } else {
      xin = p.out + (size_t)m0 * 1024;
      xout = p.out + (size_t)m0 * 1024;
      gt = (const float*)(p.ws + O_MOD) + ((size_t)(9 + (m0 >> 11))) * 3072 + 2048;
    }
    float tot = 0.f;
#pragma unroll
    for (int mi = 0; mi < 2; ++mi) {
      float sq[16];
#pragma unroll
      for (int i = 0; i < 16; ++i) sq[i] = 0.f;
#pragma unroll
      for (int ni = 0; ni < 2; ++ni) {
        int col = n0 + wn * 64 + ni * 32 + r;
        float g = gt[col];
        float xv[16];
#pragma unroll
        for (int i = 0; i < 16; ++i) xv[i] = xin[(size_t)(wm * 64 + mi * 32 + crow(i, h)) * 1024 + col];
        SCHED_FENCE();
#pragma unroll
        for (int i = 0; i < 16; ++i) {
          int row = wm * 64 + mi * 32 + crow(i, h);
          float v = xv[i] + g * acc[mi][ni][i];
          xout[(size_t)row * 1024 + col] = v;
          sq[i] += v * v;
        }
        SCHED_FENCE();
      }
      if (LAYER == 1) {
        float t = transpose_reduce16(sq, lane);
        t += __shfl_xor(t, 16);
        if (((lane >> 4) & 1) == mi) tot = t;
      }
    }
    int idx = lane & 31;
    int row = m0 + wm * 64 + (idx >> 4) * 32 + crow(idx & 15, h);
    if (LAYER == 1) part[(size_t)(nt * 2 + wn) * NROWS + row] = tot;
  }
  if (LAYER == 0) {
    __syncthreads();
    phase_prep_b(p, smem, units % (int)gridDim.x);
  }
}

DI void phase_o5(const Params& p, char* smem) {
  GemmSmem* sm = (GemmSmem*)smem;
  WAVE_IDS
  const int ULAT = (NLAT / 128) * 16, units = ULAT + (NB * LC / 128) * 8;
  const bfr* WT = (const bfr*)(p.ws + O_WT_IN1);
  bfr* U2 = (bfr*)(p.ws + O_U2);
  bfr* SZ1 = (bfr*)(p.ws + O_SZ1);
  const bfr* Ah = (const bfr*)(p.ws + O_H1);
  auto coords = [&](int u, int& m0, int& n0) {
    if (u < ULAT) {
      const int us = xcd_swz(u, 16);
      int mtl = us >> 4;
      m0 = (mtl >> 4) * LALL + LC + (mtl & 15) * 128;
      n0 = (us & 15) * 128;
    } else {
      const int us = xcd_swz(u - ULAT, 8);
      int mtc = us >> 3;
      m0 = (mtc >> 1) * LALL + (mtc & 1) * 128;
      n0 = (us & 7) * 128;
    }
  };
  auto Aof = [&](int m0) { return [=](int row, int k) { return Ah + (size_t)(m0 + row) * 1024 + k; }; };
  auto Bof = [&](int n0) { return [=](int row, int k) { return WT + (size_t)(n0 + row) * 1024 + k; }; };
  GSTAGE_DECL;
  if ((int)blockIdx.x < units) {
    int m1, n1;
    coords(blockIdx.x, m1, n1);
    gemm_prefetch(GSTAGE_ARGS, Aof(m1), Bof(n1));
  }
  for (int u = blockIdx.x; u < units; u += gridDim.x) {
    int m0, n0;
    coords(u, m0, n0);
    int b = m0 / LALL, pos0 = m0 - b * LALL;
    f32x16 acc[2][2];
    zero_acc(acc);
    gemm_main(acc, 32, Aof(m0), Bof(n0), sm, GSTAGE_ARGS);
    if (u + (int)gridDim.x < units) {
      int m1, n1;
      coords(u + gridDim.x, m1, n1);
      gemm_prefetch(GSTAGE_ARGS, Aof(m1), Bof(n1));
    }
#pragma unroll
    for (int mi = 0; mi < 2; ++mi)
#pragma unroll
      for (int ni = 0; ni < 2; ++ni) {
        int col = n0 + wn * 64 + ni * 32 + r;
#pragma unroll
        for (int i = 0; i < 16; ++i) {
          int row = wm * 64 + mi * 32 + crow(i, h);
          int tok = m0 + row;
          float v = acc[mi][ni][i];
          if (col < 1024) U2[((size_t)(col >> 4) * TOK + tok) * 16 + (col & 15)] = f2bf(v);
          else SZ1[((size_t)(b * SEQ + pos0 + row - LC)) * 1024 + (col - 1024)] = f2bf(silu_f(v));
          SCHED_FENCE();
        }
      }
  }
}

DI void phase_o6(const Params& p, char* smem) {
  GemmSmem* sm = (GemmSmem*)smem;
  WAVE_IDS
  const int NROW = NB * NCH;
  const int units = 64 * 5 * 2;
  const bfr* U2 = (const bfr*)(p.ws + O_U2);
  const bfr* WST = (const bfr*)(p.ws + O_WST);
  float* SLOC = (float*)(p.ws + O_SLOC);
  for (int u = blockIdx.x; u < units; u += gridDim.x) {
    const int us = xcd_swz(u, 10);
    int g = us / 10, rem = us - g * 10;
    int mt = rem >> 1, nt = rem & 1;
    int m0 = mt * 128, n0 = nt * 128;
    const bfr* Ag = U2 + (size_t)g * TOK * 16;
    const bfr* Bg = WST + (size_t)g * 256 * 512;
    f32x16 acc[2][2];
    zero_acc(acc);
    gemm_full(
        acc, 16,
        [&](int row, int k) {
          int rr = m0 + row;
          rr = rr < NROW ? rr : NROW - 1;
          return Ag + (size_t)rr * 512 + k;
        },
        [&](int row, int k) { return Bg + (size_t)(n0 + row) * 512 + k; }, sm);
#pragma unroll
    for (int mi = 0; mi < 2; ++mi)
#pragma unroll
      for (int ni = 0; ni < 2; ++ni) {
        int col = n0 + wn * 64 + ni * 32 + r;
#pragma unroll
        for (int i = 0; i < 16; ++i) {
          int row = m0 + wm * 64 + mi * 32 + crow(i, h);
          SLOC[((size_t)g * SLOC_ROWS + row) * 256 + col] = acc[mi][ni][i];
        }
      }
  }
}

DI void phase_o7(const Params& p) {
  const int tidx_ = opaque_tid();
  const float* SLOC = (const float*)(p.ws + O_SLOC);
  bfr* SIN = (bfr*)(p.ws + O_SIN);
  const int total = NB * 64 * 2 * 64;
  for (int idx = blockIdx.x * 256 + tidx_; idx < total; idx += gridDim.x * 256) {
    int pp = idx & 63, dir = (idx >> 6) & 1, g = (idx >> 7) & 63, b = idx >> 13;
    double dt, ar, ai;
    float fr, fi, lr, li;
    s5_disc(p, dir, g, pp, dt, ar, ai, fr, fi);
    s5_pow(dt, ar, ai, TC, lr, li);
    float sr = 0.f, si = 0.f;
#pragma unroll 8
    for (int step = 0; step < NCH; ++step) {
      int cp = dir == 0 ? step : (step < 8 ? 7 - step : NCH - 1 - (step - 8));
      const float* sl = SLOC + ((size_t)g * SLOC_ROWS + b * NCH + cp) * 256 + dir * 128 + pp;
#ifdef PROBE_NOCARRY
      if ((dir == 0 && cp == 8) || (dir == 1 && cp == NCH - 1)) { sr = 0.f; si = 0.f; }
#endif
      if (cp >= 8) {
        bfr* so = SIN + ((size_t)g * (NB * NCHL) + b * NCHL + (cp - 8)) * 256 + dir * 128 + pp;
        so[0] = f2bf(sr);
        so[64] = f2bf(si);
      }
      float lre = sl[0], lim = sl[64];
      float nr = lr * sr - li * si + lre;
      float ni = lr * si + li * sr + lim;
      sr = nr;
      si = ni;
    }
  }
}

DI void phase_o8(const Params& p, char* smem) {
  GemmSmem* sm = (GemmSmem*)smem;
  WAVE_IDS
  const int units = 64 * 4 * 4;
  const bfr* U2 = (const bfr*)(p.ws + O_U2);
  const bfr* SIN = (const bfr*)(p.ws + O_SIN);
  const bfr* KTAB = (const bfr*)(p.ws + O_KTAB);
  const bfr* VOP = (const bfr*)(p.ws + O_VOP);
  bfr* YG = (bfr*)(p.ws + O_YG);
  for (int u = blockIdx.x; u < units; u += gridDim.x) {
    const int us = xcd_swz(u, 16);
    int g = us >> 4, mt = (us >> 2) & 3, nt = us & 3;
    int m0 = mt * 128, n0 = nt * 128;
    const bfr* Ug = U2 + (size_t)g * TOK * 16;
    f32x16 acc[2][2];
    zero_acc(acc);
    gemm_full(
        acc, 16,
        [&](int row, int k) {
          int rr = m0 + row;
          int b = rr >> 6, n = rr & 63;
          return Ug + ((size_t)b * LALL + LC + n * TC) * 16 + k;
        },
        [&](int row, int k) {
          int m = n0 + row;
          int t = m >> 4, c = m & 15;
          return KTAB + (((size_t)g * 63 + (t + 31)) * 16 + c) * 16 - (k >> 4) * 256 + (k & 15);
        },
        sm);
    gemm_full(
        acc, 8, [&](int row, int k) { return SIN + ((size_t)g * (NB * NCHL) + m0 + row) * 256 + k; },
        [&](int row, int k) { return VOP + ((size_t)g * 512 + n0 + row) * 256 + k; }, sm);
    {
      float* wl = (float*)sm + wave * 2048;
      const int mcol = n0 + wn * 64 + (lane & 7) * 8;
      const int t = mcol >> 4, c0 = mcol & 15;
      const int ch = g * 16 + c0;
      const float4 d0 = *(const float4*)(p.in[I_S5D] + ch), d1 = *(const float4*)(p.in[I_S5D] + ch + 4);
#pragma unroll
      for (int mi = 0; mi < 2; ++mi) {
        float4 lo[4], hi[4];
        stage_half8(acc, mi, wl, lo, hi, lane);
        uint4 uq[4];
#pragma unroll
        for (int c = 0; c < 4; ++c) {
          int rr = m0 + wm * 64 + mi * 32 + c * 8 + (lane >> 3);
          int b = rr >> 6, n = rr & 63;
          uq[c] = *(const uint4*)(Ug + ((size_t)b * LALL + LC + n * TC + t) * 16 + c0);
        }
        SCHED_FENCE();
#pragma unroll
        for (int c = 0; c < 4; ++c) {
          int rr = m0 + wm * 64 + mi * 32 + c * 8 + (lane >> 3);
          int b = rr >> 6, n = rr & 63;
          float4 u0 = bf4_to_f4(make_uint2(uq[c].x, uq[c].y)), u1 = bf4_to_f4(make_uint2(uq[c].z, uq[c].w));
          uint4 o;
          o.x = pk2(gelu_tanh(lo[c].x + d0.x * u0.x), gelu_tanh(lo[c].y + d0.y * u0.y));
          o.y = pk2(gelu_tanh(lo[c].z + d0.z * u0.z), gelu_tanh(lo[c].w + d0.w * u0.w));
          o.z = pk2(gelu_tanh(hi[c].x + d1.x * u1.x), gelu_tanh(hi[c].y + d1.y * u1.y));
          o.w = pk2(gelu_tanh(hi[c].z + d1.z * u1.z), gelu_tanh(hi[c].w + d1.w * u1.w));
          *(uint4*)(YG + ((size_t)(b * SEQ + n * TC + t)) * 1024 + ch) = o;
        }
        SCHED_FENCE();
      }
      __syncthreads();
    }
  }
}

DI void phase_o9(const Params& p, char* smem) {
  GemmSmem* sm = (GemmSmem*)smem;
  WAVE_IDS
  const int NT = 8, units = (NLAT / 128) * NT;
  const bfr* YG = (const bfr*)(p.ws + O_YG);
  const bfr* SZ1 = (const bfr*)(p.ws + O_SZ1);
  const bfr* WT = (const bfr*)(p.ws + O_WT_GLU);
  bfr* Y2 = (bfr*)(p.ws + O_Y2);
  auto Aof = [&](int m0) { return [=](int row, int k) { return YG + (size_t)(m0 + row) * 1024 + k; }; };
  auto Bof = [&](int n0) { return [=](int row, int k) { return WT + (size_t)(n0 + row) * 1024 + k; }; };
  GSTAGE_DECL;
  if ((int)blockIdx.x < units) {
    const int us = xcd_swz(blockIdx.x, NT);
    gemm_prefetch(GSTAGE_ARGS, Aof((us / NT) * 128), Bof((us % NT) * 128));
  }
  for (int u = blockIdx.x; u < units; u += gridDim.x) {
    const int us = xcd_swz(u, NT);
    int mt = us / NT, nt = us - mt * NT;
    int m0 = mt * 128, n0 = nt * 128;
    f32x16 acc[2][2];
    zero_acc(acc);
    gemm_main(acc, 32, Aof(m0), Bof(n0), sm, GSTAGE_ARGS);
    if (u + (int)gridDim.x < units) {
      const int us1 = xcd_swz(u + gridDim.x, NT);
      gemm_prefetch(GSTAGE_ARGS, Aof((us1 / NT) * 128), Bof((us1 % NT) * 128));
    }
    float* wl = (float*)sm + wave * 2048;
    const int ccol = n0 + wn * 64 + (lane & 15) * 4;
    const float4 bg = *(const float4*)(p.in[I_BGLU] + ccol);
#pragma unroll
    for (int mi = 0; mi < 2; ++mi) {
      float4 v[8];
      stage_half(acc, mi, wl, v, lane);
      uint2 yv[8], zv[8];
#pragma unroll
      for (int c = 0; c < 8; ++c) {
        size_t o = (size_t)(m0 + wm * 64 + mi * 32 + c * 4 + (lane >> 4)) * 1024 + ccol;
        yv[c] = *(const uint2*)(YG + o);
        zv[c] = *(const uint2*)(SZ1 + o);
      }
      SCHED_FENCE();
#pragma unroll
      for (int c = 0; c < 8; ++c) {
        size_t o = (size_t)(m0 + wm * 64 + mi * 32 + c * 4 + (lane >> 4)) * 1024 + ccol;
        float4 y = bf4_to_f4(yv[c]), z = bf4_to_f4(zv[c]);
        float4 ov;
        ov.x = y.x * sigmoid_f(v[c].x + bg.x) * z.x;
        ov.y = y.y * sigmoid_f(v[c].y + bg.y) * z.y;
        ov.z = y.z * sigmoid_f(v[c].z + bg.z) * z.z;
        ov.w = y.w * sigmoid_f(v[c].w + bg.w) * z.w;
        *(uint2*)(Y2 + o) = f4_to_bf4(ov);
      }
      SCHED_FENCE();
    }
    __syncthreads();
  }
}

#define XB_TMO      128
#define XB_XCNT(j)  (256  + 64 * (j))
#define XB_XSUB(j)  (1280 + 64 * (j))
#define XB_XGEN(j)  (2304 + 64 * (j))
#define XB_TOP      3328
#define XB_TOPGEN   3392
#define XCD_BAR_WORDS 3456
#define XB_SPIN_CAP (1u << 18)
#define LAS __attribute__((address_space(3)))
DI unsigned xb_ld(unsigned* p) { return __hip_atomic_load(p, __ATOMIC_RELAXED, __HIP_MEMORY_SCOPE_AGENT); }
DI unsigned xb_add(unsigned* p, unsigned v) { return __hip_atomic_fetch_add(p, v, __ATOMIC_RELAXED, __HIP_MEMORY_SCOPE_AGENT); }
DI unsigned xb_xcc_id() { return (unsigned)__builtin_amdgcn_s_getreg((3 << 11) | 20) & 0xFu; }
#define XB_SPIN(cond, bar) do { unsigned _sp = 0; while (cond) { __builtin_amdgcn_s_sleep(1); \
    if ((++_sp & 255u) == 0u) { if (xb_ld(&(bar)[XB_TMO])) break; if (_sp > XB_SPIN_CAP) { atomicAdd(&(bar)[XB_TMO], 1u); break; } } } } while (0)
struct XcdBarrier {
  unsigned* bar;
  unsigned x;
  volatile LAS unsigned* st;
};
DI XcdBarrier xcd_barrier_post(unsigned* bar, volatile LAS unsigned* st) {
  XcdBarrier b;
  b.bar = bar;
  b.x = xb_xcc_id();
  b.st = st;
  if (threadIdx.x == 0) (void)xb_add(&bar[XB_XCNT(b.x)], 1u);
  return b;
}
DI void xcd_barrier_complete(unsigned* bar, unsigned x, unsigned& nloc, unsigned& nx) {
  const unsigned G = gridDim.x * gridDim.y * gridDim.z;
  unsigned sum, cnt, mine, sp = 0u;
  for (;;) {
    sum = 0u; cnt = 0u; mine = 0u;
#pragma unroll
    for (unsigned j = 0; j < 16; ++j) {
      const unsigned c = xb_ld(&bar[XB_XCNT(j)]);
      sum += c;
      cnt += (c > 0u) ? 1u : 0u;
      mine = (j == x) ? c : mine;
    }
    if (sum == G) break;
    __builtin_amdgcn_s_sleep(1);
    if ((++sp & 255u) == 0u) {
      if (xb_ld(&bar[XB_TMO])) break;
      if (sp > XB_SPIN_CAP) { atomicAdd(&bar[XB_TMO], 1u); break; }
    }
  }
  nloc = mine > 0u ? mine : 1u;
  nx = cnt > 0u ? cnt : 1u;
}
DI void xcd_barrier(const XcdBarrier& b) {
  asm volatile("s_waitcnt vmcnt(0)" ::: "memory");
  __syncthreads();
  if (threadIdx.x == 0) {
    unsigned* bar = b.bar;
    __builtin_amdgcn_s_waitcnt(0);
    unsigned nloc = b.st[0], nx = b.st[1];
    if (nloc == 0u) {
      xcd_barrier_complete(bar, b.x, nloc, nx);
      b.st[0] = nloc;
      b.st[1] = nx;
    }
    const unsigned old = xb_add(&bar[XB_XSUB(b.x)], 1u);
    const unsigned gen = old / nloc;
    if (old + 1u == (gen + 1u) * nloc) {
      __builtin_amdgcn_fence(__ATOMIC_RELEASE, "agent");
      asm volatile("s_waitcnt vmcnt(0)" ::: "memory");
      const unsigned og = xb_add(&bar[XB_TOP], 1u);
      const unsigned tg = og / nx;
      if (og + 1u == (tg + 1u) * nx) xb_add(&bar[XB_TOPGEN], 1u);
      else XB_SPIN(xb_ld(&bar[XB_TOPGEN]) == tg, bar);
      __builtin_amdgcn_fence(__ATOMIC_ACQUIRE, "agent");
      xb_add(&bar[XB_XGEN(b.x)], 1u);
      asm volatile("s_waitcnt vmcnt(0)" ::: "memory");
    } else {
      XB_SPIN(xb_ld(&bar[XB_XGEN(b.x)]) == gen, bar);
      __builtin_amdgcn_fence(__ATOMIC_ACQUIRE, "agent");
      asm volatile("s_waitcnt vmcnt(0)" ::: "memory");
    }
  }
  __syncthreads();
}

DI void run_phase(const Params& p, int ph, char* smem) {
  switch (ph) {
#if !defined(ONLY) || ONLY == 0
    case PH_PREP: phase_prep(p, smem); break;
#endif
#if !defined(ONLY) || ONLY == 1
    case PH_FINAL: phase_final(p); break;
#endif
#if !defined(ONLY) || ONLY == 2
    case PH_O1: phase_o1(p, smem); break;
#endif
#if !defined(ONLY) || ONLY == 3
    case PH_O2: phase_o2(p, smem); break;
#endif
#if !defined(ONLY) || ONLY == 4
    case PH_O3: phase_o3(p, smem); break;
#endif
#if !defined(ONLY) || ONLY == 5
    case PH_O4: phase_oproj<0>(p, smem); break;
#endif
#if !defined(ONLY) || ONLY == 6
    case PH_O5: phase_o5(p, smem); break;
#endif
#if !defined(ONLY) || ONLY == 7
    case PH_O6: phase_o6(p, smem); break;
#endif
#if !defined(ONLY) || ONLY == 8
    case PH_O7: phase_o7(p); break;
#endif
#if !defined(ONLY) || ONLY == 9
    case PH_O8: phase_o8(p, smem); break;
#endif
#if !defined(ONLY) || ONLY == 10
    case PH_O9: phase_o9(p, smem); break;
#endif
#if !defined(ONLY) || ONLY == 11
    case PH_O10: phase_oproj<1>(p, smem); break;
#endif
    case PH_H0: phase_hconv<0>(p); break;
    case PH_H1: phase_hconv<1>(p); break;
    default: break;
  }
}

__global__ void __launch_bounds__(256, 2) mega_one(Params p, int ph) {
  __shared__ __attribute__((aligned(16))) char smem[SMEM_BYTES];
  run_phase(p, ph, smem);
}

#if !defined(ONLY) && SINGLE_LAUNCH
__global__ void __launch_bounds__(256, 2) mega(Params p) {
  __shared__ __attribute__((aligned(16))) char smem[SMEM_BYTES];
  __shared__ uint4 xb_words;
  if (threadIdx.x == 0) xb_words = make_uint4(0u, 0u, 0u, 0u);
  __syncthreads();
  if (p.nprog < 0) cg::this_grid().sync();
  const XcdBarrier xb = xcd_barrier_post((unsigned*)(p.ws + O_BAR), (volatile LAS unsigned*)&xb_words);
  cg::grid_group grid = cg::this_grid();
#if !defined(OMIT) || OMIT != 0
  phase_prep(p, smem);
#endif
  xcd_barrier(xb);
#if (DUP >> 0) & 1
  phase_prep(p, smem);
  xcd_barrier(xb);
#endif
  phase_hconv<0>(p);
  xcd_barrier(xb);
#if !defined(OMIT) || OMIT != 1
  phase_o1(p, smem);
#endif
  xcd_barrier(xb);
#if (DUP >> 1) & 1
  phase_o1(p, smem);
  xcd_barrier(xb);
#endif
#if !defined(OMIT) || OMIT != 2
  phase_o2(p, smem);
#endif
  xcd_barrier(xb);
#if (DUP >> 2) & 1
  phase_o2(p, smem);
  xcd_barrier(xb);
#endif
#if !defined(OMIT) || OMIT != 3
  phase_o3(p, smem);
#endif
  xcd_barrier(xb);
#if (DUP >> 3) & 1
  phase_o3(p, smem);
  xcd_barrier(xb);
#endif
#if !defined(OMIT) || OMIT != 4
  phase_oproj<0>(p, smem);
#endif
  xcd_barrier(xb);
#if (DUP >> 4) & 1
  phase_oproj<0>(p, smem);
  xcd_barrier(xb);
#endif
  phase_hconv<1>(p);
  xcd_barrier(xb);
#if !defined(OMIT) || OMIT != 5
  phase_o5(p, smem);
#endif
  xcd_barrier(xb);
#if (DUP >> 5) & 1
  phase_o5(p, smem);
  xcd_barrier(xb);
#endif
#if !defined(OMIT) || OMIT != 6
  phase_o6(p, smem);
#endif
  xcd_barrier(xb);
#if (DUP >> 6) & 1
  phase_o6(p, smem);
  xcd_barrier(xb);
#endif
#if !defined(OMIT) || OMIT != 7
  phase_o7(p);
#endif
  xcd_barrier(xb);
#if (DUP >> 7) & 1
  phase_o7(p);
  xcd_barrier(xb);
#endif
#if !defined(OMIT) || OMIT != 8
  phase_o8(p, smem);
#endif
  xcd_barrier(xb);
#if (DUP >> 8) & 1
  phase_o8(p, smem);
  xcd_barrier(xb);
#endif
#if !defined(OMIT) || OMIT != 9
  phase_o9(p, smem);
#endif
  xcd_barrier(xb);
#if (DUP >> 9) & 1
  phase_o9(p, smem);
  xcd_barrier(xb);
#endif
#if !defined(OMIT) || OMIT != 10
  phase_oproj<1>(p, smem);
#endif
  xcd_barrier(xb);
#if !defined(OMIT) || OMIT != 11
  phase_final(p);
#endif
}
#else
__global__ void mega(Params p) {}
#endif


extern "C" void kernel_launch(void* const* d_in, const int* in_sizes, int n_in, void* d_out, int out_size, void* d_ws,
                              size_t ws_size, hipStream_t stream) {
  static int grid_blocks = 0;
  if (!grid_blocks) {
    int dev = 0, cus = 0, per_cu = 0;
    hipGetDevice(&dev);
    hipDeviceGetAttribute(&cus, hipDeviceAttributeMultiprocessorCount, dev);
#if SINGLE_LAUNCH
    hipOccupancyMaxActiveBlocksPerMultiprocessor(&per_cu, mega, 256, 0);
#else
    hipOccupancyMaxActiveBlocksPerMultiprocessor(&per_cu, mega_one, 256, 0);
#endif
    if (per_cu < 1) per_cu = 1;
    if (per_cu > 2) per_cu = 2;
    grid_blocks = cus * per_cu;
  }
  if (ws_size < WS_NEED || n_in < N_INPUTS) {
    fprintf(stderr, "workspace too small or bad inputs: %zu < %zu\n", ws_size, (size_t)WS_NEED);
    return;
  }
  Params p{};
  for (int i = 0; i < N_INPUTS; ++i) p.in[i] = (const float*)d_in[i];
  p.out = (float*)d_out;
  p.ws = (char*)d_ws;
#ifndef PROG
#define PROG PH_PREP, PH_H0, PH_O1, PH_O2, PH_O3, PH_O4, PH_H1, PH_O5, PH_O6, PH_O7, PH_O8, PH_O9, PH_O10, PH_FINAL
#endif
  const int prog[] = {PROG};
  p.nprog = (int)(sizeof(prog) / sizeof(int));
  for (int i = 0; i < p.nprog; ++i) p.prog[i] = prog[i];
#if SINGLE_LAUNCH
  hipMemsetAsync((char*)d_ws + O_BAR, 0, BAR_BYTES, stream);
  void* args[] = {&p};
  hipError_t e = hipLaunchCooperativeKernel((void*)mega, dim3(grid_blocks), dim3(256), args, 0, stream);
  if (e != hipSuccess) fprintf(stderr, "cooperative launch failed: %s (grid %d)\n", hipGetErrorString(e), grid_blocks);
#else
  for (int i = 0; i < p.nprog; ++i) {
    mega_one<<<dim3(grid_blocks), dim3(256), 0, stream>>>(p, p.prog[i]);
  }
#endif
}
```

```cpp
#include <hip/hip_runtime.h>
#include <hip/hip_cooperative_groups.h>
#include <cstdio>
namespace cg = cooperative_groups;
#ifndef DUP
#define DUP 0
#endif
#ifndef USE_NAIVE
#define USE_NAIVE 0
#endif
#ifndef SINGLE_LAUNCH
#define SINGLE_LAUNCH 1
#endif

#define DI __device__ __forceinline__
typedef unsigned short bfr;

constexpr int D = 1024, NB = 8, SEQ = 2048, LC = 256, LALL = 2304;
constexpr int TOK = NB * LALL;
constexpr int NLAT = NB * SEQ;
constexpr int NH = 16, DQK = 96, DV = 64;
constexpr int NIN0 = 1440, NIN1 = 2048;
constexpr float EPS = 1e-6f;
constexpr float QSCALE = 0.10206207261596577f * 1.4426950408889634f;
constexpr int TC = 32;
constexpr int NCH = LALL / TC;
constexpr int NCHL = SEQ / TC;

enum { I_X = 0, I_C, I_CTX, I_CCTX, I_ADAW, I_ADAB, I_NORMG, I_WIN0, I_QNORM, I_WUQ, I_KVNORM, I_WUKV, I_WOUT0,
       I_WIN1, I_ARE, I_AIM, I_LOGSTEP, I_BRE, I_BIM, I_CRE, I_CIM, I_S5D, I_WGLU, I_BGLU, I_WOUT1, I_FINALG, N_INPUTS };

constexpr size_t al256(size_t x) { return (x + 255) & ~(size_t)255; }
constexpr size_t O_WT_IN0 = 0;
constexpr size_t O_WT_UQ = O_WT_IN0 + al256((size_t)NIN0 * 1024 * 2);
constexpr size_t O_WT_UKV = O_WT_UQ + al256((size_t)1536 * 256 * 2);
constexpr size_t O_WT_OUT0 = O_WT_UKV + al256((size_t)2048 * 128 * 2);
constexpr size_t O_WT_IN1 = O_WT_OUT0 + al256((size_t)1024 * 1024 * 2);
constexpr size_t O_WT_GLU = O_WT_IN1 + al256((size_t)2048 * 1024 * 2);
constexpr size_t O_WT_OUT1 = O_WT_GLU + al256((size_t)1024 * 1024 * 2);
constexpr size_t O_MOD = O_WT_OUT1 + al256((size_t)1024 * 1024 * 2);
constexpr size_t O_RS0 = O_MOD + al256((size_t)2 * 9 * 3072 * 4);
constexpr size_t O_PART1 = O_RS0 + al256((size_t)TOK * 4);
constexpr size_t O_PART2 = O_PART1 + al256((size_t)16 * TOK * 4);
constexpr size_t O_X1CTX = O_PART2 + al256((size_t)16 * NLAT * 4);
constexpr size_t O_KTAB = O_X1CTX + al256((size_t)NB * LC * 1024 * 4);
constexpr size_t O_WST = O_KTAB + al256((size_t)64 * 63 * 256 * 2);
constexpr size_t O_VOP = O_WST + al256((size_t)64 * 256 * 512 * 2);
constexpr size_t O_BAR = O_VOP + al256((size_t)64 * 512 * 256 * 2);
constexpr size_t BAR_BYTES = 3456 * 4;
constexpr size_t O_LAYER = O_BAR + al256(BAR_BYTES);
constexpr size_t O_PC = O_LAYER;
constexpr size_t O_SZ0 = O_PC + al256((size_t)TOK * 384 * 2);
constexpr size_t O_K = O_SZ0 + al256((size_t)TOK * 1024 * 2);
constexpr size_t O_VT = O_K + al256((size_t)NB * NH * LALL * 64 * 2);
constexpr size_t O_OG = O_VT + al256((size_t)NB * NH * DV * LALL * 2);
constexpr size_t O_KR = O_OG + al256((size_t)TOK * 1024 * 2);
constexpr size_t O_END0 = O_KR + al256((size_t)TOK * 32 * 2);
constexpr size_t O_H0 = O_OG;
constexpr size_t O_U2 = O_LAYER;
constexpr size_t O_SZ1 = O_U2 + al256((size_t)64 * TOK * 16 * 2);
constexpr size_t O_SLOC = O_SZ1 + al256((size_t)NLAT * 1024 * 2);
constexpr int SLOC_ROWS = 640;
constexpr size_t O_SIN = O_SLOC + al256((size_t)64 * SLOC_ROWS * 256 * 4);
constexpr size_t O_YG = O_SIN + al256((size_t)64 * (NB * NCHL) * 256 * 2);
constexpr size_t O_H1 = O_YG + al256((size_t)NLAT * 1024 * 2);
constexpr size_t O_END1 = O_H1 + al256((size_t)TOK * 1024 * 2);
constexpr size_t O_Y2 = O_SLOC;
constexpr size_t WS_NEED = (O_END0 > O_END1 ? O_END0 : O_END1);
static_assert(WS_NEED <= (size_t)256 * 1024 * 1024, "workspace too large");
static_assert((size_t)NB * NH * LALL * DQK * 2 <= (size_t)NLAT * 1024 * 4, "Q does not fit d_out");

struct Params {
  const float* in[N_INPUTS];
  float* out;
  char* ws;
  int prog[32];
  int nprog;
  int pad;
};

DI bfr f2bf(float x) {
  unsigned u = __float_as_uint(x);
  u += 0x7fffu + ((u >> 16) & 1u);
  return (bfr)(u >> 16);
}
typedef __bf16 bf2_t __attribute__((ext_vector_type(2)));
typedef float f2_t __attribute__((ext_vector_type(2)));
DI unsigned pk2(float a, float b) {
  f2_t v = {a, b};
  bf2_t r = __builtin_convertvector(v, bf2_t);
  return __builtin_bit_cast(unsigned, r);
}
DI int opaque_tid() {
  int t = threadIdx.x;
  asm volatile("" : "+v"(t));
  return t;
}
DI float bf2f(bfr b) { return __uint_as_float(((unsigned)b) << 16); }
DI float silu_f(float v) { return v / (1.f + __expf(-v)); }
DI float sigmoid_f(float v) { return 1.f / (1.f + __expf(-v)); }
DI float gelu_tanh(float v) {
  float u = 0.7978845608028654f * (v + 0.044715f * v * v * v);
  return 0.5f * v * (1.f + tanhf(u));
}
DI float wave_sum(float v) {
#pragma unroll
  for (int o = 32; o > 0; o >>= 1) v += __shfl_xor(v, o);
  return v;
}
DI float wave_max(float v) {
#pragma unroll
  for (int o = 32; o > 0; o >>= 1) v = fmaxf(v, __shfl_xor(v, o));
  return v;
}
DI const float* xrow0(const Params& p, int tok) {
  int b = tok / LALL, pos = tok - b * LALL;
  return pos < LC ? p.in[I_CTX] + ((size_t)(b * LC + pos)) * D : p.in[I_X] + ((size_t)(b * SEQ + pos - LC)) * D;
}
DI float* xrow1(const Params& p, int tok) {
  int b = tok / LALL, pos = tok - b * LALL;
  return pos < LC ? (float*)(p.ws + O_X1CTX) + ((size_t)(b * LC + pos)) * D : p.out + ((size_t)(b * SEQ + pos - LC)) * D;
}
DI const float* modrow(const Params& p, int layer, int tok) {
  int b = tok / LALL, pos = tok - b * LALL;
  int r = pos < LC ? 8 : b;
  return (const float*)(p.ws + O_MOD) + ((size_t)(layer * 9 + r)) * 3072;
}
DI void rope_cs(int fi, int posv, float& cs, float& sn) {
  float inv = __builtin_amdgcn_exp2f(-(float)fi * (13.287712379549449f / 8.f));
  float rev = (float)posv * inv * 0.15915494309189535f;
  rev -= floorf(rev);
  sn = __builtin_amdgcn_sinf(rev);
  cs = __builtin_amdgcn_cosf(rev);
}
DI float rope_apply(int j, float v, float vp, int lpos) {
  int posv = (j & 16) ? (lpos & 63) : (lpos >> 6);
  float cs, sn;
  rope_cs(j & 7, posv, cs, sn);
  return (j & 8) ? (vp * sn + v * cs) : (v * cs - vp * sn);
}

DI void s5_disc(const Params& p, int dir, int g, int pp, double& dt, double& ar, double& ai, float& fr, float& fi) {
  dt = exp((double)p.in[I_LOGSTEP][dir * 64 + g]);
  ar = (double)p.in[I_ARE][(dir * 64 + g) * 64 + pp];
  ai = (double)p.in[I_AIM][(dir * 64 + g) * 64 + pp];
  double mag = exp(ar * dt);
  double a = ai * dt;
  a -= 6.283185307179586 * rint(a * 0.15915494309189535);
  float sn, cs;
  sincosf((float)a, &sn, &cs);
  double lr = mag * (double)cs, li = mag * (double)sn;
  double den = ar * ar + ai * ai, nr = lr - 1.0;
  fr = (float)((nr * ar + li * ai) / den);
  fi = (float)((li * ar - nr * ai) / den);
}
DI void s5_pow(double dt, double ar, double ai, int k, float& wr, float& wi) {
  double mag = exp(ar * dt * (double)k);
  double a = ai * dt * (double)k;
  a -= 6.283185307179586 * rint(a * 0.15915494309189535);
  float sn, cs;
  sincosf((float)a, &sn, &cs);
  wr = (float)mag * cs;
  wi = (float)mag * sn;
}

enum { PH_PREP = 0, PH_N1, PH_N2, PH_N3, PH_N4, PH_N4B, PH_N5, PH_N6A, PH_N6B, PH_N9, PH_N10, PH_N10B, PH_FINAL,
       PH_O1, PH_O2, PH_O3, PH_O4, PH_O5, PH_O6, PH_O7, PH_O8, PH_O9, PH_O10, PH_H0, PH_H1, PH_COUNT };

constexpr int SMEM_BYTES = 48 * 1024;


DI void prep_transpose(const Params& p, int widx, int tile, char* smem) {
  const int tidx_ = opaque_tid();
  int K, N;
  size_t dst;
  const float* W;
  const float* scl = nullptr;
  switch (widx) {
    case 0: W = p.in[I_WIN0]; K = 1024; N = NIN0; dst = O_WT_IN0; break;
    case 1: W = p.in[I_WUQ]; K = 256; N = 1536; dst = O_WT_UQ; scl = p.in[I_QNORM]; break;
    case 2: W = p.in[I_WUKV]; K = 128; N = 2048; dst = O_WT_UKV; scl = p.in[I_KVNORM]; break;
    case 3: W = p.in[I_WOUT0]; K = 1024; N = 1024; dst = O_WT_OUT0; break;
    case 4: W = p.in[I_WIN1]; K = 1024; N = NIN1; dst = O_WT_IN1; break;
    case 5: W = p.in[I_WGLU]; K = 1024; N = 1024; dst = O_WT_GLU; break;
    default: W = p.in[I_WOUT1]; K = 1024; N = 1024; dst = O_WT_OUT1; break;
  }
  float (*t)[33] = (float (*)[33])smem;
  int ntn = N / 32;
  int kt = tile / ntn, nt = tile - kt * ntn;
  int tx = tidx_ & 31, ty = tidx_ >> 5;
  float v[16];
#pragma unroll
  for (int i = 0; i < 16; ++i) {
    int k = kt * 128 + ty + 8 * i, n = nt * 32 + tx;
    v[i] = W[(size_t)k * N + n];
  }
  if (scl) {
#pragma unroll
    for (int i = 0; i < 16; ++i) v[i] *= scl[kt * 128 + ty + 8 * i];
  }
#pragma unroll
  for (int i = 0; i < 16; ++i) t[ty + 8 * i][tx] = v[i];
  __syncthreads();
  bfr* Wt = (bfr*)(p.ws + dst);
  {
    int nl = tidx_ >> 3, kc = (tidx_ & 7) * 16;
    unsigned w[8];
#pragma unroll
    for (int j = 0; j < 8; ++j) w[j] = pk2(t[kc + 2 * j][nl], t[kc + 2 * j + 1][nl]);
    uint4* dstp = (uint4*)(Wt + (size_t)(nt * 32 + nl) * K + kt * 128 + kc);
    dstp[0] = make_uint4(w[0], w[1], w[2], w[3]);
    dstp[1] = make_uint4(w[4], w[5], w[6], w[7]);
  }
  __syncthreads();
}

DI void prep_mod(const Params& p, int unit, char* smem) {
  const int tidx_ = opaque_tid();
  int layer = unit / 192, cgp = unit - layer * 192;
  float* sil = (float*)smem;
  float* red = sil + 9 * 1024;
  for (int i = tidx_; i < 9 * 1024; i += 256) {
    int r = i >> 10, k = i & 1023;
    float v = r < 8 ? p.in[I_C][r * 1024 + k] : p.in[I_CCTX][k];
    sil[i] = silu_f(v);
  }
  __syncthreads();
  int nn = tidx_ & 15, kg = tidx_ >> 4;
  int n = cgp * 16 + nn;
  const float* W = p.in[I_ADAW] + (size_t)layer * 1024 * 3072 + n;
  float acc[9];
#pragma unroll
  for (int r = 0; r < 9; ++r) acc[r] = 0.f;
#pragma unroll 8
  for (int k = kg * 64; k < kg * 64 + 64; ++k) {
    float w = W[(size_t)k * 3072];
#pragma unroll
    for (int r = 0; r < 9; ++r) acc[r] += sil[r * 1024 + k] * w;
  }
#pragma unroll
  for (int r = 0; r < 9; ++r) red[(kg * 9 + r) * 16 + nn] = acc[r];
  __syncthreads();
  if (tidx_ < 144) {
    int r = tidx_ >> 4, c = tidx_ & 15;
    int nc = cgp * 16 + c;
    float s = p.in[I_ADAB][layer * 3072 + nc];
#pragma unroll
    for (int g = 0; g < 16; ++g) s += red[(g * 9 + r) * 16 + c];
    ((float*)(p.ws + O_MOD))[((size_t)(layer * 9 + r)) * 3072 + nc] = s;
  }
  __syncthreads();
}

DI void prep_ktab(const Params& p, int unit, char* smem) {
  const int tidx_ = opaque_tid();
  int g = unit / 7, lg = unit - g * 7;
  float2* E = (float2*)smem;
  int tid = tidx_;
  const bool use_f = lg >= 3, use_r = lg <= 3;
  for (int i = tid; i < 9 * 128; i += 256) {
    int l = i >> 7, dir = (i >> 6) & 1, pp = i & 63;
    int lag = lg * 9 + l - 31;
    bool used = (dir == 0) ? (lag >= 0) : (lag <= 0);
    float2 e = make_float2(0.f, 0.f);
    if (used) {
      double dt, ar, ai;
      float fr, fi, wr, wi;
      s5_disc(p, dir, g, pp, dt, ar, ai, fr, fi);
      s5_pow(dt, ar, ai, lag < 0 ? -lag : lag, wr, wi);
      e.x = wr * fr - wi * fi;
      e.y = wr * fi + wi * fr;
    }
    E[(l * 2 + dir) * 64 + pp] = e;
  }
  __syncthreads();
  int c = tid >> 4, c2 = tid & 15;
  float acc[9];
#pragma unroll
  for (int l = 0; l < 9; ++l) acc[l] = 0.f;
  for (int dir = 0; dir < 2; ++dir) {
    if (dir == 0 ? !use_f : !use_r) continue;
    const float* bre = p.in[I_BRE] + ((size_t)(dir * 64 + g)) * 64 * 16;
    const float* bim = p.in[I_BIM] + ((size_t)(dir * 64 + g)) * 64 * 16;
    const float* cre = p.in[I_CRE] + ((size_t)(dir * 64 + g)) * 16 * 64;
    const float* cim = p.in[I_CIM] + ((size_t)(dir * 64 + g)) * 16 * 64;
#pragma unroll 4
    for (int pp = 0; pp < 64; ++pp) {
      float br = bre[pp * 16 + c2], bi = bim[pp * 16 + c2];
      float cr = cre[c * 64 + pp], ci = cim[c * 64 + pp];
      float mr = cr * br - ci * bi, mi = cr * bi + ci * br;
#pragma unroll
      for (int l = 0; l < 9; ++l) {
        float2 e = E[(l * 2 + dir) * 64 + pp];
        acc[l] += mr * e.x - mi * e.y;
      }
    }
  }
  bfr* KT = (bfr*)(p.ws + O_KTAB);
#pragma unroll
  for (int l = 0; l < 9; ++l) KT[(((size_t)g * 63 + lg * 9 + l) * 16 + c) * 16 + c2] = f2bf(acc[l]);
  __syncthreads();
}

DI void prep_ops(const Params& p, int unit) {
  const int tidx_ = opaque_tid();
  int idx = unit * 256 + tidx_;
  int pp = idx & 63, t = (idx >> 6) & 31, dir = (idx >> 11) & 1, g = idx >> 12;
  double dt, ar, ai;
  float fr, fi, wr, wi;
  s5_disc(p, dir, g, pp, dt, ar, ai, fr, fi);
  s5_pow(dt, ar, ai, dir == 0 ? (TC - 1 - t) : t, wr, wi);
  float er = wr * fr - wi * fi, ei = wr * fi + wi * fr;
  const float* bre = p.in[I_BRE] + (((size_t)(dir * 64 + g)) * 64 + pp) * 16;
  const float* bim = p.in[I_BIM] + (((size_t)(dir * 64 + g)) * 64 + pp) * 16;
  bfr* wst = (bfr*)(p.ws + O_WST) + (size_t)g * 256 * 512;
  bfr* rre = wst + (size_t)(dir * 128 + pp) * 512 + t * 16;
  bfr* rim = wst + (size_t)(dir * 128 + 64 + pp) * 512 + t * 16;
#pragma unroll
  for (int c2 = 0; c2 < 16; ++c2) {
    float br = bre[c2], bi = bim[c2];
    rre[c2] = f2bf(er * br - ei * bi);
    rim[c2] = f2bf(er * bi + ei * br);
  }
  s5_pow(dt, ar, ai, dir == 0 ? (t + 1) : (TC - t), wr, wi);
  const float* cre = p.in[I_CRE] + ((size_t)(dir * 64 + g)) * 16 * 64;
  const float* cim = p.in[I_CIM] + ((size_t)(dir * 64 + g)) * 16 * 64;
  bfr* vop = (bfr*)(p.ws + O_VOP) + (size_t)g * 512 * 256;
#pragma unroll
  for (int c = 0; c < 16; ++c) {
    float cr = cre[c * 64 + pp], ci = cim[c * 64 + pp];
    float dr = cr * wr - ci * wi, di = cr * wi + ci * wr;
    vop[(size_t)(t * 16 + c) * 256 + dir * 128 + pp] = f2bf(dr);
    vop[(size_t)(t * 16 + c) * 256 + dir * 128 + 64 + pp] = f2bf(-di);
  }
}

constexpr int TR_T0 = 8 * 45, TR_T1 = 2 * 48, TR_T2 = 1 * 64, TR_T3 = 256, TR_T4 = 8 * 64, TR_T5 = 256, TR_T6 = 256;
constexpr int TR_TOTAL = TR_T0 + TR_T1 + TR_T2 + TR_T3 + TR_T4 + TR_T5 + TR_T6;
constexpr int U_MOD = 384, U_RS0 = 0, U_KTAB = 64 * 7, U_OPS = 64 * 2 * 64 * 32 / 256;
constexpr int PREP_A_UNITS = U_MOD + TR_T0 + TR_T1 + TR_T2 + TR_T3;
constexpr int PREP_B_UNITS = TR_T4 + TR_T5 + TR_T6 + U_KTAB + U_OPS;

DI void phase_prep(const Params& p, char* smem) {
  for (int u = blockIdx.x; u < PREP_A_UNITS; u += gridDim.x) {
    int v = u;
    if (v < U_MOD) { prep_mod(p, v, smem); continue; }
    v -= U_MOD;
    int w = 0;
    if (v >= TR_T0) { v -= TR_T0; w = 1;
      if (v >= TR_T1) { v -= TR_T1; w = 2;
        if (v >= TR_T2) { v -= TR_T2; w = 3; } } }
    prep_transpose(p, w, v, smem);
  }
}
DI void phase_prep_b(const Params& p, char* smem, int first_blk) {
  if (first_blk >= (int)gridDim.x) first_blk = 0;
  if ((int)blockIdx.x < first_blk) return;
  const int nb = gridDim.x - first_blk;
  for (int u = blockIdx.x - first_blk; u < PREP_B_UNITS; u += nb) {
    int v = u;
    if (v < TR_T4 + TR_T5 + TR_T6) {
      int w = 4;
      if (v >= TR_T4) { v -= TR_T4; w = 5;
        if (v >= TR_T5) { v -= TR_T5; w = 6; } }
      prep_transpose(p, w, v, smem);
      continue;
    }
    v -= TR_T4 + TR_T5 + TR_T6;
    if (v < U_KTAB) { prep_ktab(p, v, smem); continue; }
    v -= U_KTAB;
    prep_ops(p, v);
  }
}

DI float rs_from_part(const float* part, int nrows, int r) {
  float s = 0.f;
#pragma unroll
  for (int j = 0; j < 16; ++j) s += part[(size_t)j * nrows + r];
  return rsqrtf(s * (1.f / 1024.f) + EPS);
}

DI void phase_final(const Params& p) {
  const int tidx_ = opaque_tid();
  const float* part = (const float*)(p.ws + O_PART2);
  const float4* g4 = (const float4*)p.in[I_FINALG];
  int lane = tidx_ & 63;
  float4 g[4];
#pragma unroll
  for (int i = 0; i < 4; ++i) g[i] = g4[lane + 64 * i];
  for (int r = (blockIdx.x * 4 + (tidx_ >> 6)) * 2; r < NLAT; r += gridDim.x * 8) {
    float4* row0 = (float4*)(p.out + (size_t)r * D);
    float4* row1 = row0 + D / 4;
    float4 v0[4], v1[4];
#pragma unroll
    for (int i = 0; i < 4; ++i) {
      v0[i] = row0[lane + 64 * i];
      v1[i] = row1[lane + 64 * i];
    }
    float ps = part[(size_t)(lane & 15) * NLAT + r + ((lane >> 4) & 1)];
    ps += __shfl_xor(ps, 1);
    ps += __shfl_xor(ps, 2);
    ps += __shfl_xor(ps, 4);
    ps += __shfl_xor(ps, 8);
    const float rs0 = rsqrtf(__shfl(ps, 0) * (1.f / 1024.f) + EPS);
    const float rs1 = rsqrtf(__shfl(ps, 16) * (1.f / 1024.f) + EPS);
#pragma unroll
    for (int i = 0; i < 4; ++i) {
      float4 a = v0[i], c = v1[i];
      a.x *= rs0 * g[i].x; a.y *= rs0 * g[i].y; a.z *= rs0 * g[i].z; a.w *= rs0 * g[i].w;
      c.x *= rs1 * g[i].x; c.y *= rs1 * g[i].y; c.z *= rs1 * g[i].z; c.w *= rs1 * g[i].w;
      row0[lane + 64 * i] = a;
      row1[lane + 64 * i] = c;
    }
  }
}

typedef short bf16x8 __attribute__((ext_vector_type(8)));
typedef short s16x4 __attribute__((ext_vector_type(4)));
typedef float f32x16 __attribute__((ext_vector_type(16)));
#define SCHED_FENCE() __builtin_amdgcn_sched_barrier(0)
#define MFMA32(a, b, c) __builtin_amdgcn_mfma_f32_32x32x16_bf16((a), (b), (c), 0, 0, 0)
DI int xcd_swz(int u, int per) {
  int x = u & 7, q = u >> 3;
  int qq = q / per;
  return (x + 8 * qq) * per + (q - qq * per);
}
DI int crow(int i, int h) { return (i & 3) + 8 * (i >> 2) + 4 * h; }

constexpr int LDT = 40;
struct GemmSmem {
  bfr A[2][128 * LDT];
  bfr B[2][128 * LDT];
  float rs[128];
};
static_assert(sizeof(GemmSmem) <= SMEM_BYTES, "smem");

DI void zero_acc(f32x16 (&acc)[2][2]) {
#pragma unroll
  for (int a = 0; a < 2; ++a)
#pragma unroll
    for (int b = 0; b < 2; ++b)
#pragma unroll
      for (int i = 0; i < 16; ++i) acc[a][b][i] = 0.f;
}

#define GSTAGE_DECL uint4 ga0, ga1, gb0, gb1, gc0, gc1, gd0, gd1
#define GSTAGE_ARGS ga0, ga1, gb0, gb1, gc0, gc1, gd0, gd1
#define GSTAGE_PARAMS uint4 &a0, uint4 &a1, uint4 &b0, uint4 &b1, uint4 &c0, uint4 &c1, uint4 &d0, uint4 &d1
template <class AAddr, class BAddr>
DI void gemm_prefetch(GSTAGE_PARAMS, AAddr aaddr, BAddr baddr) {
  const int tid = opaque_tid();
  const int lrow = tid >> 2, lkc = (tid & 3) * 8;
  b0 = *(const uint4*)baddr(lrow, lkc);
  b1 = *(const uint4*)baddr(lrow + 64, lkc);
  a0 = *(const uint4*)aaddr(lrow, lkc);
  a1 = *(const uint4*)aaddr(lrow + 64, lkc);
  d0 = *(const uint4*)baddr(lrow, 32 + lkc);
  d1 = *(const uint4*)baddr(lrow + 64, 32 + lkc);
  c0 = *(const uint4*)aaddr(lrow, 32 + lkc);
  c1 = *(const uint4*)aaddr(lrow + 64, 32 + lkc);
  SCHED_FENCE();
}
template <class AAddr, class BAddr>
DI void gemm_main(f32x16 (&acc)[2][2], int KT, AAddr aaddr, BAddr baddr, GemmSmem* sm, GSTAGE_PARAMS) {
  const int tid = opaque_tid(), lane = tid & 63, wave = tid >> 6;
  const int wm = wave >> 1, wn = wave & 1, r = lane & 31, h = lane >> 5;
  const int lrow = tid >> 2, lkc = (tid & 3) * 8;
#define GM_LOAD(KT_, A0, A1, B0, B1)                   \
  {                                                    \
    const int kk_ = (KT_) * 32 + lkc;                  \
    B0 = *(const uint4*)baddr(lrow, kk_);              \
    B1 = *(const uint4*)baddr(lrow + 64, kk_);         \
    A0 = *(const uint4*)aaddr(lrow, kk_);              \
    A1 = *(const uint4*)aaddr(lrow + 64, kk_);         \
  }
#define GM_STORE(BUF_, A0, A1, B0, B1)                                  \
  {                                                                     \
    *(uint4*)(sm->B[BUF_] + lrow * LDT + lkc) = B0;                     \
    *(uint4*)(sm->B[BUF_] + (lrow + 64) * LDT + lkc) = B1;              \
    *(uint4*)(sm->A[BUF_] + lrow * LDT + lkc) = A0;                     \
    *(uint4*)(sm->A[BUF_] + (lrow + 64) * LDT + lkc) = A1;              \
  }
#define GM_COMPUTE(BUF_)                                                                                       \
  _Pragma("unroll") for (int ks = 0; ks < 2; ++ks) {                                                           \
    bf16x8 a_[2], b_[2];                                                                                       \
    _Pragma("unroll") for (int mi = 0; mi < 2; ++mi)                                                           \
        a_[mi] = *(const bf16x8*)(sm->A[BUF_] + (wm * 64 + mi * 32 + r) * LDT + ks * 16 + h * 8);              \
    _Pragma("unroll") for (int ni = 0; ni < 2; ++ni)                                                           \
        b_[ni] = *(const bf16x8*)(sm->B[BUF_] + (wn * 64 + ni * 32 + r) * LDT + ks * 16 + h * 8);              \
    _Pragma("unroll") for (int mi = 0; mi < 2; ++mi)                                                           \
        _Pragma("unroll") for (int ni = 0; ni < 2; ++ni) acc[mi][ni] = MFMA32(a_[mi], b_[ni], acc[mi][ni]);    \
  }
  GM_STORE(0, a0, a1, b0, b1)
  if (KT > 2) GM_LOAD(2, a0, a1, b0, b1)
  SCHED_FENCE();
  __syncthreads();
  for (int kt = 0; kt < KT; kt += 2) {
    GM_STORE(1, c0, c1, d0, d1)
    if (kt + 3 < KT) GM_LOAD(kt + 3, c0, c1, d0, d1)
    SCHED_FENCE();
    GM_COMPUTE(0)
    __syncthreads();
    if (kt + 2 < KT) GM_STORE(0, a0, a1, b0, b1)
    if (kt + 4 < KT) GM_LOAD(kt + 4, a0, a1, b0, b1)
    SCHED_FENCE();
    GM_COMPUTE(1)
    __syncthreads();
  }
}

template <class AAddr, class BAddr>
DI void gemm_full(f32x16 (&acc)[2][2], int KT, AAddr aaddr, BAddr baddr, GemmSmem* sm) {
  GSTAGE_DECL;
  gemm_prefetch(GSTAGE_ARGS, aaddr, baddr);
  gemm_main(acc, KT, aaddr, baddr, sm, GSTAGE_ARGS);
}

DI float transpose_reduce16(float (&v)[16], int lane) {
  float r8[8], r4[4], r2[2];
  {
    bool up = lane & 8;
#pragma unroll
    for (int i = 0; i < 8; ++i) {
      float send = up ? v[i] : v[i + 8];
      float keep = up ? v[i + 8] : v[i];
      r8[i] = keep + __shfl_xor(send, 8);
    }
  }
  {
    bool up = lane & 4;
#pragma unroll
    for (int i = 0; i < 4; ++i) {
      float send = up ? r8[i] : r8[i + 4];
      float keep = up ? r8[i + 4] : r8[i];
      r4[i] = keep + __shfl_xor(send, 4);
    }
  }
  {
    bool up = lane & 2;
#pragma unroll
    for (int i = 0; i < 2; ++i) {
      float send = up ? r4[i] : r4[i + 2];
      float keep = up ? r4[i + 2] : r4[i];
      r2[i] = keep + __shfl_xor(send, 2);
    }
  }
  bool up = lane & 1;
  float send = up ? r2[0] : r2[1];
  float keep = up ? r2[1] : r2[0];
  return keep + __shfl_xor(send, 1);
}

DI void stage_half(const f32x16 (&acc)[2][2], int mi, float* wl, float4 (&v)[8], int lane) {
  const int r = lane & 31, h = lane >> 5;
#pragma unroll
  for (int ni = 0; ni < 2; ++ni)
#pragma unroll
    for (int i = 0; i < 16; ++i) wl[crow(i, h) * 64 + ni * 32 + r] = acc[mi][ni][i];
  asm volatile("s_waitcnt lgkmcnt(0)" ::: "memory");
#pragma unroll
  for (int c = 0; c < 8; ++c) v[c] = *(const float4*)(wl + (c * 4 + (lane >> 4)) * 64 + (lane & 15) * 4);
  asm volatile("s_waitcnt lgkmcnt(0)" ::: "memory");
}
DI void stage_half8(const f32x16 (&acc)[2][2], int mi, float* wl, float4 (&lo)[4], float4 (&hi)[4], int lane) {
  const int r = lane & 31, h = lane >> 5;
#pragma unroll
  for (int ni = 0; ni < 2; ++ni)
#pragma unroll
    for (int i = 0; i < 16; ++i) wl[crow(i, h) * 64 + ni * 32 + r] = acc[mi][ni][i];
  asm volatile("s_waitcnt lgkmcnt(0)" ::: "memory");
#pragma unroll
  for (int c = 0; c < 4; ++c) {
    const float* pch = wl + (c * 8 + (lane >> 3)) * 64 + (lane & 7) * 8;
    lo[c] = *(const float4*)pch;
    hi[c] = *(const float4*)(pch + 4);
  }
  asm volatile("s_waitcnt lgkmcnt(0)" ::: "memory");
}
DI float4 bf4_to_f4(uint2 u) {
  return make_float4(__uint_as_float(u.x << 16), __uint_as_float(u.x & 0xffff0000u), __uint_as_float(u.y << 16),
                     __uint_as_float(u.y & 0xffff0000u));
}
DI uint2 f4_to_bf4(float4 f) { return make_uint2(pk2(f.x, f.y), pk2(f.z, f.w)); }

#define WAVE_IDS                                              \
  const int tid = opaque_tid(), lane = tid & 63, wave = tid >> 6; \
  const int wm = wave >> 1, wn = wave & 1, r = lane & 31, h = lane >> 5; \
  (void)wm; (void)wn; (void)r; (void)h;

template <int LAYER>
DI void phase_hconv(const Params& p) {
  const int tid = opaque_tid(), lane = tid & 63;
  bfr* H = (bfr*)(p.ws + (LAYER == 0 ? O_H0 : O_H1));
  const float4* ng4 = (const float4*)(p.in[I_NORMG] + LAYER * 1024);
  for (int tok = (blockIdx.x * 4 + (tid >> 6)) * 2; tok < TOK; tok += gridDim.x * 8) {
    const float4* xr0 = (const float4*)(LAYER == 0 ? xrow0(p, tok) : (const float*)xrow1(p, tok));
    const float4* xr1 = xr0 + 256;
    const float4* md4 = (const float4*)modrow(p, LAYER, tok);
    float4 x0[4], x1[4], gm[4], sh[4];
#pragma unroll
    for (int i = 0; i < 4; ++i) {
      x0[i] = xr0[lane + 64 * i];
      x1[i] = xr1[lane + 64 * i];
      float4 gv = ng4[lane + 64 * i];
      float4 sc = md4[256 + lane + 64 * i];
      sh[i] = md4[lane + 64 * i];
      gm[i] = make_float4(gv.x * (1.f + sc.x), gv.y * (1.f + sc.y), gv.z * (1.f + sc.z), gv.w * (1.f + sc.w));
    }
    float s0 = 0.f, s1 = 0.f;
#pragma unroll
    for (int i = 0; i < 4; ++i) {
      s0 += x0[i].x * x0[i].x + x0[i].y * x0[i].y + x0[i].z * x0[i].z + x0[i].w * x0[i].w;
      s1 += x1[i].x * x1[i].x + x1[i].y * x1[i].y + x1[i].z * x1[i].z + x1[i].w * x1[i].w;
    }
    s0 = wave_sum(s0);
    s1 = wave_sum(s1);
    const float r0 = rsqrtf(s0 * (1.f / 1024.f) + EPS), r1 = rsqrtf(s1 * (1.f / 1024.f) + EPS);
#pragma unroll
    for (int i = 0; i < 4; ++i) {
      uint2 o0, o1;
      o0.x = pk2(x0[i].x * r0 * gm[i].x + sh[i].x, x0[i].y * r0 * gm[i].y + sh[i].y);
      o0.y = pk2(x0[i].z * r0 * gm[i].z + sh[i].z, x0[i].w * r0 * gm[i].w + sh[i].w);
      o1.x = pk2(x1[i].x * r1 * gm[i].x + sh[i].x, x1[i].y * r1 * gm[i].y + sh[i].y);
      o1.y = pk2(x1[i].z * r1 * gm[i].z + sh[i].z, x1[i].w * r1 * gm[i].w + sh[i].w);
      *(uint2*)(H + (size_t)tok * 1024 + (lane + 64 * i) * 4) = o0;
      *(uint2*)(H + (size_t)(tok + 1) * 1024 + (lane + 64 * i) * 4) = o1;
    }
  }
}

DI void phase_o1(const Params& p, char* smem) {
  GemmSmem* sm = (GemmSmem*)smem;
  WAVE_IDS
  const int NT = 12, units = (TOK / 128) * NT;
  const bfr* WT = (const bfr*)(p.ws + O_WT_IN0);
  bfr* PC = (bfr*)(p.ws + O_PC);
  bfr* SZ0 = (bfr*)(p.ws + O_SZ0);
  bfr* KRb = (bfr*)(p.ws + O_KR);
  const bfr* Ah = (const bfr*)(p.ws + O_H0);
  auto Aof = [&](int m0) { return [=](int row, int k) { return Ah + (size_t)(m0 + row) * 1024 + k; }; };
  auto Bof = [&](int n0) {
    return [=](int row, int k) {
      int n = n0 + row;
      n = n < NIN0 ? n : NIN0 - 1;
      return WT + (size_t)n * 1024 + k;
    };
  };
  GSTAGE_DECL;
  if ((int)blockIdx.x < units) {
    const int us = xcd_swz(blockIdx.x, NT);
    gemm_prefetch(GSTAGE_ARGS, Aof((us / NT) * 128), Bof((us % NT) * 128));
  }
  for (int u = blockIdx.x; u < units; u += gridDim.x) {
    const int us = xcd_swz(u, NT);
    int mt = us / NT, nt = us - mt * NT;
    int m0 = mt * 128, n0 = nt * 128;
    f32x16 acc[2][2];
    zero_acc(acc);
    gemm_main(acc, 32, Aof(m0), Bof(n0), sm, GSTAGE_ARGS);
    if (u + (int)gridDim.x < units) {
      const int us1 = xcd_swz(u + gridDim.x, NT);
      gemm_prefetch(GSTAGE_ARGS, Aof((us1 / NT) * 128), Bof((us1 % NT) * 128));
    }
    int b = m0 / LALL, pos0 = m0 - b * LALL;
    bool lat = pos0 >= LC;
#pragma unroll
    for (int mi = 0; mi < 2; ++mi)
#pragma unroll
      for (int ni = 0; ni < 2; ++ni) {
        int col0 = n0 + wn * 64 + ni * 32;
        if (col0 >= NIN0) continue;
        int col = col0 + r;
#pragma unroll
        for (int i = 0; i < 16; ++i) {
          int row = wm * 64 + mi * 32 + crow(i, h);
          int tok = m0 + row;
          float v = acc[mi][ni][i];
          if (col0 < 384) {
            PC[(size_t)tok * 384 + col] = f2bf(v);
          } else if (col0 == 384) {
            float vp = __shfl_xor(v, 8);
            int pos = pos0 + row;
            float val = lat ? rope_apply(r, v, vp, pos - LC) : v;
            KRb[(size_t)tok * 32 + r] = f2bf(val);
          } else {
            SZ0[(size_t)tok * 1024 + (col - 416)] = f2bf(silu_f(v));
          }
          SCHED_FENCE();
        }
      }
  }
}

DI void phase_o2(const Params& p, char* smem) {
  GemmSmem* sm = (GemmSmem*)smem;
  WAVE_IDS
  const int UQ = (TOK / 128) * 12, UKV = (TOK / 128) * 16;
  const bfr* PC = (const bfr*)(p.ws + O_PC);
  bfr* Q = (bfr*)p.out;
  bfr* Kb = (bfr*)(p.ws + O_K);
  bfr* VT = (bfr*)(p.ws + O_VT);
  const int total = UQ + UKV;
  const int per_blk = (total + gridDim.x - 1) / gridDim.x;
  const int u_beg = blockIdx.x * per_blk;
  const int u_end = u_beg + per_blk < total ? u_beg + per_blk : total;
  int prev_key = -1;
  for (int us = u_beg; us < u_end; ++us) {
    int mt = us / 28, rem = us - mt * 28;
    bool isq = rem < 12;
    int nt = isq ? rem : rem - 12;
    int m0 = mt * 128, n0 = nt * 128;
    int Kd = isq ? 256 : 128;
    int aoff = isq ? 0 : 256;
    const bfr* WT = (const bfr*)(p.ws + (isq ? O_WT_UQ : O_WT_UKV));
    const int key = mt * 2 + (isq ? 0 : 1);
    if (key != prev_key) {
      prev_key = key;
      __syncthreads();
      int row = tid >> 1, half = tid & 1;
      const bfr* ap = PC + (size_t)(m0 + row) * 384 + aoff + half * (Kd / 2);
      float ss = 0.f;
      for (int j = 0; j < Kd / 16; ++j) {
        uint4 v = *(const uint4*)(ap + j * 8);
        unsigned w[4] = {v.x, v.y, v.z, v.w};
#pragma unroll
        for (int e = 0; e < 4; ++e) {
          float lo = __uint_as_float(w[e] << 16), hi = __uint_as_float(w[e] & 0xffff0000u);
          ss += lo * lo + hi * hi;
        }
      }
      ss += __shfl_xor(ss, 1);
      if (half == 0) sm->rs[row] = rsqrtf(ss / (float)Kd + EPS);
      __syncthreads();
    }
    f32x16 acc[2][2];
    zero_acc(acc);
    gemm_full(
        acc, Kd / 32, [&](int row, int k) { return PC + (size_t)(m0 + row) * 384 + aoff + k; },
        [&](int row, int k) { return WT + (size_t)(n0 + row) * Kd + k; }, sm);
    int b = m0 / LALL, pos0 = m0 - b * LALL;
    bool lat = pos0 >= LC;
    float* wl = (float*)sm + wave * 2048;
    if (isq || wn == 0) {
      if (isq && lat) {
#pragma unroll
        for (int ni = 0; ni < 2; ++ni) {
          int col0 = n0 + wn * 64 + ni * 32;
          if (col0 % 96 == 64) {
#pragma unroll
            for (int mi = 0; mi < 2; ++mi)
#pragma unroll
              for (int i = 0; i < 16; ++i) {
                int pos = pos0 + wm * 64 + mi * 32 + crow(i, h);
                float v = acc[mi][ni][i];
                float vp = __shfl_xor(v, 8);
                acc[mi][ni][i] = rope_apply(r, v, vp, pos - LC);
              }
          }
        }
      }
      const int c0 = wn * 64 + (lane & 7) * 8;
      bfr* dst;
      int rstride;
      float oscale;
      if (isq) {
        int col = n0 + c0;
        int hh = col / 96, d = col - hh * 96;
        dst = Q + ((size_t)(b * NH + hh) * LALL) * DQK + d;
        rstride = DQK;
        oscale = QSCALE;
      } else {
        int hh = n0 >> 7;
        dst = Kb + ((size_t)(b * NH + hh) * LALL) * 64 + c0;
        rstride = 64;
        oscale = 1.f;
      }
#pragma unroll
      for (int mi = 0; mi < 2; ++mi) {
        float4 lo[4], hi[4];
        stage_half8(acc, mi, wl, lo, hi, lane);
#pragma unroll
        for (int c = 0; c < 4; ++c) {
          int row = wm * 64 + mi * 32 + c * 8 + (lane >> 3);
          float sc = sm->rs[row] * oscale;
          uint4 o;
          o.x = pk2(lo[c].x * sc, lo[c].y * sc);
          o.y = pk2(lo[c].z * sc, lo[c].w * sc);
          o.z = pk2(hi[c].x * sc, hi[c].y * sc);
          o.w = pk2(hi[c].z * sc, hi[c].w * sc);
          *(uint4*)(dst + (size_t)(pos0 + row) * rstride) = o;
        }
      }
    } else {
      int hh = n0 >> 7;
#pragma unroll
      for (int mi = 0; mi < 2; ++mi)
#pragma unroll
        for (int ni = 0; ni < 2; ++ni) {
          int dvv = ni * 32 + r;
#pragma unroll
          for (int g4 = 0; g4 < 4; ++g4) {
            int row = wm * 64 + mi * 32 + 8 * g4 + 4 * h;
            int pos = pos0 + row;
            uint2 o;
            o.x = pk2(acc[mi][ni][4 * g4 + 0] * sm->rs[row + 0], acc[mi][ni][4 * g4 + 1] * sm->rs[row + 1]);
            o.y = pk2(acc[mi][ni][4 * g4 + 2] * sm->rs[row + 2], acc[mi][ni][4 * g4 + 3] * sm->rs[row + 3]);
            *(uint2*)(VT + (((size_t)(b * NH + hh)) * DV + dvv) * LALL + pos) = o;
          }
        }
    }
    __syncthreads();
  }
}

constexpr int KLD = 104;
constexpr int VLD = 68;
struct AttnSmem {
  bfr K[64 * KLD];
  bfr V[64 * VLD];
};
static_assert(sizeof(AttnSmem) <= SMEM_BYTES, "smem");

DI void attn_item(const Params& p, AttnSmem* sm, int bh, int qpos0, int nkeys) {
  WAVE_IDS
  const bfr* Q = (const bfr*)p.out;
  const bfr* Kg = (const bfr*)(p.ws + O_K) + (size_t)bh * LALL * 64;
  const bfr* KRg = (const bfr*)(p.ws + O_KR) + (size_t)(bh / NH) * LALL * 32;
  const bfr* Vg = (const bfr*)(p.ws + O_VT) + (size_t)bh * DV * LALL;
  const int qpos = qpos0 + wave * 32 + r;
  bf16x8 bq[6];
  {
    const bfr* qp = Q + ((size_t)bh * LALL + qpos) * DQK + 8 * h;
#pragma unroll
    for (int s = 0; s < 6; ++s) bq[s] = *(const bf16x8*)(qp + 16 * s);
  }
  f32x16 o[2];
#pragma unroll
  for (int d = 0; d < 2; ++d)
#pragma unroll
    for (int i = 0; i < 16; ++i) o[d][i] = 0.f;
  float mrun = 0.f, lrun = 0.f;
  uint4 kv0, kv1, kv2, vv0, vv1;
  const int kr0 = tid / 12, kc0 = (tid - kr0 * 12) * 8;
  const int kr1 = (tid + 256) / 12, kc1 = (tid + 256 - kr1 * 12) * 8;
  const int kr2 = (tid + 512) / 12, kc2 = (tid + 512 - kr2 * 12) * 8;
  const int vr0 = tid >> 3, vc0 = (tid & 7) * 8;
  const bfr* kp0 = kc0 < 64 ? Kg + (size_t)kr0 * 64 + kc0 : KRg + (size_t)kr0 * 32 + (kc0 - 64);
  const bfr* kp1 = kc1 < 64 ? Kg + (size_t)kr1 * 64 + kc1 : KRg + (size_t)kr1 * 32 + (kc1 - 64);
  const bfr* kp2 = kc2 < 64 ? Kg + (size_t)kr2 * 64 + kc2 : KRg + (size_t)kr2 * 32 + (kc2 - 64);
  const int ks0 = kc0 < 64 ? 64 : 32, ks1 = kc1 < 64 ? 64 : 32, ks2 = kc2 < 64 ? 64 : 32;
#define AT_GLOAD(KEY0_)                                                          \
  {                                                                              \
    const int key0_ = (KEY0_);                                                   \
    kv0 = *(const uint4*)(kp0 + (size_t)key0_ * ks0);                            \
    kv1 = *(const uint4*)(kp1 + (size_t)key0_ * ks1);                            \
    kv2 = *(const uint4*)(kp2 + (size_t)key0_ * ks2);                            \
    vv0 = *(const uint4*)(Vg + (size_t)vr0 * LALL + key0_ + vc0);                \
    vv1 = *(const uint4*)(Vg + (size_t)(vr0 + 32) * LALL + key0_ + vc0);         \
  }
#define AT_LSTORE()                                                              \
  {                                                                              \
    *(uint4*)(sm->K + kr0 * KLD + kc0) = kv0;                                    \
    *(uint4*)(sm->K + kr1 * KLD + kc1) = kv1;                                    \
    *(uint4*)(sm->K + kr2 * KLD + kc2) = kv2;                                    \
    uint2* d0_ = (uint2*)(sm->V + vr0 * VLD + vc0);                              \
    d0_[0] = make_uint2(vv0.x, vv0.y);                                           \
    d0_[1] = make_uint2(vv0.z, vv0.w);                                           \
    uint2* d1_ = (uint2*)(sm->V + (vr0 + 32) * VLD + vc0);                       \
    d1_[0] = make_uint2(vv1.x, vv1.y);                                           \
    d1_[1] = make_uint2(vv1.z, vv1.w);                                           \
  }
  const int NTI = nkeys / 64;
  AT_GLOAD(0)
  for (int it = 0; it < NTI; ++it) {
    AT_LSTORE()
    __syncthreads();
    if (it + 1 < NTI) AT_GLOAD((it + 1) * 64)
    SCHED_FENCE();
    f32x16 st[2];
    const float ninit = -mrun;
#pragma unroll
    for (int kb = 0; kb < 2; ++kb)
#pragma unroll
      for (int i = 0; i < 16; ++i) st[kb][i] = ninit;
#pragma unroll
    for (int s = 0; s < 6; ++s) {
#pragma unroll
      for (int kb = 0; kb < 2; ++kb) {
        bf16x8 ka = *(const bf16x8*)(sm->K + (kb * 32 + r) * KLD + 16 * s + 8 * h);
        st[kb] = MFMA32(ka, bq[s], st[kb]);
      }
    }
    float mx = fmaxf(fmaxf(st[0][0], st[0][1]), st[1][0]);
#pragma unroll
    for (int i = 2; i < 16; i += 2) mx = fmaxf(fmaxf(mx, st[0][i]), st[0][i + 1]);
#pragma unroll
    for (int i = 1; i < 15; i += 2) mx = fmaxf(fmaxf(mx, st[1][i]), st[1][i + 1]);
    mx = fmaxf(mx, st[1][15]);
    mx = fmaxf(mx, __shfl_xor(mx, 32));
    const bool need = (it == 0) || (mx > 8.f);
    if (__any(need)) {
      const float delta = need ? mx : 0.f;
      const float alpha = __builtin_amdgcn_exp2f(-delta);
      mrun += delta;
      lrun *= alpha;
#pragma unroll
      for (int d = 0; d < 2; ++d)
#pragma unroll
        for (int i = 0; i < 16; ++i) o[d][i] *= alpha;
#pragma unroll
      for (int kb = 0; kb < 2; ++kb)
#pragma unroll
        for (int i = 0; i < 16; ++i) st[kb][i] -= delta;
    }
    float ps = 0.f;
#pragma unroll
    for (int kb = 0; kb < 2; ++kb)
#pragma unroll
      for (int i = 0; i < 16; ++i) {
        float e = __builtin_amdgcn_exp2f(st[kb][i]);
        st[kb][i] = e;
        ps += e;
      }
    lrun += ps;
#pragma unroll
    for (int kb = 0; kb < 2; ++kb)
#pragma unroll
      for (int s2 = 0; s2 < 2; ++s2) {
        unsigned pw[4];
#pragma unroll
        for (int j = 0; j < 4; ++j) pw[j] = pk2(st[kb][8 * s2 + 2 * j], st[kb][8 * s2 + 2 * j + 1]);
        bf16x8 pb;
        {
          uint4 t = make_uint4(pw[0], pw[1], pw[2], pw[3]);
          pb = __builtin_bit_cast(bf16x8, t);
        }
#pragma unroll
        for (int d = 0; d < 2; ++d) {
          const bfr* vp = sm->V + (d * 32 + r) * VLD + kb * 32 + 16 * s2 + 4 * h;
          uint2 lo = *(const uint2*)vp;
          uint2 hi = *(const uint2*)(vp + 8);
          uint4 t = make_uint4(lo.x, lo.y, hi.x, hi.y);
          bf16x8 va = __builtin_bit_cast(bf16x8, t);
          o[d] = MFMA32(va, pb, o[d]);
        }
      }
    __syncthreads();
  }
  float ltot = lrun + __shfl_xor(lrun, 32);
  float inv = 1.f / ltot;
  int b = bh / NH, hh = bh - b * NH;
  size_t tok = (size_t)b * LALL + qpos;
  const bfr* SZ = (const bfr*)(p.ws + O_SZ0) + tok * 1024 + hh * 64;
  bfr* OG = (bfr*)(p.ws + O_OG) + tok * 1024 + hh * 64;
#pragma unroll
  for (int d = 0; d < 2; ++d)
#pragma unroll
    for (int g4 = 0; g4 < 4; ++g4) {
      int dv0 = d * 32 + 8 * g4 + 4 * h;
      uint2 z = *(const uint2*)(SZ + dv0);
      float z0 = __uint_as_float(z.x << 16), z1 = __uint_as_float(z.x & 0xffff0000u);
      float z2 = __uint_as_float(z.y << 16), z3 = __uint_as_float(z.y & 0xffff0000u);
      uint2 ov;
      ov.x = pk2(o[d][4 * g4 + 0] * inv * z0, o[d][4 * g4 + 1] * inv * z1);
      ov.y = pk2(o[d][4 * g4 + 2] * inv * z2, o[d][4 * g4 + 3] * inv * z3);
      *(uint2*)(OG + dv0) = ov;
    }
}

DI void phase_o3(const Params& p, char* smem) {
  AttnSmem* sm = (AttnSmem*)smem;
  const int xcd = blockIdx.x & 7, local = blockIdx.x >> 3, nloc = gridDim.x >> 3;
  for (int j = local; j < 256; j += nloc) {
    int u = xcd * 256 + j;
    attn_item(p, sm, u >> 4, LC + (u & 15) * 128, LALL);
  }
  for (int j = local; j < 32; j += nloc) {
    int u = xcd * 32 + j;
    attn_item(p, sm, u >> 1, (u & 1) * 128, LC);
  }
}

template <int LAYER>
DI void phase_oproj(const Params& p, char* smem) {
  GemmSmem* sm = (GemmSmem*)smem;
  WAVE_IDS
  constexpr int NROWS = LAYER == 0 ? TOK : NLAT;
  const int NT = 8, units = (NROWS / 128) * NT;
  const bfr* Ab = (const bfr*)(p.ws + (LAYER == 0 ? O_OG : O_Y2));
  const bfr* WT = (const bfr*)(p.ws + (LAYER == 0 ? O_WT_OUT0 : O_WT_OUT1));
  float* part = (float*)(p.ws + (LAYER == 0 ? O_PART1 : O_PART2));
  auto Aof = [&](int m0) { return [=](int row, int k) { return Ab + (size_t)(m0 + row) * 1024 + k; }; };
  auto Bof = [&](int n0) { return [=](int row, int k) { return WT + (size_t)(n0 + row) * 1024 + k; }; };
  GSTAGE_DECL;
  if ((int)blockIdx.x < units) {
    const int us = xcd_swz(blockIdx.x, NT);
    gemm_prefetch(GSTAGE_ARGS, Aof((us / NT) * 128), Bof((us % NT) * 128));
  }
  for (int u = blockIdx.x; u < units; u += gridDim.x) {
    const int us = xcd_swz(u, NT);
    int mt = us / NT, nt = us - mt * NT;
    int m0 = mt * 128, n0 = nt * 128;
    f32x16 acc[2][2];
    zero_acc(acc);
    gemm_main(acc, 32, Aof(m0), Bof(n0), sm, GSTAGE_ARGS);
    if (u + (int)gridDim.x < units) {
      const int us1 = xcd_swz(u + gridDim.x, NT);
      gemm_prefetch(GSTAGE_ARGS, Aof((us1 / NT) * 128), Bof((us1 % NT) * 128));
    }
    const float* xin;
    float* xout;
    const float* gt;
    if (LAYER == 0) {
      xin = xrow0(p, m0);
      xout = xrow1(p, m0);
      gt = modrow(p, 0, m0) + 2048;
    } else {
      xin = p.out + (size_t)m0 * 1024;
      xout = p.out + (size_t)m0 * 1024;
      gt = (const float*)(p.ws + O_MOD) + ((size_t)(9 + (m0 >> 11))) * 3072 + 2048;
    }
    float tot = 0.f;
#pragma unroll
    for (int mi = 0; mi < 2; ++mi) {
      float sq[16];
#pragma unroll
      for (int i = 0; i < 16; ++i) sq[i] = 0.f;
#pragma unroll
      for (int ni = 0; ni < 2; ++ni) {
        int col = n0 + wn * 64 + ni * 32 + r;
        float g = gt[col];
        float xv[16];
#pragma unroll
        for (int i = 0; i < 16; ++i) xv[i] = xin[(size_t)(wm * 64 + mi * 32 + crow(i, h)) * 1024 + col];
        SCHED_FENCE();
#pragma unroll
        for (int i = 0; i < 16; ++i) {
          int row = wm * 64 + mi * 32 + crow(i, h);
          float v = xv[i] + g * acc[mi][ni][i];
          xout[(size_t)row * 1024 + col] = v;
          sq[i] += v * v;
        }
        SCHED_FENCE();
      }
      if (LAYER == 1) {
        float t = transpose_reduce16(sq, lane);
        t += __shfl_xor(t, 16);
        if (((lane >> 4) & 1) == mi) tot = t;
      }
    }
    int idx = lane & 31;
    int row = m0 + wm * 64 + (idx >> 4) * 32 + crow(idx & 15, h);
    if (LAYER == 1) part[(size_t)(nt * 2 + wn) * NROWS + row] = tot;
  }
  if (LAYER == 0) {
    __syncthreads();
    phase_prep_b(p, smem, units % (int)gridDim.x);
  }
}

DI void phase_o5(const Params& p, char* smem) {
  GemmSmem* sm = (GemmSmem*)smem;
  WAVE_IDS
  const int ULAT = (NLAT / 128) * 16, units = ULAT + (NB * LC / 128) * 8;
  const bfr* WT = (const bfr*)(p.ws + O_WT_IN1);
  bfr* U2 = (bfr*)(p.ws + O_U2);
  bfr* SZ1 = (bfr*)(p.ws + O_SZ1);
  const bfr* Ah = (const bfr*)(p.ws + O_H1);
  auto coords = [&](int u, int& m0, int& n0) {
    if (u < ULAT) {
      const int us = xcd_swz(u, 16);
      int mtl = us >> 4;
      m0 = (mtl >> 4) * LALL + LC + (mtl & 15) * 128;
      n0 = (us & 15) * 128;
    } else {
      const int us = xcd_swz(u - ULAT, 8);
      int mtc = us >> 3;
      m0 = (mtc >> 1) * LALL + (mtc & 1) * 128;
      n0 = (us & 7) * 128;
    }
  };
  auto Aof = [&](int m0) { return [=](int row, int k) { return Ah + (size_t)(m0 + row) * 1024 + k; }; };
  auto Bof = [&](int n0) { return [=](int row, int k) { return WT + (size_t)(n0 + row) * 1024 + k; }; };
  GSTAGE_DECL;
  if ((int)blockIdx.x < units) {
    int m1, n1;
    coords(blockIdx.x, m1, n1);
    gemm_prefetch(GSTAGE_ARGS, Aof(m1), Bof(n1));
  }
  for (int u = blockIdx.x; u < units; u += gridDim.x) {
    int m0, n0;
    coords(u, m0, n0);
    int b = m0 / LALL, pos0 = m0 - b * LALL;
    f32x16 acc[2][2];
    zero_acc(acc);
    gemm_main(acc, 32, Aof(m0), Bof(n0), sm, GSTAGE_ARGS);
    if (u + (int)gridDim.x < units) {
      int m1, n1;
      coords(u + gridDim.x, m1, n1);
      gemm_prefetch(GSTAGE_ARGS, Aof(m1), Bof(n1));
    }
#pragma unroll
    for (int mi = 0; mi < 2; ++mi)
#pragma unroll
      for (int ni = 0; ni < 2; ++ni) {
        int col = n0 + wn * 64 + ni * 32 + r;
#pragma unroll
        for (int i = 0; i < 16; ++i) {
          int row = wm * 64 + mi * 32 + crow(i, h);
          int tok = m0 + row;
          float v = acc[mi][ni][i];
          if (col < 1024) U2[((size_t)(col >> 4) * TOK + tok) * 16 + (col & 15)] = f2bf(v);
          else SZ1[((size_t)(b * SEQ + pos0 + row - LC)) * 1024 + (col - 1024)] = f2bf(silu_f(v));
          SCHED_FENCE();
        }
      }
  }
}

DI void phase_o6(const Params& p, char* smem) {
  GemmSmem* sm = (GemmSmem*)smem;
  WAVE_IDS
  const int NROW = NB * NCH;
  const int units = 64 * 5 * 2;
  const bfr* U2 = (const bfr*)(p.ws + O_U2);
  const bfr* WST = (const bfr*)(p.ws + O_WST);
  float* SLOC = (float*)(p.ws + O_SLOC);
  for (int u = blockIdx.x; u < units; u += gridDim.x) {
    const int us = xcd_swz(u, 10);
    int g = us / 10, rem = us - g * 10;
    int mt = rem >> 1, nt = rem & 1;
    int m0 = mt * 128, n0 = nt * 128;
    const bfr* Ag = U2 + (size_t)g * TOK * 16;
    const bfr* Bg = WST + (size_t)g * 256 * 512;
    f32x16 acc[2][2];
    zero_acc(acc);
    gemm_full(
        acc, 16,
        [&](int row, int k) {
          int rr = m0 + row;
          rr = rr < NROW ? rr : NROW - 1;
          return Ag + (size_t)rr * 512 + k;
        },
        [&](int row, int k) { return Bg + (size_t)(n0 + row) * 512 + k; }, sm);
#pragma unroll
    for (int mi = 0; mi < 2; ++mi)
#pragma unroll
      for (int ni = 0; ni < 2; ++ni) {
        int col = n0 + wn * 64 + ni * 32 + r;
#pragma unroll
        for (int i = 0; i < 16; ++i) {
          int row = m0 + wm * 64 + mi * 32 + crow(i, h);
          SLOC[((size_t)g * SLOC_ROWS + row) * 256 + col] = acc[mi][ni][i];
        }
      }
  }
}

DI void phase_o7(const Params& p) {
  const int tidx_ = opaque_tid();
  const float* SLOC = (const float*)(p.ws + O_SLOC);
  bfr* SIN = (bfr*)(p.ws + O_SIN);
  const int total = NB * 64 * 2 * 64;
  for (int idx = blockIdx.x * 256 + tidx_; idx < total; idx += gridDim.x * 256) {
    int pp = idx & 63, dir = (idx >> 6) & 1, g = (idx >> 7) & 63, b = idx >> 13;
    double dt, ar, ai;
    float fr, fi, lr, li;
    s5_disc(p, dir, g, pp, dt, ar, ai, fr, fi);
    s5_pow(dt, ar, ai, TC, lr, li);
    float sr = 0.f, si = 0.f;
    auto cpos = [&](int step) { return dir == 0 ? step : (step < 8 ? 7 - step : NCH - 1 - (step - 8)); };
    const float* slb = SLOC + ((size_t)g * SLOC_ROWS + b * NCH) * 256 + dir * 128 + pp;
    bfr* sob = SIN + ((size_t)g * (NB * NCHL) + b * NCHL) * 256 + dir * 128 + pp;
#pragma unroll 1
    for (int s0 = 0; s0 < NCH; s0 += 24) {
      float lre[24], lim[24];
#pragma unroll
      for (int j = 0; j < 24; ++j) {
        const float* sl = slb + (size_t)cpos(s0 + j) * 256;
        lre[j] = sl[0];
        lim[j] = sl[64];
      }
#pragma unroll
      for (int j = 0; j < 24; ++j) {
        int cp = cpos(s0 + j);
        if (cp >= 8) {
          bfr* so = sob + (size_t)(cp - 8) * 256;
          so[0] = f2bf(sr);
          so[64] = f2bf(si);
        }
        float nr = lr * sr - li * si + lre[j];
        float ni = lr * si + li * sr + lim[j];
        sr = nr;
        si = ni;
      }
    }
  }
}

DI void phase_o8(const Params& p, char* smem) {
  GemmSmem* sm = (GemmSmem*)smem;
  WAVE_IDS
  const int units = 64 * 4 * 4;
  const bfr* U2 = (const bfr*)(p.ws + O_U2);
  const bfr* SIN = (const bfr*)(p.ws + O_SIN);
  const bfr* KTAB = (const bfr*)(p.ws + O_KTAB);
  const bfr* VOP = (const bfr*)(p.ws + O_VOP);
  bfr* YG = (bfr*)(p.ws + O_YG);
  for (int u = blockIdx.x; u < units; u += gridDim.x) {
    const int us = xcd_swz(u, 16);
    int g = us >> 4, mt = (us >> 2) & 3, nt = us & 3;
    int m0 = mt * 128, n0 = nt * 128;
    const bfr* Ug = U2 + (size_t)g * TOK * 16;
    f32x16 acc[2][2];
    zero_acc(acc);
    gemm_full(
        acc, 16,
        [&](int row, int k) {
          int rr = m0 + row;
          int b = rr >> 6, n = rr & 63;
          return Ug + ((size_t)b * LALL + LC + n * TC) * 16 + k;
        },
        [&](int row, int k) {
          int m = n0 + row;
          int t = m >> 4, c = m & 15;
          return KTAB + (((size_t)g * 63 + (t + 31)) * 16 + c) * 16 - (k >> 4) * 256 + (k & 15);
        },
        sm);
    gemm_full(
        acc, 8, [&](int row, int k) { return SIN + ((size_t)g * (NB * NCHL) + m0 + row) * 256 + k; },
        [&](int row, int k) { return VOP + ((size_t)g * 512 + n0 + row) * 256 + k; }, sm);
    {
      float* wl = (float*)sm + wave * 2048;
      const int mcol = n0 + wn * 64 + (lane & 7) * 8;
      const int t = mcol >> 4, c0 = mcol & 15;
      const int ch = g * 16 + c0;
      const float4 d0 = *(const float4*)(p.in[I_S5D] + ch), d1 = *(const float4*)(p.in[I_S5D] + ch + 4);
#pragma unroll
      for (int mi = 0; mi < 2; ++mi) {
        float4 lo[4], hi[4];
        stage_half8(acc, mi, wl, lo, hi, lane);
        uint4 uq[4];
#pragma unroll
        for (int c = 0; c < 4; ++c) {
          int rr = m0 + wm * 64 + mi * 32 + c * 8 + (lane >> 3);
          int b = rr >> 6, n = rr & 63;
          uq[c] = *(const uint4*)(Ug + ((size_t)b * LALL + LC + n * TC + t) * 16 + c0);
        }
        SCHED_FENCE();
#pragma unroll
        for (int c = 0; c < 4; ++c) {
          int rr = m0 + wm * 64 + mi * 32 + c * 8 + (lane >> 3);
          int b = rr >> 6, n = rr & 63;
          float4 u0 = bf4_to_f4(make_uint2(uq[c].x, uq[c].y)), u1 = bf4_to_f4(make_uint2(uq[c].z, uq[c].w));
          uint4 o;
          o.x = pk2(gelu_tanh(lo[c].x + d0.x * u0.x), gelu_tanh(lo[c].y + d0.y * u0.y));
          o.y = pk2(gelu_tanh(lo[c].z + d0.z * u0.z), gelu_tanh(lo[c].w + d0.w * u0.w));
          o.z = pk2(gelu_tanh(hi[c].x + d1.x * u1.x), gelu_tanh(hi[c].y + d1.y * u1.y));
          o.w = pk2(gelu_tanh(hi[c].z + d1.z * u1.z), gelu_tanh(hi[c].w + d1.w * u1.w));
          *(uint4*)(YG + ((size_t)(b * SEQ + n * TC + t)) * 1024 + ch) = o;
        }
        SCHED_FENCE();
      }
      __syncthreads();
    }
  }
}

DI void phase_o9(const Params& p, char* smem) {
  GemmSmem* sm = (GemmSmem*)smem;
  WAVE_IDS
  const int NT = 8, units = (NLAT / 128) * NT;
  const bfr* YG = (const bfr*)(p.ws + O_YG);
  const bfr* SZ1 = (const bfr*)(p.ws + O_SZ1);
  const bfr* WT = (const bfr*)(p.ws + O_WT_GLU);
  bfr* Y2 = (bfr*)(p.ws + O_Y2);
  auto Aof = [&](int m0) { return [=](int row, int k) { return YG + (size_t)(m0 + row) * 1024 + k; }; };
  auto Bof = [&](int n0) { return [=](int row, int k) { return WT + (size_t)(n0 + row) * 1024 + k; }; };
  GSTAGE_DECL;
  if ((int)blockIdx.x < units) {
    const int us = xcd_swz(blockIdx.x, NT);
    gemm_prefetch(GSTAGE_ARGS, Aof((us / NT) * 128), Bof((us % NT) * 128));
  }
  for (int u = blockIdx.x; u < units; u += gridDim.x) {
    const int us = xcd_swz(u, NT);
    int mt = us / NT, nt = us - mt * NT;
    int m0 = mt * 128, n0 = nt * 128;
    f32x16 acc[2][2];
    zero_acc(acc);
    gemm_main(acc, 32, Aof(m0), Bof(n0), sm, GSTAGE_ARGS);
    if (u + (int)gridDim.x < units) {
      const int us1 = xcd_swz(u + gridDim.x, NT);
      gemm_prefetch(GSTAGE_ARGS, Aof((us1 / NT) * 128), Bof((us1 % NT) * 128));
    }
    float* wl = (float*)sm + wave * 2048;
    const int ccol = n0 + wn * 64 + (lane & 15) * 4;
    const float4 bg = *(const float4*)(p.in[I_BGLU] + ccol);
#pragma unroll
    for (int mi = 0; mi < 2; ++mi) {
      float4 v[8];
      stage_half(acc, mi, wl, v, lane);
      uint2 yv[8], zv[8];
#pragma unroll
      for (int c = 0; c < 8; ++c) {
        size_t o = (size_t)(m0 + wm * 64 + mi * 32 + c * 4 + (lane >> 4)) * 1024 + ccol;
        yv[c] = *(const uint2*)(YG + o);
        zv[c] = *(const uint2*)(SZ1 + o);
      }
      SCHED_FENCE();
#pragma unroll
      for (int c = 0; c < 8; ++c) {
        size_t o = (size_t)(m0 + wm * 64 + mi * 32 + c * 4 + (lane >> 4)) * 1024 + ccol;
        float4 y = bf4_to_f4(yv[c]), z = bf4_to_f4(zv[c]);
        float4 ov;
        ov.x = y.x * sigmoid_f(v[c].x + bg.x) * z.x;
        ov.y = y.y * sigmoid_f(v[c].y + bg.y) * z.y;
        ov.z = y.z * sigmoid_f(v[c].z + bg.z) * z.z;
        ov.w = y.w * sigmoid_f(v[c].w + bg.w) * z.w;
        *(uint2*)(Y2 + o) = f4_to_bf4(ov);
      }
      SCHED_FENCE();
    }
    __syncthreads();
  }
}

#define XB_TMO      128
#define XB_XCNT(j)  (256  + 64 * (j))
#define XB_XSUB(j)  (1280 + 64 * (j))
#define XB_XGEN(j)  (2304 + 64 * (j))
#define XB_TOP      3328
#define XB_TOPGEN   3392
#define XCD_BAR_WORDS 3456
#define XB_SPIN_CAP (1u << 18)
#define LAS __attribute__((address_space(3)))
DI unsigned xb_ld(unsigned* p) { return __hip_atomic_load(p, __ATOMIC_RELAXED, __HIP_MEMORY_SCOPE_AGENT); }
DI unsigned xb_add(unsigned* p, unsigned v) { return __hip_atomic_fetch_add(p, v, __ATOMIC_RELAXED, __HIP_MEMORY_SCOPE_AGENT); }
DI unsigned xb_xcc_id() { return (unsigned)__builtin_amdgcn_s_getreg((3 << 11) | 20) & 0xFu; }
#define XB_SPIN(cond, bar) do { unsigned _sp = 0; while (cond) { __builtin_amdgcn_s_sleep(1); \
    if ((++_sp & 255u) == 0u) { if (xb_ld(&(bar)[XB_TMO])) break; if (_sp > XB_SPIN_CAP) { atomicAdd(&(bar)[XB_TMO], 1u); break; } } } } while (0)
struct XcdBarrier {
  unsigned* bar;
  unsigned x;
  volatile LAS unsigned* st;
};
DI XcdBarrier xcd_barrier_post(unsigned* bar, volatile LAS unsigned* st) {
  XcdBarrier b;
  b.bar = bar;
  b.x = xb_xcc_id();
  b.st = st;
  if (threadIdx.x == 0) (void)xb_add(&bar[XB_XCNT(b.x)], 1u);
  return b;
}
DI void xcd_barrier_complete(unsigned* bar, unsigned x, unsigned& nloc, unsigned& nx) {
  const unsigned G = gridDim.x * gridDim.y * gridDim.z;
  unsigned sum, cnt, mine, sp = 0u;
  for (;;) {
    sum = 0u; cnt = 0u; mine = 0u;
#pragma unroll
    for (unsigned j = 0; j < 16; ++j) {
      const unsigned c = xb_ld(&bar[XB_XCNT(j)]);
      sum += c;
      cnt += (c > 0u) ? 1u : 0u;
      mine = (j == x) ? c : mine;
    }
    if (sum == G) break;
    __builtin_amdgcn_s_sleep(1);
    if ((++sp & 255u) == 0u) {
      if (xb_ld(&bar[XB_TMO])) break;
      if (sp > XB_SPIN_CAP) { atomicAdd(&bar[XB_TMO], 1u); break; }
    }
  }
  nloc = mine > 0u ? mine : 1u;
  nx = cnt > 0u ? cnt : 1u;
}
DI void xcd_barrier(const XcdBarrier& b) {
  asm volatile("s_waitcnt vmcnt(0)" ::: "memory");
  __syncthreads();
  if (threadIdx.x == 0) {
    unsigned* bar = b.bar;
    __builtin_amdgcn_s_waitcnt(0);
    unsigned nloc = b.st[0], nx = b.st[1];
    if (nloc == 0u) {
      xcd_barrier_complete(bar, b.x, nloc, nx);
      b.st[0] = nloc;
      b.st[1] = nx;
    }
    const unsigned old = xb_add(&bar[XB_XSUB(b.x)], 1u);
    const unsigned gen = old / nloc;
    if (old + 1u == (gen + 1u) * nloc) {
      __builtin_amdgcn_fence(__ATOMIC_RELEASE, "agent");
      asm volatile("s_waitcnt vmcnt(0)" ::: "memory");
      const unsigned og = xb_add(&bar[XB_TOP], 1u);
      const unsigned tg = og / nx;
      if (og + 1u == (tg + 1u) * nx) xb_add(&bar[XB_TOPGEN], 1u);
      else XB_SPIN(xb_ld(&bar[XB_TOPGEN]) == tg, bar);
      __builtin_amdgcn_fence(__ATOMIC_ACQUIRE, "agent");
      xb_add(&bar[XB_XGEN(b.x)], 1u);
      asm volatile("s_waitcnt vmcnt(0)" ::: "memory");
    } else {
      XB_SPIN(xb_ld(&bar[XB_XGEN(b.x)]) == gen, bar);
      __builtin_amdgcn_fence(__ATOMIC_ACQUIRE, "agent");
      asm volatile("s_waitcnt vmcnt(0)" ::: "memory");
    }
  }
  __syncthreads();
}

DI void run_phase(const Params& p, int ph, char* smem) {
  switch (ph) {
#if !defined(ONLY) || ONLY == 0
    case PH_PREP: phase_prep(p, smem); break;
#endif
#if !defined(ONLY) || ONLY == 1
    case PH_FINAL: phase_final(p); break;
#endif
#if !defined(ONLY) || ONLY == 2
    case PH_O1: phase_o1(p, smem); break;
#endif
#if !defined(ONLY) || ONLY == 3
    case PH_O2: phase_o2(p, smem); break;
#endif
#if !defined(ONLY) || ONLY == 4
    case PH_O3: phase_o3(p, smem); break;
#endif
#if !defined(ONLY) || ONLY == 5
    case PH_O4: phase_oproj<0>(p, smem); break;
#endif
#if !defined(ONLY) || ONLY == 6
    case PH_O5: phase_o5(p, smem); break;
#endif
#if !defined(ONLY) || ONLY == 7
    case PH_O6: phase_o6(p, smem); break;
#endif
#if !defined(ONLY) || ONLY == 8
    case PH_O7: phase_o7(p); break;
#endif
#if !defined(ONLY) || ONLY == 9
    case PH_O8: phase_o8(p, smem); break;
#endif
#if !defined(ONLY) || ONLY == 10
    case PH_O9: phase_o9(p, smem); break;
#endif
#if !defined(ONLY) || ONLY == 11
    case PH_O10: phase_oproj<1>(p, smem); break;
#endif
    case PH_H0: phase_hconv<0>(p); break;
    case PH_H1: phase_hconv<1>(p); break;
    default: break;
  }
}

__global__ void __launch_bounds__(256, 2) mega_one(Params p, int ph) {
  __shared__ __attribute__((aligned(16))) char smem[SMEM_BYTES];
  run_phase(p, ph, smem);
}

#if !defined(ONLY) && SINGLE_LAUNCH
__global__ void __launch_bounds__(256, 2) mega(Params p) {
  __shared__ __attribute__((aligned(16))) char smem[SMEM_BYTES];
  __shared__ uint4 xb_words;
  if (threadIdx.x == 0) xb_words = make_uint4(0u, 0u, 0u, 0u);
  __syncthreads();
  if (p.nprog < 0) cg::this_grid().sync();
  const XcdBarrier xb = xcd_barrier_post((unsigned*)(p.ws + O_BAR), (volatile LAS unsigned*)&xb_words);
  cg::grid_group grid = cg::this_grid();
#if !defined(OMIT) || OMIT != 0
  phase_prep(p, smem);
#endif
  xcd_barrier(xb);
#if (DUP >> 0) & 1
  phase_prep(p, smem);
  xcd_barrier(xb);
#endif
  phase_hconv<0>(p);
  xcd_barrier(xb);
#if !defined(OMIT) || OMIT != 1
  phase_o1(p, smem);
#endif
  xcd_barrier(xb);
#if (DUP >> 1) & 1
  phase_o1(p, smem);
  xcd_barrier(xb);
#endif
#if !defined(OMIT) || OMIT != 2
  phase_o2(p, smem);
#endif
  xcd_barrier(xb);
#if (DUP >> 2) & 1
  phase_o2(p, smem);
  xcd_barrier(xb);
#endif
#if !defined(OMIT) || OMIT != 3
  phase_o3(p, smem);
#endif
  xcd_barrier(xb);
#if (DUP >> 3) & 1
  phase_o3(p, smem);
  xcd_barrier(xb);
#endif
#if !defined(OMIT) || OMIT != 4
  phase_oproj<0>(p, smem);
#endif
  xcd_barrier(xb);
#if (DUP >> 4) & 1
  phase_oproj<0>(p, smem);
  xcd_barrier(xb);
#endif
  phase_hconv<1>(p);
  xcd_barrier(xb);
#if !defined(OMIT) || OMIT != 5
  phase_o5(p, smem);
#endif
  xcd_barrier(xb);
#if (DUP >> 5) & 1
  phase_o5(p, smem);
  xcd_barrier(xb);
#endif
#if !defined(OMIT) || OMIT != 6
  phase_o6(p, smem);
#endif
  xcd_barrier(xb);
#if (DUP >> 6) & 1
  phase_o6(p, smem);
  xcd_barrier(xb);
#endif
#if !defined(OMIT) || OMIT != 7
  phase_o7(p);
#endif
  xcd_barrier(xb);
#if (DUP >> 7) & 1
  phase_o7(p);
  xcd_barrier(xb);
#endif
#if !defined(OMIT) || OMIT != 8
  phase_o8(p, smem);
#endif
  xcd_barrier(xb);
#if (DUP >> 8) & 1
  phase_o8(p, smem);
  xcd_barrier(xb);
#endif
#if !defined(OMIT) || OMIT != 9
  phase_o9(p, smem);
#endif
  xcd_barrier(xb);
#if (DUP >> 9) & 1
  phase_o9(p, smem);
  xcd_barrier(xb);
#endif
#if !defined(OMIT) || OMIT != 10
  phase_oproj<1>(p, smem);
#endif
  xcd_barrier(xb);
#if !defined(OMIT) || OMIT != 11
  phase_final(p);
#endif
}
#else
__global__ void mega(Params p) {}
#endif


extern "C" void kernel_launch(void* const* d_in, const int* in_sizes, int n_in, void* d_out, int out_size, void* d_ws,
                              size_t ws_size, hipStream_t stream) {
  static int grid_blocks = 0;
  if (!grid_blocks) {
    int dev = 0, cus = 0, per_cu = 0;
    hipGetDevice(&dev);
    hipDeviceGetAttribute(&cus, hipDeviceAttributeMultiprocessorCount, dev);
#if SINGLE_LAUNCH
    hipOccupancyMaxActiveBlocksPerMultiprocessor(&per_cu, mega, 256, 0);
#else
    hipOccupancyMaxActiveBlocksPerMultiprocessor(&per_cu, mega_one, 256, 0);
#endif
    if (per_cu < 1) per_cu = 1;
    if (per_cu > 2) per_cu = 2;
    grid_blocks = cus * per_cu;
  }
  if (ws_size < WS_NEED || n_in < N_INPUTS) {
    fprintf(stderr, "workspace too small or bad inputs: %zu < %zu\n", ws_size, (size_t)WS_NEED);
    return;
  }
  Params p{};
  for (int i = 0; i < N_INPUTS; ++i) p.in[i] = (const float*)d_in[i];
  p.out = (float*)d_out;
  p.ws = (char*)d_ws;
#ifndef PROG
#define PROG PH_PREP, PH_H0, PH_O1, PH_O2, PH_O3, PH_O4, PH_H1, PH_O5, PH_O6, PH_O7, PH_O8, PH_O9, PH_O10, PH_FINAL
#endif
  const int prog[] = {PROG};
  p.nprog = (int)(sizeof(prog) / sizeof(int));
  for (int i = 0; i < p.nprog; ++i) p.prog[i] = prog[i];
#if SINGLE_LAUNCH
  hipMemsetAsync((char*)d_ws + O_BAR, 0, BAR_BYTES, stream);
  void* args[] = {&p};
  hipError_t e = hipLaunchCooperativeKernel((void*)mega, dim3(grid_blocks), dim3(256), args, 0, stream);
  if (e != hipSuccess) fprintf(stderr, "cooperative launch failed: %s (grid %d)\n", hipGetErrorString(e), grid_blocks);
#else
  for (int i = 0; i < p.nprog; ++i) {
    mega_one<<<dim3(grid_blocks), dim3(256), 0, stream>>>(p, p.prog[i]);
  }
#endif
}
```

```cpp
#include <hip/hip_runtime.h>
#include <hip/hip_cooperative_groups.h>
#include <cstdio>
namespace cg = cooperative_groups;
#ifndef DUP
#define DUP 0
#endif
#ifndef USE_NAIVE
#define USE_NAIVE 0
#endif
#ifndef SINGLE_LAUNCH
#define SINGLE_LAUNCH 1
#endif

#define DI __device__ __forceinline__
typedef unsigned short bfr;

constexpr int D = 1024, NB = 8, SEQ = 2048, LC = 256, LALL = 2304;
constexpr int TOK = NB * LALL;
constexpr int NLAT = NB * SEQ;
constexpr int NH = 16, DQK = 96, DV = 64;
constexpr int NIN0 = 1440, NIN1 = 2048;
constexpr float EPS = 1e-6f;
constexpr float QSCALE = 0.10206207261596577f * 1.4426950408889634f;
constexpr int TC = 32;
constexpr int NCH = LALL / TC;
constexpr int NCHL = SEQ / TC;

enum { I_X = 0, I_C, I_CTX, I_CCTX, I_ADAW, I_ADAB, I_NORMG, I_WIN0, I_QNORM, I_WUQ, I_KVNORM, I_WUKV, I_WOUT0,
       I_WIN1, I_ARE, I_AIM, I_LOGSTEP, I_BRE, I_BIM, I_CRE, I_CIM, I_S5D, I_WGLU, I_BGLU, I_WOUT1, I_FINALG, N_INPUTS };

constexpr size_t al256(size_t x) { return (x + 255) & ~(size_t)255; }
constexpr size_t O_WT_IN0 = 0;
constexpr size_t O_WT_UQ = O_WT_IN0 + al256((size_t)NIN0 * 1024 * 2);
constexpr size_t O_WT_UKV = O_WT_UQ + al256((size_t)1536 * 256 * 2);
constexpr size_t O_WT_OUT0 = O_WT_UKV + al256((size_t)2048 * 128 * 2);
constexpr size_t O_WT_IN1 = O_WT_OUT0 + al256((size_t)1024 * 1024 * 2);
constexpr size_t O_WT_GLU = O_WT_IN1 + al256((size_t)2048 * 1024 * 2);
constexpr size_t O_WT_OUT1 = O_WT_GLU + al256((size_t)1024 * 1024 * 2);
constexpr size_t O_MOD = O_WT_OUT1 + al256((size_t)1024 * 1024 * 2);
constexpr size_t O_RS0 = O_MOD + al256((size_t)2 * 9 * 3072 * 4);
constexpr size_t O_PART1 = O_RS0 + al256((size_t)TOK * 4);
constexpr size_t O_PART2 = O_PART1 + al256((size_t)16 * TOK * 4);
constexpr size_t O_X1CTX = O_PART2 + al256((size_t)16 * NLAT * 4);
constexpr size_t O_KTAB = O_X1CTX + al256((size_t)NB * LC * 1024 * 4);
constexpr size_t O_WST = O_KTAB + al256((size_t)64 * 63 * 256 * 2);
constexpr size_t O_VOP = O_WST + al256((size_t)64 * 256 * 512 * 2);
constexpr size_t O_BAR = O_VOP + al256((size_t)64 * 512 * 256 * 2);
constexpr size_t BAR_BYTES = 3456 * 4;
constexpr size_t O_LAYER = O_BAR + al256(BAR_BYTES);
constexpr size_t O_PC = O_LAYER;
constexpr size_t O_SZ0 = O_PC + al256((size_t)TOK * 384 * 2);
constexpr size_t O_K = O_SZ0 + al256((size_t)TOK * 1024 * 2);
constexpr size_t O_VT = O_K + al256((size_t)NB * NH * LALL * 64 * 2);
constexpr size_t O_OG = O_VT + al256((size_t)NB * NH * DV * LALL * 2);
constexpr size_t O_KR = O_OG + al256((size_t)TOK * 1024 * 2);
constexpr size_t O_END0 = O_KR + al256((size_t)TOK * 32 * 2);
constexpr size_t O_H0 = O_OG;
constexpr size_t O_U2 = O_LAYER;
constexpr size_t O_SZ1 = O_U2 + al256((size_t)64 * TOK * 16 * 2);
constexpr size_t O_SLOC = O_SZ1 + al256((size_t)NLAT * 1024 * 2);
constexpr int SLOC_ROWS = 640;
constexpr size_t O_SIN = O_SLOC + al256((size_t)64 * SLOC_ROWS * 256 * 4);
constexpr size_t O_YG = O_SIN + al256((size_t)64 * (NB * NCHL) * 256 * 2);
constexpr size_t O_H1 = O_YG + al256((size_t)NLAT * 1024 * 2);
constexpr size_t O_END1 = O_H1 + al256((size_t)TOK * 1024 * 2);
constexpr size_t O_Y2 = O_SLOC;
constexpr size_t WS_NEED = (O_END0 > O_END1 ? O_END0 : O_END1);
static_assert(WS_NEED <= (size_t)256 * 1024 * 1024, "workspace too large");
static_assert((size_t)NB * NH * LALL * DQK * 2 <= (size_t)NLAT * 1024 * 4, "Q does not fit d_out");

struct Params {
  const float* in[N_INPUTS];
  float* out;
  char* ws;
  int prog[32];
  int nprog;
  int pad;
};

DI bfr f2bf(float x) {
  unsigned u = __float_as_uint(x);
  u += 0x7fffu + ((u >> 16) & 1u);
  return (bfr)(u >> 16);
}
typedef __bf16 bf2_t __attribute__((ext_vector_type(2)));
typedef float f2_t __attribute__((ext_vector_type(2)));
DI unsigned pk2(float a, float b) {
  f2_t v = {a, b};
  bf2_t r = __builtin_convertvector(v, bf2_t);
  return __builtin_bit_cast(unsigned, r);
}
DI int opaque_tid() {
  int t = threadIdx.x;
  asm volatile("" : "+v"(t));
  return t;
}
DI float bf2f(bfr b) { return __uint_as_float(((unsigned)b) << 16); }
DI float silu_f(float v) { return v / (1.f + __expf(-v)); }
DI float sigmoid_f(float v) { return 1.f / (1.f + __expf(-v)); }
DI float gelu_tanh(float v) {
  float u = 0.7978845608028654f * (v + 0.044715f * v * v * v);
  return 0.5f * v * (1.f + tanhf(u));
}
DI float wave_sum(float v) {
#pragma unroll
  for (int o = 32; o > 0; o >>= 1) v += __shfl_xor(v, o);
  return v;
}
DI float wave_max(float v) {
#pragma unroll
  for (int o = 32; o > 0; o >>= 1) v = fmaxf(v, __shfl_xor(v, o));
  return v;
}
DI const float* xrow0(const Params& p, int tok) {
  int b = tok / LALL, pos = tok - b * LALL;
  return pos < LC ? p.in[I_CTX] + ((size_t)(b * LC + pos)) * D : p.in[I_X] + ((size_t)(b * SEQ + pos - LC)) * D;
}
DI float* xrow1(const Params& p, int tok) {
  int b = tok / LALL, pos = tok - b * LALL;
  return pos < LC ? (float*)(p.ws + O_X1CTX) + ((size_t)(b * LC + pos)) * D : p.out + ((size_t)(b * SEQ + pos - LC)) * D;
}
DI const float* modrow(const Params& p, int layer, int tok) {
  int b = tok / LALL, pos = tok - b * LALL;
  int r = pos < LC ? 8 : b;
  return (const float*)(p.ws + O_MOD) + ((size_t)(layer * 9 + r)) * 3072;
}
DI void rope_cs(int fi, int posv, float& cs, float& sn) {
  float inv = __builtin_amdgcn_exp2f(-(float)fi * (13.287712379549449f / 8.f));
  float rev = (float)posv * inv * 0.15915494309189535f;
  rev -= floorf(rev);
  sn = __builtin_amdgcn_sinf(rev);
  cs = __builtin_amdgcn_cosf(rev);
}
DI float rope_apply(int j, float v, float vp, int lpos) {
  int posv = (j & 16) ? (lpos & 63) : (lpos >> 6);
  float cs, sn;
  rope_cs(j & 7, posv, cs, sn);
  return (j & 8) ? (vp * sn + v * cs) : (v * cs - vp * sn);
}

DI void s5_disc(const Params& p, int dir, int g, int pp, double& dt, double& ar, double& ai, float& fr, float& fi) {
  dt = exp((double)p.in[I_LOGSTEP][dir * 64 + g]);
  ar = (double)p.in[I_ARE][(dir * 64 + g) * 64 + pp];
  ai = (double)p.in[I_AIM][(dir * 64 + g) * 64 + pp];
  double mag = exp(ar * dt);
  double a = ai * dt;
  a -= 6.283185307179586 * rint(a * 0.15915494309189535);
  float sn, cs;
  sincosf((float)a, &sn, &cs);
  double lr = mag * (double)cs, li = mag * (double)sn;
  double den = ar * ar + ai * ai, nr = lr - 1.0;
  fr = (float)((nr * ar + li * ai) / den);
  fi = (float)((li * ar - nr * ai) / den);
}
DI void s5_pow(double dt, double ar, double ai, int k, float& wr, float& wi) {
  double mag = exp(ar * dt * (double)k);
  double a = ai * dt * (double)k;
  a -= 6.283185307179586 * rint(a * 0.15915494309189535);
  float sn, cs;
  sincosf((float)a, &sn, &cs);
  wr = (float)mag * cs;
  wi = (float)mag * sn;
}

enum { PH_PREP = 0, PH_N1, PH_N2, PH_N3, PH_N4, PH_N4B, PH_N5, PH_N6A, PH_N6B, PH_N9, PH_N10, PH_N10B, PH_FINAL,
       PH_O1, PH_O2, PH_O3, PH_O4, PH_O5, PH_O6, PH_O7, PH_O8, PH_O9, PH_O10, PH_H0, PH_H1, PH_COUNT };

constexpr int SMEM_BYTES = 48 * 1024;


DI void prep_transpose(const Params& p, int widx, int tile, char* smem) {
  const int tidx_ = opaque_tid();
  int K, N;
  size_t dst;
  const float* W;
  const float* scl = nullptr;
  switch (widx) {
    case 0: W = p.in[I_WIN0]; K = 1024; N = NIN0; dst = O_WT_IN0; break;
    case 1: W = p.in[I_WUQ]; K = 256; N = 1536; dst = O_WT_UQ; scl = p.in[I_QNORM]; break;
    case 2: W = p.in[I_WUKV]; K = 128; N = 2048; dst = O_WT_UKV; scl = p.in[I_KVNORM]; break;
    case 3: W = p.in[I_WOUT0]; K = 1024; N = 1024; dst = O_WT_OUT0; break;
    case 4: W = p.in[I_WIN1]; K = 1024; N = NIN1; dst = O_WT_IN1; break;
    case 5: W = p.in[I_WGLU]; K = 1024; N = 1024; dst = O_WT_GLU; break;
    default: W = p.in[I_WOUT1]; K = 1024; N = 1024; dst = O_WT_OUT1; break;
  }
  float (*t)[33] = (float (*)[33])smem;
  int ntn = N / 32;
  int kt = tile / ntn, nt = tile - kt * ntn;
  int tx = tidx_ & 31, ty = tidx_ >> 5;
  float v[16];
#pragma unroll
  for (int i = 0; i < 16; ++i) {
    int k = kt * 128 + ty + 8 * i, n = nt * 32 + tx;
    v[i] = W[(size_t)k * N + n];
  }
  if (scl) {
#pragma unroll
    for (int i = 0; i < 16; ++i) v[i] *= scl[kt * 128 + ty + 8 * i];
  }
#pragma unroll
  for (int i = 0; i < 16; ++i) t[ty + 8 * i][tx] = v[i];
  __syncthreads();
  bfr* Wt = (bfr*)(p.ws + dst);
  {
    int nl = tidx_ >> 3, kc = (tidx_ & 7) * 16;
    unsigned w[8];
#pragma unroll
    for (int j = 0; j < 8; ++j) w[j] = pk2(t[kc + 2 * j][nl], t[kc + 2 * j + 1][nl]);
    uint4* dstp = (uint4*)(Wt + (size_t)(nt * 32 + nl) * K + kt * 128 + kc);
    dstp[0] = make_uint4(w[0], w[1], w[2], w[3]);
    dstp[1] = make_uint4(w[4], w[5], w[6], w[7]);
  }
  __syncthreads();
}

DI void prep_mod(const Params& p, int unit, char* smem) {
  const int tidx_ = opaque_tid();
  int layer = unit / 192, cgp = unit - layer * 192;
  float* sil = (float*)smem;
  float* red = sil + 9 * 1024;
  for (int i = tidx_; i < 9 * 1024; i += 256) {
    int r = i >> 10, k = i & 1023;
    float v = r < 8 ? p.in[I_C][r * 1024 + k] : p.in[I_CCTX][k];
    sil[i] = silu_f(v);
  }
  __syncthreads();
  int nn = tidx_ & 15, kg = tidx_ >> 4;
  int n = cgp * 16 + nn;
  const float* W = p.in[I_ADAW] + (size_t)layer * 1024 * 3072 + n;
  float acc[9];
#pragma unroll
  for (int r = 0; r < 9; ++r) acc[r] = 0.f;
#pragma unroll 1
  for (int k0 = kg * 64; k0 < kg * 64 + 64; k0 += 32) {
    float wv[32];
#pragma unroll
    for (int j = 0; j < 32; ++j) wv[j] = W[(size_t)(k0 + j) * 3072];
#pragma unroll
    for (int j = 0; j < 32; ++j) {
#pragma unroll
      for (int r = 0; r < 9; ++r) acc[r] += sil[r * 1024 + k0 + j] * wv[j];
    }
  }
#pragma unroll
  for (int r = 0; r < 9; ++r) red[(kg * 9 + r) * 16 + nn] = acc[r];
  __syncthreads();
  if (tidx_ < 144) {
    int r = tidx_ >> 4, c = tidx_ & 15;
    int nc = cgp * 16 + c;
    float s = p.in[I_ADAB][layer * 3072 + nc];
#pragma unroll
    for (int g = 0; g < 16; ++g) s += red[(g * 9 + r) * 16 + c];
    ((float*)(p.ws + O_MOD))[((size_t)(layer * 9 + r)) * 3072 + nc] = s;
  }
  __syncthreads();
}

DI void prep_ktab(const Params& p, int unit, char* smem) {
  const int tidx_ = opaque_tid();
  int g = unit / 7, lg = unit - g * 7;
  float2* E = (float2*)smem;
  int tid = tidx_;
  const bool use_f = lg >= 3, use_r = lg <= 3;
  for (int i = tid; i < 9 * 128; i += 256) {
    int l = i >> 7, dir = (i >> 6) & 1, pp = i & 63;
    int lag = lg * 9 + l - 31;
    bool used = (dir == 0) ? (lag >= 0) : (lag <= 0);
    float2 e = make_float2(0.f, 0.f);
    if (used) {
      double dt, ar, ai;
      float fr, fi, wr, wi;
      s5_disc(p, dir, g, pp, dt, ar, ai, fr, fi);
      s5_pow(dt, ar, ai, lag < 0 ? -lag : lag, wr, wi);
      e.x = wr * fr - wi * fi;
      e.y = wr * fi + wi * fr;
    }
    E[(l * 2 + dir) * 64 + pp] = e;
  }
  float* PB = (float*)(E + 9 * 128);
  for (int dir = 0; dir < 2; ++dir) {
    if (dir == 0 ? !use_f : !use_r) continue;
    const float4* s0 = (const float4*)(p.in[I_BRE] + ((size_t)(dir * 64 + g)) * 1024);
    const float4* s1 = (const float4*)(p.in[I_BIM] + ((size_t)(dir * 64 + g)) * 1024);
    const float4* s2 = (const float4*)(p.in[I_CRE] + ((size_t)(dir * 64 + g)) * 1024);
    const float4* s3 = (const float4*)(p.in[I_CIM] + ((size_t)(dir * 64 + g)) * 1024);
    float4* d = (float4*)(PB + dir * 4096);
    d[tid] = s0[tid];
    d[256 + tid] = s1[tid];
    d[512 + tid] = s2[tid];
    d[768 + tid] = s3[tid];
  }
  __syncthreads();
  int c = tid >> 4, c2 = tid & 15;
  float acc[9];
#pragma unroll
  for (int l = 0; l < 9; ++l) acc[l] = 0.f;
  for (int dir = 0; dir < 2; ++dir) {
    if (dir == 0 ? !use_f : !use_r) continue;
    const float* bre = PB + dir * 4096;
    const float* bim = bre + 1024;
    const float* cre = bre + 2048;
    const float* cim = bre + 3072;
#pragma unroll 4
    for (int pp = 0; pp < 64; ++pp) {
      float br = bre[pp * 16 + c2], bi = bim[pp * 16 + c2];
      float cr = cre[c * 64 + pp], ci = cim[c * 64 + pp];
      float mr = cr * br - ci * bi, mi = cr * bi + ci * br;
#pragma unroll
      for (int l = 0; l < 9; ++l) {
        float2 e = E[(l * 2 + dir) * 64 + pp];
        acc[l] += mr * e.x - mi * e.y;
      }
    }
  }
  bfr* KT = (bfr*)(p.ws + O_KTAB);
#pragma unroll
  for (int l = 0; l < 9; ++l) KT[(((size_t)g * 63 + lg * 9 + l) * 16 + c) * 16 + c2] = f2bf(acc[l]);
  __syncthreads();
}

DI void prep_ops(const Params& p, int unit) {
  const int tidx_ = opaque_tid();
  int idx = unit * 256 + tidx_;
  int pp = idx & 63, t = (idx >> 6) & 31, dir = (idx >> 11) & 1, g = idx >> 12;
  double dt, ar, ai;
  float fr, fi, wr, wi;
  s5_disc(p, dir, g, pp, dt, ar, ai, fr, fi);
  s5_pow(dt, ar, ai, dir == 0 ? (TC - 1 - t) : t, wr, wi);
  float er = wr * fr - wi * fi, ei = wr * fi + wi * fr;
  const float* bre = p.in[I_BRE] + (((size_t)(dir * 64 + g)) * 64 + pp) * 16;
  const float* bim = p.in[I_BIM] + (((size_t)(dir * 64 + g)) * 64 + pp) * 16;
  bfr* wst = (bfr*)(p.ws + O_WST) + (size_t)g * 256 * 512;
  bfr* rre = wst + (size_t)(dir * 128 + pp) * 512 + t * 16;
  bfr* rim = wst + (size_t)(dir * 128 + 64 + pp) * 512 + t * 16;
#pragma unroll
  for (int c2 = 0; c2 < 16; ++c2) {
    float br = bre[c2], bi = bim[c2];
    rre[c2] = f2bf(er * br - ei * bi);
    rim[c2] = f2bf(er * bi + ei * br);
  }
  s5_pow(dt, ar, ai, dir == 0 ? (t + 1) : (TC - t), wr, wi);
  const float* cre = p.in[I_CRE] + ((size_t)(dir * 64 + g)) * 16 * 64;
  const float* cim = p.in[I_CIM] + ((size_t)(dir * 64 + g)) * 16 * 64;
  bfr* vop = (bfr*)(p.ws + O_VOP) + (size_t)g * 512 * 256;
#pragma unroll
  for (int c = 0; c < 16; ++c) {
    float cr = cre[c * 64 + pp], ci = cim[c * 64 + pp];
    float dr = cr * wr - ci * wi, di = cr * wi + ci * wr;
    vop[(size_t)(t * 16 + c) * 256 + dir * 128 + pp] = f2bf(dr);
    vop[(size_t)(t * 16 + c) * 256 + dir * 128 + 64 + pp] = f2bf(-di);
  }
}

constexpr int TR_T0 = 8 * 45, TR_T1 = 2 * 48, TR_T2 = 1 * 64, TR_T3 = 256, TR_T4 = 8 * 64, TR_T5 = 256, TR_T6 = 256;
constexpr int TR_TOTAL = TR_T0 + TR_T1 + TR_T2 + TR_T3 + TR_T4 + TR_T5 + TR_T6;
constexpr int U_MOD = 384, U_RS0 = 0, U_KTAB = 64 * 7, U_OPS = 64 * 2 * 64 * 32 / 256;
constexpr int PREP_A_UNITS = U_MOD + TR_T0 + TR_T1 + TR_T2 + TR_T3;
constexpr int PREP_B_UNITS = TR_T4 + TR_T5 + TR_T6 + U_KTAB + U_OPS;

DI void phase_prep(const Params& p, char* smem) {
  for (int u = blockIdx.x; u < PREP_A_UNITS; u += gridDim.x) {
    int v = u;
    if (v < U_MOD) { prep_mod(p, v, smem); continue; }
    v -= U_MOD;
    int w = 0;
    if (v >= TR_T0) { v -= TR_T0; w = 1;
      if (v >= TR_T1) { v -= TR_T1; w = 2;
        if (v >= TR_T2) { v -= TR_T2; w = 3; } } }
    prep_transpose(p, w, v, smem);
  }
}
DI void phase_prep_b(const Params& p, char* smem, int first_blk) {
  if (first_blk >= (int)gridDim.x) first_blk = 0;
  if ((int)blockIdx.x < first_blk) return;
  const int nb = gridDim.x - first_blk;
  for (int u = blockIdx.x - first_blk; u < PREP_B_UNITS; u += nb) {
    int v = u;
    if (v < TR_T4 + TR_T5 + TR_T6) {
      int w = 4;
      if (v >= TR_T4) { v -= TR_T4; w = 5;
        if (v >= TR_T5) { v -= TR_T5; w = 6; } }
      prep_transpose(p, w, v, smem);
      continue;
    }
    v -= TR_T4 + TR_T5 + TR_T6;
    if (v < U_KTAB) { prep_ktab(p, v, smem); continue; }
    v -= U_KTAB;
    prep_ops(p, v);
  }
}

DI float rs_from_part(const float* part, int nrows, int r) {
  float s = 0.f;
#pragma unroll
  for (int j = 0; j < 16; ++j) s += part[(size_t)j * nrows + r];
  return rsqrtf(s * (1.f / 1024.f) + EPS);
}

DI void phase_final(const Params& p) {
  const int tidx_ = opaque_tid();
  const float* part = (const float*)(p.ws + O_PART2);
  const float4* g4 = (const float4*)p.in[I_FINALG];
  int lane = tidx_ & 63;
  float4 g[4];
#pragma unroll
  for (int i = 0; i < 4; ++i) g[i] = g4[lane + 64 * i];
  for (int r = (blockIdx.x * 4 + (tidx_ >> 6)) * 2; r < NLAT; r += gridDim.x * 8) {
    float4* row0 = (float4*)(p.out + (size_t)r * D);
    float4* row1 = row0 + D / 4;
    float4 v0[4], v1[4];
#pragma unroll
    for (int i = 0; i < 4; ++i) {
      v0[i] = row0[lane + 64 * i];
      v1[i] = row1[lane + 64 * i];
    }
    float ps = part[(size_t)(lane & 15) * NLAT + r + ((lane >> 4) & 1)];
    ps += __shfl_xor(ps, 1);
    ps += __shfl_xor(ps, 2);
    ps += __shfl_xor(ps, 4);
    ps += __shfl_xor(ps, 8);
    const float rs0 = rsqrtf(__shfl(ps, 0) * (1.f / 1024.f) + EPS);
    const float rs1 = rsqrtf(__shfl(ps, 16) * (1.f / 1024.f) + EPS);
#pragma unroll
    for (int i = 0; i < 4; ++i) {
      float4 a = v0[i], c = v1[i];
      a.x *= rs0 * g[i].x; a.y *= rs0 * g[i].y; a.z *= rs0 * g[i].z; a.w *= rs0 * g[i].w;
      c.x *= rs1 * g[i].x; c.y *= rs1 * g[i].y; c.z *= rs1 * g[i].z; c.w *= rs1 * g[i].w;
      row0[lane + 64 * i] = a;
      row1[lane + 64 * i] = c;
    }
  }
}

typedef short bf16x8 __attribute__((ext_vector_type(8)));
typedef short s16x4 __attribute__((ext_vector_type(4)));
typedef float f32x16 __attribute__((ext_vector_type(16)));
#define SCHED_FENCE() __builtin_amdgcn_sched_barrier(0)
#define MFMA32(a, b, c) __builtin_amdgcn_mfma_f32_32x32x16_bf16((a), (b), (c), 0, 0, 0)
DI int xcd_swz(int u, int per) {
  int x = u & 7, q = u >> 3;
  int qq = q / per;
  return (x + 8 * qq) * per + (q - qq * per);
}
DI int crow(int i, int h) { return (i & 3) + 8 * (i >> 2) + 4 * h; }

constexpr int LDT = 40;
struct GemmSmem {
  bfr A[2][128 * LDT];
  bfr B[2][128 * LDT];
  float rs[128];
};
static_assert(sizeof(GemmSmem) <= SMEM_BYTES, "smem");

DI void zero_acc(f32x16 (&acc)[2][2]) {
#pragma unroll
  for (int a = 0; a < 2; ++a)
#pragma unroll
    for (int b = 0; b < 2; ++b)
#pragma unroll
      for (int i = 0; i < 16; ++i) acc[a][b][i] = 0.f;
}

#define GSTAGE_DECL uint4 ga0, ga1, gb0, gb1, gc0, gc1, gd0, gd1
#define GSTAGE_ARGS ga0, ga1, gb0, gb1, gc0, gc1, gd0, gd1
#define GSTAGE_PARAMS uint4 &a0, uint4 &a1, uint4 &b0, uint4 &b1, uint4 &c0, uint4 &c1, uint4 &d0, uint4 &d1
template <class AAddr, class BAddr>
DI void gemm_prefetch(GSTAGE_PARAMS, AAddr aaddr, BAddr baddr) {
  const int tid = opaque_tid();
  const int lrow = tid >> 2, lkc = (tid & 3) * 8;
  b0 = *(const uint4*)baddr(lrow, lkc);
  b1 = *(const uint4*)baddr(lrow + 64, lkc);
  a0 = *(const uint4*)aaddr(lrow, lkc);
  a1 = *(const uint4*)aaddr(lrow + 64, lkc);
  d0 = *(const uint4*)baddr(lrow, 32 + lkc);
  d1 = *(const uint4*)baddr(lrow + 64, 32 + lkc);
  c0 = *(const uint4*)aaddr(lrow, 32 + lkc);
  c1 = *(const uint4*)aaddr(lrow + 64, 32 + lkc);
  SCHED_FENCE();
}
template <class AAddr, class BAddr>
DI void gemm_main(f32x16 (&acc)[2][2], int KT, AAddr aaddr, BAddr baddr, GemmSmem* sm, GSTAGE_PARAMS) {
  const int tid = opaque_tid(), lane = tid & 63, wave = tid >> 6;
  const int wm = wave >> 1, wn = wave & 1, r = lane & 31, h = lane >> 5;
  const int lrow = tid >> 2, lkc = (tid & 3) * 8;
#define GM_LOAD(KT_, A0, A1, B0, B1)                   \
  {                                                    \
    const int kk_ = (KT_) * 32 + lkc;                  \
    B0 = *(const uint4*)baddr(lrow, kk_);              \
    B1 = *(const uint4*)baddr(lrow + 64, kk_);         \
    A0 = *(const uint4*)aaddr(lrow, kk_);              \
    A1 = *(const uint4*)aaddr(lrow + 64, kk_);         \
  }
#define GM_STORE(BUF_, A0, A1, B0, B1)                                  \
  {                                                                     \
    *(uint4*)(sm->B[BUF_] + lrow * LDT + lkc) = B0;                     \
    *(uint4*)(sm->B[BUF_] + (lrow + 64) * LDT + lkc) = B1;              \
    *(uint4*)(sm->A[BUF_] + lrow * LDT + lkc) = A0;                     \
    *(uint4*)(sm->A[BUF_] + (lrow + 64) * LDT + lkc) = A1;              \
  }
#define GM_COMPUTE(BUF_)                                                                                       \
  _Pragma("unroll") for (int ks = 0; ks < 2; ++ks) {                                                           \
    bf16x8 a_[2], b_[2];                                                                                       \
    _Pragma("unroll") for (int mi = 0; mi < 2; ++mi)                                                           \
        a_[mi] = *(const bf16x8*)(sm->A[BUF_] + (wm * 64 + mi * 32 + r) * LDT + ks * 16 + h * 8);              \
    _Pragma("unroll") for (int ni = 0; ni < 2; ++ni)                                                           \
        b_[ni] = *(const bf16x8*)(sm->B[BUF_] + (wn * 64 + ni * 32 + r) * LDT + ks * 16 + h * 8);              \
    _Pragma("unroll") for (int mi = 0; mi < 2; ++mi)                                                           \
        _Pragma("unroll") for (int ni = 0; ni < 2; ++ni) acc[mi][ni] = MFMA32(a_[mi], b_[ni], acc[mi][ni]);    \
  }
  GM_STORE(0, a0, a1, b0, b1)
  if (KT > 2) GM_LOAD(2, a0, a1, b0, b1)
  SCHED_FENCE();
  __syncthreads();
  for (int kt = 0; kt < KT; kt += 2) {
    GM_STORE(1, c0, c1, d0, d1)
    if (kt + 3 < KT) GM_LOAD(kt + 3, c0, c1, d0, d1)
    SCHED_FENCE();
    GM_COMPUTE(0)
    __syncthreads();
    if (kt + 2 < KT) GM_STORE(0, a0, a1, b0, b1)
    if (kt + 4 < KT) GM_LOAD(kt + 4, a0, a1, b0, b1)
    SCHED_FENCE();
    GM_COMPUTE(1)
    __syncthreads();
  }
}

template <class AAddr, class BAddr>
DI void gemm_full(f32x16 (&acc)[2][2], int KT, AAddr aaddr, BAddr baddr, GemmSmem* sm) {
  GSTAGE_DECL;
  gemm_prefetch(GSTAGE_ARGS, aaddr, baddr);
  gemm_main(acc, KT, aaddr, baddr, sm, GSTAGE_ARGS);
}

DI float transpose_reduce16(float (&v)[16], int lane) {
  float r8[8], r4[4], r2[2];
  {
    bool up = lane & 8;
#pragma unroll
    for (int i = 0; i < 8; ++i) {
      float send = up ? v[i] : v[i + 8];
      float keep = up ? v[i + 8] : v[i];
      r8[i] = keep + __shfl_xor(send, 8);
    }
  }
  {
    bool up = lane & 4;
#pragma unroll
    for (int i = 0; i < 4; ++i) {
      float send = up ? r8[i] : r8[i + 4];
      float keep = up ? r8[i + 4] : r8[i];
      r4[i] = keep + __shfl_xor(send, 4);
    }
  }
  {
    bool up = lane & 2;
#pragma unroll
    for (int i = 0; i < 2; ++i) {
      float send = up ? r4[i] : r4[i + 2];
      float keep = up ? r4[i + 2] : r4[i];
      r2[i] = keep + __shfl_xor(send, 2);
    }
  }
  bool up = lane & 1;
  float send = up ? r2[0] : r2[1];
  float keep = up ? r2[1] : r2[0];
  return keep + __shfl_xor(send, 1);
}

DI void stage_half(const f32x16 (&acc)[2][2], int mi, float* wl, float4 (&v)[8], int lane) {
  const int r = lane & 31, h = lane >> 5;
#pragma unroll
  for (int ni = 0; ni < 2; ++ni)
#pragma unroll
    for (int i = 0; i < 16; ++i) wl[crow(i, h) * 64 + ni * 32 + r] = acc[mi][ni][i];
  asm volatile("s_waitcnt lgkmcnt(0)" ::: "memory");
#pragma unroll
  for (int c = 0; c < 8; ++c) v[c] = *(const float4*)(wl + (c * 4 + (lane >> 4)) * 64 + (lane & 15) * 4);
  asm volatile("s_waitcnt lgkmcnt(0)" ::: "memory");
}
DI void stage_half8(const f32x16 (&acc)[2][2], int mi, float* wl, float4 (&lo)[4], float4 (&hi)[4], int lane) {
  const int r = lane & 31, h = lane >> 5;
#pragma unroll
  for (int ni = 0; ni < 2; ++ni)
#pragma unroll
    for (int i = 0; i < 16; ++i) wl[crow(i, h) * 64 + ni * 32 + r] = acc[mi][ni][i];
  asm volatile("s_waitcnt lgkmcnt(0)" ::: "memory");
#pragma unroll
  for (int c = 0; c < 4; ++c) {
    const float* pch = wl + (c * 8 + (lane >> 3)) * 64 + (lane & 7) * 8;
    lo[c] = *(const float4*)pch;
    hi[c] = *(const float4*)(pch + 4);
  }
  asm volatile("s_waitcnt lgkmcnt(0)" ::: "memory");
}
DI float4 bf4_to_f4(uint2 u) {
  return make_float4(__uint_as_float(u.x << 16), __uint_as_float(u.x & 0xffff0000u), __uint_as_float(u.y << 16),
                     __uint_as_float(u.y & 0xffff0000u));
}
DI uint2 f4_to_bf4(float4 f) { return make_uint2(pk2(f.x, f.y), pk2(f.z, f.w)); }

#define WAVE_IDS                                              \
  const int tid = opaque_tid(), lane = tid & 63, wave = tid >> 6; \
  const int wm = wave >> 1, wn = wave & 1, r = lane & 31, h = lane >> 5; \
  (void)wm; (void)wn; (void)r; (void)h;

template <int LAYER>
DI void phase_hconv(const Params& p) {
  const int tid = opaque_tid(), lane = tid & 63;
  bfr* H = (bfr*)(p.ws + (LAYER == 0 ? O_H0 : O_H1));
  const float4* ng4 = (const float4*)(p.in[I_NORMG] + LAYER * 1024);
  for (int tok = (blockIdx.x * 4 + (tid >> 6)) * 2; tok < TOK; tok += gridDim.x * 8) {
    const float4* xr0 = (const float4*)(LAYER == 0 ? xrow0(p, tok) : (const float*)xrow1(p, tok));
    const float4* xr1 = xr0 + 256;
    const float4* md4 = (const float4*)modrow(p, LAYER, tok);
    float4 x0[4], x1[4], gm[4], sh[4];
#pragma unroll
    for (int i = 0; i < 4; ++i) {
      x0[i] = xr0[lane + 64 * i];
      x1[i] = xr1[lane + 64 * i];
      float4 gv = ng4[lane + 64 * i];
      float4 sc = md4[256 + lane + 64 * i];
      sh[i] = md4[lane + 64 * i];
      gm[i] = make_float4(gv.x * (1.f + sc.x), gv.y * (1.f + sc.y), gv.z * (1.f + sc.z), gv.w * (1.f + sc.w));
    }
    float s0 = 0.f, s1 = 0.f;
#pragma unroll
    for (int i = 0; i < 4; ++i) {
      s0 += x0[i].x * x0[i].x + x0[i].y * x0[i].y + x0[i].z * x0[i].z + x0[i].w * x0[i].w;
      s1 += x1[i].x * x1[i].x + x1[i].y * x1[i].y + x1[i].z * x1[i].z + x1[i].w * x1[i].w;
    }
    s0 = wave_sum(s0);
    s1 = wave_sum(s1);
    const float r0 = rsqrtf(s0 * (1.f / 1024.f) + EPS), r1 = rsqrtf(s1 * (1.f / 1024.f) + EPS);
#pragma unroll
    for (int i = 0; i < 4; ++i) {
      uint2 o0, o1;
      o0.x = pk2(x0[i].x * r0 * gm[i].x + sh[i].x, x0[i].y * r0 * gm[i].y + sh[i].y);
      o0.y = pk2(x0[i].z * r0 * gm[i].z + sh[i].z, x0[i].w * r0 * gm[i].w + sh[i].w);
      o1.x = pk2(x1[i].x * r1 * gm[i].x + sh[i].x, x1[i].y * r1 * gm[i].y + sh[i].y);
      o1.y = pk2(x1[i].z * r1 * gm[i].z + sh[i].z, x1[i].w * r1 * gm[i].w + sh[i].w);
      *(uint2*)(H + (size_t)tok * 1024 + (lane + 64 * i) * 4) = o0;
      *(uint2*)(H + (size_t)(tok + 1) * 1024 + (lane + 64 * i) * 4) = o1;
    }
  }
}

DI void phase_o1(const Params& p, char* smem) {
  GemmSmem* sm = (GemmSmem*)smem;
  WAVE_IDS
  const int NT = 12, units = (TOK / 128) * NT;
  const bfr* WT = (const bfr*)(p.ws + O_WT_IN0);
  bfr* PC = (bfr*)(p.ws + O_PC);
  bfr* SZ0 = (bfr*)(p.ws + O_SZ0);
  bfr* KRb = (bfr*)(p.ws + O_KR);
  const bfr* Ah = (const bfr*)(p.ws + O_H0);
  auto Aof = [&](int m0) { return [=](int row, int k) { return Ah + (size_t)(m0 + row) * 1024 + k; }; };
  auto Bof = [&](int n0) {
    return [=](int row, int k) {
      int n = n0 + row;
      n = n < NIN0 ? n : NIN0 - 1;
      return WT + (size_t)n * 1024 + k;
    };
  };
  GSTAGE_DECL;
  if ((int)blockIdx.x < units) {
    const int us = xcd_swz(blockIdx.x, NT);
    gemm_prefetch(GSTAGE_ARGS, Aof((us / NT) * 128), Bof((us % NT) * 128));
  }
  for (int u = blockIdx.x; u < units; u += gridDim.x) {
    const int us = xcd_swz(u, NT);
    int mt = us / NT, nt = us - mt * NT;
    int m0 = mt * 128, n0 = nt * 128;
    f32x16 acc[2][2];
    zero_acc(acc);
    gemm_main(acc, 32, Aof(m0), Bof(n0), sm, GSTAGE_ARGS);
    if (u + (int)gridDim.x < units) {
      const int us1 = xcd_swz(u + gridDim.x, NT);
      gemm_prefetch(GSTAGE_ARGS, Aof((us1 / NT) * 128), Bof((us1 % NT) * 128));
    }
    int b = m0 / LALL, pos0 = m0 - b * LALL;
    bool lat = pos0 >= LC;
#pragma unroll
    for (int mi = 0; mi < 2; ++mi)
#pragma unroll
      for (int ni = 0; ni < 2; ++ni) {
        int col0 = n0 + wn * 64 + ni * 32;
        if (col0 >= NIN0) continue;
        int col = col0 + r;
#pragma unroll
        for (int i = 0; i < 16; ++i) {
          int row = wm * 64 + mi * 32 + crow(i, h);
          int tok = m0 + row;
          float v = acc[mi][ni][i];
          if (col0 < 384) {
            PC[(size_t)tok * 384 + col] = f2bf(v);
          } else if (col0 == 384) {
            float vp = __shfl_xor(v, 8);
            int pos = pos0 + row;
            float val = lat ? rope_apply(r, v, vp, pos - LC) : v;
            KRb[(size_t)tok * 32 + r] = f2bf(val);
          } else {
            SZ0[(size_t)tok * 1024 + (col - 416)] = f2bf(silu_f(v));
          }
          SCHED_FENCE();
        }
      }
  }
}

DI void phase_o2(const Params& p, char* smem) {
  GemmSmem* sm = (GemmSmem*)smem;
  WAVE_IDS
  const int UQ = (TOK / 128) * 12, UKV = (TOK / 128) * 16;
  const bfr* PC = (const bfr*)(p.ws + O_PC);
  bfr* Q = (bfr*)p.out;
  bfr* Kb = (bfr*)(p.ws + O_K);
  bfr* VT = (bfr*)(p.ws + O_VT);
  const int total = UQ + UKV;
  const int per_blk = (total + gridDim.x - 1) / gridDim.x;
  const int u_beg = blockIdx.x * per_blk;
  const int u_end = u_beg + per_blk < total ? u_beg + per_blk : total;
  int prev_key = -1;
  for (int us = u_beg; us < u_end; ++us) {
    int mt = us / 28, rem = us - mt * 28;
    bool isq = rem < 12;
    int nt = isq ? rem : rem - 12;
    int m0 = mt * 128, n0 = nt * 128;
    int Kd = isq ? 256 : 128;
    int aoff = isq ? 0 : 256;
    const bfr* WT = (const bfr*)(p.ws + (isq ? O_WT_UQ : O_WT_UKV));
    const int key = mt * 2 + (isq ? 0 : 1);
    if (key != prev_key) {
      prev_key = key;
      __syncthreads();
      int row = tid >> 1, half = tid & 1;
      const bfr* ap = PC + (size_t)(m0 + row) * 384 + aoff + half * (Kd / 2);
      float ss = 0.f;
      for (int j = 0; j < Kd / 16; ++j) {
        uint4 v = *(const uint4*)(ap + j * 8);
        unsigned w[4] = {v.x, v.y, v.z, v.w};
#pragma unroll
        for (int e = 0; e < 4; ++e) {
          float lo = __uint_as_float(w[e] << 16), hi = __uint_as_float(w[e] & 0xffff0000u);
          ss += lo * lo + hi * hi;
        }
      }
      ss += __shfl_xor(ss, 1);
      if (half == 0) sm->rs[row] = rsqrtf(ss / (float)Kd + EPS);
      __syncthreads();
    }
    f32x16 acc[2][2];
    zero_acc(acc);
    gemm_full(
        acc, Kd / 32, [&](int row, int k) { return PC + (size_t)(m0 + row) * 384 + aoff + k; },
        [&](int row, int k) { return WT + (size_t)(n0 + row) * Kd + k; }, sm);
    int b = m0 / LALL, pos0 = m0 - b * LALL;
    bool lat = pos0 >= LC;
    float* wl = (float*)sm + wave * 2048;
    if (isq || wn == 0) {
      if (isq && lat) {
#pragma unroll
        for (int ni = 0; ni < 2; ++ni) {
          int col0 = n0 + wn * 64 + ni * 32;
          if (col0 % 96 == 64) {
#pragma unroll
            for (int mi = 0; mi < 2; ++mi)
#pragma unroll
              for (int i = 0; i < 16; ++i) {
                int pos = pos0 + wm * 64 + mi * 32 + crow(i, h);
                float v = acc[mi][ni][i];
                float vp = __shfl_xor(v, 8);
                acc[mi][ni][i] = rope_apply(r, v, vp, pos - LC);
              }
          }
        }
      }
      const int c0 = wn * 64 + (lane & 7) * 8;
      bfr* dst;
      int rstride;
      float oscale;
      if (isq) {
        int col = n0 + c0;
        int hh = col / 96, d = col - hh * 96;
        dst = Q + ((size_t)(b * NH + hh) * LALL) * DQK + d;
        rstride = DQK;
        oscale = QSCALE;
      } else {
        int hh = n0 >> 7;
        dst = Kb + ((size_t)(b * NH + hh) * LALL) * 64 + c0;
        rstride = 64;
        oscale = 1.f;
      }
#pragma unroll
      for (int mi = 0; mi < 2; ++mi) {
        float4 lo[4], hi[4];
        stage_half8(acc, mi, wl, lo, hi, lane);
#pragma unroll
        for (int c = 0; c < 4; ++c) {
          int row = wm * 64 + mi * 32 + c * 8 + (lane >> 3);
          float sc = sm->rs[row] * oscale;
          uint4 o;
          o.x = pk2(lo[c].x * sc, lo[c].y * sc);
          o.y = pk2(lo[c].z * sc, lo[c].w * sc);
          o.z = pk2(hi[c].x * sc, hi[c].y * sc);
          o.w = pk2(hi[c].z * sc, hi[c].w * sc);
          *(uint4*)(dst + (size_t)(pos0 + row) * rstride) = o;
        }
      }
    } else {
      int hh = n0 >> 7;
#pragma unroll
      for (int mi = 0; mi < 2; ++mi)
#pragma unroll
        for (int ni = 0; ni < 2; ++ni) {
          int dvv = ni * 32 + r;
#pragma unroll
          for (int g4 = 0; g4 < 4; ++g4) {
            int row = wm * 64 + mi * 32 + 8 * g4 + 4 * h;
            int pos = pos0 + row;
            uint2 o;
            o.x = pk2(acc[mi][ni][4 * g4 + 0] * sm->rs[row + 0], acc[mi][ni][4 * g4 + 1] * sm->rs[row + 1]);
            o.y = pk2(acc[mi][ni][4 * g4 + 2] * sm->rs[row + 2], acc[mi][ni][4 * g4 + 3] * sm->rs[row + 3]);
            *(uint2*)(VT + (((size_t)(b * NH + hh)) * DV + dvv) * LALL + pos) = o;
          }
        }
    }
    __syncthreads();
  }
}

constexpr int KLD = 104;
constexpr int VLD = 68;
struct AttnSmem {
  bfr K[64 * KLD];
  bfr V[64 * VLD];
};
static_assert(sizeof(AttnSmem) <= SMEM_BYTES, "smem");

DI void attn_item(const Params& p, AttnSmem* sm, int bh, int qpos0, int nkeys) {
  WAVE_IDS
  const bfr* Q = (const bfr*)p.out;
  const bfr* Kg = (const bfr*)(p.ws + O_K) + (size_t)bh * LALL * 64;
  const bfr* KRg = (const bfr*)(p.ws + O_KR) + (size_t)(bh / NH) * LALL * 32;
  const bfr* Vg = (const bfr*)(p.ws + O_VT) + (size_t)bh * DV * LALL;
  const int qpos = qpos0 + wave * 32 + r;
  bf16x8 bq[6];
  {
    const bfr* qp = Q + ((size_t)bh * LALL + qpos) * DQK + 8 * h;
#pragma unroll
    for (int s = 0; s < 6; ++s) bq[s] = *(const bf16x8*)(qp + 16 * s);
  }
  f32x16 o[2];
#pragma unroll
  for (int d = 0; d < 2; ++d)
#pragma unroll
    for (int i = 0; i < 16; ++i) o[d][i] = 0.f;
  float mrun = 0.f, lrun = 0.f;
  uint4 kv0, kv1, kv2, vv0, vv1;
  const int kr0 = tid / 12, kc0 = (tid - kr0 * 12) * 8;
  const int kr1 = (tid + 256) / 12, kc1 = (tid + 256 - kr1 * 12) * 8;
  const int kr2 = (tid + 512) / 12, kc2 = (tid + 512 - kr2 * 12) * 8;
  const int vr0 = tid >> 3, vc0 = (tid & 7) * 8;
  const bfr* kp0 = kc0 < 64 ? Kg + (size_t)kr0 * 64 + kc0 : KRg + (size_t)kr0 * 32 + (kc0 - 64);
  const bfr* kp1 = kc1 < 64 ? Kg + (size_t)kr1 * 64 + kc1 : KRg + (size_t)kr1 * 32 + (kc1 - 64);
  const bfr* kp2 = kc2 < 64 ? Kg + (size_t)kr2 * 64 + kc2 : KRg + (size_t)kr2 * 32 + (kc2 - 64);
  const int ks0 = kc0 < 64 ? 64 : 32, ks1 = kc1 < 64 ? 64 : 32, ks2 = kc2 < 64 ? 64 : 32;
#define AT_GLOAD(KEY0_)                                                          \
  {                                                                              \
    const int key0_ = (KEY0_);                                                   \
    kv0 = *(const uint4*)(kp0 + (size_t)key0_ * ks0);                            \
    kv1 = *(const uint4*)(kp1 + (size_t)key0_ * ks1);                            \
    kv2 = *(const uint4*)(kp2 + (size_t)key0_ * ks2);                            \
    vv0 = *(const uint4*)(Vg + (size_t)vr0 * LALL + key0_ + vc0);                \
    vv1 = *(const uint4*)(Vg + (size_t)(vr0 + 32) * LALL + key0_ + vc0);         \
  }
#define AT_LSTORE()                                                              \
  {                                                                              \
    *(uint4*)(sm->K + kr0 * KLD + kc0) = kv0;                                    \
    *(uint4*)(sm->K + kr1 * KLD + kc1) = kv1;                                    \
    *(uint4*)(sm->K + kr2 * KLD + kc2) = kv2;                                    \
    uint2* d0_ = (uint2*)(sm->V + vr0 * VLD + vc0);                              \
    d0_[0] = make_uint2(vv0.x, vv0.y);                                           \
    d0_[1] = make_uint2(vv0.z, vv0.w);                                           \
    uint2* d1_ = (uint2*)(sm->V + (vr0 + 32) * VLD + vc0);                       \
    d1_[0] = make_uint2(vv1.x, vv1.y);                                           \
    d1_[1] = make_uint2(vv1.z, vv1.w);                                           \
  }
  const int NTI = nkeys / 64;
  AT_GLOAD(0)
  for (int it = 0; it < NTI; ++it) {
    AT_LSTORE()
    __syncthreads();
    if (it + 1 < NTI) AT_GLOAD((it + 1) * 64)
    SCHED_FENCE();
    f32x16 st[2];
    const float ninit = -mrun;
#pragma unroll
    for (int kb = 0; kb < 2; ++kb)
#pragma unroll
      for (int i = 0; i < 16; ++i) st[kb][i] = ninit;
#pragma unroll
    for (int s = 0; s < 6; ++s) {
#pragma unroll
      for (int kb = 0; kb < 2; ++kb) {
        bf16x8 ka = *(const bf16x8*)(sm->K + (kb * 32 + r) * KLD + 16 * s + 8 * h);
        st[kb] = MFMA32(ka, bq[s], st[kb]);
      }
    }
    float mx = fmaxf(fmaxf(st[0][0], st[0][1]), st[1][0]);
#pragma unroll
    for (int i = 2; i < 16; i += 2) mx = fmaxf(fmaxf(mx, st[0][i]), st[0][i + 1]);
#pragma unroll
    for (int i = 1; i < 15; i += 2) mx = fmaxf(fmaxf(mx, st[1][i]), st[1][i + 1]);
    mx = fmaxf(mx, st[1][15]);
    mx = fmaxf(mx, __shfl_xor(mx, 32));
    const bool need = (it == 0) || (mx > 8.f);
    if (__any(need)) {
      const float delta = need ? mx : 0.f;
      const float alpha = __builtin_amdgcn_exp2f(-delta);
      mrun += delta;
      lrun *= alpha;
#pragma unroll
      for (int d = 0; d < 2; ++d)
#pragma unroll
        for (int i = 0; i < 16; ++i) o[d][i] *= alpha;
#pragma unroll
      for (int kb = 0; kb < 2; ++kb)
#pragma unroll
        for (int i = 0; i < 16; ++i) st[kb][i] -= delta;
    }
    float ps = 0.f;
#pragma unroll
    for (int kb = 0; kb < 2; ++kb)
#pragma unroll
      for (int i = 0; i < 16; ++i) {
        float e = __builtin_amdgcn_exp2f(st[kb][i]);
        st[kb][i] = e;
        ps += e;
      }
    lrun += ps;
#pragma unroll
    for (int kb = 0; kb < 2; ++kb)
#pragma unroll
      for (int s2 = 0; s2 < 2; ++s2) {
        unsigned pw[4];
#pragma unroll
        for (int j = 0; j < 4; ++j) pw[j] = pk2(st[kb][8 * s2 + 2 * j], st[kb][8 * s2 + 2 * j + 1]);
        bf16x8 pb;
        {
          uint4 t = make_uint4(pw[0], pw[1], pw[2], pw[3]);
          pb = __builtin_bit_cast(bf16x8, t);
        }
#pragma unroll
        for (int d = 0; d < 2; ++d) {
          const bfr* vp = sm->V + (d * 32 + r) * VLD + kb * 32 + 16 * s2 + 4 * h;
          uint2 lo = *(const uint2*)vp;
          uint2 hi = *(const uint2*)(vp + 8);
          uint4 t = make_uint4(lo.x, lo.y, hi.x, hi.y);
          bf16x8 va = __builtin_bit_cast(bf16x8, t);
          o[d] = MFMA32(va, pb, o[d]);
        }
      }
    __syncthreads();
  }
  float ltot = lrun + __shfl_xor(lrun, 32);
  float inv = 1.f / ltot;
  int b = bh / NH, hh = bh - b * NH;
  size_t tok = (size_t)b * LALL + qpos;
  const bfr* SZ = (const bfr*)(p.ws + O_SZ0) + tok * 1024 + hh * 64;
  bfr* OG = (bfr*)(p.ws + O_OG) + tok * 1024 + hh * 64;
#pragma unroll
  for (int d = 0; d < 2; ++d)
#pragma unroll
    for (int g4 = 0; g4 < 4; ++g4) {
      int dv0 = d * 32 + 8 * g4 + 4 * h;
      uint2 z = *(const uint2*)(SZ + dv0);
      float z0 = __uint_as_float(z.x << 16), z1 = __uint_as_float(z.x & 0xffff0000u);
      float z2 = __uint_as_float(z.y << 16), z3 = __uint_as_float(z.y & 0xffff0000u);
      uint2 ov;
      ov.x = pk2(o[d][4 * g4 + 0] * inv * z0, o[d][4 * g4 + 1] * inv * z1);
      ov.y = pk2(o[d][4 * g4 + 2] * inv * z2, o[d][4 * g4 + 3] * inv * z3);
      *(uint2*)(OG + dv0) = ov;
    }
}

DI void phase_o3(const Params& p, char* smem) {
  AttnSmem* sm = (AttnSmem*)smem;
  const int xcd = blockIdx.x & 7, local = blockIdx.x >> 3, nloc = gridDim.x >> 3;
  for (int j = local; j < 256; j += nloc) {
    int u = xcd * 256 + j;
    attn_item(p, sm, u >> 4, LC + (u & 15) * 128, LALL);
  }
  for (int j = local; j < 32; j += nloc) {
    int u = xcd * 32 + j;
    attn_item(p, sm, u >> 1, (u & 1) * 128, LC);
  }
}

template <int LAYER>
DI void phase_oproj(const Params& p, char* smem) {
  GemmSmem* sm = (GemmSmem*)smem;
  WAVE_IDS
  constexpr int NROWS = LAYER == 0 ? TOK : NLAT;
  const int NT = 8, units = (NROWS / 128) * NT;
  const bfr* Ab = (const bfr*)(p.ws + (LAYER == 0 ? O_OG : O_Y2));
  const bfr* WT = (const bfr*)(p.ws + (LAYER == 0 ? O_WT_OUT0 : O_WT_OUT1));
  float* part = (float*)(p.ws + (LAYER == 0 ? O_PART1 : O_PART2));
  auto Aof = [&](int m0) { return [=](int row, int k) { return Ab + (size_t)(m0 + row) * 1024 + k; }; };
  auto Bof = [&](int n0) { return [=](int row, int k) { return WT + (size_t)(n0 + row) * 1024 + k; }; };
  GSTAGE_DECL;
  if ((int)blockIdx.x < units) {
    const int us = xcd_swz(blockIdx.x, NT);
    gemm_prefetch(GSTAGE_ARGS, Aof((us / NT) * 128), Bof((us % NT) * 128));
  }
  for (int u = blockIdx.x; u < units; u += gridDim.x) {
    const int us = xcd_swz(u, NT);
    int mt = us / NT, nt = us - mt * NT;
    int m0 = mt * 128, n0 = nt * 128;
    f32x16 acc[2][2];
    zero_acc(acc);
    gemm_main(acc, 32, Aof(m0), Bof(n0), sm, GSTAGE_ARGS);
    if (u + (int)gridDim.x < units) {
      const int us1 = xcd_swz(u + gridDim.x, NT);
      gemm_prefetch(GSTAGE_ARGS, Aof((us1 / NT) * 128), Bof((us1 % NT) * 128));
    }
    const float* xin;
    float* xout;
    const float* gt;
    if (LAYER == 0) {
      xin = xrow0(p, m0);
      xout = xrow1(p, m0);
      gt = modrow(p, 0, m0) + 2048;
    } else {
      xin = p.out + (size_t)m0 * 1024;
      xout = p.out + (size_t)m0 * 1024;
      gt = (const float*)(p.ws + O_MOD) + ((size_t)(9 + (m0 >> 11))) * 3072 + 2048;
    }
    float tot = 0.f;
#pragma unroll
    for (int mi = 0; mi < 2; ++mi) {
      float sq[16];
#pragma unroll
      for (int i = 0; i < 16; ++i) sq[i] = 0.f;
#pragma unroll
      for (int ni = 0; ni < 2; ++ni) {
        int col = n0 + wn * 64 + ni * 32 + r;
        float g = gt[col];
        float xv[16];
#pragma unroll
        for (int i = 0; i < 16; ++i) xv[i] = xin[(size_t)(wm * 64 + mi * 32 + crow(i, h)) * 1024 + col];
        SCHED_FENCE();
#pragma unroll
        for (int i = 0; i < 16; ++i) {
          int row = wm * 64 + mi * 32 + crow(i, h);
          float v = xv[i] + g * acc[mi][ni][i];
          xout[(size_t)row * 1024 + col] = v;
          sq[i] += v * v;
        }
        SCHED_FENCE();
      }
      if (LAYER == 1) {
        float t = transpose_reduce16(sq, lane);
        t += __shfl_xor(t, 16);
        if (((lane >> 4) & 1) == mi) tot = t;
      }
    }
    int idx = lane & 31;
    int row = m0 + wm * 64 + (idx >> 4) * 32 + crow(idx & 15, h);
    if (LAYER == 1) part[(size_t)(nt * 2 + wn) * NROWS + row] = tot;
  }
  if (LAYER == 0) {
    __syncthreads();
    phase_prep_b(p, smem, units % (int)gridDim.x);
  }
}

DI void phase_o5(const Params& p, char* smem) {
  GemmSmem* sm = (GemmSmem*)smem;
  WAVE_IDS
  const int ULAT = (NLAT / 128) * 16, units = ULAT + (NB * LC / 128) * 8;
  const bfr* WT = (const bfr*)(p.ws + O_WT_IN1);
  bfr* U2 = (bfr*)(p.ws + O_U2);
  bfr* SZ1 = (bfr*)(p.ws + O_SZ1);
  const bfr* Ah = (const bfr*)(p.ws + O_H1);
  auto coords = [&](int u, int& m0, int& n0) {
    if (u < ULAT) {
      const int us = xcd_swz(u, 16);
      int mtl = us >> 4;
      m0 = (mtl >> 4) * LALL + LC + (mtl & 15) * 128;
      n0 = (us & 15) * 128;
    } else {
      const int us = xcd_swz(u - ULAT, 8);
      int mtc = us >> 3;
      m0 = (mtc >> 1) * LALL + (mtc & 1) * 128;
      n0 = (us & 7) * 128;
    }
  };
  auto Aof = [&](int m0) { return [=](int row, int k) { return Ah + (size_t)(m0 + row) * 1024 + k; }; };
  auto Bof = [&](int n0) { return [=](int row, int k) { return WT + (size_t)(n0 + row) * 1024 + k; }; };
  GSTAGE_DECL;
  if ((int)blockIdx.x < units) {
    int m1, n1;
    coords(blockIdx.x, m1, n1);
    gemm_prefetch(GSTAGE_ARGS, Aof(m1), Bof(n1));
  }
  for (int u = blockIdx.x; u < units; u += gridDim.x) {
    int m0, n0;
    coords(u, m0, n0);
    int b = m0 / LALL, pos0 = m0 - b * LALL;
    f32x16 acc[2][2];
    zero_acc(acc);
    gemm_main(acc, 32, Aof(m0), Bof(n0), sm, GSTAGE_ARGS);
    if (u + (int)gridDim.x < units) {
      int m1, n1;
      coords(u + gridDim.x, m1, n1);
      gemm_prefetch(GSTAGE_ARGS, Aof(m1), Bof(n1));
    }
#pragma unroll
    for (int mi = 0; mi < 2; ++mi)
#pragma unroll
      for (int ni = 0; ni < 2; ++ni) {
        int col = n0 + wn * 64 + ni * 32 + r;
#pragma unroll
        for (int i = 0; i < 16; ++i) {
          int row = wm * 64 + mi * 32 + crow(i, h);
          int tok = m0 + row;
          float v = acc[mi][ni][i];
          if (col < 1024) U2[((size_t)(col >> 4) * TOK + tok) * 16 + (col & 15)] = f2bf(v);
          else SZ1[((size_t)(b * SEQ + pos0 + row - LC)) * 1024 + (col - 1024)] = f2bf(silu_f(v));
          SCHED_FENCE();
        }
      }
  }
}

DI void phase_o6(const Params& p, char* smem) {
  GemmSmem* sm = (GemmSmem*)smem;
  WAVE_IDS
  const int NROW = NB * NCH;
  const int units = 64 * 5 * 2;
  const bfr* U2 = (const bfr*)(p.ws + O_U2);
  const bfr* WST = (const bfr*)(p.ws + O_WST);
  float* SLOC = (float*)(p.ws + O_SLOC);
  for (int u = blockIdx.x; u < units; u += gridDim.x) {
    const int us = xcd_swz(u, 10);
    int g = us / 10, rem = us - g * 10;
    int mt = rem >> 1, nt = rem & 1;
    int m0 = mt * 128, n0 = nt * 128;
    const bfr* Ag = U2 + (size_t)g * TOK * 16;
    const bfr* Bg = WST + (size_t)g * 256 * 512;
    f32x16 acc[2][2];
    zero_acc(acc);
    gemm_full(
        acc, 16,
        [&](int row, int k) {
          int rr = m0 + row;
          rr = rr < NROW ? rr : NROW - 1;
          return Ag + (size_t)rr * 512 + k;
        },
        [&](int row, int k) { return Bg + (size_t)(n0 + row) * 512 + k; }, sm);
#pragma unroll
    for (int mi = 0; mi < 2; ++mi)
#pragma unroll
      for (int ni = 0; ni < 2; ++ni) {
        int col = n0 + wn * 64 + ni * 32 + r;
#pragma unroll
        for (int i = 0; i < 16; ++i) {
          int row = m0 + wm * 64 + mi * 32 + crow(i, h);
          SLOC[((size_t)g * SLOC_ROWS + row) * 256 + col] = acc[mi][ni][i];
        }
      }
  }
}

DI void phase_o7(const Params& p) {
  const int tidx_ = opaque_tid();
  const float* SLOC = (const float*)(p.ws + O_SLOC);
  bfr* SIN = (bfr*)(p.ws + O_SIN);
  const int total = NB * 64 * 2 * 64;
  for (int idx = blockIdx.x * 256 + tidx_; idx < total; idx += gridDim.x * 256) {
    int pp = idx & 63, dir = (idx >> 6) & 1, g = (idx >> 7) & 63, b = idx >> 13;
    double dt, ar, ai;
    float fr, fi, lr, li;
    s5_disc(p, dir, g, pp, dt, ar, ai, fr, fi);
    s5_pow(dt, ar, ai, TC, lr, li);
    float sr = 0.f, si = 0.f;
    auto cpos = [&](int step) { return dir == 0 ? step : (step < 8 ? 7 - step : NCH - 1 - (step - 8)); };
    const float* slb = SLOC + ((size_t)g * SLOC_ROWS + b * NCH) * 256 + dir * 128 + pp;
    bfr* sob = SIN + ((size_t)g * (NB * NCHL) + b * NCHL) * 256 + dir * 128 + pp;
#pragma unroll 1
    for (int s0 = 0; s0 < NCH; s0 += 24) {
      float lre[24], lim[24];
#pragma unroll
      for (int j = 0; j < 24; ++j) {
        const float* sl = slb + (size_t)cpos(s0 + j) * 256;
        lre[j] = sl[0];
        lim[j] = sl[64];
      }
#pragma unroll
      for (int j = 0; j < 24; ++j) {
        int cp = cpos(s0 + j);
        if (cp >= 8) {
          bfr* so = sob + (size_t)(cp - 8) * 256;
          so[0] = f2bf(sr);
          so[64] = f2bf(si);
        }
        float nr = lr * sr - li * si + lre[j];
        float ni = lr * si + li * sr + lim[j];
        sr = nr;
        si = ni;
      }
    }
  }
}

DI void phase_o8(const Params& p, char* smem) {
  GemmSmem* sm = (GemmSmem*)smem;
  WAVE_IDS
  const int units = 64 * 4 * 4;
  const bfr* U2 = (const bfr*)(p.ws + O_U2);
  const bfr* SIN = (const bfr*)(p.ws + O_SIN);
  const bfr* KTAB = (const bfr*)(p.ws + O_KTAB);
  const bfr* VOP = (const bfr*)(p.ws + O_VOP);
  bfr* YG = (bfr*)(p.ws + O_YG);
  for (int u = blockIdx.x; u < units; u += gridDim.x) {
    const int us = xcd_swz(u, 16);
    int g = us >> 4, mt = (us >> 2) & 3, nt = us & 3;
    int m0 = mt * 128, n0 = nt * 128;
    const bfr* Ug = U2 + (size_t)g * TOK * 16;
    f32x16 acc[2][2];
    zero_acc(acc);
    gemm_full(
        acc, 16,
        [&](int row, int k) {
          int rr = m0 + row;
          int b = rr >> 6, n = rr & 63;
          return Ug + ((size_t)b * LALL + LC + n * TC) * 16 + k;
        },
        [&](int row, int k) {
          int m = n0 + row;
          int t = m >> 4, c = m & 15;
          return KTAB + (((size_t)g * 63 + (t + 31)) * 16 + c) * 16 - (k >> 4) * 256 + (k & 15);
        },
        sm);
    gemm_full(
        acc, 8, [&](int row, int k) { return SIN + ((size_t)g * (NB * NCHL) + m0 + row) * 256 + k; },
        [&](int row, int k) { return VOP + ((size_t)g * 512 + n0 + row) * 256 + k; }, sm);
    {
      float* wl = (float*)sm + wave * 2048;
      const int mcol = n0 + wn * 64 + (lane & 7) * 8;
      const int t = mcol >> 4, c0 = mcol & 15;
      const int ch = g * 16 + c0;
      const float4 d0 = *(const float4*)(p.in[I_S5D] + ch), d1 = *(const float4*)(p.in[I_S5D] + ch + 4);
#pragma unroll
      for (int mi = 0; mi < 2; ++mi) {
        float4 lo[4], hi[4];
        stage_half8(acc, mi, wl, lo, hi, lane);
        uint4 uq[4];
#pragma unroll
        for (int c = 0; c < 4; ++c) {
          int rr = m0 + wm * 64 + mi * 32 + c * 8 + (lane >> 3);
          int b = rr >> 6, n = rr & 63;
          uq[c] = *(const uint4*)(Ug + ((size_t)b * LALL + LC + n * TC + t) * 16 + c0);
        }
        SCHED_FENCE();
#pragma unroll
        for (int c = 0; c < 4; ++c) {
          int rr = m0 + wm * 64 + mi * 32 + c * 8 + (lane >> 3);
          int b = rr >> 6, n = rr & 63;
          float4 u0 = bf4_to_f4(make_uint2(uq[c].x, uq[c].y)), u1 = bf4_to_f4(make_uint2(uq[c].z, uq[c].w));
          uint4 o;
          o.x = pk2(gelu_tanh(lo[c].x + d0.x * u0.x), gelu_tanh(lo[c].y + d0.y * u0.y));
          o.y = pk2(gelu_tanh(lo[c].z + d0.z * u0.z), gelu_tanh(lo[c].w + d0.w * u0.w));
          o.z = pk2(gelu_tanh(hi[c].x + d1.x * u1.x), gelu_tanh(hi[c].y + d1.y * u1.y));
          o.w = pk2(gelu_tanh(hi[c].z + d1.z * u1.z), gelu_tanh(hi[c].w + d1.w * u1.w));
          *(uint4*)(YG + ((size_t)(b * SEQ + n * TC + t)) * 1024 + ch) = o;
        }
        SCHED_FENCE();
      }
      __syncthreads();
    }
  }
}

DI void phase_o9(const Params& p, char* smem) {
  GemmSmem* sm = (GemmSmem*)smem;
  WAVE_IDS
  const int NT = 8, units = (NLAT / 128) * NT;
  const bfr* YG = (const bfr*)(p.ws + O_YG);
  const bfr* SZ1 = (const bfr*)(p.ws + O_SZ1);
  const bfr* WT = (const bfr*)(p.ws + O_WT_GLU);
  bfr* Y2 = (bfr*)(p.ws + O_Y2);
  auto Aof = [&](int m0) { return [=](int row, int k) { return YG + (size_t)(m0 + row) * 1024 + k; }; };
  auto Bof = [&](int n0) { return [=](int row, int k) { return WT + (size_t)(n0 + row) * 1024 + k; }; };
  GSTAGE_DECL;
  if ((int)blockIdx.x < units) {
    const int us = xcd_swz(blockIdx.x, NT);
    gemm_prefetch(GSTAGE_ARGS, Aof((us / NT) * 128), Bof((us % NT) * 128));
  }
  for (int u = blockIdx.x; u < units; u += gridDim.x) {
    const int us = xcd_swz(u, NT);
    int mt = us / NT, nt = us - mt * NT;
    int m0 = mt * 128, n0 = nt * 128;
    f32x16 acc[2][2];
    zero_acc(acc);
    gemm_main(acc, 32, Aof(m0), Bof(n0), sm, GSTAGE_ARGS);
    if (u + (int)gridDim.x < units) {
      const int us1 = xcd_swz(u + gridDim.x, NT);
      gemm_prefetch(GSTAGE_ARGS, Aof((us1 / NT) * 128), Bof((us1 % NT) * 128));
    }
    float* wl = (float*)sm + wave * 2048;
    const int ccol = n0 + wn * 64 + (lane & 15) * 4;
    const float4 bg = *(const float4*)(p.in[I_BGLU] + ccol);
#pragma unroll
    for (int mi = 0; mi < 2; ++mi) {
      float4 v[8];
      stage_half(acc, mi, wl, v, lane);
      uint2 yv[8], zv[8];
#pragma unroll
      for (int c = 0; c < 8; ++c) {
        size_t o = (size_t)(m0 + wm * 64 + mi * 32 + c * 4 + (lane >> 4)) * 1024 + ccol;
        yv[c] = *(const uint2*)(YG + o);
        zv[c] = *(const uint2*)(SZ1 + o);
      }
      SCHED_FENCE();
#pragma unroll
      for (int c = 0; c < 8; ++c) {
        size_t o = (size_t)(m0 + wm * 64 + mi * 32 + c * 4 + (lane >> 4)) * 1024 + ccol;
        float4 y = bf4_to_f4(yv[c]), z = bf4_to_f4(zv[c]);
        float4 ov;
        ov.x = y.x * sigmoid_f(v[c].x + bg.x) * z.x;
        ov.y = y.y * sigmoid_f(v[c].y + bg.y) * z.y;
        ov.z = y.z * sigmoid_f(v[c].z + bg.z) * z.z;
        ov.w = y.w * sigmoid_f(v[c].w + bg.w) * z.w;
        *(uint2*)(Y2 + o) = f4_to_bf4(ov);
      }
      SCHED_FENCE();
    }
    __syncthreads();
  }
}

#define XB_TMO      128
#define XB_XCNT(j)  (256  + 64 * (j))
#define XB_XSUB(j)  (1280 + 64 * (j))
#define XB_XGEN(j)  (2304 + 64 * (j))
#define XB_TOP      3328
#define XB_TOPGEN   3392
#define XCD_BAR_WORDS 3456
#define XB_SPIN_CAP (1u << 18)
#define LAS __attribute__((address_space(3)))
DI unsigned xb_ld(unsigned* p) { return __hip_atomic_load(p, __ATOMIC_RELAXED, __HIP_MEMORY_SCOPE_AGENT); }
DI unsigned xb_add(unsigned* p, unsigned v) { return __hip_atomic_fetch_add(p, v, __ATOMIC_RELAXED, __HIP_MEMORY_SCOPE_AGENT); }
DI unsigned xb_xcc_id() { return (unsigned)__builtin_amdgcn_s_getreg((3 << 11) | 20) & 0xFu; }
#define XB_SPIN(cond, bar) do { unsigned _sp = 0; while (cond) { __builtin_amdgcn_s_sleep(1); \
    if ((++_sp & 255u) == 0u) { if (xb_ld(&(bar)[XB_TMO])) break; if (_sp > XB_SPIN_CAP) { atomicAdd(&(bar)[XB_TMO], 1u); break; } } } } while (0)
struct XcdBarrier {
  unsigned* bar;
  unsigned x;
  volatile LAS unsigned* st;
};
DI XcdBarrier xcd_barrier_post(unsigned* bar, volatile LAS unsigned* st) {
  XcdBarrier b;
  b.bar = bar;
  b.x = xb_xcc_id();
  b.st = st;
  if (threadIdx.x == 0) (void)xb_add(&bar[XB_XCNT(b.x)], 1u);
  return b;
}
DI void xcd_barrier_complete(unsigned* bar, unsigned x, unsigned& nloc, unsigned& nx) {
  const unsigned G = gridDim.x * gridDim.y * gridDim.z;
  unsigned sum, cnt, mine, sp = 0u;
  for (;;) {
    sum = 0u; cnt = 0u; mine = 0u;
#pragma unroll
    for (unsigned j = 0; j < 16; ++j) {
      const unsigned c = xb_ld(&bar[XB_XCNT(j)]);
      sum += c;
      cnt += (c > 0u) ? 1u : 0u;
      mine = (j == x) ? c : mine;
    }
    if (sum == G) break;
    __builtin_amdgcn_s_sleep(1);
    if ((++sp & 255u) == 0u) {
      if (xb_ld(&bar[XB_TMO])) break;
      if (sp > XB_SPIN_CAP) { atomicAdd(&bar[XB_TMO], 1u); break; }
    }
  }
  nloc = mine > 0u ? mine : 1u;
  nx = cnt > 0u ? cnt : 1u;
}
DI void xcd_barrier(const XcdBarrier& b) {
  asm volatile("s_waitcnt vmcnt(0)" ::: "memory");
  __syncthreads();
  if (threadIdx.x == 0) {
    unsigned* bar = b.bar;
    __builtin_amdgcn_s_waitcnt(0);
    unsigned nloc = b.st[0], nx = b.st[1];
    if (nloc == 0u) {
      xcd_barrier_complete(bar, b.x, nloc, nx);
      b.st[0] = nloc;
      b.st[1] = nx;
    }
    const unsigned old = xb_add(&bar[XB_XSUB(b.x)], 1u);
    const unsigned gen = old / nloc;
    if (old + 1u == (gen + 1u) * nloc) {
      __builtin_amdgcn_fence(__ATOMIC_RELEASE, "agent");
      asm volatile("s_waitcnt vmcnt(0)" ::: "memory");
      const unsigned og = xb_add(&bar[XB_TOP], 1u);
      const unsigned tg = og / nx;
      if (og + 1u == (tg + 1u) * nx) xb_add(&bar[XB_TOPGEN], 1u);
      else XB_SPIN(xb_ld(&bar[XB_TOPGEN]) == tg, bar);
      __builtin_amdgcn_fence(__ATOMIC_ACQUIRE, "agent");
      xb_add(&bar[XB_XGEN(b.x)], 1u);
      asm volatile("s_waitcnt vmcnt(0)" ::: "memory");
    } else {
      XB_SPIN(xb_ld(&bar[XB_XGEN(b.x)]) == gen, bar);
      __builtin_amdgcn_fence(__ATOMIC_ACQUIRE, "agent");
      asm volatile("s_waitcnt vmcnt(0)" ::: "memory");
    }
  }
  __syncthreads();
}

DI void run_phase(const Params& p, int ph, char* smem) {
  switch (ph) {
#if !defined(ONLY) || ONLY == 0
    case PH_PREP: phase_prep(p, smem); break;
#endif
#if !defined(ONLY) || ONLY == 1
    case PH_FINAL: phase_final(p); break;
#endif
#if !defined(ONLY) || ONLY == 2
    case PH_O1: phase_o1(p, smem); break;
#endif
#if !defined(ONLY) || ONLY == 3
    case PH_O2: phase_o2(p, smem); break;
#endif
#if !defined(ONLY) || ONLY == 4
    case PH_O3: phase_o3(p, smem); break;
#endif
#if !defined(ONLY) || ONLY == 5
    case PH_O4: phase_oproj<0>(p, smem); break;
#endif
#if !defined(ONLY) || ONLY == 6
    case PH_O5: phase_o5(p, smem); break;
#endif
#if !defined(ONLY) || ONLY == 7
    case PH_O6: phase_o6(p, smem); break;
#endif
#if !defined(ONLY) || ONLY == 8
    case PH_O7: phase_o7(p); break;
#endif
#if !defined(ONLY) || ONLY == 9
    case PH_O8: phase_o8(p, smem); break;
#endif
#if !defined(ONLY) || ONLY == 10
    case PH_O9: phase_o9(p, smem); break;
#endif
#if !defined(ONLY) || ONLY == 11
    case PH_O10: phase_oproj<1>(p, smem); break;
#endif
    case PH_H0: phase_hconv<0>(p); break;
    case PH_H1: phase_hconv<1>(p); break;
    default: break;
  }
}

__global__ void __launch_bounds__(256, 2) mega_one(Params p, int ph) {
  __shared__ __attribute__((aligned(16))) char smem[SMEM_BYTES];
  run_phase(p, ph, smem);
}

#if !defined(ONLY) && SINGLE_LAUNCH
__global__ void __launch_bounds__(256, 2) mega(Params p) {
  __shared__ __attribute__((aligned(16))) char smem[SMEM_BYTES];
  __shared__ uint4 xb_words;
  if (threadIdx.x == 0) xb_words = make_uint4(0u, 0u, 0u, 0u);
  __syncthreads();
  if (p.nprog < 0) cg::this_grid().sync();
  const XcdBarrier xb = xcd_barrier_post((unsigned*)(p.ws + O_BAR), (volatile LAS unsigned*)&xb_words);
  cg::grid_group grid = cg::this_grid();
#if !defined(OMIT) || OMIT != 0
  phase_prep(p, smem);
#endif
  xcd_barrier(xb);
#if (DUP >> 0) & 1
  phase_prep(p, smem);
  xcd_barrier(xb);
#endif
  phase_hconv<0>(p);
  xcd_barrier(xb);
#if !defined(OMIT) || OMIT != 1
  phase_o1(p, smem);
#endif
  xcd_barrier(xb);
#if (DUP >> 1) & 1
  phase_o1(p, smem);
  xcd_barrier(xb);
#endif
#if !defined(OMIT) || OMIT != 2
  phase_o2(p, smem);
#endif
  xcd_barrier(xb);
#if (DUP >> 2) & 1
  phase_o2(p, smem);
  xcd_barrier(xb);
#endif
#if !defined(OMIT) || OMIT != 3
  phase_o3(p, smem);
#endif
  xcd_barrier(xb);
#if (DUP >> 3) & 1
  phase_o3(p, smem);
  xcd_barrier(xb);
#endif
#if !defined(OMIT) || OMIT != 4
  phase_oproj<0>(p, smem);
#endif
  xcd_barrier(xb);
#if (DUP >> 4) & 1
  phase_oproj<0>(p, smem);
  xcd_barrier(xb);
#endif
  phase_hconv<1>(p);
  xcd_barrier(xb);
#if !defined(OMIT) || OMIT != 5
  phase_o5(p, smem);
#endif
  xcd_barrier(xb);
#if (DUP >> 5) & 1
  phase_o5(p, smem);
  xcd_barrier(xb);
#endif
#if !defined(OMIT) || OMIT != 6
  phase_o6(p, smem);
#endif
  xcd_barrier(xb);
#if (DUP >> 6) & 1
  phase_o6(p, smem);
  xcd_barrier(xb);
#endif
#if !defined(OMIT) || OMIT != 7
  phase_o7(p);
#endif
  xcd_barrier(xb);
#if (DUP >> 7) & 1
  phase_o7(p);
  xcd_barrier(xb);
#endif
#if !defined(OMIT) || OMIT != 8
  phase_o8(p, smem);
#endif
  xcd_barrier(xb);
#if (DUP >> 8) & 1
  phase_o8(p, smem);
  xcd_barrier(xb);
#endif
#if !defined(OMIT) || OMIT != 9
  phase_o9(p, smem);
#endif
  xcd_barrier(xb);
#if (DUP >> 9) & 1
  phase_o9(p, smem);
  xcd_barrier(xb);
#endif
#if !defined(OMIT) || OMIT != 10
  phase_oproj<1>(p, smem);
#endif
  xcd_barrier(xb);
#if !defined(OMIT) || OMIT != 11
  phase_final(p);
#endif
}
#else
__global__ void mega(Params p) {}
#endif


extern "C" void kernel_launch(void* const* d_in, const int* in_sizes, int n_in, void* d_out, int out_size, void* d_ws,
                              size_t ws_size, hipStream_t stream) {
  static int grid_blocks = 0;
  if (!grid_blocks) {
    int dev = 0, cus = 0, per_cu = 0;
    hipGetDevice(&dev);
    hipDeviceGetAttribute(&cus, hipDeviceAttributeMultiprocessorCount, dev);
#if SINGLE_LAUNCH
    hipOccupancyMaxActiveBlocksPerMultiprocessor(&per_cu, mega, 256, 0);
#else
    hipOccupancyMaxActiveBlocksPerMultiprocessor(&per_cu, mega_one, 256, 0);
#endif
    if (per_cu < 1) per_cu = 1;
    if (per_cu > 2) per_cu = 2;
    grid_blocks = cus * per_cu;
  }
  if (ws_size < WS_NEED || n_in < N_INPUTS) {
    fprintf(stderr, "workspace too small or bad inputs: %zu < %zu\n", ws_size, (size_t)WS_NEED);
    return;
  }
  Params p{};
  for (int i = 0; i < N_INPUTS; ++i) p.in[i] = (const float*)d_in[i];
  p.out = (float*)d_out;
  p.ws = (char*)d_ws;
#ifndef PROG
#define PROG PH_PREP, PH_H0, PH_O1, PH_O2, PH_O3, PH_O4, PH_H1, PH_O5, PH_O6, PH_O7, PH_O8, PH_O9, PH_O10, PH_FINAL
#endif
  const int prog[] = {PROG};
  p.nprog = (int)(sizeof(prog) / sizeof(int));
  for (int i = 0; i < p.nprog; ++i) p.prog[i] = prog[i];
#if SINGLE_LAUNCH
  hipMemsetAsync((char*)d_ws + O_BAR, 0, BAR_BYTES, stream);
  void* args[] = {&p};
  hipError_t e = hipLaunchCooperativeKernel((void*)mega, dim3(grid_blocks), dim3(256), args, 0, stream);
  if (e != hipSuccess) fprintf(stderr, "cooperative launch failed: %s (grid %d)\n", hipGetErrorString(e), grid_blocks);
#else
  for (int i = 0; i < p.nprog; ++i) {
    mega_one<<<dim3(grid_blocks), dim3(256), 0, stream>>>(p, p.prog[i]);
  }
#endif
}
```

```cpp
#include <hip/hip_runtime.h>
#include <hip/hip_cooperative_groups.h>
#include <cstdio>
namespace cg = cooperative_groups;
#ifndef DUP
#define DUP 0
#endif
#ifndef USE_NAIVE
#define USE_NAIVE 0
#endif
#ifndef SINGLE_LAUNCH
#define SINGLE_LAUNCH 1
#endif

#define DI __device__ __forceinline__
typedef unsigned short bfr;

constexpr int D = 1024, NB = 8, SEQ = 2048, LC = 256, LALL = 2304;
constexpr int TOK = NB * LALL;
constexpr int NLAT = NB * SEQ;
constexpr int NH = 16, DQK = 96, DV = 64;
constexpr int NIN0 = 1440, NIN1 = 2048;
constexpr float EPS = 1e-6f;
constexpr float QSCALE = 0.10206207261596577f * 1.4426950408889634f;
constexpr int TC = 32;
constexpr int NCH = LALL / TC;
constexpr int NCHL = SEQ / TC;

enum { I_X = 0, I_C, I_CTX, I_CCTX, I_ADAW, I_ADAB, I_NORMG, I_WIN0, I_QNORM, I_WUQ, I_KVNORM, I_WUKV, I_WOUT0,
       I_WIN1, I_ARE, I_AIM, I_LOGSTEP, I_BRE, I_BIM, I_CRE, I_CIM, I_S5D, I_WGLU, I_BGLU, I_WOUT1, I_FINALG, N_INPUTS };

constexpr size_t al256(size_t x) { return (x + 255) & ~(size_t)255; }
constexpr size_t O_WT_IN0 = 0;
constexpr size_t O_WT_UQ = O_WT_IN0 + al256((size_t)NIN0 * 1024 * 2);
constexpr size_t O_WT_UKV = O_WT_UQ + al256((size_t)1536 * 256 * 2);
constexpr size_t O_WT_OUT0 = O_WT_UKV + al256((size_t)2048 * 128 * 2);
constexpr size_t O_WT_IN1 = O_WT_OUT0 + al256((size_t)1024 * 1024 * 2);
constexpr size_t O_WT_GLU = O_WT_IN1 + al256((size_t)2048 * 1024 * 2);
constexpr size_t O_WT_OUT1 = O_WT_GLU + al256((size_t)1024 * 1024 * 2);
constexpr size_t O_MOD = O_WT_OUT1 + al256((size_t)1024 * 1024 * 2);
constexpr size_t O_RS0 = O_MOD + al256((size_t)2 * 9 * 3072 * 4);
constexpr size_t O_PART1 = O_RS0 + al256((size_t)TOK * 4);
constexpr size_t O_PART2 = O_PART1 + al256((size_t)16 * TOK * 4);
constexpr size_t O_X1CTX = O_PART2 + al256((size_t)16 * NLAT * 4);
constexpr size_t O_KTAB = O_X1CTX + al256((size_t)NB * LC * 1024 * 4);
constexpr size_t O_WST = O_KTAB + al256((size_t)64 * 63 * 256 * 2);
constexpr size_t O_VOP = O_WST + al256((size_t)64 * 256 * 512 * 2);
constexpr size_t O_BAR = O_VOP + al256((size_t)64 * 512 * 256 * 2);
constexpr size_t BAR_BYTES = 3456 * 4;
constexpr size_t O_LAYER = O_BAR + al256(BAR_BYTES);
constexpr size_t O_PC = O_LAYER;
constexpr size_t O_SZ0 = O_PC + al256((size_t)TOK * 384 * 2);
constexpr size_t O_K = O_SZ0 + al256((size_t)TOK * 1024 * 2);
constexpr size_t O_VT = O_K + al256((size_t)NB * NH * LALL * 64 * 2);
constexpr size_t O_OG = O_VT + al256((size_t)NB * NH * DV * LALL * 2);
constexpr size_t O_KR = O_OG + al256((size_t)TOK * 1024 * 2);
constexpr size_t O_END0 = O_KR + al256((size_t)TOK * 32 * 2);
constexpr size_t O_H0 = O_OG;
constexpr size_t O_U2 = O_LAYER;
constexpr size_t O_SZ1 = O_U2 + al256((size_t)64 * TOK * 16 * 2);
constexpr size_t O_SLOC = O_SZ1 + al256((size_t)NLAT * 1024 * 2);
constexpr int SLOC_ROWS = 640;
constexpr size_t O_SIN = O_SLOC + al256((size_t)64 * SLOC_ROWS * 256 * 4);
constexpr size_t O_YG = O_SIN + al256((size_t)64 * (NB * NCHL) * 256 * 2);
constexpr size_t O_H1 = O_YG + al256((size_t)NLAT * 1024 * 2);
constexpr size_t O_END1 = O_H1 + al256((size_t)TOK * 1024 * 2);
constexpr size_t O_Y2 = O_SLOC;
constexpr size_t WS_NEED = (O_END0 > O_END1 ? O_END0 : O_END1);
static_assert(WS_NEED <= (size_t)256 * 1024 * 1024, "workspace too large");
static_assert((size_t)NB * NH * LALL * DQK * 2 <= (size_t)NLAT * 1024 * 4, "Q does not fit d_out");

struct Params {
  const float* in[N_INPUTS];
  float* out;
  char* ws;
  int prog[32];
  int nprog;
  int pad;
};

DI bfr f2bf(float x) {
  unsigned u = __float_as_uint(x);
  u += 0x7fffu + ((u >> 16) & 1u);
  return (bfr)(u >> 16);
}
typedef __bf16 bf2_t __attribute__((ext_vector_type(2)));
typedef float f2_t __attribute__((ext_vector_type(2)));
DI unsigned pk2(float a, float b) {
  f2_t v = {a, b};
  bf2_t r = __builtin_convertvector(v, bf2_t);
  return __builtin_bit_cast(unsigned, r);
}
DI int opaque_tid() {
  int t = threadIdx.x;
  asm volatile("" : "+v"(t));
  return t;
}
DI float bf2f(bfr b) { return __uint_as_float(((unsigned)b) << 16); }
DI float silu_f(float v) { return v / (1.f + __expf(-v)); }
DI float sigmoid_f(float v) { return 1.f / (1.f + __expf(-v)); }
DI float gelu_tanh(float v) {
  float u = 0.7978845608028654f * (v + 0.044715f * v * v * v);
  return 0.5f * v * (1.f + tanhf(u));
}
DI float wave_sum(float v) {
#pragma unroll
  for (int o = 32; o > 0; o >>= 1) v += __shfl_xor(v, o);
  return v;
}
DI float wave_max(float v) {
#pragma unroll
  for (int o = 32; o > 0; o >>= 1) v = fmaxf(v, __shfl_xor(v, o));
  return v;
}
DI const float* xrow0(const Params& p, int tok) {
  int b = tok / LALL, pos = tok - b * LALL;
  return pos < LC ? p.in[I_CTX] + ((size_t)(b * LC + pos)) * D : p.in[I_X] + ((size_t)(b * SEQ + pos - LC)) * D;
}
DI float* xrow1(const Params& p, int tok) {
  int b = tok / LALL, pos = tok - b * LALL;
  return pos < LC ? (float*)(p.ws + O_X1CTX) + ((size_t)(b * LC + pos)) * D : p.out + ((size_t)(b * SEQ + pos - LC)) * D;
}
DI const float* modrow(const Params& p, int layer, int tok) {
  int b = tok / LALL, pos = tok - b * LALL;
  int r = pos < LC ? 8 : b;
  return (const float*)(p.ws + O_MOD) + ((size_t)(layer * 9 + r)) * 3072;
}
DI void rope_cs(int fi, int posv, float& cs, float& sn) {
  float inv = __builtin_amdgcn_exp2f(-(float)fi * (13.287712379549449f / 8.f));
  float rev = (float)posv * inv * 0.15915494309189535f;
  rev -= floorf(rev);
  sn = __builtin_amdgcn_sinf(rev);
  cs = __builtin_amdgcn_cosf(rev);
}
DI float rope_apply(int j, float v, float vp, int lpos) {
  int posv = (j & 16) ? (lpos & 63) : (lpos >> 6);
  float cs, sn;
  rope_cs(j & 7, posv, cs, sn);
  return (j & 8) ? (vp * sn + v * cs) : (v * cs - vp * sn);
}

DI void s5_disc(const Params& p, int dir, int g, int pp, double& dt, double& ar, double& ai, float& fr, float& fi) {
  dt = exp((double)p.in[I_LOGSTEP][dir * 64 + g]);
  ar = (double)p.in[I_ARE][(dir * 64 + g) * 64 + pp];
  ai = (double)p.in[I_AIM][(dir * 64 + g) * 64 + pp];
  double mag = exp(ar * dt);
  double a = ai * dt;
  a -= 6.283185307179586 * rint(a * 0.15915494309189535);
  float sn, cs;
  sincosf((float)a, &sn, &cs);
  double lr = mag * (double)cs, li = mag * (double)sn;
  double den = ar * ar + ai * ai, nr = lr - 1.0;
  fr = (float)((nr * ar + li * ai) / den);
  fi = (float)((li * ar - nr * ai) / den);
}
DI void s5_pow(double dt, double ar, double ai, int k, float& wr, float& wi) {
  double mag = exp(ar * dt * (double)k);
  double a = ai * dt * (double)k;
  a -= 6.283185307179586 * rint(a * 0.15915494309189535);
  float sn, cs;
  sincosf((float)a, &sn, &cs);
  wr = (float)mag * cs;
  wi = (float)mag * sn;
}

enum { PH_PREP = 0, PH_N1, PH_N2, PH_N3, PH_N4, PH_N4B, PH_N5, PH_N6A, PH_N6B, PH_N9, PH_N10, PH_N10B, PH_FINAL,
       PH_O1, PH_O2, PH_O3, PH_O4, PH_O5, PH_O6, PH_O7, PH_O8, PH_O9, PH_O10, PH_H0, PH_H1, PH_COUNT };

constexpr int SMEM_BYTES = 48 * 1024;


DI void prep_transpose(const Params& p, int widx, int tile, char* smem) {
  const int tidx_ = opaque_tid();
  int K, N;
  size_t dst;
  const float* W;
  const float* scl = nullptr;
  switch (widx) {
    case 0: W = p.in[I_WIN0]; K = 1024; N = NIN0; dst = O_WT_IN0; break;
    case 1: W = p.in[I_WUQ]; K = 256; N = 1536; dst = O_WT_UQ; scl = p.in[I_QNORM]; break;
    case 2: W = p.in[I_WUKV]; K = 128; N = 2048; dst = O_WT_UKV; scl = p.in[I_KVNORM]; break;
    case 3: W = p.in[I_WOUT0]; K = 1024; N = 1024; dst = O_WT_OUT0; break;
    case 4: W = p.in[I_WIN1]; K = 1024; N = NIN1; dst = O_WT_IN1; break;
    case 5: W = p.in[I_WGLU]; K = 1024; N = 1024; dst = O_WT_GLU; break;
    default: W = p.in[I_WOUT1]; K = 1024; N = 1024; dst = O_WT_OUT1; break;
  }
  float (*t)[33] = (float (*)[33])smem;
  int ntn = N / 32;
  int kt = tile / ntn, nt = tile - kt * ntn;
  int tx = tidx_ & 31, ty = tidx_ >> 5;
  float v[16];
#pragma unroll
  for (int i = 0; i < 16; ++i) {
    int k = kt * 128 + ty + 8 * i, n = nt * 32 + tx;
    v[i] = W[(size_t)k * N + n];
  }
  if (scl) {
#pragma unroll
    for (int i = 0; i < 16; ++i) v[i] *= scl[kt * 128 + ty + 8 * i];
  }
#pragma unroll
  for (int i = 0; i < 16; ++i) t[ty + 8 * i][tx] = v[i];
  __syncthreads();
  bfr* Wt = (bfr*)(p.ws + dst);
  {
    int nl = tidx_ >> 3, kc = (tidx_ & 7) * 16;
    unsigned w[8];
#pragma unroll
    for (int j = 0; j < 8; ++j) w[j] = pk2(t[kc + 2 * j][nl], t[kc + 2 * j + 1][nl]);
    uint4* dstp = (uint4*)(Wt + (size_t)(nt * 32 + nl) * K + kt * 128 + kc);
    dstp[0] = make_uint4(w[0], w[1], w[2], w[3]);
    dstp[1] = make_uint4(w[4], w[5], w[6], w[7]);
  }
  __syncthreads();
}

DI void prep_mod(const Params& p, int unit, char* smem) {
  const int tidx_ = opaque_tid();
  int layer = unit / 192, cgp = unit - layer * 192;
  float* sil = (float*)smem;
  float* red = sil + 9 * 1024;
  for (int i = tidx_; i < 9 * 1024; i += 256) {
    int r = i >> 10, k = i & 1023;
    float v = r < 8 ? p.in[I_C][r * 1024 + k] : p.in[I_CCTX][k];
    sil[i] = silu_f(v);
  }
  __syncthreads();
  int nn = tidx_ & 15, kg = tidx_ >> 4;
  int n = cgp * 16 + nn;
  const float* W = p.in[I_ADAW] + (size_t)layer * 1024 * 3072 + n;
  float acc[9];
#pragma unroll
  for (int r = 0; r < 9; ++r) acc[r] = 0.f;
#pragma unroll 1
  for (int k0 = kg * 64; k0 < kg * 64 + 64; k0 += 32) {
    float wv[32];
#pragma unroll
    for (int j = 0; j < 32; ++j) wv[j] = W[(size_t)(k0 + j) * 3072];
#pragma unroll
    for (int j = 0; j < 32; ++j) {
#pragma unroll
      for (int r = 0; r < 9; ++r) acc[r] += sil[r * 1024 + k0 + j] * wv[j];
    }
  }
#pragma unroll
  for (int r = 0; r < 9; ++r) red[(kg * 9 + r) * 16 + nn] = acc[r];
  __syncthreads();
  if (tidx_ < 144) {
    int r = tidx_ >> 4, c = tidx_ & 15;
    int nc = cgp * 16 + c;
    float s = p.in[I_ADAB][layer * 3072 + nc];
#pragma unroll
    for (int g = 0; g < 16; ++g) s += red[(g * 9 + r) * 16 + c];
    ((float*)(p.ws + O_MOD))[((size_t)(layer * 9 + r)) * 3072 + nc] = s;
  }
  __syncthreads();
}

DI void prep_ktab(const Params& p, int unit, char* smem) {
  const int tidx_ = opaque_tid();
  int g = unit / 7, lg = unit - g * 7;
  float2* E = (float2*)smem;
  int tid = tidx_;
  const bool use_f = lg >= 3, use_r = lg <= 3;
  for (int i = tid; i < 9 * 128; i += 256) {
    int l = i >> 7, dir = (i >> 6) & 1, pp = i & 63;
    int lag = lg * 9 + l - 31;
    bool used = (dir == 0) ? (lag >= 0) : (lag <= 0);
    float2 e = make_float2(0.f, 0.f);
    if (used) {
      double dt, ar, ai;
      float fr, fi, wr, wi;
      s5_disc(p, dir, g, pp, dt, ar, ai, fr, fi);
      s5_pow(dt, ar, ai, lag < 0 ? -lag : lag, wr, wi);
      e.x = wr * fr - wi * fi;
      e.y = wr * fi + wi * fr;
    }
    E[(l * 2 + dir) * 64 + pp] = e;
  }
  float* PB = (float*)(E + 9 * 128);
  for (int dir = 0; dir < 2; ++dir) {
    if (dir == 0 ? !use_f : !use_r) continue;
    const float4* s0 = (const float4*)(p.in[I_BRE] + ((size_t)(dir * 64 + g)) * 1024);
    const float4* s1 = (const float4*)(p.in[I_BIM] + ((size_t)(dir * 64 + g)) * 1024);
    const float4* s2 = (const float4*)(p.in[I_CRE] + ((size_t)(dir * 64 + g)) * 1024);
    const float4* s3 = (const float4*)(p.in[I_CIM] + ((size_t)(dir * 64 + g)) * 1024);
    float4* d = (float4*)(PB + dir * 4096);
    d[tid] = s0[tid];
    d[256 + tid] = s1[tid];
    d[512 + tid] = s2[tid];
    d[768 + tid] = s3[tid];
  }
  __syncthreads();
  int c = tid >> 4, c2 = tid & 15;
  float acc[9];
#pragma unroll
  for (int l = 0; l < 9; ++l) acc[l] = 0.f;
  for (int dir = 0; dir < 2; ++dir) {
    if (dir == 0 ? !use_f : !use_r) continue;
    const float* bre = PB + dir * 4096;
    const float* bim = bre + 1024;
    const float* cre = bre + 2048;
    const float* cim = bre + 3072;
#pragma unroll 4
    for (int pp = 0; pp < 64; ++pp) {
      float br = bre[pp * 16 + c2], bi = bim[pp * 16 + c2];
      float cr = cre[c * 64 + pp], ci = cim[c * 64 + pp];
      float mr = cr * br - ci * bi, mi = cr * bi + ci * br;
#pragma unroll
      for (int l = 0; l < 9; ++l) {
        float2 e = E[(l * 2 + dir) * 64 + pp];
        acc[l] += mr * e.x - mi * e.y;
      }
    }
  }
  bfr* KT = (bfr*)(p.ws + O_KTAB);
#pragma unroll
  for (int l = 0; l < 9; ++l) KT[(((size_t)g * 63 + lg * 9 + l) * 16 + c) * 16 + c2] = f2bf(acc[l]);
  __syncthreads();
}

DI void prep_ops(const Params& p, int unit) {
  const int tidx_ = opaque_tid();
  int idx = unit * 256 + tidx_;
  int pp = idx & 63, t = (idx >> 6) & 31, dir = (idx >> 11) & 1, g = idx >> 12;
  double dt, ar, ai;
  float fr, fi, wr, wi;
  s5_disc(p, dir, g, pp, dt, ar, ai, fr, fi);
  s5_pow(dt, ar, ai, dir == 0 ? (TC - 1 - t) : t, wr, wi);
  float er = wr * fr - wi * fi, ei = wr * fi + wi * fr;
  const float* bre = p.in[I_BRE] + (((size_t)(dir * 64 + g)) * 64 + pp) * 16;
  const float* bim = p.in[I_BIM] + (((size_t)(dir * 64 + g)) * 64 + pp) * 16;
  bfr* wst = (bfr*)(p.ws + O_WST) + (size_t)g * 256 * 512;
  bfr* rre = wst + (size_t)(dir * 128 + pp) * 512 + t * 16;
  bfr* rim = wst + (size_t)(dir * 128 + 64 + pp) * 512 + t * 16;
#pragma unroll
  for (int c2 = 0; c2 < 16; ++c2) {
    float br = bre[c2], bi = bim[c2];
    rre[c2] = f2bf(er * br - ei * bi);
    rim[c2] = f2bf(er * bi + ei * br);
  }
  s5_pow(dt, ar, ai, dir == 0 ? (t + 1) : (TC - t), wr, wi);
  const float* cre = p.in[I_CRE] + ((size_t)(dir * 64 + g)) * 16 * 64;
  const float* cim = p.in[I_CIM] + ((size_t)(dir * 64 + g)) * 16 * 64;
  bfr* vop = (bfr*)(p.ws + O_VOP) + (size_t)g * 512 * 256;
#pragma unroll
  for (int c = 0; c < 16; ++c) {
    float cr = cre[c * 64 + pp], ci = cim[c * 64 + pp];
    float dr = cr * wr - ci * wi, di = cr * wi + ci * wr;
    vop[(size_t)(t * 16 + c) * 256 + dir * 128 + pp] = f2bf(dr);
    vop[(size_t)(t * 16 + c) * 256 + dir * 128 + 64 + pp] = f2bf(-di);
  }
}

constexpr int TR_T0 = 8 * 45, TR_T1 = 2 * 48, TR_T2 = 1 * 64, TR_T3 = 256, TR_T4 = 8 * 64, TR_T5 = 256, TR_T6 = 256;
constexpr int TR_TOTAL = TR_T0 + TR_T1 + TR_T2 + TR_T3 + TR_T4 + TR_T5 + TR_T6;
constexpr int U_MOD = 384, U_RS0 = 0, U_KTAB = 64 * 7, U_OPS = 64 * 2 * 64 * 32 / 256;
constexpr int PREP_A_UNITS = U_MOD + TR_T0 + TR_T1 + TR_T2 + TR_T3;
constexpr int PREP_B_UNITS = TR_T4 + TR_T5 + TR_T6 + U_KTAB + U_OPS;

DI void phase_prep(const Params& p, char* smem) {
  for (int u = blockIdx.x; u < PREP_A_UNITS; u += gridDim.x) {
    int v = u;
    if (v < U_MOD) { prep_mod(p, v, smem); continue; }
    v -= U_MOD;
    int w = 0;
    if (v >= TR_T0) { v -= TR_T0; w = 1;
      if (v >= TR_T1) { v -= TR_T1; w = 2;
        if (v >= TR_T2) { v -= TR_T2; w = 3; } } }
    prep_transpose(p, w, v, smem);
  }
}
DI void phase_prep_b(const Params& p, char* smem, int first_blk) {
  if (first_blk >= (int)gridDim.x) first_blk = 0;
  if ((int)blockIdx.x < first_blk) return;
  const int nb = gridDim.x - first_blk;
  for (int u = blockIdx.x - first_blk; u < PREP_B_UNITS; u += nb) {
    int v = u;
    if (v < TR_T4 + TR_T5 + TR_T6) {
      int w = 4;
      if (v >= TR_T4) { v -= TR_T4; w = 5;
        if (v >= TR_T5) { v -= TR_T5; w = 6; } }
      prep_transpose(p, w, v, smem);
      continue;
    }
    v -= TR_T4 + TR_T5 + TR_T6;
    if (v < U_KTAB) { prep_ktab(p, v, smem); continue; }
    v -= U_KTAB;
    prep_ops(p, v);
  }
}

DI float rs_from_part(const float* part, int nrows, int r) {
  float s = 0.f;
#pragma unroll
  for (int j = 0; j < 16; ++j) s += part[(size_t)j * nrows + r];
  return rsqrtf(s * (1.f / 1024.f) + EPS);
}

DI void phase_final(const Params& p) {
  const int tidx_ = opaque_tid();
  const float* part = (const float*)(p.ws + O_PART2);
  const float4* g4 = (const float4*)p.in[I_FINALG];
  int lane = tidx_ & 63;
  float4 g[4];
#pragma unroll
  for (int i = 0; i < 4; ++i) g[i] = g4[lane + 64 * i];
  for (int r = (blockIdx.x * 4 + (tidx_ >> 6)) * 2; r < NLAT; r += gridDim.x * 8) {
    float4* row0 = (float4*)(p.out + (size_t)r * D);
    float4* row1 = row0 + D / 4;
    float4 v0[4], v1[4];
#pragma unroll
    for (int i = 0; i < 4; ++i) {
      v0[i] = row0[lane + 64 * i];
      v1[i] = row1[lane + 64 * i];
    }
    float ps = part[(size_t)(lane & 15) * NLAT + r + ((lane >> 4) & 1)];
    ps += __shfl_xor(ps, 1);
    ps += __shfl_xor(ps, 2);
    ps += __shfl_xor(ps, 4);
    ps += __shfl_xor(ps, 8);
    const float rs0 = rsqrtf(__shfl(ps, 0) * (1.f / 1024.f) + EPS);
    const float rs1 = rsqrtf(__shfl(ps, 16) * (1.f / 1024.f) + EPS);
#pragma unroll
    for (int i = 0; i < 4; ++i) {
      float4 a = v0[i], c = v1[i];
      a.x *= rs0 * g[i].x; a.y *= rs0 * g[i].y; a.z *= rs0 * g[i].z; a.w *= rs0 * g[i].w;
      c.x *= rs1 * g[i].x; c.y *= rs1 * g[i].y; c.z *= rs1 * g[i].z; c.w *= rs1 * g[i].w;
      row0[lane + 64 * i] = a;
      row1[lane + 64 * i] = c;
    }
  }
}

typedef short bf16x8 __attribute__((ext_vector_type(8)));
typedef short s16x4 __attribute__((ext_vector_type(4)));
typedef float f32x16 __attribute__((ext_vector_type(16)));
#define SCHED_FENCE() __builtin_amdgcn_sched_barrier(0)
#define MFMA32(a, b, c) __builtin_amdgcn_mfma_f32_32x32x16_bf16((a), (b), (c), 0, 0, 0)
DI int xcd_swz(int u, int per) {
  int x = u & 7, q = u >> 3;
  int qq = q / per;
  return (x + 8 * qq) * per + (q - qq * per);
}
DI int crow(int i, int h) { return (i & 3) + 8 * (i >> 2) + 4 * h; }

constexpr int LDT = 40;
struct GemmSmem {
  bfr A[2][128 * LDT];
  bfr B[2][128 * LDT];
  float rs[128];
};
static_assert(sizeof(GemmSmem) <= SMEM_BYTES, "smem");

DI void zero_acc(f32x16 (&acc)[2][2]) {
#pragma unroll
  for (int a = 0; a < 2; ++a)
#pragma unroll
    for (int b = 0; b < 2; ++b)
#pragma unroll
      for (int i = 0; i < 16; ++i) acc[a][b][i] = 0.f;
}

#define GSTAGE_DECL uint4 ga0, ga1, gb0, gb1, gc0, gc1, gd0, gd1
#define GSTAGE_ARGS ga0, ga1, gb0, gb1, gc0, gc1, gd0, gd1
#define GSTAGE_PARAMS uint4 &a0, uint4 &a1, uint4 &b0, uint4 &b1, uint4 &c0, uint4 &c1, uint4 &d0, uint4 &d1
template <class AAddr, class BAddr>
DI void gemm_prefetch(GSTAGE_PARAMS, AAddr aaddr, BAddr baddr) {
  const int tid = opaque_tid();
  const int lrow = tid >> 2, lkc = (tid & 3) * 8;
  b0 = *(const uint4*)baddr(lrow, lkc);
  b1 = *(const uint4*)baddr(lrow + 64, lkc);
  a0 = *(const uint4*)aaddr(lrow, lkc);
  a1 = *(const uint4*)aaddr(lrow + 64, lkc);
  d0 = *(const uint4*)baddr(lrow, 32 + lkc);
  d1 = *(const uint4*)baddr(lrow + 64, 32 + lkc);
  c0 = *(const uint4*)aaddr(lrow, 32 + lkc);
  c1 = *(const uint4*)aaddr(lrow + 64, 32 + lkc);
  SCHED_FENCE();
}
template <class AAddr, class BAddr>
DI void gemm_main(f32x16 (&acc)[2][2], int KT, AAddr aaddr, BAddr baddr, GemmSmem* sm, GSTAGE_PARAMS) {
  const int tid = opaque_tid(), lane = tid & 63, wave = tid >> 6;
  const int wm = wave >> 1, wn = wave & 1, r = lane & 31, h = lane >> 5;
  const int lrow = tid >> 2, lkc = (tid & 3) * 8;
#define GM_LOAD(KT_, A0, A1, B0, B1)                   \
  {                                                    \
    const int kk_ = (KT_) * 32 + lkc;                  \
    B0 = *(const uint4*)baddr(lrow, kk_);              \
    B1 = *(const uint4*)baddr(lrow + 64, kk_);         \
    A0 = *(const uint4*)aaddr(lrow, kk_);              \
    A1 = *(const uint4*)aaddr(lrow + 64, kk_);         \
  }
#define GM_STORE(BUF_, A0, A1, B0, B1)                                  \
  {                                                                     \
    *(uint4*)(sm->B[BUF_] + lrow * LDT + lkc) = B0;                     \
    *(uint4*)(sm->B[BUF_] + (lrow + 64) * LDT + lkc) = B1;              \
    *(uint4*)(sm->A[BUF_] + lrow * LDT + lkc) = A0;                     \
    *(uint4*)(sm->A[BUF_] + (lrow + 64) * LDT + lkc) = A1;              \
  }
#define GM_COMPUTE(BUF_)                                                                                       \
  _Pragma("unroll") for (int ks = 0; ks < 2; ++ks) {                                                           \
    bf16x8 a_[2], b_[2];                                                                                       \
    _Pragma("unroll") for (int mi = 0; mi < 2; ++mi)                                                           \
        a_[mi] = *(const bf16x8*)(sm->A[BUF_] + (wm * 64 + mi * 32 + r) * LDT + ks * 16 + h * 8);              \
    _Pragma("unroll") for (int ni = 0; ni < 2; ++ni)                                                           \
        b_[ni] = *(const bf16x8*)(sm->B[BUF_] + (wn * 64 + ni * 32 + r) * LDT + ks * 16 + h * 8);              \
    _Pragma("unroll") for (int mi = 0; mi < 2; ++mi)                                                           \
        _Pragma("unroll") for (int ni = 0; ni < 2; ++ni) acc[mi][ni] = MFMA32(a_[mi], b_[ni], acc[mi][ni]);    \
  }
  GM_STORE(0, a0, a1, b0, b1)
  if (KT > 2) GM_LOAD(2, a0, a1, b0, b1)
  SCHED_FENCE();
  __syncthreads();
  for (int kt = 0; kt < KT; kt += 2) {
    GM_STORE(1, c0, c1, d0, d1)
    if (kt + 3 < KT) GM_LOAD(kt + 3, c0, c1, d0, d1)
    SCHED_FENCE();
    GM_COMPUTE(0)
    __syncthreads();
    if (kt + 2 < KT) GM_STORE(0, a0, a1, b0, b1)
    if (kt + 4 < KT) GM_LOAD(kt + 4, a0, a1, b0, b1)
    SCHED_FENCE();
    GM_COMPUTE(1)
    __syncthreads();
  }
}

template <class AAddr, class BAddr>
DI void gemm_full(f32x16 (&acc)[2][2], int KT, AAddr aaddr, BAddr baddr, GemmSmem* sm) {
  GSTAGE_DECL;
  gemm_prefetch(GSTAGE_ARGS, aaddr, baddr);
  gemm_main(acc, KT, aaddr, baddr, sm, GSTAGE_ARGS);
}

DI float transpose_reduce16(float (&v)[16], int lane) {
  float r8[8], r4[4], r2[2];
  {
    bool up = lane & 8;
#pragma unroll
    for (int i = 0; i < 8; ++i) {
      float send = up ? v[i] : v[i + 8];
      float keep = up ? v[i + 8] : v[i];
      r8[i] = keep + __shfl_xor(send, 8);
    }
  }
  {
    bool up = lane & 4;
#pragma unroll
    for (int i = 0; i < 4; ++i) {
      float send = up ? r8[i] : r8[i + 4];
      float keep = up ? r8[i + 4] : r8[i];
      r4[i] = keep + __shfl_xor(send, 4);
    }
  }
  {
    bool up = lane & 2;
#pragma unroll
    for (int i = 0; i < 2; ++i) {
      float send = up ? r4[i] : r4[i + 2];
      float keep = up ? r4[i + 2] : r4[i];
      r2[i] = keep + __shfl_xor(send, 2);
    }
  }
  bool up = lane & 1;
  float send = up ? r2[0] : r2[1];
  float keep = up ? r2[1] : r2[0];
  return keep + __shfl_xor(send, 1);
}

DI void stage_half(const f32x16 (&acc)[2][2], int mi, float* wl, float4 (&v)[8], int lane) {
  const int r = lane & 31, h = lane >> 5;
#pragma unroll
  for (int ni = 0; ni < 2; ++ni)
#pragma unroll
    for (int i = 0; i < 16; ++i) wl[crow(i, h) * 64 + ni * 32 + r] = acc[mi][ni][i];
  asm volatile("s_waitcnt lgkmcnt(0)" ::: "memory");
#pragma unroll
  for (int c = 0; c < 8; ++c) v[c] = *(const float4*)(wl + (c * 4 + (lane >> 4)) * 64 + (lane & 15) * 4);
  asm volatile("s_waitcnt lgkmcnt(0)" ::: "memory");
}
DI void stage_half8(const f32x16 (&acc)[2][2], int mi, float* wl, float4 (&lo)[4], float4 (&hi)[4], int lane) {
  const int r = lane & 31, h = lane >> 5;
#pragma unroll
  for (int ni = 0; ni < 2; ++ni)
#pragma unroll
    for (int i = 0; i < 16; ++i) wl[crow(i, h) * 64 + ni * 32 + r] = acc[mi][ni][i];
  asm volatile("s_waitcnt lgkmcnt(0)" ::: "memory");
#pragma unroll
  for (int c = 0; c < 4; ++c) {
    const float* pch = wl + (c * 8 + (lane >> 3)) * 64 + (lane & 7) * 8;
    lo[c] = *(const float4*)pch;
    hi[c] = *(const float4*)(pch + 4);
  }
  asm volatile("s_waitcnt lgkmcnt(0)" ::: "memory");
}
DI float4 bf4_to_f4(uint2 u) {
  return make_float4(__uint_as_float(u.x << 16), __uint_as_float(u.x & 0xffff0000u), __uint_as_float(u.y << 16),
                     __uint_as_float(u.y & 0xffff0000u));
}
DI uint2 f4_to_bf4(float4 f) { return make_uint2(pk2(f.x, f.y), pk2(f.z, f.w)); }

#define WAVE_IDS                                              \
  const int tid = opaque_tid(), lane = tid & 63, wave = tid >> 6; \
  const int wm = wave >> 1, wn = wave & 1, r = lane & 31, h = lane >> 5; \
  (void)wm; (void)wn; (void)r; (void)h;

template <int LAYER>
DI void phase_hconv(const Params& p) {
  const int tid = opaque_tid(), lane = tid & 63;
  bfr* H = (bfr*)(p.ws + (LAYER == 0 ? O_H0 : O_H1));
  const float4* ng4 = (const float4*)(p.in[I_NORMG] + LAYER * 1024);
  for (int tok = (blockIdx.x * 4 + (tid >> 6)) * 2; tok < TOK; tok += gridDim.x * 8) {
    const float4* xr0 = (const float4*)(LAYER == 0 ? xrow0(p, tok) : (const float*)xrow1(p, tok));
    const float4* xr1 = xr0 + 256;
    const float4* md4 = (const float4*)modrow(p, LAYER, tok);
    float4 x0[4], x1[4], gm[4], sh[4];
#pragma unroll
    for (int i = 0; i < 4; ++i) {
      x0[i] = xr0[lane + 64 * i];
      x1[i] = xr1[lane + 64 * i];
      float4 gv = ng4[lane + 64 * i];
      float4 sc = md4[256 + lane + 64 * i];
      sh[i] = md4[lane + 64 * i];
      gm[i] = make_float4(gv.x * (1.f + sc.x), gv.y * (1.f + sc.y), gv.z * (1.f + sc.z), gv.w * (1.f + sc.w));
    }
    float s0 = 0.f, s1 = 0.f;
#pragma unroll
    for (int i = 0; i < 4; ++i) {
      s0 += x0[i].x * x0[i].x + x0[i].y * x0[i].y + x0[i].z * x0[i].z + x0[i].w * x0[i].w;
      s1 += x1[i].x * x1[i].x + x1[i].y * x1[i].y + x1[i].z * x1[i].z + x1[i].w * x1[i].w;
    }
    s0 = wave_sum(s0);
    s1 = wave_sum(s1);
    const float r0 = rsqrtf(s0 * (1.f / 1024.f) + EPS), r1 = rsqrtf(s1 * (1.f / 1024.f) + EPS);
#pragma unroll
    for (int i = 0; i < 4; ++i) {
      uint2 o0, o1;
      o0.x = pk2(x0[i].x * r0 * gm[i].x + sh[i].x, x0[i].y * r0 * gm[i].y + sh[i].y);
      o0.y = pk2(x0[i].z * r0 * gm[i].z + sh[i].z, x0[i].w * r0 * gm[i].w + sh[i].w);
      o1.x = pk2(x1[i].x * r1 * gm[i].x + sh[i].x, x1[i].y * r1 * gm[i].y + sh[i].y);
      o1.y = pk2(x1[i].z * r1 * gm[i].z + sh[i].z, x1[i].w * r1 * gm[i].w + sh[i].w);
      *(uint2*)(H + (size_t)tok * 1024 + (lane + 64 * i) * 4) = o0;
      *(uint2*)(H + (size_t)(tok + 1) * 1024 + (lane + 64 * i) * 4) = o1;
    }
  }
}

DI void phase_o1(const Params& p, char* smem) {
  GemmSmem* sm = (GemmSmem*)smem;
  WAVE_IDS
  const int NT = 12, units = (TOK / 128) * NT;
  const bfr* WT = (const bfr*)(p.ws + O_WT_IN0);
  bfr* PC = (bfr*)(p.ws + O_PC);
  bfr* SZ0 = (bfr*)(p.ws + O_SZ0);
  bfr* KRb = (bfr*)(p.ws + O_KR);
  const bfr* Ah = (const bfr*)(p.ws + O_H0);
  auto Aof = [&](int m0) { return [=](int row, int k) { return Ah + (size_t)(m0 + row) * 1024 + k; }; };
  auto Bof = [&](int n0) {
    return [=](int row, int k) {
      int n = n0 + row;
      n = n < NIN0 ? n : NIN0 - 1;
      return WT + (size_t)n * 1024 + k;
    };
  };
  GSTAGE_DECL;
  if ((int)blockIdx.x < units) {
    const int us = xcd_swz(blockIdx.x, NT);
    gemm_prefetch(GSTAGE_ARGS, Aof((us / NT) * 128), Bof((us % NT) * 128));
  }
  for (int u = blockIdx.x; u < units; u += gridDim.x) {
    const int us = xcd_swz(u, NT);
    int mt = us / NT, nt = us - mt * NT;
    int m0 = mt * 128, n0 = nt * 128;
    f32x16 acc[2][2];
    zero_acc(acc);
    gemm_main(acc, 32, Aof(m0), Bof(n0), sm, GSTAGE_ARGS);
    if (u + (int)gridDim.x < units) {
      const int us1 = xcd_swz(u + gridDim.x, NT);
      gemm_prefetch(GSTAGE_ARGS, Aof((us1 / NT) * 128), Bof((us1 % NT) * 128));
    }
    int b = m0 / LALL, pos0 = m0 - b * LALL;
    bool lat = pos0 >= LC;
    (void)b;
    if (lat && n0 + wn * 64 == 384) {
#pragma unroll
      for (int mi = 0; mi < 2; ++mi)
#pragma unroll
        for (int i = 0; i < 16; ++i) {
          int pos = pos0 + wm * 64 + mi * 32 + crow(i, h);
          float v = acc[mi][0][i];
          float vp = __shfl_xor(v, 8);
          acc[mi][0][i] = rope_apply(r, v, vp, pos - LC);
        }
    }
    {
      float* wl = (float*)sm + wave * 2048;
      const int col = n0 + wn * 64 + (lane & 7) * 8;
#pragma unroll
      for (int mi = 0; mi < 2; ++mi) {
        float4 lo[4], hi[4];
        stage_half8(acc, mi, wl, lo, hi, lane);
#pragma unroll
        for (int c = 0; c < 4; ++c) {
          int tok = m0 + wm * 64 + mi * 32 + c * 8 + (lane >> 3);
          if (col < 416) {
            uint4 o;
            o.x = pk2(lo[c].x, lo[c].y);
            o.y = pk2(lo[c].z, lo[c].w);
            o.z = pk2(hi[c].x, hi[c].y);
            o.w = pk2(hi[c].z, hi[c].w);
            bfr* dst = col < 384 ? PC + (size_t)tok * 384 + col : KRb + (size_t)tok * 32 + (col - 384);
            *(uint4*)dst = o;
          } else if (col < NIN0) {
            uint4 o;
            o.x = pk2(silu_f(lo[c].x), silu_f(lo[c].y));
            o.y = pk2(silu_f(lo[c].z), silu_f(lo[c].w));
            o.z = pk2(silu_f(hi[c].x), silu_f(hi[c].y));
            o.w = pk2(silu_f(hi[c].z), silu_f(hi[c].w));
            *(uint4*)(SZ0 + (size_t)tok * 1024 + (col - 416)) = o;
          }
        }
      }
      __syncthreads();
    }
  }
}

DI void phase_o2(const Params& p, char* smem) {
  GemmSmem* sm = (GemmSmem*)smem;
  WAVE_IDS
  const int UQ = (TOK / 128) * 12, UKV = (TOK / 128) * 16;
  const bfr* PC = (const bfr*)(p.ws + O_PC);
  bfr* Q = (bfr*)p.out;
  bfr* Kb = (bfr*)(p.ws + O_K);
  bfr* VT = (bfr*)(p.ws + O_VT);
  const int total = UQ + UKV;
  const int per_blk = (total + gridDim.x - 1) / gridDim.x;
  const int u_beg = blockIdx.x * per_blk;
  const int u_end = u_beg + per_blk < total ? u_beg + per_blk : total;
  int prev_key = -1;
  for (int us = u_beg; us < u_end; ++us) {
    int mt = us / 28, rem = us - mt * 28;
    bool isq = rem < 12;
    int nt = isq ? rem : rem - 12;
    int m0 = mt * 128, n0 = nt * 128;
    int Kd = isq ? 256 : 128;
    int aoff = isq ? 0 : 256;
    const bfr* WT = (const bfr*)(p.ws + (isq ? O_WT_UQ : O_WT_UKV));
    const int key = mt * 2 + (isq ? 0 : 1);
    if (key != prev_key) {
      prev_key = key;
      __syncthreads();
      int row = tid >> 1, half = tid & 1;
      const bfr* ap = PC + (size_t)(m0 + row) * 384 + aoff + half * (Kd / 2);
      float ss = 0.f;
      for (int j = 0; j < Kd / 16; ++j) {
        uint4 v = *(const uint4*)(ap + j * 8);
        unsigned w[4] = {v.x, v.y, v.z, v.w};
#pragma unroll
        for (int e = 0; e < 4; ++e) {
          float lo = __uint_as_float(w[e] << 16), hi = __uint_as_float(w[e] & 0xffff0000u);
          ss += lo * lo + hi * hi;
        }
      }
      ss += __shfl_xor(ss, 1);
      if (half == 0) sm->rs[row] = rsqrtf(ss / (float)Kd + EPS);
      __syncthreads();
    }
    f32x16 acc[2][2];
    zero_acc(acc);
    gemm_full(
        acc, Kd / 32, [&](int row, int k) { return PC + (size_t)(m0 + row) * 384 + aoff + k; },
        [&](int row, int k) { return WT + (size_t)(n0 + row) * Kd + k; }, sm);
    int b = m0 / LALL, pos0 = m0 - b * LALL;
    bool lat = pos0 >= LC;
    float* wl = (float*)sm + wave * 2048;
    if (isq || wn == 0) {
      if (isq && lat) {
#pragma unroll
        for (int ni = 0; ni < 2; ++ni) {
          int col0 = n0 + wn * 64 + ni * 32;
          if (col0 % 96 == 64) {
#pragma unroll
            for (int mi = 0; mi < 2; ++mi)
#pragma unroll
              for (int i = 0; i < 16; ++i) {
                int pos = pos0 + wm * 64 + mi * 32 + crow(i, h);
                float v = acc[mi][ni][i];
                float vp = __shfl_xor(v, 8);
                acc[mi][ni][i] = rope_apply(r, v, vp, pos - LC);
              }
          }
        }
      }
      const int c0 = wn * 64 + (lane & 7) * 8;
      bfr* dst;
      int rstride;
      float oscale;
      if (isq) {
        int col = n0 + c0;
        int hh = col / 96, d = col - hh * 96;
        dst = Q + ((size_t)(b * NH + hh) * LALL) * DQK + d;
        rstride = DQK;
        oscale = QSCALE;
      } else {
        int hh = n0 >> 7;
        dst = Kb + ((size_t)(b * NH + hh) * LALL) * 64 + c0;
        rstride = 64;
        oscale = 1.f;
      }
#pragma unroll
      for (int mi = 0; mi < 2; ++mi) {
        float4 lo[4], hi[4];
        stage_half8(acc, mi, wl, lo, hi, lane);
#pragma unroll
        for (int c = 0; c < 4; ++c) {
          int row = wm * 64 + mi * 32 + c * 8 + (lane >> 3);
          float sc = sm->rs[row] * oscale;
          uint4 o;
          o.x = pk2(lo[c].x * sc, lo[c].y * sc);
          o.y = pk2(lo[c].z * sc, lo[c].w * sc);
          o.z = pk2(hi[c].x * sc, hi[c].y * sc);
          o.w = pk2(hi[c].z * sc, hi[c].w * sc);
          *(uint4*)(dst + (size_t)(pos0 + row) * rstride) = o;
        }
      }
    } else {
      int hh = n0 >> 7;
#pragma unroll
      for (int mi = 0; mi < 2; ++mi)
#pragma unroll
        for (int ni = 0; ni < 2; ++ni) {
          int dvv = ni * 32 + r;
#pragma unroll
          for (int g4 = 0; g4 < 4; ++g4) {
            int row = wm * 64 + mi * 32 + 8 * g4 + 4 * h;
            int pos = pos0 + row;
            uint2 o;
            o.x = pk2(acc[mi][ni][4 * g4 + 0] * sm->rs[row + 0], acc[mi][ni][4 * g4 + 1] * sm->rs[row + 1]);
            o.y = pk2(acc[mi][ni][4 * g4 + 2] * sm->rs[row + 2], acc[mi][ni][4 * g4 + 3] * sm->rs[row + 3]);
            *(uint2*)(VT + (((size_t)(b * NH + hh)) * DV + dvv) * LALL + pos) = o;
          }
        }
    }
    __syncthreads();
  }
}

constexpr int KLD = 104;
constexpr int VLD = 68;
struct AttnSmem {
  bfr K[64 * KLD];
  bfr V[64 * VLD];
};
static_assert(sizeof(AttnSmem) <= SMEM_BYTES, "smem");

DI void attn_item(const Params& p, AttnSmem* sm, int bh, int qpos0, int nkeys) {
  WAVE_IDS
  const bfr* Q = (const bfr*)p.out;
  const bfr* Kg = (const bfr*)(p.ws + O_K) + (size_t)bh * LALL * 64;
  const bfr* KRg = (const bfr*)(p.ws + O_KR) + (size_t)(bh / NH) * LALL * 32;
  const bfr* Vg = (const bfr*)(p.ws + O_VT) + (size_t)bh * DV * LALL;
  const int qpos = qpos0 + wave * 32 + r;
  bf16x8 bq[6];
  {
    const bfr* qp = Q + ((size_t)bh * LALL + qpos) * DQK + 8 * h;
#pragma unroll
    for (int s = 0; s < 6; ++s) bq[s] = *(const bf16x8*)(qp + 16 * s);
  }
  f32x16 o[2];
#pragma unroll
  for (int d = 0; d < 2; ++d)
#pragma unroll
    for (int i = 0; i < 16; ++i) o[d][i] = 0.f;
  float mrun = 0.f, lrun = 0.f;
  uint4 kv0, kv1, kv2, vv0, vv1;
  const int kr0 = tid / 12, kc0 = (tid - kr0 * 12) * 8;
  const int kr1 = (tid + 256) / 12, kc1 = (tid + 256 - kr1 * 12) * 8;
  const int kr2 = (tid + 512) / 12, kc2 = (tid + 512 - kr2 * 12) * 8;
  const int vr0 = tid >> 3, vc0 = (tid & 7) * 8;
  const bfr* kp0 = kc0 < 64 ? Kg + (size_t)kr0 * 64 + kc0 : KRg + (size_t)kr0 * 32 + (kc0 - 64);
  const bfr* kp1 = kc1 < 64 ? Kg + (size_t)kr1 * 64 + kc1 : KRg + (size_t)kr1 * 32 + (kc1 - 64);
  const bfr* kp2 = kc2 < 64 ? Kg + (size_t)kr2 * 64 + kc2 : KRg + (size_t)kr2 * 32 + (kc2 - 64);
  const int ks0 = kc0 < 64 ? 64 : 32, ks1 = kc1 < 64 ? 64 : 32, ks2 = kc2 < 64 ? 64 : 32;
#define AT_GLOAD(KEY0_)                                                          \
  {                                                                              \
    const int key0_ = (KEY0_);                                                   \
    kv0 = *(const uint4*)(kp0 + (size_t)key0_ * ks0);                            \
    kv1 = *(const uint4*)(kp1 + (size_t)key0_ * ks1);                            \
    kv2 = *(const uint4*)(kp2 + (size_t)key0_ * ks2);                            \
    vv0 = *(const uint4*)(Vg + (size_t)vr0 * LALL + key0_ + vc0);                \
    vv1 = *(const uint4*)(Vg + (size_t)(vr0 + 32) * LALL + key0_ + vc0);         \
  }
#define AT_LSTORE()                                                              \
  {                                                                              \
    *(uint4*)(sm->K + kr0 * KLD + kc0) = kv0;                                    \
    *(uint4*)(sm->K + kr1 * KLD + kc1) = kv1;                                    \
    *(uint4*)(sm->K + kr2 * KLD + kc2) = kv2;                                    \
    uint2* d0_ = (uint2*)(sm->V + vr0 * VLD + vc0);                              \
    d0_[0] = make_uint2(vv0.x, vv0.y);                                           \
    d0_[1] = make_uint2(vv0.z, vv0.w);                                           \
    uint2* d1_ = (uint2*)(sm->V + (vr0 + 32) * VLD + vc0);                       \
    d1_[0] = make_uint2(vv1.x, vv1.y);                                           \
    d1_[1] = make_uint2(vv1.z, vv1.w);                                           \
  }
  const int NTI = nkeys / 64;
  AT_GLOAD(0)
  for (int it = 0; it < NTI; ++it) {
    AT_LSTORE()
    __syncthreads();
    if (it + 1 < NTI) AT_GLOAD((it + 1) * 64)
    SCHED_FENCE();
    f32x16 st[2];
    const float ninit = -mrun;
#pragma unroll
    for (int kb = 0; kb < 2; ++kb)
#pragma unroll
      for (int i = 0; i < 16; ++i) st[kb][i] = ninit;
#pragma unroll
    for (int s = 0; s < 6; ++s) {
#pragma unroll
      for (int kb = 0; kb < 2; ++kb) {
        bf16x8 ka = *(const bf16x8*)(sm->K + (kb * 32 + r) * KLD + 16 * s + 8 * h);
        st[kb] = MFMA32(ka, bq[s], st[kb]);
      }
    }
    float mx = fmaxf(fmaxf(st[0][0], st[0][1]), st[1][0]);
#pragma unroll
    for (int i = 2; i < 16; i += 2) mx = fmaxf(fmaxf(mx, st[0][i]), st[0][i + 1]);
#pragma unroll
    for (int i = 1; i < 15; i += 2) mx = fmaxf(fmaxf(mx, st[1][i]), st[1][i + 1]);
    mx = fmaxf(mx, st[1][15]);
    mx = fmaxf(mx, __shfl_xor(mx, 32));
    const bool need = (it == 0) || (mx > 8.f);
    if (__any(need)) {
      const float delta = need ? mx : 0.f;
      const float alpha = __builtin_amdgcn_exp2f(-delta);
      mrun += delta;
      lrun *= alpha;
#pragma unroll
      for (int d = 0; d < 2; ++d)
#pragma unroll
        for (int i = 0; i < 16; ++i) o[d][i] *= alpha;
#pragma unroll
      for (int kb = 0; kb < 2; ++kb)
#pragma unroll
        for (int i = 0; i < 16; ++i) st[kb][i] -= delta;
    }
    float ps = 0.f;
#pragma unroll
    for (int kb = 0; kb < 2; ++kb)
#pragma unroll
      for (int i = 0; i < 16; ++i) {
        float e = __builtin_amdgcn_exp2f(st[kb][i]);
        st[kb][i] = e;
        ps += e;
      }
    lrun += ps;
#pragma unroll
    for (int kb = 0; kb < 2; ++kb)
#pragma unroll
      for (int s2 = 0; s2 < 2; ++s2) {
        unsigned pw[4];
#pragma unroll
        for (int j = 0; j < 4; ++j) pw[j] = pk2(st[kb][8 * s2 + 2 * j], st[kb][8 * s2 + 2 * j + 1]);
        bf16x8 pb;
        {
          uint4 t = make_uint4(pw[0], pw[1], pw[2], pw[3]);
          pb = __builtin_bit_cast(bf16x8, t);
        }
#pragma unroll
        for (int d = 0; d < 2; ++d) {
          const bfr* vp = sm->V + (d * 32 + r) * VLD + kb * 32 + 16 * s2 + 4 * h;
          uint2 lo = *(const uint2*)vp;
          uint2 hi = *(const uint2*)(vp + 8);
          uint4 t = make_uint4(lo.x, lo.y, hi.x, hi.y);
          bf16x8 va = __builtin_bit_cast(bf16x8, t);
          o[d] = MFMA32(va, pb, o[d]);
        }
      }
    __syncthreads();
  }
  float ltot = lrun + __shfl_xor(lrun, 32);
  float inv = 1.f / ltot;
  int b = bh / NH, hh = bh - b * NH;
  size_t tok = (size_t)b * LALL + qpos;
  const bfr* SZ = (const bfr*)(p.ws + O_SZ0) + tok * 1024 + hh * 64;
  bfr* OG = (bfr*)(p.ws + O_OG) + tok * 1024 + hh * 64;
#pragma unroll
  for (int d = 0; d < 2; ++d)
#pragma unroll
    for (int g4 = 0; g4 < 4; ++g4) {
      int dv0 = d * 32 + 8 * g4 + 4 * h;
      uint2 z = *(const uint2*)(SZ + dv0);
      float z0 = __uint_as_float(z.x << 16), z1 = __uint_as_float(z.x & 0xffff0000u);
      float z2 = __uint_as_float(z.y << 16), z3 = __uint_as_float(z.y & 0xffff0000u);
      uint2 ov;
      ov.x = pk2(o[d][4 * g4 + 0] * inv * z0, o[d][4 * g4 + 1] * inv * z1);
      ov.y = pk2(o[d][4 * g4 + 2] * inv * z2, o[d][4 * g4 + 3] * inv * z3);
      *(uint2*)(OG + dv0) = ov;
    }
}

DI void phase_o3(const Params& p, char* smem) {
  AttnSmem* sm = (AttnSmem*)smem;
  const int xcd = blockIdx.x & 7, local = blockIdx.x >> 3, nloc = gridDim.x >> 3;
  for (int j = local; j < 256; j += nloc) {
    int u = xcd * 256 + j;
    attn_item(p, sm, u >> 4, LC + (u & 15) * 128, LALL);
  }
  for (int j = local; j < 32; j += nloc) {
    int u = xcd * 32 + j;
    attn_item(p, sm, u >> 1, (u & 1) * 128, LC);
  }
}

template <int LAYER>
DI void phase_oproj(const Params& p, char* smem) {
  GemmSmem* sm = (GemmSmem*)smem;
  WAVE_IDS
  constexpr int NROWS = LAYER == 0 ? TOK : NLAT;
  const int NT = 8, units = (NROWS / 128) * NT;
  const bfr* Ab = (const bfr*)(p.ws + (LAYER == 0 ? O_OG : O_Y2));
  const bfr* WT = (const bfr*)(p.ws + (LAYER == 0 ? O_WT_OUT0 : O_WT_OUT1));
  float* part = (float*)(p.ws + (LAYER == 0 ? O_PART1 : O_PART2));
  auto Aof = [&](int m0) { return [=](int row, int k) { return Ab + (size_t)(m0 + row) * 1024 + k; }; };
  auto Bof = [&](int n0) { return [=](int row, int k) { return WT + (size_t)(n0 + row) * 1024 + k; }; };
  GSTAGE_DECL;
  if ((int)blockIdx.x < units) {
    const int us = xcd_swz(blockIdx.x, NT);
    gemm_prefetch(GSTAGE_ARGS, Aof((us / NT) * 128), Bof((us % NT) * 128));
  }
  for (int u = blockIdx.x; u < units; u += gridDim.x) {
    const int us = xcd_swz(u, NT);
    int mt = us / NT, nt = us - mt * NT;
    int m0 = mt * 128, n0 = nt * 128;
    f32x16 acc[2][2];
    zero_acc(acc);
    gemm_main(acc, 32, Aof(m0), Bof(n0), sm, GSTAGE_ARGS);
    if (u + (int)gridDim.x < units) {
      const int us1 = xcd_swz(u + gridDim.x, NT);
      gemm_prefetch(GSTAGE_ARGS, Aof((us1 / NT) * 128), Bof((us1 % NT) * 128));
    }
    const float* xin;
    float* xout;
    const float* gt;
    if (LAYER == 0) {
      xin = xrow0(p, m0);
      xout = xrow1(p, m0);
      gt = modrow(p, 0, m0) + 2048;
    } else {
      xin = p.out + (size_t)m0 * 1024;
      xout = p.out + (size_t)m0 * 1024;
      gt = (const float*)(p.ws + O_MOD) + ((size_t)(9 + (m0 >> 11))) * 3072 + 2048;
    }
    {
      float* wl = (float*)sm + wave * 2048;
      const int ccol = n0 + wn * 64 + (lane & 15) * 4;
      const float4 g4 = *(const float4*)(gt + ccol);
#pragma unroll
      for (int mi = 0; mi < 2; ++mi) {
        float4 v[8], xv[8];
#pragma unroll
        for (int c = 0; c < 8; ++c)
          xv[c] = *(const float4*)(xin + (size_t)(wm * 64 + mi * 32 + c * 4 + (lane >> 4)) * 1024 + ccol);
        stage_half(acc, mi, wl, v, lane);
#pragma unroll
        for (int c = 0; c < 8; ++c) {
          int row = wm * 64 + mi * 32 + c * 4 + (lane >> 4);
          float4 o;
          o.x = xv[c].x + g4.x * v[c].x;
          o.y = xv[c].y + g4.y * v[c].y;
          o.z = xv[c].z + g4.z * v[c].z;
          o.w = xv[c].w + g4.w * v[c].w;
          *(float4*)(xout + (size_t)row * 1024 + ccol) = o;
          if (LAYER == 1) {
            float sq = o.x * o.x + o.y * o.y + o.z * o.z + o.w * o.w;
            sq += __shfl_xor(sq, 1);
            sq += __shfl_xor(sq, 2);
            sq += __shfl_xor(sq, 4);
            sq += __shfl_xor(sq, 8);
            if ((lane & 15) == 0) part[(size_t)(nt * 2 + wn) * NROWS + m0 + row] = sq;
          }
        }
      }
      __syncthreads();
    }
  }
  if (LAYER == 0) {
    __syncthreads();
    phase_prep_b(p, smem, units % (int)gridDim.x);
  }
}

DI void phase_o5(const Params& p, char* smem) {
  GemmSmem* sm = (GemmSmem*)smem;
  WAVE_IDS
  const int ULAT = (NLAT / 128) * 16, units = ULAT + (NB * LC / 128) * 8;
  const bfr* WT = (const bfr*)(p.ws + O_WT_IN1);
  bfr* U2 = (bfr*)(p.ws + O_U2);
  bfr* SZ1 = (bfr*)(p.ws + O_SZ1);
  const bfr* Ah = (const bfr*)(p.ws + O_H1);
  auto coords = [&](int u, int& m0, int& n0) {
    if (u < ULAT) {
      const int us = xcd_swz(u, 16);
      int mtl = us >> 4;
      m0 = (mtl >> 4) * LALL + LC + (mtl & 15) * 128;
      n0 = (us & 15) * 128;
    } else {
      const int us = xcd_swz(u - ULAT, 8);
      int mtc = us >> 3;
      m0 = (mtc >> 1) * LALL + (mtc & 1) * 128;
      n0 = (us & 7) * 128;
    }
  };
  auto Aof = [&](int m0) { return [=](int row, int k) { return Ah + (size_t)(m0 + row) * 1024 + k; }; };
  auto Bof = [&](int n0) { return [=](int row, int k) { return WT + (size_t)(n0 + row) * 1024 + k; }; };
  GSTAGE_DECL;
  if ((int)blockIdx.x < units) {
    int m1, n1;
    coords(blockIdx.x, m1, n1);
    gemm_prefetch(GSTAGE_ARGS, Aof(m1), Bof(n1));
  }
  for (int u = blockIdx.x; u < units; u += gridDim.x) {
    int m0, n0;
    coords(u, m0, n0);
    int b = m0 / LALL, pos0 = m0 - b * LALL;
    f32x16 acc[2][2];
    zero_acc(acc);
    gemm_main(acc, 32, Aof(m0), Bof(n0), sm, GSTAGE_ARGS);
    if (u + (int)gridDim.x < units) {
      int m1, n1;
      coords(u + gridDim.x, m1, n1);
      gemm_prefetch(GSTAGE_ARGS, Aof(m1), Bof(n1));
    }
    {
      float* wl = (float*)sm + wave * 2048;
      const int col = n0 + wn * 64 + (lane & 7) * 8;
      const bool isu = col < 1024;
#pragma unroll
      for (int mi = 0; mi < 2; ++mi) {
        float4 lo[4], hi[4];
        stage_half8(acc, mi, wl, lo, hi, lane);
#pragma unroll
        for (int c = 0; c < 4; ++c) {
          int row = wm * 64 + mi * 32 + c * 8 + (lane >> 3);
          int tok = m0 + row;
          uint4 o;
          bfr* dst;
          if (isu) {
            o.x = pk2(lo[c].x, lo[c].y);
            o.y = pk2(lo[c].z, lo[c].w);
            o.z = pk2(hi[c].x, hi[c].y);
            o.w = pk2(hi[c].z, hi[c].w);
            dst = U2 + ((size_t)(col >> 4) * TOK + tok) * 16 + (col & 15);
          } else {
            o.x = pk2(silu_f(lo[c].x), silu_f(lo[c].y));
            o.y = pk2(silu_f(lo[c].z), silu_f(lo[c].w));
            o.z = pk2(silu_f(hi[c].x), silu_f(hi[c].y));
            o.w = pk2(silu_f(hi[c].z), silu_f(hi[c].w));
            dst = SZ1 + ((size_t)(b * SEQ + pos0 + row - LC)) * 1024 + (col - 1024);
          }
          *(uint4*)dst = o;
        }
      }
      __syncthreads();
    }
  }
}

DI void phase_o6(const Params& p, char* smem) {
  GemmSmem* sm = (GemmSmem*)smem;
  WAVE_IDS
  const int NROW = NB * NCH;
  const int units = 64 * 5 * 2;
  const bfr* U2 = (const bfr*)(p.ws + O_U2);
  const bfr* WST = (const bfr*)(p.ws + O_WST);
  float* SLOC = (float*)(p.ws + O_SLOC);
  for (int u = blockIdx.x; u < units; u += gridDim.x) {
    const int us = xcd_swz(u, 10);
    int g = us / 10, rem = us - g * 10;
    int mt = rem >> 1, nt = rem & 1;
    int m0 = mt * 128, n0 = nt * 128;
    const bfr* Ag = U2 + (size_t)g * TOK * 16;
    const bfr* Bg = WST + (size_t)g * 256 * 512;
    f32x16 acc[2][2];
    zero_acc(acc);
    gemm_full(
        acc, 16,
        [&](int row, int k) {
          int rr = m0 + row;
          rr = rr < NROW ? rr : NROW - 1;
          return Ag + (size_t)rr * 512 + k;
        },
        [&](int row, int k) { return Bg + (size_t)(n0 + row) * 512 + k; }, sm);
#pragma unroll
    for (int mi = 0; mi < 2; ++mi)
#pragma unroll
      for (int ni = 0; ni < 2; ++ni) {
        int col = n0 + wn * 64 + ni * 32 + r;
#pragma unroll
        for (int i = 0; i < 16; ++i) {
          int row = m0 + wm * 64 + mi * 32 + crow(i, h);
          SLOC[((size_t)g * SLOC_ROWS + row) * 256 + col] = acc[mi][ni][i];
        }
      }
  }
}

DI void phase_o7(const Params& p) {
  const int tidx_ = opaque_tid();
  const float* SLOC = (const float*)(p.ws + O_SLOC);
  bfr* SIN = (bfr*)(p.ws + O_SIN);
  const int total = NB * 64 * 2 * 64;
  for (int idx = blockIdx.x * 256 + tidx_; idx < total; idx += gridDim.x * 256) {
    int pp = idx & 63, dir = (idx >> 6) & 1, g = (idx >> 7) & 63, b = idx >> 13;
    double dt, ar, ai;
    float fr, fi, lr, li;
    s5_disc(p, dir, g, pp, dt, ar, ai, fr, fi);
    s5_pow(dt, ar, ai, TC, lr, li);
    float sr = 0.f, si = 0.f;
    auto cpos = [&](int step) { return dir == 0 ? step : (step < 8 ? 7 - step : NCH - 1 - (step - 8)); };
    const float* slb = SLOC + ((size_t)g * SLOC_ROWS + b * NCH) * 256 + dir * 128 + pp;
    bfr* sob = SIN + ((size_t)g * (NB * NCHL) + b * NCHL) * 256 + dir * 128 + pp;
#pragma unroll 1
    for (int s0 = 0; s0 < NCH; s0 += 24) {
      float lre[24], lim[24];
#pragma unroll
      for (int j = 0; j < 24; ++j) {
        const float* sl = slb + (size_t)cpos(s0 + j) * 256;
        lre[j] = sl[0];
        lim[j] = sl[64];
      }
#pragma unroll
      for (int j = 0; j < 24; ++j) {
        int cp = cpos(s0 + j);
        if (cp >= 8) {
          bfr* so = sob + (size_t)(cp - 8) * 256;
          so[0] = f2bf(sr);
          so[64] = f2bf(si);
        }
        float nr = lr * sr - li * si + lre[j];
        float ni = lr * si + li * sr + lim[j];
        sr = nr;
        si = ni;
      }
    }
  }
}

DI void phase_o8(const Params& p, char* smem) {
  GemmSmem* sm = (GemmSmem*)smem;
  WAVE_IDS
  const int units = 64 * 4 * 4;
  const bfr* U2 = (const bfr*)(p.ws + O_U2);
  const bfr* SIN = (const bfr*)(p.ws + O_SIN);
  const bfr* KTAB = (const bfr*)(p.ws + O_KTAB);
  const bfr* VOP = (const bfr*)(p.ws + O_VOP);
  bfr* YG = (bfr*)(p.ws + O_YG);
  for (int u = blockIdx.x; u < units; u += gridDim.x) {
    const int us = xcd_swz(u, 16);
    int g = us >> 4, mt = (us >> 2) & 3, nt = us & 3;
    int m0 = mt * 128, n0 = nt * 128;
    const bfr* Ug = U2 + (size_t)g * TOK * 16;
    f32x16 acc[2][2];
    zero_acc(acc);
    gemm_full(
        acc, 16,
        [&](int row, int k) {
          int rr = m0 + row;
          int b = rr >> 6, n = rr & 63;
          return Ug + ((size_t)b * LALL + LC + n * TC) * 16 + k;
        },
        [&](int row, int k) {
          int m = n0 + row;
          int t = m >> 4, c = m & 15;
          return KTAB + (((size_t)g * 63 + (t + 31)) * 16 + c) * 16 - (k >> 4) * 256 + (k & 15);
        },
        sm);
    gemm_full(
        acc, 8, [&](int row, int k) { return SIN + ((size_t)g * (NB * NCHL) + m0 + row) * 256 + k; },
        [&](int row, int k) { return VOP + ((size_t)g * 512 + n0 + row) * 256 + k; }, sm);
    {
      float* wl = (float*)sm + wave * 2048;
      const int mcol = n0 + wn * 64 + (lane & 7) * 8;
      const int t = mcol >> 4, c0 = mcol & 15;
      const int ch = g * 16 + c0;
      const float4 d0 = *(const float4*)(p.in[I_S5D] + ch), d1 = *(const float4*)(p.in[I_S5D] + ch + 4);
#pragma unroll
      for (int mi = 0; mi < 2; ++mi) {
        float4 lo[4], hi[4];
        stage_half8(acc, mi, wl, lo, hi, lane);
        uint4 uq[4];
#pragma unroll
        for (int c = 0; c < 4; ++c) {
          int rr = m0 + wm * 64 + mi * 32 + c * 8 + (lane >> 3);
          int b = rr >> 6, n = rr & 63;
          uq[c] = *(const uint4*)(Ug + ((size_t)b * LALL + LC + n * TC + t) * 16 + c0);
        }
        SCHED_FENCE();
#pragma unroll
        for (int c = 0; c < 4; ++c) {
          int rr = m0 + wm * 64 + mi * 32 + c * 8 + (lane >> 3);
          int b = rr >> 6, n = rr & 63;
          float4 u0 = bf4_to_f4(make_uint2(uq[c].x, uq[c].y)), u1 = bf4_to_f4(make_uint2(uq[c].z, uq[c].w));
          uint4 o;
          o.x = pk2(gelu_tanh(lo[c].x + d0.x * u0.x), gelu_tanh(lo[c].y + d0.y * u0.y));
          o.y = pk2(gelu_tanh(lo[c].z + d0.z * u0.z), gelu_tanh(lo[c].w + d0.w * u0.w));
          o.z = pk2(gelu_tanh(hi[c].x + d1.x * u1.x), gelu_tanh(hi[c].y + d1.y * u1.y));
          o.w = pk2(gelu_tanh(hi[c].z + d1.z * u1.z), gelu_tanh(hi[c].w + d1.w * u1.w));
          *(uint4*)(YG + ((size_t)(b * SEQ + n * TC + t)) * 1024 + ch) = o;
        }
        SCHED_FENCE();
      }
      __syncthreads();
    }
  }
}

DI void phase_o9(const Params& p, char* smem) {
  GemmSmem* sm = (GemmSmem*)smem;
  WAVE_IDS
  const int NT = 8, units = (NLAT / 128) * NT;
  const bfr* YG = (const bfr*)(p.ws + O_YG);
  const bfr* SZ1 = (const bfr*)(p.ws + O_SZ1);
  const bfr* WT = (const bfr*)(p.ws + O_WT_GLU);
  bfr* Y2 = (bfr*)(p.ws + O_Y2);
  auto Aof = [&](int m0) { return [=](int row, int k) { return YG + (size_t)(m0 + row) * 1024 + k; }; };
  auto Bof = [&](int n0) { return [=](int row, int k) { return WT + (size_t)(n0 + row) * 1024 + k; }; };
  GSTAGE_DECL;
  if ((int)blockIdx.x < units) {
    const int us = xcd_swz(blockIdx.x, NT);
    gemm_prefetch(GSTAGE_ARGS, Aof((us / NT) * 128), Bof((us % NT) * 128));
  }
  for (int u = blockIdx.x; u < units; u += gridDim.x) {
    const int us = xcd_swz(u, NT);
    int mt = us / NT, nt = us - mt * NT;
    int m0 = mt * 128, n0 = nt * 128;
    f32x16 acc[2][2];
    zero_acc(acc);
    gemm_main(acc, 32, Aof(m0), Bof(n0), sm, GSTAGE_ARGS);
    if (u + (int)gridDim.x < units) {
      const int us1 = xcd_swz(u + gridDim.x, NT);
      gemm_prefetch(GSTAGE_ARGS, Aof((us1 / NT) * 128), Bof((us1 % NT) * 128));
    }
    float* wl = (float*)sm + wave * 2048;
    const int ccol = n0 + wn * 64 + (lane & 15) * 4;
    const float4 bg = *(const float4*)(p.in[I_BGLU] + ccol);
#pragma unroll
    for (int mi = 0; mi < 2; ++mi) {
      float4 v[8];
      stage_half(acc, mi, wl, v, lane);
      uint2 yv[8], zv[8];
#pragma unroll
      for (int c = 0; c < 8; ++c) {
        size_t o = (size_t)(m0 + wm * 64 + mi * 32 + c * 4 + (lane >> 4)) * 1024 + ccol;
        yv[c] = *(const uint2*)(YG + o);
        zv[c] = *(const uint2*)(SZ1 + o);
      }
      SCHED_FENCE();
#pragma unroll
      for (int c = 0; c < 8; ++c) {
        size_t o = (size_t)(m0 + wm * 64 + mi * 32 + c * 4 + (lane >> 4)) * 1024 + ccol;
        float4 y = bf4_to_f4(yv[c]), z = bf4_to_f4(zv[c]);
        float4 ov;
        ov.x = y.x * sigmoid_f(v[c].x + bg.x) * z.x;
        ov.y = y.y * sigmoid_f(v[c].y + bg.y) * z.y;
        ov.z = y.z * sigmoid_f(v[c].z + bg.z) * z.z;
        ov.w = y.w * sigmoid_f(v[c].w + bg.w) * z.w;
        *(uint2*)(Y2 + o) = f4_to_bf4(ov);
      }
      SCHED_FENCE();
    }
    __syncthreads();
  }
}

#define XB_TMO      128
#define XB_XCNT(j)  (256  + 64 * (j))
#define XB_XSUB(j)  (1280 + 64 * (j))
#define XB_XGEN(j)  (2304 + 64 * (j))
#define XB_TOP      3328
#define XB_TOPGEN   3392
#define XCD_BAR_WORDS 3456
#define XB_SPIN_CAP (1u << 18)
#define LAS __attribute__((address_space(3)))
DI unsigned xb_ld(unsigned* p) { return __hip_atomic_load(p, __ATOMIC_RELAXED, __HIP_MEMORY_SCOPE_AGENT); }
DI unsigned xb_add(unsigned* p, unsigned v) { return __hip_atomic_fetch_add(p, v, __ATOMIC_RELAXED, __HIP_MEMORY_SCOPE_AGENT); }
DI unsigned xb_xcc_id() { return (unsigned)__builtin_amdgcn_s_getreg((3 << 11) | 20) & 0xFu; }
#define XB_SPIN(cond, bar) do { unsigned _sp = 0; while (cond) { __builtin_amdgcn_s_sleep(1); \
    if ((++_sp & 255u) == 0u) { if (xb_ld(&(bar)[XB_TMO])) break; if (_sp > XB_SPIN_CAP) { atomicAdd(&(bar)[XB_TMO], 1u); break; } } } } while (0)
struct XcdBarrier {
  unsigned* bar;
  unsigned x;
  volatile LAS unsigned* st;
};
DI XcdBarrier xcd_barrier_post(unsigned* bar, volatile LAS unsigned* st) {
  XcdBarrier b;
  b.bar = bar;
  b.x = xb_xcc_id();
  b.st = st;
  if (threadIdx.x == 0) (void)xb_add(&bar[XB_XCNT(b.x)], 1u);
  return b;
}
DI void xcd_barrier_complete(unsigned* bar, unsigned x, unsigned& nloc, unsigned& nx) {
  const unsigned G = gridDim.x * gridDim.y * gridDim.z;
  unsigned sum, cnt, mine, sp = 0u;
  for (;;) {
    sum = 0u; cnt = 0u; mine = 0u;
#pragma unroll
    for (unsigned j = 0; j < 16; ++j) {
      const unsigned c = xb_ld(&bar[XB_XCNT(j)]);
      sum += c;
      cnt += (c > 0u) ? 1u : 0u;
      mine = (j == x) ? c : mine;
    }
    if (sum == G) break;
    __builtin_amdgcn_s_sleep(1);
    if ((++sp & 255u) == 0u) {
      if (xb_ld(&bar[XB_TMO])) break;
      if (sp > XB_SPIN_CAP) { atomicAdd(&bar[XB_TMO], 1u); break; }
    }
  }
  nloc = mine > 0u ? mine : 1u;
  nx = cnt > 0u ? cnt : 1u;
}
DI void xcd_barrier(const XcdBarrier& b) {
  asm volatile("s_waitcnt vmcnt(0)" ::: "memory");
  __syncthreads();
  if (threadIdx.x == 0) {
    unsigned* bar = b.bar;
    __builtin_amdgcn_s_waitcnt(0);
    unsigned nloc = b.st[0], nx = b.st[1];
    if (nloc == 0u) {
      xcd_barrier_complete(bar, b.x, nloc, nx);
      b.st[0] = nloc;
      b.st[1] = nx;
    }
    const unsigned old = xb_add(&bar[XB_XSUB(b.x)], 1u);
    const unsigned gen = old / nloc;
    if (old + 1u == (gen + 1u) * nloc) {
      __builtin_amdgcn_fence(__ATOMIC_RELEASE, "agent");
      asm volatile("s_waitcnt vmcnt(0)" ::: "memory");
      const unsigned og = xb_add(&bar[XB_TOP], 1u);
      const unsigned tg = og / nx;
      if (og + 1u == (tg + 1u) * nx) xb_add(&bar[XB_TOPGEN], 1u);
      else XB_SPIN(xb_ld(&bar[XB_TOPGEN]) == tg, bar);
      __builtin_amdgcn_fence(__ATOMIC_ACQUIRE, "agent");
      xb_add(&bar[XB_XGEN(b.x)], 1u);
      asm volatile("s_waitcnt vmcnt(0)" ::: "memory");
    } else {
      XB_SPIN(xb_ld(&bar[XB_XGEN(b.x)]) == gen, bar);
      __builtin_amdgcn_fence(__ATOMIC_ACQUIRE, "agent");
      asm volatile("s_waitcnt vmcnt(0)" ::: "memory");
    }
  }
  __syncthreads();
}

DI void run_phase(const Params& p, int ph, char* smem) {
  switch (ph) {
#if !defined(ONLY) || ONLY == 0
    case PH_PREP: phase_prep(p, smem); break;
#endif
#if !defined(ONLY) || ONLY == 1
    case PH_FINAL: phase_final(p); break;
#endif
#if !defined(ONLY) || ONLY == 2
    case PH_O1: phase_o1(p, smem); break;
#endif
#if !defined(ONLY) || ONLY == 3
    case PH_O2: phase_o2(p, smem); break;
#endif
#if !defined(ONLY) || ONLY == 4
    case PH_O3: phase_o3(p, smem); break;
#endif
#if !defined(ONLY) || ONLY == 5
    case PH_O4: phase_oproj<0>(p, smem); break;
#endif
#if !defined(ONLY) || ONLY == 6
    case PH_O5: phase_o5(p, smem); break;
#endif
#if !defined(ONLY) || ONLY == 7
    case PH_O6: phase_o6(p, smem); break;
#endif
#if !defined(ONLY) || ONLY == 8
    case PH_O7: phase_o7(p); break;
#endif
#if !defined(ONLY) || ONLY == 9
    case PH_O8: phase_o8(p, smem); break;
#endif
#if !defined(ONLY) || ONLY == 10
    case PH_O9: phase_o9(p, smem); break;
#endif
#if !defined(ONLY) || ONLY == 11
    case PH_O10: phase_oproj<1>(p, smem); break;
#endif
    case PH_H0: phase_hconv<0>(p); break;
    case PH_H1: phase_hconv<1>(p); break;
    default: break;
  }
}

__global__ void __launch_bounds__(256, 2) mega_one(Params p, int ph) {
  __shared__ __attribute__((aligned(16))) char smem[SMEM_BYTES];
  run_phase(p, ph, smem);
}

#if !defined(ONLY) && SINGLE_LAUNCH
__global__ void __launch_bounds__(256, 2) mega(Params p) {
  __shared__ __attribute__((aligned(16))) char smem[SMEM_BYTES];
  __shared__ uint4 xb_words;
  if (threadIdx.x == 0) xb_words = make_uint4(0u, 0u, 0u, 0u);
  __syncthreads();
  if (p.nprog < 0) cg::this_grid().sync();
  const XcdBarrier xb = xcd_barrier_post((unsigned*)(p.ws + O_BAR), (volatile LAS unsigned*)&xb_words);
  cg::grid_group grid = cg::this_grid();
#if !defined(OMIT) || OMIT != 0
  phase_prep(p, smem);
#endif
  xcd_barrier(xb);
#if (DUP >> 0) & 1
  phase_prep(p, smem);
  xcd_barrier(xb);
#endif
  phase_hconv<0>(p);
  xcd_barrier(xb);
#if !defined(OMIT) || OMIT != 1
  phase_o1(p, smem);
#endif
  xcd_barrier(xb);
#if (DUP >> 1) & 1
  phase_o1(p, smem);
  xcd_barrier(xb);
#endif
#if !defined(OMIT) || OMIT != 2
  phase_o2(p, smem);
#endif
  xcd_barrier(xb);
#if (DUP >> 2) & 1
  phase_o2(p, smem);
  xcd_barrier(xb);
#endif
#if !defined(OMIT) || OMIT != 3
  phase_o3(p, smem);
#endif
  xcd_barrier(xb);
#if (DUP >> 3) & 1
  phase_o3(p, smem);
  xcd_barrier(xb);
#endif
#if !defined(OMIT) || OMIT != 4
  phase_oproj<0>(p, smem);
#endif
  xcd_barrier(xb);
#if (DUP >> 4) & 1
  phase_oproj<0>(p, smem);
  xcd_barrier(xb);
#endif
  phase_hconv<1>(p);
  xcd_barrier(xb);
#if !defined(OMIT) || OMIT != 5
  phase_o5(p, smem);
#endif
  xcd_barrier(xb);
#if (DUP >> 5) & 1
  phase_o5(p, smem);
  xcd_barrier(xb);
#endif
#if !defined(OMIT) || OMIT != 6
  phase_o6(p, smem);
#endif
  xcd_barrier(xb);
#if (DUP >> 6) & 1
  phase_o6(p, smem);
  xcd_barrier(xb);
#endif
#if !defined(OMIT) || OMIT != 7
  phase_o7(p);
#endif
  xcd_barrier(xb);
#if (DUP >> 7) & 1
  phase_o7(p);
  xcd_barrier(xb);
#endif
#if !defined(OMIT) || OMIT != 8
  phase_o8(p, smem);
#endif
  xcd_barrier(xb);
#if (DUP >> 8) & 1
  phase_o8(p, smem);
  xcd_barrier(xb);
#endif
#if !defined(OMIT) || OMIT != 9
  phase_o9(p, smem);
#endif
  xcd_barrier(xb);
#if (DUP >> 9) & 1
  phase_o9(p, smem);
  xcd_barrier(xb);
#endif
#if !defined(OMIT) || OMIT != 10
  phase_oproj<1>(p, smem);
#endif
  xcd_barrier(xb);
#if !defined(OMIT) || OMIT != 11
  phase_final(p);
#endif
}
#else
__global__ void mega(Params p) {}
#endif


extern "C" void kernel_launch(void* const* d_in, const int* in_sizes, int n_in, void* d_out, int out_size, void* d_ws,
                              size_t ws_size, hipStream_t stream) {
  static int grid_blocks = 0;
  if (!grid_blocks) {
    int dev = 0, cus = 0, per_cu = 0;
    hipGetDevice(&dev);
    hipDeviceGetAttribute(&cus, hipDeviceAttributeMultiprocessorCount, dev);
#if SINGLE_LAUNCH
    hipOccupancyMaxActiveBlocksPerMultiprocessor(&per_cu, mega, 256, 0);
#else
    hipOccupancyMaxActiveBlocksPerMultiprocessor(&per_cu, mega_one, 256, 0);
#endif
    if (per_cu < 1) per_cu = 1;
    if (per_cu > 2) per_cu = 2;
    grid_blocks = cus * per_cu;
  }
  if (ws_size < WS_NEED || n_in < N_INPUTS) {
    fprintf(stderr, "workspace too small or bad inputs: %zu < %zu\n", ws_size, (size_t)WS_NEED);
    return;
  }
  Params p{};
  for (int i = 0; i < N_INPUTS; ++i) p.in[i] = (const float*)d_in[i];
  p.out = (float*)d_out;
  p.ws = (char*)d_ws;
#ifndef PROG
#define PROG PH_PREP, PH_H0, PH_O1, PH_O2, PH_O3, PH_O4, PH_H1, PH_O5, PH_O6, PH_O7, PH_O8, PH_O9, PH_O10, PH_FINAL
#endif
  const int prog[] = {PROG};
  p.nprog = (int)(sizeof(prog) / sizeof(int));
  for (int i = 0; i < p.nprog; ++i) p.prog[i] = prog[i];
#if SINGLE_LAUNCH
  hipMemsetAsync((char*)d_ws + O_BAR, 0, BAR_BYTES, stream);
  void* args[] = {&p};
  hipError_t e = hipLaunchCooperativeKernel((void*)mega, dim3(grid_blocks), dim3(256), args, 0, stream);
  if (e != hipSuccess) fprintf(stderr, "cooperative launch failed: %s (grid %d)\n", hipGetErrorString(e), grid_blocks);
#else
  for (int i = 0; i < p.nprog; ++i) {
    mega_one<<<dim3(grid_blocks), dim3(256), 0, stream>>>(p, p.prog[i]);
  }
#endif
}
```

```cpp
#include <hip/hip_runtime.h>
#include <hip/hip_cooperative_groups.h>
#include <cstdio>
namespace cg = cooperative_groups;
#ifndef DUP
#define DUP 0
#endif
#ifndef USE_NAIVE
#define USE_NAIVE 0
#endif
#ifndef SINGLE_LAUNCH
#define SINGLE_LAUNCH 1
#endif

#define DI __device__ __forceinline__
typedef unsigned short bfr;

constexpr int D = 1024, NB = 8, SEQ = 2048, LC = 256, LALL = 2304;
constexpr int TOK = NB * LALL;
constexpr int NLAT = NB * SEQ;
constexpr int NH = 16, DQK = 96, DV = 64;
constexpr int NIN0 = 1440, NIN1 = 2048;
constexpr float EPS = 1e-6f;
constexpr float QSCALE = 0.10206207261596577f * 1.4426950408889634f;
constexpr int TC = 32;
constexpr int NCH = LALL / TC;
constexpr int NCHL = SEQ / TC;

enum { I_X = 0, I_C, I_CTX, I_CCTX, I_ADAW, I_ADAB, I_NORMG, I_WIN0, I_QNORM, I_WUQ, I_KVNORM, I_WUKV, I_WOUT0,
       I_WIN1, I_ARE, I_AIM, I_LOGSTEP, I_BRE, I_BIM, I_CRE, I_CIM, I_S5D, I_WGLU, I_BGLU, I_WOUT1, I_FINALG, N_INPUTS };

constexpr size_t al256(size_t x) { return (x + 255) & ~(size_t)255; }
constexpr size_t O_WT_IN0 = 0;
constexpr size_t O_WT_UQ = O_WT_IN0 + al256((size_t)NIN0 * 1024 * 2);
constexpr size_t O_WT_UKV = O_WT_UQ + al256((size_t)1536 * 256 * 2);
constexpr size_t O_WT_OUT0 = O_WT_UKV + al256((size_t)2048 * 128 * 2);
constexpr size_t O_WT_IN1 = O_WT_OUT0 + al256((size_t)1024 * 1024 * 2);
constexpr size_t O_WT_GLU = O_WT_IN1 + al256((size_t)2048 * 1024 * 2);
constexpr size_t O_WT_OUT1 = O_WT_GLU + al256((size_t)1024 * 1024 * 2);
constexpr size_t O_MOD = O_WT_OUT1 + al256((size_t)1024 * 1024 * 2);
constexpr size_t O_RS0 = O_MOD + al256((size_t)2 * 9 * 3072 * 4);
constexpr size_t O_PART1 = O_RS0 + al256((size_t)TOK * 4);
constexpr size_t O_PART2 = O_PART1 + al256((size_t)16 * TOK * 4);
constexpr size_t O_X1CTX = O_PART2 + al256((size_t)16 * NLAT * 4);
constexpr size_t O_KTAB = O_X1CTX + al256((size_t)NB * LC * 1024 * 4);
constexpr size_t O_WST = O_KTAB + al256((size_t)64 * 63 * 256 * 2);
constexpr size_t O_VOP = O_WST + al256((size_t)64 * 256 * 512 * 2);
constexpr size_t O_BAR = O_VOP + al256((size_t)64 * 512 * 256 * 2);
constexpr size_t BAR_BYTES = 3456 * 4;
constexpr size_t O_LAYER = O_BAR + al256(BAR_BYTES);
constexpr size_t O_PC = O_LAYER;
constexpr size_t O_SZ0 = O_PC + al256((size_t)TOK * 384 * 2);
constexpr size_t O_K = O_SZ0 + al256((size_t)TOK * 1024 * 2);
constexpr size_t O_VT = O_K + al256((size_t)NB * NH * LALL * 64 * 2);
constexpr size_t O_OG = O_VT + al256((size_t)NB * NH * DV * LALL * 2);
constexpr size_t O_KR = O_OG + al256((size_t)TOK * 1024 * 2);
constexpr size_t O_END0 = O_KR + al256((size_t)TOK * 32 * 2);
constexpr size_t O_H0 = O_OG;
constexpr size_t O_U2 = O_LAYER;
constexpr size_t O_SZ1 = O_U2 + al256((size_t)64 * TOK * 16 * 2);
constexpr size_t O_SLOC = O_SZ1 + al256((size_t)NLAT * 1024 * 2);
constexpr int SLOC_ROWS = 640;
constexpr size_t O_SIN = O_SLOC + al256((size_t)64 * SLOC_ROWS * 256 * 4);
constexpr size_t O_YG = O_SIN + al256((size_t)64 * (NB * NCHL) * 256 * 2);
constexpr size_t O_H1 = O_YG + al256((size_t)NLAT * 1024 * 2);
constexpr size_t O_END1 = O_H1 + al256((size_t)TOK * 1024 * 2);
constexpr size_t O_Y2 = O_SLOC;
constexpr size_t WS_NEED = (O_END0 > O_END1 ? O_END0 : O_END1);
static_assert(WS_NEED <= (size_t)256 * 1024 * 1024, "workspace too large");
static_assert((size_t)NB * NH * LALL * DQK * 2 <= (size_t)NLAT * 1024 * 4, "Q does not fit d_out");

struct Params {
  const float* in[N_INPUTS];
  float* out;
  char* ws;
  int prog[32];
  int nprog;
  int pad;
};

DI bfr f2bf(float x) {
  unsigned u = __float_as_uint(x);
  u += 0x7fffu + ((u >> 16) & 1u);
  return (bfr)(u >> 16);
}
typedef __bf16 bf2_t __attribute__((ext_vector_type(2)));
typedef float f2_t __attribute__((ext_vector_type(2)));
DI unsigned pk2(float a, float b) {
  f2_t v = {a, b};
  bf2_t r = __builtin_convertvector(v, bf2_t);
  return __builtin_bit_cast(unsigned, r);
}
DI int opaque_tid() {
  int t = threadIdx.x;
  asm volatile("" : "+v"(t));
  return t;
}
DI float bf2f(bfr b) { return __uint_as_float(((unsigned)b) << 16); }
DI float silu_f(float v) { return v / (1.f + __expf(-v)); }
DI float sigmoid_f(float v) { return 1.f / (1.f + __expf(-v)); }
DI float gelu_tanh(float v) {
  float u = 0.7978845608028654f * (v + 0.044715f * v * v * v);
  return 0.5f * v * (1.f + tanhf(u));
}
DI float wave_sum(float v) {
#pragma unroll
  for (int o = 32; o > 0; o >>= 1) v += __shfl_xor(v, o);
  return v;
}
DI float wave_max(float v) {
#pragma unroll
  for (int o = 32; o > 0; o >>= 1) v = fmaxf(v, __shfl_xor(v, o));
  return v;
}
DI const float* xrow0(const Params& p, int tok) {
  int b = tok / LALL, pos = tok - b * LALL;
  return pos < LC ? p.in[I_CTX] + ((size_t)(b * LC + pos)) * D : p.in[I_X] + ((size_t)(b * SEQ + pos - LC)) * D;
}
DI float* xrow1(const Params& p, int tok) {
  int b = tok / LALL, pos = tok - b * LALL;
  return pos < LC ? (float*)(p.ws + O_X1CTX) + ((size_t)(b * LC + pos)) * D : p.out + ((size_t)(b * SEQ + pos - LC)) * D;
}
DI const float* modrow(const Params& p, int layer, int tok) {
  int b = tok / LALL, pos = tok - b * LALL;
  int r = pos < LC ? 8 : b;
  return (const float*)(p.ws + O_MOD) + ((size_t)(layer * 9 + r)) * 3072;
}
DI void rope_cs(int fi, int posv, float& cs, float& sn) {
  float inv = __builtin_amdgcn_exp2f(-(float)fi * (13.287712379549449f / 8.f));
  float rev = (float)posv * inv * 0.15915494309189535f;
  rev -= floorf(rev);
  sn = __builtin_amdgcn_sinf(rev);
  cs = __builtin_amdgcn_cosf(rev);
}
DI float rope_apply(int j, float v, float vp, int lpos) {
  int posv = (j & 16) ? (lpos & 63) : (lpos >> 6);
  float cs, sn;
  rope_cs(j & 7, posv, cs, sn);
  return (j & 8) ? (vp * sn + v * cs) : (v * cs - vp * sn);
}

DI void s5_disc(const Params& p, int dir, int g, int pp, double& dt, double& ar, double& ai, float& fr, float& fi) {
  dt = exp((double)p.in[I_LOGSTEP][dir * 64 + g]);
  ar = (double)p.in[I_ARE][(dir * 64 + g) * 64 + pp];
  ai = (double)p.in[I_AIM][(dir * 64 + g) * 64 + pp];
  double mag = exp(ar * dt);
  double a = ai * dt;
  a -= 6.283185307179586 * rint(a * 0.15915494309189535);
  float sn, cs;
  sincosf((float)a, &sn, &cs);
  double lr = mag * (double)cs, li = mag * (double)sn;
  double den = ar * ar + ai * ai, nr = lr - 1.0;
  fr = (float)((nr * ar + li * ai) / den);
  fi = (float)((li * ar - nr * ai) / den);
}
DI void s5_pow(double dt, double ar, double ai, int k, float& wr, float& wi) {
  double mag = exp(ar * dt * (double)k);
  double a = ai * dt * (double)k;
  a -= 6.283185307179586 * rint(a * 0.15915494309189535);
  float sn, cs;
  sincosf((float)a, &sn, &cs);
  wr = (float)mag * cs;
  wi = (float)mag * sn;
}

enum { PH_PREP = 0, PH_N1, PH_N2, PH_N3, PH_N4, PH_N4B, PH_N5, PH_N6A, PH_N6B, PH_N9, PH_N10, PH_N10B, PH_FINAL,
       PH_O1, PH_O2, PH_O3, PH_O4, PH_O5, PH_O6, PH_O7, PH_O8, PH_O9, PH_O10, PH_H0, PH_H1, PH_COUNT };

constexpr int SMEM_BYTES = 48 * 1024;


DI void prep_transpose(const Params& p, int widx, int tile, char* smem) {
  const int tidx_ = opaque_tid();
  int K, N;
  size_t dst;
  const float* W;
  const float* scl = nullptr;
  switch (widx) {
    case 0: W = p.in[I_WIN0]; K = 1024; N = NIN0; dst = O_WT_IN0; break;
    case 1: W = p.in[I_WUQ]; K = 256; N = 1536; dst = O_WT_UQ; scl = p.in[I_QNORM]; break;
    case 2: W = p.in[I_WUKV]; K = 128; N = 2048; dst = O_WT_UKV; scl = p.in[I_KVNORM]; break;
    case 3: W = p.in[I_WOUT0]; K = 1024; N = 1024; dst = O_WT_OUT0; break;
    case 4: W = p.in[I_WIN1]; K = 1024; N = NIN1; dst = O_WT_IN1; break;
    case 5: W = p.in[I_WGLU]; K = 1024; N = 1024; dst = O_WT_GLU; break;
    default: W = p.in[I_WOUT1]; K = 1024; N = 1024; dst = O_WT_OUT1; break;
  }
  float (*t)[33] = (float (*)[33])smem;
  int ntn = N / 32;
  int kt = tile / ntn, nt = tile - kt * ntn;
  int tx = tidx_ & 31, ty = tidx_ >> 5;
  float v[16];
#pragma unroll
  for (int i = 0; i < 16; ++i) {
    int k = kt * 128 + ty + 8 * i, n = nt * 32 + tx;
    v[i] = W[(size_t)k * N + n];
  }
  if (scl) {
#pragma unroll
    for (int i = 0; i < 16; ++i) v[i] *= scl[kt * 128 + ty + 8 * i];
  }
#pragma unroll
  for (int i = 0; i < 16; ++i) t[ty + 8 * i][tx] = v[i];
  __syncthreads();
  bfr* Wt = (bfr*)(p.ws + dst);
  {
    int nl = tidx_ >> 3, kc = (tidx_ & 7) * 16;
    unsigned w[8];
#pragma unroll
    for (int j = 0; j < 8; ++j) w[j] = pk2(t[kc + 2 * j][nl], t[kc + 2 * j + 1][nl]);
    uint4* dstp = (uint4*)(Wt + (size_t)(nt * 32 + nl) * K + kt * 128 + kc);
    dstp[0] = make_uint4(w[0], w[1], w[2], w[3]);
    dstp[1] = make_uint4(w[4], w[5], w[6], w[7]);
  }
  __syncthreads();
}

DI void prep_mod(const Params& p, int unit, char* smem) {
  const int tidx_ = opaque_tid();
  int layer = unit / 192, cgp = unit - layer * 192;
  float* sil = (float*)smem;
  float* red = sil + 9 * 1024;
  for (int i = tidx_; i < 9 * 1024; i += 256) {
    int r = i >> 10, k = i & 1023;
    float v = r < 8 ? p.in[I_C][r * 1024 + k] : p.in[I_CCTX][k];
    sil[i] = silu_f(v);
  }
  __syncthreads();
  int nn = tidx_ & 15, kg = tidx_ >> 4;
  int n = cgp * 16 + nn;
  const float* W = p.in[I_ADAW] + (size_t)layer * 1024 * 3072 + n;
  float acc[9];
#pragma unroll
  for (int r = 0; r < 9; ++r) acc[r] = 0.f;
#pragma unroll 1
  for (int k0 = kg * 64; k0 < kg * 64 + 64; k0 += 32) {
    float wv[32];
#pragma unroll
    for (int j = 0; j < 32; ++j) wv[j] = W[(size_t)(k0 + j) * 3072];
#pragma unroll
    for (int j = 0; j < 32; ++j) {
#pragma unroll
      for (int r = 0; r < 9; ++r) acc[r] += sil[r * 1024 + k0 + j] * wv[j];
    }
  }
#pragma unroll
  for (int r = 0; r < 9; ++r) red[(kg * 9 + r) * 16 + nn] = acc[r];
  __syncthreads();
  if (tidx_ < 144) {
    int r = tidx_ >> 4, c = tidx_ & 15;
    int nc = cgp * 16 + c;
    float s = p.in[I_ADAB][layer * 3072 + nc];
#pragma unroll
    for (int g = 0; g < 16; ++g) s += red[(g * 9 + r) * 16 + c];
    ((float*)(p.ws + O_MOD))[((size_t)(layer * 9 + r)) * 3072 + nc] = s;
  }
  __syncthreads();
}

DI void prep_ktab(const Params& p, int unit, char* smem) {
  const int tidx_ = opaque_tid();
  int g = unit / 7, lg = unit - g * 7;
  float2* E = (float2*)smem;
  int tid = tidx_;
  const bool use_f = lg >= 3, use_r = lg <= 3;
  for (int i = tid; i < 9 * 128; i += 256) {
    int l = i >> 7, dir = (i >> 6) & 1, pp = i & 63;
    int lag = lg * 9 + l - 31;
    bool used = (dir == 0) ? (lag >= 0) : (lag <= 0);
    float2 e = make_float2(0.f, 0.f);
    if (used) {
      double dt, ar, ai;
      float fr, fi, wr, wi;
      s5_disc(p, dir, g, pp, dt, ar, ai, fr, fi);
      s5_pow(dt, ar, ai, lag < 0 ? -lag : lag, wr, wi);
      e.x = wr * fr - wi * fi;
      e.y = wr * fi + wi * fr;
    }
    E[(l * 2 + dir) * 64 + pp] = e;
  }
  float* PB = (float*)(E + 9 * 128);
  for (int dir = 0; dir < 2; ++dir) {
    if (dir == 0 ? !use_f : !use_r) continue;
    const float4* s0 = (const float4*)(p.in[I_BRE] + ((size_t)(dir * 64 + g)) * 1024);
    const float4* s1 = (const float4*)(p.in[I_BIM] + ((size_t)(dir * 64 + g)) * 1024);
    const float4* s2 = (const float4*)(p.in[I_CRE] + ((size_t)(dir * 64 + g)) * 1024);
    const float4* s3 = (const float4*)(p.in[I_CIM] + ((size_t)(dir * 64 + g)) * 1024);
    float4* d = (float4*)(PB + dir * 4096);
    d[tid] = s0[tid];
    d[256 + tid] = s1[tid];
    d[512 + tid] = s2[tid];
    d[768 + tid] = s3[tid];
  }
  __syncthreads();
  int c = tid >> 4, c2 = tid & 15;
  float acc[9];
#pragma unroll
  for (int l = 0; l < 9; ++l) acc[l] = 0.f;
  for (int dir = 0; dir < 2; ++dir) {
    if (dir == 0 ? !use_f : !use_r) continue;
    const float* bre = PB + dir * 4096;
    const float* bim = bre + 1024;
    const float* cre = bre + 2048;
    const float* cim = bre + 3072;
#pragma unroll 4
    for (int pp = 0; pp < 64; ++pp) {
      float br = bre[pp * 16 + c2], bi = bim[pp * 16 + c2];
      float cr = cre[c * 64 + pp], ci = cim[c * 64 + pp];
      float mr = cr * br - ci * bi, mi = cr * bi + ci * br;
#pragma unroll
      for (int l = 0; l < 9; ++l) {
        float2 e = E[(l * 2 + dir) * 64 + pp];
        acc[l] += mr * e.x - mi * e.y;
      }
    }
  }
  bfr* KT = (bfr*)(p.ws + O_KTAB);
#pragma unroll
  for (int l = 0; l < 9; ++l) KT[(((size_t)g * 63 + lg * 9 + l) * 16 + c) * 16 + c2] = f2bf(acc[l]);
  __syncthreads();
}

DI void prep_ops(const Params& p, int unit) {
  const int tidx_ = opaque_tid();
  int idx = unit * 256 + tidx_;
  int pp = idx & 63, t = (idx >> 6) & 31, dir = (idx >> 11) & 1, g = idx >> 12;
  double dt, ar, ai;
  float fr, fi, wr, wi;
  s5_disc(p, dir, g, pp, dt, ar, ai, fr, fi);
  s5_pow(dt, ar, ai, dir == 0 ? (TC - 1 - t) : t, wr, wi);
  float er = wr * fr - wi * fi, ei = wr * fi + wi * fr;
  const float* bre = p.in[I_BRE] + (((size_t)(dir * 64 + g)) * 64 + pp) * 16;
  const float* bim = p.in[I_BIM] + (((size_t)(dir * 64 + g)) * 64 + pp) * 16;
  bfr* wst = (bfr*)(p.ws + O_WST) + (size_t)g * 256 * 512;
  bfr* rre = wst + (size_t)(dir * 128 + pp) * 512 + t * 16;
  bfr* rim = wst + (size_t)(dir * 128 + 64 + pp) * 512 + t * 16;
#pragma unroll
  for (int c2 = 0; c2 < 16; ++c2) {
    float br = bre[c2], bi = bim[c2];
    rre[c2] = f2bf(er * br - ei * bi);
    rim[c2] = f2bf(er * bi + ei * br);
  }
  s5_pow(dt, ar, ai, dir == 0 ? (t + 1) : (TC - t), wr, wi);
  const float* cre = p.in[I_CRE] + ((size_t)(dir * 64 + g)) * 16 * 64;
  const float* cim = p.in[I_CIM] + ((size_t)(dir * 64 + g)) * 16 * 64;
  bfr* vop = (bfr*)(p.ws + O_VOP) + (size_t)g * 512 * 256;
#pragma unroll
  for (int c = 0; c < 16; ++c) {
    float cr = cre[c * 64 + pp], ci = cim[c * 64 + pp];
    float dr = cr * wr - ci * wi, di = cr * wi + ci * wr;
    vop[(size_t)(t * 16 + c) * 256 + dir * 128 + pp] = f2bf(dr);
    vop[(size_t)(t * 16 + c) * 256 + dir * 128 + 64 + pp] = f2bf(-di);
  }
}

constexpr int TR_T0 = 8 * 45, TR_T1 = 2 * 48, TR_T2 = 1 * 64, TR_T3 = 256, TR_T4 = 8 * 64, TR_T5 = 256, TR_T6 = 256;
constexpr int TR_TOTAL = TR_T0 + TR_T1 + TR_T2 + TR_T3 + TR_T4 + TR_T5 + TR_T6;
constexpr int U_MOD = 384, U_RS0 = 0, U_KTAB = 64 * 7, U_OPS = 64 * 2 * 64 * 32 / 256;
constexpr int PREP_A_UNITS = U_MOD + TR_T0 + TR_T1 + TR_T2 + TR_T3;
constexpr int PREP_B_UNITS = TR_T4 + TR_T5 + TR_T6 + U_KTAB + U_OPS;

DI void phase_prep(const Params& p, char* smem) {
  for (int u = blockIdx.x; u < PREP_A_UNITS; u += gridDim.x) {
    int v = u;
    if (v < U_MOD) { prep_mod(p, v, smem); continue; }
    v -= U_MOD;
    int w = 0;
    if (v >= TR_T0) { v -= TR_T0; w = 1;
      if (v >= TR_T1) { v -= TR_T1; w = 2;
        if (v >= TR_T2) { v -= TR_T2; w = 3; } } }
    prep_transpose(p, w, v, smem);
  }
}
DI void phase_prep_b(const Params& p, char* smem, int first_blk) {
  if (first_blk >= (int)gridDim.x) first_blk = 0;
  if ((int)blockIdx.x < first_blk) return;
  const int nb = gridDim.x - first_blk;
  for (int u = blockIdx.x - first_blk; u < PREP_B_UNITS; u += nb) {
    int v = u;
    if (v < TR_T4 + TR_T5 + TR_T6) {
      int w = 4;
      if (v >= TR_T4) { v -= TR_T4; w = 5;
        if (v >= TR_T5) { v -= TR_T5; w = 6; } }
      prep_transpose(p, w, v, smem);
      continue;
    }
    v -= TR_T4 + TR_T5 + TR_T6;
    if (v < U_KTAB) { prep_ktab(p, v, smem); continue; }
    v -= U_KTAB;
    prep_ops(p, v);
  }
}

DI float rs_from_part(const float* part, int nrows, int r) {
  float s = 0.f;
#pragma unroll
  for (int j = 0; j < 16; ++j) s += part[(size_t)j * nrows + r];
  return rsqrtf(s * (1.f / 1024.f) + EPS);
}

DI void phase_final(const Params& p) {
  const int tidx_ = opaque_tid();
  const float* part = (const float*)(p.ws + O_PART2);
  const float4* g4 = (const float4*)p.in[I_FINALG];
  int lane = tidx_ & 63;
  float4 g[4];
#pragma unroll
  for (int i = 0; i < 4; ++i) g[i] = g4[lane + 64 * i];
  for (int r = (blockIdx.x * 4 + (tidx_ >> 6)) * 2; r < NLAT; r += gridDim.x * 8) {
    float4* row0 = (float4*)(p.out + (size_t)r * D);
    float4* row1 = row0 + D / 4;
    float4 v0[4], v1[4];
#pragma unroll
    for (int i = 0; i < 4; ++i) {
      v0[i] = row0[lane + 64 * i];
      v1[i] = row1[lane + 64 * i];
    }
    float ps = part[(size_t)(lane & 15) * NLAT + r + ((lane >> 4) & 1)];
    ps += __shfl_xor(ps, 1);
    ps += __shfl_xor(ps, 2);
    ps += __shfl_xor(ps, 4);
    ps += __shfl_xor(ps, 8);
    const float rs0 = rsqrtf(__shfl(ps, 0) * (1.f / 1024.f) + EPS);
    const float rs1 = rsqrtf(__shfl(ps, 16) * (1.f / 1024.f) + EPS);
#pragma unroll
    for (int i = 0; i < 4; ++i) {
      float4 a = v0[i], c = v1[i];
      a.x *= rs0 * g[i].x; a.y *= rs0 * g[i].y; a.z *= rs0 * g[i].z; a.w *= rs0 * g[i].w;
      c.x *= rs1 * g[i].x; c.y *= rs1 * g[i].y; c.z *= rs1 * g[i].z; c.w *= rs1 * g[i].w;
      row0[lane + 64 * i] = a;
      row1[lane + 64 * i] = c;
    }
  }
}

typedef short bf16x8 __attribute__((ext_vector_type(8)));
typedef short s16x4 __attribute__((ext_vector_type(4)));
typedef float f32x16 __attribute__((ext_vector_type(16)));
#define SCHED_FENCE() __builtin_amdgcn_sched_barrier(0)
#define MFMA32(a, b, c) __builtin_amdgcn_mfma_f32_32x32x16_bf16((a), (b), (c), 0, 0, 0)
DI int xcd_swz(int u, int per) {
  int x = u & 7, q = u >> 3;
  int qq = q / per;
  return (x + 8 * qq) * per + (q - qq * per);
}
DI int crow(int i, int h) { return (i & 3) + 8 * (i >> 2) + 4 * h; }

constexpr int LDT = 40;
struct GemmSmem {
  bfr A[2][128 * LDT];
  bfr B[2][128 * LDT];
  float rs[128];
};
static_assert(sizeof(GemmSmem) <= SMEM_BYTES, "smem");

DI void zero_acc(f32x16 (&acc)[2][2]) {
#pragma unroll
  for (int a = 0; a < 2; ++a)
#pragma unroll
    for (int b = 0; b < 2; ++b)
#pragma unroll
      for (int i = 0; i < 16; ++i) acc[a][b][i] = 0.f;
}

#define GSTAGE_DECL uint4 ga0, ga1, gb0, gb1, gc0, gc1, gd0, gd1
#define GSTAGE_ARGS ga0, ga1, gb0, gb1, gc0, gc1, gd0, gd1
#define GSTAGE_PARAMS uint4 &a0, uint4 &a1, uint4 &b0, uint4 &b1, uint4 &c0, uint4 &c1, uint4 &d0, uint4 &d1
template <class AAddr, class BAddr>
DI void gemm_prefetch(GSTAGE_PARAMS, AAddr aaddr, BAddr baddr) {
  const int tid = opaque_tid();
  const int lrow = tid >> 2, lkc = (tid & 3) * 8;
  b0 = *(const uint4*)baddr(lrow, lkc);
  b1 = *(const uint4*)baddr(lrow + 64, lkc);
  a0 = *(const uint4*)aaddr(lrow, lkc);
  a1 = *(const uint4*)aaddr(lrow + 64, lkc);
  d0 = *(const uint4*)baddr(lrow, 32 + lkc);
  d1 = *(const uint4*)baddr(lrow + 64, 32 + lkc);
  c0 = *(const uint4*)aaddr(lrow, 32 + lkc);
  c1 = *(const uint4*)aaddr(lrow + 64, 32 + lkc);
  SCHED_FENCE();
}
template <class AAddr, class BAddr>
DI void gemm_main(f32x16 (&acc)[2][2], int KT, AAddr aaddr, BAddr baddr, GemmSmem* sm, GSTAGE_PARAMS) {
  const int tid = opaque_tid(), lane = tid & 63, wave = tid >> 6;
  const int wm = wave >> 1, wn = wave & 1, r = lane & 31, h = lane >> 5;
  const int lrow = tid >> 2, lkc = (tid & 3) * 8;
#define GM_LOAD(KT_, A0, A1, B0, B1)                   \
  {                                                    \
    const int kk_ = (KT_) * 32 + lkc;                  \
    B0 = *(const uint4*)baddr(lrow, kk_);              \
    B1 = *(const uint4*)baddr(lrow + 64, kk_);         \
    A0 = *(const uint4*)aaddr(lrow, kk_);              \
    A1 = *(const uint4*)aaddr(lrow + 64, kk_);         \
  }
#define GM_STORE(BUF_, A0, A1, B0, B1)                                  \
  {                                                                     \
    *(uint4*)(sm->B[BUF_] + lrow * LDT + lkc) = B0;                     \
    *(uint4*)(sm->B[BUF_] + (lrow + 64) * LDT + lkc) = B1;              \
    *(uint4*)(sm->A[BUF_] + lrow * LDT + lkc) = A0;                     \
    *(uint4*)(sm->A[BUF_] + (lrow + 64) * LDT + lkc) = A1;              \
  }
#define GM_COMPUTE(BUF_)                                                                                       \
  _Pragma("unroll") for (int ks = 0; ks < 2; ++ks) {                                                           \
    bf16x8 a_[2], b_[2];                                                                                       \
    _Pragma("unroll") for (int mi = 0; mi < 2; ++mi)                                                           \
        a_[mi] = *(const bf16x8*)(sm->A[BUF_] + (wm * 64 + mi * 32 + r) * LDT + ks * 16 + h * 8);              \
    _Pragma("unroll") for (int ni = 0; ni < 2; ++ni)                                                           \
        b_[ni] = *(const bf16x8*)(sm->B[BUF_] + (wn * 64 + ni * 32 + r) * LDT + ks * 16 + h * 8);              \
    _Pragma("unroll") for (int mi = 0; mi < 2; ++mi)                                                           \
        _Pragma("unroll") for (int ni = 0; ni < 2; ++ni) acc[mi][ni] = MFMA32(a_[mi], b_[ni], acc[mi][ni]);    \
  }
  GM_STORE(0, a0, a1, b0, b1)
  if (KT > 2) GM_LOAD(2, a0, a1, b0, b1)
  SCHED_FENCE();
  __syncthreads();
  for (int kt = 0; kt < KT; kt += 2) {
    GM_STORE(1, c0, c1, d0, d1)
    if (kt + 3 < KT) GM_LOAD(kt + 3, c0, c1, d0, d1)
    SCHED_FENCE();
    GM_COMPUTE(0)
    __syncthreads();
    if (kt + 2 < KT) GM_STORE(0, a0, a1, b0, b1)
    if (kt + 4 < KT) GM_LOAD(kt + 4, a0, a1, b0, b1)
    SCHED_FENCE();
    GM_COMPUTE(1)
    __syncthreads();
  }
}

template <class AAddr, class BAddr>
DI void gemm_full(f32x16 (&acc)[2][2], int KT, AAddr aaddr, BAddr baddr, GemmSmem* sm) {
  GSTAGE_DECL;
  gemm_prefetch(GSTAGE_ARGS, aaddr, baddr);
  gemm_main(acc, KT, aaddr, baddr, sm, GSTAGE_ARGS);
}

DI float transpose_reduce16(float (&v)[16], int lane) {
  float r8[8], r4[4], r2[2];
  {
    bool up = lane & 8;
#pragma unroll
    for (int i = 0; i < 8; ++i) {
      float send = up ? v[i] : v[i + 8];
      float keep = up ? v[i + 8] : v[i];
      r8[i] = keep + __shfl_xor(send, 8);
    }
  }
  {
    bool up = lane & 4;
#pragma unroll
    for (int i = 0; i < 4; ++i) {
      float send = up ? r8[i] : r8[i + 4];
      float keep = up ? r8[i + 4] : r8[i];
      r4[i] = keep + __shfl_xor(send, 4);
    }
  }
  {
    bool up = lane & 2;
#pragma unroll
    for (int i = 0; i < 2; ++i) {
      float send = up ? r4[i] : r4[i + 2];
      float keep = up ? r4[i + 2] : r4[i];
      r2[i] = keep + __shfl_xor(send, 2);
    }
  }
  bool up = lane & 1;
  float send = up ? r2[0] : r2[1];
  float keep = up ? r2[1] : r2[0];
  return keep + __shfl_xor(send, 1);
}

DI void stage_half(const f32x16 (&acc)[2][2], int mi, float* wl, float4 (&v)[8], int lane) {
  const int r = lane & 31, h = lane >> 5;
#pragma unroll
  for (int ni = 0; ni < 2; ++ni)
#pragma unroll
    for (int i = 0; i < 16; ++i) wl[crow(i, h) * 64 + ni * 32 + r] = acc[mi][ni][i];
  asm volatile("s_waitcnt lgkmcnt(0)" ::: "memory");
#pragma unroll
  for (int c = 0; c < 8; ++c) v[c] = *(const float4*)(wl + (c * 4 + (lane >> 4)) * 64 + (lane & 15) * 4);
  asm volatile("s_waitcnt lgkmcnt(0)" ::: "memory");
}
DI void stage_half8(const f32x16 (&acc)[2][2], int mi, float* wl, float4 (&lo)[4], float4 (&hi)[4], int lane) {
  const int r = lane & 31, h = lane >> 5;
#pragma unroll
  for (int ni = 0; ni < 2; ++ni)
#pragma unroll
    for (int i = 0; i < 16; ++i) wl[crow(i, h) * 64 + ni * 32 + r] = acc[mi][ni][i];
  asm volatile("s_waitcnt lgkmcnt(0)" ::: "memory");
#pragma unroll
  for (int c = 0; c < 4; ++c) {
    const float* pch = wl + (c * 8 + (lane >> 3)) * 64 + (lane & 7) * 8;
    lo[c] = *(const float4*)pch;
    hi[c] = *(const float4*)(pch + 4);
  }
  asm volatile("s_waitcnt lgkmcnt(0)" ::: "memory");
}
DI float4 bf4_to_f4(uint2 u) {
  return make_float4(__uint_as_float(u.x << 16), __uint_as_float(u.x & 0xffff0000u), __uint_as_float(u.y << 16),
                     __uint_as_float(u.y & 0xffff0000u));
}
DI uint2 f4_to_bf4(float4 f) { return make_uint2(pk2(f.x, f.y), pk2(f.z, f.w)); }

#define WAVE_IDS                                              \
  const int tid = opaque_tid(), lane = tid & 63, wave = tid >> 6; \
  const int wm = wave >> 1, wn = wave & 1, r = lane & 31, h = lane >> 5; \
  (void)wm; (void)wn; (void)r; (void)h;

template <int LAYER>
DI void phase_hconv(const Params& p) {
  const int tid = opaque_tid(), lane = tid & 63;
  bfr* H = (bfr*)(p.ws + (LAYER == 0 ? O_H0 : O_H1));
  const float4* ng4 = (const float4*)(p.in[I_NORMG] + LAYER * 1024);
  for (int tok = (blockIdx.x * 4 + (tid >> 6)) * 2; tok < TOK; tok += gridDim.x * 8) {
    const float4* xr0 = (const float4*)(LAYER == 0 ? xrow0(p, tok) : (const float*)xrow1(p, tok));
    const float4* xr1 = xr0 + 256;
    const float4* md4 = (const float4*)modrow(p, LAYER, tok);
    float4 x0[4], x1[4], gm[4], sh[4];
#pragma unroll
    for (int i = 0; i < 4; ++i) {
      x0[i] = xr0[lane + 64 * i];
      x1[i] = xr1[lane + 64 * i];
      float4 gv = ng4[lane + 64 * i];
      float4 sc = md4[256 + lane + 64 * i];
      sh[i] = md4[lane + 64 * i];
      gm[i] = make_float4(gv.x * (1.f + sc.x), gv.y * (1.f + sc.y), gv.z * (1.f + sc.z), gv.w * (1.f + sc.w));
    }
    float s0 = 0.f, s1 = 0.f;
#pragma unroll
    for (int i = 0; i < 4; ++i) {
      s0 += x0[i].x * x0[i].x + x0[i].y * x0[i].y + x0[i].z * x0[i].z + x0[i].w * x0[i].w;
      s1 += x1[i].x * x1[i].x + x1[i].y * x1[i].y + x1[i].z * x1[i].z + x1[i].w * x1[i].w;
    }
    s0 = wave_sum(s0);
    s1 = wave_sum(s1);
    const float r0 = rsqrtf(s0 * (1.f / 1024.f) + EPS), r1 = rsqrtf(s1 * (1.f / 1024.f) + EPS);
#pragma unroll
    for (int i = 0; i < 4; ++i) {
      uint2 o0, o1;
      o0.x = pk2(x0[i].x * r0 * gm[i].x + sh[i].x, x0[i].y * r0 * gm[i].y + sh[i].y);
      o0.y = pk2(x0[i].z * r0 * gm[i].z + sh[i].z, x0[i].w * r0 * gm[i].w + sh[i].w);
      o1.x = pk2(x1[i].x * r1 * gm[i].x + sh[i].x, x1[i].y * r1 * gm[i].y + sh[i].y);
      o1.y = pk2(x1[i].z * r1 * gm[i].z + sh[i].z, x1[i].w * r1 * gm[i].w + sh[i].w);
      *(uint2*)(H + (size_t)tok * 1024 + (lane + 64 * i) * 4) = o0;
      *(uint2*)(H + (size_t)(tok + 1) * 1024 + (lane + 64 * i) * 4) = o1;
    }
  }
}

DI void phase_o1(const Params& p, char* smem) {
  GemmSmem* sm = (GemmSmem*)smem;
  WAVE_IDS
  const int NT = 12, units = (TOK / 128) * NT;
  const bfr* WT = (const bfr*)(p.ws + O_WT_IN0);
  bfr* PC = (bfr*)(p.ws + O_PC);
  bfr* SZ0 = (bfr*)(p.ws + O_SZ0);
  bfr* KRb = (bfr*)(p.ws + O_KR);
  const bfr* Ah = (const bfr*)(p.ws + O_H0);
  auto Aof = [&](int m0) { return [=](int row, int k) { return Ah + (size_t)(m0 + row) * 1024 + k; }; };
  auto Bof = [&](int n0) {
    return [=](int row, int k) {
      int n = n0 + row;
      n = n < NIN0 ? n : NIN0 - 1;
      return WT + (size_t)n * 1024 + k;
    };
  };
  GSTAGE_DECL;
  if ((int)blockIdx.x < units) {
    const int us = xcd_swz(blockIdx.x, NT);
    gemm_prefetch(GSTAGE_ARGS, Aof((us / NT) * 128), Bof((us % NT) * 128));
  }
  for (int u = blockIdx.x; u < units; u += gridDim.x) {
    const int us = xcd_swz(u, NT);
    int mt = us / NT, nt = us - mt * NT;
    int m0 = mt * 128, n0 = nt * 128;
    f32x16 acc[2][2];
    zero_acc(acc);
    gemm_main(acc, 32, Aof(m0), Bof(n0), sm, GSTAGE_ARGS);
    if (u + (int)gridDim.x < units) {
      const int us1 = xcd_swz(u + gridDim.x, NT);
      gemm_prefetch(GSTAGE_ARGS, Aof((us1 / NT) * 128), Bof((us1 % NT) * 128));
    }
    int b = m0 / LALL, pos0 = m0 - b * LALL;
    bool lat = pos0 >= LC;
    (void)b;
    if (lat && n0 + wn * 64 == 384) {
#pragma unroll
      for (int mi = 0; mi < 2; ++mi)
#pragma unroll
        for (int i = 0; i < 16; ++i) {
          int pos = pos0 + wm * 64 + mi * 32 + crow(i, h);
          float v = acc[mi][0][i];
          float vp = __shfl_xor(v, 8);
          acc[mi][0][i] = rope_apply(r, v, vp, pos - LC);
        }
    }
    {
      float* wl = (float*)sm + wave * 2048;
      const int col = n0 + wn * 64 + (lane & 7) * 8;
#pragma unroll
      for (int mi = 0; mi < 2; ++mi) {
        float4 lo[4], hi[4];
        stage_half8(acc, mi, wl, lo, hi, lane);
#pragma unroll
        for (int c = 0; c < 4; ++c) {
          int tok = m0 + wm * 64 + mi * 32 + c * 8 + (lane >> 3);
          if (col < 416) {
            uint4 o;
            o.x = pk2(lo[c].x, lo[c].y);
            o.y = pk2(lo[c].z, lo[c].w);
            o.z = pk2(hi[c].x, hi[c].y);
            o.w = pk2(hi[c].z, hi[c].w);
            bfr* dst = col < 384 ? PC + (size_t)tok * 384 + col : KRb + (size_t)tok * 32 + (col - 384);
            *(uint4*)dst = o;
          } else if (col < NIN0) {
            uint4 o;
            o.x = pk2(silu_f(lo[c].x), silu_f(lo[c].y));
            o.y = pk2(silu_f(lo[c].z), silu_f(lo[c].w));
            o.z = pk2(silu_f(hi[c].x), silu_f(hi[c].y));
            o.w = pk2(silu_f(hi[c].z), silu_f(hi[c].w));
            *(uint4*)(SZ0 + (size_t)tok * 1024 + (col - 416)) = o;
          }
        }
      }
      __syncthreads();
    }
  }
}

DI void phase_o2(const Params& p, char* smem) {
  GemmSmem* sm = (GemmSmem*)smem;
  WAVE_IDS
  const int UQ = (TOK / 128) * 12, UKV = (TOK / 128) * 16;
  const bfr* PC = (const bfr*)(p.ws + O_PC);
  bfr* Q = (bfr*)p.out;
  bfr* Kb = (bfr*)(p.ws + O_K);
  bfr* VT = (bfr*)(p.ws + O_VT);
  const int total = UQ + UKV;
  const int per_blk = (total + gridDim.x - 1) / gridDim.x;
  const int u_beg = blockIdx.x * per_blk;
  const int u_end = u_beg + per_blk < total ? u_beg + per_blk : total;
  int prev_key = -1;
  for (int us = u_beg; us < u_end; ++us) {
    int mt = us / 28, rem = us - mt * 28;
    bool isq = rem < 12;
    int nt = isq ? rem : rem - 12;
    int m0 = mt * 128, n0 = nt * 128;
    int Kd = isq ? 256 : 128;
    int aoff = isq ? 0 : 256;
    const bfr* WT = (const bfr*)(p.ws + (isq ? O_WT_UQ : O_WT_UKV));
    const int key = mt * 2 + (isq ? 0 : 1);
    if (key != prev_key) {
      prev_key = key;
      __syncthreads();
      int row = tid >> 1, half = tid & 1;
      const bfr* ap = PC + (size_t)(m0 + row) * 384 + aoff + half * (Kd / 2);
      float ss = 0.f;
      for (int j = 0; j < Kd / 16; ++j) {
        uint4 v = *(const uint4*)(ap + j * 8);
        unsigned w[4] = {v.x, v.y, v.z, v.w};
#pragma unroll
        for (int e = 0; e < 4; ++e) {
          float lo = __uint_as_float(w[e] << 16), hi = __uint_as_float(w[e] & 0xffff0000u);
          ss += lo * lo + hi * hi;
        }
      }
      ss += __shfl_xor(ss, 1);
      if (half == 0) sm->rs[row] = rsqrtf(ss / (float)Kd + EPS);
      __syncthreads();
    }
    f32x16 acc[2][2];
    zero_acc(acc);
    gemm_full(
        acc, Kd / 32, [&](int row, int k) { return PC + (size_t)(m0 + row) * 384 + aoff + k; },
        [&](int row, int k) { return WT + (size_t)(n0 + row) * Kd + k; }, sm);
    int b = m0 / LALL, pos0 = m0 - b * LALL;
    bool lat = pos0 >= LC;
    float* wl = (float*)sm + wave * 2048;
    if (isq || wn == 0) {
      if (isq && lat) {
#pragma unroll
        for (int ni = 0; ni < 2; ++ni) {
          int col0 = n0 + wn * 64 + ni * 32;
          if (col0 % 96 == 64) {
#pragma unroll
            for (int mi = 0; mi < 2; ++mi)
#pragma unroll
              for (int i = 0; i < 16; ++i) {
                int pos = pos0 + wm * 64 + mi * 32 + crow(i, h);
                float v = acc[mi][ni][i];
                float vp = __shfl_xor(v, 8);
                acc[mi][ni][i] = rope_apply(r, v, vp, pos - LC);
              }
          }
        }
      }
      const int c0 = wn * 64 + (lane & 7) * 8;
      bfr* dst;
      int rstride;
      float oscale;
      if (isq) {
        int col = n0 + c0;
        int hh = col / 96, d = col - hh * 96;
        dst = Q + ((size_t)(b * NH + hh) * LALL) * DQK + d;
        rstride = DQK;
        oscale = QSCALE;
      } else {
        int hh = n0 >> 7;
        dst = Kb + ((size_t)(b * NH + hh) * LALL) * 64 + c0;
        rstride = 64;
        oscale = 1.f;
      }
#pragma unroll
      for (int mi = 0; mi < 2; ++mi) {
        float4 lo[4], hi[4];
        stage_half8(acc, mi, wl, lo, hi, lane);
#pragma unroll
        for (int c = 0; c < 4; ++c) {
          int row = wm * 64 + mi * 32 + c * 8 + (lane >> 3);
          float sc = sm->rs[row] * oscale;
          uint4 o;
          o.x = pk2(lo[c].x * sc, lo[c].y * sc);
          o.y = pk2(lo[c].z * sc, lo[c].w * sc);
          o.z = pk2(hi[c].x * sc, hi[c].y * sc);
          o.w = pk2(hi[c].z * sc, hi[c].w * sc);
          *(uint4*)(dst + (size_t)(pos0 + row) * rstride) = o;
        }
      }
    } else {
      int hh = n0 >> 7;
#pragma unroll
      for (int mi = 0; mi < 2; ++mi)
#pragma unroll
        for (int ni = 0; ni < 2; ++ni) {
          int dvv = ni * 32 + r;
#pragma unroll
          for (int g4 = 0; g4 < 4; ++g4) {
            int row = wm * 64 + mi * 32 + 8 * g4 + 4 * h;
            int pos = pos0 + row;
            uint2 o;
            o.x = pk2(acc[mi][ni][4 * g4 + 0] * sm->rs[row + 0], acc[mi][ni][4 * g4 + 1] * sm->rs[row + 1]);
            o.y = pk2(acc[mi][ni][4 * g4 + 2] * sm->rs[row + 2], acc[mi][ni][4 * g4 + 3] * sm->rs[row + 3]);
            *(uint2*)(VT + (((size_t)(b * NH + hh)) * DV + dvv) * LALL + pos) = o;
          }
        }
    }
    __syncthreads();
  }
}

constexpr int KLD = 104;
constexpr int VLD = 68;
struct AttnSmem {
  bfr K[64 * KLD];
  bfr V[64 * VLD];
};
static_assert(sizeof(AttnSmem) <= SMEM_BYTES, "smem");

DI void attn_item(const Params& p, AttnSmem* sm, int bh, int qpos0, int nkeys) {
  WAVE_IDS
  const bfr* Q = (const bfr*)p.out;
  const bfr* Kg = (const bfr*)(p.ws + O_K) + (size_t)bh * LALL * 64;
  const bfr* KRg = (const bfr*)(p.ws + O_KR) + (size_t)(bh / NH) * LALL * 32;
  const bfr* Vg = (const bfr*)(p.ws + O_VT) + (size_t)bh * DV * LALL;
  const int qpos = qpos0 + wave * 32 + r;
  bf16x8 bq[6];
  {
    const bfr* qp = Q + ((size_t)bh * LALL + qpos) * DQK + 8 * h;
#pragma unroll
    for (int s = 0; s < 6; ++s) bq[s] = *(const bf16x8*)(qp + 16 * s);
  }
  f32x16 o[2];
#pragma unroll
  for (int d = 0; d < 2; ++d)
#pragma unroll
    for (int i = 0; i < 16; ++i) o[d][i] = 0.f;
  float mrun = 0.f, lrun = 0.f;
  uint4 kv0, kv1, kv2, vv0, vv1;
  const int kr0 = tid / 12, kc0 = (tid - kr0 * 12) * 8;
  const int kr1 = (tid + 256) / 12, kc1 = (tid + 256 - kr1 * 12) * 8;
  const int kr2 = (tid + 512) / 12, kc2 = (tid + 512 - kr2 * 12) * 8;
  const int vr0 = tid >> 3, vc0 = (tid & 7) * 8;
  const bfr* kp0 = kc0 < 64 ? Kg + (size_t)kr0 * 64 + kc0 : KRg + (size_t)kr0 * 32 + (kc0 - 64);
  const bfr* kp1 = kc1 < 64 ? Kg + (size_t)kr1 * 64 + kc1 : KRg + (size_t)kr1 * 32 + (kc1 - 64);
  const bfr* kp2 = kc2 < 64 ? Kg + (size_t)kr2 * 64 + kc2 : KRg + (size_t)kr2 * 32 + (kc2 - 64);
  const int ks0 = kc0 < 64 ? 64 : 32, ks1 = kc1 < 64 ? 64 : 32, ks2 = kc2 < 64 ? 64 : 32;
#define AT_GLOAD(KEY0_)                                                          \
  {                                                                              \
    const int key0_ = (KEY0_);                                                   \
    kv0 = *(const uint4*)(kp0 + (size_t)key0_ * ks0);                            \
    kv1 = *(const uint4*)(kp1 + (size_t)key0_ * ks1);                            \
    kv2 = *(const uint4*)(kp2 + (size_t)key0_ * ks2);                            \
    vv0 = *(const uint4*)(Vg + (size_t)vr0 * LALL + key0_ + vc0);                \
    vv1 = *(const uint4*)(Vg + (size_t)(vr0 + 32) * LALL + key0_ + vc0);         \
  }
#define AT_LSTORE()                                                              \
  {                                                                              \
    *(uint4*)(sm->K + kr0 * KLD + kc0) = kv0;                                    \
    *(uint4*)(sm->K + kr1 * KLD + kc1) = kv1;                                    \
    *(uint4*)(sm->K + kr2 * KLD + kc2) = kv2;                                    \
    uint2* d0_ = (uint2*)(sm->V + vr0 * VLD + vc0);                              \
    d0_[0] = make_uint2(vv0.x, vv0.y);                                           \
    d0_[1] = make_uint2(vv0.z, vv0.w);                                           \
    uint2* d1_ = (uint2*)(sm->V + (vr0 + 32) * VLD + vc0);                       \
    d1_[0] = make_uint2(vv1.x, vv1.y);                                           \
    d1_[1] = make_uint2(vv1.z, vv1.w);                                           \
  }
  const int NTI = nkeys / 64;
  AT_GLOAD(0)
  for (int it = 0; it < NTI; ++it) {
    AT_LSTORE()
    __syncthreads();
    if (it + 1 < NTI) AT_GLOAD((it + 1) * 64)
    SCHED_FENCE();
    f32x16 st[2];
    const float ninit = -mrun;
#pragma unroll
    for (int kb = 0; kb < 2; ++kb)
#pragma unroll
      for (int i = 0; i < 16; ++i) st[kb][i] = ninit;
#pragma unroll
    for (int s = 0; s < 6; ++s) {
#pragma unroll
      for (int kb = 0; kb < 2; ++kb) {
        bf16x8 ka = *(const bf16x8*)(sm->K + (kb * 32 + r) * KLD + 16 * s + 8 * h);
        st[kb] = MFMA32(ka, bq[s], st[kb]);
      }
    }
    float mx = fmaxf(fmaxf(st[0][0], st[0][1]), st[1][0]);
#pragma unroll
    for (int i = 2; i < 16; i += 2) mx = fmaxf(fmaxf(mx, st[0][i]), st[0][i + 1]);
#pragma unroll
    for (int i = 1; i < 15; i += 2) mx = fmaxf(fmaxf(mx, st[1][i]), st[1][i + 1]);
    mx = fmaxf(mx, st[1][15]);
    mx = fmaxf(mx, __shfl_xor(mx, 32));
    const bool need = (it == 0) || (mx > 8.f);
    if (__any(need)) {
      const float delta = need ? mx : 0.f;
      const float alpha = __builtin_amdgcn_exp2f(-delta);
      mrun += delta;
      lrun *= alpha;
#pragma unroll
      for (int d = 0; d < 2; ++d)
#pragma unroll
        for (int i = 0; i < 16; ++i) o[d][i] *= alpha;
#pragma unroll
      for (int kb = 0; kb < 2; ++kb)
#pragma unroll
        for (int i = 0; i < 16; ++i) st[kb][i] -= delta;
    }
    float ps = 0.f;
#pragma unroll
    for (int kb = 0; kb < 2; ++kb)
#pragma unroll
      for (int i = 0; i < 16; ++i) {
        float e = __builtin_amdgcn_exp2f(st[kb][i]);
        st[kb][i] = e;
        ps += e;
      }
    lrun += ps;
#pragma unroll
    for (int kb = 0; kb < 2; ++kb)
#pragma unroll
      for (int s2 = 0; s2 < 2; ++s2) {
        unsigned pw[4];
#pragma unroll
        for (int j = 0; j < 4; ++j) pw[j] = pk2(st[kb][8 * s2 + 2 * j], st[kb][8 * s2 + 2 * j + 1]);
        bf16x8 pb;
        {
          uint4 t = make_uint4(pw[0], pw[1], pw[2], pw[3]);
          pb = __builtin_bit_cast(bf16x8, t);
        }
#pragma unroll
        for (int d = 0; d < 2; ++d) {
          const bfr* vp = sm->V + (d * 32 + r) * VLD + kb * 32 + 16 * s2 + 4 * h;
          uint2 lo = *(const uint2*)vp;
          uint2 hi = *(const uint2*)(vp + 8);
          uint4 t = make_uint4(lo.x, lo.y, hi.x, hi.y);
          bf16x8 va = __builtin_bit_cast(bf16x8, t);
          o[d] = MFMA32(va, pb, o[d]);
        }
      }
    __syncthreads();
  }
  float ltot = lrun + __shfl_xor(lrun, 32);
  float inv = 1.f / ltot;
  int b = bh / NH, hh = bh - b * NH;
  size_t tok = (size_t)b * LALL + qpos;
  const bfr* SZ = (const bfr*)(p.ws + O_SZ0) + tok * 1024 + hh * 64;
  bfr* OG = (bfr*)(p.ws + O_OG) + tok * 1024 + hh * 64;
#pragma unroll
  for (int d = 0; d < 2; ++d)
#pragma unroll
    for (int g4 = 0; g4 < 4; ++g4) {
      int dv0 = d * 32 + 8 * g4 + 4 * h;
      uint2 z = *(const uint2*)(SZ + dv0);
      float z0 = __uint_as_float(z.x << 16), z1 = __uint_as_float(z.x & 0xffff0000u);
      float z2 = __uint_as_float(z.y << 16), z3 = __uint_as_float(z.y & 0xffff0000u);
      uint2 ov;
      ov.x = pk2(o[d][4 * g4 + 0] * inv * z0, o[d][4 * g4 + 1] * inv * z1);
      ov.y = pk2(o[d][4 * g4 + 2] * inv * z2, o[d][4 * g4 + 3] * inv * z3);
      *(uint2*)(OG + dv0) = ov;
    }
}

DI void phase_o3(const Params& p, char* smem) {
  AttnSmem* sm = (AttnSmem*)smem;
  const int xcd = blockIdx.x & 7, local = blockIdx.x >> 3, nloc = gridDim.x >> 3;
  for (int j = local; j < 256; j += nloc) {
    int u = xcd * 256 + j;
    attn_item(p, sm, u >> 4, LC + (u & 15) * 128, LALL);
  }
  for (int j = local; j < 32; j += nloc) {
    int u = xcd * 32 + j;
    attn_item(p, sm, u >> 1, (u & 1) * 128, LC);
  }
}

template <int LAYER>
DI void phase_oproj(const Params& p, char* smem) {
  GemmSmem* sm = (GemmSmem*)smem;
  WAVE_IDS
  constexpr int NROWS = LAYER == 0 ? TOK : NLAT;
  const int NT = 8, units = (NROWS / 128) * NT;
  const bfr* Ab = (const bfr*)(p.ws + (LAYER == 0 ? O_OG : O_Y2));
  const bfr* WT = (const bfr*)(p.ws + (LAYER == 0 ? O_WT_OUT0 : O_WT_OUT1));
  float* part = (float*)(p.ws + (LAYER == 0 ? O_PART1 : O_PART2));
  auto Aof = [&](int m0) { return [=](int row, int k) { return Ab + (size_t)(m0 + row) * 1024 + k; }; };
  auto Bof = [&](int n0) { return [=](int row, int k) { return WT + (size_t)(n0 + row) * 1024 + k; }; };
  GSTAGE_DECL;
  if ((int)blockIdx.x < units) {
    const int us = xcd_swz(blockIdx.x, NT);
    gemm_prefetch(GSTAGE_ARGS, Aof((us / NT) * 128), Bof((us % NT) * 128));
  }
  for (int u = blockIdx.x; u < units; u += gridDim.x) {
    const int us = xcd_swz(u, NT);
    int mt = us / NT, nt = us - mt * NT;
    int m0 = mt * 128, n0 = nt * 128;
    f32x16 acc[2][2];
    zero_acc(acc);
    gemm_main(acc, 32, Aof(m0), Bof(n0), sm, GSTAGE_ARGS);
    if (u + (int)gridDim.x < units) {
      const int us1 = xcd_swz(u + gridDim.x, NT);
      gemm_prefetch(GSTAGE_ARGS, Aof((us1 / NT) * 128), Bof((us1 % NT) * 128));
    }
    const float* xin;
    float* xout;
    const float* gt;
    if (LAYER == 0) {
      xin = xrow0(p, m0);
      xout = xrow1(p, m0);
      gt = modrow(p, 0, m0) + 2048;
    } else {
      xin = p.out + (size_t)m0 * 1024;
      xout = p.out + (size_t)m0 * 1024;
      gt = (const float*)(p.ws + O_MOD) + ((size_t)(9 + (m0 >> 11))) * 3072 + 2048;
    }
    {
      float* wl = (float*)sm + wave * 2048;
      const int ccol = n0 + wn * 64 + (lane & 15) * 4;
      const float4 g4 = *(const float4*)(gt + ccol);
#pragma unroll
      for (int mi = 0; mi < 2; ++mi) {
        float4 v[8], xv[8];
#pragma unroll
        for (int c = 0; c < 8; ++c)
          xv[c] = *(const float4*)(xin + (size_t)(wm * 64 + mi * 32 + c * 4 + (lane >> 4)) * 1024 + ccol);
        stage_half(acc, mi, wl, v, lane);
#pragma unroll
        for (int c = 0; c < 8; ++c) {
          int row = wm * 64 + mi * 32 + c * 4 + (lane >> 4);
          float4 o;
          o.x = xv[c].x + g4.x * v[c].x;
          o.y = xv[c].y + g4.y * v[c].y;
          o.z = xv[c].z + g4.z * v[c].z;
          o.w = xv[c].w + g4.w * v[c].w;
          *(float4*)(xout + (size_t)row * 1024 + ccol) = o;
          if (LAYER == 1) {
            float sq = o.x * o.x + o.y * o.y + o.z * o.z + o.w * o.w;
            sq += __shfl_xor(sq, 1);
            sq += __shfl_xor(sq, 2);
            sq += __shfl_xor(sq, 4);
            sq += __shfl_xor(sq, 8);
            if ((lane & 15) == 0) part[(size_t)(nt * 2 + wn) * NROWS + m0 + row] = sq;
          }
        }
      }
      __syncthreads();
    }
  }
  if (LAYER == 0) {
    __syncthreads();
    phase_prep_b(p, smem, units % (int)gridDim.x);
  }
}

DI void phase_o5(const Params& p, char* smem) {
  GemmSmem* sm = (GemmSmem*)smem;
  WAVE_IDS
  const int ULAT = (NLAT / 128) * 16, units = ULAT + (NB * LC / 128) * 8;
  const bfr* WT = (const bfr*)(p.ws + O_WT_IN1);
  bfr* U2 = (bfr*)(p.ws + O_U2);
  bfr* SZ1 = (bfr*)(p.ws + O_SZ1);
  const bfr* Ah = (const bfr*)(p.ws + O_H1);
  auto coords = [&](int u, int& m0, int& n0) {
    if (u < ULAT) {
      const int us = xcd_swz(u, 16);
      int mtl = us >> 4;
      m0 = (mtl >> 4) * LALL + LC + (mtl & 15) * 128;
      n0 = (us & 15) * 128;
    } else {
      const int us = xcd_swz(u - ULAT, 8);
      int mtc = us >> 3;
      m0 = (mtc >> 1) * LALL + (mtc & 1) * 128;
      n0 = (us & 7) * 128;
    }
  };
  auto Aof = [&](int m0) { return [=](int row, int k) { return Ah + (size_t)(m0 + row) * 1024 + k; }; };
  auto Bof = [&](int n0) { return [=](int row, int k) { return WT + (size_t)(n0 + row) * 1024 + k; }; };
  GSTAGE_DECL;
  if ((int)blockIdx.x < units) {
    int m1, n1;
    coords(blockIdx.x, m1, n1);
    gemm_prefetch(GSTAGE_ARGS, Aof(m1), Bof(n1));
  }
  for (int u = blockIdx.x; u < units; u += gridDim.x) {
    int m0, n0;
    coords(u, m0, n0);
    int b = m0 / LALL, pos0 = m0 - b * LALL;
    f32x16 acc[2][2];
    zero_acc(acc);
    gemm_main(acc, 32, Aof(m0), Bof(n0), sm, GSTAGE_ARGS);
    if (u + (int)gridDim.x < units) {
      int m1, n1;
      coords(u + gridDim.x, m1, n1);
      gemm_prefetch(GSTAGE_ARGS, Aof(m1), Bof(n1));
    }
    {
      float* wl = (float*)sm + wave * 2048;
      const int col = n0 + wn * 64 + (lane & 7) * 8;
      const bool isu = col < 1024;
#pragma unroll
      for (int mi = 0; mi < 2; ++mi) {
        float4 lo[4], hi[4];
        stage_half8(acc, mi, wl, lo, hi, lane);
#pragma unroll
        for (int c = 0; c < 4; ++c) {
          int row = wm * 64 + mi * 32 + c * 8 + (lane >> 3);
          int tok = m0 + row;
          uint4 o;
          bfr* dst;
          if (isu) {
            o.x = pk2(lo[c].x, lo[c].y);
            o.y = pk2(lo[c].z, lo[c].w);
            o.z = pk2(hi[c].x, hi[c].y);
            o.w = pk2(hi[c].z, hi[c].w);
            dst = U2 + ((size_t)(col >> 4) * TOK + tok) * 16 + (col & 15);
          } else {
            o.x = pk2(silu_f(lo[c].x), silu_f(lo[c].y));
            o.y = pk2(silu_f(lo[c].z), silu_f(lo[c].w));
            o.z = pk2(silu_f(hi[c].x), silu_f(hi[c].y));
            o.w = pk2(silu_f(hi[c].z), silu_f(hi[c].w));
            dst = SZ1 + ((size_t)(b * SEQ + pos0 + row - LC)) * 1024 + (col - 1024);
          }
          *(uint4*)dst = o;
        }
      }
      __syncthreads();
    }
  }
}

DI void phase_o6(const Params& p, char* smem) {
  GemmSmem* sm = (GemmSmem*)smem;
  WAVE_IDS
  const int NROW = NB * NCH;
  const int units = 64 * 5 * 2;
  const bfr* U2 = (const bfr*)(p.ws + O_U2);
  const bfr* WST = (const bfr*)(p.ws + O_WST);
  float* SLOC = (float*)(p.ws + O_SLOC);
  for (int u = blockIdx.x; u < units; u += gridDim.x) {
    const int us = xcd_swz(u, 10);
    int g = us / 10, rem = us - g * 10;
    int mt = rem >> 1, nt = rem & 1;
    int m0 = mt * 128, n0 = nt * 128;
    const bfr* Ag = U2 + (size_t)g * TOK * 16;
    const bfr* Bg = WST + (size_t)g * 256 * 512;
    f32x16 acc[2][2];
    zero_acc(acc);
    gemm_full(
        acc, 16,
        [&](int row, int k) {
          int rr = m0 + row;
          rr = rr < NROW ? rr : NROW - 1;
          return Ag + (size_t)rr * 512 + k;
        },
        [&](int row, int k) { return Bg + (size_t)(n0 + row) * 512 + k; }, sm);
#pragma unroll
    for (int mi = 0; mi < 2; ++mi)
#pragma unroll
      for (int ni = 0; ni < 2; ++ni) {
        int col = n0 + wn * 64 + ni * 32 + r;
#pragma unroll
        for (int i = 0; i < 16; ++i) {
          int row = m0 + wm * 64 + mi * 32 + crow(i, h);
          SLOC[((size_t)g * SLOC_ROWS + row) * 256 + col] = acc[mi][ni][i];
        }
      }
  }
}

DI void phase_o7(const Params& p) {
  const int tidx_ = opaque_tid();
  const float* SLOC = (const float*)(p.ws + O_SLOC);
  bfr* SIN = (bfr*)(p.ws + O_SIN);
  const int total = NB * 64 * 2 * 64;
  for (int idx = blockIdx.x * 256 + tidx_; idx < total; idx += gridDim.x * 256) {
    int pp = idx & 63, dir = (idx >> 6) & 1, g = (idx >> 7) & 63, b = idx >> 13;
    double dt, ar, ai;
    float fr, fi, lr, li;
    s5_disc(p, dir, g, pp, dt, ar, ai, fr, fi);
    s5_pow(dt, ar, ai, TC, lr, li);
    float sr = 0.f, si = 0.f;
    auto cpos = [&](int step) { return dir == 0 ? step : (step < 8 ? 7 - step : NCH - 1 - (step - 8)); };
    const float* slb = SLOC + ((size_t)g * SLOC_ROWS + b * NCH) * 256 + dir * 128 + pp;
    bfr* sob = SIN + ((size_t)g * (NB * NCHL) + b * NCHL) * 256 + dir * 128 + pp;
#pragma unroll 1
    for (int s0 = 0; s0 < NCH; s0 += 24) {
      float lre[24], lim[24];
#pragma unroll
      for (int j = 0; j < 24; ++j) {
        const float* sl = slb + (size_t)cpos(s0 + j) * 256;
        lre[j] = sl[0];
        lim[j] = sl[64];
      }
#pragma unroll
      for (int j = 0; j < 24; ++j) {
        int cp = cpos(s0 + j);
        if (cp >= 8) {
          bfr* so = sob + (size_t)(cp - 8) * 256;
          so[0] = f2bf(sr);
          so[64] = f2bf(si);
        }
        float nr = lr * sr - li * si + lre[j];
        float ni = lr * si + li * sr + lim[j];
        sr = nr;
        si = ni;
      }
    }
  }
}

DI void phase_o8(const Params& p, char* smem) {
  GemmSmem* sm = (GemmSmem*)smem;
  WAVE_IDS
  const int units = 64 * 4 * 4;
  const bfr* U2 = (const bfr*)(p.ws + O_U2);
  const bfr* SIN = (const bfr*)(p.ws + O_SIN);
  const bfr* KTAB = (const bfr*)(p.ws + O_KTAB);
  const bfr* VOP = (const bfr*)(p.ws + O_VOP);
  bfr* YG = (bfr*)(p.ws + O_YG);
  for (int u = blockIdx.x; u < units; u += gridDim.x) {
    const int us = xcd_swz(u, 16);
    int g = us >> 4, mt = (us >> 2) & 3, nt = us & 3;
    int m0 = mt * 128, n0 = nt * 128;
    const bfr* Ug = U2 + (size_t)g * TOK * 16;
    f32x16 acc[2][2];
    zero_acc(acc);
    gemm_full(
        acc, 16,
        [&](int row, int k) {
          int rr = m0 + row;
          int b = rr >> 6, n = rr & 63;
          return Ug + ((size_t)b * LALL + LC + n * TC) * 16 + k;
        },
        [&](int row, int k) {
          int m = n0 + row;
          int t = m >> 4, c = m & 15;
          return KTAB + (((size_t)g * 63 + (t + 31)) * 16 + c) * 16 - (k >> 4) * 256 + (k & 15);
        },
        sm);
    gemm_full(
        acc, 8, [&](int row, int k) { return SIN + ((size_t)g * (NB * NCHL) + m0 + row) * 256 + k; },
        [&](int row, int k) { return VOP + ((size_t)g * 512 + n0 + row) * 256 + k; }, sm);
    {
      float* wl = (float*)sm + wave * 2048;
      const int mcol = n0 + wn * 64 + (lane & 7) * 8;
      const int t = mcol >> 4, c0 = mcol & 15;
      const int ch = g * 16 + c0;
      const float4 d0 = *(const float4*)(p.in[I_S5D] + ch), d1 = *(const float4*)(p.in[I_S5D] + ch + 4);
#pragma unroll
      for (int mi = 0; mi < 2; ++mi) {
        float4 lo[4], hi[4];
        stage_half8(acc, mi, wl, lo, hi, lane);
        uint4 uq[4];
#pragma unroll
        for (int c = 0; c < 4; ++c) {
          int rr = m0 + wm * 64 + mi * 32 + c * 8 + (lane >> 3);
          int b = rr >> 6, n = rr & 63;
          uq[c] = *(const uint4*)(Ug + ((size_t)b * LALL + LC + n * TC + t) * 16 + c0);
        }
        SCHED_FENCE();
#pragma unroll
        for (int c = 0; c < 4; ++c) {
          int rr = m0 + wm * 64 + mi * 32 + c * 8 + (lane >> 3);
          int b = rr >> 6, n = rr & 63;
          float4 u0 = bf4_to_f4(make_uint2(uq[c].x, uq[c].y)), u1 = bf4_to_f4(make_uint2(uq[c].z, uq[c].w));
          uint4 o;
          o.x = pk2(gelu_tanh(lo[c].x + d0.x * u0.x), gelu_tanh(lo[c].y + d0.y * u0.y));
          o.y = pk2(gelu_tanh(lo[c].z + d0.z * u0.z), gelu_tanh(lo[c].w + d0.w * u0.w));
          o.z = pk2(gelu_tanh(hi[c].x + d1.x * u1.x), gelu_tanh(hi[c].y + d1.y * u1.y));
          o.w = pk2(gelu_tanh(hi[c].z + d1.z * u1.z), gelu_tanh(hi[c].w + d1.w * u1.w));
          *(uint4*)(YG + ((size_t)(b * SEQ + n * TC + t)) * 1024 + ch) = o;
        }
        SCHED_FENCE();
      }
      __syncthreads();
    }
  }
}

DI void phase_o9(const Params& p, char* smem) {
  GemmSmem* sm = (GemmSmem*)smem;
  WAVE_IDS
  const int NT = 8, units = (NLAT / 128) * NT;
  const bfr* YG = (const bfr*)(p.ws + O_YG);
  const bfr* SZ1 = (const bfr*)(p.ws + O_SZ1);
  const bfr* WT = (const bfr*)(p.ws + O_WT_GLU);
  bfr* Y2 = (bfr*)(p.ws + O_Y2);
  auto Aof = [&](int m0) { return [=](int row, int k) { return YG + (size_t)(m0 + row) * 1024 + k; }; };
  auto Bof = [&](int n0) { return [=](int row, int k) { return WT + (size_t)(n0 + row) * 1024 + k; }; };
  GSTAGE_DECL;
  if ((int)blockIdx.x < units) {
    const int us = xcd_swz(blockIdx.x, NT);
    gemm_prefetch(GSTAGE_ARGS, Aof((us / NT) * 128), Bof((us % NT) * 128));
  }
  for (int u = blockIdx.x; u < units; u += gridDim.x) {
    const int us = xcd_swz(u, NT);
    int mt = us / NT, nt = us - mt * NT;
    int m0 = mt * 128, n0 = nt * 128;
    f32x16 acc[2][2];
    zero_acc(acc);
    gemm_main(acc, 32, Aof(m0), Bof(n0), sm, GSTAGE_ARGS);
    if (u + (int)gridDim.x < units) {
      const int us1 = xcd_swz(u + gridDim.x, NT);
      gemm_prefetch(GSTAGE_ARGS, Aof((us1 / NT) * 128), Bof((us1 % NT) * 128));
    }
    float* wl = (float*)sm + wave * 2048;
    const int ccol = n0 + wn * 64 + (lane & 7) * 8;
    const float4 bg0 = *(const float4*)(p.in[I_BGLU] + ccol), bg1 = *(const float4*)(p.in[I_BGLU] + ccol + 4);
#pragma unroll
    for (int mi = 0; mi < 2; ++mi) {
      float4 lo[4], hi[4];
      stage_half8(acc, mi, wl, lo, hi, lane);
      uint4 yv[4], zv[4];
#pragma unroll
      for (int c = 0; c < 4; ++c) {
        size_t o = (size_t)(m0 + wm * 64 + mi * 32 + c * 8 + (lane >> 3)) * 1024 + ccol;
        yv[c] = *(const uint4*)(YG + o);
        zv[c] = *(const uint4*)(SZ1 + o);
      }
      SCHED_FENCE();
#pragma unroll
      for (int c = 0; c < 4; ++c) {
        size_t o = (size_t)(m0 + wm * 64 + mi * 32 + c * 8 + (lane >> 3)) * 1024 + ccol;
        float4 y0 = bf4_to_f4(make_uint2(yv[c].x, yv[c].y)), y1 = bf4_to_f4(make_uint2(yv[c].z, yv[c].w));
        float4 z0 = bf4_to_f4(make_uint2(zv[c].x, zv[c].y)), z1 = bf4_to_f4(make_uint2(zv[c].z, zv[c].w));
        uint4 ov;
        ov.x = pk2(y0.x * sigmoid_f(lo[c].x + bg0.x) * z0.x, y0.y * sigmoid_f(lo[c].y + bg0.y) * z0.y);
        ov.y = pk2(y0.z * sigmoid_f(lo[c].z + bg0.z) * z0.z, y0.w * sigmoid_f(lo[c].w + bg0.w) * z0.w);
        ov.z = pk2(y1.x * sigmoid_f(hi[c].x + bg1.x) * z1.x, y1.y * sigmoid_f(hi[c].y + bg1.y) * z1.y);
        ov.w = pk2(y1.z * sigmoid_f(hi[c].z + bg1.z) * z1.z, y1.w * sigmoid_f(hi[c].w + bg1.w) * z1.w);
        *(uint4*)(Y2 + o) = ov;
      }
      SCHED_FENCE();
    }
    __syncthreads();
  }
}

#define XB_TMO      128
#define XB_XCNT(j)  (256  + 64 * (j))
#define XB_XSUB(j)  (1280 + 64 * (j))
#define XB_XGEN(j)  (2304 + 64 * (j))
#define XB_TOP      3328
#define XB_TOPGEN   3392
#define XCD_BAR_WORDS 3456
#define XB_SPIN_CAP (1u << 18)
#define LAS __attribute__((address_space(3)))
DI unsigned xb_ld(unsigned* p) { return __hip_atomic_load(p, __ATOMIC_RELAXED, __HIP_MEMORY_SCOPE_AGENT); }
DI unsigned xb_add(unsigned* p, unsigned v) { return __hip_atomic_fetch_add(p, v, __ATOMIC_RELAXED, __HIP_MEMORY_SCOPE_AGENT); }
DI unsigned xb_xcc_id() { return (unsigned)__builtin_amdgcn_s_getreg((3 << 11) | 20) & 0xFu; }
#define XB_SPIN(cond, bar) do { unsigned _sp = 0; while (cond) { __builtin_amdgcn_s_sleep(1); \
    if ((++_sp & 255u) == 0u) { if (xb_ld(&(bar)[XB_TMO])) break; if (_sp > XB_SPIN_CAP) { atomicAdd(&(bar)[XB_TMO], 1u); break; } } } } while (0)
struct XcdBarrier {
  unsigned* bar;
  unsigned x;
  volatile LAS unsigned* st;
};
DI XcdBarrier xcd_barrier_post(unsigned* bar, volatile LAS unsigned* st) {
  XcdBarrier b;
  b.bar = bar;
  b.x = xb_xcc_id();
  b.st = st;
  if (threadIdx.x == 0) (void)xb_add(&bar[XB_XCNT(b.x)], 1u);
  return b;
}
DI void xcd_barrier_complete(unsigned* bar, unsigned x, unsigned& nloc, unsigned& nx) {
  const unsigned G = gridDim.x * gridDim.y * gridDim.z;
  unsigned sum, cnt, mine, sp = 0u;
  for (;;) {
    sum = 0u; cnt = 0u; mine = 0u;
#pragma unroll
    for (unsigned j = 0; j < 16; ++j) {
      const unsigned c = xb_ld(&bar[XB_XCNT(j)]);
      sum += c;
      cnt += (c > 0u) ? 1u : 0u;
      mine = (j == x) ? c : mine;
    }
    if (sum == G) break;
    __builtin_amdgcn_s_sleep(1);
    if ((++sp & 255u) == 0u) {
      if (xb_ld(&bar[XB_TMO])) break;
      if (sp > XB_SPIN_CAP) { atomicAdd(&bar[XB_TMO], 1u); break; }
    }
  }
  nloc = mine > 0u ? mine : 1u;
  nx = cnt > 0u ? cnt : 1u;
}
DI void xcd_barrier(const XcdBarrier& b) {
  asm volatile("s_waitcnt vmcnt(0)" ::: "memory");
  __syncthreads();
  if (threadIdx.x == 0) {
    unsigned* bar = b.bar;
    __builtin_amdgcn_s_waitcnt(0);
    unsigned nloc = b.st[0], nx = b.st[1];
    if (nloc == 0u) {
      xcd_barrier_complete(bar, b.x, nloc, nx);
      b.st[0] = nloc;
      b.st[1] = nx;
    }
    const unsigned old = xb_add(&bar[XB_XSUB(b.x)], 1u);
    const unsigned gen = old / nloc;
    if (old + 1u == (gen + 1u) * nloc) {
      __builtin_amdgcn_fence(__ATOMIC_RELEASE, "agent");
      asm volatile("s_waitcnt vmcnt(0)" ::: "memory");
      const unsigned og = xb_add(&bar[XB_TOP], 1u);
      const unsigned tg = og / nx;
      if (og + 1u == (tg + 1u) * nx) xb_add(&bar[XB_TOPGEN], 1u);
      else XB_SPIN(xb_ld(&bar[XB_TOPGEN]) == tg, bar);
      __builtin_amdgcn_fence(__ATOMIC_ACQUIRE, "agent");
      xb_add(&bar[XB_XGEN(b.x)], 1u);
      asm volatile("s_waitcnt vmcnt(0)" ::: "memory");
    } else {
      XB_SPIN(xb_ld(&bar[XB_XGEN(b.x)]) == gen, bar);
      __builtin_amdgcn_fence(__ATOMIC_ACQUIRE, "agent");
      asm volatile("s_waitcnt vmcnt(0)" ::: "memory");
    }
  }
  __syncthreads();
}

DI void run_phase(const Params& p, int ph, char* smem) {
  switch (ph) {
#if !defined(ONLY) || ONLY == 0
    case PH_PREP: phase_prep(p, smem); break;
#endif
#if !defined(ONLY) || ONLY == 1
    case PH_FINAL: phase_final(p); break;
#endif
#if !defined(ONLY) || ONLY == 2
    case PH_O1: phase_o1(p, smem); break;
#endif
#if !defined(ONLY) || ONLY == 3
    case PH_O2: phase_o2(p, smem); break;
#endif
#if !defined(ONLY) || ONLY == 4
    case PH_O3: phase_o3(p, smem); break;
#endif
#if !defined(ONLY) || ONLY == 5
    case PH_O4: phase_oproj<0>(p, smem); break;
#endif
#if !defined(ONLY) || ONLY == 6
    case PH_O5: phase_o5(p, smem); break;
#endif
#if !defined(ONLY) || ONLY == 7
    case PH_O6: phase_o6(p, smem); break;
#endif
#if !defined(ONLY) || ONLY == 8
    case PH_O7: phase_o7(p); break;
#endif
#if !defined(ONLY) || ONLY == 9
    case PH_O8: phase_o8(p, smem); break;
#endif
#if !defined(ONLY) || ONLY == 10
    case PH_O9: phase_o9(p, smem); break;
#endif
#if !defined(ONLY) || ONLY == 11
    case PH_O10: phase_oproj<1>(p, smem); break;
#endif
    case PH_H0: phase_hconv<0>(p); break;
    case PH_H1: phase_hconv<1>(p); break;
    default: break;
  }
}

__global__ void __launch_bounds__(256, 2) mega_one(Params p, int ph) {
  __shared__ __attribute__((aligned(16))) char smem[SMEM_BYTES];
  run_phase(p, ph, smem);
}

#if !defined(ONLY) && SINGLE_LAUNCH
__global__ void __launch_bounds__(256, 2) mega(Params p) {
  __shared__ __attribute__((aligned(16))) char smem[SMEM_BYTES];
  __shared__ uint4 xb_words;
  if (threadIdx.x == 0) xb_words = make_uint4(0u, 0u, 0u, 0u);
  __syncthreads();
  if (p.nprog < 0) cg::this_grid().sync();
  const XcdBarrier xb = xcd_barrier_post((unsigned*)(p.ws + O_BAR), (volatile LAS unsigned*)&xb_words);
  cg::grid_group grid = cg::this_grid();
#if !defined(OMIT) || OMIT != 0
  phase_prep(p, smem);
#endif
  xcd_barrier(xb);
#if (DUP >> 0) & 1
  phase_prep(p, smem);
  xcd_barrier(xb);
#endif
  phase_hconv<0>(p);
  xcd_barrier(xb);
#if !defined(OMIT) || OMIT != 1
  phase_o1(p, smem);
#endif
  xcd_barrier(xb);
#if (DUP >> 1) & 1
  phase_o1(p, smem);
  xcd_barrier(xb);
#endif
#if !defined(OMIT) || OMIT != 2
  phase_o2(p, smem);
#endif
  xcd_barrier(xb);
#if (DUP >> 2) & 1
  phase_o2(p, smem);
  xcd_barrier(xb);
#endif
#if !defined(OMIT) || OMIT != 3
  phase_o3(p, smem);
#endif
  xcd_barrier(xb);
#if (DUP >> 3) & 1
  phase_o3(p, smem);
  xcd_barrier(xb);
#endif
#if !defined(OMIT) || OMIT != 4
  phase_oproj<0>(p, smem);
#endif
  xcd_barrier(xb);
#if (DUP >> 4) & 1
  phase_oproj<0>(p, smem);
  xcd_barrier(xb);
#endif
  phase_hconv<1>(p);
  xcd_barrier(xb);
#if !defined(OMIT) || OMIT != 5
  phase_o5(p, smem);
#endif
  xcd_barrier(xb);
#if (DUP >> 5) & 1
  phase_o5(p, smem);
  xcd_barrier(xb);
#endif
#if !defined(OMIT) || OMIT != 6
  phase_o6(p, smem);
#endif
  xcd_barrier(xb);
#if (DUP >> 6) & 1
  phase_o6(p, smem);
  xcd_barrier(xb);
#endif
#if !defined(OMIT) || OMIT != 7
  phase_o7(p);
#endif
  xcd_barrier(xb);
#if (DUP >> 7) & 1
  phase_o7(p);
  xcd_barrier(xb);
#endif
#if !defined(OMIT) || OMIT != 8
  phase_o8(p, smem);
#endif
  xcd_barrier(xb);
#if (DUP >> 8) & 1
  phase_o8(p, smem);
  xcd_barrier(xb);
#endif
#if !defined(OMIT) || OMIT != 9
  phase_o9(p, smem);
#endif
  xcd_barrier(xb);
#if (DUP >> 9) & 1
  phase_o9(p, smem);
  xcd_barrier(xb);
#endif
#if !defined(OMIT) || OMIT != 10
  phase_oproj<1>(p, smem);
#endif
  xcd_barrier(xb);
#if !defined(OMIT) || OMIT != 11
  phase_final(p);
#endif
}
#else
__global__ void mega(Params p) {}
#endif


extern "C" void kernel_launch(void* const* d_in, const int* in_sizes, int n_in, void* d_out, int out_size, void* d_ws,
                              size_t ws_size, hipStream_t stream) {
  static int grid_blocks = 0;
  if (!grid_blocks) {
    int dev = 0, cus = 0, per_cu = 0;
    hipGetDevice(&dev);
    hipDeviceGetAttribute(&cus, hipDeviceAttributeMultiprocessorCount, dev);
#if SINGLE_LAUNCH
    hipOccupancyMaxActiveBlocksPerMultiprocessor(&per_cu, mega, 256, 0);
#else
    hipOccupancyMaxActiveBlocksPerMultiprocessor(&per_cu, mega_one, 256, 0);
#endif
    if (per_cu < 1) per_cu = 1;
    if (per_cu > 2) per_cu = 2;
    grid_blocks = cus * per_cu;
  }
  if (ws_size < WS_NEED || n_in < N_INPUTS) {
    fprintf(stderr, "workspace too small or bad inputs: %zu < %zu\n", ws_size, (size_t)WS_NEED);
    return;
  }
  Params p{};
  for (int i = 0; i < N_INPUTS; ++i) p.in[i] = (const float*)d_in[i];
  p.out = (float*)d_out;
  p.ws = (char*)d_ws;
#ifndef PROG
#define PROG PH_PREP, PH_H0, PH_O1, PH_O2, PH_O3, PH_O4, PH_H1, PH_O5, PH_O6, PH_O7, PH_O8, PH_O9, PH_O10, PH_FINAL
#endif
  const int prog[] = {PROG};
  p.nprog = (int)(sizeof(prog) / sizeof(int));
  for (int i = 0; i < p.nprog; ++i) p.prog[i] = prog[i];
#if SINGLE_LAUNCH
  hipMemsetAsync((char*)d_ws + O_BAR, 0, BAR_BYTES, stream);
  void* args[] = {&p};
  hipError_t e = hipLaunchCooperativeKernel((void*)mega, dim3(grid_blocks), dim3(256), args, 0, stream);
  if (e != hipSuccess) fprintf(stderr, "cooperative launch failed: %s (grid %d)\n", hipGetErrorString(e), grid_blocks);
#else
  for (int i = 0; i < p.nprog; ++i) {
    mega_one<<<dim3(grid_blocks), dim3(256), 0, stream>>>(p, p.prog[i]);
  }
#endif
}
```

```cpp
#include <hip/hip_runtime.h>
#include <hip/hip_cooperative_groups.h>
#include <cstdio>
namespace cg = cooperative_groups;
#ifndef DUP
#define DUP 0
#endif
#ifndef USE_NAIVE
#define USE_NAIVE 0
#endif
#ifndef SINGLE_LAUNCH
#define SINGLE_LAUNCH 1
#endif

#define DI __device__ __forceinline__
typedef unsigned short bfr;

constexpr int D = 1024, NB = 8, SEQ = 2048, LC = 256, LALL = 2304;
constexpr int TOK = NB * LALL;
constexpr int NLAT = NB * SEQ;
constexpr int NH = 16, DQK = 96, DV = 64;
constexpr int NIN0 = 1440, NIN1 = 2048;
constexpr float EPS = 1e-6f;
constexpr float QSCALE = 0.10206207261596577f * 1.4426950408889634f;
constexpr int TC = 32;
constexpr int NCH = LALL / TC;
constexpr int NCHL = SEQ / TC;

enum { I_X = 0, I_C, I_CTX, I_CCTX, I_ADAW, I_ADAB, I_NORMG, I_WIN0, I_QNORM, I_WUQ, I_KVNORM, I_WUKV, I_WOUT0,
       I_WIN1, I_ARE, I_AIM, I_LOGSTEP, I_BRE, I_BIM, I_CRE, I_CIM, I_S5D, I_WGLU, I_BGLU, I_WOUT1, I_FINALG, N_INPUTS };

constexpr size_t al256(size_t x) { return (x + 255) & ~(size_t)255; }
constexpr size_t O_WT_IN0 = 0;
constexpr size_t O_WT_UQ = O_WT_IN0 + al256((size_t)NIN0 * 1024 * 2);
constexpr size_t O_WT_UKV = O_WT_UQ + al256((size_t)1536 * 256 * 2);
constexpr size_t O_WT_OUT0 = O_WT_UKV + al256((size_t)2048 * 128 * 2);
constexpr size_t O_WT_IN1 = O_WT_OUT0 + al256((size_t)1024 * 1024 * 2);
constexpr size_t O_WT_GLU = O_WT_IN1 + al256((size_t)2048 * 1024 * 2);
constexpr size_t O_WT_OUT1 = O_WT_GLU + al256((size_t)1024 * 1024 * 2);
constexpr size_t O_MOD = O_WT_OUT1 + al256((size_t)1024 * 1024 * 2);
constexpr size_t O_RS0 = O_MOD + al256((size_t)2 * 9 * 3072 * 4);
constexpr size_t O_PART1 = O_RS0 + al256((size_t)TOK * 4);
constexpr size_t O_PART2 = O_PART1 + al256((size_t)16 * TOK * 4);
constexpr size_t O_X1CTX = O_PART2 + al256((size_t)16 * NLAT * 4);
constexpr size_t O_KTAB = O_X1CTX + al256((size_t)NB * LC * 1024 * 4);
constexpr size_t O_WST = O_KTAB + al256((size_t)64 * 63 * 256 * 2);
constexpr size_t O_VOP = O_WST + al256((size_t)64 * 256 * 512 * 2);
constexpr size_t O_BAR = O_VOP + al256((size_t)64 * 512 * 256 * 2);
constexpr size_t BAR_BYTES = 3456 * 4;
constexpr size_t O_LAYER = O_BAR + al256(BAR_BYTES);
constexpr size_t O_PC = O_LAYER;
constexpr size_t O_SZ0 = O_PC + al256((size_t)TOK * 384 * 2);
constexpr size_t O_K = O_SZ0 + al256((size_t)TOK * 1024 * 2);
constexpr size_t O_VT = O_K + al256((size_t)NB * NH * LALL * 64 * 2);
constexpr size_t O_OG = O_VT + al256((size_t)NB * NH * DV * LALL * 2);
constexpr size_t O_KR = O_OG + al256((size_t)TOK * 1024 * 2);
constexpr size_t O_END0 = O_KR + al256((size_t)TOK * 32 * 2);
constexpr size_t O_H0 = O_OG;
constexpr size_t O_U2 = O_LAYER;
constexpr size_t O_SZ1 = O_U2 + al256((size_t)64 * TOK * 16 * 2);
constexpr size_t O_SLOC = O_SZ1 + al256((size_t)NLAT * 1024 * 2);
constexpr int SLOC_ROWS = 640;
constexpr size_t O_SIN = O_SLOC + al256((size_t)64 * SLOC_ROWS * 256 * 4);
constexpr size_t O_YG = O_SIN + al256((size_t)64 * (NB * NCHL) * 256 * 2);
constexpr size_t O_H1 = O_YG + al256((size_t)NLAT * 1024 * 2);
constexpr size_t O_END1 = O_H1 + al256((size_t)TOK * 1024 * 2);
constexpr size_t O_Y2 = O_SLOC;
constexpr size_t WS_NEED = (O_END0 > O_END1 ? O_END0 : O_END1);
static_assert(WS_NEED <= (size_t)256 * 1024 * 1024, "workspace too large");
static_assert((size_t)NB * NH * LALL * DQK * 2 <= (size_t)NLAT * 1024 * 4, "Q does not fit d_out");

struct Params {
  const float* in[N_INPUTS];
  float* out;
  char* ws;
  int prog[32];
  int nprog;
  int pad;
};

DI bfr f2bf(float x) {
  unsigned u = __float_as_uint(x);
  u += 0x7fffu + ((u >> 16) & 1u);
  return (bfr)(u >> 16);
}
typedef __bf16 bf2_t __attribute__((ext_vector_type(2)));
typedef float f2_t __attribute__((ext_vector_type(2)));
DI unsigned pk2(float a, float b) {
  f2_t v = {a, b};
  bf2_t r = __builtin_convertvector(v, bf2_t);
  return __builtin_bit_cast(unsigned, r);
}
DI int opaque_tid() {
  int t = threadIdx.x;
  asm volatile("" : "+v"(t));
  return t;
}
DI float bf2f(bfr b) { return __uint_as_float(((unsigned)b) << 16); }
DI float silu_f(float v) { return v / (1.f + __expf(-v)); }
DI float sigmoid_f(float v) { return 1.f / (1.f + __expf(-v)); }
DI float gelu_tanh(float v) {
  float u = 0.7978845608028654f * (v + 0.044715f * v * v * v);
  return 0.5f * v * (1.f + tanhf(u));
}
DI float wave_sum(float v) {
#pragma unroll
  for (int o = 32; o > 0; o >>= 1) v += __shfl_xor(v, o);
  return v;
}
DI float wave_max(float v) {
#pragma unroll
  for (int o = 32; o > 0; o >>= 1) v = fmaxf(v, __shfl_xor(v, o));
  return v;
}
DI const float* xrow0(const Params& p, int tok) {
  int b = tok / LALL, pos = tok - b * LALL;
  return pos < LC ? p.in[I_CTX] + ((size_t)(b * LC + pos)) * D : p.in[I_X] + ((size_t)(b * SEQ + pos - LC)) * D;
}
DI float* xrow1(const Params& p, int tok) {
  int b = tok / LALL, pos = tok - b * LALL;
  return pos < LC ? (float*)(p.ws + O_X1CTX) + ((size_t)(b * LC + pos)) * D : p.out + ((size_t)(b * SEQ + pos - LC)) * D;
}
DI const float* modrow(const Params& p, int layer, int tok) {
  int b = tok / LALL, pos = tok - b * LALL;
  int r = pos < LC ? 8 : b;
  return (const float*)(p.ws + O_MOD) + ((size_t)(layer * 9 + r)) * 3072;
}
DI void rope_cs(int fi, int posv, float& cs, float& sn) {
  float inv = __builtin_amdgcn_exp2f(-(float)fi * (13.287712379549449f / 8.f));
  float rev = (float)posv * inv * 0.15915494309189535f;
  rev -= floorf(rev);
  sn = __builtin_amdgcn_sinf(rev);
  cs = __builtin_amdgcn_cosf(rev);
}
DI float rope_apply(int j, float v, float vp, int lpos) {
  int posv = (j & 16) ? (lpos & 63) : (lpos >> 6);
  float cs, sn;
  rope_cs(j & 7, posv, cs, sn);
  return (j & 8) ? (vp * sn + v * cs) : (v * cs - vp * sn);
}

DI void s5_disc(const Params& p, int dir, int g, int pp, double& dt, double& ar, double& ai, float& fr, float& fi) {
  dt = exp((double)p.in[I_LOGSTEP][dir * 64 + g]);
  ar = (double)p.in[I_ARE][(dir * 64 + g) * 64 + pp];
  ai = (double)p.in[I_AIM][(dir * 64 + g) * 64 + pp];
  double mag = exp(ar * dt);
  double a = ai * dt;
  a -= 6.283185307179586 * rint(a * 0.15915494309189535);
  float sn, cs;
  sincosf((float)a, &sn, &cs);
  double lr = mag * (double)cs, li = mag * (double)sn;
  double den = ar * ar + ai * ai, nr = lr - 1.0;
  fr = (float)((nr * ar + li * ai) / den);
  fi = (float)((li * ar - nr * ai) / den);
}
DI void s5_pow(double dt, double ar, double ai, int k, float& wr, float& wi) {
  double mag = exp(ar * dt * (double)k);
  double a = ai * dt * (double)k;
  a -= 6.283185307179586 * rint(a * 0.15915494309189535);
  float sn, cs;
  sincosf((float)a, &sn, &cs);
  wr = (float)mag * cs;
  wi = (float)mag * sn;
}

enum { PH_PREP = 0, PH_N1, PH_N2, PH_N3, PH_N4, PH_N4B, PH_N5, PH_N6A, PH_N6B, PH_N9, PH_N10, PH_N10B, PH_FINAL,
       PH_O1, PH_O2, PH_O3, PH_O4, PH_O5, PH_O6, PH_O7, PH_O8, PH_O9, PH_O10, PH_H0, PH_H1, PH_COUNT };

constexpr int SMEM_BYTES = 48 * 1024;


DI void prep_transpose(const Params& p, int widx, int tile, char* smem) {
  const int tidx_ = opaque_tid();
  int K, N;
  size_t dst;
  const float* W;
  const float* scl = nullptr;
  switch (widx) {
    case 0: W = p.in[I_WIN0]; K = 1024; N = NIN0; dst = O_WT_IN0; break;
    case 1: W = p.in[I_WUQ]; K = 256; N = 1536; dst = O_WT_UQ; scl = p.in[I_QNORM]; break;
    case 2: W = p.in[I_WUKV]; K = 128; N = 2048; dst = O_WT_UKV; scl = p.in[I_KVNORM]; break;
    case 3: W = p.in[I_WOUT0]; K = 1024; N = 1024; dst = O_WT_OUT0; break;
    case 4: W = p.in[I_WIN1]; K = 1024; N = NIN1; dst = O_WT_IN1; break;
    case 5: W = p.in[I_WGLU]; K = 1024; N = 1024; dst = O_WT_GLU; break;
    default: W = p.in[I_WOUT1]; K = 1024; N = 1024; dst = O_WT_OUT1; break;
  }
  float (*t)[33] = (float (*)[33])smem;
  int ntn = N / 32;
  int kt = tile / ntn, nt = tile - kt * ntn;
  int tx = tidx_ & 31, ty = tidx_ >> 5;
  float v[16];
#pragma unroll
  for (int i = 0; i < 16; ++i) {
    int k = kt * 128 + ty + 8 * i, n = nt * 32 + tx;
    v[i] = W[(size_t)k * N + n];
  }
  if (scl) {
#pragma unroll
    for (int i = 0; i < 16; ++i) v[i] *= scl[kt * 128 + ty + 8 * i];
  }
#pragma unroll
  for (int i = 0; i < 16; ++i) t[ty + 8 * i][tx] = v[i];
  __syncthreads();
  bfr* Wt = (bfr*)(p.ws + dst);
  {
    int nl = tidx_ >> 3, kc = (tidx_ & 7) * 16;
    unsigned w[8];
#pragma unroll
    for (int j = 0; j < 8; ++j) w[j] = pk2(t[kc + 2 * j][nl], t[kc + 2 * j + 1][nl]);
    uint4* dstp = (uint4*)(Wt + (size_t)(nt * 32 + nl) * K + kt * 128 + kc);
    dstp[0] = make_uint4(w[0], w[1], w[2], w[3]);
    dstp[1] = make_uint4(w[4], w[5], w[6], w[7]);
  }
  __syncthreads();
}

DI void prep_mod(const Params& p, int unit, char* smem) {
  const int tidx_ = opaque_tid();
  int layer = unit / 192, cgp = unit - layer * 192;
  float* sil = (float*)smem;
  float* red = sil + 9 * 1024;
  for (int i = tidx_; i < 9 * 1024; i += 256) {
    int r = i >> 10, k = i & 1023;
    float v = r < 8 ? p.in[I_C][r * 1024 + k] : p.in[I_CCTX][k];
    sil[i] = silu_f(v);
  }
  __syncthreads();
  int nn = tidx_ & 15, kg = tidx_ >> 4;
  int n = cgp * 16 + nn;
  const float* W = p.in[I_ADAW] + (size_t)layer * 1024 * 3072 + n;
  float acc[9];
#pragma unroll
  for (int r = 0; r < 9; ++r) acc[r] = 0.f;
#pragma unroll 1
  for (int k0 = kg * 64; k0 < kg * 64 + 64; k0 += 32) {
    float wv[32];
#pragma unroll
    for (int j = 0; j < 32; ++j) wv[j] = W[(size_t)(k0 + j) * 3072];
#pragma unroll
    for (int j = 0; j < 32; ++j) {
#pragma unroll
      for (int r = 0; r < 9; ++r) acc[r] += sil[r * 1024 + k0 + j] * wv[j];
    }
  }
#pragma unroll
  for (int r = 0; r < 9; ++r) red[(kg * 9 + r) * 16 + nn] = acc[r];
  __syncthreads();
  if (tidx_ < 144) {
    int r = tidx_ >> 4, c = tidx_ & 15;
    int nc = cgp * 16 + c;
    float s = p.in[I_ADAB][layer * 3072 + nc];
#pragma unroll
    for (int g = 0; g < 16; ++g) s += red[(g * 9 + r) * 16 + c];
    ((float*)(p.ws + O_MOD))[((size_t)(layer * 9 + r)) * 3072 + nc] = s;
  }
  __syncthreads();
}

DI void prep_ktab(const Params& p, int unit, char* smem) {
  const int tidx_ = opaque_tid();
  int g = unit / 7, lg = unit - g * 7;
  float2* E = (float2*)smem;
  int tid = tidx_;
  const bool use_f = lg >= 3, use_r = lg <= 3;
  for (int i = tid; i < 9 * 128; i += 256) {
    int l = i >> 7, dir = (i >> 6) & 1, pp = i & 63;
    int lag = lg * 9 + l - 31;
    bool used = (dir == 0) ? (lag >= 0) : (lag <= 0);
    float2 e = make_float2(0.f, 0.f);
    if (used) {
      double dt, ar, ai;
      float fr, fi, wr, wi;
      s5_disc(p, dir, g, pp, dt, ar, ai, fr, fi);
      s5_pow(dt, ar, ai, lag < 0 ? -lag : lag, wr, wi);
      e.x = wr * fr - wi * fi;
      e.y = wr * fi + wi * fr;
    }
    E[(l * 2 + dir) * 64 + pp] = e;
  }
  float* PB = (float*)(E + 9 * 128);
  for (int dir = 0; dir < 2; ++dir) {
    if (dir == 0 ? !use_f : !use_r) continue;
    const float4* s0 = (const float4*)(p.in[I_BRE] + ((size_t)(dir * 64 + g)) * 1024);
    const float4* s1 = (const float4*)(p.in[I_BIM] + ((size_t)(dir * 64 + g)) * 1024);
    const float4* s2 = (const float4*)(p.in[I_CRE] + ((size_t)(dir * 64 + g)) * 1024);
    const float4* s3 = (const float4*)(p.in[I_CIM] + ((size_t)(dir * 64 + g)) * 1024);
    float4* d = (float4*)(PB + dir * 4096);
    d[tid] = s0[tid];
    d[256 + tid] = s1[tid];
    d[512 + tid] = s2[tid];
    d[768 + tid] = s3[tid];
  }
  __syncthreads();
  int c = tid >> 4, c2 = tid & 15;
  float acc[9];
#pragma unroll
  for (int l = 0; l < 9; ++l) acc[l] = 0.f;
  for (int dir = 0; dir < 2; ++dir) {
    if (dir == 0 ? !use_f : !use_r) continue;
    const float* bre = PB + dir * 4096;
    const float* bim = bre + 1024;
    const float* cre = bre + 2048;
    const float* cim = bre + 3072;
#pragma unroll 4
    for (int pp = 0; pp < 64; ++pp) {
      float br = bre[pp * 16 + c2], bi = bim[pp * 16 + c2];
      float cr = cre[c * 64 + pp], ci = cim[c * 64 + pp];
      float mr = cr * br - ci * bi, mi = cr * bi + ci * br;
#pragma unroll
      for (int l = 0; l < 9; ++l) {
        float2 e = E[(l * 2 + dir) * 64 + pp];
        acc[l] += mr * e.x - mi * e.y;
      }
    }
  }
  bfr* KT = (bfr*)(p.ws + O_KTAB);
#pragma unroll
  for (int l = 0; l < 9; ++l) KT[(((size_t)g * 63 + lg * 9 + l) * 16 + c) * 16 + c2] = f2bf(acc[l]);
  __syncthreads();
}

DI void prep_ops(const Params& p, int unit) {
  const int tidx_ = opaque_tid();
  int idx = unit * 256 + tidx_;
  int pp = idx & 63, t = (idx >> 6) & 31, dir = (idx >> 11) & 1, g = idx >> 12;
  double dt, ar, ai;
  float fr, fi, wr, wi;
  s5_disc(p, dir, g, pp, dt, ar, ai, fr, fi);
  s5_pow(dt, ar, ai, dir == 0 ? (TC - 1 - t) : t, wr, wi);
  float er = wr * fr - wi * fi, ei = wr * fi + wi * fr;
  const float* bre = p.in[I_BRE] + (((size_t)(dir * 64 + g)) * 64 + pp) * 16;
  const float* bim = p.in[I_BIM] + (((size_t)(dir * 64 + g)) * 64 + pp) * 16;
  bfr* wst = (bfr*)(p.ws + O_WST) + (size_t)g * 256 * 512;
  bfr* rre = wst + (size_t)(dir * 128 + pp) * 512 + t * 16;
  bfr* rim = wst + (size_t)(dir * 128 + 64 + pp) * 512 + t * 16;
#pragma unroll
  for (int c2 = 0; c2 < 16; ++c2) {
    float br = bre[c2], bi = bim[c2];
    rre[c2] = f2bf(er * br - ei * bi);
    rim[c2] = f2bf(er * bi + ei * br);
  }
  s5_pow(dt, ar, ai, dir == 0 ? (t + 1) : (TC - t), wr, wi);
  const float* cre = p.in[I_CRE] + ((size_t)(dir * 64 + g)) * 16 * 64;
  const float* cim = p.in[I_CIM] + ((size_t)(dir * 64 + g)) * 16 * 64;
  bfr* vop = (bfr*)(p.ws + O_VOP) + (size_t)g * 512 * 256;
#pragma unroll
  for (int c = 0; c < 16; ++c) {
    float cr = cre[c * 64 + pp], ci = cim[c * 64 + pp];
    float dr = cr * wr - ci * wi, di = cr * wi + ci * wr;
    vop[(size_t)(t * 16 + c) * 256 + dir * 128 + pp] = f2bf(dr);
    vop[(size_t)(t * 16 + c) * 256 + dir * 128 + 64 + pp] = f2bf(-di);
  }
}

constexpr int TR_T0 = 8 * 45, TR_T1 = 2 * 48, TR_T2 = 1 * 64, TR_T3 = 256, TR_T4 = 8 * 64, TR_T5 = 256, TR_T6 = 256;
constexpr int TR_TOTAL = TR_T0 + TR_T1 + TR_T2 + TR_T3 + TR_T4 + TR_T5 + TR_T6;
constexpr int U_MOD = 384, U_RS0 = 0, U_KTAB = 64 * 7, U_OPS = 64 * 2 * 64 * 32 / 256;
constexpr int PREP_A_UNITS = U_MOD + TR_T0 + TR_T1 + TR_T2 + TR_T3;
constexpr int PREP_B_UNITS = TR_T4 + TR_T5 + TR_T6 + U_KTAB + U_OPS;

DI void phase_prep(const Params& p, char* smem) {
  for (int u = blockIdx.x; u < PREP_A_UNITS; u += gridDim.x) {
    int v = u;
    if (v < U_MOD) { prep_mod(p, v, smem); continue; }
    v -= U_MOD;
    int w = 0;
    if (v >= TR_T0) { v -= TR_T0; w = 1;
      if (v >= TR_T1) { v -= TR_T1; w = 2;
        if (v >= TR_T2) { v -= TR_T2; w = 3; } } }
    prep_transpose(p, w, v, smem);
  }
}
DI void phase_prep_b(const Params& p, char* smem, int first_blk) {
  if (first_blk >= (int)gridDim.x) first_blk = 0;
  if ((int)blockIdx.x < first_blk) return;
  const int nb = gridDim.x - first_blk;
  for (int u = blockIdx.x - first_blk; u < PREP_B_UNITS; u += nb) {
    int v = u;
    if (v < TR_T4 + TR_T5 + TR_T6) {
      int w = 4;
      if (v >= TR_T4) { v -= TR_T4; w = 5;
        if (v >= TR_T5) { v -= TR_T5; w = 6; } }
      prep_transpose(p, w, v, smem);
      continue;
    }
    v -= TR_T4 + TR_T5 + TR_T6;
    if (v < U_KTAB) { prep_ktab(p, v, smem); continue; }
    v -= U_KTAB;
    prep_ops(p, v);
  }
}

DI float rs_from_part(const float* part, int nrows, int r) {
  float s = 0.f;
#pragma unroll
  for (int j = 0; j < 16; ++j) s += part[(size_t)j * nrows + r];
  return rsqrtf(s * (1.f / 1024.f) + EPS);
}

DI void phase_final(const Params& p) {
  const int tidx_ = opaque_tid();
  const float* part = (const float*)(p.ws + O_PART2);
  const float4* g4 = (const float4*)p.in[I_FINALG];
  int lane = tidx_ & 63;
  float4 g[4];
#pragma unroll
  for (int i = 0; i < 4; ++i) g[i] = g4[lane + 64 * i];
  for (int r = (blockIdx.x * 4 + (tidx_ >> 6)) * 2; r < NLAT; r += gridDim.x * 8) {
    float4* row0 = (float4*)(p.out + (size_t)r * D);
    float4* row1 = row0 + D / 4;
    float4 v0[4], v1[4];
#pragma unroll
    for (int i = 0; i < 4; ++i) {
      v0[i] = row0[lane + 64 * i];
      v1[i] = row1[lane + 64 * i];
    }
    float ps = part[(size_t)(lane & 15) * NLAT + r + ((lane >> 4) & 1)];
    ps += __shfl_xor(ps, 1);
    ps += __shfl_xor(ps, 2);
    ps += __shfl_xor(ps, 4);
    ps += __shfl_xor(ps, 8);
    const float rs0 = rsqrtf(__shfl(ps, 0) * (1.f / 1024.f) + EPS);
    const float rs1 = rsqrtf(__shfl(ps, 16) * (1.f / 1024.f) + EPS);
#pragma unroll
    for (int i = 0; i < 4; ++i) {
      float4 a = v0[i], c = v1[i];
      a.x *= rs0 * g[i].x; a.y *= rs0 * g[i].y; a.z *= rs0 * g[i].z; a.w *= rs0 * g[i].w;
      c.x *= rs1 * g[i].x; c.y *= rs1 * g[i].y; c.z *= rs1 * g[i].z; c.w *= rs1 * g[i].w;
      row0[lane + 64 * i] = a;
      row1[lane + 64 * i] = c;
    }
  }
}

typedef short bf16x8 __attribute__((ext_vector_type(8)));
typedef short s16x4 __attribute__((ext_vector_type(4)));
typedef float f32x16 __attribute__((ext_vector_type(16)));
#define SCHED_FENCE() __builtin_amdgcn_sched_barrier(0)
#define MFMA32(a, b, c) __builtin_amdgcn_mfma_f32_32x32x16_bf16((a), (b), (c), 0, 0, 0)
DI int xcd_swz(int u, int per) {
  int x = u & 7, q = u >> 3;
  int qq = q / per;
  return (x + 8 * qq) * per + (q - qq * per);
}
DI int crow(int i, int h) { return (i & 3) + 8 * (i >> 2) + 4 * h; }

constexpr int LDT = 40;
struct GemmSmem {
  bfr A[2][128 * LDT];
  bfr B[2][128 * LDT];
  float rs[128];
};
static_assert(sizeof(GemmSmem) <= SMEM_BYTES, "smem");

DI void zero_acc(f32x16 (&acc)[2][2]) {
#pragma unroll
  for (int a = 0; a < 2; ++a)
#pragma unroll
    for (int b = 0; b < 2; ++b)
#pragma unroll
      for (int i = 0; i < 16; ++i) acc[a][b][i] = 0.f;
}

#define GSTAGE_DECL uint4 ga0, ga1, gb0, gb1, gc0, gc1, gd0, gd1
#define GSTAGE_ARGS ga0, ga1, gb0, gb1, gc0, gc1, gd0, gd1
#define GSTAGE_PARAMS uint4 &a0, uint4 &a1, uint4 &b0, uint4 &b1, uint4 &c0, uint4 &c1, uint4 &d0, uint4 &d1
template <class AAddr, class BAddr>
DI void gemm_prefetch(GSTAGE_PARAMS, AAddr aaddr, BAddr baddr) {
  const int tid = opaque_tid();
  const int lrow = tid >> 2, lkc = (tid & 3) * 8;
  b0 = *(const uint4*)baddr(lrow, lkc);
  b1 = *(const uint4*)baddr(lrow + 64, lkc);
  a0 = *(const uint4*)aaddr(lrow, lkc);
  a1 = *(const uint4*)aaddr(lrow + 64, lkc);
  d0 = *(const uint4*)baddr(lrow, 32 + lkc);
  d1 = *(const uint4*)baddr(lrow + 64, 32 + lkc);
  c0 = *(const uint4*)aaddr(lrow, 32 + lkc);
  c1 = *(const uint4*)aaddr(lrow + 64, 32 + lkc);
  SCHED_FENCE();
}
template <class AAddr, class BAddr>
DI void gemm_main(f32x16 (&acc)[2][2], int KT, AAddr aaddr, BAddr baddr, GemmSmem* sm, GSTAGE_PARAMS) {
  const int tid = opaque_tid(), lane = tid & 63, wave = tid >> 6;
  const int wm = wave >> 1, wn = wave & 1, r = lane & 31, h = lane >> 5;
  const int lrow = tid >> 2, lkc = (tid & 3) * 8;
#define GM_LOAD(KT_, A0, A1, B0, B1)                   \
  {                                                    \
    const int kk_ = (KT_) * 32 + lkc;                  \
    B0 = *(const uint4*)baddr(lrow, kk_);              \
    B1 = *(const uint4*)baddr(lrow + 64, kk_);         \
    A0 = *(const uint4*)aaddr(lrow, kk_);              \
    A1 = *(const uint4*)aaddr(lrow + 64, kk_);         \
  }
#define GM_STORE(BUF_, A0, A1, B0, B1)                                  \
  {                                                                     \
    *(uint4*)(sm->B[BUF_] + lrow * LDT + lkc) = B0;                     \
    *(uint4*)(sm->B[BUF_] + (lrow + 64) * LDT + lkc) = B1;              \
    *(uint4*)(sm->A[BUF_] + lrow * LDT + lkc) = A0;                     \
    *(uint4*)(sm->A[BUF_] + (lrow + 64) * LDT + lkc) = A1;              \
  }
#define GM_COMPUTE(BUF_)                                                                                       \
  _Pragma("unroll") for (int ks = 0; ks < 2; ++ks) {                                                           \
    bf16x8 a_[2], b_[2];                                                                                       \
    _Pragma("unroll") for (int mi = 0; mi < 2; ++mi)                                                           \
        a_[mi] = *(const bf16x8*)(sm->A[BUF_] + (wm * 64 + mi * 32 + r) * LDT + ks * 16 + h * 8);              \
    _Pragma("unroll") for (int ni = 0; ni < 2; ++ni)                                                           \
        b_[ni] = *(const bf16x8*)(sm->B[BUF_] + (wn * 64 + ni * 32 + r) * LDT + ks * 16 + h * 8);              \
    _Pragma("unroll") for (int mi = 0; mi < 2; ++mi)                                                           \
        _Pragma("unroll") for (int ni = 0; ni < 2; ++ni) acc[mi][ni] = MFMA32(a_[mi], b_[ni], acc[mi][ni]);    \
  }
  GM_STORE(0, a0, a1, b0, b1)
  if (KT > 2) GM_LOAD(2, a0, a1, b0, b1)
  SCHED_FENCE();
  __syncthreads();
  for (int kt = 0; kt < KT; kt += 2) {
    GM_STORE(1, c0, c1, d0, d1)
    if (kt + 3 < KT) GM_LOAD(kt + 3, c0, c1, d0, d1)
    SCHED_FENCE();
    GM_COMPUTE(0)
    __syncthreads();
    if (kt + 2 < KT) GM_STORE(0, a0, a1, b0, b1)
    if (kt + 4 < KT) GM_LOAD(kt + 4, a0, a1, b0, b1)
    SCHED_FENCE();
    GM_COMPUTE(1)
    __syncthreads();
  }
}

template <class AAddr, class BAddr>
DI void gemm_full(f32x16 (&acc)[2][2], int KT, AAddr aaddr, BAddr baddr, GemmSmem* sm) {
  GSTAGE_DECL;
  gemm_prefetch(GSTAGE_ARGS, aaddr, baddr);
  gemm_main(acc, KT, aaddr, baddr, sm, GSTAGE_ARGS);
}

DI float transpose_reduce16(float (&v)[16], int lane) {
  float r8[8], r4[4], r2[2];
  {
    bool up = lane & 8;
#pragma unroll
    for (int i = 0; i < 8; ++i) {
      float send = up ? v[i] : v[i + 8];
      float keep = up ? v[i + 8] : v[i];
      r8[i] = keep + __shfl_xor(send, 8);
    }
  }
  {
    bool up = lane & 4;
#pragma unroll
    for (int i = 0; i < 4; ++i) {
      float send = up ? r8[i] : r8[i + 4];
      float keep = up ? r8[i + 4] : r8[i];
      r4[i] = keep + __shfl_xor(send, 4);
    }
  }
  {
    bool up = lane & 2;
#pragma unroll
    for (int i = 0; i < 2; ++i) {
      float send = up ? r4[i] : r4[i + 2];
      float keep = up ? r4[i + 2] : r4[i];
      r2[i] = keep + __shfl_xor(send, 2);
    }
  }
  bool up = lane & 1;
  float send = up ? r2[0] : r2[1];
  float keep = up ? r2[1] : r2[0];
  return keep + __shfl_xor(send, 1);
}

DI void stage_half(const f32x16 (&acc)[2][2], int mi, float* wl, float4 (&v)[8], int lane) {
  const int r = lane & 31, h = lane >> 5;
#pragma unroll
  for (int ni = 0; ni < 2; ++ni)
#pragma unroll
    for (int i = 0; i < 16; ++i) wl[crow(i, h) * 64 + ni * 32 + r] = acc[mi][ni][i];
  asm volatile("s_waitcnt lgkmcnt(0)" ::: "memory");
#pragma unroll
  for (int c = 0; c < 8; ++c) v[c] = *(const float4*)(wl + (c * 4 + (lane >> 4)) * 64 + (lane & 15) * 4);
  asm volatile("s_waitcnt lgkmcnt(0)" ::: "memory");
}
DI void stage_half8(const f32x16 (&acc)[2][2], int mi, float* wl, float4 (&lo)[4], float4 (&hi)[4], int lane) {
  const int r = lane & 31, h = lane >> 5;
#pragma unroll
  for (int ni = 0; ni < 2; ++ni)
#pragma unroll
    for (int i = 0; i < 16; ++i) wl[crow(i, h) * 64 + ni * 32 + r] = acc[mi][ni][i];
  asm volatile("s_waitcnt lgkmcnt(0)" ::: "memory");
#pragma unroll
  for (int c = 0; c < 4; ++c) {
    const float* pch = wl + (c * 8 + (lane >> 3)) * 64 + (lane & 7) * 8;
    lo[c] = *(const float4*)pch;
    hi[c] = *(const float4*)(pch + 4);
  }
  asm volatile("s_waitcnt lgkmcnt(0)" ::: "memory");
}
DI float4 bf4_to_f4(uint2 u) {
  return make_float4(__uint_as_float(u.x << 16), __uint_as_float(u.x & 0xffff0000u), __uint_as_float(u.y << 16),
                     __uint_as_float(u.y & 0xffff0000u));
}
DI uint2 f4_to_bf4(float4 f) { return make_uint2(pk2(f.x, f.y), pk2(f.z, f.w)); }

#define WAVE_IDS                                              \
  const int tid = opaque_tid(), lane = tid & 63, wave = tid >> 6; \
  const int wm = wave >> 1, wn = wave & 1, r = lane & 31, h = lane >> 5; \
  (void)wm; (void)wn; (void)r; (void)h;

template <int LAYER>
DI void phase_hconv(const Params& p) {
  const int tid = opaque_tid(), lane = tid & 63;
  bfr* H = (bfr*)(p.ws + (LAYER == 0 ? O_H0 : O_H1));
  const float4* ng4 = (const float4*)(p.in[I_NORMG] + LAYER * 1024);
  for (int tok = (blockIdx.x * 4 + (tid >> 6)) * 2; tok < TOK; tok += gridDim.x * 8) {
    const float4* xr0 = (const float4*)(LAYER == 0 ? xrow0(p, tok) : (const float*)xrow1(p, tok));
    const float4* xr1 = xr0 + 256;
    const float4* md4 = (const float4*)modrow(p, LAYER, tok);
    float4 x0[4], x1[4], gm[4], sh[4];
#pragma unroll
    for (int i = 0; i < 4; ++i) {
      x0[i] = xr0[lane + 64 * i];
      x1[i] = xr1[lane + 64 * i];
      float4 gv = ng4[lane + 64 * i];
      float4 sc = md4[256 + lane + 64 * i];
      sh[i] = md4[lane + 64 * i];
      gm[i] = make_float4(gv.x * (1.f + sc.x), gv.y * (1.f + sc.y), gv.z * (1.f + sc.z), gv.w * (1.f + sc.w));
    }
    float s0 = 0.f, s1 = 0.f;
#pragma unroll
    for (int i = 0; i < 4; ++i) {
      s0 += x0[i].x * x0[i].x + x0[i].y * x0[i].y + x0[i].z * x0[i].z + x0[i].w * x0[i].w;
      s1 += x1[i].x * x1[i].x + x1[i].y * x1[i].y + x1[i].z * x1[i].z + x1[i].w * x1[i].w;
    }
    s0 = wave_sum(s0);
    s1 = wave_sum(s1);
    const float r0 = rsqrtf(s0 * (1.f / 1024.f) + EPS), r1 = rsqrtf(s1 * (1.f / 1024.f) + EPS);
#pragma unroll
    for (int i = 0; i < 4; ++i) {
      uint2 o0, o1;
      o0.x = pk2(x0[i].x * r0 * gm[i].x + sh[i].x, x0[i].y * r0 * gm[i].y + sh[i].y);
      o0.y = pk2(x0[i].z * r0 * gm[i].z + sh[i].z, x0[i].w * r0 * gm[i].w + sh[i].w);
      o1.x = pk2(x1[i].x * r1 * gm[i].x + sh[i].x, x1[i].y * r1 * gm[i].y + sh[i].y);
      o1.y = pk2(x1[i].z * r1 * gm[i].z + sh[i].z, x1[i].w * r1 * gm[i].w + sh[i].w);
      *(uint2*)(H + (size_t)tok * 1024 + (lane + 64 * i) * 4) = o0;
      *(uint2*)(H + (size_t)(tok + 1) * 1024 + (lane + 64 * i) * 4) = o1;
    }
  }
}

DI void phase_o1(const Params& p, char* smem) {
  GemmSmem* sm = (GemmSmem*)smem;
  WAVE_IDS
  const int NT = 12, units = (TOK / 128) * NT;
  const bfr* WT = (const bfr*)(p.ws + O_WT_IN0);
  bfr* PC = (bfr*)(p.ws + O_PC);
  bfr* SZ0 = (bfr*)(p.ws + O_SZ0);
  bfr* KRb = (bfr*)(p.ws + O_KR);
  const bfr* Ah = (const bfr*)(p.ws + O_H0);
  auto Aof = [&](int m0) { return [=](int row, int k) { return Ah + (size_t)(m0 + row) * 1024 + k; }; };
  auto Bof = [&](int n0) {
    return [=](int row, int k) {
      int n = n0 + row;
      n = n < NIN0 ? n : NIN0 - 1;
      return WT + (size_t)n * 1024 + k;
    };
  };
  GSTAGE_DECL;
  if ((int)blockIdx.x < units) {
    const int us = xcd_swz(blockIdx.x, NT);
    gemm_prefetch(GSTAGE_ARGS, Aof((us / NT) * 128), Bof((us % NT) * 128));
  }
  for (int u = blockIdx.x; u < units; u += gridDim.x) {
    const int us = xcd_swz(u, NT);
    int mt = us / NT, nt = us - mt * NT;
    int m0 = mt * 128, n0 = nt * 128;
    f32x16 acc[2][2];
    zero_acc(acc);
    gemm_main(acc, 32, Aof(m0), Bof(n0), sm, GSTAGE_ARGS);
    if (u + (int)gridDim.x < units) {
      const int us1 = xcd_swz(u + gridDim.x, NT);
      gemm_prefetch(GSTAGE_ARGS, Aof((us1 / NT) * 128), Bof((us1 % NT) * 128));
    }
    int b = m0 / LALL, pos0 = m0 - b * LALL;
    bool lat = pos0 >= LC;
    (void)b;
    if (lat && n0 + wn * 64 == 384) {
#pragma unroll
      for (int mi = 0; mi < 2; ++mi)
#pragma unroll
        for (int i = 0; i < 16; ++i) {
          int pos = pos0 + wm * 64 + mi * 32 + crow(i, h);
          float v = acc[mi][0][i];
          float vp = __shfl_xor(v, 8);
          acc[mi][0][i] = rope_apply(r, v, vp, pos - LC);
        }
    }
    {
      float* wl = (float*)sm + wave * 2048;
      const int col = n0 + wn * 64 + (lane & 7) * 8;
#pragma unroll
      for (int mi = 0; mi < 2; ++mi) {
        float4 lo[4], hi[4];
        stage_half8(acc, mi, wl, lo, hi, lane);
#pragma unroll
        for (int c = 0; c < 4; ++c) {
          int tok = m0 + wm * 64 + mi * 32 + c * 8 + (lane >> 3);
          if (col < 416) {
            uint4 o;
            o.x = pk2(lo[c].x, lo[c].y);
            o.y = pk2(lo[c].z, lo[c].w);
            o.z = pk2(hi[c].x, hi[c].y);
            o.w = pk2(hi[c].z, hi[c].w);
            bfr* dst = col < 384 ? PC + (size_t)tok * 384 + col : KRb + (size_t)tok * 32 + (col - 384);
            *(uint4*)dst = o;
          } else if (col < NIN0) {
            uint4 o;
            o.x = pk2(silu_f(lo[c].x), silu_f(lo[c].y));
            o.y = pk2(silu_f(lo[c].z), silu_f(lo[c].w));
            o.z = pk2(silu_f(hi[c].x), silu_f(hi[c].y));
            o.w = pk2(silu_f(hi[c].z), silu_f(hi[c].w));
            *(uint4*)(SZ0 + (size_t)tok * 1024 + (col - 416)) = o;
          }
        }
      }
      __syncthreads();
    }
  }
}

DI void phase_o2(const Params& p, char* smem) {
  GemmSmem* sm = (GemmSmem*)smem;
  WAVE_IDS
  const int UQ = (TOK / 128) * 12, UKV = (TOK / 128) * 16;
  const bfr* PC = (const bfr*)(p.ws + O_PC);
  bfr* Q = (bfr*)p.out;
  bfr* Kb = (bfr*)(p.ws + O_K);
  bfr* VT = (bfr*)(p.ws + O_VT);
  const int total = UQ + UKV;
  const int per_blk = (total + gridDim.x - 1) / gridDim.x;
  const int u_beg = blockIdx.x * per_blk;
  const int u_end = u_beg + per_blk < total ? u_beg + per_blk : total;
  int prev_key = -1;
  for (int us = u_beg; us < u_end; ++us) {
    int mt = us / 28, rem = us - mt * 28;
    bool isq = rem < 12;
    int nt = isq ? rem : rem - 12;
    int m0 = mt * 128, n0 = nt * 128;
    int Kd = isq ? 256 : 128;
    int aoff = isq ? 0 : 256;
    const bfr* WT = (const bfr*)(p.ws + (isq ? O_WT_UQ : O_WT_UKV));
    const int key = mt * 2 + (isq ? 0 : 1);
    if (key != prev_key) {
      prev_key = key;
      __syncthreads();
      int row = tid >> 1, half = tid & 1;
      const bfr* ap = PC + (size_t)(m0 + row) * 384 + aoff + half * (Kd / 2);
      float ss = 0.f;
      for (int j = 0; j < Kd / 16; ++j) {
        uint4 v = *(const uint4*)(ap + j * 8);
        unsigned w[4] = {v.x, v.y, v.z, v.w};
#pragma unroll
        for (int e = 0; e < 4; ++e) {
          float lo = __uint_as_float(w[e] << 16), hi = __uint_as_float(w[e] & 0xffff0000u);
          ss += lo * lo + hi * hi;
        }
      }
      ss += __shfl_xor(ss, 1);
      if (half == 0) sm->rs[row] = rsqrtf(ss / (float)Kd + EPS);
      __syncthreads();
    }
    f32x16 acc[2][2];
    zero_acc(acc);
    gemm_full(
        acc, Kd / 32, [&](int row, int k) { return PC + (size_t)(m0 + row) * 384 + aoff + k; },
        [&](int row, int k) { return WT + (size_t)(n0 + row) * Kd + k; }, sm);
    int b = m0 / LALL, pos0 = m0 - b * LALL;
    bool lat = pos0 >= LC;
    float* wl = (float*)sm + wave * 2048;
    if (isq || wn == 0) {
      if (isq && lat) {
#pragma unroll
        for (int ni = 0; ni < 2; ++ni) {
          int col0 = n0 + wn * 64 + ni * 32;
          if (col0 % 96 == 64) {
#pragma unroll
            for (int mi = 0; mi < 2; ++mi)
#pragma unroll
              for (int i = 0; i < 16; ++i) {
                int pos = pos0 + wm * 64 + mi * 32 + crow(i, h);
                float v = acc[mi][ni][i];
                float vp = __shfl_xor(v, 8);
                acc[mi][ni][i] = rope_apply(r, v, vp, pos - LC);
              }
          }
        }
      }
      const int c0 = wn * 64 + (lane & 7) * 8;
      bfr* dst;
      int rstride;
      float oscale;
      if (isq) {
        int col = n0 + c0;
        int hh = col / 96, d = col - hh * 96;
        dst = Q + ((size_t)(b * NH + hh) * LALL) * DQK + d;
        rstride = DQK;
        oscale = QSCALE;
      } else {
        int hh = n0 >> 7;
        dst = Kb + ((size_t)(b * NH + hh) * LALL) * 64 + c0;
        rstride = 64;
        oscale = 1.f;
      }
#pragma unroll
      for (int mi = 0; mi < 2; ++mi) {
        float4 lo[4], hi[4];
        stage_half8(acc, mi, wl, lo, hi, lane);
#pragma unroll
        for (int c = 0; c < 4; ++c) {
          int row = wm * 64 + mi * 32 + c * 8 + (lane >> 3);
          float sc = sm->rs[row] * oscale;
          uint4 o;
          o.x = pk2(lo[c].x * sc, lo[c].y * sc);
          o.y = pk2(lo[c].z * sc, lo[c].w * sc);
          o.z = pk2(hi[c].x * sc, hi[c].y * sc);
          o.w = pk2(hi[c].z * sc, hi[c].w * sc);
          *(uint4*)(dst + (size_t)(pos0 + row) * rstride) = o;
        }
      }
    } else {
      int hh = n0 >> 7;
#pragma unroll
      for (int mi = 0; mi < 2; ++mi)
#pragma unroll
        for (int ni = 0; ni < 2; ++ni) {
          int dvv = ni * 32 + r;
#pragma unroll
          for (int g4 = 0; g4 < 4; ++g4) {
            int row = wm * 64 + mi * 32 + 8 * g4 + 4 * h;
            int pos = pos0 + row;
            uint2 o;
            o.x = pk2(acc[mi][ni][4 * g4 + 0] * sm->rs[row + 0], acc[mi][ni][4 * g4 + 1] * sm->rs[row + 1]);
            o.y = pk2(acc[mi][ni][4 * g4 + 2] * sm->rs[row + 2], acc[mi][ni][4 * g4 + 3] * sm->rs[row + 3]);
            *(uint2*)(VT + (((size_t)(b * NH + hh)) * DV + dvv) * LALL + pos) = o;
          }
        }
    }
    __syncthreads();
  }
}

constexpr int KLD = 104;
constexpr int VLD = 68;
struct AttnSmem {
  bfr K[64 * KLD];
  bfr V[64 * VLD];
};
static_assert(sizeof(AttnSmem) <= SMEM_BYTES, "smem");

DI void attn_item(const Params& p, AttnSmem* sm, int bh, int qpos0, int nkeys) {
  WAVE_IDS
  const bfr* Q = (const bfr*)p.out;
  const bfr* Kg = (const bfr*)(p.ws + O_K) + (size_t)bh * LALL * 64;
  const bfr* KRg = (const bfr*)(p.ws + O_KR) + (size_t)(bh / NH) * LALL * 32;
  const bfr* Vg = (const bfr*)(p.ws + O_VT) + (size_t)bh * DV * LALL;
  const int qpos = qpos0 + wave * 32 + r;
  bf16x8 bq[6];
  {
    const bfr* qp = Q + ((size_t)bh * LALL + qpos) * DQK + 8 * h;
#pragma unroll
    for (int s = 0; s < 6; ++s) bq[s] = *(const bf16x8*)(qp + 16 * s);
  }
  f32x16 o[2];
#pragma unroll
  for (int d = 0; d < 2; ++d)
#pragma unroll
    for (int i = 0; i < 16; ++i) o[d][i] = 0.f;
  float mrun = 0.f, lrun = 0.f;
  uint4 kv0, kv1, kv2, vv0, vv1;
  const int kr0 = tid / 12, kc0 = (tid - kr0 * 12) * 8;
  const int kr1 = (tid + 256) / 12, kc1 = (tid + 256 - kr1 * 12) * 8;
  const int kr2 = (tid + 512) / 12, kc2 = (tid + 512 - kr2 * 12) * 8;
  const int vr0 = tid >> 3, vc0 = (tid & 7) * 8;
  const bfr* kp0 = kc0 < 64 ? Kg + (size_t)kr0 * 64 + kc0 : KRg + (size_t)kr0 * 32 + (kc0 - 64);
  const bfr* kp1 = kc1 < 64 ? Kg + (size_t)kr1 * 64 + kc1 : KRg + (size_t)kr1 * 32 + (kc1 - 64);
  const bfr* kp2 = kc2 < 64 ? Kg + (size_t)kr2 * 64 + kc2 : KRg + (size_t)kr2 * 32 + (kc2 - 64);
  const int ks0 = kc0 < 64 ? 64 : 32, ks1 = kc1 < 64 ? 64 : 32, ks2 = kc2 < 64 ? 64 : 32;
#define AT_GLOAD(KEY0_)                                                          \
  {                                                                              \
    const int key0_ = (KEY0_);                                                   \
    kv0 = *(const uint4*)(kp0 + (size_t)key0_ * ks0);                            \
    kv1 = *(const uint4*)(kp1 + (size_t)key0_ * ks1);                            \
    kv2 = *(const uint4*)(kp2 + (size_t)key0_ * ks2);                            \
    vv0 = *(const uint4*)(Vg + (size_t)vr0 * LALL + key0_ + vc0);                \
    vv1 = *(const uint4*)(Vg + (size_t)(vr0 + 32) * LALL + key0_ + vc0);         \
  }
#define AT_LSTORE()                                                              \
  {                                                                              \
    *(uint4*)(sm->K + kr0 * KLD + kc0) = kv0;                                    \
    *(uint4*)(sm->K + kr1 * KLD + kc1) = kv1;                                    \
    *(uint4*)(sm->K + kr2 * KLD + kc2) = kv2;                                    \
    uint2* d0_ = (uint2*)(sm->V + vr0 * VLD + vc0);                              \
    d0_[0] = make_uint2(vv0.x, vv0.y);                                           \
    d0_[1] = make_uint2(vv0.z, vv0.w);                                           \
    uint2* d1_ = (uint2*)(sm->V + (vr0 + 32) * VLD + vc0);                       \
    d1_[0] = make_uint2(vv1.x, vv1.y);                                           \
    d1_[1] = make_uint2(vv1.z, vv1.w);                                           \
  }
  const int NTI = nkeys / 64;
  AT_GLOAD(0)
  for (int it = 0; it < NTI; ++it) {
    AT_LSTORE()
    __syncthreads();
    if (it + 1 < NTI) AT_GLOAD((it + 1) * 64)
    SCHED_FENCE();
    f32x16 st[2];
    const float ninit = -mrun;
#pragma unroll
    for (int kb = 0; kb < 2; ++kb)
#pragma unroll
      for (int i = 0; i < 16; ++i) st[kb][i] = ninit;
#pragma unroll
    for (int s = 0; s < 6; ++s) {
#pragma unroll
      for (int kb = 0; kb < 2; ++kb) {
        bf16x8 ka = *(const bf16x8*)(sm->K + (kb * 32 + r) * KLD + 16 * s + 8 * h);
        st[kb] = MFMA32(ka, bq[s], st[kb]);
      }
    }
    float mx = fmaxf(fmaxf(st[0][0], st[0][1]), st[1][0]);
#pragma unroll
    for (int i = 2; i < 16; i += 2) mx = fmaxf(fmaxf(mx, st[0][i]), st[0][i + 1]);
#pragma unroll
    for (int i = 1; i < 15; i += 2) mx = fmaxf(fmaxf(mx, st[1][i]), st[1][i + 1]);
    mx = fmaxf(mx, st[1][15]);
    mx = fmaxf(mx, __shfl_xor(mx, 32));
    const bool need = (it == 0) || (mx > 8.f);
    if (__any(need)) {
      const float delta = need ? mx : 0.f;
      const float alpha = __builtin_amdgcn_exp2f(-delta);
      mrun += delta;
      lrun *= alpha;
#pragma unroll
      for (int d = 0; d < 2; ++d)
#pragma unroll
        for (int i = 0; i < 16; ++i) o[d][i] *= alpha;
#pragma unroll
      for (int kb = 0; kb < 2; ++kb)
#pragma unroll
        for (int i = 0; i < 16; ++i) st[kb][i] -= delta;
    }
    float ps = 0.f;
#pragma unroll
    for (int kb = 0; kb < 2; ++kb)
#pragma unroll
      for (int i = 0; i < 16; ++i) {
        float e = __builtin_amdgcn_exp2f(st[kb][i]);
        st[kb][i] = e;
        ps += e;
      }
    lrun += ps;
#pragma unroll
    for (int kb = 0; kb < 2; ++kb)
#pragma unroll
      for (int s2 = 0; s2 < 2; ++s2) {
        unsigned pw[4];
#pragma unroll
        for (int j = 0; j < 4; ++j) pw[j] = pk2(st[kb][8 * s2 + 2 * j], st[kb][8 * s2 + 2 * j + 1]);
        bf16x8 pb;
        {
          uint4 t = make_uint4(pw[0], pw[1], pw[2], pw[3]);
          pb = __builtin_bit_cast(bf16x8, t);
        }
#pragma unroll
        for (int d = 0; d < 2; ++d) {
          const bfr* vp = sm->V + (d * 32 + r) * VLD + kb * 32 + 16 * s2 + 4 * h;
          uint2 lo = *(const uint2*)vp;
          uint2 hi = *(const uint2*)(vp + 8);
          uint4 t = make_uint4(lo.x, lo.y, hi.x, hi.y);
          bf16x8 va = __builtin_bit_cast(bf16x8, t);
          o[d] = MFMA32(va, pb, o[d]);
        }
      }
    __syncthreads();
  }
  float ltot = lrun + __shfl_xor(lrun, 32);
  float inv = 1.f / ltot;
  int b = bh / NH, hh = bh - b * NH;
  bfr* wl = (bfr*)sm + wave * (32 * 72);
#pragma unroll
  for (int d = 0; d < 2; ++d)
#pragma unroll
    for (int g4 = 0; g4 < 4; ++g4) {
      int dv0 = d * 32 + 8 * g4 + 4 * h;
      uint2 ov;
      ov.x = pk2(o[d][4 * g4 + 0] * inv, o[d][4 * g4 + 1] * inv);
      ov.y = pk2(o[d][4 * g4 + 2] * inv, o[d][4 * g4 + 3] * inv);
      *(uint2*)(wl + r * 72 + dv0) = ov;
    }
  asm volatile("s_waitcnt lgkmcnt(0)" ::: "memory");
  {
    const int dvc = (lane & 7) * 8;
    uint4 ov[4], zv[4];
#pragma unroll
    for (int c = 0; c < 4; ++c) {
      int ql = c * 8 + (lane >> 3);
      size_t tok = (size_t)b * LALL + qpos0 + wave * 32 + ql;
      ov[c] = *(const uint4*)(wl + ql * 72 + dvc);
      zv[c] = *(const uint4*)((const bfr*)(p.ws + O_SZ0) + tok * 1024 + hh * 64 + dvc);
    }
#pragma unroll
    for (int c = 0; c < 4; ++c) {
      int ql = c * 8 + (lane >> 3);
      size_t tok = (size_t)b * LALL + qpos0 + wave * 32 + ql;
      float4 o0 = bf4_to_f4(make_uint2(ov[c].x, ov[c].y)), o1 = bf4_to_f4(make_uint2(ov[c].z, ov[c].w));
      float4 z0 = bf4_to_f4(make_uint2(zv[c].x, zv[c].y)), z1 = bf4_to_f4(make_uint2(zv[c].z, zv[c].w));
      uint4 out;
      out.x = pk2(o0.x * z0.x, o0.y * z0.y);
      out.y = pk2(o0.z * z0.z, o0.w * z0.w);
      out.z = pk2(o1.x * z1.x, o1.y * z1.y);
      out.w = pk2(o1.z * z1.z, o1.w * z1.w);
      *(uint4*)((bfr*)(p.ws + O_OG) + tok * 1024 + hh * 64 + dvc) = out;
    }
  }
  __syncthreads();
}

DI void phase_o3(const Params& p, char* smem) {
  AttnSmem* sm = (AttnSmem*)smem;
  const int xcd = blockIdx.x & 7, local = blockIdx.x >> 3, nloc = gridDim.x >> 3;
  for (int j = local; j < 256; j += nloc) {
    int u = xcd * 256 + j;
    attn_item(p, sm, u >> 4, LC + (u & 15) * 128, LALL);
  }
  for (int j = local; j < 32; j += nloc) {
    int u = xcd * 32 + j;
    attn_item(p, sm, u >> 1, (u & 1) * 128, LC);
  }
}

template <int LAYER>
DI void phase_oproj(const Params& p, char* smem) {
  GemmSmem* sm = (GemmSmem*)smem;
  WAVE_IDS
  constexpr int NROWS = LAYER == 0 ? TOK : NLAT;
  const int NT = 8, units = (NROWS / 128) * NT;
  const bfr* Ab = (const bfr*)(p.ws + (LAYER == 0 ? O_OG : O_Y2));
  const bfr* WT = (const bfr*)(p.ws + (LAYER == 0 ? O_WT_OUT0 : O_WT_OUT1));
  float* part = (float*)(p.ws + (LAYER == 0 ? O_PART1 : O_PART2));
  auto Aof = [&](int m0) { return [=](int row, int k) { return Ab + (size_t)(m0 + row) * 1024 + k; }; };
  auto Bof = [&](int n0) { return [=](int row, int k) { return WT + (size_t)(n0 + row) * 1024 + k; }; };
  GSTAGE_DECL;
  if ((int)blockIdx.x < units) {
    const int us = xcd_swz(blockIdx.x, NT);
    gemm_prefetch(GSTAGE_ARGS, Aof((us / NT) * 128), Bof((us % NT) * 128));
  }
  for (int u = blockIdx.x; u < units; u += gridDim.x) {
    const int us = xcd_swz(u, NT);
    int mt = us / NT, nt = us - mt * NT;
    int m0 = mt * 128, n0 = nt * 128;
    f32x16 acc[2][2];
    zero_acc(acc);
    gemm_main(acc, 32, Aof(m0), Bof(n0), sm, GSTAGE_ARGS);
    if (u + (int)gridDim.x < units) {
      const int us1 = xcd_swz(u + gridDim.x, NT);
      gemm_prefetch(GSTAGE_ARGS, Aof((us1 / NT) * 128), Bof((us1 % NT) * 128));
    }
    const float* xin;
    float* xout;
    const float* gt;
    if (LAYER == 0) {
      xin = xrow0(p, m0);
      xout = xrow1(p, m0);
      gt = modrow(p, 0, m0) + 2048;
    } else {
      xin = p.out + (size_t)m0 * 1024;
      xout = p.out + (size_t)m0 * 1024;
      gt = (const float*)(p.ws + O_MOD) + ((size_t)(9 + (m0 >> 11))) * 3072 + 2048;
    }
    {
      float* wl = (float*)sm + wave * 2048;
      const int ccol = n0 + wn * 64 + (lane & 15) * 4;
      const float4 g4 = *(const float4*)(gt + ccol);
#pragma unroll
      for (int mi = 0; mi < 2; ++mi) {
        float4 v[8], xv[8];
#pragma unroll
        for (int c = 0; c < 8; ++c)
          xv[c] = *(const float4*)(xin + (size_t)(wm * 64 + mi * 32 + c * 4 + (lane >> 4)) * 1024 + ccol);
        stage_half(acc, mi, wl, v, lane);
#pragma unroll
        for (int c = 0; c < 8; ++c) {
          int row = wm * 64 + mi * 32 + c * 4 + (lane >> 4);
          float4 o;
          o.x = xv[c].x + g4.x * v[c].x;
          o.y = xv[c].y + g4.y * v[c].y;
          o.z = xv[c].z + g4.z * v[c].z;
          o.w = xv[c].w + g4.w * v[c].w;
          *(float4*)(xout + (size_t)row * 1024 + ccol) = o;
          if (LAYER == 1) {
            float sq = o.x * o.x + o.y * o.y + o.z * o.z + o.w * o.w;
            sq += __shfl_xor(sq, 1);
            sq += __shfl_xor(sq, 2);
            sq += __shfl_xor(sq, 4);
            sq += __shfl_xor(sq, 8);
            if ((lane & 15) == 0) part[(size_t)(nt * 2 + wn) * NROWS + m0 + row] = sq;
          }
        }
      }
      __syncthreads();
    }
  }
  if (LAYER == 0) {
    __syncthreads();
    phase_prep_b(p, smem, units % (int)gridDim.x);
  }
}

DI void phase_o5(const Params& p, char* smem) {
  GemmSmem* sm = (GemmSmem*)smem;
  WAVE_IDS
  const int ULAT = (NLAT / 128) * 16, units = ULAT + (NB * LC / 128) * 8;
  const bfr* WT = (const bfr*)(p.ws + O_WT_IN1);
  bfr* U2 = (bfr*)(p.ws + O_U2);
  bfr* SZ1 = (bfr*)(p.ws + O_SZ1);
  const bfr* Ah = (const bfr*)(p.ws + O_H1);
  auto coords = [&](int u, int& m0, int& n0) {
    if (u < ULAT) {
      const int us = xcd_swz(u, 16);
      int mtl = us >> 4;
      m0 = (mtl >> 4) * LALL + LC + (mtl & 15) * 128;
      n0 = (us & 15) * 128;
    } else {
      const int us = xcd_swz(u - ULAT, 8);
      int mtc = us >> 3;
      m0 = (mtc >> 1) * LALL + (mtc & 1) * 128;
      n0 = (us & 7) * 128;
    }
  };
  auto Aof = [&](int m0) { return [=](int row, int k) { return Ah + (size_t)(m0 + row) * 1024 + k; }; };
  auto Bof = [&](int n0) { return [=](int row, int k) { return WT + (size_t)(n0 + row) * 1024 + k; }; };
  GSTAGE_DECL;
  if ((int)blockIdx.x < units) {
    int m1, n1;
    coords(blockIdx.x, m1, n1);
    gemm_prefetch(GSTAGE_ARGS, Aof(m1), Bof(n1));
  }
  for (int u = blockIdx.x; u < units; u += gridDim.x) {
    int m0, n0;
    coords(u, m0, n0);
    int b = m0 / LALL, pos0 = m0 - b * LALL;
    f32x16 acc[2][2];
    zero_acc(acc);
    gemm_main(acc, 32, Aof(m0), Bof(n0), sm, GSTAGE_ARGS);
    if (u + (int)gridDim.x < units) {
      int m1, n1;
      coords(u + gridDim.x, m1, n1);
      gemm_prefetch(GSTAGE_ARGS, Aof(m1), Bof(n1));
    }
    {
      float* wl = (float*)sm + wave * 2048;
      const int col = n0 + wn * 64 + (lane & 7) * 8;
      const bool isu = col < 1024;
#pragma unroll
      for (int mi = 0; mi < 2; ++mi) {
        float4 lo[4], hi[4];
        stage_half8(acc, mi, wl, lo, hi, lane);
#pragma unroll
        for (int c = 0; c < 4; ++c) {
          int row = wm * 64 + mi * 32 + c * 8 + (lane >> 3);
          int tok = m0 + row;
          uint4 o;
          bfr* dst;
          if (isu) {
            o.x = pk2(lo[c].x, lo[c].y);
            o.y = pk2(lo[c].z, lo[c].w);
            o.z = pk2(hi[c].x, hi[c].y);
            o.w = pk2(hi[c].z, hi[c].w);
            dst = U2 + ((size_t)(col >> 4) * TOK + tok) * 16 + (col & 15);
          } else {
            o.x = pk2(silu_f(lo[c].x), silu_f(lo[c].y));
            o.y = pk2(silu_f(lo[c].z), silu_f(lo[c].w));
            o.z = pk2(silu_f(hi[c].x), silu_f(hi[c].y));
            o.w = pk2(silu_f(hi[c].z), silu_f(hi[c].w));
            dst = SZ1 + ((size_t)(b * SEQ + pos0 + row - LC)) * 1024 + (col - 1024);
          }
          *(uint4*)dst = o;
        }
      }
      __syncthreads();
    }
  }
}

DI void phase_o6(const Params& p, char* smem) {
  GemmSmem* sm = (GemmSmem*)smem;
  WAVE_IDS
  const int NROW = NB * NCH;
  const int units = 64 * 5 * 2;
  const bfr* U2 = (const bfr*)(p.ws + O_U2);
  const bfr* WST = (const bfr*)(p.ws + O_WST);
  float* SLOC = (float*)(p.ws + O_SLOC);
  for (int u = blockIdx.x; u < units; u += gridDim.x) {
    const int us = xcd_swz(u, 10);
    int g = us / 10, rem = us - g * 10;
    int mt = rem >> 1, nt = rem & 1;
    int m0 = mt * 128, n0 = nt * 128;
    const bfr* Ag = U2 + (size_t)g * TOK * 16;
    const bfr* Bg = WST + (size_t)g * 256 * 512;
    f32x16 acc[2][2];
    zero_acc(acc);
    gemm_full(
        acc, 16,
        [&](int row, int k) {
          int rr = m0 + row;
          rr = rr < NROW ? rr : NROW - 1;
          return Ag + (size_t)rr * 512 + k;
        },
        [&](int row, int k) { return Bg + (size_t)(n0 + row) * 512 + k; }, sm);
#pragma unroll
    for (int mi = 0; mi < 2; ++mi)
#pragma unroll
      for (int ni = 0; ni < 2; ++ni) {
        int col = n0 + wn * 64 + ni * 32 + r;
#pragma unroll
        for (int i = 0; i < 16; ++i) {
          int row = m0 + wm * 64 + mi * 32 + crow(i, h);
          SLOC[((size_t)g * SLOC_ROWS + row) * 256 + col] = acc[mi][ni][i];
        }
      }
  }
}

DI void phase_o7(const Params& p) {
  const int tidx_ = opaque_tid();
  const float* SLOC = (const float*)(p.ws + O_SLOC);
  bfr* SIN = (bfr*)(p.ws + O_SIN);
  const int total = NB * 64 * 2 * 64;
  for (int idx = blockIdx.x * 256 + tidx_; idx < total; idx += gridDim.x * 256) {
    int pp = idx & 63, dir = (idx >> 6) & 1, g = (idx >> 7) & 63, b = idx >> 13;
    double dt, ar, ai;
    float fr, fi, lr, li;
    s5_disc(p, dir, g, pp, dt, ar, ai, fr, fi);
    s5_pow(dt, ar, ai, TC, lr, li);
    float sr = 0.f, si = 0.f;
    auto cpos = [&](int step) { return dir == 0 ? step : (step < 8 ? 7 - step : NCH - 1 - (step - 8)); };
    const float* slb = SLOC + ((size_t)g * SLOC_ROWS + b * NCH) * 256 + dir * 128 + pp;
    bfr* sob = SIN + ((size_t)g * (NB * NCHL) + b * NCHL) * 256 + dir * 128 + pp;
#pragma unroll 1
    for (int s0 = 0; s0 < NCH; s0 += 24) {
      float lre[24], lim[24];
#pragma unroll
      for (int j = 0; j < 24; ++j) {
        const float* sl = slb + (size_t)cpos(s0 + j) * 256;
        lre[j] = sl[0];
        lim[j] = sl[64];
      }
#pragma unroll
      for (int j = 0; j < 24; ++j) {
        int cp = cpos(s0 + j);
        if (cp >= 8) {
          bfr* so = sob + (size_t)(cp - 8) * 256;
          so[0] = f2bf(sr);
          so[64] = f2bf(si);
        }
        float nr = lr * sr - li * si + lre[j];
        float ni = lr * si + li * sr + lim[j];
        sr = nr;
        si = ni;
      }
    }
  }
}

DI void phase_o8(const Params& p, char* smem) {
  GemmSmem* sm = (GemmSmem*)smem;
  WAVE_IDS
  const int units = 64 * 4 * 4;
  const bfr* U2 = (const bfr*)(p.ws + O_U2);
  const bfr* SIN = (const bfr*)(p.ws + O_SIN);
  const bfr* KTAB = (const bfr*)(p.ws + O_KTAB);
  const bfr* VOP = (const bfr*)(p.ws + O_VOP);
  bfr* YG = (bfr*)(p.ws + O_YG);
  for (int u = blockIdx.x; u < units; u += gridDim.x) {
    const int us = xcd_swz(u, 16);
    int g = us >> 4, mt = (us >> 2) & 3, nt = us & 3;
    int m0 = mt * 128, n0 = nt * 128;
    const bfr* Ug = U2 + (size_t)g * TOK * 16;
    f32x16 acc[2][2];
    zero_acc(acc);
    gemm_full(
        acc, 16,
        [&](int row, int k) {
          int rr = m0 + row;
          int b = rr >> 6, n = rr & 63;
          return Ug + ((size_t)b * LALL + LC + n * TC) * 16 + k;
        },
        [&](int row, int k) {
          int m = n0 + row;
          int t = m >> 4, c = m & 15;
          return KTAB + (((size_t)g * 63 + (t + 31)) * 16 + c) * 16 - (k >> 4) * 256 + (k & 15);
        },
        sm);
    gemm_full(
        acc, 8, [&](int row, int k) { return SIN + ((size_t)g * (NB * NCHL) + m0 + row) * 256 + k; },
        [&](int row, int k) { return VOP + ((size_t)g * 512 + n0 + row) * 256 + k; }, sm);
    {
      float* wl = (float*)sm + wave * 2048;
      const int mcol = n0 + wn * 64 + (lane & 7) * 8;
      const int t = mcol >> 4, c0 = mcol & 15;
      const int ch = g * 16 + c0;
      const float4 d0 = *(const float4*)(p.in[I_S5D] + ch), d1 = *(const float4*)(p.in[I_S5D] + ch + 4);
#pragma unroll
      for (int mi = 0; mi < 2; ++mi) {
        float4 lo[4], hi[4];
        stage_half8(acc, mi, wl, lo, hi, lane);
        uint4 uq[4];
#pragma unroll
        for (int c = 0; c < 4; ++c) {
          int rr = m0 + wm * 64 + mi * 32 + c * 8 + (lane >> 3);
          int b = rr >> 6, n = rr & 63;
          uq[c] = *(const uint4*)(Ug + ((size_t)b * LALL + LC + n * TC + t) * 16 + c0);
        }
        SCHED_FENCE();
#pragma unroll
        for (int c = 0; c < 4; ++c) {
          int rr = m0 + wm * 64 + mi * 32 + c * 8 + (lane >> 3);
          int b = rr >> 6, n = rr & 63;
          float4 u0 = bf4_to_f4(make_uint2(uq[c].x, uq[c].y)), u1 = bf4_to_f4(make_uint2(uq[c].z, uq[c].w));
          uint4 o;
          o.x = pk2(gelu_tanh(lo[c].x + d0.x * u0.x), gelu_tanh(lo[c].y + d0.y * u0.y));
          o.y = pk2(gelu_tanh(lo[c].z + d0.z * u0.z), gelu_tanh(lo[c].w + d0.w * u0.w));
          o.z = pk2(gelu_tanh(hi[c].x + d1.x * u1.x), gelu_tanh(hi[c].y + d1.y * u1.y));
          o.w = pk2(gelu_tanh(hi[c].z + d1.z * u1.z), gelu_tanh(hi[c].w + d1.w * u1.w));
          *(uint4*)(YG + ((size_t)(b * SEQ + n * TC + t)) * 1024 + ch) = o;
        }
        SCHED_FENCE();
      }
      __syncthreads();
    }
  }
}

DI void phase_o9(const Params& p, char* smem) {
  GemmSmem* sm = (GemmSmem*)smem;
  WAVE_IDS
  const int NT = 8, units = (NLAT / 128) * NT;
  const bfr* YG = (const bfr*)(p.ws + O_YG);
  const bfr* SZ1 = (const bfr*)(p.ws + O_SZ1);
  const bfr* WT = (const bfr*)(p.ws + O_WT_GLU);
  bfr* Y2 = (bfr*)(p.ws + O_Y2);
  auto Aof = [&](int m0) { return [=](int row, int k) { return YG + (size_t)(m0 + row) * 1024 + k; }; };
  auto Bof = [&](int n0) { return [=](int row, int k) { return WT + (size_t)(n0 + row) * 1024 + k; }; };
  GSTAGE_DECL;
  if ((int)blockIdx.x < units) {
    const int us = xcd_swz(blockIdx.x, NT);
    gemm_prefetch(GSTAGE_ARGS, Aof((us / NT) * 128), Bof((us % NT) * 128));
  }
  for (int u = blockIdx.x; u < units; u += gridDim.x) {
    const int us = xcd_swz(u, NT);
    int mt = us / NT, nt = us - mt * NT;
    int m0 = mt * 128, n0 = nt * 128;
    f32x16 acc[2][2];
    zero_acc(acc);
    gemm_main(acc, 32, Aof(m0), Bof(n0), sm, GSTAGE_ARGS);
    if (u + (int)gridDim.x < units) {
      const int us1 = xcd_swz(u + gridDim.x, NT);
      gemm_prefetch(GSTAGE_ARGS, Aof((us1 / NT) * 128), Bof((us1 % NT) * 128));
    }
    float* wl = (float*)sm + wave * 2048;
    const int ccol = n0 + wn * 64 + (lane & 7) * 8;
    const float4 bg0 = *(const float4*)(p.in[I_BGLU] + ccol), bg1 = *(const float4*)(p.in[I_BGLU] + ccol + 4);
#pragma unroll
    for (int mi = 0; mi < 2; ++mi) {
      float4 lo[4], hi[4];
      stage_half8(acc, mi, wl, lo, hi, lane);
      uint4 yv[4], zv[4];
#pragma unroll
      for (int c = 0; c < 4; ++c) {
        size_t o = (size_t)(m0 + wm * 64 + mi * 32 + c * 8 + (lane >> 3)) * 1024 + ccol;
        yv[c] = *(const uint4*)(YG + o);
        zv[c] = *(const uint4*)(SZ1 + o);
      }
      SCHED_FENCE();
#pragma unroll
      for (int c = 0; c < 4; ++c) {
        size_t o = (size_t)(m0 + wm * 64 + mi * 32 + c * 8 + (lane >> 3)) * 1024 + ccol;
        float4 y0 = bf4_to_f4(make_uint2(yv[c].x, yv[c].y)), y1 = bf4_to_f4(make_uint2(yv[c].z, yv[c].w));
        float4 z0 = bf4_to_f4(make_uint2(zv[c].x, zv[c].y)), z1 = bf4_to_f4(make_uint2(zv[c].z, zv[c].w));
        uint4 ov;
        ov.x = pk2(y0.x * sigmoid_f(lo[c].x + bg0.x) * z0.x, y0.y * sigmoid_f(lo[c].y + bg0.y) * z0.y);
        ov.y = pk2(y0.z * sigmoid_f(lo[c].z + bg0.z) * z0.z, y0.w * sigmoid_f(lo[c].w + bg0.w) * z0.w);
        ov.z = pk2(y1.x * sigmoid_f(hi[c].x + bg1.x) * z1.x, y1.y * sigmoid_f(hi[c].y + bg1.y) * z1.y);
        ov.w = pk2(y1.z * sigmoid_f(hi[c].z + bg1.z) * z1.z, y1.w * sigmoid_f(hi[c].w + bg1.w) * z1.w);
        *(uint4*)(Y2 + o) = ov;
      }
      SCHED_FENCE();
    }
    __syncthreads();
  }
}

#define XB_TMO      128
#define XB_XCNT(j)  (256  + 64 * (j))
#define XB_XSUB(j)  (1280 + 64 * (j))
#define XB_XGEN(j)  (2304 + 64 * (j))
#define XB_TOP      3328
#define XB_TOPGEN   3392
#define XCD_BAR_WORDS 3456
#define XB_SPIN_CAP (1u << 18)
#define LAS __attribute__((address_space(3)))
DI unsigned xb_ld(unsigned* p) { return __hip_atomic_load(p, __ATOMIC_RELAXED, __HIP_MEMORY_SCOPE_AGENT); }
DI unsigned xb_add(unsigned* p, unsigned v) { return __hip_atomic_fetch_add(p, v, __ATOMIC_RELAXED, __HIP_MEMORY_SCOPE_AGENT); }
DI unsigned xb_xcc_id() { return (unsigned)__builtin_amdgcn_s_getreg((3 << 11) | 20) & 0xFu; }
#define XB_SPIN(cond, bar) do { unsigned _sp = 0; while (cond) { __builtin_amdgcn_s_sleep(1); \
    if ((++_sp & 255u) == 0u) { if (xb_ld(&(bar)[XB_TMO])) break; if (_sp > XB_SPIN_CAP) { atomicAdd(&(bar)[XB_TMO], 1u); break; } } } } while (0)
struct XcdBarrier {
  unsigned* bar;
  unsigned x;
  volatile LAS unsigned* st;
};
DI XcdBarrier xcd_barrier_post(unsigned* bar, volatile LAS unsigned* st) {
  XcdBarrier b;
  b.bar = bar;
  b.x = xb_xcc_id();
  b.st = st;
  if (threadIdx.x == 0) (void)xb_add(&bar[XB_XCNT(b.x)], 1u);
  return b;
}
DI void xcd_barrier_complete(unsigned* bar, unsigned x, unsigned& nloc, unsigned& nx) {
  const unsigned G = gridDim.x * gridDim.y * gridDim.z;
  unsigned sum, cnt, mine, sp = 0u;
  for (;;) {
    sum = 0u; cnt = 0u; mine = 0u;
#pragma unroll
    for (unsigned j = 0; j < 16; ++j) {
      const unsigned c = xb_ld(&bar[XB_XCNT(j)]);
      sum += c;
      cnt += (c > 0u) ? 1u : 0u;
      mine = (j == x) ? c : mine;
    }
    if (sum == G) break;
    __builtin_amdgcn_s_sleep(1);
    if ((++sp & 255u) == 0u) {
      if (xb_ld(&bar[XB_TMO])) break;
      if (sp > XB_SPIN_CAP) { atomicAdd(&bar[XB_TMO], 1u); break; }
    }
  }
  nloc = mine > 0u ? mine : 1u;
  nx = cnt > 0u ? cnt : 1u;
}
DI void xcd_barrier(const XcdBarrier& b) {
  asm volatile("s_waitcnt vmcnt(0)" ::: "memory");
  __syncthreads();
  if (threadIdx.x == 0) {
    unsigned* bar = b.bar;
    __builtin_amdgcn_s_waitcnt(0);
    unsigned nloc = b.st[0], nx = b.st[1];
    if (nloc == 0u) {
      xcd_barrier_complete(bar, b.x, nloc, nx);
      b.st[0] = nloc;
      b.st[1] = nx;
    }
    const unsigned old = xb_add(&bar[XB_XSUB(b.x)], 1u);
    const unsigned gen = old / nloc;
    if (old + 1u == (gen + 1u) * nloc) {
      __builtin_amdgcn_fence(__ATOMIC_RELEASE, "agent");
      asm volatile("s_waitcnt vmcnt(0)" ::: "memory");
      const unsigned og = xb_add(&bar[XB_TOP], 1u);
      const unsigned tg = og / nx;
      if (og + 1u == (tg + 1u) * nx) xb_add(&bar[XB_TOPGEN], 1u);
      else XB_SPIN(xb_ld(&bar[XB_TOPGEN]) == tg, bar);
      __builtin_amdgcn_fence(__ATOMIC_ACQUIRE, "agent");
      xb_add(&bar[XB_XGEN(b.x)], 1u);
      asm volatile("s_waitcnt vmcnt(0)" ::: "memory");
    } else {
      XB_SPIN(xb_ld(&bar[XB_XGEN(b.x)]) == gen, bar);
      __builtin_amdgcn_fence(__ATOMIC_ACQUIRE, "agent");
      asm volatile("s_waitcnt vmcnt(0)" ::: "memory");
    }
  }
  __syncthreads();
}

DI void run_phase(const Params& p, int ph, char* smem) {
  switch (ph) {
#if !defined(ONLY) || ONLY == 0
    case PH_PREP: phase_prep(p, smem); break;
#endif
#if !defined(ONLY) || ONLY == 1
    case PH_FINAL: phase_final(p); break;
#endif
#if !defined(ONLY) || ONLY == 2
    case PH_O1: phase_o1(p, smem); break;
#endif
#if !defined(ONLY) || ONLY == 3
    case PH_O2: phase_o2(p, smem); break;
#endif
#if !defined(ONLY) || ONLY == 4
    case PH_O3: phase_o3(p, smem); break;
#endif
#if !defined(ONLY) || ONLY == 5
    case PH_O4: phase_oproj<0>(p, smem); break;
#endif
#if !defined(ONLY) || ONLY == 6
    case PH_O5: phase_o5(p, smem); break;
#endif
#if !defined(ONLY) || ONLY == 7
    case PH_O6: phase_o6(p, smem); break;
#endif
#if !defined(ONLY) || ONLY == 8
    case PH_O7: phase_o7(p); break;
#endif
#if !defined(ONLY) || ONLY == 9
    case PH_O8: phase_o8(p, smem); break;
#endif
#if !defined(ONLY) || ONLY == 10
    case PH_O9: phase_o9(p, smem); break;
#endif
#if !defined(ONLY) || ONLY == 11
    case PH_O10: phase_oproj<1>(p, smem); break;
#endif
    case PH_H0: phase_hconv<0>(p); break;
    case PH_H1: phase_hconv<1>(p); break;
    default: break;
  }
}

__global__ void __launch_bounds__(256, 2) mega_one(Params p, int ph) {
  __shared__ __attribute__((aligned(16))) char smem[SMEM_BYTES];
  run_phase(p, ph, smem);
}

#if !defined(ONLY) && SINGLE_LAUNCH
__global__ void __launch_bounds__(256, 2) mega(Params p) {
  __shared__ __attribute__((aligned(16))) char smem[SMEM_BYTES];
  __shared__ uint4 xb_words;
  if (threadIdx.x == 0) xb_words = make_uint4(0u, 0u, 0u, 0u);
  __syncthreads();
  if (p.nprog < 0) cg::this_grid().sync();
  const XcdBarrier xb = xcd_barrier_post((unsigned*)(p.ws + O_BAR), (volatile LAS unsigned*)&xb_words);
  cg::grid_group grid = cg::this_grid();
#if !defined(OMIT) || OMIT != 0
  phase_prep(p, smem);
#endif
  xcd_barrier(xb);
#if (DUP >> 0) & 1
  phase_prep(p, smem);
  xcd_barrier(xb);
#endif
  phase_hconv<0>(p);
  xcd_barrier(xb);
#if !defined(OMIT) || OMIT != 1
  phase_o1(p, smem);
#endif
  xcd_barrier(xb);
#if (DUP >> 1) & 1
  phase_o1(p, smem);
  xcd_barrier(xb);
#endif
#if !defined(OMIT) || OMIT != 2
  phase_o2(p, smem);
#endif
  xcd_barrier(xb);
#if (DUP >> 2) & 1
  phase_o2(p, smem);
  xcd_barrier(xb);
#endif
#if !defined(OMIT) || OMIT != 3
  phase_o3(p, smem);
#endif
  xcd_barrier(xb);
#if (DUP >> 3) & 1
  phase_o3(p, smem);
  xcd_barrier(xb);
#endif
#if !defined(OMIT) || OMIT != 4
  phase_oproj<0>(p, smem);
#endif
  xcd_barrier(xb);
#if (DUP >> 4) & 1
  phase_oproj<0>(p, smem);
  xcd_barrier(xb);
#endif
  phase_hconv<1>(p);
  xcd_barrier(xb);
#if !defined(OMIT) || OMIT != 5
  phase_o5(p, smem);
#endif
  xcd_barrier(xb);
#if (DUP >> 5) & 1
  phase_o5(p, smem);
  xcd_barrier(xb);
#endif
#if !defined(OMIT) || OMIT != 6
  phase_o6(p, smem);
#endif
  xcd_barrier(xb);
#if (DUP >> 6) & 1
  phase_o6(p, smem);
  xcd_barrier(xb);
#endif
#if !defined(OMIT) || OMIT != 7
  phase_o7(p);
#endif
  xcd_barrier(xb);
#if (DUP >> 7) & 1
  phase_o7(p);
  xcd_barrier(xb);
#endif
#if !defined(OMIT) || OMIT != 8
  phase_o8(p, smem);
#endif
  xcd_barrier(xb);
#if (DUP >> 8) & 1
  phase_o8(p, smem);
  xcd_barrier(xb);
#endif
#if !defined(OMIT) || OMIT != 9
  phase_o9(p, smem);
#endif
  xcd_barrier(xb);
#if (DUP >> 9) & 1
  phase_o9(p, smem);
  xcd_barrier(xb);
#endif
#if !defined(OMIT) || OMIT != 10
  phase_oproj<1>(p, smem);
#endif
  xcd_barrier(xb);
#if !defined(OMIT) || OMIT != 11
  phase_final(p);
#endif
}
#else
__global__ void mega(Params p) {}
#endif


extern "C" void kernel_launch(void* const* d_in, const int* in_sizes, int n_in, void* d_out, int out_size, void* d_ws,
                              size_t ws_size, hipStream_t stream) {
  static int grid_blocks = 0;
  if (!grid_blocks) {
    int dev = 0, cus = 0, per_cu = 0;
    hipGetDevice(&dev);
    hipDeviceGetAttribute(&cus, hipDeviceAttributeMultiprocessorCount, dev);
#if SINGLE_LAUNCH
    hipOccupancyMaxActiveBlocksPerMultiprocessor(&per_cu, mega, 256, 0);
#else
    hipOccupancyMaxActiveBlocksPerMultiprocessor(&per_cu, mega_one, 256, 0);
#endif
    if (per_cu < 1) per_cu = 1;
    if (per_cu > 2) per_cu = 2;
    grid_blocks = cus * per_cu;
  }
  if (ws_size < WS_NEED || n_in < N_INPUTS) {
    fprintf(stderr, "workspace too small or bad inputs: %zu < %zu\n", ws_size, (size_t)WS_NEED);
    return;
  }
  Params p{};
  for (int i = 0; i < N_INPUTS; ++i) p.in[i] = (const float*)d_in[i];
  p.out = (float*)d_out;
  p.ws = (char*)d_ws;
#ifndef PROG
#define PROG PH_PREP, PH_H0, PH_O1, PH_O2, PH_O3, PH_O4, PH_H1, PH_O5, PH_O6, PH_O7, PH_O8, PH_O9, PH_O10, PH_FINAL
#endif
  const int prog[] = {PROG};
  p.nprog = (int)(sizeof(prog) / sizeof(int));
  for (int i = 0; i < p.nprog; ++i) p.prog[i] = prog[i];
#if SINGLE_LAUNCH
  hipMemsetAsync((char*)d_ws + O_BAR, 0, BAR_BYTES, stream);
  void* args[] = {&p};
  hipError_t e = hipLaunchCooperativeKernel((void*)mega, dim3(grid_blocks), dim3(256), args, 0, stream);
  if (e != hipSuccess) fprintf(stderr, "cooperative launch failed: %s (grid %d)\n", hipGetErrorString(e), grid_blocks);
#else
  for (int i = 0; i < p.nprog; ++i) {
    mega_one<<<dim3(grid_blocks), dim3(256), 0, stream>>>(p, p.prog[i]);
  }
#endif
}
```

```cpp
#include <hip/hip_runtime.h>
#include <hip/hip_cooperative_groups.h>
#include <cstdio>
namespace cg = cooperative_groups;
#ifndef DUP
#define DUP 0
#endif
#ifndef USE_NAIVE
#define USE_NAIVE 0
#endif
#ifndef SINGLE_LAUNCH
#define SINGLE_LAUNCH 1
#endif

#define DI __device__ __forceinline__
typedef unsigned short bfr;

constexpr int D = 1024, NB = 8, SEQ = 2048, LC = 256, LALL = 2304;
constexpr int TOK = NB * LALL;
constexpr int NLAT = NB * SEQ;
constexpr int NH = 16, DQK = 96, DV = 64;
constexpr int NIN0 = 1440, NIN1 = 2048;
constexpr float EPS = 1e-6f;
constexpr float QSCALE = 0.10206207261596577f * 1.4426950408889634f;
constexpr int TC = 32;
constexpr int NCH = LALL / TC;
constexpr int NCHL = SEQ / TC;

enum { I_X = 0, I_C, I_CTX, I_CCTX, I_ADAW, I_ADAB, I_NORMG, I_WIN0, I_QNORM, I_WUQ, I_KVNORM, I_WUKV, I_WOUT0,
       I_WIN1, I_ARE, I_AIM, I_LOGSTEP, I_BRE, I_BIM, I_CRE, I_CIM, I_S5D, I_WGLU, I_BGLU, I_WOUT1, I_FINALG, N_INPUTS };

constexpr size_t al256(size_t x) { return (x + 255) & ~(size_t)255; }
constexpr size_t O_WT_IN0 = 0;
constexpr size_t O_WT_UQ = O_WT_IN0 + al256((size_t)NIN0 * 1024 * 2);
constexpr size_t O_WT_UKV = O_WT_UQ + al256((size_t)1536 * 256 * 2);
constexpr size_t O_WT_OUT0 = O_WT_UKV + al256((size_t)2048 * 128 * 2);
constexpr size_t O_WT_IN1 = O_WT_OUT0 + al256((size_t)1024 * 1024 * 2);
constexpr size_t O_WT_GLU = O_WT_IN1 + al256((size_t)2048 * 1024 * 2);
constexpr size_t O_WT_OUT1 = O_WT_GLU + al256((size_t)1024 * 1024 * 2);
constexpr size_t O_MOD = O_WT_OUT1 + al256((size_t)1024 * 1024 * 2);
constexpr size_t O_RS0 = O_MOD + al256((size_t)2 * 9 * 3072 * 4);
constexpr size_t O_PART1 = O_RS0 + al256((size_t)TOK * 4);
constexpr size_t O_PART2 = O_PART1 + al256((size_t)16 * TOK * 4);
constexpr size_t O_X1CTX = O_PART2 + al256((size_t)16 * NLAT * 4);
constexpr size_t O_KTAB = O_X1CTX + al256((size_t)NB * LC * 1024 * 4);
constexpr size_t O_WST = O_KTAB + al256((size_t)64 * 63 * 256 * 2);
constexpr size_t O_VOP = O_WST + al256((size_t)64 * 256 * 512 * 2);
constexpr size_t O_BAR = O_VOP + al256((size_t)64 * 512 * 256 * 2);
constexpr size_t BAR_BYTES = 3456 * 4;
constexpr size_t O_SHW = O_BAR + al256(BAR_BYTES);
constexpr size_t O_LAYER = O_SHW + al256((size_t)9 * 2048 * 4);
constexpr size_t O_PC = O_LAYER;
constexpr size_t O_SZ0 = O_PC + al256((size_t)TOK * 384 * 2);
constexpr size_t O_K = O_SZ0 + al256((size_t)TOK * 1024 * 2);
constexpr size_t O_VT = O_K + al256((size_t)NB * NH * LALL * 64 * 2);
constexpr size_t O_OG = O_VT + al256((size_t)NB * NH * DV * LALL * 2);
constexpr size_t O_KR = O_OG + al256((size_t)TOK * 1024 * 2);
constexpr size_t O_END0 = O_KR + al256((size_t)TOK * 32 * 2);
constexpr size_t O_H0 = O_OG;
constexpr size_t O_U2 = O_LAYER;
constexpr size_t O_SZ1 = O_U2 + al256((size_t)64 * TOK * 16 * 2);
constexpr size_t O_SLOC = O_SZ1 + al256((size_t)NLAT * 1024 * 2);
constexpr int SLOC_ROWS = 640;
constexpr size_t O_SIN = O_SLOC + al256((size_t)64 * SLOC_ROWS * 256 * 4);
constexpr size_t O_YG = O_SIN + al256((size_t)64 * (NB * NCHL) * 256 * 2);
constexpr size_t O_YG_END = O_YG + al256((size_t)NLAT * 1024 * 2);
constexpr size_t O_H1 = (O_END0 > O_YG_END ? O_END0 : O_YG_END);
constexpr size_t O_END1 = O_H1 + al256((size_t)TOK * 1024 * 2);
constexpr size_t O_Y2 = O_SLOC;
constexpr size_t WS_NEED = (O_END0 > O_END1 ? O_END0 : O_END1);
static_assert(WS_NEED <= (size_t)256 * 1024 * 1024, "workspace too large");
static_assert((size_t)NB * NH * LALL * DQK * 2 <= (size_t)NLAT * 1024 * 4, "Q does not fit d_out");

struct Params {
  const float* in[N_INPUTS];
  float* out;
  char* ws;
  int prog[32];
  int nprog;
  int pad;
};

DI bfr f2bf(float x) {
  unsigned u = __float_as_uint(x);
  u += 0x7fffu + ((u >> 16) & 1u);
  return (bfr)(u >> 16);
}
typedef __bf16 bf2_t __attribute__((ext_vector_type(2)));
typedef float f2_t __attribute__((ext_vector_type(2)));
DI unsigned pk2(float a, float b) {
  f2_t v = {a, b};
  bf2_t r = __builtin_convertvector(v, bf2_t);
  return __builtin_bit_cast(unsigned, r);
}
DI int opaque_tid() {
  int t = threadIdx.x;
  asm volatile("" : "+v"(t));
  return t;
}
DI float bf2f(bfr b) { return __uint_as_float(((unsigned)b) << 16); }
DI float silu_f(float v) { return v / (1.f + __expf(-v)); }
DI float sigmoid_f(float v) { return 1.f / (1.f + __expf(-v)); }
DI float gelu_tanh(float v) {
  float u = 0.7978845608028654f * (v + 0.044715f * v * v * v);
  return 0.5f * v * (1.f + tanhf(u));
}
DI float wave_sum(float v) {
#pragma unroll
  for (int o = 32; o > 0; o >>= 1) v += __shfl_xor(v, o);
  return v;
}
DI float wave_max(float v) {
#pragma unroll
  for (int o = 32; o > 0; o >>= 1) v = fmaxf(v, __shfl_xor(v, o));
  return v;
}
DI const float* xrow0(const Params& p, int tok) {
  int b = tok / LALL, pos = tok - b * LALL;
  return pos < LC ? p.in[I_CTX] + ((size_t)(b * LC + pos)) * D : p.in[I_X] + ((size_t)(b * SEQ + pos - LC)) * D;
}
DI float* xrow1(const Params& p, int tok) {
  int b = tok / LALL, pos = tok - b * LALL;
  return pos < LC ? (float*)(p.ws + O_X1CTX) + ((size_t)(b * LC + pos)) * D : p.out + ((size_t)(b * SEQ + pos - LC)) * D;
}
DI const float* modrow(const Params& p, int layer, int tok) {
  int b = tok / LALL, pos = tok - b * LALL;
  int r = pos < LC ? 8 : b;
  return (const float*)(p.ws + O_MOD) + ((size_t)(layer * 9 + r)) * 3072;
}
DI void rope_cs(int fi, int posv, float& cs, float& sn) {
  float inv = __builtin_amdgcn_exp2f(-(float)fi * (13.287712379549449f / 8.f));
  float rev = (float)posv * inv * 0.15915494309189535f;
  rev -= floorf(rev);
  sn = __builtin_amdgcn_sinf(rev);
  cs = __builtin_amdgcn_cosf(rev);
}
DI float rope_apply(int j, float v, float vp, int lpos) {
  int posv = (j & 16) ? (lpos & 63) : (lpos >> 6);
  float cs, sn;
  rope_cs(j & 7, posv, cs, sn);
  return (j & 8) ? (vp * sn + v * cs) : (v * cs - vp * sn);
}

DI void s5_disc(const Params& p, int dir, int g, int pp, double& dt, double& ar, double& ai, float& fr, float& fi) {
  dt = exp((double)p.in[I_LOGSTEP][dir * 64 + g]);
  ar = (double)p.in[I_ARE][(dir * 64 + g) * 64 + pp];
  ai = (double)p.in[I_AIM][(dir * 64 + g) * 64 + pp];
  double mag = exp(ar * dt);
  double a = ai * dt;
  a -= 6.283185307179586 * rint(a * 0.15915494309189535);
  float sn, cs;
  sincosf((float)a, &sn, &cs);
  double lr = mag * (double)cs, li = mag * (double)sn;
  double den = ar * ar + ai * ai, nr = lr - 1.0;
  fr = (float)((nr * ar + li * ai) / den);
  fi = (float)((li * ar - nr * ai) / den);
}
DI void s5_pow(double dt, double ar, double ai, int k, float& wr, float& wi) {
  double mag = exp(ar * dt * (double)k);
  double a = ai * dt * (double)k;
  a -= 6.283185307179586 * rint(a * 0.15915494309189535);
  float sn, cs;
  sincosf((float)a, &sn, &cs);
  wr = (float)mag * cs;
  wi = (float)mag * sn;
}

enum { PH_PREP = 0, PH_N1, PH_N2, PH_N3, PH_N4, PH_N4B, PH_N5, PH_N6A, PH_N6B, PH_N9, PH_N10, PH_N10B, PH_FINAL,
       PH_O1, PH_O2, PH_O3, PH_O4, PH_O5, PH_O6, PH_O7, PH_O8, PH_O9, PH_O10, PH_H0, PH_H1, PH_COUNT };

constexpr int SMEM_BYTES = 48 * 1024;


DI void prep_transpose(const Params& p, int widx, int tile, char* smem) {
  const int tidx_ = opaque_tid();
  int K, N;
  size_t dst;
  const float* W;
  const float* scl = nullptr;
  switch (widx) {
    case 0: W = p.in[I_WIN0]; K = 1024; N = NIN0; dst = O_WT_IN0; break;
    case 1: W = p.in[I_WUQ]; K = 256; N = 1536; dst = O_WT_UQ; scl = p.in[I_QNORM]; break;
    case 2: W = p.in[I_WUKV]; K = 128; N = 2048; dst = O_WT_UKV; scl = p.in[I_KVNORM]; break;
    case 3: W = p.in[I_WOUT0]; K = 1024; N = 1024; dst = O_WT_OUT0; break;
    case 4: W = p.in[I_WIN1]; K = 1024; N = NIN1; dst = O_WT_IN1; break;
    case 5: W = p.in[I_WGLU]; K = 1024; N = 1024; dst = O_WT_GLU; break;
    default: W = p.in[I_WOUT1]; K = 1024; N = 1024; dst = O_WT_OUT1; break;
  }
  float (*t)[33] = (float (*)[33])smem;
  int ntn = N / 32;
  int kt = tile / ntn, nt = tile - kt * ntn;
  int tx = tidx_ & 31, ty = tidx_ >> 5;
  float v[16];
#pragma unroll
  for (int i = 0; i < 16; ++i) {
    int k = kt * 128 + ty + 8 * i, n = nt * 32 + tx;
    v[i] = W[(size_t)k * N + n];
  }
  if (scl) {
#pragma unroll
    for (int i = 0; i < 16; ++i) v[i] *= scl[kt * 128 + ty + 8 * i];
  }
#pragma unroll
  for (int i = 0; i < 16; ++i) t[ty + 8 * i][tx] = v[i];
  __syncthreads();
  bfr* Wt = (bfr*)(p.ws + dst);
  {
    int nl = tidx_ >> 3, kc = (tidx_ & 7) * 16;
    unsigned w[8];
#pragma unroll
    for (int j = 0; j < 8; ++j) w[j] = pk2(t[kc + 2 * j][nl], t[kc + 2 * j + 1][nl]);
    uint4* dstp = (uint4*)(Wt + (size_t)(nt * 32 + nl) * K + kt * 128 + kc);
    dstp[0] = make_uint4(w[0], w[1], w[2], w[3]);
    dstp[1] = make_uint4(w[4], w[5], w[6], w[7]);
  }
  __syncthreads();
}

DI void prep_mod(const Params& p, int unit, char* smem) {
  const int tidx_ = opaque_tid();
  int layer = unit / 192, cgp = unit - layer * 192;
  float* sil = (float*)smem;
  float* red = sil + 9 * 1024;
  for (int i = tidx_; i < 9 * 1024; i += 256) {
    int r = i >> 10, k = i & 1023;
    float v = r < 8 ? p.in[I_C][r * 1024 + k] : p.in[I_CCTX][k];
    sil[i] = silu_f(v);
  }
  __syncthreads();
  int nn = tidx_ & 15, kg = tidx_ >> 4;
  int n = cgp * 16 + nn;
  const float* W = p.in[I_ADAW] + (size_t)layer * 1024 * 3072 + n;
  float acc[9];
#pragma unroll
  for (int r = 0; r < 9; ++r) acc[r] = 0.f;
#pragma unroll 1
  for (int k0 = kg * 64; k0 < kg * 64 + 64; k0 += 32) {
    float wv[32];
#pragma unroll
    for (int j = 0; j < 32; ++j) wv[j] = W[(size_t)(k0 + j) * 3072];
#pragma unroll
    for (int j = 0; j < 32; ++j) {
#pragma unroll
      for (int r = 0; r < 9; ++r) acc[r] += sil[r * 1024 + k0 + j] * wv[j];
    }
  }
#pragma unroll
  for (int r = 0; r < 9; ++r) red[(kg * 9 + r) * 16 + nn] = acc[r];
  __syncthreads();
  if (tidx_ < 144) {
    int r = tidx_ >> 4, c = tidx_ & 15;
    int nc = cgp * 16 + c;
    float s = p.in[I_ADAB][layer * 3072 + nc];
#pragma unroll
    for (int g = 0; g < 16; ++g) s += red[(g * 9 + r) * 16 + c];
    ((float*)(p.ws + O_MOD))[((size_t)(layer * 9 + r)) * 3072 + nc] = s;
  }
  __syncthreads();
}

DI void prep_shw(const Params& p, int unit, char* smem) {
  const int tidx_ = opaque_tid();
  int cgp = unit;
  float* sil = (float*)smem;
  float* red = sil + 9 * 1024;
  for (int i = tidx_; i < 9 * 1024; i += 256) {
    int r = i >> 10, k = i & 1023;
    sil[i] = ((const float*)(p.ws + O_MOD))[((size_t)(9 + r)) * 3072 + k];
  }
  __syncthreads();
  int nn = tidx_ & 15, kg = tidx_ >> 4;
  int n = cgp * 16 + nn;
  const float* W = p.in[I_WIN1] + n;
  float acc[9];
#pragma unroll
  for (int r = 0; r < 9; ++r) acc[r] = 0.f;
#pragma unroll 1
  for (int k0 = kg * 64; k0 < kg * 64 + 64; k0 += 32) {
    float wv[32];
#pragma unroll
    for (int j = 0; j < 32; ++j) wv[j] = W[(size_t)(k0 + j) * 2048];
#pragma unroll
    for (int j = 0; j < 32; ++j) {
#pragma unroll
      for (int r = 0; r < 9; ++r) acc[r] += sil[r * 1024 + k0 + j] * wv[j];
    }
  }
#pragma unroll
  for (int r = 0; r < 9; ++r) red[(kg * 9 + r) * 16 + nn] = acc[r];
  __syncthreads();
  if (tidx_ < 144) {
    int r = tidx_ >> 4, c = tidx_ & 15;
    int nc = cgp * 16 + c;
    float s = 0.f;
#pragma unroll
    for (int g = 0; g < 16; ++g) s += red[(g * 9 + r) * 16 + c];
    ((float*)(p.ws + O_SHW))[(size_t)r * 2048 + nc] = s;
  }
  __syncthreads();
}

DI void prep_ktab(const Params& p, int unit, char* smem) {
  const int tidx_ = opaque_tid();
  int g = unit / 7, lg = unit - g * 7;
  float2* E = (float2*)smem;
  int tid = tidx_;
  const bool use_f = lg >= 3, use_r = lg <= 3;
  for (int i = tid; i < 9 * 128; i += 256) {
    int l = i >> 7, dir = (i >> 6) & 1, pp = i & 63;
    int lag = lg * 9 + l - 31;
    bool used = (dir == 0) ? (lag >= 0) : (lag <= 0);
    float2 e = make_float2(0.f, 0.f);
    if (used) {
      double dt, ar, ai;
      float fr, fi, wr, wi;
      s5_disc(p, dir, g, pp, dt, ar, ai, fr, fi);
      s5_pow(dt, ar, ai, lag < 0 ? -lag : lag, wr, wi);
      e.x = wr * fr - wi * fi;
      e.y = wr * fi + wi * fr;
    }
    E[(l * 2 + dir) * 64 + pp] = e;
  }
  float* PB = (float*)(E + 9 * 128);
  for (int dir = 0; dir < 2; ++dir) {
    if (dir == 0 ? !use_f : !use_r) continue;
    const float4* s0 = (const float4*)(p.in[I_BRE] + ((size_t)(dir * 64 + g)) * 1024);
    const float4* s1 = (const float4*)(p.in[I_BIM] + ((size_t)(dir * 64 + g)) * 1024);
    const float4* s2 = (const float4*)(p.in[I_CRE] + ((size_t)(dir * 64 + g)) * 1024);
    const float4* s3 = (const float4*)(p.in[I_CIM] + ((size_t)(dir * 64 + g)) * 1024);
    float4* d = (float4*)(PB + dir * 4096);
    d[tid] = s0[tid];
    d[256 + tid] = s1[tid];
    d[512 + tid] = s2[tid];
    d[768 + tid] = s3[tid];
  }
  __syncthreads();
  int c = tid >> 4, c2 = tid & 15;
  float acc[9];
#pragma unroll
  for (int l = 0; l < 9; ++l) acc[l] = 0.f;
  for (int dir = 0; dir < 2; ++dir) {
    if (dir == 0 ? !use_f : !use_r) continue;
    const float* bre = PB + dir * 4096;
    const float* bim = bre + 1024;
    const float* cre = bre + 2048;
    const float* cim = bre + 3072;
#pragma unroll 4
    for (int pp = 0; pp < 64; ++pp) {
      float br = bre[pp * 16 + c2], bi = bim[pp * 16 + c2];
      float cr = cre[c * 64 + pp], ci = cim[c * 64 + pp];
      float mr = cr * br - ci * bi, mi = cr * bi + ci * br;
#pragma unroll
      for (int l = 0; l < 9; ++l) {
        float2 e = E[(l * 2 + dir) * 64 + pp];
        acc[l] += mr * e.x - mi * e.y;
      }
    }
  }
  bfr* KT = (bfr*)(p.ws + O_KTAB);
#pragma unroll
  for (int l = 0; l < 9; ++l) KT[(((size_t)g * 63 + lg * 9 + l) * 16 + c) * 16 + c2] = f2bf(acc[l]);
  __syncthreads();
}

DI void prep_ops(const Params& p, int unit) {
  const int tidx_ = opaque_tid();
  int idx = unit * 256 + tidx_;
  int pp = idx & 63, t = (idx >> 6) & 31, dir = (idx >> 11) & 1, g = idx >> 12;
  double dt, ar, ai;
  float fr, fi, wr, wi;
  s5_disc(p, dir, g, pp, dt, ar, ai, fr, fi);
  s5_pow(dt, ar, ai, dir == 0 ? (TC - 1 - t) : t, wr, wi);
  float er = wr * fr - wi * fi, ei = wr * fi + wi * fr;
  const float* bre = p.in[I_BRE] + (((size_t)(dir * 64 + g)) * 64 + pp) * 16;
  const float* bim = p.in[I_BIM] + (((size_t)(dir * 64 + g)) * 64 + pp) * 16;
  bfr* wst = (bfr*)(p.ws + O_WST) + (size_t)g * 256 * 512;
  bfr* rre = wst + (size_t)(dir * 128 + pp) * 512 + t * 16;
  bfr* rim = wst + (size_t)(dir * 128 + 64 + pp) * 512 + t * 16;
#pragma unroll
  for (int c2 = 0; c2 < 16; ++c2) {
    float br = bre[c2], bi = bim[c2];
    rre[c2] = f2bf(er * br - ei * bi);
    rim[c2] = f2bf(er * bi + ei * br);
  }
  s5_pow(dt, ar, ai, dir == 0 ? (t + 1) : (TC - t), wr, wi);
  const float* cre = p.in[I_CRE] + ((size_t)(dir * 64 + g)) * 16 * 64;
  const float* cim = p.in[I_CIM] + ((size_t)(dir * 64 + g)) * 16 * 64;
  bfr* vop = (bfr*)(p.ws + O_VOP) + (size_t)g * 512 * 256;
#pragma unroll
  for (int c = 0; c < 16; ++c) {
    float cr = cre[c * 64 + pp], ci = cim[c * 64 + pp];
    float dr = cr * wr - ci * wi, di = cr * wi + ci * wr;
    vop[(size_t)(t * 16 + c) * 256 + dir * 128 + pp] = f2bf(dr);
    vop[(size_t)(t * 16 + c) * 256 + dir * 128 + 64 + pp] = f2bf(-di);
  }
}

constexpr int TR_T0 = 8 * 45, TR_T1 = 2 * 48, TR_T2 = 1 * 64, TR_T3 = 256, TR_T4 = 8 * 64, TR_T5 = 256, TR_T6 = 256;
constexpr int TR_TOTAL = TR_T0 + TR_T1 + TR_T2 + TR_T3 + TR_T4 + TR_T5 + TR_T6;
constexpr int U_MOD = 384, U_RS0 = 0, U_KTAB = 64 * 7, U_OPS = 64 * 2 * 64 * 32 / 256;
constexpr int PREP_A_UNITS = U_MOD + TR_T0 + TR_T1 + TR_T2 + TR_T3;
constexpr int U_SHW = 128;
constexpr int PREP_B_UNITS = TR_T4 + TR_T5 + TR_T6 + U_KTAB + U_OPS + U_SHW;

DI void phase_prep(const Params& p, char* smem) {
  for (int u = blockIdx.x; u < PREP_A_UNITS; u += gridDim.x) {
    int v = u;
    if (v < U_MOD) { prep_mod(p, v, smem); continue; }
    v -= U_MOD;
    int w = 0;
    if (v >= TR_T0) { v -= TR_T0; w = 1;
      if (v >= TR_T1) { v -= TR_T1; w = 2;
        if (v >= TR_T2) { v -= TR_T2; w = 3; } } }
    prep_transpose(p, w, v, smem);
  }
}
DI void phase_prep_b(const Params& p, char* smem, int first_blk) {
  if (first_blk >= (int)gridDim.x) first_blk = 0;
  if ((int)blockIdx.x < first_blk) return;
  const int nb = gridDim.x - first_blk;
  for (int u = blockIdx.x - first_blk; u < PREP_B_UNITS; u += nb) {
    int v = u;
    if (v < TR_T4 + TR_T5 + TR_T6) {
      int w = 4;
      if (v >= TR_T4) { v -= TR_T4; w = 5;
        if (v >= TR_T5) { v -= TR_T5; w = 6; } }
      prep_transpose(p, w, v, smem);
      continue;
    }
    v -= TR_T4 + TR_T5 + TR_T6;
    if (v < U_KTAB) { prep_ktab(p, v, smem); continue; }
    v -= U_KTAB;
    if (v < U_OPS) { prep_ops(p, v); continue; }
    v -= U_OPS;
    prep_shw(p, v, smem);
  }
}

DI float rs_from_part(const float* part, int nrows, int r) {
  float s = 0.f;
#pragma unroll
  for (int j = 0; j < 16; ++j) s += part[(size_t)j * nrows + r];
  return rsqrtf(s * (1.f / 1024.f) + EPS);
}

DI void phase_final(const Params& p) {
  const int tidx_ = opaque_tid();
  const float* part = (const float*)(p.ws + O_PART2);
  const float4* g4 = (const float4*)p.in[I_FINALG];
  int lane = tidx_ & 63;
  float4 g[4];
#pragma unroll
  for (int i = 0; i < 4; ++i) g[i] = g4[lane + 64 * i];
  for (int r = (blockIdx.x * 4 + (tidx_ >> 6)) * 2; r < NLAT; r += gridDim.x * 8) {
    float4* row0 = (float4*)(p.out + (size_t)r * D);
    float4* row1 = row0 + D / 4;
    float4 v0[4], v1[4];
#pragma unroll
    for (int i = 0; i < 4; ++i) {
      v0[i] = row0[lane + 64 * i];
      v1[i] = row1[lane + 64 * i];
    }
    float ps = part[(size_t)(lane & 15) * NLAT + r + ((lane >> 4) & 1)];
    ps += __shfl_xor(ps, 1);
    ps += __shfl_xor(ps, 2);
    ps += __shfl_xor(ps, 4);
    ps += __shfl_xor(ps, 8);
    const float rs0 = rsqrtf(__shfl(ps, 0) * (1.f / 1024.f) + EPS);
    const float rs1 = rsqrtf(__shfl(ps, 16) * (1.f / 1024.f) + EPS);
#pragma unroll
    for (int i = 0; i < 4; ++i) {
      float4 a = v0[i], c = v1[i];
      a.x *= rs0 * g[i].x; a.y *= rs0 * g[i].y; a.z *= rs0 * g[i].z; a.w *= rs0 * g[i].w;
      c.x *= rs1 * g[i].x; c.y *= rs1 * g[i].y; c.z *= rs1 * g[i].z; c.w *= rs1 * g[i].w;
      row0[lane + 64 * i] = a;
      row1[lane + 64 * i] = c;
    }
  }
}

typedef short bf16x8 __attribute__((ext_vector_type(8)));
typedef short s16x4 __attribute__((ext_vector_type(4)));
typedef float f32x16 __attribute__((ext_vector_type(16)));
#define SCHED_FENCE() __builtin_amdgcn_sched_barrier(0)
#define MFMA32(a, b, c) __builtin_amdgcn_mfma_f32_32x32x16_bf16((a), (b), (c), 0, 0, 0)
DI int xcd_swz(int u, int per) {
  int x = u & 7, q = u >> 3;
  int qq = q / per;
  return (x + 8 * qq) * per + (q - qq * per);
}
DI int crow(int i, int h) { return (i & 3) + 8 * (i >> 2) + 4 * h; }

constexpr int LDT = 40;
struct GemmSmem {
  bfr A[2][128 * LDT];
  bfr B[2][128 * LDT];
  float rs[128];
};
static_assert(sizeof(GemmSmem) <= SMEM_BYTES, "smem");

DI void zero_acc(f32x16 (&acc)[2][2]) {
#pragma unroll
  for (int a = 0; a < 2; ++a)
#pragma unroll
    for (int b = 0; b < 2; ++b)
#pragma unroll
      for (int i = 0; i < 16; ++i) acc[a][b][i] = 0.f;
}

#define GSTAGE_DECL uint4 ga0, ga1, gb0, gb1, gc0, gc1, gd0, gd1
#define GSTAGE_ARGS ga0, ga1, gb0, gb1, gc0, gc1, gd0, gd1
#define GSTAGE_PARAMS uint4 &a0, uint4 &a1, uint4 &b0, uint4 &b1, uint4 &c0, uint4 &c1, uint4 &d0, uint4 &d1
template <class AAddr, class BAddr>
DI void gemm_prefetch(GSTAGE_PARAMS, AAddr aaddr, BAddr baddr) {
  const int tid = opaque_tid();
  const int lrow = tid >> 2, lkc = (tid & 3) * 8;
  b0 = *(const uint4*)baddr(lrow, lkc);
  b1 = *(const uint4*)baddr(lrow + 64, lkc);
  a0 = *(const uint4*)aaddr(lrow, lkc);
  a1 = *(const uint4*)aaddr(lrow + 64, lkc);
  d0 = *(const uint4*)baddr(lrow, 32 + lkc);
  d1 = *(const uint4*)baddr(lrow + 64, 32 + lkc);
  c0 = *(const uint4*)aaddr(lrow, 32 + lkc);
  c1 = *(const uint4*)aaddr(lrow + 64, 32 + lkc);
  SCHED_FENCE();
}
template <class AAddr, class BAddr>
DI void gemm_main(f32x16 (&acc)[2][2], int KT, AAddr aaddr, BAddr baddr, GemmSmem* sm, GSTAGE_PARAMS) {
  const int tid = opaque_tid(), lane = tid & 63, wave = tid >> 6;
  const int wm = wave >> 1, wn = wave & 1, r = lane & 31, h = lane >> 5;
  const int lrow = tid >> 2, lkc = (tid & 3) * 8;
#define GM_LOAD(KT_, A0, A1, B0, B1)                   \
  {                                                    \
    const int kk_ = (KT_) * 32 + lkc;                  \
    B0 = *(const uint4*)baddr(lrow, kk_);              \
    B1 = *(const uint4*)baddr(lrow + 64, kk_);         \
    A0 = *(const uint4*)aaddr(lrow, kk_);              \
    A1 = *(const uint4*)aaddr(lrow + 64, kk_);         \
  }
#define GM_STORE(BUF_, A0, A1, B0, B1)                                  \
  {                                                                     \
    *(uint4*)(sm->B[BUF_] + lrow * LDT + lkc) = B0;                     \
    *(uint4*)(sm->B[BUF_] + (lrow + 64) * LDT + lkc) = B1;              \
    *(uint4*)(sm->A[BUF_] + lrow * LDT + lkc) = A0;                     \
    *(uint4*)(sm->A[BUF_] + (lrow + 64) * LDT + lkc) = A1;              \
  }
#define GM_COMPUTE(BUF_)                                                                                       \
  _Pragma("unroll") for (int ks = 0; ks < 2; ++ks) {                                                           \
    bf16x8 a_[2], b_[2];                                                                                       \
    _Pragma("unroll") for (int mi = 0; mi < 2; ++mi)                                                           \
        a_[mi] = *(const bf16x8*)(sm->A[BUF_] + (wm * 64 + mi * 32 + r) * LDT + ks * 16 + h * 8);              \
    _Pragma("unroll") for (int ni = 0; ni < 2; ++ni)                                                           \
        b_[ni] = *(const bf16x8*)(sm->B[BUF_] + (wn * 64 + ni * 32 + r) * LDT + ks * 16 + h * 8);              \
    _Pragma("unroll") for (int mi = 0; mi < 2; ++mi)                                                           \
        _Pragma("unroll") for (int ni = 0; ni < 2; ++ni) acc[mi][ni] = MFMA32(a_[mi], b_[ni], acc[mi][ni]);    \
  }
  GM_STORE(0, a0, a1, b0, b1)
  if (KT > 2) GM_LOAD(2, a0, a1, b0, b1)
  SCHED_FENCE();
  __syncthreads();
  for (int kt = 0; kt < KT; kt += 2) {
    GM_STORE(1, c0, c1, d0, d1)
    if (kt + 3 < KT) GM_LOAD(kt + 3, c0, c1, d0, d1)
    SCHED_FENCE();
    GM_COMPUTE(0)
    __syncthreads();
    if (kt + 2 < KT) GM_STORE(0, a0, a1, b0, b1)
    if (kt + 4 < KT) GM_LOAD(kt + 4, a0, a1, b0, b1)
    SCHED_FENCE();
    GM_COMPUTE(1)
    __syncthreads();
  }
}

template <class AAddr, class BAddr>
DI void gemm_full(f32x16 (&acc)[2][2], int KT, AAddr aaddr, BAddr baddr, GemmSmem* sm) {
  GSTAGE_DECL;
  gemm_prefetch(GSTAGE_ARGS, aaddr, baddr);
  gemm_main(acc, KT, aaddr, baddr, sm, GSTAGE_ARGS);
}

DI float transpose_reduce16(float (&v)[16], int lane) {
  float r8[8], r4[4], r2[2];
  {
    bool up = lane & 8;
#pragma unroll
    for (int i = 0; i < 8; ++i) {
      float send = up ? v[i] : v[i + 8];
      float keep = up ? v[i + 8] : v[i];
      r8[i] = keep + __shfl_xor(send, 8);
    }
  }
  {
    bool up = lane & 4;
#pragma unroll
    for (int i = 0; i < 4; ++i) {
      float send = up ? r8[i] : r8[i + 4];
      float keep = up ? r8[i + 4] : r8[i];
      r4[i] = keep + __shfl_xor(send, 4);
    }
  }
  {
    bool up = lane & 2;
#pragma unroll
    for (int i = 0; i < 2; ++i) {
      float send = up ? r4[i] : r4[i + 2];
      float keep = up ? r4[i + 2] : r4[i];
      r2[i] = keep + __shfl_xor(send, 2);
    }
  }
  bool up = lane & 1;
  float send = up ? r2[0] : r2[1];
  float keep = up ? r2[1] : r2[0];
  return keep + __shfl_xor(send, 1);
}

DI void stage_half(const f32x16 (&acc)[2][2], int mi, float* wl, float4 (&v)[8], int lane) {
  const int r = lane & 31, h = lane >> 5;
#pragma unroll
  for (int ni = 0; ni < 2; ++ni)
#pragma unroll
    for (int i = 0; i < 16; ++i) wl[crow(i, h) * 64 + ni * 32 + r] = acc[mi][ni][i];
  asm volatile("s_waitcnt lgkmcnt(0)" ::: "memory");
#pragma unroll
  for (int c = 0; c < 8; ++c) v[c] = *(const float4*)(wl + (c * 4 + (lane >> 4)) * 64 + (lane & 15) * 4);
  asm volatile("s_waitcnt lgkmcnt(0)" ::: "memory");
}
DI void stage_half8(const f32x16 (&acc)[2][2], int mi, float* wl, float4 (&lo)[4], float4 (&hi)[4], int lane) {
  const int r = lane & 31, h = lane >> 5;
#pragma unroll
  for (int ni = 0; ni < 2; ++ni)
#pragma unroll
    for (int i = 0; i < 16; ++i) wl[crow(i, h) * 64 + ni * 32 + r] = acc[mi][ni][i];
  asm volatile("s_waitcnt lgkmcnt(0)" ::: "memory");
#pragma unroll
  for (int c = 0; c < 4; ++c) {
    const float* pch = wl + (c * 8 + (lane >> 3)) * 64 + (lane & 7) * 8;
    lo[c] = *(const float4*)pch;
    hi[c] = *(const float4*)(pch + 4);
  }
  asm volatile("s_waitcnt lgkmcnt(0)" ::: "memory");
}
DI float4 bf4_to_f4(uint2 u) {
  return make_float4(__uint_as_float(u.x << 16), __uint_as_float(u.x & 0xffff0000u), __uint_as_float(u.y << 16),
                     __uint_as_float(u.y & 0xffff0000u));
}
DI uint2 f4_to_bf4(float4 f) { return make_uint2(pk2(f.x, f.y), pk2(f.z, f.w)); }

#define WAVE_IDS                                              \
  const int tid = opaque_tid(), lane = tid & 63, wave = tid >> 6; \
  const int wm = wave >> 1, wn = wave & 1, r = lane & 31, h = lane >> 5; \
  (void)wm; (void)wn; (void)r; (void)h;

template <int LAYER>
DI void phase_hconv(const Params& p) {
  const int tid = opaque_tid(), lane = tid & 63;
  bfr* H = (bfr*)(p.ws + (LAYER == 0 ? O_H0 : O_H1));
  const float4* ng4 = (const float4*)(p.in[I_NORMG] + LAYER * 1024);
  for (int tok = (blockIdx.x * 4 + (tid >> 6)) * 2; tok < TOK; tok += gridDim.x * 8) {
    const float4* xr0 = (const float4*)(LAYER == 0 ? xrow0(p, tok) : (const float*)xrow1(p, tok));
    const float4* xr1 = xr0 + 256;
    const float4* md4 = (const float4*)modrow(p, LAYER, tok);
    float4 x0[4], x1[4], gm[4], sh[4];
#pragma unroll
    for (int i = 0; i < 4; ++i) {
      x0[i] = xr0[lane + 64 * i];
      x1[i] = xr1[lane + 64 * i];
      float4 gv = ng4[lane + 64 * i];
      float4 sc = md4[256 + lane + 64 * i];
      sh[i] = md4[lane + 64 * i];
      gm[i] = make_float4(gv.x * (1.f + sc.x), gv.y * (1.f + sc.y), gv.z * (1.f + sc.z), gv.w * (1.f + sc.w));
    }
    float s0 = 0.f, s1 = 0.f;
#pragma unroll
    for (int i = 0; i < 4; ++i) {
      s0 += x0[i].x * x0[i].x + x0[i].y * x0[i].y + x0[i].z * x0[i].z + x0[i].w * x0[i].w;
      s1 += x1[i].x * x1[i].x + x1[i].y * x1[i].y + x1[i].z * x1[i].z + x1[i].w * x1[i].w;
    }
    s0 = wave_sum(s0);
    s1 = wave_sum(s1);
    const float r0 = rsqrtf(s0 * (1.f / 1024.f) + EPS), r1 = rsqrtf(s1 * (1.f / 1024.f) + EPS);
#pragma unroll
    for (int i = 0; i < 4; ++i) {
      uint2 o0, o1;
      o0.x = pk2(x0[i].x * r0 * gm[i].x + sh[i].x, x0[i].y * r0 * gm[i].y + sh[i].y);
      o0.y = pk2(x0[i].z * r0 * gm[i].z + sh[i].z, x0[i].w * r0 * gm[i].w + sh[i].w);
      o1.x = pk2(x1[i].x * r1 * gm[i].x + sh[i].x, x1[i].y * r1 * gm[i].y + sh[i].y);
      o1.y = pk2(x1[i].z * r1 * gm[i].z + sh[i].z, x1[i].w * r1 * gm[i].w + sh[i].w);
      *(uint2*)(H + (size_t)tok * 1024 + (lane + 64 * i) * 4) = o0;
      *(uint2*)(H + (size_t)(tok + 1) * 1024 + (lane + 64 * i) * 4) = o1;
    }
  }
}

DI void phase_o1(const Params& p, char* smem) {
  GemmSmem* sm = (GemmSmem*)smem;
  WAVE_IDS
  const int NT = 12, units = (TOK / 128) * NT;
  const bfr* WT = (const bfr*)(p.ws + O_WT_IN0);
  bfr* PC = (bfr*)(p.ws + O_PC);
  bfr* SZ0 = (bfr*)(p.ws + O_SZ0);
  bfr* KRb = (bfr*)(p.ws + O_KR);
  const bfr* Ah = (const bfr*)(p.ws + O_H0);
  auto Aof = [&](int m0) { return [=](int row, int k) { return Ah + (size_t)(m0 + row) * 1024 + k; }; };
  auto Bof = [&](int n0) {
    return [=](int row, int k) {
      int n = n0 + row;
      n = n < NIN0 ? n : NIN0 - 1;
      return WT + (size_t)n * 1024 + k;
    };
  };
  GSTAGE_DECL;
  if ((int)blockIdx.x < units) {
    const int us = xcd_swz(blockIdx.x, NT);
    gemm_prefetch(GSTAGE_ARGS, Aof((us / NT) * 128), Bof((us % NT) * 128));
  }
  for (int u = blockIdx.x; u < units; u += gridDim.x) {
    const int us = xcd_swz(u, NT);
    int mt = us / NT, nt = us - mt * NT;
    int m0 = mt * 128, n0 = nt * 128;
    f32x16 acc[2][2];
    zero_acc(acc);
    gemm_main(acc, 32, Aof(m0), Bof(n0), sm, GSTAGE_ARGS);
    if (u + (int)gridDim.x < units) {
      const int us1 = xcd_swz(u + gridDim.x, NT);
      gemm_prefetch(GSTAGE_ARGS, Aof((us1 / NT) * 128), Bof((us1 % NT) * 128));
    }
    int b = m0 / LALL, pos0 = m0 - b * LALL;
    bool lat = pos0 >= LC;
    (void)b;
    if (lat && n0 + wn * 64 == 384) {
#pragma unroll
      for (int mi = 0; mi < 2; ++mi)
#pragma unroll
        for (int i = 0; i < 16; ++i) {
          int pos = pos0 + wm * 64 + mi * 32 + crow(i, h);
          float v = acc[mi][0][i];
          float vp = __shfl_xor(v, 8);
          acc[mi][0][i] = rope_apply(r, v, vp, pos - LC);
        }
    }
    {
      float* wl = (float*)sm + wave * 2048;
      const int col = n0 + wn * 64 + (lane & 7) * 8;
#pragma unroll
      for (int mi = 0; mi < 2; ++mi) {
        float4 lo[4], hi[4];
        stage_half8(acc, mi, wl, lo, hi, lane);
#pragma unroll
        for (int c = 0; c < 4; ++c) {
          int tok = m0 + wm * 64 + mi * 32 + c * 8 + (lane >> 3);
          if (col < 416) {
            uint4 o;
            o.x = pk2(lo[c].x, lo[c].y);
            o.y = pk2(lo[c].z, lo[c].w);
            o.z = pk2(hi[c].x, hi[c].y);
            o.w = pk2(hi[c].z, hi[c].w);
            bfr* dst = col < 384 ? PC + (size_t)tok * 384 + col : KRb + (size_t)tok * 32 + (col - 384);
            *(uint4*)dst = o;
          } else if (col < NIN0) {
            uint4 o;
            o.x = pk2(silu_f(lo[c].x), silu_f(lo[c].y));
            o.y = pk2(silu_f(lo[c].z), silu_f(lo[c].w));
            o.z = pk2(silu_f(hi[c].x), silu_f(hi[c].y));
            o.w = pk2(silu_f(hi[c].z), silu_f(hi[c].w));
            *(uint4*)(SZ0 + (size_t)tok * 1024 + (col - 416)) = o;
          }
        }
      }
      __syncthreads();
    }
  }
}

DI void phase_o2(const Params& p, char* smem) {
  GemmSmem* sm = (GemmSmem*)smem;
  WAVE_IDS
  const int UQ = (TOK / 128) * 12, UKV = (TOK / 128) * 16;
  const bfr* PC = (const bfr*)(p.ws + O_PC);
  bfr* Q = (bfr*)p.out;
  bfr* Kb = (bfr*)(p.ws + O_K);
  bfr* VT = (bfr*)(p.ws + O_VT);
  const int total = UQ + UKV;
  const int per_blk = (total + gridDim.x - 1) / gridDim.x;
  const int u_beg = blockIdx.x * per_blk;
  const int u_end = u_beg + per_blk < total ? u_beg + per_blk : total;
  int prev_key = -1;
  for (int us = u_beg; us < u_end; ++us) {
    int mt = us / 28, rem = us - mt * 28;
    bool isq = rem < 12;
    int nt = isq ? rem : rem - 12;
    int m0 = mt * 128, n0 = nt * 128;
    int Kd = isq ? 256 : 128;
    int aoff = isq ? 0 : 256;
    const bfr* WT = (const bfr*)(p.ws + (isq ? O_WT_UQ : O_WT_UKV));
    const int key = mt * 2 + (isq ? 0 : 1);
    if (key != prev_key) {
      prev_key = key;
      __syncthreads();
      int row = tid >> 1, half = tid & 1;
      const bfr* ap = PC + (size_t)(m0 + row) * 384 + aoff + half * (Kd / 2);
      float ss = 0.f;
      for (int j = 0; j < Kd / 16; ++j) {
        uint4 v = *(const uint4*)(ap + j * 8);
        unsigned w[4] = {v.x, v.y, v.z, v.w};
#pragma unroll
        for (int e = 0; e < 4; ++e) {
          float lo = __uint_as_float(w[e] << 16), hi = __uint_as_float(w[e] & 0xffff0000u);
          ss += lo * lo + hi * hi;
        }
      }
      ss += __shfl_xor(ss, 1);
      if (half == 0) sm->rs[row] = rsqrtf(ss / (float)Kd + EPS);
      __syncthreads();
    }
    f32x16 acc[2][2];
    zero_acc(acc);
    gemm_full(
        acc, Kd / 32, [&](int row, int k) { return PC + (size_t)(m0 + row) * 384 + aoff + k; },
        [&](int row, int k) { return WT + (size_t)(n0 + row) * Kd + k; }, sm);
    int b = m0 / LALL, pos0 = m0 - b * LALL;
    bool lat = pos0 >= LC;
    float* wl = (float*)sm + wave * 2048;
    if (isq || wn == 0) {
      if (isq && lat) {
#pragma unroll
        for (int ni = 0; ni < 2; ++ni) {
          int col0 = n0 + wn * 64 + ni * 32;
          if (col0 % 96 == 64) {
#pragma unroll
            for (int mi = 0; mi < 2; ++mi)
#pragma unroll
              for (int i = 0; i < 16; ++i) {
                int pos = pos0 + wm * 64 + mi * 32 + crow(i, h);
                float v = acc[mi][ni][i];
                float vp = __shfl_xor(v, 8);
                acc[mi][ni][i] = rope_apply(r, v, vp, pos - LC);
              }
          }
        }
      }
      const int c0 = wn * 64 + (lane & 7) * 8;
      bfr* dst;
      int rstride;
      float oscale;
      if (isq) {
        int col = n0 + c0;
        int hh = col / 96, d = col - hh * 96;
        dst = Q + ((size_t)(b * NH + hh) * LALL) * DQK + d;
        rstride = DQK;
        oscale = QSCALE;
      } else {
        int hh = n0 >> 7;
        dst = Kb + ((size_t)(b * NH + hh) * LALL) * 64 + c0;
        rstride = 64;
        oscale = 1.f;
      }
#pragma unroll
      for (int mi = 0; mi < 2; ++mi) {
        float4 lo[4], hi[4];
        stage_half8(acc, mi, wl, lo, hi, lane);
#pragma unroll
        for (int c = 0; c < 4; ++c) {
          int row = wm * 64 + mi * 32 + c * 8 + (lane >> 3);
          float sc = sm->rs[row] * oscale;
          uint4 o;
          o.x = pk2(lo[c].x * sc, lo[c].y * sc);
          o.y = pk2(lo[c].z * sc, lo[c].w * sc);
          o.z = pk2(hi[c].x * sc, hi[c].y * sc);
          o.w = pk2(hi[c].z * sc, hi[c].w * sc);
          *(uint4*)(dst + (size_t)(pos0 + row) * rstride) = o;
        }
      }
    } else {
      int hh = n0 >> 7;
#pragma unroll
      for (int mi = 0; mi < 2; ++mi)
#pragma unroll
        for (int ni = 0; ni < 2; ++ni) {
          int dvv = ni * 32 + r;
#pragma unroll
          for (int g4 = 0; g4 < 4; ++g4) {
            int row = wm * 64 + mi * 32 + 8 * g4 + 4 * h;
            int pos = pos0 + row;
            uint2 o;
            o.x = pk2(acc[mi][ni][4 * g4 + 0] * sm->rs[row + 0], acc[mi][ni][4 * g4 + 1] * sm->rs[row + 1]);
            o.y = pk2(acc[mi][ni][4 * g4 + 2] * sm->rs[row + 2], acc[mi][ni][4 * g4 + 3] * sm->rs[row + 3]);
            *(uint2*)(VT + (((size_t)(b * NH + hh)) * DV + dvv) * LALL + pos) = o;
          }
        }
    }
    __syncthreads();
  }
}

constexpr int KLD = 104;
constexpr int VLD = 68;
struct AttnSmem {
  bfr K[64 * KLD];
  bfr V[64 * VLD];
};
static_assert(sizeof(AttnSmem) <= SMEM_BYTES, "smem");

DI void attn_item(const Params& p, AttnSmem* sm, int bh, int qpos0, int nkeys) {
  WAVE_IDS
  const bfr* Q = (const bfr*)p.out;
  const bfr* Kg = (const bfr*)(p.ws + O_K) + (size_t)bh * LALL * 64;
  const bfr* KRg = (const bfr*)(p.ws + O_KR) + (size_t)(bh / NH) * LALL * 32;
  const bfr* Vg = (const bfr*)(p.ws + O_VT) + (size_t)bh * DV * LALL;
  const int qpos = qpos0 + wave * 32 + r;
  bf16x8 bq[6];
  {
    const bfr* qp = Q + ((size_t)bh * LALL + qpos) * DQK + 8 * h;
#pragma unroll
    for (int s = 0; s < 6; ++s) bq[s] = *(const bf16x8*)(qp + 16 * s);
  }
  f32x16 o[2];
#pragma unroll
  for (int d = 0; d < 2; ++d)
#pragma unroll
    for (int i = 0; i < 16; ++i) o[d][i] = 0.f;
  float mrun = 0.f, lrun = 0.f;
  uint4 kv0, kv1, kv2, vv0, vv1;
  const int kr0 = tid / 12, kc0 = (tid - kr0 * 12) * 8;
  const int kr1 = (tid + 256) / 12, kc1 = (tid + 256 - kr1 * 12) * 8;
  const int kr2 = (tid + 512) / 12, kc2 = (tid + 512 - kr2 * 12) * 8;
  const int vr0 = tid >> 3, vc0 = (tid & 7) * 8;
  const bfr* kp0 = kc0 < 64 ? Kg + (size_t)kr0 * 64 + kc0 : KRg + (size_t)kr0 * 32 + (kc0 - 64);
  const bfr* kp1 = kc1 < 64 ? Kg + (size_t)kr1 * 64 + kc1 : KRg + (size_t)kr1 * 32 + (kc1 - 64);
  const bfr* kp2 = kc2 < 64 ? Kg + (size_t)kr2 * 64 + kc2 : KRg + (size_t)kr2 * 32 + (kc2 - 64);
  const int ks0 = kc0 < 64 ? 64 : 32, ks1 = kc1 < 64 ? 64 : 32, ks2 = kc2 < 64 ? 64 : 32;
#define AT_GLOAD(KEY0_)                                                          \
  {                                                                              \
    const int key0_ = (KEY0_);                                                   \
    kv0 = *(const uint4*)(kp0 + (size_t)key0_ * ks0);                            \
    kv1 = *(const uint4*)(kp1 + (size_t)key0_ * ks1);                            \
    kv2 = *(const uint4*)(kp2 + (size_t)key0_ * ks2);                            \
    vv0 = *(const uint4*)(Vg + (size_t)vr0 * LALL + key0_ + vc0);                \
    vv1 = *(const uint4*)(Vg + (size_t)(vr0 + 32) * LALL + key0_ + vc0);         \
  }
#define AT_LSTORE()                                                              \
  {                                                                              \
    *(uint4*)(sm->K + kr0 * KLD + kc0) = kv0;                                    \
    *(uint4*)(sm->K + kr1 * KLD + kc1) = kv1;                                    \
    *(uint4*)(sm->K + kr2 * KLD + kc2) = kv2;                                    \
    uint2* d0_ = (uint2*)(sm->V + vr0 * VLD + vc0);                              \
    d0_[0] = make_uint2(vv0.x, vv0.y);                                           \
    d0_[1] = make_uint2(vv0.z, vv0.w);                                           \
    uint2* d1_ = (uint2*)(sm->V + (vr0 + 32) * VLD + vc0);                       \
    d1_[0] = make_uint2(vv1.x, vv1.y);                                           \
    d1_[1] = make_uint2(vv1.z, vv1.w);                                           \
  }
  const int NTI = nkeys / 64;
  AT_GLOAD(0)
  for (int it = 0; it < NTI; ++it) {
    AT_LSTORE()
    __syncthreads();
    if (it + 1 < NTI) AT_GLOAD((it + 1) * 64)
    SCHED_FENCE();
    f32x16 st[2];
    const float ninit = -mrun;
#pragma unroll
    for (int kb = 0; kb < 2; ++kb)
#pragma unroll
      for (int i = 0; i < 16; ++i) st[kb][i] = ninit;
#pragma unroll
    for (int s = 0; s < 6; ++s) {
#pragma unroll
      for (int kb = 0; kb < 2; ++kb) {
        bf16x8 ka = *(const bf16x8*)(sm->K + (kb * 32 + r) * KLD + 16 * s + 8 * h);
        st[kb] = MFMA32(ka, bq[s], st[kb]);
      }
    }
    float mx = fmaxf(fmaxf(st[0][0], st[0][1]), st[1][0]);
#pragma unroll
    for (int i = 2; i < 16; i += 2) mx = fmaxf(fmaxf(mx, st[0][i]), st[0][i + 1]);
#pragma unroll
    for (int i = 1; i < 15; i += 2) mx = fmaxf(fmaxf(mx, st[1][i]), st[1][i + 1]);
    mx = fmaxf(mx, st[1][15]);
    mx = fmaxf(mx, __shfl_xor(mx, 32));
    const bool need = (it == 0) || (mx > 8.f);
    if (__any(need)) {
      const float delta = need ? mx : 0.f;
      const float alpha = __builtin_amdgcn_exp2f(-delta);
      mrun += delta;
      lrun *= alpha;
#pragma unroll
      for (int d = 0; d < 2; ++d)
#pragma unroll
        for (int i = 0; i < 16; ++i) o[d][i] *= alpha;
#pragma unroll
      for (int kb = 0; kb < 2; ++kb)
#pragma unroll
        for (int i = 0; i < 16; ++i) st[kb][i] -= delta;
    }
    float ps = 0.f;
#pragma unroll
    for (int kb = 0; kb < 2; ++kb)
#pragma unroll
      for (int i = 0; i < 16; ++i) {
        float e = __builtin_amdgcn_exp2f(st[kb][i]);
        st[kb][i] = e;
        ps += e;
      }
    lrun += ps;
#pragma unroll
    for (int kb = 0; kb < 2; ++kb)
#pragma unroll
      for (int s2 = 0; s2 < 2; ++s2) {
        unsigned pw[4];
#pragma unroll
        for (int j = 0; j < 4; ++j) pw[j] = pk2(st[kb][8 * s2 + 2 * j], st[kb][8 * s2 + 2 * j + 1]);
        bf16x8 pb;
        {
          uint4 t = make_uint4(pw[0], pw[1], pw[2], pw[3]);
          pb = __builtin_bit_cast(bf16x8, t);
        }
#pragma unroll
        for (int d = 0; d < 2; ++d) {
          const bfr* vp = sm->V + (d * 32 + r) * VLD + kb * 32 + 16 * s2 + 4 * h;
          uint2 lo = *(const uint2*)vp;
          uint2 hi = *(const uint2*)(vp + 8);
          uint4 t = make_uint4(lo.x, lo.y, hi.x, hi.y);
          bf16x8 va = __builtin_bit_cast(bf16x8, t);
          o[d] = MFMA32(va, pb, o[d]);
        }
      }
    __syncthreads();
  }
  float ltot = lrun + __shfl_xor(lrun, 32);
  float inv = 1.f / ltot;
  int b = bh / NH, hh = bh - b * NH;
  bfr* wl = (bfr*)sm + wave * (32 * 72);
#pragma unroll
  for (int d = 0; d < 2; ++d)
#pragma unroll
    for (int g4 = 0; g4 < 4; ++g4) {
      int dv0 = d * 32 + 8 * g4 + 4 * h;
      uint2 ov;
      ov.x = pk2(o[d][4 * g4 + 0] * inv, o[d][4 * g4 + 1] * inv);
      ov.y = pk2(o[d][4 * g4 + 2] * inv, o[d][4 * g4 + 3] * inv);
      *(uint2*)(wl + r * 72 + dv0) = ov;
    }
  asm volatile("s_waitcnt lgkmcnt(0)" ::: "memory");
  {
    const int dvc = (lane & 7) * 8;
    uint4 ov[4], zv[4];
#pragma unroll
    for (int c = 0; c < 4; ++c) {
      int ql = c * 8 + (lane >> 3);
      size_t tok = (size_t)b * LALL + qpos0 + wave * 32 + ql;
      ov[c] = *(const uint4*)(wl + ql * 72 + dvc);
      zv[c] = *(const uint4*)((const bfr*)(p.ws + O_SZ0) + tok * 1024 + hh * 64 + dvc);
    }
#pragma unroll
    for (int c = 0; c < 4; ++c) {
      int ql = c * 8 + (lane >> 3);
      size_t tok = (size_t)b * LALL + qpos0 + wave * 32 + ql;
      float4 o0 = bf4_to_f4(make_uint2(ov[c].x, ov[c].y)), o1 = bf4_to_f4(make_uint2(ov[c].z, ov[c].w));
      float4 z0 = bf4_to_f4(make_uint2(zv[c].x, zv[c].y)), z1 = bf4_to_f4(make_uint2(zv[c].z, zv[c].w));
      uint4 out;
      out.x = pk2(o0.x * z0.x, o0.y * z0.y);
      out.y = pk2(o0.z * z0.z, o0.w * z0.w);
      out.z = pk2(o1.x * z1.x, o1.y * z1.y);
      out.w = pk2(o1.z * z1.z, o1.w * z1.w);
      *(uint4*)((bfr*)(p.ws + O_OG) + tok * 1024 + hh * 64 + dvc) = out;
    }
  }
  __syncthreads();
}

DI void phase_o3(const Params& p, char* smem) {
  AttnSmem* sm = (AttnSmem*)smem;
  const int xcd = blockIdx.x & 7, local = blockIdx.x >> 3, nloc = gridDim.x >> 3;
  for (int j = local; j < 256; j += nloc) {
    int u = xcd * 256 + j;
    attn_item(p, sm, u >> 4, LC + (u & 15) * 128, LALL);
  }
  for (int j = local; j < 32; j += nloc) {
    int u = xcd * 32 + j;
    attn_item(p, sm, u >> 1, (u & 1) * 128, LC);
  }
}

template <int LAYER>
DI void phase_oproj(const Params& p, char* smem) {
  GemmSmem* sm = (GemmSmem*)smem;
  WAVE_IDS
  constexpr int NROWS = LAYER == 0 ? TOK : NLAT;
  const int NT = 8, units = (NROWS / 128) * NT;
  const bfr* Ab = (const bfr*)(p.ws + (LAYER == 0 ? O_OG : O_Y2));
  const bfr* WT = (const bfr*)(p.ws + (LAYER == 0 ? O_WT_OUT0 : O_WT_OUT1));
  float* part = (float*)(p.ws + (LAYER == 0 ? O_PART1 : O_PART2));
  auto Aof = [&](int m0) { return [=](int row, int k) { return Ab + (size_t)(m0 + row) * 1024 + k; }; };
  auto Bof = [&](int n0) { return [=](int row, int k) { return WT + (size_t)(n0 + row) * 1024 + k; }; };
  GSTAGE_DECL;
  if ((int)blockIdx.x < units) {
    const int us = xcd_swz(blockIdx.x, NT);
    gemm_prefetch(GSTAGE_ARGS, Aof((us / NT) * 128), Bof((us % NT) * 128));
  }
  for (int u = blockIdx.x; u < units; u += gridDim.x) {
    const int us = xcd_swz(u, NT);
    int mt = us / NT, nt = us - mt * NT;
    int m0 = mt * 128, n0 = nt * 128;
    f32x16 acc[2][2];
    zero_acc(acc);
    gemm_main(acc, 32, Aof(m0), Bof(n0), sm, GSTAGE_ARGS);
    if (u + (int)gridDim.x < units) {
      const int us1 = xcd_swz(u + gridDim.x, NT);
      gemm_prefetch(GSTAGE_ARGS, Aof((us1 / NT) * 128), Bof((us1 % NT) * 128));
    }
    const float* xin;
    float* xout;
    const float* gt;
    if (LAYER == 0) {
      xin = xrow0(p, m0);
      xout = xrow1(p, m0);
      gt = modrow(p, 0, m0) + 2048;
    } else {
      xin = p.out + (size_t)m0 * 1024;
      xout = p.out + (size_t)m0 * 1024;
      gt = (const float*)(p.ws + O_MOD) + ((size_t)(9 + (m0 >> 11))) * 3072 + 2048;
    }
    {
      float* wl = (float*)sm + wave * 2048;
      const int ccol = n0 + wn * 64 + (lane & 15) * 4;
      const float4 g4 = *(const float4*)(gt + ccol);
      float4 gm1 = make_float4(0.f, 0.f, 0.f, 0.f);
      bfr* XG = (bfr*)(p.ws + O_H1);
      if (LAYER == 0) {
        const float4 ngv = *(const float4*)(p.in[I_NORMG] + 1024 + ccol);
        const float4 scv = *(const float4*)(modrow(p, 1, m0) + 1024 + ccol);
        gm1 = make_float4(ngv.x * (1.f + scv.x), ngv.y * (1.f + scv.y), ngv.z * (1.f + scv.z), ngv.w * (1.f + scv.w));
      }
#pragma unroll
      for (int mi = 0; mi < 2; ++mi) {
        float4 v[8], xv[8];
#pragma unroll
        for (int c = 0; c < 8; ++c)
          xv[c] = *(const float4*)(xin + (size_t)(wm * 64 + mi * 32 + c * 4 + (lane >> 4)) * 1024 + ccol);
        stage_half(acc, mi, wl, v, lane);
#pragma unroll
        for (int c = 0; c < 8; ++c) {
          int row = wm * 64 + mi * 32 + c * 4 + (lane >> 4);
          float4 o;
          o.x = xv[c].x + g4.x * v[c].x;
          o.y = xv[c].y + g4.y * v[c].y;
          o.z = xv[c].z + g4.z * v[c].z;
          o.w = xv[c].w + g4.w * v[c].w;
          *(float4*)(xout + (size_t)row * 1024 + ccol) = o;
          if (LAYER == 0)
            *(uint2*)(XG + (size_t)(m0 + row) * 1024 + ccol) =
                make_uint2(pk2(o.x * gm1.x, o.y * gm1.y), pk2(o.z * gm1.z, o.w * gm1.w));
          {
            float sq = o.x * o.x + o.y * o.y + o.z * o.z + o.w * o.w;
            sq += __shfl_xor(sq, 1);
            sq += __shfl_xor(sq, 2);
            sq += __shfl_xor(sq, 4);
            sq += __shfl_xor(sq, 8);
            if ((lane & 15) == 0) part[(size_t)(nt * 2 + wn) * NROWS + m0 + row] = sq;
          }
        }
      }
      __syncthreads();
    }
  }
  if (LAYER == 0) {
    __syncthreads();
    phase_prep_b(p, smem, units % (int)gridDim.x);
  }
}

DI void phase_o5(const Params& p, char* smem) {
  GemmSmem* sm = (GemmSmem*)smem;
  WAVE_IDS
  const int ULAT = (NLAT / 128) * 16, units = ULAT + (NB * LC / 128) * 8;
  const bfr* WT = (const bfr*)(p.ws + O_WT_IN1);
  bfr* U2 = (bfr*)(p.ws + O_U2);
  bfr* SZ1 = (bfr*)(p.ws + O_SZ1);
  const bfr* Ah = (const bfr*)(p.ws + O_H1);
  auto coords = [&](int u, int& m0, int& n0) {
    if (u < ULAT) {
      const int us = xcd_swz(u, 16);
      int mtl = us >> 4;
      m0 = (mtl >> 4) * LALL + LC + (mtl & 15) * 128;
      n0 = (us & 15) * 128;
    } else {
      const int us = xcd_swz(u - ULAT, 8);
      int mtc = us >> 3;
      m0 = (mtc >> 1) * LALL + (mtc & 1) * 128;
      n0 = (us & 7) * 128;
    }
  };
  auto Aof = [&](int m0) { return [=](int row, int k) { return Ah + (size_t)(m0 + row) * 1024 + k; }; };
  auto Bof = [&](int n0) { return [=](int row, int k) { return WT + (size_t)(n0 + row) * 1024 + k; }; };
  GSTAGE_DECL;
  if ((int)blockIdx.x < units) {
    int m1, n1;
    coords(blockIdx.x, m1, n1);
    gemm_prefetch(GSTAGE_ARGS, Aof(m1), Bof(n1));
  }
  for (int u = blockIdx.x; u < units; u += gridDim.x) {
    int m0, n0;
    coords(u, m0, n0);
    int b = m0 / LALL, pos0 = m0 - b * LALL;
    if (tid < 128) sm->rs[tid] = rs_from_part((const float*)(p.ws + O_PART1), TOK, m0 + tid);
    f32x16 acc[2][2];
    zero_acc(acc);
    gemm_main(acc, 32, Aof(m0), Bof(n0), sm, GSTAGE_ARGS);
    if (u + (int)gridDim.x < units) {
      int m1, n1;
      coords(u + gridDim.x, m1, n1);
      gemm_prefetch(GSTAGE_ARGS, Aof(m1), Bof(n1));
    }
    {
      float* wl = (float*)sm + wave * 2048;
      const int col = n0 + wn * 64 + (lane & 7) * 8;
      const bool isu = col < 1024;
      const float* shw = (const float*)(p.ws + O_SHW) + (size_t)(pos0 < LC ? 8 : b) * 2048 + col;
      const float4 bs0 = *(const float4*)shw, bs1 = *(const float4*)(shw + 4);
#pragma unroll
      for (int mi = 0; mi < 2; ++mi) {
        float4 lo[4], hi[4];
        stage_half8(acc, mi, wl, lo, hi, lane);
#pragma unroll
        for (int c = 0; c < 4; ++c) {
          int row = wm * 64 + mi * 32 + c * 8 + (lane >> 3);
          int tok = m0 + row;
          {
            const float rsc = sm->rs[row];
            lo[c].x = lo[c].x * rsc + bs0.x; lo[c].y = lo[c].y * rsc + bs0.y; lo[c].z = lo[c].z * rsc + bs0.z; lo[c].w = lo[c].w * rsc + bs0.w;
            hi[c].x = hi[c].x * rsc + bs1.x; hi[c].y = hi[c].y * rsc + bs1.y; hi[c].z = hi[c].z * rsc + bs1.z; hi[c].w = hi[c].w * rsc + bs1.w;
          }
          uint4 o;
          bfr* dst;
          if (isu) {
            o.x = pk2(lo[c].x, lo[c].y);
            o.y = pk2(lo[c].z, lo[c].w);
            o.z = pk2(hi[c].x, hi[c].y);
            o.w = pk2(hi[c].z, hi[c].w);
            dst = U2 + ((size_t)(col >> 4) * TOK + tok) * 16 + (col & 15);
          } else {
            o.x = pk2(silu_f(lo[c].x), silu_f(lo[c].y));
            o.y = pk2(silu_f(lo[c].z), silu_f(lo[c].w));
            o.z = pk2(silu_f(hi[c].x), silu_f(hi[c].y));
            o.w = pk2(silu_f(hi[c].z), silu_f(hi[c].w));
            dst = SZ1 + ((size_t)(b * SEQ + pos0 + row - LC)) * 1024 + (col - 1024);
          }
          *(uint4*)dst = o;
        }
      }
      __syncthreads();
    }
  }
}

DI void phase_o6(const Params& p, char* smem) {
  GemmSmem* sm = (GemmSmem*)smem;
  WAVE_IDS
  const int NROW = NB * NCH;
  const int units = 64 * 5 * 2;
  const bfr* U2 = (const bfr*)(p.ws + O_U2);
  const bfr* WST = (const bfr*)(p.ws + O_WST);
  float* SLOC = (float*)(p.ws + O_SLOC);
  for (int u = blockIdx.x; u < units; u += gridDim.x) {
    const int us = xcd_swz(u, 10);
    int g = us / 10, rem = us - g * 10;
    int mt = rem >> 1, nt = rem & 1;
    int m0 = mt * 128, n0 = nt * 128;
    const bfr* Ag = U2 + (size_t)g * TOK * 16;
    const bfr* Bg = WST + (size_t)g * 256 * 512;
    f32x16 acc[2][2];
    zero_acc(acc);
    gemm_full(
        acc, 16,
        [&](int row, int k) {
          int rr = m0 + row;
          rr = rr < NROW ? rr : NROW - 1;
          return Ag + (size_t)rr * 512 + k;
        },
        [&](int row, int k) { return Bg + (size_t)(n0 + row) * 512 + k; }, sm);
#pragma unroll
    for (int mi = 0; mi < 2; ++mi)
#pragma unroll
      for (int ni = 0; ni < 2; ++ni) {
        int col = n0 + wn * 64 + ni * 32 + r;
#pragma unroll
        for (int i = 0; i < 16; ++i) {
          int row = m0 + wm * 64 + mi * 32 + crow(i, h);
          SLOC[((size_t)g * SLOC_ROWS + row) * 256 + col] = acc[mi][ni][i];
        }
      }
  }
}

DI void phase_o7(const Params& p) {
  const int tidx_ = opaque_tid();
  const float* SLOC = (const float*)(p.ws + O_SLOC);
  bfr* SIN = (bfr*)(p.ws + O_SIN);
  const int total = NB * 64 * 2 * 64;
  for (int idx = blockIdx.x * 256 + tidx_; idx < total; idx += gridDim.x * 256) {
    int pp = idx & 63, dir = (idx >> 6) & 1, g = (idx >> 7) & 63, b = idx >> 13;
    double dt, ar, ai;
    float fr, fi, lr, li;
    s5_disc(p, dir, g, pp, dt, ar, ai, fr, fi);
    s5_pow(dt, ar, ai, TC, lr, li);
    float sr = 0.f, si = 0.f;
    auto cpos = [&](int step) { return dir == 0 ? step : (step < 8 ? 7 - step : NCH - 1 - (step - 8)); };
    const float* slb = SLOC + ((size_t)g * SLOC_ROWS + b * NCH) * 256 + dir * 128 + pp;
    bfr* sob = SIN + ((size_t)g * (NB * NCHL) + b * NCHL) * 256 + dir * 128 + pp;
#pragma unroll 1
    for (int s0 = 0; s0 < NCH; s0 += 24) {
      float lre[24], lim[24];
#pragma unroll
      for (int j = 0; j < 24; ++j) {
        const float* sl = slb + (size_t)cpos(s0 + j) * 256;
        lre[j] = sl[0];
        lim[j] = sl[64];
      }
#pragma unroll
      for (int j = 0; j < 24; ++j) {
        int cp = cpos(s0 + j);
        if (cp >= 8) {
          bfr* so = sob + (size_t)(cp - 8) * 256;
          so[0] = f2bf(sr);
          so[64] = f2bf(si);
        }
        float nr = lr * sr - li * si + lre[j];
        float ni = lr * si + li * sr + lim[j];
        sr = nr;
        si = ni;
      }
    }
  }
}

DI void phase_o8(const Params& p, char* smem) {
  GemmSmem* sm = (GemmSmem*)smem;
  WAVE_IDS
  const int units = 64 * 4 * 4;
  const bfr* U2 = (const bfr*)(p.ws + O_U2);
  const bfr* SIN = (const bfr*)(p.ws + O_SIN);
  const bfr* KTAB = (const bfr*)(p.ws + O_KTAB);
  const bfr* VOP = (const bfr*)(p.ws + O_VOP);
  bfr* YG = (bfr*)(p.ws + O_YG);
  for (int u = blockIdx.x; u < units; u += gridDim.x) {
    const int us = xcd_swz(u, 16);
    int g = us >> 4, mt = (us >> 2) & 3, nt = us & 3;
    int m0 = mt * 128, n0 = nt * 128;
    const bfr* Ug = U2 + (size_t)g * TOK * 16;
    f32x16 acc[2][2];
    zero_acc(acc);
    gemm_full(
        acc, 16,
        [&](int row, int k) {
          int rr = m0 + row;
          int b = rr >> 6, n = rr & 63;
          return Ug + ((size_t)b * LALL + LC + n * TC) * 16 + k;
        },
        [&](int row, int k) {
          int m = n0 + row;
          int t = m >> 4, c = m & 15;
          return KTAB + (((size_t)g * 63 + (t + 31)) * 16 + c) * 16 - (k >> 4) * 256 + (k & 15);
        },
        sm);
    gemm_full(
        acc, 8, [&](int row, int k) { return SIN + ((size_t)g * (NB * NCHL) + m0 + row) * 256 + k; },
        [&](int row, int k) { return VOP + ((size_t)g * 512 + n0 + row) * 256 + k; }, sm);
    {
      float* wl = (float*)sm + wave * 2048;
      const int mcol = n0 + wn * 64 + (lane & 7) * 8;
      const int t = mcol >> 4, c0 = mcol & 15;
      const int ch = g * 16 + c0;
      const float4 d0 = *(const float4*)(p.in[I_S5D] + ch), d1 = *(const float4*)(p.in[I_S5D] + ch + 4);
#pragma unroll
      for (int mi = 0; mi < 2; ++mi) {
        float4 lo[4], hi[4];
        stage_half8(acc, mi, wl, lo, hi, lane);
        uint4 uq[4];
#pragma unroll
        for (int c = 0; c < 4; ++c) {
          int rr = m0 + wm * 64 + mi * 32 + c * 8 + (lane >> 3);
          int b = rr >> 6, n = rr & 63;
          uq[c] = *(const uint4*)(Ug + ((size_t)b * LALL + LC + n * TC + t) * 16 + c0);
        }
        SCHED_FENCE();
#pragma unroll
        for (int c = 0; c < 4; ++c) {
          int rr = m0 + wm * 64 + mi * 32 + c * 8 + (lane >> 3);
          int b = rr >> 6, n = rr & 63;
          float4 u0 = bf4_to_f4(make_uint2(uq[c].x, uq[c].y)), u1 = bf4_to_f4(make_uint2(uq[c].z, uq[c].w));
          uint4 o;
          o.x = pk2(gelu_tanh(lo[c].x + d0.x * u0.x), gelu_tanh(lo[c].y + d0.y * u0.y));
          o.y = pk2(gelu_tanh(lo[c].z + d0.z * u0.z), gelu_tanh(lo[c].w + d0.w * u0.w));
          o.z = pk2(gelu_tanh(hi[c].x + d1.x * u1.x), gelu_tanh(hi[c].y + d1.y * u1.y));
          o.w = pk2(gelu_tanh(hi[c].z + d1.z * u1.z), gelu_tanh(hi[c].w + d1.w * u1.w));
          *(uint4*)(YG + ((size_t)(b * SEQ + n * TC + t)) * 1024 + ch) = o;
        }
        SCHED_FENCE();
      }
      __syncthreads();
    }
  }
}

DI void phase_o9(const Params& p, char* smem) {
  GemmSmem* sm = (GemmSmem*)smem;
  WAVE_IDS
  const int NT = 8, units = (NLAT / 128) * NT;
  const bfr* YG = (const bfr*)(p.ws + O_YG);
  const bfr* SZ1 = (const bfr*)(p.ws + O_SZ1);
  const bfr* WT = (const bfr*)(p.ws + O_WT_GLU);
  bfr* Y2 = (bfr*)(p.ws + O_Y2);
  auto Aof = [&](int m0) { return [=](int row, int k) { return YG + (size_t)(m0 + row) * 1024 + k; }; };
  auto Bof = [&](int n0) { return [=](int row, int k) { return WT + (size_t)(n0 + row) * 1024 + k; }; };
  GSTAGE_DECL;
  if ((int)blockIdx.x < units) {
    const int us = xcd_swz(blockIdx.x, NT);
    gemm_prefetch(GSTAGE_ARGS, Aof((us / NT) * 128), Bof((us % NT) * 128));
  }
  for (int u = blockIdx.x; u < units; u += gridDim.x) {
    const int us = xcd_swz(u, NT);
    int mt = us / NT, nt = us - mt * NT;
    int m0 = mt * 128, n0 = nt * 128;
    f32x16 acc[2][2];
    zero_acc(acc);
    gemm_main(acc, 32, Aof(m0), Bof(n0), sm, GSTAGE_ARGS);
    if (u + (int)gridDim.x < units) {
      const int us1 = xcd_swz(u + gridDim.x, NT);
      gemm_prefetch(GSTAGE_ARGS, Aof((us1 / NT) * 128), Bof((us1 % NT) * 128));
    }
    float* wl = (float*)sm + wave * 2048;
    const int ccol = n0 + wn * 64 + (lane & 7) * 8;
    const float4 bg0 = *(const float4*)(p.in[I_BGLU] + ccol), bg1 = *(const float4*)(p.in[I_BGLU] + ccol + 4);
#pragma unroll
    for (int mi = 0; mi < 2; ++mi) {
      float4 lo[4], hi[4];
      stage_half8(acc, mi, wl, lo, hi, lane);
      uint4 yv[4], zv[4];
#pragma unroll
      for (int c = 0; c < 4; ++c) {
        size_t o = (size_t)(m0 + wm * 64 + mi * 32 + c * 8 + (lane >> 3)) * 1024 + ccol;
        yv[c] = *(const uint4*)(YG + o);
        zv[c] = *(const uint4*)(SZ1 + o);
      }
      SCHED_FENCE();
#pragma unroll
      for (int c = 0; c < 4; ++c) {
        size_t o = (size_t)(m0 + wm * 64 + mi * 32 + c * 8 + (lane >> 3)) * 1024 + ccol;
        float4 y0 = bf4_to_f4(make_uint2(yv[c].x, yv[c].y)), y1 = bf4_to_f4(make_uint2(yv[c].z, yv[c].w));
        float4 z0 = bf4_to_f4(make_uint2(zv[c].x, zv[c].y)), z1 = bf4_to_f4(make_uint2(zv[c].z, zv[c].w));
        uint4 ov;
        ov.x = pk2(y0.x * sigmoid_f(lo[c].x + bg0.x) * z0.x, y0.y * sigmoid_f(lo[c].y + bg0.y) * z0.y);
        ov.y = pk2(y0.z * sigmoid_f(lo[c].z + bg0.z) * z0.z, y0.w * sigmoid_f(lo[c].w + bg0.w) * z0.w);
        ov.z = pk2(y1.x * sigmoid_f(hi[c].x + bg1.x) * z1.x, y1.y * sigmoid_f(hi[c].y + bg1.y) * z1.y);
        ov.w = pk2(y1.z * sigmoid_f(hi[c].z + bg1.z) * z1.z, y1.w * sigmoid_f(hi[c].w + bg1.w) * z1.w);
        *(uint4*)(Y2 + o) = ov;
      }
      SCHED_FENCE();
    }
    __syncthreads();
  }
}

#define XB_TMO      128
#define XB_XCNT(j)  (256  + 64 * (j))
#define XB_XSUB(j)  (1280 + 64 * (j))
#define XB_XGEN(j)  (2304 + 64 * (j))
#define XB_TOP      3328
#define XB_TOPGEN   3392
#define XCD_BAR_WORDS 3456
#define XB_SPIN_CAP (1u << 18)
#define LAS __attribute__((address_space(3)))
DI unsigned xb_ld(unsigned* p) { return __hip_atomic_load(p, __ATOMIC_RELAXED, __HIP_MEMORY_SCOPE_AGENT); }
DI unsigned xb_add(unsigned* p, unsigned v) { return __hip_atomic_fetch_add(p, v, __ATOMIC_RELAXED, __HIP_MEMORY_SCOPE_AGENT); }
DI unsigned xb_xcc_id() { return (unsigned)__builtin_amdgcn_s_getreg((3 << 11) | 20) & 0xFu; }
#define XB_SPIN(cond, bar) do { unsigned _sp = 0; while (cond) { __builtin_amdgcn_s_sleep(1); \
    if ((++_sp & 255u) == 0u) { if (xb_ld(&(bar)[XB_TMO])) break; if (_sp > XB_SPIN_CAP) { atomicAdd(&(bar)[XB_TMO], 1u); break; } } } } while (0)
struct XcdBarrier {
  unsigned* bar;
  unsigned x;
  volatile LAS unsigned* st;
};
DI XcdBarrier xcd_barrier_post(unsigned* bar, volatile LAS unsigned* st) {
  XcdBarrier b;
  b.bar = bar;
  b.x = xb_xcc_id();
  b.st = st;
  if (threadIdx.x == 0) (void)xb_add(&bar[XB_XCNT(b.x)], 1u);
  return b;
}
DI void xcd_barrier_complete(unsigned* bar, unsigned x, unsigned& nloc, unsigned& nx) {
  const unsigned G = gridDim.x * gridDim.y * gridDim.z;
  unsigned sum, cnt, mine, sp = 0u;
  for (;;) {
    sum = 0u; cnt = 0u; mine = 0u;
#pragma unroll
    for (unsigned j = 0; j < 16; ++j) {
      const unsigned c = xb_ld(&bar[XB_XCNT(j)]);
      sum += c;
      cnt += (c > 0u) ? 1u : 0u;
      mine = (j == x) ? c : mine;
    }
    if (sum == G) break;
    __builtin_amdgcn_s_sleep(1);
    if ((++sp & 255u) == 0u) {
      if (xb_ld(&bar[XB_TMO])) break;
      if (sp > XB_SPIN_CAP) { atomicAdd(&bar[XB_TMO], 1u); break; }
    }
  }
  nloc = mine > 0u ? mine : 1u;
  nx = cnt > 0u ? cnt : 1u;
}
DI void xcd_barrier(const XcdBarrier& b) {
  asm volatile("s_waitcnt vmcnt(0)" ::: "memory");
  __syncthreads();
  if (threadIdx.x == 0) {
    unsigned* bar = b.bar;
    __builtin_amdgcn_s_waitcnt(0);
    unsigned nloc = b.st[0], nx = b.st[1];
    if (nloc == 0u) {
      xcd_barrier_complete(bar, b.x, nloc, nx);
      b.st[0] = nloc;
      b.st[1] = nx;
    }
    const unsigned old = xb_add(&bar[XB_XSUB(b.x)], 1u);
    const unsigned gen = old / nloc;
    if (old + 1u == (gen + 1u) * nloc) {
      __builtin_amdgcn_fence(__ATOMIC_RELEASE, "agent");
      asm volatile("s_waitcnt vmcnt(0)" ::: "memory");
      const unsigned og = xb_add(&bar[XB_TOP], 1u);
      const unsigned tg = og / nx;
      if (og + 1u == (tg + 1u) * nx) xb_add(&bar[XB_TOPGEN], 1u);
      else XB_SPIN(xb_ld(&bar[XB_TOPGEN]) == tg, bar);
      __builtin_amdgcn_fence(__ATOMIC_ACQUIRE, "agent");
      xb_add(&bar[XB_XGEN(b.x)], 1u);
      asm volatile("s_waitcnt vmcnt(0)" ::: "memory");
    } else {
      XB_SPIN(xb_ld(&bar[XB_XGEN(b.x)]) == gen, bar);
      __builtin_amdgcn_fence(__ATOMIC_ACQUIRE, "agent");
      asm volatile("s_waitcnt vmcnt(0)" ::: "memory");
    }
  }
  __syncthreads();
}

DI void run_phase(const Params& p, int ph, char* smem) {
  switch (ph) {
#if !defined(ONLY) || ONLY == 0
    case PH_PREP: phase_prep(p, smem); break;
#endif
#if !defined(ONLY) || ONLY == 1
    case PH_FINAL: phase_final(p); break;
#endif
#if !defined(ONLY) || ONLY == 2
    case PH_O1: phase_o1(p, smem); break;
#endif
#if !defined(ONLY) || ONLY == 3
    case PH_O2: phase_o2(p, smem); break;
#endif
#if !defined(ONLY) || ONLY == 4
    case PH_O3: phase_o3(p, smem); break;
#endif
#if !defined(ONLY) || ONLY == 5
    case PH_O4: phase_oproj<0>(p, smem); break;
#endif
#if !defined(ONLY) || ONLY == 6
    case PH_O5: phase_o5(p, smem); break;
#endif
#if !defined(ONLY) || ONLY == 7
    case PH_O6: phase_o6(p, smem); break;
#endif
#if !defined(ONLY) || ONLY == 8
    case PH_O7: phase_o7(p); break;
#endif
#if !defined(ONLY) || ONLY == 9
    case PH_O8: phase_o8(p, smem); break;
#endif
#if !defined(ONLY) || ONLY == 10
    case PH_O9: phase_o9(p, smem); break;
#endif
#if !defined(ONLY) || ONLY == 11
    case PH_O10: phase_oproj<1>(p, smem); break;
#endif
    case PH_H0: phase_hconv<0>(p); break;
    case PH_H1: phase_hconv<1>(p); break;
    default: break;
  }
}

__global__ void __launch_bounds__(256, 2) mega_one(Params p, int ph) {
  __shared__ __attribute__((aligned(16))) char smem[SMEM_BYTES];
  run_phase(p, ph, smem);
}

#if !defined(ONLY) && SINGLE_LAUNCH
__global__ void __launch_bounds__(256, 2) mega(Params p) {
  __shared__ __attribute__((aligned(16))) char smem[SMEM_BYTES];
  __shared__ uint4 xb_words;
  if (threadIdx.x == 0) xb_words = make_uint4(0u, 0u, 0u, 0u);
  __syncthreads();
  if (p.nprog < 0) cg::this_grid().sync();
  const XcdBarrier xb = xcd_barrier_post((unsigned*)(p.ws + O_BAR), (volatile LAS unsigned*)&xb_words);
  cg::grid_group grid = cg::this_grid();
#if !defined(OMIT) || OMIT != 0
  phase_prep(p, smem);
#endif
  xcd_barrier(xb);
#if (DUP >> 0) & 1
  phase_prep(p, smem);
  xcd_barrier(xb);
#endif
  phase_hconv<0>(p);
  xcd_barrier(xb);
#if !defined(OMIT) || OMIT != 1
  phase_o1(p, smem);
#endif
  xcd_barrier(xb);
#if (DUP >> 1) & 1
  phase_o1(p, smem);
  xcd_barrier(xb);
#endif
#if !defined(OMIT) || OMIT != 2
  phase_o2(p, smem);
#endif
  xcd_barrier(xb);
#if (DUP >> 2) & 1
  phase_o2(p, smem);
  xcd_barrier(xb);
#endif
#if !defined(OMIT) || OMIT != 3
  phase_o3(p, smem);
#endif
  xcd_barrier(xb);
#if (DUP >> 3) & 1
  phase_o3(p, smem);
  xcd_barrier(xb);
#endif
#if !defined(OMIT) || OMIT != 4
  phase_oproj<0>(p, smem);
#endif
  xcd_barrier(xb);
#if (DUP >> 4) & 1
  phase_oproj<0>(p, smem);
  xcd_barrier(xb);
#endif
#if !defined(OMIT) || OMIT != 5
  phase_o5(p, smem);
#endif
  xcd_barrier(xb);
#if (DUP >> 5) & 1
  phase_o5(p, smem);
  xcd_barrier(xb);
#endif
#if !defined(OMIT) || OMIT != 6
  phase_o6(p, smem);
#endif
  xcd_barrier(xb);
#if (DUP >> 6) & 1
  phase_o6(p, smem);
  xcd_barrier(xb);
#endif
#if !defined(OMIT) || OMIT != 7
  phase_o7(p);
#endif
  xcd_barrier(xb);
#if (DUP >> 7) & 1
  phase_o7(p);
  xcd_barrier(xb);
#endif
#if !defined(OMIT) || OMIT != 8
  phase_o8(p, smem);
#endif
  xcd_barrier(xb);
#if (DUP >> 8) & 1
  phase_o8(p, smem);
  xcd_barrier(xb);
#endif
#if !defined(OMIT) || OMIT != 9
  phase_o9(p, smem);
#endif
  xcd_barrier(xb);
#if (DUP >> 9) & 1
  phase_o9(p, smem);
  xcd_barrier(xb);
#endif
#if !defined(OMIT) || OMIT != 10
  phase_oproj<1>(p, smem);
#endif
  xcd_barrier(xb);
#if !defined(OMIT) || OMIT != 11
  phase_final(p);
#endif
}
#else
__global__ void mega(Params p) {}
#endif


extern "C" void kernel_launch(void* const* d_in, const int* in_sizes, int n_in, void* d_out, int out_size, void* d_ws,
                              size_t ws_size, hipStream_t stream) {
  static int grid_blocks = 0;
  if (!grid_blocks) {
    int dev = 0, cus = 0, per_cu = 0;
    hipGetDevice(&dev);
    hipDeviceGetAttribute(&cus, hipDeviceAttributeMultiprocessorCount, dev);
#if SINGLE_LAUNCH
    hipOccupancyMaxActiveBlocksPerMultiprocessor(&per_cu, mega, 256, 0);
#else
    hipOccupancyMaxActiveBlocksPerMultiprocessor(&per_cu, mega_one, 256, 0);
#endif
    if (per_cu < 1) per_cu = 1;
    if (per_cu > 2) per_cu = 2;
    grid_blocks = cus * per_cu;
  }
  if (ws_size < WS_NEED || n_in < N_INPUTS) {
    fprintf(stderr, "workspace too small or bad inputs: %zu < %zu\n", ws_size, (size_t)WS_NEED);
    return;
  }
  Params p{};
  for (int i = 0; i < N_INPUTS; ++i) p.in[i] = (const float*)d_in[i];
  p.out = (float*)d_out;
  p.ws = (char*)d_ws;
#ifndef PROG
#define PROG PH_PREP, PH_H0, PH_O1, PH_O2, PH_O3, PH_O4, PH_O5, PH_O6, PH_O7, PH_O8, PH_O9, PH_O10, PH_FINAL
#endif
  const int prog[] = {PROG};
  p.nprog = (int)(sizeof(prog) / sizeof(int));
  for (int i = 0; i < p.nprog; ++i) p.prog[i] = prog[i];
#if SINGLE_LAUNCH
  hipMemsetAsync((char*)d_ws + O_BAR, 0, BAR_BYTES, stream);
  void* args[] = {&p};
  hipError_t e = hipLaunchCooperativeKernel((void*)mega, dim3(grid_blocks), dim3(256), args, 0, stream);
  if (e != hipSuccess) fprintf(stderr, "cooperative launch failed: %s (grid %d)\n", hipGetErrorString(e), grid_blocks);
#else
  for (int i = 0; i < p.nprog; ++i) {
    mega_one<<<dim3(grid_blocks), dim3(256), 0, stream>>>(p, p.prog[i]);
  }
#endif
}
```
